# Optimizing an MI355X kernel written in HIP

```python
import math
import jax, jax.numpy as jnp
from jax import lax
import numpy as np

D_MODEL = 1024
BATCH = 1
SEQ = 16384
DEPTH = 4

GRID_W = 64
CTX_LEN = 256
MIXERS = ('chunk_mlp', 'mlstm', 'rglru', 'fourier')
N_MIXERS = 4
PREFIX_READERS = ('mlstm', 'rglru')
N_MOD = 6
EPS = 1e-6
POS_BASE = 10000.0
CONV_WIDTH = 4
CM_CHUNK = 128
CM_WIDTH = 1024
CM_GROUPS = 4
ML_HEADS = 4
ML_DK = 128
ML_DV = 256
ML_QK = ML_HEADS * ML_DK
ML_V = ML_HEADS * ML_DV
ML_CHUNK = 128
ML_IN = 2 * ML_QK + 2 * ML_V + 4 * ML_HEADS
LRU_WIDTH = 1280
LRU_HEADS = 10
LRU_BLOCK = LRU_WIDTH // LRU_HEADS
LRU_C = 8.0
FN_WIDTH = 1024
FN_GROUPS = 4
MOE_GROUPS = 4
MOE_EXPERTS_PER_GROUP = 8
MOE_EXPERTS = MOE_GROUPS * MOE_EXPERTS_PER_GROUP
MOE_TOPK = 2
MOE_HIDDEN = 512
MOE_BLOCK = 128

kernel_name = 'hybrid_interleaved_diffusion_block'


def _rms_norm(x, g):
    xf = x.astype(jnp.float32)
    y = xf * lax.rsqrt(jnp.mean(xf * xf, axis=-1, keepdims=True) + EPS)
    return (y * g.astype(jnp.float32)).astype(x.dtype)


def _modulate(h, shift, scale):
    return h * (1 + scale) + shift


def _dwconv_centred(x, w, b):
    k_w = w.shape[0]
    left = k_w // 2
    right = k_w - 1 - left
    t = x.shape[1]
    xp = jnp.pad(x, ((0, 0), (left, right), (0, 0)))
    y = xp[:, 0:t] * w[0]
    for j in range(1, k_w):
        y = y + xp[:, j:j + t] * w[j]
    return y + b


def _grid_pos_embedding(n_tok, d):
    rows = n_tok // GRID_W
    r = jnp.repeat(jnp.arange(rows, dtype=jnp.float32), GRID_W)
    col = jnp.tile(jnp.arange(GRID_W, dtype=jnp.float32), rows)
    q = d // 4
    freq = jnp.exp(-math.log(POS_BASE) * jnp.arange(q, dtype=jnp.float32) / q)
    ar = r[:, None] * freq
    ac = col[:, None] * freq
    return jnp.concatenate([jnp.sin(ar), jnp.cos(ar), jnp.sin(ac), jnp.cos(ac)], axis=-1)


def _chunk_mlp(h, w_in, v_norm_g, w_s, b_s, w_out):
    bsz, t, _ = h.shape
    z = jax.nn.gelu(h @ w_in)
    u = z[..., :CM_WIDTH]
    v = _rms_norm(z[..., CM_WIDTH:], v_norm_g)
    vb = v.reshape(bsz, t // CM_CHUNK, CM_CHUNK, CM_GROUPS, CM_WIDTH // CM_GROUPS)
    s = jnp.einsum('gts,bnsgc->bntgc', w_s, vb) + b_s.T[None, None, :, :, None]
    return (u * s.reshape(bsz, t, CM_WIDTH)) @ w_out


def _fourier_mix(h, w_in, w_out):
    bsz, t, _ = h.shape
    z = (h @ w_in).astype(jnp.float32).reshape(bsz, t, FN_GROUPS, FN_WIDTH // FN_GROUPS)
    f = jnp.fft.fftn(z, axes=(1, 3), norm='ortho').real
    return f.reshape(bsz, t, FN_WIDTH).astype(h.dtype) @ w_out


def _heads_to_chunks(a):
    bsz, t, nh, d = a.shape
    return a.reshape(bsz, t // ML_CHUNK, ML_CHUNK, nh, d).transpose(0, 3, 1, 2, 4)


def _gates_to_chunks(a):
    bsz, t, nh = a.shape
    return a.reshape(bsz, t // ML_CHUNK, ML_CHUNK, nh).transpose(0, 3, 1, 2)


def _chunks_to_heads(a):
    bsz, nh, nc, cl, d = a.shape
    return a.transpose(0, 2, 3, 1, 4).reshape(bsz, nc * cl, nh, d)


def _mlstm_chunk_states(k, v, li, lf, state0):
    b = jnp.cumsum(lf, axis=-1)
    g = b[..., -1]
    a = g[..., None] - b + li
    m_loc = jnp.max(a, axis=-1)
    kw = k * jnp.exp(a - m_loc[..., None])[..., None]
    c_loc = jnp.einsum('bhnlk,bhnlv->bhnkv', kw, v)
    n_loc = jnp.sum(kw, axis=-2)

    def step(carry, inp):
        c_prev, n_prev, m_prev = carry
        cl, nl, ml, gl = inp
        m_new = jnp.maximum(gl + m_prev, ml)
        dec = jnp.exp(gl + m_prev - m_new)
        sc = jnp.exp(ml - m_new)
        c_new = dec[..., None, None] * c_prev + sc[..., None, None] * cl
        n_new = dec[..., None] * n_prev + sc[..., None] * nl
        return (c_new, n_new, m_new), (c_prev, n_prev, m_prev)

    xs = (jnp.moveaxis(c_loc, 2, 0), jnp.moveaxis(n_loc, 2, 0),
          jnp.moveaxis(m_loc, 2, 0), jnp.moveaxis(g, 2, 0))
    final, starts = lax.scan(step, state0, xs)
    starts = tuple(jnp.moveaxis(s, 0, 2) for s in starts)
    return starts, final


def _mlstm_chunk_outputs(q, k, v, li, lf, starts):
    c0, n0, m0 = starts
    cl = q.shape[-2]
    b = jnp.cumsum(lf, axis=-1)
    inter = b + m0[..., None]
    past_in_chunk = jnp.tril(jnp.ones((cl, cl), dtype=bool))
    dlog = jnp.where(past_in_chunk, b[..., :, None] - b[..., None, :] + li[..., None, :], -jnp.inf)
    m = jnp.maximum(inter, jnp.max(dlog, axis=-1))
    s = jnp.einsum('bhntk,bhnsk->bhnts', q, k) * jnp.exp(dlog - m[..., None])
    w_inter = jnp.exp(inter - m)
    num = jnp.einsum('bhnts,bhnsv->bhntv', s, v) + w_inter[..., None] * jnp.einsum('bhntk,bhnkv->bhntv', q, c0)
    den = jnp.sum(s, axis=-1) + w_inter * jnp.einsum('bhntk,bhnk->bhnt', q, n0)
    return num / jnp.maximum(jnp.abs(den), jnp.exp(-m))[..., None]


def _mlstm_direction(q, k, v, li, lf, state0, want_out):
    kc, vc = _heads_to_chunks(k), _heads_to_chunks(v)
    lic, lfc = _gates_to_chunks(li), _gates_to_chunks(lf)
    starts, final = _mlstm_chunk_states(kc, vc, lic, lfc, state0)
    if not want_out:
        return None, final
    h = _mlstm_chunk_outputs(_heads_to_chunks(q), kc, vc, lic, lfc, starts)
    return _chunks_to_heads(h), final


def _mlstm_mixer(h_ctx, h_lat, want_ctx_out, w_in, conv_w, conv_b, gate_b, norm_g, w_out):
    f32 = jnp.float32

    def project(h):
        bsz, t, _ = h.shape
        z = h @ w_in
        qk = jax.nn.silu(_dwconv_centred(z[..., :2 * ML_QK], conv_w, conv_b)).astype(f32)
        q = qk[..., :ML_QK].reshape(bsz, t, ML_HEADS, ML_DK) * (ML_DK ** -0.5)
        k = qk[..., ML_QK:].reshape(bsz, t, ML_HEADS, ML_DK)
        v = z[..., 2 * ML_QK:2 * ML_QK + ML_V].astype(f32).reshape(bsz, t, ML_HEADS, ML_DV)
        o = z[..., 2 * ML_QK + ML_V:2 * ML_QK + 2 * ML_V]
        pre = z[..., 2 * ML_QK + 2 * ML_V:].astype(f32).reshape(bsz, t, 2, 2, ML_HEADS) + gate_b.astype(f32)
        li = pre[:, :, :, 0]
        lf = jax.nn.log_sigmoid(pre[:, :, :, 1])
        return q, k, v, o, li, lf

    def readout(h_sum, o):
        bsz, t = o.shape[:2]
        hn = h_sum * lax.rsqrt(jnp.mean(h_sum * h_sum, axis=-1, keepdims=True) + EPS)
        hn = hn.reshape(bsz, t, ML_V) * norm_g.astype(f32)
        return (hn.astype(o.dtype) * jax.nn.sigmoid(o)) @ w_out

    qc, kc, vc, oc, lic, lfc = project(h_ctx)
    ql, kl, vl, ol, lil, lfl = project(h_lat)
    bsz = h_lat.shape[0]
    zero = (jnp.zeros((bsz, ML_HEADS, ML_DK, ML_DV), f32),
            jnp.zeros((bsz, ML_HEADS, ML_DK), f32),
            jnp.zeros((bsz, ML_HEADS), f32))
    ident = lambda a: a
    rev = lambda a: jnp.flip(a, axis=1)
    outs_ctx, outs_lat = [], []
    for d, order in enumerate((ident, rev)):
        hc, state = _mlstm_direction(order(qc), order(kc), order(vc), order(lic[:, :, d]),
                                     order(lfc[:, :, d]), zero, want_ctx_out)
        hl, _ = _mlstm_direction(order(ql), order(kl), order(vl), order(lil[:, :, d]),
                                 order(lfl[:, :, d]), state, True)
        outs_lat.append(order(hl))
        if want_ctx_out:
            outs_ctx.append(order(hc))
    y_lat = readout(outs_lat[0] + outs_lat[1], ol)
    y_ctx = readout(outs_ctx[0] + outs_ctx[1], oc) if want_ctx_out else None
    return y_ctx, y_lat


def _linrec_combine(left, right):
    a_l, b_l = left
    a_r, b_r = right
    return a_l * a_r, a_r * b_l + b_r


def _rglru_mixer(h_ctx, h_lat, want_ctx_out, w_in, conv_w, conv_b, w_a, b_a, w_x, b_x, lam, w_out):
    f32 = jnp.float32

    def branches(h):
        z = h @ w_in
        return (jax.nn.gelu(z[..., :LRU_WIDTH]),
                _dwconv_centred(z[..., LRU_WIDTH:], conv_w, conv_b).astype(f32))

    def block_diag_gate(xr, w, b):
        bsz, t, _ = xr.shape
        y = jnp.einsum('btnc,ncd->btnd', xr.reshape(bsz, t, LRU_HEADS, LRU_BLOCK), w.astype(f32))
        return jax.nn.sigmoid(y.reshape(bsz, t, LRU_WIDTH) + b.astype(f32))

    def recur(xr, d, h0, reverse):
        r = block_diag_gate(xr, w_a[d], b_a[d])
        i = block_diag_gate(xr, w_x[d], b_x[d])
        log_a = -LRU_C * r * jax.nn.softplus(-lam[d].astype(f32))
        a = jnp.exp(log_a)
        u = jnp.sqrt(-jnp.expm1(2.0 * log_a)) * (i * xr)
        a_cum, u_cum = lax.associative_scan(_linrec_combine, (a, u), reverse=reverse, axis=1)
        return a_cum * h0[:, None, :] + u_cum

    g_c, x_c = branches(h_ctx)
    g_l, x_l = branches(h_lat)
    h0 = jnp.zeros((h_lat.shape[0], LRU_WIDTH), f32)
    hl_sum = 0.0
    hc_sum = 0.0
    for d, reverse in ((0, False), (1, True)):
        hc = recur(x_c, d, h0, reverse)
        state = hc[:, 0] if reverse else hc[:, -1]
        hl_sum = hl_sum + recur(x_l, d, state, reverse)
        if want_ctx_out:
            hc_sum = hc_sum + hc
    y_lat = (g_l * hl_sum.astype(g_l.dtype)) @ w_out
    y_ctx = (g_c * hc_sum.astype(g_c.dtype)) @ w_out if want_ctx_out else None
    return y_ctx, y_lat


def _hier_moe(h, rg_w, rg_b, re_w, re_b, w_gate, w_up, w_down):
    n_tok, d = h.shape
    g_logits = (h @ rg_w + rg_b).astype(jnp.float32)
    grp = jnp.argmax(g_logits, axis=-1)
    p_grp = jnp.take_along_axis(jax.nn.softmax(g_logits, axis=-1), grp[:, None], axis=-1)
    e_logits = (h @ re_w + re_b).astype(jnp.float32).reshape(n_tok, MOE_GROUPS, MOE_EXPERTS_PER_GROUP)
    e_in_grp = jnp.take_along_axis(e_logits, grp[:, None, None], axis=1)[:, 0]
    top_val, top_idx = lax.top_k(e_in_grp, MOE_TOPK)
    weight = (jax.nn.softmax(top_val, axis=-1) * p_grp).astype(h.dtype)
    expert = grp[:, None] * MOE_EXPERTS_PER_GROUP + top_idx
    n_asg = n_tok * MOE_TOPK
    flat_e = expert.reshape(n_asg)
    order = jnp.argsort(flat_e)
    se = flat_e[order]
    stok = order // MOE_TOPK
    sw = weight.reshape(n_asg)[order]
    counts = jnp.bincount(flat_e, length=MOE_EXPERTS)
    seg_start = jnp.cumsum(counts) - counts
    padded = (counts + MOE_BLOCK - 1) // MOE_BLOCK * MOE_BLOCK
    pad_end = jnp.cumsum(padded)
    pad_start = pad_end - padded
    dest = pad_start[se] + jnp.arange(n_asg) - seg_start[se]
    n_blocks = -(-(n_asg + MOE_EXPERTS * (MOE_BLOCK - 1)) // MOE_BLOCK)
    buf = jnp.zeros((n_blocks * MOE_BLOCK, d), h.dtype).at[dest].set(h[stok])
    blk_expert = jnp.minimum(jnp.searchsorted(pad_end, jnp.arange(n_blocks) * MOE_BLOCK, side='right'),
                             MOE_EXPERTS - 1)

    def expert_block(args):
        xb, e = args
        return (jax.nn.silu(xb @ w_gate[e]) * (xb @ w_up[e])) @ w_down[e]

    ybuf = lax.map(expert_block, (buf.reshape(n_blocks, MOE_BLOCK, d), blk_expert)).reshape(-1, d)
    return jnp.zeros_like(h).at[stok].add(ybuf[dest] * sw[:, None])


def setup_inputs(seed: int = 0) -> dict:
    key = jax.random.key(seed)
    keys = iter(jax.random.split(key, 64))

    def nrm(shape, scale):
        return jax.random.normal(next(keys), shape, jnp.float32) * scale

    d = D_MODEL
    n_a, n_b, n_c, n_d = (len(range(m, DEPTH, N_MIXERS)) for m in range(N_MIXERS))
    ml_gate_b = nrm((n_b, 2, 2, ML_HEADS), 0.1).at[:, :, 1].add(jnp.linspace(3.0, 6.0, ML_HEADS))
    u = jax.random.uniform(next(keys), (n_c, 2, LRU_WIDTH), jnp.float32, 0.9, 0.999)
    p = u ** (1.0 / LRU_C)
    lru_lambda = jnp.log(p) - jnp.log1p(-p)
    return {
        'x': nrm((BATCH, SEQ, d), 1.0),
        'c': nrm((BATCH, d), 1.0),
        'ctx': nrm((BATCH, CTX_LEN, d), 1.0),
        'c_ctx': nrm((d,), 1.0),
        'ada_w': nrm((DEPTH, d, N_MOD * d), 0.5 * d ** -0.5),
        'ada_b': nrm((DEPTH, N_MOD * d), 0.02),
        'norm_mix_g': 1.0 + nrm((DEPTH, d), 0.1),
        'norm_ffn_g': 1.0 + nrm((DEPTH, d), 0.1),
        'final_norm_g': 1.0 + nrm((d,), 0.1),
        'router_group_w': nrm((DEPTH, d, MOE_GROUPS), d ** -0.5),
        'router_group_b': nrm((DEPTH, MOE_GROUPS), 0.01),
        'router_expert_w': nrm((DEPTH, d, MOE_EXPERTS), d ** -0.5),
        'router_expert_b': nrm((DEPTH, MOE_EXPERTS), 0.01),
        'expert_w_gate': nrm((DEPTH, MOE_EXPERTS, d, MOE_HIDDEN), d ** -0.5),
        'expert_w_up': nrm((DEPTH, MOE_EXPERTS, d, MOE_HIDDEN), d ** -0.5),
        'expert_w_down': nrm((DEPTH, MOE_EXPERTS, MOE_HIDDEN, d), MOE_HIDDEN ** -0.5),
        'cm_w_in': nrm((n_a, d, 2 * CM_WIDTH), d ** -0.5),
        'cm_v_norm_g': 1.0 + nrm((n_a, CM_WIDTH), 0.1),
        'cm_w_s': nrm((n_a, CM_GROUPS, CM_CHUNK, CM_CHUNK), CM_CHUNK ** -0.5),
        'cm_b_s': nrm((n_a, CM_GROUPS, CM_CHUNK), 0.02),
        'cm_w_out': nrm((n_a, CM_WIDTH, d), CM_WIDTH ** -0.5),
        'ml_w_in': nrm((n_b, d, ML_IN), d ** -0.5),
        'ml_conv_w': nrm((n_b, CONV_WIDTH, 2 * ML_QK), CONV_WIDTH ** -0.5),
        'ml_conv_b': nrm((n_b, 2 * ML_QK), 0.02),
        'ml_gate_b': ml_gate_b,
        'ml_norm_g': 1.0 + nrm((n_b, ML_V), 0.1),
        'ml_w_out': nrm((n_b, ML_V, d), ML_V ** -0.5),
        'lru_w_in': nrm((n_c, d, 2 * LRU_WIDTH), d ** -0.5),
        'lru_conv_w': nrm((n_c, CONV_WIDTH, LRU_WIDTH), CONV_WIDTH ** -0.5),
        'lru_conv_b': nrm((n_c, LRU_WIDTH), 0.02),
        'lru_w_a': nrm((n_c, 2, LRU_HEADS, LRU_BLOCK, LRU_BLOCK), LRU_BLOCK ** -0.5),
        'lru_b_a': nrm((n_c, 2, LRU_WIDTH), 0.02),
        'lru_w_x': nrm((n_c, 2, LRU_HEADS, LRU_BLOCK, LRU_BLOCK), LRU_BLOCK ** -0.5),
        'lru_b_x': nrm((n_c, 2, LRU_WIDTH), 0.02),
        'lru_lambda': lru_lambda,
        'lru_w_out': nrm((n_c, LRU_WIDTH, d), LRU_WIDTH ** -0.5),
        'fn_w_in': nrm((n_d, d, FN_WIDTH), d ** -0.5),
        'fn_w_out': nrm((n_d, FN_WIDTH, d), FN_WIDTH ** -0.5),
    }


def reference(x, c, ctx, c_ctx, ada_w, ada_b, norm_mix_g, norm_ffn_g, final_norm_g,
              router_group_w, router_group_b, router_expert_w, router_expert_b,
              expert_w_gate, expert_w_up, expert_w_down,
              cm_w_in, cm_v_norm_g, cm_w_s, cm_b_s, cm_w_out,
              ml_w_in, ml_conv_w, ml_conv_b, ml_gate_b, ml_norm_g, ml_w_out,
              lru_w_in, lru_conv_w, lru_conv_b, lru_w_a, lru_b_a, lru_w_x, lru_b_x, lru_lambda, lru_w_out,
              fn_w_in, fn_w_out):
    bsz, seq, d = x.shape
    n_ctx = ctx.shape[1]
    lat = x + _grid_pos_embedding(seq, d).astype(x.dtype)[None]
    cx = ctx
    readers = [i for i in range(DEPTH) if MIXERS[i % N_MIXERS] in PREFIX_READERS]
    last_reader = readers[-1] if readers else -1
    silu_c = jax.nn.silu(c)
    silu_cc = jax.nn.silu(c_ctx)
    for i in range(DEPTH):
        kind = MIXERS[i % N_MIXERS]
        j = i // N_MIXERS
        ctx_in = i <= last_reader
        ctx_upd = i < last_reader
        mod_l = jnp.split((silu_c @ ada_w[i] + ada_b[i])[:, None, :], N_MOD, axis=-1)
        hl = _modulate(_rms_norm(lat, norm_mix_g[i]), mod_l[0], mod_l[1])
        hc = None
        mod_c = None
        if ctx_in:
            mod_c = jnp.split((silu_cc @ ada_w[i] + ada_b[i])[None, None, :], N_MOD, axis=-1)
            hc = _modulate(_rms_norm(cx, norm_mix_g[i]), mod_c[0], mod_c[1])
        if kind == 'chunk_mlp':
            prm = (cm_w_in[j], cm_v_norm_g[j], cm_w_s[j], cm_b_s[j], cm_w_out[j])
            yl = _chunk_mlp(hl, *prm)
            yc = _chunk_mlp(hc, *prm) if ctx_upd else None
        elif kind == 'fourier':
            yl = _fourier_mix(hl, fn_w_in[j], fn_w_out[j])
            yc = _fourier_mix(hc, fn_w_in[j], fn_w_out[j]) if ctx_upd else None
        elif kind == 'mlstm':
            yc, yl = _mlstm_mixer(hc, hl, ctx_upd, ml_w_in[j], ml_conv_w[j], ml_conv_b[j],
                                  ml_gate_b[j], ml_norm_g[j], ml_w_out[j])
        else:
            yc, yl = _rglru_mixer(hc, hl, ctx_upd, lru_w_in[j], lru_conv_w[j], lru_conv_b[j],
                                  lru_w_a[j], lru_b_a[j], lru_w_x[j], lru_b_x[j], lru_lambda[j],
                                  lru_w_out[j])
        lat = lat + mod_l[2] * yl
        if ctx_upd:
            cx = cx + mod_c[2] * yc
        moe_p = (router_group_w[i], router_group_b[i], router_expert_w[i], router_expert_b[i],
                 expert_w_gate[i], expert_w_up[i], expert_w_down[i])
        hl2 = _modulate(_rms_norm(lat, norm_ffn_g[i]), mod_l[3], mod_l[4])
        if ctx_upd:
            hc2 = _modulate(_rms_norm(cx, norm_ffn_g[i]), mod_c[3], mod_c[4])
            tok = jnp.concatenate([hc2, hl2], axis=1)
            y = _hier_moe(tok.reshape(-1, d), *moe_p).reshape(tok.shape)
            cx = cx + mod_c[5] * y[:, :n_ctx]
            lat = lat + mod_l[5] * y[:, n_ctx:]
        else:
            y = _hier_moe(hl2.reshape(-1, d), *moe_p).reshape(hl2.shape)
            lat = lat + mod_l[5] * y
    return _rms_norm(lat, final_norm_g)
```

```cpp
#include <hip/hip_runtime.h>
#include <hip/hip_cooperative_groups.h>
#include <cstdio>
namespace cg = cooperative_groups;

#define T_ALL 16640
#define T_LAT 16384
#define T_CTX 256
#define DM 1024
#define NCH 130
#define EPSN 1e-6f

typedef float act_t;
__device__ __forceinline__ float ldA(const act_t* p) { return *p; }
__device__ __forceinline__ void stA(act_t* p, float v) { *p = v; }

constexpr size_t AL(size_t x) { return (x + 255) & ~(size_t)255; }
constexpr size_t WS_MOD    = 0;
constexpr size_t WS_MODP   = AL(WS_MOD + 4 * 2 * 6144 * 4);
constexpr size_t WS_CNT    = AL(WS_MODP + 16 * 4 * 2 * 6144 * 4);
constexpr size_t WS_TAB    = AL(WS_CNT + 1024);
constexpr size_t WS_TOK    = AL(WS_TAB + 2 * 16384 * 4);
constexpr size_t WS_H      = AL(WS_TOK + (size_t)T_ALL * DM * 4);
constexpr size_t WS_ASGW   = AL(WS_H + (size_t)T_ALL * DM * 4);
constexpr size_t WS_LIST   = AL(WS_ASGW + 33280 * 4);
constexpr size_t WS_ROWTOK = AL(WS_LIST + (size_t)32 * 33280 * 4);
constexpr size_t WS_ROWEXP = AL(WS_ROWTOK + 37376 * 4);
constexpr size_t WS_R      = AL(WS_ROWEXP + 292 * 4);
constexpr size_t R_YBUF = 0;
constexpr size_t R_GU   = AL(R_YBUF + (size_t)33280 * 1024 * 4);
constexpr size_t R_MOE_END = AL(R_GU + (size_t)37376 * 1024 * 4);
constexpr size_t R0_ZU = 0;
constexpr size_t R0_ZV = AL(R0_ZU + (size_t)T_ALL * 1024 * 4);
constexpr size_t R0_P  = AL(R0_ZV + (size_t)T_ALL * 1024 * 4);
constexpr size_t R0_RV = AL(R0_P + (size_t)T_ALL * 1024 * 4);
constexpr size_t R0_END = AL(R0_RV + T_ALL * 4);
constexpr size_t R1_Z    = 0;
constexpr size_t R1_GPRE = AL(R1_Z + (size_t)T_ALL * 3072 * 4);
constexpr size_t R1_QK   = AL(R1_GPRE + (size_t)T_ALL * 16 * 4);
constexpr size_t R1_BC   = AL(R1_QK + (size_t)T_ALL * 1024 * 4);
constexpr size_t R1_LI   = AL(R1_BC + (size_t)8 * T_ALL * 4);
constexpr size_t R1_GCH  = AL(R1_LI + (size_t)8 * T_ALL * 4);
constexpr size_t R1_CST  = AL(R1_GCH + 8 * NCH * 4);
constexpr size_t R1_NST  = AL(R1_CST + (size_t)8 * T_ALL * 256 * 4);
constexpr size_t R1_SB   = AL(R1_NST + (size_t)8 * T_ALL * 4);
constexpr size_t R1_HNUM = AL(R1_SB + (size_t)8 * T_ALL * 128 * 4);
constexpr size_t R1_HDEN = AL(R1_HNUM + (size_t)8 * T_ALL * 256 * 4);
constexpr size_t R1_A2   = AL(R1_HDEN + (size_t)8 * T_ALL * 4);
constexpr size_t R1_END  = AL(R1_A2 + (size_t)T_ALL * 1024 * 4);
constexpr size_t R2_ZG  = 0;
constexpr size_t R2_ZX  = AL(R2_ZG + (size_t)T_ALL * 1280 * 4);
constexpr size_t R2_XC  = AL(R2_ZX + (size_t)T_ALL * 1280 * 4);
constexpr size_t R2_R4  = AL(R2_XC + (size_t)T_ALL * 1280 * 4);
constexpr size_t R2_CA  = AL(R2_R4 + (size_t)4 * T_ALL * 1280 * 4);
constexpr size_t R2_CH  = AL(R2_CA + 2 * NCH * 1280 * 4);
constexpr size_t R2_CIN = AL(R2_CH + 2 * NCH * 1280 * 4);
constexpr size_t R2_END = AL(R2_CIN + 2 * NCH * 1280 * 4);
constexpr size_t R3_ZF = 0;
constexpr size_t R3_PQ = AL(R3_ZF + (size_t)T_LAT * 1024 * 4);
constexpr size_t R3_FF = AL(R3_PQ + (size_t)T_LAT * 2048 * 4);
constexpr size_t R3_END = AL(R3_FF + (size_t)T_LAT * 1024 * 4);
constexpr size_t cmax(size_t a, size_t b) { return a > b ? a : b; }
constexpr size_t R_SIZE = cmax(cmax(R_MOE_END, R0_END), cmax(cmax(R1_END, R2_END), R3_END));
constexpr size_t WS_NEED = WS_R + R_SIZE;

struct Params { const float* in[38]; float* out; unsigned char* ws; };

__device__ __forceinline__ float sigmoid_f(float x) { return 1.f / (1.f + expf(-x)); }
__device__ __forceinline__ float silu_f(float x) { return x / (1.f + expf(-x)); }
__device__ __forceinline__ float gelu_f(float x) {
  return 0.5f * x * (1.f + tanhf(0.7978845608028654f * (x + 0.044715f * x * x * x)));
}
__device__ __forceinline__ float logsig_f(float x) { return fminf(x, 0.f) - log1pf(expf(-fabsf(x))); }
__device__ __forceinline__ float wave_sum(float v) {
#pragma unroll
  for (int o = 32; o >= 1; o >>= 1) v += __shfl_xor(v, o);
  return v;
}
__device__ __forceinline__ int scan_order(int d, int i) { return d == 0 ? i : (i == 0 ? 1 : (i == 1 ? 0 : 131 - i)); }

template <class AF, class BF, class EF>
__device__ __forceinline__ void gemm_naive(int M, int N, int K, AF af, BF bf, EF ef, float* smem) {
  const int tid = threadIdx.x;
  const int tilesM = (M + 63) >> 6, tilesN = (N + 63) >> 6;
  const int ntiles = tilesM * tilesN;
  float (*As)[68] = (float (*)[68])smem;
  float (*Bs)[68] = (float (*)[68])(smem + 16 * 68);
  const int ty = tid >> 4, tx = tid & 15;
  for (int tile = blockIdx.x; tile < ntiles; tile += gridDim.x) {
    const int tm = tile / tilesN, tn = tile - tm * tilesN;
    const int m0 = tm << 6, n0 = tn << 6;
    float acc[4][4];
#pragma unroll
    for (int i = 0; i < 4; ++i)
#pragma unroll
      for (int j = 0; j < 4; ++j) acc[i][j] = 0.f;
    for (int k0 = 0; k0 < K; k0 += 16) {
#pragma unroll
      for (int i = 0; i < 4; ++i) {
        const int mm = (tid >> 4) + 16 * i, kk = tid & 15;
        const int m = m0 + mm, k = k0 + kk;
        As[kk][mm] = (m < M && k < K) ? af(m, k, n0) : 0.f;
      }
#pragma unroll
      for (int i = 0; i < 4; ++i) {
        const int kk = (tid >> 6) + 4 * i, nn = tid & 63;
        const int k = k0 + kk, n = n0 + nn;
        Bs[kk][nn] = (k < K && n < N) ? bf(k, n, m0) : 0.f;
      }
      __syncthreads();
#pragma unroll
      for (int kk = 0; kk < 16; ++kk) {
        const float4 a = *(const float4*)&As[kk][ty * 4];
        const float4 b = *(const float4*)&Bs[kk][tx * 4];
        const float av[4] = {a.x, a.y, a.z, a.w};
        const float bv[4] = {b.x, b.y, b.z, b.w};
#pragma unroll
        for (int i = 0; i < 4; ++i)
#pragma unroll
          for (int j = 0; j < 4; ++j) acc[i][j] = fmaf(av[i], bv[j], acc[i][j]);
      }
      __syncthreads();
    }
#pragma unroll
    for (int i = 0; i < 4; ++i)
#pragma unroll
      for (int j = 0; j < 4; ++j) {
        const int m = m0 + ty * 4 + i, n = n0 + tx * 4 + j;
        if (m < M && n < N) ef(m, n, acc[i][j]);
      }
  }
}

__device__ __forceinline__ void norm_phase(const Params& P, int t0, const float* gw,
                                           int mod_layer, int shift_idx,
                                           int pend_layer, int pend_t0,
                                           bool to_out, bool router, int layer) {
  unsigned char* ws = P.ws;
  float* tok = (float*)(ws + WS_TOK);
  act_t* hb = (act_t*)(ws + WS_H);
  const float* mod = (const float*)(ws + WS_MOD);
  const float* ybuf = (const float*)(ws + WS_R + R_YBUF);
  const int lane = threadIdx.x & 63;
  const int gw_id = blockIdx.x * 4 + (threadIdx.x >> 6);
  const int gw_n = gridDim.x * 4;
  for (int t = t0 + gw_id; t < T_ALL; t += gw_n) {
    const int s = (t < T_CTX) ? 1 : 0;
    float v[16];
#pragma unroll
    for (int j = 0; j < 4; ++j) {
      const int n = j * 256 + lane * 4;
      const float4 x = *(const float4*)&tok[(size_t)t * DM + n];
      v[j * 4 + 0] = x.x; v[j * 4 + 1] = x.y; v[j * 4 + 2] = x.z; v[j * 4 + 3] = x.w;
    }
    if (pend_layer >= 0 && t >= pend_t0) {
      const float* gate = mod + (size_t)((pend_layer * 2 + s) * 6 + 5) * 1024;
#pragma unroll
      for (int j = 0; j < 4; ++j) {
        const int n = j * 256 + lane * 4;
        const float4 y0 = *(const float4*)&ybuf[(size_t)(2 * t) * DM + n];
        const float4 y1 = *(const float4*)&ybuf[(size_t)(2 * t + 1) * DM + n];
        const float4 g = *(const float4*)&gate[n];
        v[j * 4 + 0] += g.x * (y0.x + y1.x);
        v[j * 4 + 1] += g.y * (y0.y + y1.y);
        v[j * 4 + 2] += g.z * (y0.z + y1.z);
        v[j * 4 + 3] += g.w * (y0.w + y1.w);
        *(float4*)&tok[(size_t)t * DM + n] = make_float4(v[j * 4 + 0], v[j * 4 + 1], v[j * 4 + 2], v[j * 4 + 3]);
      }
    }
    float ss = 0.f;
#pragma unroll
    for (int e = 0; e < 16; ++e) ss += v[e] * v[e];
    ss = wave_sum(ss);
    const float r = 1.f / sqrtf(ss * (1.f / 1024.f) + EPSN);
    float h[16];
#pragma unroll
    for (int j = 0; j < 4; ++j) {
      const int n = j * 256 + lane * 4;
      const float4 g = *(const float4*)&gw[n];
      h[j * 4 + 0] = v[j * 4 + 0] * r * g.x;
      h[j * 4 + 1] = v[j * 4 + 1] * r * g.y;
      h[j * 4 + 2] = v[j * 4 + 2] * r * g.z;
      h[j * 4 + 3] = v[j * 4 + 3] * r * g.w;
      if (shift_idx >= 0) {
        const float* sh = mod + (size_t)((mod_layer * 2 + s) * 6 + shift_idx) * 1024;
        const float* sc = sh + 1024;
        const float4 a = *(const float4*)&sh[n];
        const float4 b = *(const float4*)&sc[n];
        h[j * 4 + 0] = h[j * 4 + 0] * (1.f + b.x) + a.x;
        h[j * 4 + 1] = h[j * 4 + 1] * (1.f + b.y) + a.y;
        h[j * 4 + 2] = h[j * 4 + 2] * (1.f + b.z) + a.z;
        h[j * 4 + 3] = h[j * 4 + 3] * (1.f + b.w) + a.w;
      }
      if (to_out) {
        *(float4*)&P.out[(size_t)(t - T_CTX) * DM + n] = make_float4(h[j * 4 + 0], h[j * 4 + 1], h[j * 4 + 2], h[j * 4 + 3]);
      } else {
        stA(&hb[(size_t)t * DM + n + 0], h[j * 4 + 0]);
        stA(&hb[(size_t)t * DM + n + 1], h[j * 4 + 1]);
        stA(&hb[(size_t)t * DM + n + 2], h[j * 4 + 2]);
        stA(&hb[(size_t)t * DM + n + 3], h[j * 4 + 3]);
      }
    }
    if (router) {
      const float* rgw = P.in[9] + (size_t)layer * 1024 * 4;
      const float* rgb = P.in[10] + layer * 4;
      const float* rew = P.in[11] + (size_t)layer * 1024 * 32;
      const float* reb = P.in[12] + layer * 32;
      float lg[36];
#pragma unroll
      for (int q = 0; q < 36; ++q) lg[q] = 0.f;
#pragma unroll
      for (int j = 0; j < 4; ++j) {
#pragma unroll
        for (int e = 0; e < 4; ++e) {
          const int n = j * 256 + lane * 4 + e;
          const float hv = h[j * 4 + e];
          const float4 g4 = *(const float4*)&rgw[(size_t)n * 4];
          lg[0] += hv * g4.x; lg[1] += hv * g4.y; lg[2] += hv * g4.z; lg[3] += hv * g4.w;
#pragma unroll
          for (int q = 0; q < 8; ++q) {
            const float4 w4 = *(const float4*)&rew[(size_t)n * 32 + q * 4];
            lg[4 + q * 4 + 0] += hv * w4.x; lg[4 + q * 4 + 1] += hv * w4.y;
            lg[4 + q * 4 + 2] += hv * w4.z; lg[4 + q * 4 + 3] += hv * w4.w;
          }
        }
      }
#pragma unroll
      for (int q = 0; q < 36; ++q) lg[q] = wave_sum(lg[q]);
#pragma unroll
      for (int q = 0; q < 4; ++q) lg[q] += rgb[q];
#pragma unroll
      for (int q = 0; q < 32; ++q) lg[4 + q] += reb[q];
      int grp = 0; float best = lg[0];
#pragma unroll
      for (int q = 1; q < 4; ++q) if (lg[q] > best) { best = lg[q]; grp = q; }
      float se = 0.f;
#pragma unroll
      for (int q = 0; q < 4; ++q) se += expf(lg[q] - best);
      const float pg = 1.f / se;
      float v0 = -3.0e38f, v1 = -3.0e38f; int i0 = 0, i1 = 0;
#pragma unroll
      for (int g = 0; g < 4; ++g) {
#pragma unroll
        for (int q = 0; q < 8; ++q) {
          const float x = lg[4 + g * 8 + q];
          if (g == grp) {
            if (x > v0) { v1 = v0; i1 = i0; v0 = x; i0 = q; }
            else if (x > v1) { v1 = x; i1 = q; }
          }
        }
      }
      const float w0 = 1.f / (1.f + expf(v1 - v0));
      const float w1 = 1.f - w0;
      if (lane == 0) {
        int* cnt = (int*)(ws + WS_CNT) + layer * 32;
        int* list = (int*)(ws + WS_LIST);
        float* asgw = (float*)(ws + WS_ASGW);
        const int e0 = grp * 8 + i0, e1 = grp * 8 + i1;
        const int p0 = atomicAdd(&cnt[e0], 1);
        list[(size_t)e0 * 33280 + p0] = 2 * t;
        asgw[2 * t] = w0 * pg;
        const int p1 = atomicAdd(&cnt[e1], 1);
        list[(size_t)e1 * 33280 + p1] = 2 * t + 1;
        asgw[2 * t + 1] = w1 * pg;
      }
    }
  }
}

__device__ __forceinline__ void moe_build(const Params& P, int layer, int* sm) {
  unsigned char* ws = P.ws;
  const int* cnt = (const int*)(ws + WS_CNT) + layer * 32;
  int* meta = (int*)(ws + WS_CNT) + 128;
  const int* list = (const int*)(ws + WS_LIST);
  int* rowtok = (int*)(ws + WS_ROWTOK);
  int* rowexp = (int*)(ws + WS_ROWEXP);
  if (threadIdx.x == 0) {
    int s = 0;
    for (int e = 0; e < 32; ++e) { sm[e] = s; s += (cnt[e] + 127) / 128 * 128; }
    sm[32] = s;
  }
  __syncthreads();
  const int total = sm[32];
  for (int m = blockIdx.x * 256 + threadIdx.x; m < total; m += gridDim.x * 256) {
    int e = 0;
    for (int q = 1; q < 32; ++q) if (sm[q] <= m) e = q;
    const int r = m - sm[e];
    rowtok[m] = (r < cnt[e]) ? list[(size_t)e * 33280 + r] : -1;
    if ((m & 127) == 0) rowexp[m >> 7] = e;
  }
  if (blockIdx.x == 0 && threadIdx.x == 0) meta[layer] = total;
  __syncthreads();
}

__global__ void __launch_bounds__(256) mega(Params P) {
  cg::grid_group grid = cg::this_grid();
  __shared__ __attribute__((aligned(16))) float smem[2 * 16 * 68 + 64];
  unsigned char* ws = P.ws;
  const int tid = threadIdx.x;
  const int gtid = blockIdx.x * 256 + tid;
  const int gstride = gridDim.x * 256;
  float* tok = (float*)(ws + WS_TOK);
  act_t* hb = (act_t*)(ws + WS_H);
  float* mod = (float*)(ws + WS_MOD);
  float* cosT = (float*)(ws + WS_TAB);
  float* sinT = cosT + 16384;
  unsigned char* R = ws + WS_R;

  {
    const float* x = P.in[0]; const float* ctx = P.in[2];
    for (int idx = gtid; idx < T_ALL * 256; idx += gstride) {
      const int t = idx >> 8, n = (idx & 255) * 4;
      float4 o;
      if (t < T_CTX) o = *(const float4*)&ctx[(size_t)t * DM + n];
      else {
        const int tl = t - T_CTX;
        o = *(const float4*)&x[(size_t)tl * DM + n];
        float pe[4];
#pragma unroll
        for (int e = 0; e < 4; ++e) {
          const int nn = n + e, qd = nn >> 8, j = nn & 255;
          const float freq = expf(-9.210340371976184f * (float)j / 256.f);
          const float pos = (qd < 2) ? (float)(tl >> 6) : (float)(tl & 63);
          const float ang = pos * freq;
          pe[e] = (qd & 1) ? cosf(ang) : sinf(ang);
        }
        o.x += pe[0]; o.y += pe[1]; o.z += pe[2]; o.w += pe[3];
      }
      *(float4*)&tok[(size_t)t * DM + n] = o;
    }
    const float* c = P.in[1]; const float* cc = P.in[3]; const float* adaw = P.in[4];
    float* modp = (float*)(ws + WS_MODP);
    for (int idx = gtid; idx < 16 * 4 * 6144; idx += gstride) {
      const int ks = idx / 24576, rem = idx - ks * 24576, i = rem / 6144, j = rem - i * 6144;
      float a0 = 0.f, a1 = 0.f;
      for (int k = ks * 64; k < ks * 64 + 64; ++k) {
        const float w = adaw[((size_t)i * 1024 + k) * 6144 + j];
        a0 += silu_f(c[k]) * w;
        a1 += silu_f(cc[k]) * w;
      }
      modp[(size_t)(ks * 8 + i * 2 + 0) * 6144 + j] = a0;
      modp[(size_t)(ks * 8 + i * 2 + 1) * 6144 + j] = a1;
    }
    for (int idx = gtid; idx < 16384; idx += gstride) {
      const double a = (double)idx / 8192.0;
      cosT[idx] = (float)cospi(a);
      sinT[idx] = (float)sinpi(a);
    }
    if (gtid < 256) ((int*)(ws + WS_CNT))[gtid] = 0;
  }
  grid.sync();
  {
    const float* modp = (const float*)(ws + WS_MODP);
    const float* adab = P.in[5];
    for (int idx = gtid; idx < 8 * 6144; idx += gstride) {
      const int is = idx / 6144, j = idx - is * 6144, i = is >> 1;
      float a = adab[i * 6144 + j];
      for (int ks = 0; ks < 16; ++ks) a += modp[(size_t)(ks * 8 + is) * 6144 + j];
      mod[idx] = a;
    }
  }
  grid.sync();

#define MODV(i, s, j, n) mod[(size_t)(((i) * 2 + (s)) * 6 + (j)) * 1024 + (n)]

  auto moe_layer = [&](int layer, int t0) {
    norm_phase(P, t0, P.in[7] + layer * 1024, layer, 3, -1, 0, false, true, layer);
    grid.sync();
    moe_build(P, layer, (int*)smem);
    grid.sync();
    const int total = ((const int*)(ws + WS_CNT))[128 + layer];
    const int* rowtok = (const int*)(ws + WS_ROWTOK);
    const int* rowexp = (const int*)(ws + WS_ROWEXP);
    float* GU = (float*)(R + R_GU);
    float* ybuf = (float*)(R + R_YBUF);
    const float* asgw = (const float*)(ws + WS_ASGW);
    const float* wg = P.in[13] + (size_t)layer * 32 * 1024 * 512;
    const float* wu = P.in[14] + (size_t)layer * 32 * 1024 * 512;
    const float* wd = P.in[15] + (size_t)layer * 32 * 512 * 1024;
    gemm_naive(total, 1024, 1024,
      [=](int m, int k, int n0) -> float { const int rt = rowtok[m]; return rt >= 0 ? ldA(&hb[(size_t)(rt >> 1) * DM + k]) : 0.f; },
      [=](int k, int n, int m0) -> float { const int e = rowexp[m0 >> 7];
        return n < 512 ? wg[((size_t)e * 1024 + k) * 512 + n] : wu[((size_t)e * 1024 + k) * 512 + (n - 512)]; },
      [=](int m, int n, float a) { GU[(size_t)m * 1024 + n] = a; }, smem);
    grid.sync();
    gemm_naive(total, 1024, 512,
      [=](int m, int k, int n0) -> float { return silu_f(GU[(size_t)m * 1024 + k]) * GU[(size_t)m * 1024 + 512 + k]; },
      [=](int k, int n, int m0) -> float { const int e = rowexp[m0 >> 7]; return wd[((size_t)e * 512 + k) * 1024 + n]; },
      [=](int m, int n, float a) { const int rt = rowtok[m]; if (rt >= 0) ybuf[(size_t)rt * 1024 + n] = asgw[rt] * a; }, smem);
    grid.sync();
  };

  {
    norm_phase(P, 0, P.in[6] + 0 * 1024, 0, 0, -1, 0, false, false, 0);
    grid.sync();
    act_t* zu = (act_t*)(R + R0_ZU); act_t* zv = (act_t*)(R + R0_ZV); act_t* pb = (act_t*)(R + R0_P);
    float* rv = (float*)(R + R0_RV);
    const float* w_in = P.in[16]; const float* vg = P.in[17]; const float* w_s = P.in[18];
    const float* b_s = P.in[19]; const float* w_out = P.in[20];
    gemm_naive(T_ALL, 2048, 1024,
      [=](int m, int k, int n0) -> float { return ldA(&hb[(size_t)m * DM + k]); },
      [=](int k, int n, int m0) -> float { return w_in[(size_t)k * 2048 + n]; },
      [=](int m, int n, float a) { const float g = gelu_f(a);
        if (n < 1024) stA(&zu[(size_t)m * 1024 + n], g); else stA(&zv[(size_t)m * 1024 + n - 1024], g); }, smem);
    grid.sync();
    {
      const int lane = tid & 63;
      for (int t = blockIdx.x * 4 + (tid >> 6); t < T_ALL; t += gridDim.x * 4) {
        float ss = 0.f;
        for (int n = lane; n < 1024; n += 64) { const float x = ldA(&zv[(size_t)t * 1024 + n]); ss += x * x; }
        ss = wave_sum(ss);
        if (lane == 0) rv[t] = 1.f / sqrtf(ss * (1.f / 1024.f) + EPSN);
      }
    }
    grid.sync();
    gemm_naive(T_ALL, 1024, 128,
      [=](int m, int k, int n0) -> float { return w_s[((size_t)(n0 >> 8) * 128 + (m & 127)) * 128 + k]; },
      [=](int k, int n, int m0) -> float { const int ts = (m0 & ~127) + k; return ldA(&zv[(size_t)ts * 1024 + n]) * rv[ts]; },
      [=](int m, int n, float a) {
        const float sv = a * vg[n] + b_s[(n >> 8) * 128 + (m & 127)];
        stA(&pb[(size_t)m * 1024 + n], ldA(&zu[(size_t)m * 1024 + n]) * sv); }, smem);
    grid.sync();
    gemm_naive(T_ALL, 1024, 1024,
      [=](int m, int k, int n0) -> float { return ldA(&pb[(size_t)m * 1024 + k]); },
      [=](int k, int n, int m0) -> float { return w_out[(size_t)k * 1024 + n]; },
      [=](int m, int n, float a) { const int s = m < T_CTX ? 1 : 0; tok[(size_t)m * DM + n] += MODV(0, s, 2, n) * a; }, smem);
    grid.sync();
  }
  moe_layer(0, 0);

  {
    norm_phase(P, 0, P.in[6] + 1 * 1024, 1, 0, 0, 0, false, false, 0);
    grid.sync();
    act_t* Z = (act_t*)(R + R1_Z); float* gpre = (float*)(R + R1_GPRE); act_t* qk = (act_t*)(R + R1_QK);
    float* bc = (float*)(R + R1_BC); float* li = (float*)(R + R1_LI); float* gch = (float*)(R + R1_GCH);
    float* Cst = (float*)(R + R1_CST); float* nst = (float*)(R + R1_NST); float* Sb = (float*)(R + R1_SB);
    float* hnum = (float*)(R + R1_HNUM); float* hden = (float*)(R + R1_HDEN); act_t* A2 = (act_t*)(R + R1_A2);
    const float* w_in = P.in[21]; const float* cw = P.in[22]; const float* cb = P.in[23];
    const float* gb = P.in[24]; const float* ng = P.in[25]; const float* w_out = P.in[26];
    gemm_naive(T_ALL, 3088, 1024,
      [=](int m, int k, int n0) -> float { return ldA(&hb[(size_t)m * DM + k]); },
      [=](int k, int n, int m0) -> float { return w_in[(size_t)k * 3088 + n]; },
      [=](int m, int n, float a) { if (n < 3072) stA(&Z[(size_t)m * 3072 + n], a); else gpre[(size_t)m * 16 + n - 3072] = a; }, smem);
    grid.sync();
    for (int idx = gtid; idx < T_ALL * 1024; idx += gstride) {
      const int t = idx >> 10, col = idx & 1023;
      const int lo = t < T_CTX ? 0 : T_CTX, hi = t < T_CTX ? T_CTX : T_ALL;
      float a = cb[col];
#pragma unroll
      for (int j = 0; j < 4; ++j) { const int tt = t + j - 2; if (tt >= lo && tt < hi) a += ldA(&Z[(size_t)tt * 3072 + col]) * cw[j * 1024 + col]; }
      float v = silu_f(a);
      if (col < 512) v *= 0.08838834764831845f;
      stA(&qk[idx], v);
    }
    for (int idx = gtid; idx < 8 * NCH; idx += gstride) {
      const int dh = idx / NCH, n = idx - dh * NCH, d = dh >> 2, hd = dh & 3;
      float b = 0.f;
      for (int st = 0; st < 128; ++st) {
        const int tt = n * 128 + (d == 0 ? st : 127 - st);
        const float pi = gpre[(size_t)tt * 16 + d * 8 + hd] + gb[d * 8 + hd];
        const float pf = gpre[(size_t)tt * 16 + d * 8 + 4 + hd] + gb[d * 8 + 4 + hd];
        b += logsig_f(pf);
        bc[(size_t)dh * T_ALL + tt] = b;
        li[(size_t)dh * T_ALL + tt] = pi;
      }
      gch[idx] = b;
    }
    grid.sync();
    gemm_naive(8 * T_ALL, 257, 128,
      [=](int m, int k, int n0) -> float { const int dh = m / T_ALL, rem = m - dh * T_ALL, n = rem >> 7, kk = rem & 127, hd = dh & 3;
        const int ts = n * 128 + k;
        const float w = expf(gch[dh * NCH + n] - bc[(size_t)dh * T_ALL + ts] + li[(size_t)dh * T_ALL + ts]);
        return w * ldA(&qk[(size_t)ts * 1024 + 512 + hd * 128 + kk]); },
      [=](int k, int n, int m0) -> float { const int dh = m0 / T_ALL, rem = m0 - dh * T_ALL, hd = dh & 3;
        const int ts = (rem & ~127) + k;
        return n < 256 ? ldA(&Z[(size_t)ts * 3072 + 1024 + hd * 256 + n]) : 1.f; },
      [=](int m, int n, float a) { if (n < 256) Cst[(size_t)m * 256 + n] = a; else nst[m] = a; }, smem);
    grid.sync();
    for (int idx = gtid; idx < 8 * (32768 + 128); idx += gstride) {
      const int dh = idx / 32896, e = idx - dh * 32896, d = dh >> 2;
      float st = 0.f;
      for (int i = 0; i < NCH; ++i) {
        const int n = scan_order(d, i);
        float* p = (e < 32768) ? &Cst[((size_t)dh * T_ALL + n * 128) * 256 + e] : &nst[(size_t)dh * T_ALL + n * 128 + (e - 32768)];
        const float tmp = *p;
        *p = st;
        st = expf(gch[dh * NCH + n]) * st + tmp;
      }
    }
    grid.sync();
    gemm_naive(8 * T_ALL, 128, 128,
      [=](int m, int k, int n0) -> float { const int dh = m / T_ALL, tt = m - dh * T_ALL, hd = dh & 3;
        return ldA(&qk[(size_t)tt * 1024 + hd * 128 + k]); },
      [=](int k, int n, int m0) -> float { const int dh = m0 / T_ALL, rem = m0 - dh * T_ALL, hd = dh & 3;
        const int ts = (rem & ~127) + n;
        return ldA(&qk[(size_t)ts * 1024 + 512 + hd * 128 + k]); },
      [=](int m, int n, float a) { const int dh = m / T_ALL, tt = m - dh * T_ALL, d = dh >> 2, t = tt & 127;
        const int ts = (tt & ~127) + n;
        const bool ok = (d == 0) ? (n <= t) : (n >= t);
        const float w = ok ? expf(bc[(size_t)dh * T_ALL + tt] - bc[(size_t)dh * T_ALL + ts] + li[(size_t)dh * T_ALL + ts]) : 0.f;
        Sb[(size_t)m * 128 + n] = a * w; }, smem);
    grid.sync();
    gemm_naive(8 * T_ALL, 257, 256,
      [=](int m, int k, int n0) -> float { const int dh = m / T_ALL, tt = m - dh * T_ALL, hd = dh & 3;
        if (k < 128) return Sb[(size_t)m * 128 + k];
        return expf(bc[(size_t)dh * T_ALL + tt]) * ldA(&qk[(size_t)tt * 1024 + hd * 128 + (k - 128)]); },
      [=](int k, int n, int m0) -> float { const int dh = m0 / T_ALL, rem = m0 - dh * T_ALL, hd = dh & 3;
        if (k < 128) { const int ts = (rem & ~127) + k; return n < 256 ? ldA(&Z[(size_t)ts * 3072 + 1024 + hd * 256 + n]) : 1.f; }
        const int row = (m0 & ~127) + (k - 128);
        return n < 256 ? Cst[(size_t)row * 256 + n] : nst[row]; },
      [=](int m, int n, float a) { if (n < 256) hnum[(size_t)m * 256 + n] = a; else hden[m] = a; }, smem);
    grid.sync();
    {
      const int lane = tid & 63;
      for (int it = blockIdx.x * 4 + (tid >> 6); it < T_ALL * 4; it += gridDim.x * 4) {
        const int tt = it >> 2, hd = it & 3;
        float hs[4] = {0.f, 0.f, 0.f, 0.f};
#pragma unroll
        for (int d = 0; d < 2; ++d) {
          const size_t m = (size_t)(d * 4 + hd) * T_ALL + tt;
          const float dn = fmaxf(fabsf(hden[m]), 1.f);
          const float4 x = *(const float4*)&hnum[m * 256 + lane * 4];
          hs[0] += x.x / dn; hs[1] += x.y / dn; hs[2] += x.z / dn; hs[3] += x.w / dn;
        }
        float ss = hs[0] * hs[0] + hs[1] * hs[1] + hs[2] * hs[2] + hs[3] * hs[3];
        ss = wave_sum(ss);
        const float r = 1.f / sqrtf(ss * (1.f / 256.f) + EPSN);
#pragma unroll
        for (int e = 0; e < 4; ++e) {
          const int col = hd * 256 + lane * 4 + e;
          const float o = ldA(&Z[(size_t)tt * 3072 + 2048 + col]);
          stA(&A2[(size_t)tt * 1024 + col], hs[e] * r * ng[col] * sigmoid_f(o));
        }
      }
    }
    grid.sync();
    gemm_naive(T_ALL, 1024, 1024,
      [=](int m, int k, int n0) -> float { return ldA(&A2[(size_t)m * 1024 + k]); },
      [=](int k, int n, int m0) -> float { return w_out[(size_t)k * 1024 + n]; },
      [=](int m, int n, float a) { const int s = m < T_CTX ? 1 : 0; tok[(size_t)m * DM + n] += MODV(1, s, 2, n) * a; }, smem);
    grid.sync();
  }
  moe_layer(1, 0);

  {
    norm_phase(P, 0, P.in[6] + 2 * 1024, 2, 0, 1, 0, false, false, 0);
    grid.sync();
    act_t* Zg = (act_t*)(R + R2_ZG); act_t* Zx = (act_t*)(R + R2_ZX); float* xc = (float*)(R + R2_XC);
    float* R4 = (float*)(R + R2_R4); float* cA = (float*)(R + R2_CA); float* cH = (float*)(R + R2_CH);
    float* cin = (float*)(R + R2_CIN); act_t* A3 = (act_t*)(R + R2_ZX);
    const float* w_in = P.in[27]; const float* cw = P.in[28]; const float* cb = P.in[29];
    const float* w_a = P.in[30]; const float* b_a = P.in[31]; const float* w_x = P.in[32]; const float* b_x = P.in[33];
    const float* lam = P.in[34]; const float* w_out = P.in[35];
    gemm_naive(T_ALL, 2560, 1024,
      [=](int m, int k, int n0) -> float { return ldA(&hb[(size_t)m * DM + k]); },
      [=](int k, int n, int m0) -> float { return w_in[(size_t)k * 2560 + n]; },
      [=](int m, int n, float a) { if (n < 1280) stA(&Zg[(size_t)m * 1280 + n], gelu_f(a)); else stA(&Zx[(size_t)m * 1280 + n - 1280], a); }, smem);
    grid.sync();
    for (int idx = gtid; idx < T_ALL * 1280; idx += gstride) {
      const int t = idx / 1280, col = idx - t * 1280;
      const int lo = t < T_CTX ? 0 : T_CTX, hi = t < T_CTX ? T_CTX : T_ALL;
      float a = cb[col];
#pragma unroll
      for (int j = 0; j < 4; ++j) { const int tt = t + j - 2; if (tt >= lo && tt < hi) a += ldA(&Zx[(size_t)tt * 1280 + col]) * cw[j * 1280 + col]; }
      xc[idx] = a;
    }
    grid.sync();
    gemm_naive(T_ALL, 5120, 128,
      [=](int m, int k, int n0) -> float { const int c0 = n0 % 1280; return xc[(size_t)m * 1280 + (c0 & ~127) + k]; },
      [=](int k, int n, int m0) -> float { const int dt = n / 1280, c = n - dt * 1280, d = dt >> 1, nb = c >> 7, j = c & 127;
        const float* w = (dt & 1) ? w_x : w_a;
        return w[((size_t)(d * 10 + nb) * 128 + k) * 128 + j]; },
      [=](int m, int n, float a) { const int dt = n / 1280, c = n - dt * 1280, d = dt >> 1;
        const float bias = (dt & 1) ? b_x[d * 1280 + c] : b_a[d * 1280 + c];
        R4[((size_t)dt * T_ALL + m) * 1280 + c] = a + bias; }, smem);
    grid.sync();
    for (int idx = gtid; idx < 2 * NCH * 1280; idx += gstride) {
      const int c = idx % 1280, dn = idx / 1280, n = dn % NCH, d = dn / NCH;
      const float sp = log1pf(expf(-lam[d * 1280 + c]));
      float h = 0.f, A = 1.f;
      for (int st = 0; st < 128; ++st) {
        const int tt = n * 128 + (d == 0 ? st : 127 - st);
        const size_t ia = ((size_t)(2 * d) * T_ALL + tt) * 1280 + c;
        const size_t ix = ((size_t)(2 * d + 1) * T_ALL + tt) * 1280 + c;
        const float r = sigmoid_f(R4[ia]);
        const float ig = sigmoid_f(R4[ix]);
        const float la = -8.f * r * sp;
        const float a = expf(la);
        const float mult = sqrtf(-expm1f(2.f * la));
        const float u = mult * (ig * xc[(size_t)tt * 1280 + c]);
        h = a * h + u;
        A = A * a;
        R4[ia] = h;
        R4[ix] = A;
      }
      cA[idx] = A;
      cH[idx] = h;
    }
    grid.sync();
    for (int idx = gtid; idx < 2 * 1280; idx += gstride) {
      const int d = idx / 1280, c = idx - d * 1280;
      float st = 0.f;
      for (int i = 0; i < NCH; ++i) {
        const int n = scan_order(d, i);
        const int q = (d * NCH + n) * 1280 + c;
        cin[q] = st;
        st = cA[q] * st + cH[q];
      }
    }
    grid.sync();
    for (int idx = gtid; idx < T_LAT * 1280; idx += gstride) {
      const int tl = idx / 1280, c = idx - tl * 1280, t = tl + T_CTX, n = t >> 7;
      float hs = 0.f;
#pragma unroll
      for (int d = 0; d < 2; ++d) {
        const float hl = R4[((size_t)(2 * d) * T_ALL + t) * 1280 + c];
        const float Ac = R4[((size_t)(2 * d + 1) * T_ALL + t) * 1280 + c];
        hs += hl + Ac * cin[(d * NCH + n) * 1280 + c];
      }
      stA(&A3[(size_t)t * 1280 + c], ldA(&Zg[(size_t)t * 1280 + c]) * hs);
    }
    grid.sync();
    gemm_naive(T_LAT, 1024, 1280,
      [=](int m, int k, int n0) -> float { return ldA(&A3[(size_t)(m + T_CTX) * 1280 + k]); },
      [=](int k, int n, int m0) -> float { return w_out[(size_t)k * 1024 + n]; },
      [=](int m, int n, float a) { tok[(size_t)(m + T_CTX) * DM + n] += MODV(2, 0, 2, n) * a; }, smem);
    grid.sync();
  }
  moe_layer(2, T_CTX);

  {
    norm_phase(P, T_CTX, P.in[6] + 3 * 1024, 3, 0, 2, T_CTX, false, false, 0);
    grid.sync();
    float* Zf = (float*)(R + R3_ZF); float* PQ = (float*)(R + R3_PQ); act_t* Ff = (act_t*)(R + R3_FF);
    const float* w_in = P.in[36]; const float* w_out = P.in[37];
    gemm_naive(T_LAT, 1024, 1024,
      [=](int m, int k, int n0) -> float { return ldA(&hb[(size_t)(m + T_CTX) * DM + k]); },
      [=](int k, int n, int m0) -> float { return w_in[(size_t)k * 1024 + n]; },
      [=](int m, int n, float a) { Zf[(size_t)m * 1024 + n] = a; }, smem);
    grid.sync();
    gemm_naive(T_LAT, 2048, 256,
      [=](int m, int k, int n0) -> float { return Zf[(size_t)m * 1024 + ((n0 & 1023) & ~255) + k]; },
      [=](int k, int n, int m0) -> float { const int kc = n & 255; const int ix = ((k * kc) & 255) * 64;
        return (n >> 10) ? sinT[ix] : cosT[ix]; },
      [=](int m, int n, float a) { PQ[(size_t)m * 2048 + n] = a; }, smem);
    grid.sync();
    gemm_naive(T_LAT, 1024, 32768,
      [=](int m, int k, int n0) -> float { return k < 16384 ? cosT[(m * k) & 16383] : -sinT[(m * (k - 16384)) & 16383]; },
      [=](int k, int n, int m0) -> float { return k < 16384 ? PQ[(size_t)k * 2048 + n] : PQ[(size_t)(k - 16384) * 2048 + 1024 + n]; },
      [=](int m, int n, float a) { stA(&Ff[(size_t)m * 1024 + n], a * (1.f / 2048.f)); }, smem);
    grid.sync();
    gemm_naive(T_LAT, 1024, 1024,
      [=](int m, int k, int n0) -> float { return ldA(&Ff[(size_t)m * 1024 + k]); },
      [=](int k, int n, int m0) -> float { return w_out[(size_t)k * 1024 + n]; },
      [=](int m, int n, float a) { tok[(size_t)(m + T_CTX) * DM + n] += MODV(3, 0, 2, n) * a; }, smem);
    grid.sync();
  }
  moe_layer(3, T_CTX);

  norm_phase(P, T_CTX, P.in[8], 0, -1, 3, T_CTX, true, false, 0);
}

extern "C" void kernel_launch(void* const* d_in, const int* in_sizes, int n_in, void* d_out, int out_size,
                              void* d_ws, size_t ws_size, hipStream_t stream) {
  static int grid_blocks = 0;
  if (!grid_blocks) {
    int dev = 0, cus = 0, per_cu = 0;
    hipGetDevice(&dev);
    hipDeviceGetAttribute(&cus, hipDeviceAttributeMultiprocessorCount, dev);
    hipOccupancyMaxActiveBlocksPerMultiprocessor(&per_cu, mega, 256, 0);
    if (per_cu > 2) per_cu = 2;
    if (per_cu < 1) per_cu = 1;
    grid_blocks = cus * per_cu;
    if (ws_size < WS_NEED) fprintf(stderr, "kernel_launch: workspace too small: %zu < %zu\n", ws_size, (size_t)WS_NEED);
  }
  if (n_in != 38 || ws_size < WS_NEED) return;
  Params p{};
  for (int i = 0; i < 38; ++i) p.in[i] = (const float*)d_in[i];
  p.out = (float*)d_out;
  p.ws = (unsigned char*)d_ws;
  void* args[] = {&p};
  hipError_t e = hipLaunchCooperativeKernel((void*)mega, dim3(grid_blocks), dim3(256), args, 0, stream);
  if (e != hipSuccess) fprintf(stderr, "cooperative launch failed: %s (grid %d)\n", hipGetErrorString(e), grid_blocks);
}
```

```cpp
#include <hip/hip_runtime.h>
#include <hip/hip_cooperative_groups.h>
#include <cstdio>
namespace cg = cooperative_groups;

#define T_ALL 16640
#define T_LAT 16384
#define T_CTX 256
#define DM 1024
#define NCH 130
#define EPSN 1e-6f
#define NT 512

typedef unsigned short bf16_t;
using bf16x8 = __attribute__((ext_vector_type(8))) short;
using f32x4 = __attribute__((ext_vector_type(4))) float;

__device__ __forceinline__ float bf2f(bf16_t v) { return __uint_as_float(((unsigned)v) << 16); }
__device__ __forceinline__ bf16_t f2bf(float f) { unsigned u = __float_as_uint(f); u += 0x7fffu + ((u >> 16) & 1u); return (bf16_t)(u >> 16); }
__device__ __forceinline__ unsigned pack2(float a, float b) { return (unsigned)f2bf(a) | (((unsigned)f2bf(b)) << 16); }
__device__ __forceinline__ float lo2f(unsigned u) { return __uint_as_float(u << 16); }
__device__ __forceinline__ float hi2f(unsigned u) { return __uint_as_float(u & 0xffff0000u); }

constexpr size_t AL(size_t x) { return (x + 255) & ~(size_t)255; }
constexpr size_t WS_MOD    = 0;
constexpr size_t WS_MODP   = AL(WS_MOD + 4 * 2 * 6144 * 4);
constexpr size_t WS_CNT    = AL(WS_MODP + 16 * 4 * 2 * 6144 * 4);
constexpr size_t WS_ZROW   = AL(WS_CNT + 1024);
constexpr size_t WS_TOK    = AL(WS_ZROW + 4096);
constexpr size_t WS_H      = AL(WS_TOK + (size_t)T_ALL * DM * 4);
constexpr size_t WS_ASGW   = AL(WS_H + (size_t)T_ALL * DM * 2);
constexpr size_t WS_LIST   = AL(WS_ASGW + 33280 * 4);
constexpr size_t WS_ROWTOK = AL(WS_LIST + (size_t)32 * 33280 * 4);
constexpr size_t WS_ROWEXP = AL(WS_ROWTOK + 37376 * 4);
constexpr size_t W_CMIN   = AL(WS_ROWEXP + 292 * 4);
constexpr size_t W_CMOUT  = AL(W_CMIN + (size_t)2048 * 1024 * 2);
constexpr size_t W_MLIN   = AL(W_CMOUT + (size_t)1024 * 1024 * 2);
constexpr size_t W_MLOUT  = AL(W_MLIN + (size_t)3072 * 1024 * 2);
constexpr size_t W_LRUIN  = AL(W_MLOUT + (size_t)1024 * 1024 * 2);
constexpr size_t W_LRUOUT = AL(W_LRUIN + (size_t)2560 * 1024 * 2);
constexpr size_t W_FNIN   = AL(W_LRUOUT + (size_t)1024 * 1280 * 2);
constexpr size_t W_FNP    = AL(W_FNIN + (size_t)1024 * 1024 * 2);
constexpr size_t W_FNOUT  = AL(W_FNP + (size_t)2048 * 1024 * 2);
constexpr size_t W_DC     = AL(W_FNOUT + (size_t)1024 * 1024 * 2);
constexpr size_t W_DA     = AL(W_DC + 512 * 256 * 2);
constexpr size_t W_TW     = AL(W_DA + 256 * 256 * 2);
constexpr size_t W_EGU    = AL(W_TW + (size_t)128 * 128 * 256 * 2);
constexpr size_t W_ED     = AL(W_EGU + (size_t)128 * 1024 * 1024 * 2);
constexpr size_t WS_R     = AL(W_ED + (size_t)128 * 1024 * 512 * 2);
constexpr size_t R_YBUF = 0;
constexpr size_t R_HB   = AL(R_YBUF + (size_t)33280 * 1024 * 2);
constexpr size_t R_MOE_END = AL(R_HB + (size_t)37376 * 512 * 2);
constexpr size_t R0_ZU = 0;
constexpr size_t R0_ZV = AL(R0_ZU + (size_t)T_ALL * 1024 * 2);
constexpr size_t R0_P  = AL(R0_ZV + (size_t)T_ALL * 1024 * 2);
constexpr size_t R0_RV = AL(R0_P + (size_t)T_ALL * 1024 * 2);
constexpr size_t R0_END = AL(R0_RV + T_ALL * 4);
constexpr size_t R1_Z    = 0;
constexpr size_t R1_GPRE = AL(R1_Z + (size_t)T_ALL * 3072 * 2);
constexpr size_t R1_QK   = AL(R1_GPRE + (size_t)T_ALL * 16 * 4);
constexpr size_t R1_BC   = AL(R1_QK + (size_t)T_ALL * 1024 * 2);
constexpr size_t R1_LI   = AL(R1_BC + (size_t)8 * T_ALL * 4);
constexpr size_t R1_GCH  = AL(R1_LI + (size_t)8 * T_ALL * 4);
constexpr size_t R1_CST  = AL(R1_GCH + 8 * NCH * 4);
constexpr size_t R1_NST  = AL(R1_CST + (size_t)8 * T_ALL * 256 * 4);
constexpr size_t R1_SB   = AL(R1_NST + (size_t)8 * T_ALL * 4);
constexpr size_t R1_HNUM = AL(R1_SB + (size_t)8 * T_ALL * 128 * 2);
constexpr size_t R1_HDEN = AL(R1_HNUM + (size_t)8 * T_ALL * 256 * 4);
constexpr size_t R1_A2   = AL(R1_HDEN + (size_t)8 * T_ALL * 4);
constexpr size_t R1_END  = AL(R1_A2 + (size_t)T_ALL * 1024 * 2);
constexpr size_t R2_ZG  = 0;
constexpr size_t R2_ZX  = AL(R2_ZG + (size_t)T_ALL * 1280 * 2);
constexpr size_t R2_XC  = AL(R2_ZX + (size_t)T_ALL * 1280 * 2);
constexpr size_t R2_R4  = AL(R2_XC + (size_t)T_ALL * 1280 * 4);
constexpr size_t R2_CA  = AL(R2_R4 + (size_t)4 * T_ALL * 1280 * 4);
constexpr size_t R2_CH  = AL(R2_CA + 2 * NCH * 1280 * 4);
constexpr size_t R2_CIN = AL(R2_CH + 2 * NCH * 1280 * 4);
constexpr size_t R2_END = AL(R2_CIN + 2 * NCH * 1280 * 4);
constexpr size_t R3_YT = 0;
constexpr size_t R3_GT = AL(R3_YT + (size_t)128 * 2048 * 128 * 2);
constexpr size_t R3_FF = AL(R3_GT + (size_t)128 * 2048 * 128 * 2);
constexpr size_t R3_END = AL(R3_FF + (size_t)T_LAT * 1024 * 2);
constexpr size_t cmax(size_t a, size_t b) { return a > b ? a : b; }
constexpr size_t R_SIZE = cmax(cmax(R_MOE_END, R0_END), cmax(cmax(R1_END, R2_END), R3_END));
constexpr size_t WS_NEED = WS_R + R_SIZE;

struct Params { const float* in[38]; float* out; unsigned char* ws; };

__device__ __forceinline__ float sigmoid_f(float x) { return 1.f / (1.f + expf(-x)); }
__device__ __forceinline__ float silu_f(float x) { return x / (1.f + expf(-x)); }
__device__ __forceinline__ float gelu_f(float x) {
  return 0.5f * x * (1.f + tanhf(0.7978845608028654f * (x + 0.044715f * x * x * x)));
}
__device__ __forceinline__ float logsig_f(float x) { return fminf(x, 0.f) - log1pf(expf(-fabsf(x))); }
__device__ __forceinline__ float wave_sum(float v) {
#pragma unroll
  for (int o = 32; o >= 1; o >>= 1) v += __shfl_xor(v, o);
  return v;
}
__device__ __forceinline__ int scan_order(int d, int i) { return d == 0 ? i : (i == 0 ? 1 : (i == 1 ? 0 : 131 - i)); }
__device__ __forceinline__ void st16bf(bf16_t* p, const f32x4 (&a)[4]) {
  uint4 o0, o1;
  o0.x = pack2(a[0][0], a[0][1]); o0.y = pack2(a[0][2], a[0][3]); o0.z = pack2(a[1][0], a[1][1]); o0.w = pack2(a[1][2], a[1][3]);
  o1.x = pack2(a[2][0], a[2][1]); o1.y = pack2(a[2][2], a[2][3]); o1.z = pack2(a[3][0], a[3][1]); o1.w = pack2(a[3][2], a[3][3]);
  *(uint4*)p = o0; *(uint4*)(p + 8) = o1;
}

__device__ __forceinline__ int lds_byte(int r, int c) {
  const int st = (r >> 4) * 2 + (c >> 5), ob = (r & 15) * 64 + (c & 31) * 2;
  return st * 1024 + (ob ^ (((ob >> 9) & 1) << 5));
}
__device__ __forceinline__ void stage_rc(int b, int& R, int& C) {
  const int st = b >> 10, sb = b & 1023, swz = sb ^ (((sb >> 9) & 1) << 5);
  R = (st >> 1) * 16 + (swz >> 6);
  C = (st & 1) * 32 + ((swz & 63) >> 1);
}
__device__ __forceinline__ int perm_col(int p) {
  const int q = p & 63, n = q >> 4, i = q & 15;
  return (p & ~63) + (i >> 2) * 16 + n * 4 + (i & 3);
}
struct KOff64 { __device__ __forceinline__ int operator()(int kt) const { return kt * 64; } };
#define GEMM_LDS_BYTES 131072

template <int MI, bool SWAP, class RA, class RB, class KA, class KB, class EP>
__device__ __forceinline__ void gemm_tile(char* shm, int nk, RA rowA, RB rowB, KA koffA, KB koffB, EP epi) {
  constexpr int BM = 32 * MI, GLA = MI / 2, GLB = 4;
  constexpr int TILE_A = BM * 128, TILE_B = 256 * 128, STG = TILE_A + TILE_B;
  static_assert(2 * STG <= GEMM_LDS_BYTES, "LDS");
  const int tid = threadIdx.x, wid = tid >> 6, lane = tid & 63, wr = wid >> 2, wc = wid & 3, fr = lane & 15, fq = lane >> 4;
  const bf16_t* pa[GLA];
  const bf16_t* pb[GLB];
#pragma unroll
  for (int i = 0; i < GLA; ++i) { int R, C; stage_rc(wid * 1024 + i * 8192 + lane * 16, R, C); pa[i] = rowA(R) + C; }
#pragma unroll
  for (int i = 0; i < GLB; ++i) { int R, C; stage_rc(wid * 1024 + i * 8192 + lane * 16, R, C); pb[i] = rowB(SWAP ? perm_col(R) : R) + C; }
  f32x4 acc[MI][4];
#pragma unroll
  for (int m = 0; m < MI; ++m)
#pragma unroll
    for (int n = 0; n < 4; ++n) acc[m][n] = f32x4{0.f, 0.f, 0.f, 0.f};

#define GT_STAGE(buf, kt) do { const int ka_ = koffA(kt), kb_ = koffB(kt);                                            \
    _Pragma("unroll") for (int i = 0; i < GLA; ++i)                                                                    \
      __builtin_amdgcn_global_load_lds((const unsigned*)(pa[i] + ka_), (unsigned*)(shm + (buf) * STG + wid * 1024 + i * 8192), 16, 0, 0); \
    _Pragma("unroll") for (int i = 0; i < GLB; ++i)                                                                    \
      __builtin_amdgcn_global_load_lds((const unsigned*)(pb[i] + kb_), (unsigned*)(shm + (buf) * STG + TILE_A + wid * 1024 + i * 8192), 16, 0, 0); } while (0)

  GT_STAGE(0, 0);
  asm volatile("s_waitcnt vmcnt(0)" ::: "memory");
  __syncthreads();
  for (int t = 0; t < nk; ++t) {
    const int cur = t & 1;
    if (t + 1 < nk) GT_STAGE(cur ^ 1, t + 1);
    const char* sa = shm + cur * STG;
    const char* sb = sa + TILE_A;
#pragma unroll
    for (int ks = 0; ks < 2; ++ks) {
      bf16x8 At[MI], Bf[4];
#pragma unroll
      for (int m = 0; m < MI; ++m) At[m] = *(const bf16x8*)(sa + lds_byte(wr * (MI * 16) + m * 16 + fr, ks * 32 + fq * 8));
#pragma unroll
      for (int n = 0; n < 4; ++n) Bf[n] = *(const bf16x8*)(sb + lds_byte(wc * 64 + n * 16 + fr, ks * 32 + fq * 8));
#pragma unroll
      for (int m = 0; m < MI; ++m)
#pragma unroll
        for (int n = 0; n < 4; ++n) {
          if (SWAP) acc[m][n] = __builtin_amdgcn_mfma_f32_16x16x32_bf16(Bf[n], At[m], acc[m][n], 0, 0, 0);
          else      acc[m][n] = __builtin_amdgcn_mfma_f32_16x16x32_bf16(At[m], Bf[n], acc[m][n], 0, 0, 0);
        }
      __builtin_amdgcn_sched_barrier(0);
    }
    asm volatile("s_waitcnt vmcnt(0)" ::: "memory");
    __syncthreads();
  }
#undef GT_STAGE
  if constexpr (SWAP) {
#pragma unroll
    for (int m = 0; m < MI; ++m) epi(wr * (MI * 16) + m * 16 + fr, wc * 64 + fq * 16, acc[m]);
  } else {
#pragma unroll
    for (int m = 0; m < MI; ++m)
#pragma unroll
      for (int n = 0; n < 4; ++n) epi(wr * (MI * 16) + m * 16 + fq * 4, wc * 64 + n * 16 + fr, acc[m][n]);
  }
}

template <class AF, class BF, class EF>
__device__ __forceinline__ void gemm_naive(int M, int N, int K, AF af, BF bf, EF ef, float* smem_all) {
  const int half = threadIdx.x >> 8, tid = threadIdx.x & 255;
  float* smem = smem_all + half * (2 * 16 * 68);
  const int tilesM = (M + 63) >> 6, tilesN = (N + 63) >> 6;
  const int ntiles = tilesM * tilesN;
  float (*As)[68] = (float (*)[68])smem;
  float (*Bs)[68] = (float (*)[68])(smem + 16 * 68);
  const int ty = tid >> 4, tx = tid & 15;
  const int stride = gridDim.x * 2;
  const int iters = (ntiles + stride - 1) / stride;
  for (int it = 0; it < iters; ++it) {
    const int tile = it * stride + blockIdx.x * 2 + half;
    const bool valid = tile < ntiles;
    const int tm = valid ? tile / tilesN : 0, tn = valid ? tile - tm * tilesN : 0;
    const int m0 = tm << 6, n0 = tn << 6;
    float acc[4][4];
#pragma unroll
    for (int i = 0; i < 4; ++i)
#pragma unroll
      for (int j = 0; j < 4; ++j) acc[i][j] = 0.f;
    for (int k0 = 0; k0 < K; k0 += 16) {
#pragma unroll
      for (int i = 0; i < 4; ++i) {
        const int mm = (tid >> 4) + 16 * i, kk = tid & 15;
        const int m = m0 + mm, k = k0 + kk;
        As[kk][mm] = (valid && m < M && k < K) ? af(m, k, n0) : 0.f;
      }
#pragma unroll
      for (int i = 0; i < 4; ++i) {
        const int kk = (tid >> 6) + 4 * i, nn = tid & 63;
        const int k = k0 + kk, n = n0 + nn;
        Bs[kk][nn] = (valid && k < K && n < N) ? bf(k, n, m0) : 0.f;
      }
      __syncthreads();
#pragma unroll
      for (int kk = 0; kk < 16; ++kk) {
        const float4 a = *(const float4*)&As[kk][ty * 4];
        const float4 b = *(const float4*)&Bs[kk][tx * 4];
        const float av[4] = {a.x, a.y, a.z, a.w};
        const float bv[4] = {b.x, b.y, b.z, b.w};
#pragma unroll
        for (int i = 0; i < 4; ++i)
#pragma unroll
          for (int j = 0; j < 4; ++j) acc[i][j] = fmaf(av[i], bv[j], acc[i][j]);
      }
      __syncthreads();
    }
    if (valid) {
#pragma unroll
      for (int i = 0; i < 4; ++i)
#pragma unroll
        for (int j = 0; j < 4; ++j) {
          const int m = m0 + ty * 4 + i, n = n0 + tx * 4 + j;
          if (m < M && n < N) ef(m, n, acc[i][j]);
        }
    }
  }
}

__device__ __forceinline__ void conv_tile(const float* src, int ldn, bf16_t* dst, int ldk, int k0, int n0, int mapmode, float* sm) {
  const int tid = threadIdx.x;
  float (*tl)[65] = (float (*)[65])sm;
  {
    const int row = tid >> 3, c4 = (tid & 7) * 4;
    const float4 a = *(const float4*)&src[(size_t)(k0 + row) * ldn + n0 + c4];
    const float4 b = *(const float4*)&src[(size_t)(k0 + row) * ldn + n0 + 32 + c4];
    tl[row][c4 + 0] = a.x; tl[row][c4 + 1] = a.y; tl[row][c4 + 2] = a.z; tl[row][c4 + 3] = a.w;
    tl[row][32 + c4 + 0] = b.x; tl[row][32 + c4 + 1] = b.y; tl[row][32 + c4 + 2] = b.z; tl[row][32 + c4 + 3] = b.w;
  }
  __syncthreads();
  {
    const int n = tid >> 3, kg = (tid & 7) * 8;
    uint4 o;
    o.x = pack2(tl[kg + 0][n], tl[kg + 1][n]); o.y = pack2(tl[kg + 2][n], tl[kg + 3][n]);
    o.z = pack2(tl[kg + 4][n], tl[kg + 5][n]); o.w = pack2(tl[kg + 6][n], tl[kg + 7][n]);
    const int h = n0 + n;
    const int dr = mapmode == 0 ? h : ((h >> 3) * 16 + (h & 7) + (mapmode == 2 ? 8 : 0));
    *(uint4*)&dst[(size_t)dr * ldk + k0 + kg] = o;
  }
  __syncthreads();
}

__device__ __forceinline__ void norm_phase(const Params& P, int t0, const float* gw,
                                           int mod_layer, int shift_idx,
                                           int pend_layer, int pend_t0,
                                           bool to_out, bool router, int layer) {
  unsigned char* ws = P.ws;
  float* tok = (float*)(ws + WS_TOK);
  bf16_t* hb = (bf16_t*)(ws + WS_H);
  const float* mod = (const float*)(ws + WS_MOD);
  const bf16_t* ybuf = (const bf16_t*)(ws + WS_R + R_YBUF);
  const int lane = threadIdx.x & 63;
  const int gw_id = blockIdx.x * (NT / 64) + (threadIdx.x >> 6);
  const int gw_n = gridDim.x * (NT / 64);
  for (int t = t0 + gw_id; t < T_ALL; t += gw_n) {
    const int s = (t < T_CTX) ? 1 : 0;
    float v[16];
#pragma unroll
    for (int j = 0; j < 4; ++j) {
      const int n = j * 256 + lane * 4;
      const float4 x = *(const float4*)&tok[(size_t)t * DM + n];
      v[j * 4 + 0] = x.x; v[j * 4 + 1] = x.y; v[j * 4 + 2] = x.z; v[j * 4 + 3] = x.w;
    }
    if (pend_layer >= 0 && t >= pend_t0) {
      const float* gate = mod + (size_t)((pend_layer * 2 + s) * 6 + 5) * 1024;
#pragma unroll
      for (int j = 0; j < 4; ++j) {
        const int n = j * 256 + lane * 4;
        const uint2 y0 = *(const uint2*)&ybuf[(size_t)(2 * t) * DM + n];
        const uint2 y1 = *(const uint2*)&ybuf[(size_t)(2 * t + 1) * DM + n];
        const float4 g = *(const float4*)&gate[n];
        v[j * 4 + 0] += g.x * (lo2f(y0.x) + lo2f(y1.x));
        v[j * 4 + 1] += g.y * (hi2f(y0.x) + hi2f(y1.x));
        v[j * 4 + 2] += g.z * (lo2f(y0.y) + lo2f(y1.y));
        v[j * 4 + 3] += g.w * (hi2f(y0.y) + hi2f(y1.y));
        *(float4*)&tok[(size_t)t * DM + n] = make_float4(v[j * 4 + 0], v[j * 4 + 1], v[j * 4 + 2], v[j * 4 + 3]);
      }
    }
    float ss = 0.f;
#pragma unroll
    for (int e = 0; e < 16; ++e) ss += v[e] * v[e];
    ss = wave_sum(ss);
    const float r = 1.f / sqrtf(ss * (1.f / 1024.f) + EPSN);
    float h[16];
#pragma unroll
    for (int j = 0; j < 4; ++j) {
      const int n = j * 256 + lane * 4;
      const float4 g = *(const float4*)&gw[n];
      h[j * 4 + 0] = v[j * 4 + 0] * r * g.x;
      h[j * 4 + 1] = v[j * 4 + 1] * r * g.y;
      h[j * 4 + 2] = v[j * 4 + 2] * r * g.z;
      h[j * 4 + 3] = v[j * 4 + 3] * r * g.w;
      if (shift_idx >= 0) {
        const float* sh = mod + (size_t)((mod_layer * 2 + s) * 6 + shift_idx) * 1024;
        const float* sc = sh + 1024;
        const float4 a = *(const float4*)&sh[n];
        const float4 b = *(const float4*)&sc[n];
        h[j * 4 + 0] = h[j * 4 + 0] * (1.f + b.x) + a.x;
        h[j * 4 + 1] = h[j * 4 + 1] * (1.f + b.y) + a.y;
        h[j * 4 + 2] = h[j * 4 + 2] * (1.f + b.z) + a.z;
        h[j * 4 + 3] = h[j * 4 + 3] * (1.f + b.w) + a.w;
      }
      if (to_out) {
        *(float4*)&P.out[(size_t)(t - T_CTX) * DM + n] = make_float4(h[j * 4 + 0], h[j * 4 + 1], h[j * 4 + 2], h[j * 4 + 3]);
      } else {
        uint2 o; o.x = pack2(h[j * 4 + 0], h[j * 4 + 1]); o.y = pack2(h[j * 4 + 2], h[j * 4 + 3]);
        *(uint2*)&hb[(size_t)t * DM + n] = o;
      }
    }
    if (router) {
      const float* rgw = P.in[9] + (size_t)layer * 1024 * 4;
      const float* rgb = P.in[10] + layer * 4;
      const float* rew = P.in[11] + (size_t)layer * 1024 * 32;
      const float* reb = P.in[12] + layer * 32;
      float lg[36];
#pragma unroll
      for (int q = 0; q < 36; ++q) lg[q] = 0.f;
#pragma unroll
      for (int j = 0; j < 4; ++j) {
#pragma unroll
        for (int e = 0; e < 4; ++e) {
          const int n = j * 256 + lane * 4 + e;
          const float hv = h[j * 4 + e];
          const float4 g4 = *(const float4*)&rgw[(size_t)n * 4];
          lg[0] += hv * g4.x; lg[1] += hv * g4.y; lg[2] += hv * g4.z; lg[3] += hv * g4.w;
#pragma unroll
          for (int q = 0; q < 8; ++q) {
            const float4 w4 = *(const float4*)&rew[(size_t)n * 32 + q * 4];
            lg[4 + q * 4 + 0] += hv * w4.x; lg[4 + q * 4 + 1] += hv * w4.y;
            lg[4 + q * 4 + 2] += hv * w4.z; lg[4 + q * 4 + 3] += hv * w4.w;
          }
        }
      }
#pragma unroll
      for (int q = 0; q < 36; ++q) lg[q] = wave_sum(lg[q]);
#pragma unroll
      for (int q = 0; q < 4; ++q) lg[q] += rgb[q];
#pragma unroll
      for (int q = 0; q < 32; ++q) lg[4 + q] += reb[q];
      int grp = 0; float best = lg[0];
#pragma unroll
      for (int q = 1; q < 4; ++q) if (lg[q] > best) { best = lg[q]; grp = q; }
      float se = 0.f;
#pragma unroll
      for (int q = 0; q < 4; ++q) se += expf(lg[q] - best);
      const float pg = 1.f / se;
      float v0 = -3.0e38f, v1 = -3.0e38f; int i0 = 0, i1 = 0;
#pragma unroll
      for (int g = 0; g < 4; ++g) {
#pragma unroll
        for (int q = 0; q < 8; ++q) {
          const float x = lg[4 + g * 8 + q];
          if (g == grp) {
            if (x > v0) { v1 = v0; i1 = i0; v0 = x; i0 = q; }
            else if (x > v1) { v1 = x; i1 = q; }
          }
        }
      }
      const float w0 = 1.f / (1.f + expf(v1 - v0));
      const float w1 = 1.f - w0;
      if (lane == 0) {
        int* cnt = (int*)(ws + WS_CNT) + layer * 32;
        int* list = (int*)(ws + WS_LIST);
        float* asgw = (float*)(ws + WS_ASGW);
        const int e0 = grp * 8 + i0, e1 = grp * 8 + i1;
        const int p0 = atomicAdd(&cnt[e0], 1);
        list[(size_t)e0 * 33280 + p0] = 2 * t;
        asgw[2 * t] = w0 * pg;
        const int p1 = atomicAdd(&cnt[e1], 1);
        list[(size_t)e1 * 33280 + p1] = 2 * t + 1;
        asgw[2 * t + 1] = w1 * pg;
      }
    }
  }
}

__device__ __forceinline__ void moe_build(const Params& P, int layer, int* sm) {
  unsigned char* ws = P.ws;
  const int* cnt = (const int*)(ws + WS_CNT) + layer * 32;
  int* meta = (int*)(ws + WS_CNT) + 128;
  const int* list = (const int*)(ws + WS_LIST);
  int* rowtok = (int*)(ws + WS_ROWTOK);
  int* rowexp = (int*)(ws + WS_ROWEXP);
  if (threadIdx.x == 0) {
    int s = 0;
    for (int e = 0; e < 32; ++e) { sm[e] = s; s += (cnt[e] + 127) / 128 * 128; }
    sm[32] = s;
  }
  __syncthreads();
  const int total = sm[32];
  for (int m = blockIdx.x * NT + threadIdx.x; m < total; m += gridDim.x * NT) {
    int e = 0;
    for (int q = 1; q < 32; ++q) if (sm[q] <= m) e = q;
    const int r = m - sm[e];
    rowtok[m] = (r < cnt[e]) ? list[(size_t)e * 33280 + r] : -1;
    if ((m & 127) == 0) rowexp[m >> 7] = e;
  }
  if (blockIdx.x == 0 && threadIdx.x == 0) meta[layer] = total;
  __syncthreads();
}

__global__ void __launch_bounds__(NT, 2) mega(Params P) {
  cg::grid_group grid = cg::this_grid();
  __shared__ __attribute__((aligned(1024))) char shm[GEMM_LDS_BYTES];
  float* smem = (float*)shm;
  unsigned char* ws = P.ws;
  const int tid = threadIdx.x;
  const int gtid = blockIdx.x * NT + tid;
  const int gstride = gridDim.x * NT;
  const int G = gridDim.x;
  const int vb = (G % 8 == 0) ? ((int)(blockIdx.x & 7) * (G / 8) + (int)(blockIdx.x >> 3)) : (int)blockIdx.x;
  float* tok = (float*)(ws + WS_TOK);
  bf16_t* hb = (bf16_t*)(ws + WS_H);
  float* mod = (float*)(ws + WS_MOD);
  const bf16_t* zrow = (const bf16_t*)(ws + WS_ZROW);
  unsigned char* R = ws + WS_R;

  {
    const float* x = P.in[0]; const float* ctx = P.in[2];
    for (int idx = gtid; idx < T_ALL * 256; idx += gstride) {
      const int t = idx >> 8, n = (idx & 255) * 4;
      float4 o;
      if (t < T_CTX) o = *(const float4*)&ctx[(size_t)t * DM + n];
      else {
        const int tl = t - T_CTX;
        o = *(const float4*)&x[(size_t)tl * DM + n];
        float pe[4];
#pragma unroll
        for (int e = 0; e < 4; ++e) {
          const int nn = n + e, qd = nn >> 8, j = nn & 255;
          const float freq = expf(-9.210340371976184f * (float)j / 256.f);
          const float pos = (qd < 2) ? (float)(tl >> 6) : (float)(tl & 63);
          const float ang = pos * freq;
          pe[e] = (qd & 1) ? cosf(ang) : sinf(ang);
        }
        o.x += pe[0]; o.y += pe[1]; o.z += pe[2]; o.w += pe[3];
      }
      *(float4*)&tok[(size_t)t * DM + n] = o;
    }
    const float* c = P.in[1]; const float* cc = P.in[3]; const float* adaw = P.in[4];
    float* modp = (float*)(ws + WS_MODP);
    for (int idx = gtid; idx < 16 * 4 * 6144; idx += gstride) {
      const int ks = idx / 24576, rem = idx - ks * 24576, i = rem / 6144, j = rem - i * 6144;
      float a0 = 0.f, a1 = 0.f;
      for (int k = ks * 64; k < ks * 64 + 64; ++k) {
        const float w = adaw[((size_t)i * 1024 + k) * 6144 + j];
        a0 += silu_f(c[k]) * w;
        a1 += silu_f(cc[k]) * w;
      }
      modp[(size_t)(ks * 8 + i * 2 + 0) * 6144 + j] = a0;
      modp[(size_t)(ks * 8 + i * 2 + 1) * 6144 + j] = a1;
    }
    if (gtid < 256) ((int*)(ws + WS_CNT))[gtid] = 0;
    if (gtid < 1024) ((unsigned*)(ws + WS_ZROW))[gtid] = 0u;
    bf16_t* DC = (bf16_t*)(ws + W_DC); bf16_t* DA = (bf16_t*)(ws + W_DA); bf16_t* TW = (bf16_t*)(ws + W_TW);
    for (int idx = gtid; idx < 512 * 256; idx += gstride) {
      const int row = idx >> 8, cch = idx & 255, pq = row >> 8, kc = row & 255;
      const float a = (float)((kc * cch) & 255) * (1.f / 128.f);
      DC[idx] = f2bf(pq ? -sinpif(a) : cospif(a));
    }
    for (int idx = gtid; idx < 256 * 256; idx += gstride) {
      const int row = idx >> 8, col = idx & 255, ri = row >> 7, cc2 = row & 127, rj = col >> 7, aa = col & 127;
      const float a = (float)((aa * cc2) & 127) * (1.f / 64.f);
      const float cs = cospif(a), sn = sinpif(a);
      DA[idx] = f2bf(ri == rj ? cs : (ri == 0 ? sn : -sn));
    }
    for (int idx = gtid; idx < 128 * 128 * 256; idx += gstride) {
      const int col = idx & 255, e = (idx >> 8) & 127, c2 = idx >> 15, ri = col >> 7, b = col & 127;
      const float a = (float)((b * (c2 + 128 * e)) & 16383) * (1.f / 8192.f);
      TW[idx] = f2bf(ri ? sinpif(a) : cospif(a));
    }
    {
      const float* src = P.in[36]; bf16_t* dst = (bf16_t*)(ws + W_FNIN);
      for (int idx = gtid; idx < 1024 * 1024 / 4; idx += gstride) {
        const float4 a = *(const float4*)&src[(size_t)idx * 4];
        uint2 o; o.x = pack2(a.x, a.y); o.y = pack2(a.z, a.w);
        *(uint2*)&dst[(size_t)idx * 4] = o;
      }
    }
    const int NDENSE = 512 + 256 + 768 + 256 + 640 + 320 + 256;
    const int NTOT = NDENSE + 128 * 384;
    for (int u = blockIdx.x; u < NTOT; u += G) {
      if (u < NDENSE) {
        int v = u;
        if (v < 512) { conv_tile(P.in[16], 2048, (bf16_t*)(ws + W_CMIN), 1024, (v >> 5) * 64, (v & 31) * 64, 0, smem); continue; }
        v -= 512;
        if (v < 256) { conv_tile(P.in[20], 1024, (bf16_t*)(ws + W_CMOUT), 1024, (v >> 4) * 64, (v & 15) * 64, 0, smem); continue; }
        v -= 256;
        if (v < 768) { conv_tile(P.in[21], 3088, (bf16_t*)(ws + W_MLIN), 1024, (v / 48) * 64, (v % 48) * 64, 0, smem); continue; }
        v -= 768;
        if (v < 256) { conv_tile(P.in[26], 1024, (bf16_t*)(ws + W_MLOUT), 1024, (v >> 4) * 64, (v & 15) * 64, 0, smem); continue; }
        v -= 256;
        if (v < 640) { conv_tile(P.in[27], 2560, (bf16_t*)(ws + W_LRUIN), 1024, (v / 40) * 64, (v % 40) * 64, 0, smem); continue; }
        v -= 640;
        if (v < 320) { conv_tile(P.in[35], 1024, (bf16_t*)(ws + W_LRUOUT), 1280, (v >> 4) * 64, (v & 15) * 64, 0, smem); continue; }
        v -= 320;
        conv_tile(P.in[37], 1024, (bf16_t*)(ws + W_FNOUT), 1024, (v >> 4) * 64, (v & 15) * 64, 0, smem);
      } else {
        const int v = u - NDENSE, le = v / 384, r = v - le * 384, kind = r >> 7, tt = r & 127;
        if (kind < 2) {
          const float* src = (kind == 0 ? P.in[13] : P.in[14]) + (size_t)le * 1024 * 512;
          conv_tile(src, 512, (bf16_t*)(ws + W_EGU) + (size_t)le * 1024 * 1024, 1024, (tt >> 3) * 64, (tt & 7) * 64, kind + 1, smem);
        } else {
          const float* src = P.in[15] + (size_t)le * 512 * 1024;
          conv_tile(src, 1024, (bf16_t*)(ws + W_ED) + (size_t)le * 1024 * 512, 512, (tt >> 4) * 64, (tt & 15) * 64, 0, smem);
        }
      }
    }
  }
  grid.sync();
  {
    const float* modp = (const float*)(ws + WS_MODP);
    const float* adab = P.in[5];
    for (int idx = gtid; idx < 8 * 6144; idx += gstride) {
      const int is = idx / 6144, j = idx - is * 6144, i = is >> 1;
      float a = adab[i * 6144 + j];
      for (int ks = 0; ks < 16; ++ks) a += modp[(size_t)(ks * 8 + is) * 6144 + j];
      mod[idx] = a;
    }
    if (vb < 32) {
      const int tm = vb >> 2, tn = vb & 3, pq = tm >> 2, g = tm & 3, n0 = tn * 256;
      const bf16_t* DC = (const bf16_t*)(ws + W_DC);
      const bf16_t* WI = (const bf16_t*)(ws + W_FNIN);
      bf16_t* WP = (bf16_t*)(ws + W_FNP);
      gemm_tile<8, true>(shm, 4,
        [=](int r) { return DC + (size_t)(pq * 256 + r) * 256; },
        [=](int cidx) { return WI + (size_t)(n0 + cidx) * 1024 + g * 256; }, KOff64(), KOff64(),
        [=](int row, int col0, const f32x4 (&a)[4]) { st16bf(WP + (size_t)(tm * 256 + row) * 1024 + n0 + col0, a); });
    }
  }
  grid.sync();

#define MODV(i, s, j, n) mod[(size_t)(((i) * 2 + (s)) * 6 + (j)) * 1024 + (n)]

#define DENSE_PHASE(Aptr, lda, Wt, ldw, NTILES_N, NK, WITH_CTX, EPI)                                                    \
  do {                                                                                                                  \
    const int nbig_ = 64 * (NTILES_N);                                                                                  \
    for (int L_ = vb; L_ < nbig_; L_ += G) {                                                                            \
      const int m0_ = (1 + L_ / (NTILES_N)) * 256, n0_ = (L_ % (NTILES_N)) * 256;                                       \
      gemm_tile<8, true>(shm, (NK),                                                                                     \
        [=](int r) { return (Aptr) + (size_t)(m0_ + r) * (lda); },                                                      \
        [=](int cidx) { return (Wt) + (size_t)(n0_ + cidx) * (ldw); }, KOff64(), KOff64(),                              \
        [=](int row, int col0, const f32x4 (&a)[4]) { EPI(m0_ + row, n0_ + col0, a); });                                \
    }                                                                                                                   \
    if (WITH_CTX) {                                                                                                     \
      const int s_ = (vb - (nbig_ % G) + G) % G;                                                                        \
      if (s_ < 4 * (NTILES_N)) {                                                                                        \
        const int m0_ = (s_ / (NTILES_N)) * 64, n0_ = (s_ % (NTILES_N)) * 256;                                          \
        gemm_tile<2, true>(shm, (NK),                                                                                   \
          [=](int r) { return (Aptr) + (size_t)(m0_ + r) * (lda); },                                                    \
          [=](int cidx) { return (Wt) + (size_t)(n0_ + cidx) * (ldw); }, KOff64(), KOff64(),                            \
          [=](int row, int col0, const f32x4 (&a)[4]) { EPI(m0_ + row, n0_ + col0, a); });                              \
      }                                                                                                                 \
    }                                                                                                                   \
  } while (0)

  auto resid_epi = [=](int layer, int grow, int gcol0, const f32x4 (&a)[4]) {
    const int s = grow < T_CTX ? 1 : 0;
    const float* gate = &MODV(layer, s, 2, gcol0);
    float* p = tok + (size_t)grow * DM + gcol0;
#pragma unroll
    for (int n = 0; n < 4; ++n) {
      float4 t4 = *(float4*)(p + n * 4);
      const float4 g4 = *(const float4*)(gate + n * 4);
      t4.x += g4.x * a[n][0]; t4.y += g4.y * a[n][1]; t4.z += g4.z * a[n][2]; t4.w += g4.w * a[n][3];
      *(float4*)(p + n * 4) = t4;
    }
  };

  auto moe_layer = [&](int layer, int t0) {
    norm_phase(P, t0, P.in[7] + layer * 1024, layer, 3, -1, 0, false, true, layer);
    grid.sync();
    moe_build(P, layer, (int*)smem);
    grid.sync();
    const int total = ((const int*)(ws + WS_CNT))[128 + layer];
    const int* rowtok = (const int*)(ws + WS_ROWTOK);
    const int* rowexp = (const int*)(ws + WS_ROWEXP);
    bf16_t* HB = (bf16_t*)(R + R_HB);
    bf16_t* ybuf = (bf16_t*)(R + R_YBUF);
    const float* asgw = (const float*)(ws + WS_ASGW);
    const bf16_t* WGU = (const bf16_t*)(ws + W_EGU) + (size_t)layer * 32 * 1024 * 1024;
    const bf16_t* WD = (const bf16_t*)(ws + W_ED) + (size_t)layer * 32 * 1024 * 512;
    const int ntile = (total >> 7) * 4;
    for (int L = vb; L < ntile; L += G) {
      const int mb = L >> 2, n0 = (L & 3) * 256, m0 = mb * 128, e = rowexp[mb];
      const bf16_t* wb = WGU + (size_t)e * 1024 * 1024;
      gemm_tile<4, true>(shm, 16,
        [=](int r) { const int rt = rowtok[m0 + r]; return rt >= 0 ? (const bf16_t*)(hb + (size_t)(rt >> 1) * DM) : zrow; },
        [=](int cidx) { return wb + (size_t)(n0 + cidx) * 1024; }, KOff64(), KOff64(),
        [=](int row, int col0, const f32x4 (&a)[4]) {
          float hv[8];
#pragma unroll
          for (int j = 0; j < 8; ++j) { const float gv = a[j >> 2][j & 3], uv = a[2 + (j >> 2)][j & 3]; hv[j] = silu_f(gv) * uv; }
          uint4 o; o.x = pack2(hv[0], hv[1]); o.y = pack2(hv[2], hv[3]); o.z = pack2(hv[4], hv[5]); o.w = pack2(hv[6], hv[7]);
          *(uint4*)&HB[(size_t)(m0 + row) * 512 + ((n0 + col0) >> 1)] = o;
        });
    }
    grid.sync();
    for (int L = vb; L < ntile; L += G) {
      const int mb = L >> 2, n0 = (L & 3) * 256, m0 = mb * 128, e = rowexp[mb];
      const bf16_t* wb = WD + (size_t)e * 1024 * 512;
      gemm_tile<4, true>(shm, 8,
        [=](int r) { return (const bf16_t*)(HB + (size_t)(m0 + r) * 512); },
        [=](int cidx) { return wb + (size_t)(n0 + cidx) * 512; }, KOff64(), KOff64(),
        [=](int row, int col0, const f32x4 (&a)[4]) {
          const int rt = rowtok[m0 + row];
          if (rt >= 0) {
            const float w = asgw[rt];
            f32x4 b[4];
#pragma unroll
            for (int n = 0; n < 4; ++n) b[n] = a[n] * w;
            st16bf(ybuf + (size_t)rt * 1024 + n0 + col0, b);
          }
        });
    }
    grid.sync();
  };

  {
    norm_phase(P, 0, P.in[6] + 0 * 1024, 0, 0, -1, 0, false, false, 0);
    grid.sync();
    bf16_t* zu = (bf16_t*)(R + R0_ZU); bf16_t* zv = (bf16_t*)(R + R0_ZV); bf16_t* pb = (bf16_t*)(R + R0_P);
    float* rv = (float*)(R + R0_RV);
    const float* vg = P.in[17]; const float* w_s = P.in[18]; const float* b_s = P.in[19];
    const bf16_t* Wt = (const bf16_t*)(ws + W_CMIN);
    auto epi_in = [=](int grow, int gcol0, const f32x4 (&a)[4]) {
      f32x4 b[4];
#pragma unroll
      for (int n = 0; n < 4; ++n)
#pragma unroll
        for (int j = 0; j < 4; ++j) b[n][j] = gelu_f(a[n][j]);
      if (gcol0 < 1024) st16bf(zu + (size_t)grow * 1024 + gcol0, b); else st16bf(zv + (size_t)grow * 1024 + gcol0 - 1024, b);
    };
    DENSE_PHASE(hb, 1024, Wt, 1024, 8, 16, true, epi_in);
    grid.sync();
    {
      const int lane = tid & 63;
      for (int t = blockIdx.x * (NT / 64) + (tid >> 6); t < T_ALL; t += G * (NT / 64)) {
        float ss = 0.f;
        for (int n = lane; n < 1024; n += 64) { const float x = bf2f(zv[(size_t)t * 1024 + n]); ss += x * x; }
        ss = wave_sum(ss);
        if (lane == 0) rv[t] = 1.f / sqrtf(ss * (1.f / 1024.f) + EPSN);
      }
    }
    grid.sync();
    gemm_naive(T_ALL, 1024, 128,
      [=](int m, int k, int n0) -> float { return w_s[((size_t)(n0 >> 8) * 128 + (m & 127)) * 128 + k]; },
      [=](int k, int n, int m0) -> float { const int ts = (m0 & ~127) + k; return bf2f(zv[(size_t)ts * 1024 + n]) * rv[ts]; },
      [=](int m, int n, float a) {
        const float sv = a * vg[n] + b_s[(n >> 8) * 128 + (m & 127)];
        pb[(size_t)m * 1024 + n] = f2bf(bf2f(zu[(size_t)m * 1024 + n]) * sv); }, smem);
    grid.sync();
    const bf16_t* Wo = (const bf16_t*)(ws + W_CMOUT);
    auto epi_out = [=](int grow, int gcol0, const f32x4 (&a)[4]) { resid_epi(0, grow, gcol0, a); };
    DENSE_PHASE(pb, 1024, Wo, 1024, 4, 16, true, epi_out);
    grid.sync();
  }
  moe_layer(0, 0);

  {
    norm_phase(P, 0, P.in[6] + 1 * 1024, 1, 0, 0, 0, false, false, 0);
    grid.sync();
    bf16_t* Z = (bf16_t*)(R + R1_Z); float* gpre = (float*)(R + R1_GPRE); bf16_t* qk = (bf16_t*)(R + R1_QK);
    float* bc = (float*)(R + R1_BC); float* li = (float*)(R + R1_LI); float* gch = (float*)(R + R1_GCH);
    float* Cst = (float*)(R + R1_CST); float* nst = (float*)(R + R1_NST); bf16_t* Sb = (bf16_t*)(R + R1_SB);
    float* hnum = (float*)(R + R1_HNUM); float* hden = (float*)(R + R1_HDEN); bf16_t* A2 = (bf16_t*)(R + R1_A2);
    const float* w_in = P.in[21]; const float* cw = P.in[22]; const float* cb = P.in[23];
    const float* gb = P.in[24]; const float* ng = P.in[25];
    const bf16_t* Wt = (const bf16_t*)(ws + W_MLIN);
    auto epi_in = [=](int grow, int gcol0, const f32x4 (&a)[4]) { st16bf(Z + (size_t)grow * 3072 + gcol0, a); };
    DENSE_PHASE(hb, 1024, Wt, 1024, 12, 16, true, epi_in);
    {
      const int lane = tid & 63;
      for (int t = blockIdx.x * (NT / 64) + (tid >> 6); t < T_ALL; t += G * (NT / 64)) {
        float a16[16];
#pragma unroll
        for (int j = 0; j < 16; ++j) a16[j] = 0.f;
        for (int k = lane; k < 1024; k += 64) {
          const float hv = bf2f(hb[(size_t)t * DM + k]);
#pragma unroll
          for (int q = 0; q < 4; ++q) {
            const float4 w4 = *(const float4*)&w_in[(size_t)k * 3088 + 3072 + q * 4];
            a16[q * 4 + 0] += hv * w4.x; a16[q * 4 + 1] += hv * w4.y; a16[q * 4 + 2] += hv * w4.z; a16[q * 4 + 3] += hv * w4.w;
          }
        }
#pragma unroll
        for (int j = 0; j < 16; ++j) a16[j] = wave_sum(a16[j]);
        if (lane == 0) {
#pragma unroll
          for (int j = 0; j < 16; ++j) gpre[(size_t)t * 16 + j] = a16[j];
        }
      }
    }
    grid.sync();
    for (int idx = gtid; idx < T_ALL * 1024; idx += gstride) {
      const int t = idx >> 10, col = idx & 1023;
      const int lo = t < T_CTX ? 0 : T_CTX, hi = t < T_CTX ? T_CTX : T_ALL;
      float a = cb[col];
#pragma unroll
      for (int j = 0; j < 4; ++j) { const int tt = t + j - 2; if (tt >= lo && tt < hi) a += bf2f(Z[(size_t)tt * 3072 + col]) * cw[j * 1024 + col]; }
      float v = silu_f(a);
      if (col < 512) v *= 0.08838834764831845f;
      qk[idx] = f2bf(v);
    }
    for (int idx = gtid; idx < 8 * NCH; idx += gstride) {
      const int dh = idx / NCH, n = idx - dh * NCH, d = dh >> 2, hd = dh & 3;
      float b = 0.f;
      for (int st = 0; st < 128; ++st) {
        const int tt = n * 128 + (d == 0 ? st : 127 - st);
        const float pi = gpre[(size_t)tt * 16 + d * 8 + hd] + gb[d * 8 + hd];
        const float pf = gpre[(size_t)tt * 16 + d * 8 + 4 + hd] + gb[d * 8 + 4 + hd];
        b += logsig_f(pf);
        bc[(size_t)dh * T_ALL + tt] = b;
        li[(size_t)dh * T_ALL + tt] = pi;
      }
      gch[idx] = b;
    }
    grid.sync();
    gemm_naive(8 * T_ALL, 257, 128,
      [=](int m, int k, int n0) -> float { const int dh = m / T_ALL, rem = m - dh * T_ALL, n = rem >> 7, kk = rem & 127, hd = dh & 3;
        const int ts = n * 128 + k;
        const float w = expf(gch[dh * NCH + n] - bc[(size_t)dh * T_ALL + ts] + li[(size_t)dh * T_ALL + ts]);
        return w * bf2f(qk[(size_t)ts * 1024 + 512 + hd * 128 + kk]); },
      [=](int k, int n, int m0) -> float { const int dh = m0 / T_ALL, rem = m0 - dh * T_ALL, hd = dh & 3;
        const int ts = (rem & ~127) + k;
        return n < 256 ? bf2f(Z[(size_t)ts * 3072 + 1024 + hd * 256 + n]) : 1.f; },
      [=](int m, int n, float a) { if (n < 256) Cst[(size_t)m * 256 + n] = a; else nst[m] = a; }, smem);
    grid.sync();
    for (int idx = gtid; idx < 8 * (32768 + 128); idx += gstride) {
      const int dh = idx / 32896, e = idx - dh * 32896, d = dh >> 2;
      float st = 0.f;
      for (int i = 0; i < NCH; ++i) {
        const int n = scan_order(d, i);
        float* p = (e < 32768) ? &Cst[((size_t)dh * T_ALL + n * 128) * 256 + e] : &nst[(size_t)dh * T_ALL + n * 128 + (e - 32768)];
        const float tmp = *p;
        *p = st;
        st = expf(gch[dh * NCH + n]) * st + tmp;
      }
    }
    grid.sync();
    gemm_naive(8 * T_ALL, 128, 128,
      [=](int m, int k, int n0) -> float { const int dh = m / T_ALL, tt = m - dh * T_ALL, hd = dh & 3;
        return bf2f(qk[(size_t)tt * 1024 + hd * 128 + k]); },
      [=](int k, int n, int m0) -> float { const int dh = m0 / T_ALL, rem = m0 - dh * T_ALL, hd = dh & 3;
        const int ts = (rem & ~127) + n;
        return bf2f(qk[(size_t)ts * 1024 + 512 + hd * 128 + k]); },
      [=](int m, int n, float a) { const int dh = m / T_ALL, tt = m - dh * T_ALL, d = dh >> 2, t = tt & 127;
        const int ts = (tt & ~127) + n;
        const bool ok = (d == 0) ? (n <= t) : (n >= t);
        const float w = ok ? expf(bc[(size_t)dh * T_ALL + tt] - bc[(size_t)dh * T_ALL + ts] + li[(size_t)dh * T_ALL + ts]) : 0.f;
        Sb[(size_t)m * 128 + n] = f2bf(a * w); }, smem);
    grid.sync();
    gemm_naive(8 * T_ALL, 257, 256,
      [=](int m, int k, int n0) -> float { const int dh = m / T_ALL, tt = m - dh * T_ALL, hd = dh & 3;
        if (k < 128) return bf2f(Sb[(size_t)m * 128 + k]);
        return expf(bc[(size_t)dh * T_ALL + tt]) * bf2f(qk[(size_t)tt * 1024 + hd * 128 + (k - 128)]); },
      [=](int k, int n, int m0) -> float { const int dh = m0 / T_ALL, rem = m0 - dh * T_ALL, hd = dh & 3;
        if (k < 128) { const int ts = (rem & ~127) + k; return n < 256 ? bf2f(Z[(size_t)ts * 3072 + 1024 + hd * 256 + n]) : 1.f; }
        const int row = (m0 & ~127) + (k - 128);
        return n < 256 ? Cst[(size_t)row * 256 + n] : nst[row]; },
      [=](int m, int n, float a) { if (n < 256) hnum[(size_t)m * 256 + n] = a; else hden[m] = a; }, smem);
    grid.sync();
    {
      const int lane = tid & 63;
      for (int it = blockIdx.x * (NT / 64) + (tid >> 6); it < T_ALL * 4; it += G * (NT / 64)) {
        const int tt = it >> 2, hd = it & 3;
        float hs[4] = {0.f, 0.f, 0.f, 0.f};
#pragma unroll
        for (int d = 0; d < 2; ++d) {
          const size_t m = (size_t)(d * 4 + hd) * T_ALL + tt;
          const float dn = fmaxf(fabsf(hden[m]), 1.f);
          const float4 x = *(const float4*)&hnum[m * 256 + lane * 4];
          hs[0] += x.x / dn; hs[1] += x.y / dn; hs[2] += x.z / dn; hs[3] += x.w / dn;
        }
        float ss = hs[0] * hs[0] + hs[1] * hs[1] + hs[2] * hs[2] + hs[3] * hs[3];
        ss = wave_sum(ss);
        const float r = 1.f / sqrtf(ss * (1.f / 256.f) + EPSN);
        float o4[4];
#pragma unroll
        for (int e = 0; e < 4; ++e) {
          const int col = hd * 256 + lane * 4 + e;
          const float o = bf2f(Z[(size_t)tt * 3072 + 2048 + col]);
          o4[e] = hs[e] * r * ng[col] * sigmoid_f(o);
        }
        uint2 o; o.x = pack2(o4[0], o4[1]); o.y = pack2(o4[2], o4[3]);
        *(uint2*)&A2[(size_t)tt * 1024 + hd * 256 + lane * 4] = o;
      }
    }
    grid.sync();
    const bf16_t* Wo = (const bf16_t*)(ws + W_MLOUT);
    auto epi_out = [=](int grow, int gcol0, const f32x4 (&a)[4]) { resid_epi(1, grow, gcol0, a); };
    DENSE_PHASE(A2, 1024, Wo, 1024, 4, 16, true, epi_out);
    grid.sync();
  }
  moe_layer(1, 0);

  {
    norm_phase(P, 0, P.in[6] + 2 * 1024, 2, 0, 1, 0, false, false, 0);
    grid.sync();
    bf16_t* Zg = (bf16_t*)(R + R2_ZG); bf16_t* Zx = (bf16_t*)(R + R2_ZX); float* xc = (float*)(R + R2_XC);
    float* R4 = (float*)(R + R2_R4); float* cA = (float*)(R + R2_CA); float* cH = (float*)(R + R2_CH);
    float* cin = (float*)(R + R2_CIN); bf16_t* A3 = (bf16_t*)(R + R2_ZX);
    const float* cw = P.in[28]; const float* cb = P.in[29];
    const float* w_a = P.in[30]; const float* b_a = P.in[31]; const float* w_x = P.in[32]; const float* b_x = P.in[33];
    const float* lam = P.in[34];
    const bf16_t* Wt = (const bf16_t*)(ws + W_LRUIN);
    auto epi_in = [=](int grow, int gcol0, const f32x4 (&a)[4]) {
      if (gcol0 < 1280) {
        f32x4 b[4];
#pragma unroll
        for (int n = 0; n < 4; ++n)
#pragma unroll
          for (int j = 0; j < 4; ++j) b[n][j] = gelu_f(a[n][j]);
        st16bf(Zg + (size_t)grow * 1280 + gcol0, b);
      } else st16bf(Zx + (size_t)grow * 1280 + gcol0 - 1280, a);
    };
    DENSE_PHASE(hb, 1024, Wt, 1024, 10, 16, true, epi_in);
    grid.sync();
    for (int idx = gtid; idx < T_ALL * 1280; idx += gstride) {
      const int t = idx / 1280, col = idx - t * 1280;
      const int lo = t < T_CTX ? 0 : T_CTX, hi = t < T_CTX ? T_CTX : T_ALL;
      float a = cb[col];
#pragma unroll
      for (int j = 0; j < 4; ++j) { const int tt = t + j - 2; if (tt >= lo && tt < hi) a += bf2f(Zx[(size_t)tt * 1280 + col]) * cw[j * 1280 + col]; }
      xc[idx] = a;
    }
    grid.sync();
    gemm_naive(T_ALL, 5120, 128,
      [=](int m, int k, int n0) -> float { const int c0 = n0 % 1280; return xc[(size_t)m * 1280 + (c0 & ~127) + k]; },
      [=](int k, int n, int m0) -> float { const int dt = n / 1280, c = n - dt * 1280, d = dt >> 1, nb = c >> 7, j = c & 127;
        const float* w = (dt & 1) ? w_x : w_a;
        return w[((size_t)(d * 10 + nb) * 128 + k) * 128 + j]; },
      [=](int m, int n, float a) { const int dt = n / 1280, c = n - dt * 1280, d = dt >> 1;
        const float bias = (dt & 1) ? b_x[d * 1280 + c] : b_a[d * 1280 + c];
        R4[((size_t)dt * T_ALL + m) * 1280 + c] = a + bias; }, smem);
    grid.sync();
    for (int idx = gtid; idx < 2 * NCH * 1280; idx += gstride) {
      const int c = idx % 1280, dn = idx / 1280, n = dn % NCH, d = dn / NCH;
      const float sp = log1pf(expf(-lam[d * 1280 + c]));
      float h = 0.f, A = 1.f;
      for (int st = 0; st < 128; ++st) {
        const int tt = n * 128 + (d == 0 ? st : 127 - st);
        const size_t ia = ((size_t)(2 * d) * T_ALL + tt) * 1280 + c;
        const size_t ix = ((size_t)(2 * d + 1) * T_ALL + tt) * 1280 + c;
        const float r = sigmoid_f(R4[ia]);
        const float ig = sigmoid_f(R4[ix]);
        const float la = -8.f * r * sp;
        const float a = expf(la);
        const float mult = sqrtf(-expm1f(2.f * la));
        const float u = mult * (ig * xc[(size_t)tt * 1280 + c]);
        h = a * h + u;
        A = A * a;
        R4[ia] = h;
        R4[ix] = A;
      }
      cA[idx] = A;
      cH[idx] = h;
    }
    grid.sync();
    for (int idx = gtid; idx < 2 * 1280; idx += gstride) {
      const int d = idx / 1280, c = idx - d * 1280;
      float st = 0.f;
      for (int i = 0; i < NCH; ++i) {
        const int n = scan_order(d, i);
        const int q = (d * NCH + n) * 1280 + c;
        cin[q] = st;
        st = cA[q] * st + cH[q];
      }
    }
    grid.sync();
    for (int idx = gtid; idx < T_LAT * 1280; idx += gstride) {
      const int tl = idx / 1280, c = idx - tl * 1280, t = tl + T_CTX, n = t >> 7;
      float hs = 0.f;
#pragma unroll
      for (int d = 0; d < 2; ++d) {
        const float hl = R4[((size_t)(2 * d) * T_ALL + t) * 1280 + c];
        const float Ac = R4[((size_t)(2 * d + 1) * T_ALL + t) * 1280 + c];
        hs += hl + Ac * cin[(d * NCH + n) * 1280 + c];
      }
      A3[(size_t)t * 1280 + c] = f2bf(bf2f(Zg[(size_t)t * 1280 + c]) * hs);
    }
    grid.sync();
    const bf16_t* Wo = (const bf16_t*)(ws + W_LRUOUT);
    auto epi_out = [=](int grow, int gcol0, const f32x4 (&a)[4]) { resid_epi(2, grow, gcol0, a); };
    DENSE_PHASE(A3, 1280, Wo, 1280, 4, 20, false, epi_out);
    grid.sync();
  }
  moe_layer(2, T_CTX);

  {
    norm_phase(P, T_CTX, P.in[6] + 3 * 1024, 3, 0, 2, T_CTX, false, false, 0);
    grid.sync();
    bf16_t* YT = (bf16_t*)(R + R3_YT); bf16_t* GT = (bf16_t*)(R + R3_GT); bf16_t* Ff = (bf16_t*)(R + R3_FF);
    const bf16_t* WP = (const bf16_t*)(ws + W_FNP);
    for (int L = vb; L < 64 * 8; L += G) {
      const int tm = L >> 3, n0 = (L & 7) * 256;
      gemm_tile<8, false>(shm, 16,
        [=](int r) { return (const bf16_t*)(hb + (size_t)(T_CTX + 128 * (r & 127) + 2 * tm + (r >> 7)) * DM); },
        [=](int cidx) { return WP + (size_t)(n0 + cidx) * 1024; }, KOff64(), KOff64(),
        [=](int row0, int col, f32x4 v) {
          const int b = 2 * tm + (row0 >> 7), a0 = row0 & 127;
          uint2 o; o.x = pack2(v[0], v[1]); o.y = pack2(v[2], v[3]);
          *(uint2*)&YT[((size_t)b * 2048 + n0 + col) * 128 + a0] = o;
        });
    }
    grid.sync();
    {
      const bf16_t* DA = (const bf16_t*)(ws + W_DA);
      for (int colc = vb; colc < 1024; colc += G) {
        gemm_tile<4, false>(shm, 4,
          [=](int r) { return (const bf16_t*)(YT + ((size_t)r * 2048 + colc) * 128); },
          [=](int cidx) { return DA + (size_t)cidx * 256; },
          [=](int kt) { return kt < 2 ? kt * 64 : 1024 * 128 + (kt - 2) * 64; }, KOff64(),
          [=](int row0, int col, f32x4 v) {
            const int ri = col >> 7, c2 = col & 127;
            uint2 o; o.x = pack2(v[0], v[1]); o.y = pack2(v[2], v[3]);
            *(uint2*)&GT[(((size_t)c2 * 1024 + colc) * 2 + ri) * 128 + row0] = o;
          });
      }
    }
    grid.sync();
    {
      const bf16_t* TW = (const bf16_t*)(ws + W_TW);
      for (int L = vb; L < 128 * 4; L += G) {
        const int c2 = L >> 2, n0 = (L & 3) * 256;
        gemm_tile<4, true>(shm, 4,
          [=](int r) { return TW + ((size_t)c2 * 128 + r) * 256; },
          [=](int cidx) { return (const bf16_t*)(GT + ((size_t)c2 * 1024 + n0 + cidx) * 256); }, KOff64(), KOff64(),
          [=](int row, int col0, const f32x4 (&a)[4]) {
            f32x4 b[4];
#pragma unroll
            for (int n = 0; n < 4; ++n) b[n] = a[n] * (1.f / 2048.f);
            st16bf(Ff + (size_t)(c2 + 128 * row) * 1024 + n0 + col0, b);
          });
      }
    }
    grid.sync();
    const bf16_t* Wo = (const bf16_t*)(ws + W_FNOUT);
    const bf16_t* FfA = Ff - (size_t)T_CTX * 1024;
    auto epi_out = [=](int grow, int gcol0, const f32x4 (&a)[4]) { resid_epi(3, grow, gcol0, a); };
    DENSE_PHASE(FfA, 1024, Wo, 1024, 4, 16, false, epi_out);
    grid.sync();
  }
  moe_layer(3, T_CTX);

  norm_phase(P, T_CTX, P.in[8], 0, -1, 3, T_CTX, true, false, 0);
}

extern "C" void kernel_launch(void* const* d_in, const int* in_sizes, int n_in, void* d_out, int out_size,
                              void* d_ws, size_t ws_size, hipStream_t stream) {
  static int grid_blocks = 0;
  if (!grid_blocks) {
    int dev = 0, cus = 0, per_cu = 0;
    (void)hipGetDevice(&dev);
    (void)hipDeviceGetAttribute(&cus, hipDeviceAttributeMultiprocessorCount, dev);
    (void)hipOccupancyMaxActiveBlocksPerMultiprocessor(&per_cu, mega, NT, 0);
    if (per_cu < 1) fprintf(stderr, "kernel_launch: occupancy query says %d blocks/CU\n", per_cu);
    grid_blocks = cus;
    if (ws_size < WS_NEED) fprintf(stderr, "kernel_launch: workspace too small: %zu < %zu\n", ws_size, (size_t)WS_NEED);
  }
  if (n_in != 38 || ws_size < WS_NEED) return;
  Params p{};
  for (int i = 0; i < 38; ++i) p.in[i] = (const float*)d_in[i];
  p.out = (float*)d_out;
  p.ws = (unsigned char*)d_ws;
  void* args[] = {&p};
  hipError_t e = hipLaunchCooperativeKernel((void*)mega, dim3(grid_blocks), dim3(NT), args, 0, stream);
  if (e != hipSuccess) fprintf(stderr, "cooperative launch failed: %s (grid %d)\n", hipGetErrorString(e), grid_blocks);
}
```

```cpp
#include <hip/hip_runtime.h>
#include <hip/hip_cooperative_groups.h>
#include <cstdio>
namespace cg = cooperative_groups;

#define T_ALL 16640
#define T_LAT 16384
#define T_CTX 256
#define DM 1024
#define NCH 130
#define EPSN 1e-6f
#define NT 512

typedef unsigned short bf16_t;
using bf16x8 = __attribute__((ext_vector_type(8))) short;
using f32x4 = __attribute__((ext_vector_type(4))) float;

__device__ __forceinline__ float bf2f(bf16_t v) { return __uint_as_float(((unsigned)v) << 16); }
__device__ __forceinline__ bf16_t f2bf(float f) { unsigned u = __float_as_uint(f); u += 0x7fffu + ((u >> 16) & 1u); return (bf16_t)(u >> 16); }
__device__ __forceinline__ unsigned pack2(float a, float b) { return (unsigned)f2bf(a) | (((unsigned)f2bf(b)) << 16); }
__device__ __forceinline__ float lo2f(unsigned u) { return __uint_as_float(u << 16); }
__device__ __forceinline__ float hi2f(unsigned u) { return __uint_as_float(u & 0xffff0000u); }

constexpr size_t AL(size_t x) { return (x + 255) & ~(size_t)255; }
constexpr size_t WS_MOD    = 0;
constexpr size_t WS_MODP   = AL(WS_MOD + 4 * 2 * 6144 * 4);
constexpr size_t WS_CNT    = AL(WS_MODP + 16 * 4 * 2 * 6144 * 4);
constexpr size_t WS_ZROW   = AL(WS_CNT + 1024);
constexpr size_t WS_BAR    = AL(WS_ZROW + 4096);
constexpr size_t WS_TOK    = AL(WS_BAR + 16384);
constexpr size_t WS_H      = AL(WS_TOK + (size_t)T_ALL * DM * 4);
constexpr size_t WS_ASGW   = AL(WS_H + (size_t)T_ALL * DM * 2);
constexpr size_t WS_LIST   = AL(WS_ASGW + 33280 * 4);
constexpr size_t WS_ROWTOK = AL(WS_LIST + (size_t)32 * 33280 * 4);
constexpr size_t WS_ROWEXP = AL(WS_ROWTOK + 37376 * 4);
constexpr size_t W_CMIN   = AL(WS_ROWEXP + 292 * 4);
constexpr size_t W_CMOUT  = AL(W_CMIN + (size_t)2048 * 1024 * 2);
constexpr size_t W_MLIN   = AL(W_CMOUT + (size_t)1024 * 1024 * 2);
constexpr size_t W_MLOUT  = AL(W_MLIN + (size_t)3072 * 1024 * 2);
constexpr size_t W_LRUIN  = AL(W_MLOUT + (size_t)1024 * 1024 * 2);
constexpr size_t W_LRUOUT = AL(W_LRUIN + (size_t)2560 * 1024 * 2);
constexpr size_t W_FNIN   = AL(W_LRUOUT + (size_t)1024 * 1280 * 2);
constexpr size_t W_FNP    = AL(W_FNIN + (size_t)1024 * 1024 * 2);
constexpr size_t W_FNOUT  = AL(W_FNP + (size_t)2048 * 1024 * 2);
constexpr size_t W_DC     = AL(W_FNOUT + (size_t)1024 * 1024 * 2);
constexpr size_t W_DA     = AL(W_DC + 512 * 256 * 2);
constexpr size_t W_TW     = AL(W_DA + 256 * 256 * 2);
constexpr size_t W_LRUG   = AL(W_TW + (size_t)128 * 128 * 256 * 2);
constexpr size_t W_SP     = AL(W_LRUG + (size_t)20 * 256 * 128 * 2);
constexpr size_t W_EGU    = AL(W_SP + 2 * 1280 * 4);
constexpr size_t W_ED     = AL(W_EGU + (size_t)128 * 1024 * 1024 * 2);
constexpr size_t WS_R     = AL(W_ED + (size_t)128 * 1024 * 512 * 2);
constexpr size_t R_YBUF = 0;
constexpr size_t R_HB   = AL(R_YBUF + (size_t)33280 * 1024 * 2);
constexpr size_t R_MOE_END = AL(R_HB + (size_t)37376 * 512 * 2);
constexpr size_t R0_ZU  = 0;
constexpr size_t R0_ZVT = AL(R0_ZU + (size_t)T_ALL * 1024 * 2);
constexpr size_t R0_P   = AL(R0_ZVT + (size_t)T_ALL * 1024 * 2);
constexpr size_t R0_WSC = AL(R0_P + (size_t)T_ALL * 1024 * 2);
constexpr size_t R0_END = AL(R0_WSC + (size_t)NCH * 4 * 128 * 128 * 2);
constexpr size_t R1_ZQK  = 0;
constexpr size_t R1_ZO   = AL(R1_ZQK + (size_t)T_ALL * 1024 * 2);
constexpr size_t R1_VT   = AL(R1_ZO + (size_t)T_ALL * 1024 * 2);
constexpr size_t R1_GPRE = AL(R1_VT + (size_t)T_ALL * 1024 * 2);
constexpr size_t R1_QN   = AL(R1_GPRE + (size_t)T_ALL * 16 * 4);
constexpr size_t R1_KN   = AL(R1_QN + (size_t)T_ALL * 512 * 2);
constexpr size_t R1_AS   = AL(R1_KN + (size_t)T_ALL * 512 * 2);
constexpr size_t R1_KWT  = AL(R1_AS + (size_t)8 * T_ALL * 256 * 2);
constexpr size_t R1_BC   = AL(R1_KWT + (size_t)8 * T_ALL * 128 * 2);
constexpr size_t R1_LI   = AL(R1_BC + (size_t)8 * T_ALL * 4);
constexpr size_t R1_GCH  = AL(R1_LI + (size_t)8 * T_ALL * 4);
constexpr size_t R1_NLOC = AL(R1_GCH + 8 * NCH * 4);
constexpr size_t R1_NIN  = AL(R1_NLOC + 8 * NCH * 128 * 4);
constexpr size_t R1_CLOC = AL(R1_NIN + 8 * NCH * 128 * 4);
constexpr size_t R1_CINT = AL(R1_CLOC + (size_t)8 * T_ALL * 256 * 4);
constexpr size_t R1_HDEN = AL(R1_CINT + (size_t)8 * T_ALL * 256 * 2);
constexpr size_t R1_A2   = AL(R1_HDEN + 256);
constexpr size_t R1_END  = AL(R1_A2 + (size_t)T_ALL * 1024 * 2);
constexpr size_t R2_ZG  = 0;
constexpr size_t R2_ZX  = AL(R2_ZG + (size_t)T_ALL * 1280 * 2);
constexpr size_t R2_XC  = AL(R2_ZX + (size_t)T_ALL * 1280 * 2);
constexpr size_t R2_LA  = AL(R2_XC + (size_t)T_ALL * 1280 * 2);
constexpr size_t R2_U   = AL(R2_LA + (size_t)2 * T_ALL * 1280 * 2);
constexpr size_t R2_CA  = AL(R2_U + (size_t)2 * T_ALL * 1280 * 2);
constexpr size_t R2_CH  = AL(R2_CA + 2 * NCH * 1280 * 4);
constexpr size_t R2_CIN = AL(R2_CH + 2 * NCH * 1280 * 4);
constexpr size_t R2_END = AL(R2_CIN + 2 * NCH * 1280 * 4);
constexpr size_t R3_YT = 0;
constexpr size_t R3_GT = AL(R3_YT + (size_t)128 * 2048 * 128 * 2);
constexpr size_t R3_FF = AL(R3_GT + (size_t)128 * 2048 * 128 * 2);
constexpr size_t R3_END = AL(R3_FF + (size_t)T_LAT * 1024 * 2);
constexpr size_t cmax(size_t a, size_t b) { return a > b ? a : b; }
constexpr size_t R_SIZE = cmax(cmax(R_MOE_END, R0_END), cmax(cmax(R1_END, R2_END), R3_END));
constexpr size_t WS_NEED = WS_R + R_SIZE;

struct Params { const float* in[38]; float* out; unsigned char* ws; };

__device__ __forceinline__ float sigmoid_f(float x) { return 1.f / (1.f + expf(-x)); }
__device__ __forceinline__ float silu_f(float x) { return x / (1.f + expf(-x)); }
__device__ __forceinline__ float gelu_f(float x) {
  return 0.5f * x * (1.f + tanhf(0.7978845608028654f * (x + 0.044715f * x * x * x)));
}
__device__ __forceinline__ float logsig_f(float x) { return fminf(x, 0.f) - log1pf(expf(-fabsf(x))); }
__device__ __forceinline__ float wave_sum(float v) {
#pragma unroll
  for (int o = 32; o >= 1; o >>= 1) v += __shfl_xor(v, o);
  return v;
}
__device__ __forceinline__ int scan_order(int d, int i) { return d == 0 ? i : (i == 0 ? 1 : (i == 1 ? 0 : 131 - i)); }
__device__ __forceinline__ void st16bf(bf16_t* p, const f32x4 (&a)[4]) {
  uint4 o0, o1;
  o0.x = pack2(a[0][0], a[0][1]); o0.y = pack2(a[0][2], a[0][3]); o0.z = pack2(a[1][0], a[1][1]); o0.w = pack2(a[1][2], a[1][3]);
  o1.x = pack2(a[2][0], a[2][1]); o1.y = pack2(a[2][2], a[2][3]); o1.z = pack2(a[3][0], a[3][1]); o1.w = pack2(a[3][2], a[3][3]);
  *(uint4*)p = o0; *(uint4*)(p + 8) = o1;
}

__device__ __forceinline__ int lds_byte(int r, int c) {
  const int st = (r >> 4) * 2 + (c >> 5), ob = (r & 15) * 64 + (c & 31) * 2;
  return st * 1024 + (ob ^ (((ob >> 9) & 1) << 5));
}
__device__ __forceinline__ void stage_rc(int b, int& R, int& C) {
  const int st = b >> 10, sb = b & 1023, swz = sb ^ (((sb >> 9) & 1) << 5);
  R = (st >> 1) * 16 + (swz >> 6);
  C = (st & 1) * 32 + ((swz & 63) >> 1);
}
__device__ __forceinline__ int perm_col(int p) {
  const int q = p & 63, n = q >> 4, i = q & 15;
  return (p & ~63) + (i >> 2) * 16 + n * 4 + (i & 3);
}
struct KOff64 { __device__ __forceinline__ int operator()(int kt) const { return kt * 64; } };
#define GEMM_LDS_BYTES 131072

template <int MI, bool SWAP, class RA, class RB, class KA, class KB, class EP>
__device__ __forceinline__ void gemm_tile(char* shm, int nk, RA rowA, RB rowB, KA koffA, KB koffB, EP epi) {
  constexpr int BM = 32 * MI, GLA = MI / 2, GLB = 4;
  constexpr int TILE_A = BM * 128, TILE_B = 256 * 128, STG = TILE_A + TILE_B;
  static_assert(2 * STG <= GEMM_LDS_BYTES, "LDS");
  int tid_ = threadIdx.x;
  asm volatile("" : "+v"(tid_));
  const int tid = tid_, wid = tid >> 6, lane = tid & 63, wr = wid >> 2, wc = wid & 3, fr = lane & 15, fq = lane >> 4;
  const bf16_t* pa[GLA];
  const bf16_t* pb[GLB];
#pragma unroll
  for (int i = 0; i < GLA; ++i) { int R, C; stage_rc(wid * 1024 + i * 8192 + lane * 16, R, C); pa[i] = rowA(R) + C; }
#pragma unroll
  for (int i = 0; i < GLB; ++i) { int R, C; stage_rc(wid * 1024 + i * 8192 + lane * 16, R, C); pb[i] = rowB(SWAP ? perm_col(R) : R) + C; }
  f32x4 acc[MI][4];
#pragma unroll
  for (int m = 0; m < MI; ++m)
#pragma unroll
    for (int n = 0; n < 4; ++n) acc[m][n] = f32x4{0.f, 0.f, 0.f, 0.f};

#define GT_STAGE(buf, kt) do { const int ka_ = koffA(kt), kb_ = koffB(kt);                                            \
    _Pragma("unroll") for (int i = 0; i < GLA; ++i)                                                                    \
      __builtin_amdgcn_global_load_lds((const unsigned*)(pa[i] + ka_), (unsigned*)(shm + (buf) * STG + wid * 1024 + i * 8192), 16, 0, 0); \
    _Pragma("unroll") for (int i = 0; i < GLB; ++i)                                                                    \
      __builtin_amdgcn_global_load_lds((const unsigned*)(pb[i] + kb_), (unsigned*)(shm + (buf) * STG + TILE_A + wid * 1024 + i * 8192), 16, 0, 0); } while (0)

  GT_STAGE(0, 0);
  asm volatile("s_waitcnt vmcnt(0)" ::: "memory");
  __syncthreads();
  for (int t = 0; t < nk; ++t) {
    const int cur = t & 1;
    if (t + 1 < nk) GT_STAGE(cur ^ 1, t + 1);
    const char* sa = shm + cur * STG;
    const char* sb = sa + TILE_A;
#pragma unroll
    for (int ks = 0; ks < 2; ++ks) {
      bf16x8 At[MI], Bf[4];
#pragma unroll
      for (int m = 0; m < MI; ++m) At[m] = *(const bf16x8*)(sa + lds_byte(wr * (MI * 16) + m * 16 + fr, ks * 32 + fq * 8));
#pragma unroll
      for (int n = 0; n < 4; ++n) Bf[n] = *(const bf16x8*)(sb + lds_byte(wc * 64 + n * 16 + fr, ks * 32 + fq * 8));
#pragma unroll
      for (int m = 0; m < MI; ++m)
#pragma unroll
        for (int n = 0; n < 4; ++n) {
          if (SWAP) acc[m][n] = __builtin_amdgcn_mfma_f32_16x16x32_bf16(Bf[n], At[m], acc[m][n], 0, 0, 0);
          else      acc[m][n] = __builtin_amdgcn_mfma_f32_16x16x32_bf16(At[m], Bf[n], acc[m][n], 0, 0, 0);
        }
      __builtin_amdgcn_sched_barrier(0);
    }
    asm volatile("s_waitcnt vmcnt(0)" ::: "memory");
    __syncthreads();
  }
#undef GT_STAGE
  if constexpr (SWAP) {
#pragma unroll
    for (int m = 0; m < MI; ++m) epi(wr * (MI * 16) + m * 16 + fr, wc * 64 + fq * 16, acc[m]);
  } else {
#pragma unroll
    for (int m = 0; m < MI; ++m)
#pragma unroll
      for (int n = 0; n < 4; ++n) epi(wr * (MI * 16) + m * 16 + fq * 4, wc * 64 + n * 16 + fr, acc[m][n]);
  }
}


#define XB_TMO      128
#define XB_XCNT(j)  (256  + 64 * (j))
#define XB_XSUB(j)  (1280 + 64 * (j))
#define XB_XGEN(j)  (2304 + 64 * (j))
#define XB_TOP      3328
#define XB_TOPGEN   3392
#define XCD_BAR_WORDS 3456
#define XB_SPIN_CAP (1u << 22)
#define LAS __attribute__((address_space(3)))
__device__ __forceinline__ unsigned xb_ld(unsigned* p)              { return __hip_atomic_load(p, __ATOMIC_RELAXED, __HIP_MEMORY_SCOPE_AGENT); }
__device__ __forceinline__ unsigned xb_add(unsigned* p, unsigned v) { return __hip_atomic_fetch_add(p, v, __ATOMIC_RELAXED, __HIP_MEMORY_SCOPE_AGENT); }
__device__ __forceinline__ unsigned xb_xcc_id() { return (unsigned)__builtin_amdgcn_s_getreg((3 << 11) | 20) & 0xFu; }
#define XB_SPIN(cond, bar) do { unsigned _sp = 0; while (cond) { __builtin_amdgcn_s_sleep(1); \
    if ((++_sp & 255u) == 0u) { if (xb_ld(&(bar)[XB_TMO])) break; if (_sp > XB_SPIN_CAP) { atomicAdd(&(bar)[XB_TMO], 1u); break; } } } } while (0)
struct XcdBarrier { unsigned* bar; unsigned x; volatile LAS unsigned* st; };
__device__ __forceinline__ XcdBarrier xcd_barrier_post(unsigned* bar, volatile LAS unsigned* st) {
    XcdBarrier b; b.bar = bar; b.x = xb_xcc_id(); b.st = st;
    if (threadIdx.x == 0) (void)xb_add(&bar[XB_XCNT(b.x)], 1u);
    return b;
}
__device__ __forceinline__ void xcd_barrier_complete(unsigned* bar, unsigned x, unsigned& nloc, unsigned& nx) {
    const unsigned G = gridDim.x * gridDim.y * gridDim.z;
    unsigned sum, cnt, mine, sp = 0u;
    for (;;) {
        sum = 0u; cnt = 0u; mine = 0u;
#pragma unroll
        for (unsigned j = 0; j < 16; ++j) { const unsigned c = xb_ld(&bar[XB_XCNT(j)]); sum += c; cnt += (c > 0u) ? 1u : 0u; mine = (j == x) ? c : mine; }
        if (sum == G) break;
        __builtin_amdgcn_s_sleep(1);
        if ((++sp & 255u) == 0u) { if (xb_ld(&bar[XB_TMO])) break; if (sp > XB_SPIN_CAP) { atomicAdd(&bar[XB_TMO], 1u); break; } }
    }
    nloc = mine > 0u ? mine : 1u; nx = cnt > 0u ? cnt : 1u;
}
__device__ __forceinline__ void xcd_barrier(const XcdBarrier& b) {
    asm volatile("s_waitcnt vmcnt(0)" ::: "memory");
    __syncthreads();
    if (threadIdx.x == 0) {
        unsigned* bar = b.bar;
        __builtin_amdgcn_s_waitcnt(0);
        unsigned nloc = b.st[0], nx = b.st[1];
        if (nloc == 0u) { xcd_barrier_complete(bar, b.x, nloc, nx); b.st[0] = nloc; b.st[1] = nx; }
        const unsigned old = xb_add(&bar[XB_XSUB(b.x)], 1u);
        const unsigned gen = old / nloc;
        if (old + 1u == (gen + 1u) * nloc) {
            __builtin_amdgcn_fence(__ATOMIC_RELEASE, "agent");
            asm volatile("s_waitcnt vmcnt(0)" ::: "memory");
            const unsigned og = xb_add(&bar[XB_TOP], 1u);
            const unsigned tg = og / nx;
            if (og + 1u == (tg + 1u) * nx) xb_add(&bar[XB_TOPGEN], 1u);
            else XB_SPIN(xb_ld(&bar[XB_TOPGEN]) == tg, bar);
            __builtin_amdgcn_fence(__ATOMIC_ACQUIRE, "agent");
            xb_add(&bar[XB_XGEN(b.x)], 1u);
            asm volatile("s_waitcnt vmcnt(0)" ::: "memory");
        } else {
            XB_SPIN(xb_ld(&bar[XB_XGEN(b.x)]) == gen, bar);
            __builtin_amdgcn_fence(__ATOMIC_ACQUIRE, "agent");
            asm volatile("s_waitcnt vmcnt(0)" ::: "memory");
        }
    }
    __syncthreads();
}

template <class AF, class BF, class EF>
__device__ __forceinline__ void gemm_naive(int M, int N, int K, AF af, BF bf, EF ef, float* smem_all) {
  const int half = threadIdx.x >> 8, tid = threadIdx.x & 255;
  float* smem = smem_all + half * (2 * 16 * 68);
  const int tilesM = (M + 63) >> 6, tilesN = (N + 63) >> 6;
  const int ntiles = tilesM * tilesN;
  float (*As)[68] = (float (*)[68])smem;
  float (*Bs)[68] = (float (*)[68])(smem + 16 * 68);
  const int ty = tid >> 4, tx = tid & 15;
  const int stride = gridDim.x * 2;
  const int iters = (ntiles + stride - 1) / stride;
  for (int it = 0; it < iters; ++it) {
    const int tile = it * stride + blockIdx.x * 2 + half;
    const bool valid = tile < ntiles;
    const int tm = valid ? tile / tilesN : 0, tn = valid ? tile - tm * tilesN : 0;
    const int m0 = tm << 6, n0 = tn << 6;
    float acc[4][4];
#pragma unroll
    for (int i = 0; i < 4; ++i)
#pragma unroll
      for (int j = 0; j < 4; ++j) acc[i][j] = 0.f;
    for (int k0 = 0; k0 < K; k0 += 16) {
#pragma unroll
      for (int i = 0; i < 4; ++i) {
        const int mm = (tid >> 4) + 16 * i, kk = tid & 15;
        const int m = m0 + mm, k = k0 + kk;
        As[kk][mm] = (valid && m < M && k < K) ? af(m, k, n0) : 0.f;
      }
#pragma unroll
      for (int i = 0; i < 4; ++i) {
        const int kk = (tid >> 6) + 4 * i, nn = tid & 63;
        const int k = k0 + kk, n = n0 + nn;
        Bs[kk][nn] = (valid && k < K && n < N) ? bf(k, n, m0) : 0.f;
      }
      __syncthreads();
#pragma unroll
      for (int kk = 0; kk < 16; ++kk) {
        const float4 a = *(const float4*)&As[kk][ty * 4];
        const float4 b = *(const float4*)&Bs[kk][tx * 4];
        const float av[4] = {a.x, a.y, a.z, a.w};
        const float bv[4] = {b.x, b.y, b.z, b.w};
#pragma unroll
        for (int i = 0; i < 4; ++i)
#pragma unroll
          for (int j = 0; j < 4; ++j) acc[i][j] = fmaf(av[i], bv[j], acc[i][j]);
      }
      __syncthreads();
    }
    if (valid) {
#pragma unroll
      for (int i = 0; i < 4; ++i)
#pragma unroll
        for (int j = 0; j < 4; ++j) {
          const int m = m0 + ty * 4 + i, n = n0 + tx * 4 + j;
          if (m < M && n < N) ef(m, n, acc[i][j]);
        }
    }
  }
}

__device__ __forceinline__ void conv_tile(const float* src, int ldn, bf16_t* dst, int ldk, int k0, int n0, int mapmode, float* sm) {
  const int tid = threadIdx.x;
  float (*tl)[65] = (float (*)[65])sm;
  {
    const int row = tid >> 3, c4 = (tid & 7) * 4;
    const float4 a = *(const float4*)&src[(size_t)(k0 + row) * ldn + n0 + c4];
    const float4 b = *(const float4*)&src[(size_t)(k0 + row) * ldn + n0 + 32 + c4];
    tl[row][c4 + 0] = a.x; tl[row][c4 + 1] = a.y; tl[row][c4 + 2] = a.z; tl[row][c4 + 3] = a.w;
    tl[row][32 + c4 + 0] = b.x; tl[row][32 + c4 + 1] = b.y; tl[row][32 + c4 + 2] = b.z; tl[row][32 + c4 + 3] = b.w;
  }
  __syncthreads();
  {
    const int n = tid >> 3, kg = (tid & 7) * 8;
    uint4 o;
    o.x = pack2(tl[kg + 0][n], tl[kg + 1][n]); o.y = pack2(tl[kg + 2][n], tl[kg + 3][n]);
    o.z = pack2(tl[kg + 4][n], tl[kg + 5][n]); o.w = pack2(tl[kg + 6][n], tl[kg + 7][n]);
    const int h = n0 + n;
    const int dr = mapmode == 0 ? h : ((h >> 3) * 16 + (h & 7) + (mapmode == 2 ? 8 : 0));
    *(uint4*)&dst[(size_t)dr * ldk + k0 + kg] = o;
  }
  __syncthreads();
}

__device__ __forceinline__ void norm_phase(const Params& P, int t0, const float* gw,
                                           int mod_layer, int shift_idx,
                                           int pend_layer, int pend_t0,
                                           bool to_out, bool router, int layer) {
  unsigned char* ws = P.ws;
  float* tok = (float*)(ws + WS_TOK);
  bf16_t* hb = (bf16_t*)(ws + WS_H);
  const float* mod = (const float*)(ws + WS_MOD);
  const bf16_t* ybuf = (const bf16_t*)(ws + WS_R + R_YBUF);
  const int lane = threadIdx.x & 63;
  const int gw_id = blockIdx.x * (NT / 64) + (threadIdx.x >> 6);
  const int gw_n = gridDim.x * (NT / 64);
  for (int t = t0 + gw_id; t < T_ALL; t += gw_n) {
    const int s = (t < T_CTX) ? 1 : 0;
    float v[16];
#pragma unroll
    for (int j = 0; j < 4; ++j) {
      const int n = j * 256 + lane * 4;
      const float4 x = *(const float4*)&tok[(size_t)t * DM + n];
      v[j * 4 + 0] = x.x; v[j * 4 + 1] = x.y; v[j * 4 + 2] = x.z; v[j * 4 + 3] = x.w;
    }
    if (pend_layer >= 0 && t >= pend_t0) {
      const float* gate = mod + (size_t)((pend_layer * 2 + s) * 6 + 5) * 1024;
#pragma unroll
      for (int j = 0; j < 4; ++j) {
        const int n = j * 256 + lane * 4;
        const uint2 y0 = *(const uint2*)&ybuf[(size_t)(2 * t) * DM + n];
        const uint2 y1 = *(const uint2*)&ybuf[(size_t)(2 * t + 1) * DM + n];
        const float4 g = *(const float4*)&gate[n];
        v[j * 4 + 0] += g.x * (lo2f(y0.x) + lo2f(y1.x));
        v[j * 4 + 1] += g.y * (hi2f(y0.x) + hi2f(y1.x));
        v[j * 4 + 2] += g.z * (lo2f(y0.y) + lo2f(y1.y));
        v[j * 4 + 3] += g.w * (hi2f(y0.y) + hi2f(y1.y));
        *(float4*)&tok[(size_t)t * DM + n] = make_float4(v[j * 4 + 0], v[j * 4 + 1], v[j * 4 + 2], v[j * 4 + 3]);
      }
    }
    float ss = 0.f;
#pragma unroll
    for (int e = 0; e < 16; ++e) ss += v[e] * v[e];
    ss = wave_sum(ss);
    const float r = 1.f / sqrtf(ss * (1.f / 1024.f) + EPSN);
    float h[16];
#pragma unroll
    for (int j = 0; j < 4; ++j) {
      const int n = j * 256 + lane * 4;
      const float4 g = *(const float4*)&gw[n];
      h[j * 4 + 0] = v[j * 4 + 0] * r * g.x;
      h[j * 4 + 1] = v[j * 4 + 1] * r * g.y;
      h[j * 4 + 2] = v[j * 4 + 2] * r * g.z;
      h[j * 4 + 3] = v[j * 4 + 3] * r * g.w;
      if (shift_idx >= 0) {
        const float* sh = mod + (size_t)((mod_layer * 2 + s) * 6 + shift_idx) * 1024;
        const float* sc = sh + 1024;
        const float4 a = *(const float4*)&sh[n];
        const float4 b = *(const float4*)&sc[n];
        h[j * 4 + 0] = h[j * 4 + 0] * (1.f + b.x) + a.x;
        h[j * 4 + 1] = h[j * 4 + 1] * (1.f + b.y) + a.y;
        h[j * 4 + 2] = h[j * 4 + 2] * (1.f + b.z) + a.z;
        h[j * 4 + 3] = h[j * 4 + 3] * (1.f + b.w) + a.w;
      }
      if (to_out) {
        *(float4*)&P.out[(size_t)(t - T_CTX) * DM + n] = make_float4(h[j * 4 + 0], h[j * 4 + 1], h[j * 4 + 2], h[j * 4 + 3]);
      } else {
        uint2 o; o.x = pack2(h[j * 4 + 0], h[j * 4 + 1]); o.y = pack2(h[j * 4 + 2], h[j * 4 + 3]);
        *(uint2*)&hb[(size_t)t * DM + n] = o;
      }
    }
    if (router) {
      const float* rgw = P.in[9] + (size_t)layer * 1024 * 4;
      const float* rgb = P.in[10] + layer * 4;
      const float* rew = P.in[11] + (size_t)layer * 1024 * 32;
      const float* reb = P.in[12] + layer * 32;
      float lg[36];
#pragma unroll
      for (int q = 0; q < 36; ++q) lg[q] = 0.f;
#pragma unroll
      for (int j = 0; j < 4; ++j) {
#pragma unroll
        for (int e = 0; e < 4; ++e) {
          const int n = j * 256 + lane * 4 + e;
          const float hv = h[j * 4 + e];
          const float4 g4 = *(const float4*)&rgw[(size_t)n * 4];
          lg[0] += hv * g4.x; lg[1] += hv * g4.y; lg[2] += hv * g4.z; lg[3] += hv * g4.w;
#pragma unroll
          for (int q = 0; q < 8; ++q) {
            const float4 w4 = *(const float4*)&rew[(size_t)n * 32 + q * 4];
            lg[4 + q * 4 + 0] += hv * w4.x; lg[4 + q * 4 + 1] += hv * w4.y;
            lg[4 + q * 4 + 2] += hv * w4.z; lg[4 + q * 4 + 3] += hv * w4.w;
          }
        }
      }
#pragma unroll
      for (int q = 0; q < 36; ++q) lg[q] = wave_sum(lg[q]);
#pragma unroll
      for (int q = 0; q < 4; ++q) lg[q] += rgb[q];
#pragma unroll
      for (int q = 0; q < 32; ++q) lg[4 + q] += reb[q];
      int grp = 0; float best = lg[0];
#pragma unroll
      for (int q = 1; q < 4; ++q) if (lg[q] > best) { best = lg[q]; grp = q; }
      float se = 0.f;
#pragma unroll
      for (int q = 0; q < 4; ++q) se += expf(lg[q] - best);
      const float pg = 1.f / se;
      float v0 = -3.0e38f, v1 = -3.0e38f; int i0 = 0, i1 = 0;
#pragma unroll
      for (int g = 0; g < 4; ++g) {
#pragma unroll
        for (int q = 0; q < 8; ++q) {
          const float x = lg[4 + g * 8 + q];
          if (g == grp) {
            if (x > v0) { v1 = v0; i1 = i0; v0 = x; i0 = q; }
            else if (x > v1) { v1 = x; i1 = q; }
          }
        }
      }
      const float w0 = 1.f / (1.f + expf(v1 - v0));
      const float w1 = 1.f - w0;
      if (lane == 0) {
        int* cnt = (int*)(ws + WS_CNT) + layer * 32;
        int* list = (int*)(ws + WS_LIST);
        float* asgw = (float*)(ws + WS_ASGW);
        const int e0 = grp * 8 + i0, e1 = grp * 8 + i1;
        const int p0 = atomicAdd(&cnt[e0], 1);
        list[(size_t)e0 * 33280 + p0] = 2 * t;
        asgw[2 * t] = w0 * pg;
        const int p1 = atomicAdd(&cnt[e1], 1);
        list[(size_t)e1 * 33280 + p1] = 2 * t + 1;
        asgw[2 * t + 1] = w1 * pg;
      }
    }
  }
}

__device__ __forceinline__ void moe_build(const Params& P, int layer, int* sm) {
  unsigned char* ws = P.ws;
  const int* cnt = (const int*)(ws + WS_CNT) + layer * 32;
  int* meta = (int*)(ws + WS_CNT) + 128;
  const int* list = (const int*)(ws + WS_LIST);
  int* rowtok = (int*)(ws + WS_ROWTOK);
  int* rowexp = (int*)(ws + WS_ROWEXP);
  if (threadIdx.x == 0) {
    int s = 0;
    for (int e = 0; e < 32; ++e) { sm[e] = s; s += (cnt[e] + 127) / 128 * 128; }
    sm[32] = s;
  }
  __syncthreads();
  const int total = sm[32];
  for (int m = blockIdx.x * NT + threadIdx.x; m < total; m += gridDim.x * NT) {
    int e = 0;
    for (int q = 1; q < 32; ++q) if (sm[q] <= m) e = q;
    const int r = m - sm[e];
    rowtok[m] = (r < cnt[e]) ? list[(size_t)e * 33280 + r] : -1;
    if ((m & 127) == 0) rowexp[m >> 7] = e;
  }
  if (blockIdx.x == 0 && threadIdx.x == 0) meta[layer] = total;
  __syncthreads();
}

__global__ void __launch_bounds__(NT, 2) mega(Params P) {
  cg::grid_group grid = cg::this_grid();
  __shared__ __attribute__((aligned(1024))) char shm[GEMM_LDS_BYTES + 16];
  float* smem = (float*)shm;
  if (threadIdx.x < 4) ((unsigned*)(shm + GEMM_LDS_BYTES))[threadIdx.x] = 0u;
  __syncthreads();
  XcdBarrier xbar = xcd_barrier_post((unsigned*)(P.ws + WS_BAR), (volatile LAS unsigned*)(shm + GEMM_LDS_BYTES));
  unsigned char* ws = P.ws;
  const int tid = threadIdx.x;
  const int gtid = blockIdx.x * NT + tid;
  const int gstride = gridDim.x * NT;
  const int G = gridDim.x;
  const int vb = (G % 8 == 0) ? ((int)(blockIdx.x & 7) * (G / 8) + (int)(blockIdx.x >> 3)) : (int)blockIdx.x;
  float* tok = (float*)(ws + WS_TOK);
  bf16_t* hb = (bf16_t*)(ws + WS_H);
  float* mod = (float*)(ws + WS_MOD);
  const bf16_t* zrow = (const bf16_t*)(ws + WS_ZROW);
  unsigned char* R = ws + WS_R;

  {
    const float* x = P.in[0]; const float* ctx = P.in[2];
    for (int idx = gtid; idx < T_ALL * 256; idx += gstride) {
      const int t = idx >> 8, n = (idx & 255) * 4;
      float4 o;
      if (t < T_CTX) o = *(const float4*)&ctx[(size_t)t * DM + n];
      else {
        const int tl = t - T_CTX;
        o = *(const float4*)&x[(size_t)tl * DM + n];
        float pe[4];
#pragma unroll
        for (int e = 0; e < 4; ++e) {
          const int nn = n + e, qd = nn >> 8, j = nn & 255;
          const float freq = expf(-9.210340371976184f * (float)j / 256.f);
          const float pos = (qd < 2) ? (float)(tl >> 6) : (float)(tl & 63);
          const float ang = pos * freq;
          pe[e] = (qd & 1) ? cosf(ang) : sinf(ang);
        }
        o.x += pe[0]; o.y += pe[1]; o.z += pe[2]; o.w += pe[3];
      }
      *(float4*)&tok[(size_t)t * DM + n] = o;
    }
    const float* c = P.in[1]; const float* cc = P.in[3]; const float* adaw = P.in[4];
    float* modp = (float*)(ws + WS_MODP);
    for (int idx = gtid; idx < 16 * 4 * 6144; idx += gstride) {
      const int ks = idx / 24576, rem = idx - ks * 24576, i = rem / 6144, j = rem - i * 6144;
      float a0 = 0.f, a1 = 0.f;
      for (int k = ks * 64; k < ks * 64 + 64; ++k) {
        const float w = adaw[((size_t)i * 1024 + k) * 6144 + j];
        a0 += silu_f(c[k]) * w;
        a1 += silu_f(cc[k]) * w;
      }
      modp[(size_t)(ks * 8 + i * 2 + 0) * 6144 + j] = a0;
      modp[(size_t)(ks * 8 + i * 2 + 1) * 6144 + j] = a1;
    }
    if (gtid < 256) ((int*)(ws + WS_CNT))[gtid] = 0;
    if (gtid < 1024) ((unsigned*)(ws + WS_ZROW))[gtid] = 0u;
    bf16_t* DC = (bf16_t*)(ws + W_DC); bf16_t* DA = (bf16_t*)(ws + W_DA); bf16_t* TW = (bf16_t*)(ws + W_TW);
    for (int idx = gtid; idx < 512 * 256; idx += gstride) {
      const int row = idx >> 8, cch = idx & 255, pq = row >> 8, kc = row & 255;
      const float a = (float)((kc * cch) & 255) * (1.f / 128.f);
      DC[idx] = f2bf(pq ? -sinpif(a) : cospif(a));
    }
    for (int idx = gtid; idx < 256 * 256; idx += gstride) {
      const int row = idx >> 8, col = idx & 255, ri = row >> 7, cc2 = row & 127, rj = col >> 7, aa = col & 127;
      const float a = (float)((aa * cc2) & 127) * (1.f / 64.f);
      const float cs = cospif(a), sn = sinpif(a);
      DA[idx] = f2bf(ri == rj ? cs : (ri == 0 ? sn : -sn));
    }
    for (int idx = gtid; idx < 128 * 128 * 256; idx += gstride) {
      const int col = idx & 255, e = (idx >> 8) & 127, c2 = idx >> 15, ri = col >> 7, b = col & 127;
      const float a = (float)((b * (c2 + 128 * e)) & 16383) * (1.f / 8192.f);
      TW[idx] = f2bf(ri ? sinpif(a) : cospif(a));
    }
    for (int idx = gtid; idx < 2 * 1280; idx += gstride) ((float*)(ws + W_SP))[idx] = log1pf(expf(-P.in[34][idx]));
    {
      const float* src = P.in[36]; bf16_t* dst = (bf16_t*)(ws + W_FNIN);
      for (int idx = gtid; idx < 1024 * 1024 / 4; idx += gstride) {
        const float4 a = *(const float4*)&src[(size_t)idx * 4];
        uint2 o; o.x = pack2(a.x, a.y); o.y = pack2(a.z, a.w);
        *(uint2*)&dst[(size_t)idx * 4] = o;
      }
    }
    const int NDENSE = 512 + 256 + 768 + 256 + 640 + 320 + 256 + 160;
    const int NTOT = NDENSE + 128 * 384;
    for (int u = blockIdx.x; u < NTOT; u += G) {
      if (u < NDENSE) {
        int v = u;
        if (v < 512) { conv_tile(P.in[16], 2048, (bf16_t*)(ws + W_CMIN), 1024, (v >> 5) * 64, (v & 31) * 64, 0, smem); continue; }
        v -= 512;
        if (v < 256) { conv_tile(P.in[20], 1024, (bf16_t*)(ws + W_CMOUT), 1024, (v >> 4) * 64, (v & 15) * 64, 0, smem); continue; }
        v -= 256;
        if (v < 768) { conv_tile(P.in[21], 3088, (bf16_t*)(ws + W_MLIN), 1024, (v / 48) * 64, (v % 48) * 64, 0, smem); continue; }
        v -= 768;
        if (v < 256) { conv_tile(P.in[26], 1024, (bf16_t*)(ws + W_MLOUT), 1024, (v >> 4) * 64, (v & 15) * 64, 0, smem); continue; }
        v -= 256;
        if (v < 640) { conv_tile(P.in[27], 2560, (bf16_t*)(ws + W_LRUIN), 1024, (v / 40) * 64, (v % 40) * 64, 0, smem); continue; }
        v -= 640;
        if (v < 320) { conv_tile(P.in[35], 1024, (bf16_t*)(ws + W_LRUOUT), 1280, (v >> 4) * 64, (v & 15) * 64, 0, smem); continue; }
        v -= 320;
        if (v < 256) { conv_tile(P.in[37], 1024, (bf16_t*)(ws + W_FNOUT), 1024, (v >> 4) * 64, (v & 15) * 64, 0, smem); continue; }
        v -= 256;
        {
          const int mat = v >> 2, tl4 = v & 3, type = mat / 20, dnb = mat % 20, d = dnb / 10, nb = dnb % 10;
          const float* srcm = (type ? P.in[32] : P.in[30]) + (size_t)dnb * 128 * 128;
          conv_tile(srcm, 128, (bf16_t*)(ws + W_LRUG) + (size_t)(nb * 2 + d) * 256 * 128, 128, (tl4 >> 1) * 64, (tl4 & 1) * 64, type + 1, smem);
        }
      } else {
        const int v = u - NDENSE, le = v / 384, r = v - le * 384, kind = r >> 7, tt = r & 127;
        if (kind < 2) {
          const float* src = (kind == 0 ? P.in[13] : P.in[14]) + (size_t)le * 1024 * 512;
          conv_tile(src, 512, (bf16_t*)(ws + W_EGU) + (size_t)le * 1024 * 1024, 1024, (tt >> 3) * 64, (tt & 7) * 64, kind + 1, smem);
        } else {
          const float* src = P.in[15] + (size_t)le * 512 * 1024;
          conv_tile(src, 1024, (bf16_t*)(ws + W_ED) + (size_t)le * 1024 * 512, 512, (tt >> 4) * 64, (tt & 15) * 64, 0, smem);
        }
      }
    }
  }
  grid.sync();
  {
    const float* modp = (const float*)(ws + WS_MODP);
    const float* adab = P.in[5];
    for (int idx = gtid; idx < 8 * 6144; idx += gstride) {
      const int is = idx / 6144, j = idx - is * 6144, i = is >> 1;
      float a = adab[i * 6144 + j];
      for (int ks = 0; ks < 16; ++ks) a += modp[(size_t)(ks * 8 + is) * 6144 + j];
      mod[idx] = a;
    }
    if (vb < 32) {
      const int tm = vb >> 2, tn = vb & 3, pq = tm >> 2, g = tm & 3, n0 = tn * 256;
      const bf16_t* DC = (const bf16_t*)(ws + W_DC);
      const bf16_t* WI = (const bf16_t*)(ws + W_FNIN);
      bf16_t* WP = (bf16_t*)(ws + W_FNP);
      gemm_tile<8, true>(shm, 4,
        [=](int r) { return DC + (size_t)(pq * 256 + r) * 256; },
        [=](int cidx) { return WI + (size_t)(n0 + cidx) * 1024 + g * 256; }, KOff64(), KOff64(),
        [=](int row, int col0, const f32x4 (&a)[4]) { st16bf(WP + (size_t)(tm * 256 + row) * 1024 + n0 + col0, a); });
    }
  }
  xcd_barrier(xbar);

#define MODV(i, s, j, n) mod[(size_t)(((i) * 2 + (s)) * 6 + (j)) * 1024 + (n)]

#define DENSE_PHASE(Aptr, lda, Wt, ldw, NTILES_N, NK, WITH_CTX, EPI)                                                    \
  do {                                                                                                                  \
    const int nbig_ = 64 * (NTILES_N);                                                                                  \
    for (int L_ = vb; L_ < nbig_; L_ += G) {                                                                            \
      const int m0_ = (1 + L_ / (NTILES_N)) * 256, n0_ = (L_ % (NTILES_N)) * 256;                                       \
      gemm_tile<8, true>(shm, (NK),                                                                                     \
        [=](int r) { return (Aptr) + (size_t)(m0_ + r) * (lda); },                                                      \
        [=](int cidx) { return (Wt) + (size_t)(n0_ + cidx) * (ldw); }, KOff64(), KOff64(),                              \
        [=](int row, int col0, const f32x4 (&a)[4]) { EPI(m0_ + row, n0_ + col0, a); });                                \
    }                                                                                                                   \
    if (WITH_CTX) {                                                                                                     \
      const int s_ = (vb - (nbig_ % G) + G) % G;                                                                        \
      if (s_ < 4 * (NTILES_N)) {                                                                                        \
        const int m0_ = (s_ / (NTILES_N)) * 64, n0_ = (s_ % (NTILES_N)) * 256;                                          \
        gemm_tile<2, true>(shm, (NK),                                                                                   \
          [=](int r) { return (Aptr) + (size_t)(m0_ + r) * (lda); },                                                    \
          [=](int cidx) { return (Wt) + (size_t)(n0_ + cidx) * (ldw); }, KOff64(), KOff64(),                            \
          [=](int row, int col0, const f32x4 (&a)[4]) { EPI(m0_ + row, n0_ + col0, a); });                              \
      }                                                                                                                 \
    }                                                                                                                   \
  } while (0)

  auto resid_epi = [=](int layer, int grow, int gcol0, const f32x4 (&a)[4]) {
    const int s = grow < T_CTX ? 1 : 0;
    const float* gate = &MODV(layer, s, 2, gcol0);
    float* p = tok + (size_t)grow * DM + gcol0;
#pragma unroll
    for (int n = 0; n < 4; ++n) {
      float4 t4 = *(float4*)(p + n * 4);
      const float4 g4 = *(const float4*)(gate + n * 4);
      t4.x += g4.x * a[n][0]; t4.y += g4.y * a[n][1]; t4.z += g4.z * a[n][2]; t4.w += g4.w * a[n][3];
      *(float4*)(p + n * 4) = t4;
    }
  };

  auto moe_layer = [&](int layer, int t0) {
    norm_phase(P, t0, P.in[7] + layer * 1024, layer, 3, -1, 0, false, true, layer);
    xcd_barrier(xbar);
    moe_build(P, layer, (int*)smem);
    xcd_barrier(xbar);
    const int total = ((const int*)(ws + WS_CNT))[128 + layer];
    const int* rowtok = (const int*)(ws + WS_ROWTOK);
    const int* rowexp = (const int*)(ws + WS_ROWEXP);
    bf16_t* HB = (bf16_t*)(R + R_HB);
    bf16_t* ybuf = (bf16_t*)(R + R_YBUF);
    const float* asgw = (const float*)(ws + WS_ASGW);
    const bf16_t* WGU = (const bf16_t*)(ws + W_EGU) + (size_t)layer * 32 * 1024 * 1024;
    const bf16_t* WD = (const bf16_t*)(ws + W_ED) + (size_t)layer * 32 * 1024 * 512;
    const int ntile = (total >> 7) * 4;
    for (int L = vb; L < ntile; L += G) {
      const int mb = L >> 2, n0 = (L & 3) * 256, m0 = mb * 128, e = rowexp[mb];
      const bf16_t* wb = WGU + (size_t)e * 1024 * 1024;
      gemm_tile<4, true>(shm, 16,
        [=](int r) { const int rt = rowtok[m0 + r]; return rt >= 0 ? (const bf16_t*)(hb + (size_t)(rt >> 1) * DM) : zrow; },
        [=](int cidx) { return wb + (size_t)(n0 + cidx) * 1024; }, KOff64(), KOff64(),
        [=](int row, int col0, const f32x4 (&a)[4]) {
          float hv[8];
#pragma unroll
          for (int j = 0; j < 8; ++j) { const float gv = a[j >> 2][j & 3], uv = a[2 + (j >> 2)][j & 3]; hv[j] = silu_f(gv) * uv; }
          uint4 o; o.x = pack2(hv[0], hv[1]); o.y = pack2(hv[2], hv[3]); o.z = pack2(hv[4], hv[5]); o.w = pack2(hv[6], hv[7]);
          *(uint4*)&HB[(size_t)(m0 + row) * 512 + ((n0 + col0) >> 1)] = o;
        });
    }
    xcd_barrier(xbar);
    for (int L = vb; L < ntile; L += G) {
      const int mb = L >> 2, n0 = (L & 3) * 256, m0 = mb * 128, e = rowexp[mb];
      const bf16_t* wb = WD + (size_t)e * 1024 * 512;
      gemm_tile<4, true>(shm, 8,
        [=](int r) { return (const bf16_t*)(HB + (size_t)(m0 + r) * 512); },
        [=](int cidx) { return wb + (size_t)(n0 + cidx) * 512; }, KOff64(), KOff64(),
        [=](int row, int col0, const f32x4 (&a)[4]) {
          const int rt = rowtok[m0 + row];
          if (rt >= 0) {
            const float w = asgw[rt];
            f32x4 b[4];
#pragma unroll
            for (int n = 0; n < 4; ++n) b[n] = a[n] * w;
            st16bf(ybuf + (size_t)rt * 1024 + n0 + col0, b);
          }
        });
    }
    xcd_barrier(xbar);
  };

  {
    norm_phase(P, 0, P.in[6] + 0 * 1024, 0, 0, -1, 0, false, false, 0);
    xcd_barrier(xbar);
    bf16_t* zu = (bf16_t*)(R + R0_ZU); bf16_t* zvT = (bf16_t*)(R + R0_ZVT); bf16_t* pb = (bf16_t*)(R + R0_P);
    bf16_t* Wsc = (bf16_t*)(R + R0_WSC);
    const float* vg = P.in[17]; const float* w_s = P.in[18]; const float* b_s = P.in[19];
    const bf16_t* Wt = (const bf16_t*)(ws + W_CMIN);
    {
      auto epi_u = [=](int grow, int gcol0, const f32x4 (&a)[4]) {
        f32x4 bq[4];
#pragma unroll
        for (int n = 0; n < 4; ++n)
#pragma unroll
          for (int j = 0; j < 4; ++j) bq[n][j] = gelu_f(a[n][j]);
        st16bf(zu + (size_t)grow * 1024 + gcol0, bq);
      };
      auto epi_v = [=](int grow0, int gcol, f32x4 v) {
        uint2 o; o.x = pack2(gelu_f(v[0]), gelu_f(v[1])); o.y = pack2(gelu_f(v[2]), gelu_f(v[3]));
        *(uint2*)&zvT[((size_t)(grow0 >> 7) * 1024 + (gcol - 1024)) * 128 + (grow0 & 127)] = o;
      };
      const int nbig = 64 * 8;
      for (int L = vb; L < nbig; L += G) {
        const int m0 = (1 + L / 8) * 256, tn = L % 8, n0 = tn * 256;
        if (tn >= 4) {
          gemm_tile<8, false>(shm, 16, [=](int r) { return (const bf16_t*)(hb + (size_t)(m0 + r) * DM); },
            [=](int cidx) { return Wt + (size_t)(n0 + cidx) * 1024; }, KOff64(), KOff64(),
            [=](int row0, int col, f32x4 v) { epi_v(m0 + row0, n0 + col, v); });
        } else {
          gemm_tile<8, true>(shm, 16, [=](int r) { return (const bf16_t*)(hb + (size_t)(m0 + r) * DM); },
            [=](int cidx) { return Wt + (size_t)(n0 + cidx) * 1024; }, KOff64(), KOff64(),
            [=](int row, int col0, const f32x4 (&a)[4]) { epi_u(m0 + row, n0 + col0, a); });
        }
      }
      const int s = (vb - (nbig % G) + G) % G;
      if (s < 32) {
        const int m0 = (s / 8) * 64, tn = s % 8, n0 = tn * 256;
        if (tn >= 4) {
          gemm_tile<2, false>(shm, 16, [=](int r) { return (const bf16_t*)(hb + (size_t)(m0 + r) * DM); },
            [=](int cidx) { return Wt + (size_t)(n0 + cidx) * 1024; }, KOff64(), KOff64(),
            [=](int row0, int col, f32x4 v) { epi_v(m0 + row0, n0 + col, v); });
        } else {
          gemm_tile<2, true>(shm, 16, [=](int r) { return (const bf16_t*)(hb + (size_t)(m0 + r) * DM); },
            [=](int cidx) { return Wt + (size_t)(n0 + cidx) * 1024; }, KOff64(), KOff64(),
            [=](int row, int col0, const f32x4 (&a)[4]) { epi_u(m0 + row, n0 + col0, a); });
        }
      }
    }
    xcd_barrier(xbar);
    {
      float* s_part = smem;
      float* s_rv = smem + 512;
      for (int n = blockIdx.x; n < NCH; n += G) {
        const int sidx = tid & 127, qt = tid >> 7;
        float ss = 0.f;
        for (int col = qt * 256; col < qt * 256 + 256; ++col) { const float x = bf2f(zvT[((size_t)n * 1024 + col) * 128 + sidx]); ss += x * x; }
        s_part[qt * 128 + sidx] = ss;
        __syncthreads();
        if (tid < 128) s_rv[tid] = 1.f / sqrtf((s_part[tid] + s_part[128 + tid] + s_part[256 + tid] + s_part[384 + tid]) * (1.f / 1024.f) + EPSN);
        __syncthreads();
        for (int idx = tid; idx < 4 * 128 * 32; idx += NT) {
          const int s4 = (idx & 31) * 4, gt = idx >> 5;
          const float4 w4 = *(const float4*)&w_s[(size_t)gt * 128 + s4];
          uint2 o; o.x = pack2(w4.x * s_rv[s4], w4.y * s_rv[s4 + 1]); o.y = pack2(w4.z * s_rv[s4 + 2], w4.w * s_rv[s4 + 3]);
          *(uint2*)&Wsc[((size_t)n * 512 + gt) * 128 + s4] = o;
        }
        __syncthreads();
      }
    }
    xcd_barrier(xbar);
    for (int L = vb; L < NCH * 4; L += G) {
      const int n = L >> 2, g = L & 3;
      const bf16_t* a0 = Wsc + ((size_t)n * 512 + g * 128) * 128;
      const bf16_t* b0 = zvT + ((size_t)n * 1024 + g * 256) * 128;
      gemm_tile<4, true>(shm, 2, [=](int r) { return a0 + (size_t)r * 128; }, [=](int cidx) { return b0 + (size_t)cidx * 128; },
        KOff64(), KOff64(),
        [=](int row, int col0, const f32x4 (&a)[4]) {
          const int t = n * 128 + row, col = g * 256 + col0;
          const float bias = b_s[g * 128 + row];
          const uint4 u0 = *(const uint4*)&zu[(size_t)t * 1024 + col], u1 = *(const uint4*)&zu[(size_t)t * 1024 + col + 8];
          const unsigned uu[8] = {u0.x, u0.y, u0.z, u0.w, u1.x, u1.y, u1.z, u1.w};
          f32x4 o[4];
#pragma unroll
          for (int nn = 0; nn < 4; ++nn) {
            const float4 g4 = *(const float4*)&vg[col + nn * 4];
            o[nn][0] = lo2f(uu[nn * 2]) * (a[nn][0] * g4.x + bias);
            o[nn][1] = hi2f(uu[nn * 2]) * (a[nn][1] * g4.y + bias);
            o[nn][2] = lo2f(uu[nn * 2 + 1]) * (a[nn][2] * g4.z + bias);
            o[nn][3] = hi2f(uu[nn * 2 + 1]) * (a[nn][3] * g4.w + bias);
          }
          st16bf(pb + (size_t)t * 1024 + col, o);
        });
    }
    xcd_barrier(xbar);
    const bf16_t* Wo = (const bf16_t*)(ws + W_CMOUT);
    auto epi_out = [=](int grow, int gcol0, const f32x4 (&a)[4]) { resid_epi(0, grow, gcol0, a); };
    DENSE_PHASE(pb, 1024, Wo, 1024, 4, 16, true, epi_out);
    xcd_barrier(xbar);
  }
  moe_layer(0, 0);

  {
    norm_phase(P, 0, P.in[6] + 1 * 1024, 1, 0, 0, 0, false, false, 0);
    xcd_barrier(xbar);
    bf16_t* ZQK = (bf16_t*)(R + R1_ZQK); bf16_t* ZO = (bf16_t*)(R + R1_ZO); bf16_t* VT = (bf16_t*)(R + R1_VT);
    float* gpre = (float*)(R + R1_GPRE); bf16_t* Qn = (bf16_t*)(R + R1_QN); bf16_t* Kn = (bf16_t*)(R + R1_KN);
    bf16_t* AS = (bf16_t*)(R + R1_AS); bf16_t* KwT = (bf16_t*)(R + R1_KWT);
    float* bc = (float*)(R + R1_BC); float* li = (float*)(R + R1_LI); float* egch = (float*)(R + R1_GCH);
    float* nloc = (float*)(R + R1_NLOC); float* nin = (float*)(R + R1_NIN);
    float* Cloc = (float*)(R + R1_CLOC); bf16_t* CinT = (bf16_t*)(R + R1_CINT); float* hnum = (float*)(R + R1_CLOC);
    bf16_t* A2 = (bf16_t*)(R + R1_A2);
    const float* w_in = P.in[21]; const float* cw = P.in[22]; const float* cb = P.in[23];
    const float* gb = P.in[24]; const float* ng = P.in[25];
    const bf16_t* Wt = (const bf16_t*)(ws + W_MLIN);
    {
      auto epi_nat = [=](int grow, int gcol0, const f32x4 (&a)[4]) {
        if (gcol0 < 1024) st16bf(ZQK + (size_t)grow * 1024 + gcol0, a); else st16bf(ZO + (size_t)grow * 1024 + gcol0 - 2048, a);
      };
      auto epi_vt = [=](int grow0, int gcol, f32x4 v) {
        uint2 o; o.x = pack2(v[0], v[1]); o.y = pack2(v[2], v[3]);
        *(uint2*)&VT[((size_t)(grow0 >> 7) * 1024 + (gcol - 1024)) * 128 + (grow0 & 127)] = o;
      };
      const int nbig = 64 * 12;
      for (int L = vb; L < nbig; L += G) {
        const int m0 = (1 + L / 12) * 256, tn = L % 12, n0 = tn * 256;
        if (tn >= 4 && tn < 8) {
          gemm_tile<8, false>(shm, 16, [=](int r) { return (const bf16_t*)(hb + (size_t)(m0 + r) * DM); },
            [=](int cidx) { return Wt + (size_t)(n0 + cidx) * 1024; }, KOff64(), KOff64(),
            [=](int row0, int col, f32x4 v) { epi_vt(m0 + row0, n0 + col, v); });
        } else {
          gemm_tile<8, true>(shm, 16, [=](int r) { return (const bf16_t*)(hb + (size_t)(m0 + r) * DM); },
            [=](int cidx) { return Wt + (size_t)(n0 + cidx) * 1024; }, KOff64(), KOff64(),
            [=](int row, int col0, const f32x4 (&a)[4]) { epi_nat(m0 + row, n0 + col0, a); });
        }
      }
      const int s = (vb - (nbig % G) + G) % G;
      if (s < 48) {
        const int m0 = (s / 12) * 64, tn = s % 12, n0 = tn * 256;
        if (tn >= 4 && tn < 8) {
          gemm_tile<2, false>(shm, 16, [=](int r) { return (const bf16_t*)(hb + (size_t)(m0 + r) * DM); },
            [=](int cidx) { return Wt + (size_t)(n0 + cidx) * 1024; }, KOff64(), KOff64(),
            [=](int row0, int col, f32x4 v) { epi_vt(m0 + row0, n0 + col, v); });
        } else {
          gemm_tile<2, true>(shm, 16, [=](int r) { return (const bf16_t*)(hb + (size_t)(m0 + r) * DM); },
            [=](int cidx) { return Wt + (size_t)(n0 + cidx) * 1024; }, KOff64(), KOff64(),
            [=](int row, int col0, const f32x4 (&a)[4]) { epi_nat(m0 + row, n0 + col0, a); });
        }
      }
      const int lane = tid & 63;
      for (int t = blockIdx.x * (NT / 64) + (tid >> 6); t < T_ALL; t += G * (NT / 64)) {
        float a16[16];
#pragma unroll
        for (int j = 0; j < 16; ++j) a16[j] = 0.f;
        for (int k = lane; k < 1024; k += 64) {
          const float hv = bf2f(hb[(size_t)t * DM + k]);
#pragma unroll
          for (int q = 0; q < 4; ++q) {
            const float4 w4 = *(const float4*)&w_in[(size_t)k * 3088 + 3072 + q * 4];
            a16[q * 4 + 0] += hv * w4.x; a16[q * 4 + 1] += hv * w4.y; a16[q * 4 + 2] += hv * w4.z; a16[q * 4 + 3] += hv * w4.w;
          }
        }
#pragma unroll
        for (int j = 0; j < 16; ++j) a16[j] = wave_sum(a16[j]);
        if (lane == 0) {
#pragma unroll
          for (int j = 0; j < 16; ++j) gpre[(size_t)t * 16 + j] = a16[j];
        }
      }
    }
    xcd_barrier(xbar);
    {
      float* s_bc = smem;
      float* s_w  = smem + 1024;
      float* s_k  = smem + 2048;
      const int wv = tid >> 6, lane = tid & 63;
      for (int n = blockIdx.x; n < NCH; n += G) {
        {
          const int dh = wv, d = dh >> 2, hd = dh & 3;
          const int p0 = 2 * lane, p1 = p0 + 1;
          const int t0 = n * 128 + (d == 0 ? p0 : 127 - p0), t1 = n * 128 + (d == 0 ? p1 : 127 - p1);
          const float li0 = gpre[(size_t)t0 * 16 + d * 8 + hd] + gb[d * 8 + hd];
          const float li1 = gpre[(size_t)t1 * 16 + d * 8 + hd] + gb[d * 8 + hd];
          const float lf0 = logsig_f(gpre[(size_t)t0 * 16 + d * 8 + 4 + hd] + gb[d * 8 + 4 + hd]);
          const float lf1 = logsig_f(gpre[(size_t)t1 * 16 + d * 8 + 4 + hd] + gb[d * 8 + 4 + hd]);
          float run = lf0 + lf1;
#pragma unroll
          for (int o = 1; o < 64; o <<= 1) { const float y = __shfl_up(run, o); if (lane >= o) run += y; }
          const float b1 = run, b0 = run - lf1;
          const float g = __shfl(run, 63);
          bc[(size_t)dh * T_ALL + t0] = expf(b0); bc[(size_t)dh * T_ALL + t1] = expf(b1);
          li[(size_t)dh * T_ALL + t0] = expf(li0 - b0); li[(size_t)dh * T_ALL + t1] = expf(li1 - b1);
          s_bc[dh * 128 + (t0 & 127)] = b0; s_bc[dh * 128 + (t1 & 127)] = b1;
          s_w[dh * 128 + (t0 & 127)] = expf(g - b0 + li0); s_w[dh * 128 + (t1 & 127)] = expf(g - b1 + li1);
          if (lane == 0) egch[dh * NCH + n] = expf(g);
        }
        __syncthreads();
        const int lo = n < 2 ? 0 : T_CTX, hi = n < 2 ? T_CTX : T_ALL;
        for (int idx = tid; idx < 128 * 64; idx += NT) {
          const int tl = idx >> 6, c0 = (idx & 63) * 8, t = n * 128 + tl, hd = c0 >> 7;
          float q[8];
#pragma unroll
          for (int e = 0; e < 8; ++e) q[e] = cb[c0 + e];
#pragma unroll
          for (int j = 0; j < 4; ++j) {
            const int tt = t + j - 2;
            if (tt >= lo && tt < hi) {
              const uint4 z = *(const uint4*)&ZQK[(size_t)tt * 1024 + c0];
              const float4 w0 = *(const float4*)&cw[j * 1024 + c0], w1 = *(const float4*)&cw[j * 1024 + c0 + 4];
              q[0] += lo2f(z.x) * w0.x; q[1] += hi2f(z.x) * w0.y; q[2] += lo2f(z.y) * w0.z; q[3] += hi2f(z.y) * w0.w;
              q[4] += lo2f(z.z) * w1.x; q[5] += hi2f(z.z) * w1.y; q[6] += lo2f(z.w) * w1.z; q[7] += hi2f(z.w) * w1.w;
            }
          }
#pragma unroll
          for (int e = 0; e < 8; ++e) q[e] = silu_f(q[e]) * 0.08838834764831845f;
          uint4 o; o.x = pack2(q[0], q[1]); o.y = pack2(q[2], q[3]); o.z = pack2(q[4], q[5]); o.w = pack2(q[6], q[7]);
          *(uint4*)&Qn[(size_t)t * 512 + c0] = o;
#pragma unroll
          for (int d = 0; d < 2; ++d) {
            const int dh = d * 4 + hd;
            const float eb = expf(s_bc[dh * 128 + tl]);
            uint4 o2; o2.x = pack2(q[0] * eb, q[1] * eb); o2.y = pack2(q[2] * eb, q[3] * eb); o2.z = pack2(q[4] * eb, q[5] * eb); o2.w = pack2(q[6] * eb, q[7] * eb);
            *(uint4*)&AS[((size_t)dh * T_ALL + t) * 256 + 128 + (c0 & 127)] = o2;
          }
        }
        for (int hd = 0; hd < 4; ++hd) {
          for (int idx = tid; idx < 128 * 16; idx += NT) {
            const int tl = idx >> 4, k0 = (idx & 15) * 8, t = n * 128 + tl, c0 = 512 + hd * 128 + k0;
            float q[8];
#pragma unroll
            for (int e = 0; e < 8; ++e) q[e] = cb[c0 + e];
#pragma unroll
            for (int j = 0; j < 4; ++j) {
              const int tt = t + j - 2;
              if (tt >= lo && tt < hi) {
                const uint4 z = *(const uint4*)&ZQK[(size_t)tt * 1024 + c0];
                const float4 w0 = *(const float4*)&cw[j * 1024 + c0], w1 = *(const float4*)&cw[j * 1024 + c0 + 4];
                q[0] += lo2f(z.x) * w0.x; q[1] += hi2f(z.x) * w0.y; q[2] += lo2f(z.y) * w0.z; q[3] += hi2f(z.y) * w0.w;
                q[4] += lo2f(z.z) * w1.x; q[5] += hi2f(z.z) * w1.y; q[6] += lo2f(z.w) * w1.z; q[7] += hi2f(z.w) * w1.w;
              }
            }
#pragma unroll
            for (int e = 0; e < 8; ++e) { q[e] = silu_f(q[e]); s_k[tl * 129 + k0 + e] = q[e]; }
            uint4 o; o.x = pack2(q[0], q[1]); o.y = pack2(q[2], q[3]); o.z = pack2(q[4], q[5]); o.w = pack2(q[6], q[7]);
            *(uint4*)&Kn[(size_t)t * 512 + hd * 128 + k0] = o;
          }
          __syncthreads();
          for (int idx = tid; idx < 2 * 128 * 16; idx += NT) {
            const int d = idx >> 11, rem = idx & 2047, kk = rem >> 4, s0 = (rem & 15) * 8, dh = d * 4 + hd;
            float v8[8];
#pragma unroll
            for (int e = 0; e < 8; ++e) v8[e] = s_w[dh * 128 + s0 + e] * s_k[(s0 + e) * 129 + kk];
            uint4 o; o.x = pack2(v8[0], v8[1]); o.y = pack2(v8[2], v8[3]); o.z = pack2(v8[4], v8[5]); o.w = pack2(v8[6], v8[7]);
            *(uint4*)&KwT[((size_t)dh * T_ALL + n * 128 + kk) * 128 + s0] = o;
          }
          if (tid < 256) {
            const int d = tid >> 7, kk = tid & 127, dh = d * 4 + hd;
            float a = 0.f;
            for (int s2 = 0; s2 < 128; ++s2) a += s_w[dh * 128 + s2] * s_k[s2 * 129 + kk];
            nloc[(dh * NCH + n) * 128 + kk] = a;
          }
          __syncthreads();
        }
      }
    }
    xcd_barrier(xbar);
    for (int L = vb; L < 1040 + 520; L += G) {
      if (L < 1040) {
        const int dh = L / NCH, n = L - dh * NCH, hd = dh & 3;
        const bf16_t* a0 = KwT + ((size_t)dh * T_ALL + n * 128) * 128;
        const bf16_t* b0 = VT + ((size_t)n * 1024 + hd * 256) * 128;
        float* co = Cloc + (size_t)(dh * NCH + n) * 32768;
        gemm_tile<4, false>(shm, 2, [=](int r) { return a0 + (size_t)r * 128; }, [=](int cidx) { return b0 + (size_t)cidx * 128; },
          KOff64(), KOff64(),
          [=](int row0, int col, f32x4 v) { *(float4*)&co[(size_t)col * 128 + row0] = make_float4(v[0], v[1], v[2], v[3]); });
      } else {
        const int q = L - 1040, hd = q / NCH, n = q - hd * NCH;
        const bf16_t* a0 = Qn + (size_t)(n * 128) * 512 + hd * 128;
        const bf16_t* b0 = Kn + (size_t)(n * 128) * 512 + hd * 128;
        gemm_tile<4, true>(shm, 2, [=](int r) { return a0 + (size_t)r * 512; },
          [=](int cidx) { return cidx < 128 ? b0 + (size_t)cidx * 512 : zrow; }, KOff64(), KOff64(),
          [=](int row, int col0, const f32x4 (&a)[4]) {
            if (col0 < 128) {
              const int tt = n * 128 + row;
#pragma unroll
              for (int d = 0; d < 2; ++d) {
                const int dh = d * 4 + hd;
                const float bt = bc[(size_t)dh * T_ALL + tt];
                const float* cf = li + (size_t)dh * T_ALL + n * 128 + col0;
                f32x4 o[4];
#pragma unroll
                for (int nn = 0; nn < 4; ++nn) {
                  const float4 c4 = *(const float4*)(cf + nn * 4);
                  const float cv[4] = {c4.x, c4.y, c4.z, c4.w};
#pragma unroll
                  for (int j = 0; j < 4; ++j) {
                    const int sc = col0 + nn * 4 + j;
                    const bool ok = (d == 0) ? (sc <= row) : (sc >= row);
                    o[nn][j] = ok ? a[nn][j] * bt * cv[j] : 0.f;
                  }
                }
                st16bf(AS + ((size_t)dh * T_ALL + tt) * 256 + col0, o);
              }
            }
          });
      }
    }
    xcd_barrier(xbar);
    for (int idx = gtid; idx < 8 * (32768 + 128); idx += gstride) {
      const int dh = idx / 32896, e = idx - dh * 32896, d = dh >> 2;
      float st = 0.f;
      if (e < 32768) {
        for (int ib = 0; ib < NCH; ib += 10) {
          float xv[10], gv[10];
#pragma unroll
          for (int u = 0; u < 10; ++u) { const int n = scan_order(d, ib + u); xv[u] = Cloc[(size_t)(dh * NCH + n) * 32768 + e]; gv[u] = egch[dh * NCH + n]; }
#pragma unroll
          for (int u = 0; u < 10; ++u) { const int n = scan_order(d, ib + u); CinT[(size_t)(dh * NCH + n) * 32768 + e] = f2bf(st); st = gv[u] * st + xv[u]; }
        }
      } else {
        const int kk = e - 32768;
        for (int i = 0; i < NCH; ++i) {
          const int n = scan_order(d, i);
          nin[(dh * NCH + n) * 128 + kk] = st;
          st = egch[dh * NCH + n] * st + nloc[(dh * NCH + n) * 128 + kk];
        }
      }
    }
    xcd_barrier(xbar);
    for (int L = vb; L < 1040; L += G) {
      const int dh = L / NCH, n = L - dh * NCH, hd = dh & 3;
      const bf16_t* a0 = AS + ((size_t)dh * T_ALL + n * 128) * 256;
      const bf16_t* b0 = VT + ((size_t)n * 1024 + hd * 256) * 128;
      const int delta = (int)((CinT + (size_t)(dh * NCH + n) * 32768) - b0);
      float* ho = hnum + ((size_t)dh * T_ALL + n * 128) * 256;
      gemm_tile<4, true>(shm, 4, [=](int r) { return a0 + (size_t)r * 256; }, [=](int cidx) { return b0 + (size_t)cidx * 128; },
        KOff64(), [=](int kt) { return kt < 2 ? kt * 64 : delta + (kt - 2) * 64; },
        [=](int row, int col0, const f32x4 (&a)[4]) {
          float* p = ho + (size_t)row * 256 + col0;
#pragma unroll
          for (int nn = 0; nn < 4; ++nn) *(float4*)(p + nn * 4) = make_float4(a[nn][0], a[nn][1], a[nn][2], a[nn][3]);
        });
    }
    xcd_barrier(xbar);
    {
      const int lane = tid & 63;
      for (int it = blockIdx.x * (NT / 64) + (tid >> 6); it < T_ALL * 4; it += G * (NT / 64)) {
        const int tt = it >> 2, hd = it & 3, n = tt >> 7;
        float hs[4] = {0.f, 0.f, 0.f, 0.f};
#pragma unroll
        for (int d = 0; d < 2; ++d) {
          const int dh = d * 4 + hd;
          const size_t m = (size_t)dh * T_ALL + tt;
          const uint2 av = *(const uint2*)&AS[m * 256 + lane * 4];
          float part;
          if (lane < 32) part = lo2f(av.x) + hi2f(av.x) + lo2f(av.y) + hi2f(av.y);
          else {
            const float4 nv = *(const float4*)&nin[(dh * NCH + n) * 128 + (lane - 32) * 4];
            part = lo2f(av.x) * nv.x + hi2f(av.x) * nv.y + lo2f(av.y) * nv.z + hi2f(av.y) * nv.w;
          }
          const float den = wave_sum(part);
          const float dn = 1.f / fmaxf(fabsf(den), 1.f);
          const float4 x = *(const float4*)&hnum[m * 256 + lane * 4];
          hs[0] += x.x * dn; hs[1] += x.y * dn; hs[2] += x.z * dn; hs[3] += x.w * dn;
        }
        float ss = hs[0] * hs[0] + hs[1] * hs[1] + hs[2] * hs[2] + hs[3] * hs[3];
        ss = wave_sum(ss);
        const float r = 1.f / sqrtf(ss * (1.f / 256.f) + EPSN);
        const int col = hd * 256 + lane * 4;
        const uint2 ov = *(const uint2*)&ZO[(size_t)tt * 1024 + col];
        const float4 g4 = *(const float4*)&ng[col];
        uint2 o;
        o.x = pack2(hs[0] * r * g4.x * sigmoid_f(lo2f(ov.x)), hs[1] * r * g4.y * sigmoid_f(hi2f(ov.x)));
        o.y = pack2(hs[2] * r * g4.z * sigmoid_f(lo2f(ov.y)), hs[3] * r * g4.w * sigmoid_f(hi2f(ov.y)));
        *(uint2*)&A2[(size_t)tt * 1024 + col] = o;
      }
    }
    xcd_barrier(xbar);
    const bf16_t* Wo = (const bf16_t*)(ws + W_MLOUT);
    auto epi_out = [=](int grow, int gcol0, const f32x4 (&a)[4]) { resid_epi(1, grow, gcol0, a); };
    DENSE_PHASE(A2, 1024, Wo, 1024, 4, 16, true, epi_out);
    xcd_barrier(xbar);
  }
  moe_layer(1, 0);

  {
    norm_phase(P, 0, P.in[6] + 2 * 1024, 2, 0, 1, 0, false, false, 0);
    xcd_barrier(xbar);
    bf16_t* Zg = (bf16_t*)(R + R2_ZG); bf16_t* Zx = (bf16_t*)(R + R2_ZX); bf16_t* xc = (bf16_t*)(R + R2_XC);
    bf16_t* LA = (bf16_t*)(R + R2_LA); bf16_t* U = (bf16_t*)(R + R2_U);
    float* cA = (float*)(R + R2_CA); float* cH = (float*)(R + R2_CH);
    float* cin = (float*)(R + R2_CIN); bf16_t* A3 = (bf16_t*)(R + R2_ZX);
    const float* cw = P.in[28]; const float* cb = P.in[29];
    const float* b_a = P.in[31]; const float* b_x = P.in[33];
    const float* SP = (const float*)(ws + W_SP);
    const bf16_t* Wt = (const bf16_t*)(ws + W_LRUIN);
    auto epi_in = [=](int grow, int gcol0, const f32x4 (&a)[4]) {
      if (gcol0 < 1280) {
        f32x4 bq[4];
#pragma unroll
        for (int n = 0; n < 4; ++n)
#pragma unroll
          for (int j = 0; j < 4; ++j) bq[n][j] = gelu_f(a[n][j]);
        st16bf(Zg + (size_t)grow * 1280 + gcol0, bq);
      } else st16bf(Zx + (size_t)grow * 1280 + gcol0 - 1280, a);
    };
    DENSE_PHASE(hb, 1024, Wt, 1024, 10, 16, true, epi_in);
    xcd_barrier(xbar);
    for (int idx = gtid; idx < T_ALL * 160; idx += gstride) {
      const int t = idx / 160, c0 = (idx - t * 160) * 8;
      const int lo = t < T_CTX ? 0 : T_CTX, hi = t < T_CTX ? T_CTX : T_ALL;
      float q[8];
#pragma unroll
      for (int e = 0; e < 8; ++e) q[e] = cb[c0 + e];
#pragma unroll
      for (int j = 0; j < 4; ++j) {
        const int tt = t + j - 2;
        if (tt >= lo && tt < hi) {
          const uint4 z = *(const uint4*)&Zx[(size_t)tt * 1280 + c0];
          const float4 w0 = *(const float4*)&cw[j * 1280 + c0], w1 = *(const float4*)&cw[j * 1280 + c0 + 4];
          q[0] += lo2f(z.x) * w0.x; q[1] += hi2f(z.x) * w0.y; q[2] += lo2f(z.y) * w0.z; q[3] += hi2f(z.y) * w0.w;
          q[4] += lo2f(z.z) * w1.x; q[5] += hi2f(z.z) * w1.y; q[6] += lo2f(z.w) * w1.z; q[7] += hi2f(z.w) * w1.w;
        }
      }
      uint4 o; o.x = pack2(q[0], q[1]); o.y = pack2(q[2], q[3]); o.z = pack2(q[4], q[5]); o.w = pack2(q[6], q[7]);
      *(uint4*)&xc[(size_t)t * 1280 + c0] = o;
    }
    xcd_barrier(xbar);
    {
      const bf16_t* WLG = (const bf16_t*)(ws + W_LRUG);
      for (int L = vb; L < 65 * 20; L += G) {
        const int m0 = (L / 20) * 256, q = L % 20, nb = q >> 1, d = q & 1;
        const bf16_t* a0 = xc + (size_t)m0 * 1280 + nb * 128;
        const bf16_t* b0 = WLG + (size_t)q * 256 * 128;
        gemm_tile<8, true>(shm, 2, [=](int r) { return a0 + (size_t)r * 1280; }, [=](int cidx) { return b0 + (size_t)cidx * 128; },
          KOff64(), KOff64(),
          [=](int row, int col0, const f32x4 (&a)[4]) {
            const int t = m0 + row, c = nb * 128 + (col0 >> 1);
            const uint4 xv = *(const uint4*)&xc[(size_t)t * 1280 + c];
            const unsigned xx[4] = {xv.x, xv.y, xv.z, xv.w};
            float la8[8], u8[8];
#pragma unroll
            for (int e = 0; e < 8; ++e) {
              const float ra = a[e >> 2][e & 3] + b_a[d * 1280 + c + e];
              const float rx = a[2 + (e >> 2)][e & 3] + b_x[d * 1280 + c + e];
              const float la = -8.f * sigmoid_f(ra) * SP[d * 1280 + c + e];
              const float xe = (e & 1) ? hi2f(xx[e >> 1]) : lo2f(xx[e >> 1]);
              la8[e] = la;
              u8[e] = sqrtf(-expm1f(2.f * la)) * (sigmoid_f(rx) * xe);
            }
            uint4 o1, o2;
            o1.x = pack2(la8[0], la8[1]); o1.y = pack2(la8[2], la8[3]); o1.z = pack2(la8[4], la8[5]); o1.w = pack2(la8[6], la8[7]);
            o2.x = pack2(u8[0], u8[1]); o2.y = pack2(u8[2], u8[3]); o2.z = pack2(u8[4], u8[5]); o2.w = pack2(u8[6], u8[7]);
            *(uint4*)&LA[((size_t)d * T_ALL + t) * 1280 + c] = o1;
            *(uint4*)&U[((size_t)d * T_ALL + t) * 1280 + c] = o2;
          });
      }
    }
    xcd_barrier(xbar);
    for (int idx = gtid; idx < 2 * NCH * 1280; idx += gstride) {
      const int c = idx % 1280, dn = idx / 1280, n = dn % NCH, d = dn / NCH;
      float h = 0.f, sl = 0.f;
      for (int sb = 0; sb < 128; sb += 16) {
        float lv[16], uv[16];
#pragma unroll
        for (int e = 0; e < 16; ++e) {
          const int tt = n * 128 + (d == 0 ? sb + e : 127 - sb - e);
          lv[e] = bf2f(LA[((size_t)d * T_ALL + tt) * 1280 + c]); uv[e] = bf2f(U[((size_t)d * T_ALL + tt) * 1280 + c]);
        }
#pragma unroll
        for (int e = 0; e < 16; ++e) { h = __expf(lv[e]) * h + uv[e]; sl += lv[e]; }
      }
      cA[idx] = __expf(sl);
      cH[idx] = h;
    }
    xcd_barrier(xbar);
    for (int idx = gtid; idx < 2 * 1280; idx += gstride) {
      const int d = idx / 1280, c = idx - d * 1280;
      float st = 0.f;
      for (int i = 0; i < NCH; ++i) {
        const int n = scan_order(d, i);
        const int q = (d * NCH + n) * 1280 + c;
        cin[q] = st;
        st = cA[q] * st + cH[q];
      }
    }
    xcd_barrier(xbar);
    for (int idx = gtid; idx < 128 * 1280; idx += gstride) {
      const int c = idx % 1280, n = 2 + idx / 1280;
      float h = cin[(0 * NCH + n) * 1280 + c];
      for (int sb = 0; sb < 128; sb += 16) {
        float lv[16], uv[16];
#pragma unroll
        for (int e = 0; e < 16; ++e) { const size_t o = ((size_t)(n * 128 + sb + e)) * 1280 + c; lv[e] = bf2f(LA[o]); uv[e] = bf2f(U[o]); }
#pragma unroll
        for (int e = 0; e < 16; ++e) { h = __expf(lv[e]) * h + uv[e]; A3[((size_t)(n * 128 + sb + e)) * 1280 + c] = f2bf(h); }
      }
      h = cin[(1 * NCH + n) * 1280 + c];
      for (int sb = 0; sb < 128; sb += 16) {
        float lv[16], uv[16], gv[16], h0[16];
#pragma unroll
        for (int e = 0; e < 16; ++e) {
          const size_t o = ((size_t)(n * 128 + 127 - sb - e)) * 1280 + c;
          lv[e] = bf2f(LA[(size_t)T_ALL * 1280 + o]); uv[e] = bf2f(U[(size_t)T_ALL * 1280 + o]); gv[e] = bf2f(Zg[o]); h0[e] = bf2f(A3[o]);
        }
#pragma unroll
        for (int e = 0; e < 16; ++e) {
          h = __expf(lv[e]) * h + uv[e];
          A3[((size_t)(n * 128 + 127 - sb - e)) * 1280 + c] = f2bf(gv[e] * (h0[e] + h));
        }
      }
    }
    xcd_barrier(xbar);
    const bf16_t* Wo = (const bf16_t*)(ws + W_LRUOUT);
    auto epi_out = [=](int grow, int gcol0, const f32x4 (&a)[4]) { resid_epi(2, grow, gcol0, a); };
    DENSE_PHASE(A3, 1280, Wo, 1280, 4, 20, false, epi_out);
    xcd_barrier(xbar);
  }
  moe_layer(2, T_CTX);

  {
    norm_phase(P, T_CTX, P.in[6] + 3 * 1024, 3, 0, 2, T_CTX, false, false, 0);
    xcd_barrier(xbar);
    bf16_t* YT = (bf16_t*)(R + R3_YT); bf16_t* GT = (bf16_t*)(R + R3_GT); bf16_t* Ff = (bf16_t*)(R + R3_FF);
    const bf16_t* WP = (const bf16_t*)(ws + W_FNP);
    for (int L = vb; L < 64 * 8; L += G) {
      const int tm = L >> 3, n0 = (L & 7) * 256;
      gemm_tile<8, false>(shm, 16,
        [=](int r) { return (const bf16_t*)(hb + (size_t)(T_CTX + 128 * (r & 127) + 2 * tm + (r >> 7)) * DM); },
        [=](int cidx) { return WP + (size_t)(n0 + cidx) * 1024; }, KOff64(), KOff64(),
        [=](int row0, int col, f32x4 v) {
          const int b = 2 * tm + (row0 >> 7), a0 = row0 & 127;
          uint2 o; o.x = pack2(v[0], v[1]); o.y = pack2(v[2], v[3]);
          *(uint2*)&YT[((size_t)b * 2048 + n0 + col) * 128 + a0] = o;
        });
    }
    xcd_barrier(xbar);
    {
      const bf16_t* DA = (const bf16_t*)(ws + W_DA);
      for (int colc = vb; colc < 1024; colc += G) {
        gemm_tile<4, false>(shm, 4,
          [=](int r) { return (const bf16_t*)(YT + ((size_t)r * 2048 + colc) * 128); },
          [=](int cidx) { return DA + (size_t)cidx * 256; },
          [=](int kt) { return kt < 2 ? kt * 64 : 1024 * 128 + (kt - 2) * 64; }, KOff64(),
          [=](int row0, int col, f32x4 v) {
            const int ri = col >> 7, c2 = col & 127;
            uint2 o; o.x = pack2(v[0], v[1]); o.y = pack2(v[2], v[3]);
            *(uint2*)&GT[(((size_t)c2 * 1024 + colc) * 2 + ri) * 128 + row0] = o;
          });
      }
    }
    xcd_barrier(xbar);
    {
      const bf16_t* TW = (const bf16_t*)(ws + W_TW);
      for (int L = vb; L < 128 * 4; L += G) {
        const int c2 = L >> 2, n0 = (L & 3) * 256;
        gemm_tile<4, true>(shm, 4,
          [=](int r) { return TW + ((size_t)c2 * 128 + r) * 256; },
          [=](int cidx) { return (const bf16_t*)(GT + ((size_t)c2 * 1024 + n0 + cidx) * 256); }, KOff64(), KOff64(),
          [=](int row, int col0, const f32x4 (&a)[4]) {
            f32x4 b[4];
#pragma unroll
            for (int n = 0; n < 4; ++n) b[n] = a[n] * (1.f / 2048.f);
            st16bf(Ff + (size_t)(c2 + 128 * row) * 1024 + n0 + col0, b);
          });
      }
    }
    xcd_barrier(xbar);
    const bf16_t* Wo = (const bf16_t*)(ws + W_FNOUT);
    const bf16_t* FfA = Ff - (size_t)T_CTX * 1024;
    auto epi_out = [=](int grow, int gcol0, const f32x4 (&a)[4]) { resid_epi(3, grow, gcol0, a); };
    DENSE_PHASE(FfA, 1024, Wo, 1024, 4, 16, false, epi_out);
    xcd_barrier(xbar);
  }
  moe_layer(3, T_CTX);

  norm_phase(P, T_CTX, P.in[8], 0, -1, 3, T_CTX, true, false, 0);
}

extern "C" void kernel_launch(void* const* d_in, const int* in_sizes, int n_in, void* d_out, int out_size,
                              void* d_ws, size_t ws_size, hipStream_t stream) {
  static int grid_blocks = 0;
  if (!grid_blocks) {
    int dev = 0, cus = 0, per_cu = 0;
    (void)hipGetDevice(&dev);
    (void)hipDeviceGetAttribute(&cus, hipDeviceAttributeMultiprocessorCount, dev);
    (void)hipOccupancyMaxActiveBlocksPerMultiprocessor(&per_cu, mega, NT, 0);
    if (per_cu < 1) fprintf(stderr, "kernel_launch: occupancy query says %d blocks/CU\n", per_cu);
    grid_blocks = cus;
    if (ws_size < WS_NEED) fprintf(stderr, "kernel_launch: workspace too small: %zu < %zu\n", ws_size, (size_t)WS_NEED);
  }
  if (n_in != 38 || ws_size < WS_NEED) return;
  Params p{};
  for (int i = 0; i < 38; ++i) p.in[i] = (const float*)d_in[i];
  p.out = (float*)d_out;
  p.ws = (unsigned char*)d_ws;
  (void)hipMemsetAsync((char*)d_ws + WS_BAR, 0, 16384, stream);
  void* args[] = {&p};
  hipError_t e = hipLaunchCooperativeKernel((void*)mega, dim3(grid_blocks), dim3(NT), args, 0, stream);
  if (e != hipSuccess) fprintf(stderr, "cooperative launch failed: %s (grid %d)\n", hipGetErrorString(e), grid_blocks);
}
```

```cpp
#include <hip/hip_runtime.h>
#include <hip/hip_cooperative_groups.h>
#include <cstdio>
namespace cg = cooperative_groups;

#define T_ALL 16640
#define T_LAT 16384
#define T_CTX 256
#define DM 1024
#define NCH 130
#define EPSN 1e-6f
#define NT 512

typedef unsigned short bf16_t;
using bf16x8 = __attribute__((ext_vector_type(8))) short;
using f32x4 = __attribute__((ext_vector_type(4))) float;

__device__ __forceinline__ float bf2f(bf16_t v) { return __uint_as_float(((unsigned)v) << 16); }
__device__ __forceinline__ bf16_t f2bf(float f) { unsigned u = __float_as_uint(f); u += 0x7fffu + ((u >> 16) & 1u); return (bf16_t)(u >> 16); }
__device__ __forceinline__ unsigned pack2(float a, float b) { return (unsigned)f2bf(a) | (((unsigned)f2bf(b)) << 16); }
__device__ __forceinline__ float lo2f(unsigned u) { return __uint_as_float(u << 16); }
__device__ __forceinline__ float hi2f(unsigned u) { return __uint_as_float(u & 0xffff0000u); }

constexpr size_t AL(size_t x) { return (x + 255) & ~(size_t)255; }
constexpr size_t WS_MOD    = 0;
constexpr size_t WS_MODP   = AL(WS_MOD + 4 * 2 * 6144 * 4);
constexpr size_t WS_CNT    = AL(WS_MODP + 16 * 4 * 2 * 6144 * 4);
constexpr size_t WS_ZROW   = AL(WS_CNT + 1024);
constexpr size_t WS_BAR    = AL(WS_ZROW + 8192);
constexpr size_t WS_TOK    = AL(WS_BAR + 16384);
constexpr size_t WS_H      = AL(WS_TOK + (size_t)T_ALL * DM * 4);
constexpr size_t WS_HLO    = AL(WS_H + (size_t)T_ALL * DM * 2);
constexpr size_t WS_ASGW   = AL(WS_HLO + (size_t)T_ALL * DM * 2);
constexpr size_t WS_LIST   = AL(WS_ASGW + 33280 * 4);
constexpr size_t WS_ROWTOK = AL(WS_LIST + (size_t)32 * 33280 * 4);
constexpr size_t WS_ROWEXP = AL(WS_ROWTOK + 37376 * 4);
constexpr size_t W_CMIN   = AL(WS_ROWEXP + 292 * 4);
constexpr size_t W_CMOUT  = AL(W_CMIN + (size_t)2048 * 1024 * 2);
constexpr size_t W_MLIN   = AL(W_CMOUT + (size_t)1024 * 1024 * 2);
constexpr size_t W_MLOUT  = AL(W_MLIN + (size_t)3072 * 1024 * 2);
constexpr size_t W_LRUIN  = AL(W_MLOUT + (size_t)1024 * 1024 * 2);
constexpr size_t W_LRUOUT = AL(W_LRUIN + (size_t)2560 * 1024 * 2);
constexpr size_t W_FNIN   = AL(W_LRUOUT + (size_t)1024 * 1280 * 2);
constexpr size_t W_FNP    = AL(W_FNIN + (size_t)1024 * 1024 * 2);
constexpr size_t W_FNOUT  = AL(W_FNP + (size_t)2048 * 1024 * 2);
constexpr size_t W_DC     = AL(W_FNOUT + (size_t)1024 * 1024 * 2);
constexpr size_t W_DA     = AL(W_DC + 512 * 256 * 2);
constexpr size_t W_TW     = AL(W_DA + 256 * 256 * 2);
constexpr size_t W_LRUG   = AL(W_TW + (size_t)128 * 128 * 256 * 2);
constexpr size_t W_SP     = AL(W_LRUG + (size_t)20 * 256 * 128 * 2);
constexpr size_t W_RT     = AL(W_SP + 2 * 1280 * 4);
constexpr size_t W_EGU    = AL(W_RT + (size_t)4 * 64 * 3072 * 2);
constexpr size_t W_ED     = AL(W_EGU + (size_t)128 * 1024 * 1024 * 2);
constexpr size_t WS_R     = AL(W_ED + (size_t)128 * 1024 * 512 * 2);
constexpr size_t R_YBUF = 0;
constexpr size_t R_HB   = AL(R_YBUF + (size_t)33280 * 1024 * 2);
constexpr size_t R_MOE_END = AL(R_HB + (size_t)37376 * 512 * 2);
constexpr size_t R0_ZU  = 0;
constexpr size_t R0_ZVT = AL(R0_ZU + (size_t)T_ALL * 1024 * 2);
constexpr size_t R0_P   = AL(R0_ZVT + (size_t)T_ALL * 1024 * 2);
constexpr size_t R0_WSC = AL(R0_P + (size_t)T_ALL * 1024 * 2);
constexpr size_t R0_END = AL(R0_WSC + (size_t)NCH * 4 * 128 * 128 * 2);
constexpr size_t R1_ZQK  = 0;
constexpr size_t R1_ZO   = AL(R1_ZQK + (size_t)T_ALL * 1024 * 2);
constexpr size_t R1_VT   = AL(R1_ZO + (size_t)T_ALL * 1024 * 2);
constexpr size_t R1_GPRE = AL(R1_VT + (size_t)T_ALL * 1024 * 2);
constexpr size_t R1_QN   = AL(R1_GPRE + (size_t)T_ALL * 16 * 4);
constexpr size_t R1_KN   = AL(R1_QN + (size_t)T_ALL * 512 * 2);
constexpr size_t R1_AS   = AL(R1_KN + (size_t)T_ALL * 512 * 2);
constexpr size_t R1_KWT  = AL(R1_AS + (size_t)8 * T_ALL * 256 * 2);
constexpr size_t R1_BC   = AL(R1_KWT + (size_t)8 * T_ALL * 128 * 2);
constexpr size_t R1_LI   = AL(R1_BC + (size_t)8 * T_ALL * 4);
constexpr size_t R1_GCH  = AL(R1_LI + (size_t)8 * T_ALL * 4);
constexpr size_t R1_NLOC = AL(R1_GCH + 8 * NCH * 4);
constexpr size_t R1_NIN  = AL(R1_NLOC + 8 * NCH * 128 * 4);
constexpr size_t R1_CLOC = AL(R1_NIN + 8 * NCH * 128 * 4);
constexpr size_t R1_CINT = AL(R1_CLOC + (size_t)8 * T_ALL * 256 * 4);
constexpr size_t R1_HDEN = AL(R1_CINT + (size_t)8 * T_ALL * 256 * 2);
constexpr size_t R1_A2   = AL(R1_HDEN + 256);
constexpr size_t R1_END  = AL(R1_A2 + (size_t)T_ALL * 1024 * 2);
constexpr size_t R2_ZG  = 0;
constexpr size_t R2_ZX  = AL(R2_ZG + (size_t)T_ALL * 1280 * 2);
constexpr size_t R2_XC  = AL(R2_ZX + (size_t)T_ALL * 1280 * 2);
constexpr size_t R2_LA  = AL(R2_XC + (size_t)T_ALL * 1280 * 2);
constexpr size_t R2_U   = AL(R2_LA + (size_t)2 * T_ALL * 1280 * 2);
constexpr size_t R2_CA  = AL(R2_U + (size_t)2 * T_ALL * 1280 * 2);
constexpr size_t R2_CH  = AL(R2_CA + 2 * NCH * 1280 * 4);
constexpr size_t R2_CIN = AL(R2_CH + 2 * NCH * 1280 * 4);
constexpr size_t R2_END = AL(R2_CIN + 2 * NCH * 1280 * 4);
constexpr size_t R3_YT = 0;
constexpr size_t R3_GT = AL(R3_YT + (size_t)128 * 2048 * 128 * 2);
constexpr size_t R3_FF = AL(R3_GT + (size_t)128 * 2048 * 128 * 2);
constexpr size_t R3_END = AL(R3_FF + (size_t)T_LAT * 1024 * 2);
constexpr size_t cmax(size_t a, size_t b) { return a > b ? a : b; }
constexpr size_t R_SIZE = cmax(cmax(R_MOE_END, R0_END), cmax(cmax(R1_END, R2_END), R3_END));
constexpr size_t WS_NEED = WS_R + R_SIZE;

struct Params { const float* in[38]; float* out; unsigned char* ws; };

__device__ __forceinline__ float sigmoid_f(float x) { return 1.f / (1.f + expf(-x)); }
__device__ __forceinline__ float silu_f(float x) { return x / (1.f + expf(-x)); }
__device__ __forceinline__ float gelu_f(float x) {
  return 0.5f * x * (1.f + tanhf(0.7978845608028654f * (x + 0.044715f * x * x * x)));
}
__device__ __forceinline__ float logsig_f(float x) { return fminf(x, 0.f) - log1pf(expf(-fabsf(x))); }
__device__ __forceinline__ float wave_sum(float v) {
#pragma unroll
  for (int o = 32; o >= 1; o >>= 1) v += __shfl_xor(v, o);
  return v;
}
__device__ __forceinline__ int scan_order(int d, int i) { return d == 0 ? i : (i == 0 ? 1 : (i == 1 ? 0 : 131 - i)); }
__device__ __forceinline__ void st16bf(bf16_t* p, const f32x4 (&a)[4]) {
  uint4 o0, o1;
  o0.x = pack2(a[0][0], a[0][1]); o0.y = pack2(a[0][2], a[0][3]); o0.z = pack2(a[1][0], a[1][1]); o0.w = pack2(a[1][2], a[1][3]);
  o1.x = pack2(a[2][0], a[2][1]); o1.y = pack2(a[2][2], a[2][3]); o1.z = pack2(a[3][0], a[3][1]); o1.w = pack2(a[3][2], a[3][3]);
  *(uint4*)p = o0; *(uint4*)(p + 8) = o1;
}

__device__ __forceinline__ int lds_byte(int r, int c) {
  const int st = (r >> 4) * 2 + (c >> 5), ob = (r & 15) * 64 + (c & 31) * 2;
  return st * 1024 + (ob ^ (((ob >> 9) & 1) << 5));
}
__device__ __forceinline__ void stage_rc(int b, int& R, int& C) {
  const int st = b >> 10, sb = b & 1023, swz = sb ^ (((sb >> 9) & 1) << 5);
  R = (st >> 1) * 16 + (swz >> 6);
  C = (st & 1) * 32 + ((swz & 63) >> 1);
}
__device__ __forceinline__ int perm_col(int p) {
  const int q = p & 63, n = q >> 4, i = q & 15;
  return (p & ~63) + (i >> 2) * 16 + n * 4 + (i & 3);
}
struct KOff64 { __device__ __forceinline__ int operator()(int kt) const { return kt * 64; } };
#define GEMM_LDS_BYTES 131072

template <int MI, bool SWAP, class RA, class RB, class KA, class KB, class EP>
__device__ __forceinline__ void gemm_tile(char* shm, int nk, RA rowA, RB rowB, KA koffA, KB koffB, EP epi) {
  constexpr int BM = 32 * MI, GLA = MI / 2, GLB = 4;
  constexpr int TILE_A = BM * 128, TILE_B = 256 * 128, STG = TILE_A + TILE_B;
  static_assert(2 * STG <= GEMM_LDS_BYTES, "LDS");
  int tid_ = threadIdx.x;
  asm volatile("" : "+v"(tid_));
  const int tid = tid_, wid = tid >> 6, lane = tid & 63, wr = wid >> 2, wc = wid & 3, fr = lane & 15, fq = lane >> 4;
  const bf16_t* pa[GLA];
  const bf16_t* pb[GLB];
#pragma unroll
  for (int i = 0; i < GLA; ++i) { int R, C; stage_rc(wid * 1024 + i * 8192 + lane * 16, R, C); pa[i] = rowA(R) + C; }
#pragma unroll
  for (int i = 0; i < GLB; ++i) { int R, C; stage_rc(wid * 1024 + i * 8192 + lane * 16, R, C); pb[i] = rowB(SWAP ? perm_col(R) : R) + C; }
  f32x4 acc[MI][4];
#pragma unroll
  for (int m = 0; m < MI; ++m)
#pragma unroll
    for (int n = 0; n < 4; ++n) acc[m][n] = f32x4{0.f, 0.f, 0.f, 0.f};

#define GT_STAGE(buf, kt) do { const int ka_ = koffA(kt), kb_ = koffB(kt);                                            \
    _Pragma("unroll") for (int i = 0; i < GLA; ++i)                                                                    \
      __builtin_amdgcn_global_load_lds((const unsigned*)(pa[i] + ka_), (unsigned*)(shm + (buf) * STG + wid * 1024 + i * 8192), 16, 0, 0); \
    _Pragma("unroll") for (int i = 0; i < GLB; ++i)                                                                    \
      __builtin_amdgcn_global_load_lds((const unsigned*)(pb[i] + kb_), (unsigned*)(shm + (buf) * STG + TILE_A + wid * 1024 + i * 8192), 16, 0, 0); } while (0)

  GT_STAGE(0, 0);
  asm volatile("s_waitcnt vmcnt(0)" ::: "memory");
  __syncthreads();
  for (int t = 0; t < nk; ++t) {
    const int cur = t & 1;
    if (t + 1 < nk) GT_STAGE(cur ^ 1, t + 1);
    const char* sa = shm + cur * STG;
    const char* sb = sa + TILE_A;
#pragma unroll
    for (int ks = 0; ks < 2; ++ks) {
      bf16x8 At[MI], Bf[4];
#pragma unroll
      for (int m = 0; m < MI; ++m) At[m] = *(const bf16x8*)(sa + lds_byte(wr * (MI * 16) + m * 16 + fr, ks * 32 + fq * 8));
#pragma unroll
      for (int n = 0; n < 4; ++n) Bf[n] = *(const bf16x8*)(sb + lds_byte(wc * 64 + n * 16 + fr, ks * 32 + fq * 8));
#pragma unroll
      for (int m = 0; m < MI; ++m)
#pragma unroll
        for (int n = 0; n < 4; ++n) {
          if (SWAP) acc[m][n] = __builtin_amdgcn_mfma_f32_16x16x32_bf16(Bf[n], At[m], acc[m][n], 0, 0, 0);
          else      acc[m][n] = __builtin_amdgcn_mfma_f32_16x16x32_bf16(At[m], Bf[n], acc[m][n], 0, 0, 0);
        }
      __builtin_amdgcn_sched_barrier(0);
    }
    asm volatile("s_waitcnt vmcnt(0)" ::: "memory");
    __syncthreads();
  }
#undef GT_STAGE
  if constexpr (SWAP) {
#pragma unroll
    for (int m = 0; m < MI; ++m) epi(wr * (MI * 16) + m * 16 + fr, wc * 64 + fq * 16, acc[m]);
  } else {
#pragma unroll
    for (int m = 0; m < MI; ++m)
#pragma unroll
      for (int n = 0; n < 4; ++n) epi(wr * (MI * 16) + m * 16 + fq * 4, wc * 64 + n * 16 + fr, acc[m][n]);
  }
}


#define XB_TMO      128
#define XB_XCNT(j)  (256  + 64 * (j))
#define XB_XSUB(j)  (1280 + 64 * (j))
#define XB_XGEN(j)  (2304 + 64 * (j))
#define XB_TOP      3328
#define XB_TOPGEN   3392
#define XCD_BAR_WORDS 3456
#define XB_SPIN_CAP (1u << 22)
#define LAS __attribute__((address_space(3)))
__device__ __forceinline__ unsigned xb_ld(unsigned* p)              { return __hip_atomic_load(p, __ATOMIC_RELAXED, __HIP_MEMORY_SCOPE_AGENT); }
__device__ __forceinline__ unsigned xb_add(unsigned* p, unsigned v) { return __hip_atomic_fetch_add(p, v, __ATOMIC_RELAXED, __HIP_MEMORY_SCOPE_AGENT); }
__device__ __forceinline__ unsigned xb_xcc_id() { return (unsigned)__builtin_amdgcn_s_getreg((3 << 11) | 20) & 0xFu; }
#define XB_SPIN(cond, bar) do { unsigned _sp = 0; while (cond) { __builtin_amdgcn_s_sleep(1); \
    if ((++_sp & 255u) == 0u) { if (xb_ld(&(bar)[XB_TMO])) break; if (_sp > XB_SPIN_CAP) { atomicAdd(&(bar)[XB_TMO], 1u); break; } } } } while (0)
struct XcdBarrier { unsigned* bar; unsigned x; volatile LAS unsigned* st; };
__device__ __forceinline__ XcdBarrier xcd_barrier_post(unsigned* bar, volatile LAS unsigned* st) {
    XcdBarrier b; b.bar = bar; b.x = xb_xcc_id(); b.st = st;
    if (threadIdx.x == 0) (void)xb_add(&bar[XB_XCNT(b.x)], 1u);
    return b;
}
__device__ __forceinline__ void xcd_barrier_complete(unsigned* bar, unsigned x, unsigned& nloc, unsigned& nx) {
    const unsigned G = gridDim.x * gridDim.y * gridDim.z;
    unsigned sum, cnt, mine, sp = 0u;
    for (;;) {
        sum = 0u; cnt = 0u; mine = 0u;
#pragma unroll
        for (unsigned j = 0; j < 16; ++j) { const unsigned c = xb_ld(&bar[XB_XCNT(j)]); sum += c; cnt += (c > 0u) ? 1u : 0u; mine = (j == x) ? c : mine; }
        if (sum == G) break;
        __builtin_amdgcn_s_sleep(1);
        if ((++sp & 255u) == 0u) { if (xb_ld(&bar[XB_TMO])) break; if (sp > XB_SPIN_CAP) { atomicAdd(&bar[XB_TMO], 1u); break; } }
    }
    nloc = mine > 0u ? mine : 1u; nx = cnt > 0u ? cnt : 1u;
}
__device__ __forceinline__ void xcd_barrier(const XcdBarrier& b) {
    asm volatile("s_waitcnt vmcnt(0)" ::: "memory");
    __syncthreads();
    if (threadIdx.x == 0) {
        unsigned* bar = b.bar;
        __builtin_amdgcn_s_waitcnt(0);
        unsigned nloc = b.st[0], nx = b.st[1];
        if (nloc == 0u) { xcd_barrier_complete(bar, b.x, nloc, nx); b.st[0] = nloc; b.st[1] = nx; }
        const unsigned old = xb_add(&bar[XB_XSUB(b.x)], 1u);
        const unsigned gen = old / nloc;
        if (old + 1u == (gen + 1u) * nloc) {
            __builtin_amdgcn_fence(__ATOMIC_RELEASE, "agent");
            asm volatile("s_waitcnt vmcnt(0)" ::: "memory");
            const unsigned og = xb_add(&bar[XB_TOP], 1u);
            const unsigned tg = og / nx;
            if (og + 1u == (tg + 1u) * nx) xb_add(&bar[XB_TOPGEN], 1u);
            else XB_SPIN(xb_ld(&bar[XB_TOPGEN]) == tg, bar);
            __builtin_amdgcn_fence(__ATOMIC_ACQUIRE, "agent");
            xb_add(&bar[XB_XGEN(b.x)], 1u);
            asm volatile("s_waitcnt vmcnt(0)" ::: "memory");
        } else {
            XB_SPIN(xb_ld(&bar[XB_XGEN(b.x)]) == gen, bar);
            __builtin_amdgcn_fence(__ATOMIC_ACQUIRE, "agent");
            asm volatile("s_waitcnt vmcnt(0)" ::: "memory");
        }
    }
    __syncthreads();
}

template <class AF, class BF, class EF>
__device__ __forceinline__ void gemm_naive(int M, int N, int K, AF af, BF bf, EF ef, float* smem_all) {
  const int half = threadIdx.x >> 8, tid = threadIdx.x & 255;
  float* smem = smem_all + half * (2 * 16 * 68);
  const int tilesM = (M + 63) >> 6, tilesN = (N + 63) >> 6;
  const int ntiles = tilesM * tilesN;
  float (*As)[68] = (float (*)[68])smem;
  float (*Bs)[68] = (float (*)[68])(smem + 16 * 68);
  const int ty = tid >> 4, tx = tid & 15;
  const int stride = gridDim.x * 2;
  const int iters = (ntiles + stride - 1) / stride;
  for (int it = 0; it < iters; ++it) {
    const int tile = it * stride + blockIdx.x * 2 + half;
    const bool valid = tile < ntiles;
    const int tm = valid ? tile / tilesN : 0, tn = valid ? tile - tm * tilesN : 0;
    const int m0 = tm << 6, n0 = tn << 6;
    float acc[4][4];
#pragma unroll
    for (int i = 0; i < 4; ++i)
#pragma unroll
      for (int j = 0; j < 4; ++j) acc[i][j] = 0.f;
    for (int k0 = 0; k0 < K; k0 += 16) {
#pragma unroll
      for (int i = 0; i < 4; ++i) {
        const int mm = (tid >> 4) + 16 * i, kk = tid & 15;
        const int m = m0 + mm, k = k0 + kk;
        As[kk][mm] = (valid && m < M && k < K) ? af(m, k, n0) : 0.f;
      }
#pragma unroll
      for (int i = 0; i < 4; ++i) {
        const int kk = (tid >> 6) + 4 * i, nn = tid & 63;
        const int k = k0 + kk, n = n0 + nn;
        Bs[kk][nn] = (valid && k < K && n < N) ? bf(k, n, m0) : 0.f;
      }
      __syncthreads();
#pragma unroll
      for (int kk = 0; kk < 16; ++kk) {
        const float4 a = *(const float4*)&As[kk][ty * 4];
        const float4 b = *(const float4*)&Bs[kk][tx * 4];
        const float av[4] = {a.x, a.y, a.z, a.w};
        const float bv[4] = {b.x, b.y, b.z, b.w};
#pragma unroll
        for (int i = 0; i < 4; ++i)
#pragma unroll
          for (int j = 0; j < 4; ++j) acc[i][j] = fmaf(av[i], bv[j], acc[i][j]);
      }
      __syncthreads();
    }
    if (valid) {
#pragma unroll
      for (int i = 0; i < 4; ++i)
#pragma unroll
        for (int j = 0; j < 4; ++j) {
          const int m = m0 + ty * 4 + i, n = n0 + tx * 4 + j;
          if (m < M && n < N) ef(m, n, acc[i][j]);
        }
    }
  }
}

__device__ __forceinline__ void conv_tile(const float* src, int ldn, bf16_t* dst, int ldk, int k0, int n0, int mapmode, float* sm) {
  const int tid = threadIdx.x;
  float (*tl)[65] = (float (*)[65])sm;
  {
    const int row = tid >> 3, c4 = (tid & 7) * 4;
    const float4 a = *(const float4*)&src[(size_t)(k0 + row) * ldn + n0 + c4];
    const float4 b = *(const float4*)&src[(size_t)(k0 + row) * ldn + n0 + 32 + c4];
    tl[row][c4 + 0] = a.x; tl[row][c4 + 1] = a.y; tl[row][c4 + 2] = a.z; tl[row][c4 + 3] = a.w;
    tl[row][32 + c4 + 0] = b.x; tl[row][32 + c4 + 1] = b.y; tl[row][32 + c4 + 2] = b.z; tl[row][32 + c4 + 3] = b.w;
  }
  __syncthreads();
  {
    const int n = tid >> 3, kg = (tid & 7) * 8;
    uint4 o;
    o.x = pack2(tl[kg + 0][n], tl[kg + 1][n]); o.y = pack2(tl[kg + 2][n], tl[kg + 3][n]);
    o.z = pack2(tl[kg + 4][n], tl[kg + 5][n]); o.w = pack2(tl[kg + 6][n], tl[kg + 7][n]);
    const int h = n0 + n;
    const int dr = mapmode == 0 ? h : ((h >> 3) * 16 + (h & 7) + (mapmode == 2 ? 8 : 0));
    *(uint4*)&dst[(size_t)dr * ldk + k0 + kg] = o;
  }
  __syncthreads();
}

__device__ __forceinline__ void norm_phase(const Params& P, int t0, const float* gw,
                                           int mod_layer, int shift_idx,
                                           int pend_layer, int pend_t0,
                                           bool to_out, bool write_lo, int layer) {
  unsigned char* ws = P.ws;
  float* tok = (float*)(ws + WS_TOK);
  bf16_t* hb = (bf16_t*)(ws + WS_H);
  bf16_t* hlo = (bf16_t*)(ws + WS_HLO);
  const float* mod = (const float*)(ws + WS_MOD);
  const bf16_t* ybuf = (const bf16_t*)(ws + WS_R + R_YBUF);
  const int lane = threadIdx.x & 63;
  const int gw_id = blockIdx.x * (NT / 64) + (threadIdx.x >> 6);
  const int gw_n = gridDim.x * (NT / 64);
  for (int t = t0 + gw_id; t < T_ALL; t += gw_n) {
    const int s = (t < T_CTX) ? 1 : 0;
    float v[16];
#pragma unroll
    for (int j = 0; j < 4; ++j) {
      const int n = j * 256 + lane * 4;
      const float4 x = *(const float4*)&tok[(size_t)t * DM + n];
      v[j * 4 + 0] = x.x; v[j * 4 + 1] = x.y; v[j * 4 + 2] = x.z; v[j * 4 + 3] = x.w;
    }
    if (pend_layer >= 0 && t >= pend_t0) {
      const float* gate = mod + (size_t)((pend_layer * 2 + s) * 6 + 5) * 1024;
#pragma unroll
      for (int j = 0; j < 4; ++j) {
        const int n = j * 256 + lane * 4;
        const uint2 y0 = *(const uint2*)&ybuf[(size_t)(2 * t) * DM + n];
        const uint2 y1 = *(const uint2*)&ybuf[(size_t)(2 * t + 1) * DM + n];
        const float4 g = *(const float4*)&gate[n];
        v[j * 4 + 0] += g.x * (lo2f(y0.x) + lo2f(y1.x));
        v[j * 4 + 1] += g.y * (hi2f(y0.x) + hi2f(y1.x));
        v[j * 4 + 2] += g.z * (lo2f(y0.y) + lo2f(y1.y));
        v[j * 4 + 3] += g.w * (hi2f(y0.y) + hi2f(y1.y));
        *(float4*)&tok[(size_t)t * DM + n] = make_float4(v[j * 4 + 0], v[j * 4 + 1], v[j * 4 + 2], v[j * 4 + 3]);
      }
    }
    float ss = 0.f;
#pragma unroll
    for (int e = 0; e < 16; ++e) ss += v[e] * v[e];
    ss = wave_sum(ss);
    const float r = 1.f / sqrtf(ss * (1.f / 1024.f) + EPSN);
    float h[16];
#pragma unroll
    for (int j = 0; j < 4; ++j) {
      const int n = j * 256 + lane * 4;
      const float4 g = *(const float4*)&gw[n];
      h[j * 4 + 0] = v[j * 4 + 0] * r * g.x;
      h[j * 4 + 1] = v[j * 4 + 1] * r * g.y;
      h[j * 4 + 2] = v[j * 4 + 2] * r * g.z;
      h[j * 4 + 3] = v[j * 4 + 3] * r * g.w;
      if (shift_idx >= 0) {
        const float* sh = mod + (size_t)((mod_layer * 2 + s) * 6 + shift_idx) * 1024;
        const float* sc = sh + 1024;
        const float4 a = *(const float4*)&sh[n];
        const float4 b = *(const float4*)&sc[n];
        h[j * 4 + 0] = h[j * 4 + 0] * (1.f + b.x) + a.x;
        h[j * 4 + 1] = h[j * 4 + 1] * (1.f + b.y) + a.y;
        h[j * 4 + 2] = h[j * 4 + 2] * (1.f + b.z) + a.z;
        h[j * 4 + 3] = h[j * 4 + 3] * (1.f + b.w) + a.w;
      }
      if (to_out) {
        *(float4*)&P.out[(size_t)(t - T_CTX) * DM + n] = make_float4(h[j * 4 + 0], h[j * 4 + 1], h[j * 4 + 2], h[j * 4 + 3]);
      } else {
        uint2 o; o.x = pack2(h[j * 4 + 0], h[j * 4 + 1]); o.y = pack2(h[j * 4 + 2], h[j * 4 + 3]);
        *(uint2*)&hb[(size_t)t * DM + n] = o;
        if (write_lo) {
          uint2 o2;
          o2.x = pack2(h[j * 4 + 0] - lo2f(o.x), h[j * 4 + 1] - hi2f(o.x));
          o2.y = pack2(h[j * 4 + 2] - lo2f(o.y), h[j * 4 + 3] - hi2f(o.y));
          *(uint2*)&hlo[(size_t)t * DM + n] = o2;
        }
      }
    }
  }
}

__global__ void __launch_bounds__(NT, 2) mega(Params P) {
  cg::grid_group grid = cg::this_grid();
  __shared__ __attribute__((aligned(1024))) char shm[GEMM_LDS_BYTES + 16 + 256];
  float* smem = (float*)shm;
  if (threadIdx.x < 4) ((unsigned*)(shm + GEMM_LDS_BYTES))[threadIdx.x] = 0u;
  __syncthreads();
  XcdBarrier xbar = xcd_barrier_post((unsigned*)(P.ws + WS_BAR), (volatile LAS unsigned*)(shm + GEMM_LDS_BYTES));
  unsigned char* ws = P.ws;
  const int tid = threadIdx.x;
  const int gtid = blockIdx.x * NT + tid;
  const int gstride = gridDim.x * NT;
  const int G = gridDim.x;
  const int vb = (G % 8 == 0) ? ((int)(blockIdx.x & 7) * (G / 8) + (int)(blockIdx.x >> 3)) : (int)blockIdx.x;
  float* tok = (float*)(ws + WS_TOK);
  bf16_t* hb = (bf16_t*)(ws + WS_H);
  float* mod = (float*)(ws + WS_MOD);
  const bf16_t* zrow = (const bf16_t*)(ws + WS_ZROW);
  unsigned char* R = ws + WS_R;

  {
    const float* x = P.in[0]; const float* ctx = P.in[2];
    for (int idx = gtid; idx < T_ALL * 256; idx += gstride) {
      const int t = idx >> 8, n = (idx & 255) * 4;
      float4 o;
      if (t < T_CTX) o = *(const float4*)&ctx[(size_t)t * DM + n];
      else {
        const int tl = t - T_CTX;
        o = *(const float4*)&x[(size_t)tl * DM + n];
        float pe[4];
#pragma unroll
        for (int e = 0; e < 4; ++e) {
          const int nn = n + e, qd = nn >> 8, j = nn & 255;
          const float freq = expf(-9.210340371976184f * (float)j / 256.f);
          const float pos = (qd < 2) ? (float)(tl >> 6) : (float)(tl & 63);
          const float ang = pos * freq;
          pe[e] = (qd & 1) ? cosf(ang) : sinf(ang);
        }
        o.x += pe[0]; o.y += pe[1]; o.z += pe[2]; o.w += pe[3];
      }
      *(float4*)&tok[(size_t)t * DM + n] = o;
    }
    const float* c = P.in[1]; const float* cc = P.in[3]; const float* adaw = P.in[4];
    float* modp = (float*)(ws + WS_MODP);
    for (int idx = gtid; idx < 16 * 4 * 6144; idx += gstride) {
      const int ks = idx / 24576, rem = idx - ks * 24576, i = rem / 6144, j = rem - i * 6144;
      float a0 = 0.f, a1 = 0.f;
      for (int k = ks * 64; k < ks * 64 + 64; ++k) {
        const float w = adaw[((size_t)i * 1024 + k) * 6144 + j];
        a0 += silu_f(c[k]) * w;
        a1 += silu_f(cc[k]) * w;
      }
      modp[(size_t)(ks * 8 + i * 2 + 0) * 6144 + j] = a0;
      modp[(size_t)(ks * 8 + i * 2 + 1) * 6144 + j] = a1;
    }
    if (gtid < 256) ((int*)(ws + WS_CNT))[gtid] = 0;
    if (gtid < 2048) ((unsigned*)(ws + WS_ZROW))[gtid] = 0u;
    bf16_t* DC = (bf16_t*)(ws + W_DC); bf16_t* DA = (bf16_t*)(ws + W_DA); bf16_t* TW = (bf16_t*)(ws + W_TW);
    for (int idx = gtid; idx < 512 * 256; idx += gstride) {
      const int row = idx >> 8, cch = idx & 255, pq = row >> 8, kc = row & 255;
      const float a = (float)((kc * cch) & 255) * (1.f / 128.f);
      DC[idx] = f2bf(pq ? -sinpif(a) : cospif(a));
    }
    for (int idx = gtid; idx < 256 * 256; idx += gstride) {
      const int row = idx >> 8, col = idx & 255, ri = row >> 7, cc2 = row & 127, rj = col >> 7, aa = col & 127;
      const float a = (float)((aa * cc2) & 127) * (1.f / 64.f);
      const float cs = cospif(a), sn = sinpif(a);
      DA[idx] = f2bf(ri == rj ? cs : (ri == 0 ? sn : -sn));
    }
    for (int idx = gtid; idx < 128 * 128 * 256; idx += gstride) {
      const int col = idx & 255, e = (idx >> 8) & 127, c2 = idx >> 15, ri = col >> 7, b = col & 127;
      const float a = (float)((b * (c2 + 128 * e)) & 16383) * (1.f / 8192.f);
      TW[idx] = f2bf(ri ? sinpif(a) : cospif(a));
    }
    for (int idx = gtid; idx < 2 * 1280; idx += gstride) ((float*)(ws + W_SP))[idx] = log1pf(expf(-P.in[34][idx]));
    {
      bf16_t* WR = (bf16_t*)(ws + W_RT);
      for (int idx = gtid; idx < 4 * 64 * 1024; idx += gstride) {
        const int k = idx & 1023, j = (idx >> 10) & 63, l = idx >> 16;
        float w = 0.f;
        if (j < 4) w = P.in[9][((size_t)l * 1024 + k) * 4 + j];
        else if (j < 36) w = P.in[11][((size_t)l * 1024 + k) * 32 + (j - 4)];
        const bf16_t hi = f2bf(w), lo = f2bf(w - bf2f(hi));
        bf16_t* row = WR + ((size_t)l * 64 + j) * 3072;
        row[k] = hi; row[1024 + k] = hi; row[2048 + k] = lo;
      }
    }
    {
      const float* src = P.in[36]; bf16_t* dst = (bf16_t*)(ws + W_FNIN);
      for (int idx = gtid; idx < 1024 * 1024 / 4; idx += gstride) {
        const float4 a = *(const float4*)&src[(size_t)idx * 4];
        uint2 o; o.x = pack2(a.x, a.y); o.y = pack2(a.z, a.w);
        *(uint2*)&dst[(size_t)idx * 4] = o;
      }
    }
    const int NDENSE = 512 + 256 + 768 + 256 + 640 + 320 + 256 + 160;
    const int NTOT = NDENSE + 128 * 384;
    for (int u = blockIdx.x; u < NTOT; u += G) {
      if (u < NDENSE) {
        int v = u;
        if (v < 512) { conv_tile(P.in[16], 2048, (bf16_t*)(ws + W_CMIN), 1024, (v >> 5) * 64, (v & 31) * 64, 0, smem); continue; }
        v -= 512;
        if (v < 256) { conv_tile(P.in[20], 1024, (bf16_t*)(ws + W_CMOUT), 1024, (v >> 4) * 64, (v & 15) * 64, 0, smem); continue; }
        v -= 256;
        if (v < 768) { conv_tile(P.in[21], 3088, (bf16_t*)(ws + W_MLIN), 1024, (v / 48) * 64, (v % 48) * 64, 0, smem); continue; }
        v -= 768;
        if (v < 256) { conv_tile(P.in[26], 1024, (bf16_t*)(ws + W_MLOUT), 1024, (v >> 4) * 64, (v & 15) * 64, 0, smem); continue; }
        v -= 256;
        if (v < 640) { conv_tile(P.in[27], 2560, (bf16_t*)(ws + W_LRUIN), 1024, (v / 40) * 64, (v % 40) * 64, 0, smem); continue; }
        v -= 640;
        if (v < 320) { conv_tile(P.in[35], 1024, (bf16_t*)(ws + W_LRUOUT), 1280, (v >> 4) * 64, (v & 15) * 64, 0, smem); continue; }
        v -= 320;
        if (v < 256) { conv_tile(P.in[37], 1024, (bf16_t*)(ws + W_FNOUT), 1024, (v >> 4) * 64, (v & 15) * 64, 0, smem); continue; }
        v -= 256;
        {
          const int mat = v >> 2, tl4 = v & 3, type = mat / 20, dnb = mat % 20, d = dnb / 10, nb = dnb % 10;
          const float* srcm = (type ? P.in[32] : P.in[30]) + (size_t)dnb * 128 * 128;
          conv_tile(srcm, 128, (bf16_t*)(ws + W_LRUG) + (size_t)(nb * 2 + d) * 256 * 128, 128, (tl4 >> 1) * 64, (tl4 & 1) * 64, type + 1, smem);
        }
      } else {
        const int v = u - NDENSE, le = v / 384, r = v - le * 384, kind = r >> 7, tt = r & 127;
        if (kind < 2) {
          const float* src = (kind == 0 ? P.in[13] : P.in[14]) + (size_t)le * 1024 * 512;
          conv_tile(src, 512, (bf16_t*)(ws + W_EGU) + (size_t)le * 1024 * 1024, 1024, (tt >> 3) * 64, (tt & 7) * 64, kind + 1, smem);
        } else {
          const float* src = P.in[15] + (size_t)le * 512 * 1024;
          conv_tile(src, 1024, (bf16_t*)(ws + W_ED) + (size_t)le * 1024 * 512, 512, (tt >> 4) * 64, (tt & 15) * 64, 0, smem);
        }
      }
    }
  }
  grid.sync();
  {
    const float* modp = (const float*)(ws + WS_MODP);
    const float* adab = P.in[5];
    for (int idx = gtid; idx < 8 * 6144; idx += gstride) {
      const int is = idx / 6144, j = idx - is * 6144, i = is >> 1;
      float a = adab[i * 6144 + j];
      for (int ks = 0; ks < 16; ++ks) a += modp[(size_t)(ks * 8 + is) * 6144 + j];
      mod[idx] = a;
    }
    if (vb < 32) {
      const int tm = vb >> 2, tn = vb & 3, pq = tm >> 2, g = tm & 3, n0 = tn * 256;
      const bf16_t* DC = (const bf16_t*)(ws + W_DC);
      const bf16_t* WI = (const bf16_t*)(ws + W_FNIN);
      bf16_t* WP = (bf16_t*)(ws + W_FNP);
      gemm_tile<8, true>(shm, 4,
        [=](int r) { return DC + (size_t)(pq * 256 + r) * 256; },
        [=](int cidx) { return WI + (size_t)(n0 + cidx) * 1024 + g * 256; }, KOff64(), KOff64(),
        [=](int row, int col0, const f32x4 (&a)[4]) { st16bf(WP + (size_t)(tm * 256 + row) * 1024 + n0 + col0, a); });
    }
  }
  xcd_barrier(xbar);

#define MODV(i, s, j, n) mod[(size_t)(((i) * 2 + (s)) * 6 + (j)) * 1024 + (n)]

#define DENSE_PHASE(Aptr, lda, Wt, ldw, NTILES_N, NK, WITH_CTX, EPI)                                                    \
  do {                                                                                                                  \
    const int nbig_ = 64 * (NTILES_N);                                                                                  \
    for (int L_ = vb; L_ < nbig_; L_ += G) {                                                                            \
      const int m0_ = (1 + L_ / (NTILES_N)) * 256, n0_ = (L_ % (NTILES_N)) * 256;                                       \
      gemm_tile<8, true>(shm, (NK),                                                                                     \
        [=](int r) { return (Aptr) + (size_t)(m0_ + r) * (lda); },                                                      \
        [=](int cidx) { return (Wt) + (size_t)(n0_ + cidx) * (ldw); }, KOff64(), KOff64(),                              \
        [=](int row, int col0, const f32x4 (&a)[4]) { EPI(m0_ + row, n0_ + col0, a); });                                \
    }                                                                                                                   \
    if (WITH_CTX) {                                                                                                     \
      const int s_ = (vb - (nbig_ % G) + G) % G;                                                                        \
      if (s_ < 4 * (NTILES_N)) {                                                                                        \
        const int m0_ = (s_ / (NTILES_N)) * 64, n0_ = (s_ % (NTILES_N)) * 256;                                          \
        gemm_tile<2, true>(shm, (NK),                                                                                   \
          [=](int r) { return (Aptr) + (size_t)(m0_ + r) * (lda); },                                                    \
          [=](int cidx) { return (Wt) + (size_t)(n0_ + cidx) * (ldw); }, KOff64(), KOff64(),                            \
          [=](int row, int col0, const f32x4 (&a)[4]) { EPI(m0_ + row, n0_ + col0, a); });                              \
      }                                                                                                                 \
    }                                                                                                                   \
  } while (0)

  auto resid_epi = [=](int layer, int grow, int gcol0, const f32x4 (&a)[4]) {
    const int s = grow < T_CTX ? 1 : 0;
    const float* gate = &MODV(layer, s, 2, gcol0);
    float* p = tok + (size_t)grow * DM + gcol0;
#pragma unroll
    for (int n = 0; n < 4; ++n) {
      float4 t4 = *(float4*)(p + n * 4);
      const float4 g4 = *(const float4*)(gate + n * 4);
      t4.x += g4.x * a[n][0]; t4.y += g4.y * a[n][1]; t4.z += g4.z * a[n][2]; t4.w += g4.w * a[n][3];
      *(float4*)(p + n * 4) = t4;
    }
  };

  auto moe_layer = [&](int layer, int t0) {
    norm_phase(P, t0, P.in[7] + layer * 1024, layer, 3, -1, 0, false, true, layer);
    xcd_barrier(xbar);
    int* cnt = (int*)(ws + WS_CNT) + layer * 32;
    int* list = (int*)(ws + WS_LIST);
    float* asgw = (float*)(ws + WS_ASGW);
    {
      const bf16_t* WR = (const bf16_t*)(ws + W_RT) + (size_t)layer * 64 * 3072;
      const bf16_t* hlo = (const bf16_t*)(ws + WS_HLO);
      const int dlo = (int)(hlo - hb);
      const float* rgb = P.in[10] + layer * 4;
      const float* reb = P.in[12] + layer * 32;
      const int ntl = (T_ALL - t0) >> 7;
      for (int L = vb; L < ntl; L += G) {
        const int m0 = t0 + L * 128;
        gemm_tile<4, true>(shm, 48,
          [=](int r) { return (const bf16_t*)(hb + (size_t)(m0 + r) * DM); },
          [=](int cidx) { return cidx < 64 ? WR + (size_t)cidx * 3072 : zrow; },
          [=](int kt) { return kt < 16 ? kt * 64 : (kt < 32 ? dlo + (kt - 16) * 64 : (kt - 32) * 64); }, KOff64(),
          [=](int row, int col0, const f32x4 (&a)[4]) {
            if (col0 < 64) {
              const int ln = threadIdx.x & 63, fr_ = ln & 15;
              float lg[36];
#pragma unroll
              for (int i = 0; i < 16; ++i) lg[i] = a[i >> 2][i & 3];
#pragma unroll
              for (int i = 0; i < 16; ++i) lg[16 + i] = __shfl(a[i >> 2][i & 3], fr_ + 16);
#pragma unroll
              for (int i = 0; i < 4; ++i) lg[32 + i] = __shfl(a[0][i], fr_ + 32);
              if (ln < 16) {
                const int t = m0 + row;
#pragma unroll
                for (int q = 0; q < 4; ++q) lg[q] += rgb[q];
#pragma unroll
                for (int q = 0; q < 32; ++q) lg[4 + q] += reb[q];
                int grp = 0; float best = lg[0];
#pragma unroll
                for (int q = 1; q < 4; ++q) if (lg[q] > best) { best = lg[q]; grp = q; }
                float se = 0.f;
#pragma unroll
                for (int q = 0; q < 4; ++q) se += expf(lg[q] - best);
                const float pg = 1.f / se;
                float v0 = -3.0e38f, v1 = -3.0e38f; int i0 = 0, i1 = 0;
#pragma unroll
                for (int g = 0; g < 4; ++g) {
#pragma unroll
                  for (int q = 0; q < 8; ++q) {
                    const float x = lg[4 + g * 8 + q];
                    if (g == grp) {
                      if (x > v0) { v1 = v0; i1 = i0; v0 = x; i0 = q; }
                      else if (x > v1) { v1 = x; i1 = q; }
                    }
                  }
                }
                const float w0 = 1.f / (1.f + expf(v1 - v0));
                const float w1 = 1.f - w0;
                const int e0 = grp * 8 + i0, e1 = grp * 8 + i1;
                const int p0 = atomicAdd(&cnt[e0], 1);
                list[(size_t)e0 * 33280 + p0] = 2 * t;
                asgw[2 * t] = w0 * pg;
                const int p1 = atomicAdd(&cnt[e1], 1);
                list[(size_t)e1 * 33280 + p1] = 2 * t + 1;
                asgw[2 * t + 1] = w1 * pg;
              }
            }
          });
      }
    }
    xcd_barrier(xbar);
    int* ps = (int*)(shm + GEMM_LDS_BYTES + 64);
    if (tid == 0) {
      int s = 0;
      for (int e = 0; e < 32; ++e) { ps[e] = s; s += (cnt[e] + 127) / 128 * 128; }
      ps[32] = s;
    }
    __syncthreads();
    const int total = ps[32];
    bf16_t* HB = (bf16_t*)(R + R_HB);
    bf16_t* ybuf = (bf16_t*)(R + R_YBUF);
    const bf16_t* WGU = (const bf16_t*)(ws + W_EGU) + (size_t)layer * 32 * 1024 * 1024;
    const bf16_t* WD = (const bf16_t*)(ws + W_ED) + (size_t)layer * 32 * 1024 * 512;
    const int ntile = (total >> 7) * 4;
    for (int L = vb; L < ntile; L += G) {
      const int mb = L >> 2, n0 = (L & 3) * 256, m0 = mb * 128;
      int e = 0;
      for (int q = 1; q < 32; ++q) if (ps[q] <= m0) e = q;
      const int r0 = m0 - ps[e], ce = cnt[e];
      const int* le = list + (size_t)e * 33280 + r0;
      const bf16_t* wb = WGU + (size_t)e * 1024 * 1024;
      gemm_tile<4, true>(shm, 16,
        [=](int r) { return (r0 + r < ce) ? (const bf16_t*)(hb + (size_t)(le[r] >> 1) * DM) : zrow; },
        [=](int cidx) { return wb + (size_t)(n0 + cidx) * 1024; }, KOff64(), KOff64(),
        [=](int row, int col0, const f32x4 (&a)[4]) {
          float hv[8];
#pragma unroll
          for (int j = 0; j < 8; ++j) { const float gv = a[j >> 2][j & 3], uv = a[2 + (j >> 2)][j & 3]; hv[j] = silu_f(gv) * uv; }
          uint4 o; o.x = pack2(hv[0], hv[1]); o.y = pack2(hv[2], hv[3]); o.z = pack2(hv[4], hv[5]); o.w = pack2(hv[6], hv[7]);
          *(uint4*)&HB[(size_t)(m0 + row) * 512 + ((n0 + col0) >> 1)] = o;
        });
    }
    xcd_barrier(xbar);
    for (int L = vb; L < ntile; L += G) {
      const int mb = L >> 2, n0 = (L & 3) * 256, m0 = mb * 128;
      int e = 0;
      for (int q = 1; q < 32; ++q) if (ps[q] <= m0) e = q;
      const int r0 = m0 - ps[e], ce = cnt[e];
      const int* le = list + (size_t)e * 33280 + r0;
      const bf16_t* wb = WD + (size_t)e * 1024 * 512;
      gemm_tile<4, true>(shm, 8,
        [=](int r) { return (const bf16_t*)(HB + (size_t)(m0 + r) * 512); },
        [=](int cidx) { return wb + (size_t)(n0 + cidx) * 512; }, KOff64(), KOff64(),
        [=](int row, int col0, const f32x4 (&a)[4]) {
          if (r0 + row < ce) {
            const int rt = le[row];
            const float w = asgw[rt];
            f32x4 bq[4];
#pragma unroll
            for (int n = 0; n < 4; ++n) bq[n] = a[n] * w;
            st16bf(ybuf + (size_t)rt * 1024 + n0 + col0, bq);
          }
        });
    }
    xcd_barrier(xbar);
  };

  {
    norm_phase(P, 0, P.in[6] + 0 * 1024, 0, 0, -1, 0, false, false, 0);
    xcd_barrier(xbar);
    bf16_t* zu = (bf16_t*)(R + R0_ZU); bf16_t* zvT = (bf16_t*)(R + R0_ZVT); bf16_t* pb = (bf16_t*)(R + R0_P);
    bf16_t* Wsc = (bf16_t*)(R + R0_WSC);
    const float* vg = P.in[17]; const float* w_s = P.in[18]; const float* b_s = P.in[19];
    const bf16_t* Wt = (const bf16_t*)(ws + W_CMIN);
    {
      auto epi_u = [=](int grow, int gcol0, const f32x4 (&a)[4]) {
        f32x4 bq[4];
#pragma unroll
        for (int n = 0; n < 4; ++n)
#pragma unroll
          for (int j = 0; j < 4; ++j) bq[n][j] = gelu_f(a[n][j]);
        st16bf(zu + (size_t)grow * 1024 + gcol0, bq);
      };
      auto epi_v = [=](int grow0, int gcol, f32x4 v) {
        uint2 o; o.x = pack2(gelu_f(v[0]), gelu_f(v[1])); o.y = pack2(gelu_f(v[2]), gelu_f(v[3]));
        *(uint2*)&zvT[((size_t)(grow0 >> 7) * 1024 + (gcol - 1024)) * 128 + (grow0 & 127)] = o;
      };
      const int nbig = 64 * 8;
      for (int L = vb; L < nbig; L += G) {
        const int m0 = (1 + L / 8) * 256, tn = L % 8, n0 = tn * 256;
        if (tn >= 4) {
          gemm_tile<8, false>(shm, 16, [=](int r) { return (const bf16_t*)(hb + (size_t)(m0 + r) * DM); },
            [=](int cidx) { return Wt + (size_t)(n0 + cidx) * 1024; }, KOff64(), KOff64(),
            [=](int row0, int col, f32x4 v) { epi_v(m0 + row0, n0 + col, v); });
        } else {
          gemm_tile<8, true>(shm, 16, [=](int r) { return (const bf16_t*)(hb + (size_t)(m0 + r) * DM); },
            [=](int cidx) { return Wt + (size_t)(n0 + cidx) * 1024; }, KOff64(), KOff64(),
            [=](int row, int col0, const f32x4 (&a)[4]) { epi_u(m0 + row, n0 + col0, a); });
        }
      }
      const int s = (vb - (nbig % G) + G) % G;
      if (s < 32) {
        const int m0 = (s / 8) * 64, tn = s % 8, n0 = tn * 256;
        if (tn >= 4) {
          gemm_tile<2, false>(shm, 16, [=](int r) { return (const bf16_t*)(hb + (size_t)(m0 + r) * DM); },
            [=](int cidx) { return Wt + (size_t)(n0 + cidx) * 1024; }, KOff64(), KOff64(),
            [=](int row0, int col, f32x4 v) { epi_v(m0 + row0, n0 + col, v); });
        } else {
          gemm_tile<2, true>(shm, 16, [=](int r) { return (const bf16_t*)(hb + (size_t)(m0 + r) * DM); },
            [=](int cidx) { return Wt + (size_t)(n0 + cidx) * 1024; }, KOff64(), KOff64(),
            [=](int row, int col0, const f32x4 (&a)[4]) { epi_u(m0 + row, n0 + col0, a); });
        }
      }
    }
    xcd_barrier(xbar);
    {
      float* s_part = smem;
      float* s_rv = smem + 512;
      for (int n = blockIdx.x; n < NCH; n += G) {
        const int sidx = tid & 127, qt = tid >> 7;
        float ss = 0.f;
        for (int col = qt * 256; col < qt * 256 + 256; ++col) { const float x = bf2f(zvT[((size_t)n * 1024 + col) * 128 + sidx]); ss += x * x; }
        s_part[qt * 128 + sidx] = ss;
        __syncthreads();
        if (tid < 128) s_rv[tid] = 1.f / sqrtf((s_part[tid] + s_part[128 + tid] + s_part[256 + tid] + s_part[384 + tid]) * (1.f / 1024.f) + EPSN);
        __syncthreads();
        for (int idx = tid; idx < 4 * 128 * 32; idx += NT) {
          const int s4 = (idx & 31) * 4, gt = idx >> 5;
          const float4 w4 = *(const float4*)&w_s[(size_t)gt * 128 + s4];
          uint2 o; o.x = pack2(w4.x * s_rv[s4], w4.y * s_rv[s4 + 1]); o.y = pack2(w4.z * s_rv[s4 + 2], w4.w * s_rv[s4 + 3]);
          *(uint2*)&Wsc[((size_t)n * 512 + gt) * 128 + s4] = o;
        }
        __syncthreads();
      }
    }
    xcd_barrier(xbar);
    for (int L = vb; L < NCH * 4; L += G) {
      const int n = L >> 2, g = L & 3;
      const bf16_t* a0 = Wsc + ((size_t)n * 512 + g * 128) * 128;
      const bf16_t* b0 = zvT + ((size_t)n * 1024 + g * 256) * 128;
      gemm_tile<4, true>(shm, 2, [=](int r) { return a0 + (size_t)r * 128; }, [=](int cidx) { return b0 + (size_t)cidx * 128; },
        KOff64(), KOff64(),
        [=](int row, int col0, const f32x4 (&a)[4]) {
          const int t = n * 128 + row, col = g * 256 + col0;
          const float bias = b_s[g * 128 + row];
          const uint4 u0 = *(const uint4*)&zu[(size_t)t * 1024 + col], u1 = *(const uint4*)&zu[(size_t)t * 1024 + col + 8];
          const unsigned uu[8] = {u0.x, u0.y, u0.z, u0.w, u1.x, u1.y, u1.z, u1.w};
          f32x4 o[4];
#pragma unroll
          for (int nn = 0; nn < 4; ++nn) {
            const float4 g4 = *(const float4*)&vg[col + nn * 4];
            o[nn][0] = lo2f(uu[nn * 2]) * (a[nn][0] * g4.x + bias);
            o[nn][1] = hi2f(uu[nn * 2]) * (a[nn][1] * g4.y + bias);
            o[nn][2] = lo2f(uu[nn * 2 + 1]) * (a[nn][2] * g4.z + bias);
            o[nn][3] = hi2f(uu[nn * 2 + 1]) * (a[nn][3] * g4.w + bias);
          }
          st16bf(pb + (size_t)t * 1024 + col, o);
        });
    }
    xcd_barrier(xbar);
    const bf16_t* Wo = (const bf16_t*)(ws + W_CMOUT);
    auto epi_out = [=](int grow, int gcol0, const f32x4 (&a)[4]) { resid_epi(0, grow, gcol0, a); };
    DENSE_PHASE(pb, 1024, Wo, 1024, 4, 16, true, epi_out);
    xcd_barrier(xbar);
  }
  moe_layer(0, 0);

  {
    norm_phase(P, 0, P.in[6] + 1 * 1024, 1, 0, 0, 0, false, false, 0);
    xcd_barrier(xbar);
    bf16_t* ZQK = (bf16_t*)(R + R1_ZQK); bf16_t* ZO = (bf16_t*)(R + R1_ZO); bf16_t* VT = (bf16_t*)(R + R1_VT);
    float* gpre = (float*)(R + R1_GPRE); bf16_t* Qn = (bf16_t*)(R + R1_QN); bf16_t* Kn = (bf16_t*)(R + R1_KN);
    bf16_t* AS = (bf16_t*)(R + R1_AS); bf16_t* KwT = (bf16_t*)(R + R1_KWT);
    float* bc = (float*)(R + R1_BC); float* li = (float*)(R + R1_LI); float* egch = (float*)(R + R1_GCH);
    float* nloc = (float*)(R + R1_NLOC); float* nin = (float*)(R + R1_NIN);
    float* Cloc = (float*)(R + R1_CLOC); bf16_t* CinT = (bf16_t*)(R + R1_CINT); float* hnum = (float*)(R + R1_CLOC);
    bf16_t* A2 = (bf16_t*)(R + R1_A2);
    const float* w_in = P.in[21]; const float* cw = P.in[22]; const float* cb = P.in[23];
    const float* gb = P.in[24]; const float* ng = P.in[25];
    const bf16_t* Wt = (const bf16_t*)(ws + W_MLIN);
    {
      auto epi_nat = [=](int grow, int gcol0, const f32x4 (&a)[4]) {
        if (gcol0 < 1024) st16bf(ZQK + (size_t)grow * 1024 + gcol0, a); else st16bf(ZO + (size_t)grow * 1024 + gcol0 - 2048, a);
      };
      auto epi_vt = [=](int grow0, int gcol, f32x4 v) {
        uint2 o; o.x = pack2(v[0], v[1]); o.y = pack2(v[2], v[3]);
        *(uint2*)&VT[((size_t)(grow0 >> 7) * 1024 + (gcol - 1024)) * 128 + (grow0 & 127)] = o;
      };
      const int nbig = 64 * 12;
      for (int L = vb; L < nbig; L += G) {
        const int m0 = (1 + L / 12) * 256, tn = L % 12, n0 = tn * 256;
        if (tn >= 4 && tn < 8) {
          gemm_tile<8, false>(shm, 16, [=](int r) { return (const bf16_t*)(hb + (size_t)(m0 + r) * DM); },
            [=](int cidx) { return Wt + (size_t)(n0 + cidx) * 1024; }, KOff64(), KOff64(),
            [=](int row0, int col, f32x4 v) { epi_vt(m0 + row0, n0 + col, v); });
        } else {
          gemm_tile<8, true>(shm, 16, [=](int r) { return (const bf16_t*)(hb + (size_t)(m0 + r) * DM); },
            [=](int cidx) { return Wt + (size_t)(n0 + cidx) * 1024; }, KOff64(), KOff64(),
            [=](int row, int col0, const f32x4 (&a)[4]) { epi_nat(m0 + row, n0 + col0, a); });
        }
      }
      const int s = (vb - (nbig % G) + G) % G;
      if (s < 48) {
        const int m0 = (s / 12) * 64, tn = s % 12, n0 = tn * 256;
        if (tn >= 4 && tn < 8) {
          gemm_tile<2, false>(shm, 16, [=](int r) { return (const bf16_t*)(hb + (size_t)(m0 + r) * DM); },
            [=](int cidx) { return Wt + (size_t)(n0 + cidx) * 1024; }, KOff64(), KOff64(),
            [=](int row0, int col, f32x4 v) { epi_vt(m0 + row0, n0 + col, v); });
        } else {
          gemm_tile<2, true>(shm, 16, [=](int r) { return (const bf16_t*)(hb + (size_t)(m0 + r) * DM); },
            [=](int cidx) { return Wt + (size_t)(n0 + cidx) * 1024; }, KOff64(), KOff64(),
            [=](int row, int col0, const f32x4 (&a)[4]) { epi_nat(m0 + row, n0 + col0, a); });
        }
      }
      const int lane = tid & 63;
      for (int t = blockIdx.x * (NT / 64) + (tid >> 6); t < T_ALL; t += G * (NT / 64)) {
        float a16[16];
#pragma unroll
        for (int j = 0; j < 16; ++j) a16[j] = 0.f;
        for (int k = lane; k < 1024; k += 64) {
          const float hv = bf2f(hb[(size_t)t * DM + k]);
#pragma unroll
          for (int q = 0; q < 4; ++q) {
            const float4 w4 = *(const float4*)&w_in[(size_t)k * 3088 + 3072 + q * 4];
            a16[q * 4 + 0] += hv * w4.x; a16[q * 4 + 1] += hv * w4.y; a16[q * 4 + 2] += hv * w4.z; a16[q * 4 + 3] += hv * w4.w;
          }
        }
#pragma unroll
        for (int j = 0; j < 16; ++j) a16[j] = wave_sum(a16[j]);
        if (lane == 0) {
#pragma unroll
          for (int j = 0; j < 16; ++j) gpre[(size_t)t * 16 + j] = a16[j];
        }
      }
    }
    xcd_barrier(xbar);
    {
      float* s_bc = smem;
      float* s_w  = smem + 1024;
      float* s_k  = smem + 2048;
      const int wv = tid >> 6, lane = tid & 63;
      for (int n = blockIdx.x; n < NCH; n += G) {
        {
          const int dh = wv, d = dh >> 2, hd = dh & 3;
          const int p0 = 2 * lane, p1 = p0 + 1;
          const int t0 = n * 128 + (d == 0 ? p0 : 127 - p0), t1 = n * 128 + (d == 0 ? p1 : 127 - p1);
          const float li0 = gpre[(size_t)t0 * 16 + d * 8 + hd] + gb[d * 8 + hd];
          const float li1 = gpre[(size_t)t1 * 16 + d * 8 + hd] + gb[d * 8 + hd];
          const float lf0 = logsig_f(gpre[(size_t)t0 * 16 + d * 8 + 4 + hd] + gb[d * 8 + 4 + hd]);
          const float lf1 = logsig_f(gpre[(size_t)t1 * 16 + d * 8 + 4 + hd] + gb[d * 8 + 4 + hd]);
          float run = lf0 + lf1;
#pragma unroll
          for (int o = 1; o < 64; o <<= 1) { const float y = __shfl_up(run, o); if (lane >= o) run += y; }
          const float b1 = run, b0 = run - lf1;
          const float g = __shfl(run, 63);
          bc[(size_t)dh * T_ALL + t0] = expf(b0); bc[(size_t)dh * T_ALL + t1] = expf(b1);
          li[(size_t)dh * T_ALL + t0] = expf(li0 - b0); li[(size_t)dh * T_ALL + t1] = expf(li1 - b1);
          s_bc[dh * 128 + (t0 & 127)] = b0; s_bc[dh * 128 + (t1 & 127)] = b1;
          s_w[dh * 128 + (t0 & 127)] = expf(g - b0 + li0); s_w[dh * 128 + (t1 & 127)] = expf(g - b1 + li1);
          if (lane == 0) egch[dh * NCH + n] = expf(g);
        }
        __syncthreads();
        const int lo = n < 2 ? 0 : T_CTX, hi = n < 2 ? T_CTX : T_ALL;
        for (int idx = tid; idx < 128 * 64; idx += NT) {
          const int tl = idx >> 6, c0 = (idx & 63) * 8, t = n * 128 + tl, hd = c0 >> 7;
          float q[8];
#pragma unroll
          for (int e = 0; e < 8; ++e) q[e] = cb[c0 + e];
#pragma unroll
          for (int j = 0; j < 4; ++j) {
            const int tt = t + j - 2;
            if (tt >= lo && tt < hi) {
              const uint4 z = *(const uint4*)&ZQK[(size_t)tt * 1024 + c0];
              const float4 w0 = *(const float4*)&cw[j * 1024 + c0], w1 = *(const float4*)&cw[j * 1024 + c0 + 4];
              q[0] += lo2f(z.x) * w0.x; q[1] += hi2f(z.x) * w0.y; q[2] += lo2f(z.y) * w0.z; q[3] += hi2f(z.y) * w0.w;
              q[4] += lo2f(z.z) * w1.x; q[5] += hi2f(z.z) * w1.y; q[6] += lo2f(z.w) * w1.z; q[7] += hi2f(z.w) * w1.w;
            }
          }
#pragma unroll
          for (int e = 0; e < 8; ++e) q[e] = silu_f(q[e]) * 0.08838834764831845f;
          uint4 o; o.x = pack2(q[0], q[1]); o.y = pack2(q[2], q[3]); o.z = pack2(q[4], q[5]); o.w = pack2(q[6], q[7]);
          *(uint4*)&Qn[(size_t)t * 512 + c0] = o;
#pragma unroll
          for (int d = 0; d < 2; ++d) {
            const int dh = d * 4 + hd;
            const float eb = expf(s_bc[dh * 128 + tl]);
            uint4 o2; o2.x = pack2(q[0] * eb, q[1] * eb); o2.y = pack2(q[2] * eb, q[3] * eb); o2.z = pack2(q[4] * eb, q[5] * eb); o2.w = pack2(q[6] * eb, q[7] * eb);
            *(uint4*)&AS[((size_t)dh * T_ALL + t) * 256 + 128 + (c0 & 127)] = o2;
          }
        }
        for (int hd = 0; hd < 4; ++hd) {
          for (int idx = tid; idx < 128 * 16; idx += NT) {
            const int tl = idx >> 4, k0 = (idx & 15) * 8, t = n * 128 + tl, c0 = 512 + hd * 128 + k0;
            float q[8];
#pragma unroll
            for (int e = 0; e < 8; ++e) q[e] = cb[c0 + e];
#pragma unroll
            for (int j = 0; j < 4; ++j) {
              const int tt = t + j - 2;
              if (tt >= lo && tt < hi) {
                const uint4 z = *(const uint4*)&ZQK[(size_t)tt * 1024 + c0];
                const float4 w0 = *(const float4*)&cw[j * 1024 + c0], w1 = *(const float4*)&cw[j * 1024 + c0 + 4];
                q[0] += lo2f(z.x) * w0.x; q[1] += hi2f(z.x) * w0.y; q[2] += lo2f(z.y) * w0.z; q[3] += hi2f(z.y) * w0.w;
                q[4] += lo2f(z.z) * w1.x; q[5] += hi2f(z.z) * w1.y; q[6] += lo2f(z.w) * w1.z; q[7] += hi2f(z.w) * w1.w;
              }
            }
#pragma unroll
            for (int e = 0; e < 8; ++e) { q[e] = silu_f(q[e]); s_k[tl * 129 + k0 + e] = q[e]; }
            uint4 o; o.x = pack2(q[0], q[1]); o.y = pack2(q[2], q[3]); o.z = pack2(q[4], q[5]); o.w = pack2(q[6], q[7]);
            *(uint4*)&Kn[(size_t)t * 512 + hd * 128 + k0] = o;
          }
          __syncthreads();
          for (int idx = tid; idx < 2 * 128 * 16; idx += NT) {
            const int d = idx >> 11, rem = idx & 2047, kk = rem >> 4, s0 = (rem & 15) * 8, dh = d * 4 + hd;
            float v8[8];
#pragma unroll
            for (int e = 0; e < 8; ++e) v8[e] = s_w[dh * 128 + s0 + e] * s_k[(s0 + e) * 129 + kk];
            uint4 o; o.x = pack2(v8[0], v8[1]); o.y = pack2(v8[2], v8[3]); o.z = pack2(v8[4], v8[5]); o.w = pack2(v8[6], v8[7]);
            *(uint4*)&KwT[((size_t)dh * T_ALL + n * 128 + kk) * 128 + s0] = o;
          }
          if (tid < 256) {
            const int d = tid >> 7, kk = tid & 127, dh = d * 4 + hd;
            float a = 0.f;
            for (int s2 = 0; s2 < 128; ++s2) a += s_w[dh * 128 + s2] * s_k[s2 * 129 + kk];
            nloc[(dh * NCH + n) * 128 + kk] = a;
          }
          __syncthreads();
        }
      }
    }
    xcd_barrier(xbar);
    for (int L = vb; L < 1040 + 520; L += G) {
      if (L < 1040) {
        const int dh = L / NCH, n = L - dh * NCH, hd = dh & 3;
        const bf16_t* a0 = KwT + ((size_t)dh * T_ALL + n * 128) * 128;
        const bf16_t* b0 = VT + ((size_t)n * 1024 + hd * 256) * 128;
        float* co = Cloc + (size_t)(dh * NCH + n) * 32768;
        gemm_tile<4, false>(shm, 2, [=](int r) { return a0 + (size_t)r * 128; }, [=](int cidx) { return b0 + (size_t)cidx * 128; },
          KOff64(), KOff64(),
          [=](int row0, int col, f32x4 v) { *(float4*)&co[(size_t)col * 128 + row0] = make_float4(v[0], v[1], v[2], v[3]); });
      } else {
        const int q = L - 1040, hd = q / NCH, n = q - hd * NCH;
        const bf16_t* a0 = Qn + (size_t)(n * 128) * 512 + hd * 128;
        const bf16_t* b0 = Kn + (size_t)(n * 128) * 512 + hd * 128;
        gemm_tile<4, true>(shm, 2, [=](int r) { return a0 + (size_t)r * 512; },
          [=](int cidx) { return cidx < 128 ? b0 + (size_t)cidx * 512 : zrow; }, KOff64(), KOff64(),
          [=](int row, int col0, const f32x4 (&a)[4]) {
            if (col0 < 128) {
              const int tt = n * 128 + row;
#pragma unroll
              for (int d = 0; d < 2; ++d) {
                const int dh = d * 4 + hd;
                const float bt = bc[(size_t)dh * T_ALL + tt];
                const float* cf = li + (size_t)dh * T_ALL + n * 128 + col0;
                f32x4 o[4];
#pragma unroll
                for (int nn = 0; nn < 4; ++nn) {
                  const float4 c4 = *(const float4*)(cf + nn * 4);
                  const float cv[4] = {c4.x, c4.y, c4.z, c4.w};
#pragma unroll
                  for (int j = 0; j < 4; ++j) {
                    const int sc = col0 + nn * 4 + j;
                    const bool ok = (d == 0) ? (sc <= row) : (sc >= row);
                    o[nn][j] = ok ? a[nn][j] * bt * cv[j] : 0.f;
                  }
                }
                st16bf(AS + ((size_t)dh * T_ALL + tt) * 256 + col0, o);
              }
            }
          });
      }
    }
    xcd_barrier(xbar);
    for (int idx = gtid; idx < 8 * (32768 + 128); idx += gstride) {
      const int dh = idx / 32896, e = idx - dh * 32896, d = dh >> 2;
      float st = 0.f;
      if (e < 32768) {
        for (int ib = 0; ib < NCH; ib += 10) {
          float xv[10], gv[10];
#pragma unroll
          for (int u = 0; u < 10; ++u) { const int n = scan_order(d, ib + u); xv[u] = Cloc[(size_t)(dh * NCH + n) * 32768 + e]; gv[u] = egch[dh * NCH + n]; }
#pragma unroll
          for (int u = 0; u < 10; ++u) { const int n = scan_order(d, ib + u); CinT[(size_t)(dh * NCH + n) * 32768 + e] = f2bf(st); st = gv[u] * st + xv[u]; }
        }
      } else {
        const int kk = e - 32768;
        for (int i = 0; i < NCH; ++i) {
          const int n = scan_order(d, i);
          nin[(dh * NCH + n) * 128 + kk] = st;
          st = egch[dh * NCH + n] * st + nloc[(dh * NCH + n) * 128 + kk];
        }
      }
    }
    xcd_barrier(xbar);
    for (int L = vb; L < 1040; L += G) {
      const int dh = L / NCH, n = L - dh * NCH, hd = dh & 3;
      const bf16_t* a0 = AS + ((size_t)dh * T_ALL + n * 128) * 256;
      const bf16_t* b0 = VT + ((size_t)n * 1024 + hd * 256) * 128;
      const int delta = (int)((CinT + (size_t)(dh * NCH + n) * 32768) - b0);
      float* ho = hnum + ((size_t)dh * T_ALL + n * 128) * 256;
      gemm_tile<4, true>(shm, 4, [=](int r) { return a0 + (size_t)r * 256; }, [=](int cidx) { return b0 + (size_t)cidx * 128; },
        KOff64(), [=](int kt) { return kt < 2 ? kt * 64 : delta + (kt - 2) * 64; },
        [=](int row, int col0, const f32x4 (&a)[4]) {
          float* p = ho + (size_t)row * 256 + col0;
#pragma unroll
          for (int nn = 0; nn < 4; ++nn) *(float4*)(p + nn * 4) = make_float4(a[nn][0], a[nn][1], a[nn][2], a[nn][3]);
        });
    }
    xcd_barrier(xbar);
    {
      const int lane = tid & 63;
      for (int it = blockIdx.x * (NT / 64) + (tid >> 6); it < T_ALL * 4; it += G * (NT / 64)) {
        const int tt = it >> 2, hd = it & 3, n = tt >> 7;
        float hs[4] = {0.f, 0.f, 0.f, 0.f};
#pragma unroll
        for (int d = 0; d < 2; ++d) {
          const int dh = d * 4 + hd;
          const size_t m = (size_t)dh * T_ALL + tt;
          const uint2 av = *(const uint2*)&AS[m * 256 + lane * 4];
          float part;
          if (lane < 32) part = lo2f(av.x) + hi2f(av.x) + lo2f(av.y) + hi2f(av.y);
          else {
            const float4 nv = *(const float4*)&nin[(dh * NCH + n) * 128 + (lane - 32) * 4];
            part = lo2f(av.x) * nv.x + hi2f(av.x) * nv.y + lo2f(av.y) * nv.z + hi2f(av.y) * nv.w;
          }
          const float den = wave_sum(part);
          const float dn = 1.f / fmaxf(fabsf(den), 1.f);
          const float4 x = *(const float4*)&hnum[m * 256 + lane * 4];
          hs[0] += x.x * dn; hs[1] += x.y * dn; hs[2] += x.z * dn; hs[3] += x.w * dn;
        }
        float ss = hs[0] * hs[0] + hs[1] * hs[1] + hs[2] * hs[2] + hs[3] * hs[3];
        ss = wave_sum(ss);
        const float r = 1.f / sqrtf(ss * (1.f / 256.f) + EPSN);
        const int col = hd * 256 + lane * 4;
        const uint2 ov = *(const uint2*)&ZO[(size_t)tt * 1024 + col];
        const float4 g4 = *(const float4*)&ng[col];
        uint2 o;
        o.x = pack2(hs[0] * r * g4.x * sigmoid_f(lo2f(ov.x)), hs[1] * r * g4.y * sigmoid_f(hi2f(ov.x)));
        o.y = pack2(hs[2] * r * g4.z * sigmoid_f(lo2f(ov.y)), hs[3] * r * g4.w * sigmoid_f(hi2f(ov.y)));
        *(uint2*)&A2[(size_t)tt * 1024 + col] = o;
      }
    }
    xcd_barrier(xbar);
    const bf16_t* Wo = (const bf16_t*)(ws + W_MLOUT);
    auto epi_out = [=](int grow, int gcol0, const f32x4 (&a)[4]) { resid_epi(1, grow, gcol0, a); };
    DENSE_PHASE(A2, 1024, Wo, 1024, 4, 16, true, epi_out);
    xcd_barrier(xbar);
  }
  moe_layer(1, 0);

  {
    norm_phase(P, 0, P.in[6] + 2 * 1024, 2, 0, 1, 0, false, false, 0);
    xcd_barrier(xbar);
    bf16_t* Zg = (bf16_t*)(R + R2_ZG); bf16_t* Zx = (bf16_t*)(R + R2_ZX); bf16_t* xc = (bf16_t*)(R + R2_XC);
    bf16_t* LA = (bf16_t*)(R + R2_LA); bf16_t* U = (bf16_t*)(R + R2_U);
    float* cA = (float*)(R + R2_CA); float* cH = (float*)(R + R2_CH);
    float* cin = (float*)(R + R2_CIN); bf16_t* A3 = (bf16_t*)(R + R2_ZX);
    const float* cw = P.in[28]; const float* cb = P.in[29];
    const float* b_a = P.in[31]; const float* b_x = P.in[33];
    const float* SP = (const float*)(ws + W_SP);
    const bf16_t* Wt = (const bf16_t*)(ws + W_LRUIN);
    auto epi_in = [=](int grow, int gcol0, const f32x4 (&a)[4]) {
      if (gcol0 < 1280) {
        f32x4 bq[4];
#pragma unroll
        for (int n = 0; n < 4; ++n)
#pragma unroll
          for (int j = 0; j < 4; ++j) bq[n][j] = gelu_f(a[n][j]);
        st16bf(Zg + (size_t)grow * 1280 + gcol0, bq);
      } else st16bf(Zx + (size_t)grow * 1280 + gcol0 - 1280, a);
    };
    DENSE_PHASE(hb, 1024, Wt, 1024, 10, 16, true, epi_in);
    xcd_barrier(xbar);
    for (int idx = gtid; idx < T_ALL * 160; idx += gstride) {
      const int t = idx / 160, c0 = (idx - t * 160) * 8;
      const int lo = t < T_CTX ? 0 : T_CTX, hi = t < T_CTX ? T_CTX : T_ALL;
      float q[8];
#pragma unroll
      for (int e = 0; e < 8; ++e) q[e] = cb[c0 + e];
#pragma unroll
      for (int j = 0; j < 4; ++j) {
        const int tt = t + j - 2;
        if (tt >= lo && tt < hi) {
          const uint4 z = *(const uint4*)&Zx[(size_t)tt * 1280 + c0];
          const float4 w0 = *(const float4*)&cw[j * 1280 + c0], w1 = *(const float4*)&cw[j * 1280 + c0 + 4];
          q[0] += lo2f(z.x) * w0.x; q[1] += hi2f(z.x) * w0.y; q[2] += lo2f(z.y) * w0.z; q[3] += hi2f(z.y) * w0.w;
          q[4] += lo2f(z.z) * w1.x; q[5] += hi2f(z.z) * w1.y; q[6] += lo2f(z.w) * w1.z; q[7] += hi2f(z.w) * w1.w;
        }
      }
      uint4 o; o.x = pack2(q[0], q[1]); o.y = pack2(q[2], q[3]); o.z = pack2(q[4], q[5]); o.w = pack2(q[6], q[7]);
      *(uint4*)&xc[(size_t)t * 1280 + c0] = o;
    }
    xcd_barrier(xbar);
    {
      const bf16_t* WLG = (const bf16_t*)(ws + W_LRUG);
      for (int L = vb; L < 65 * 20; L += G) {
        const int m0 = (L / 20) * 256, q = L % 20, nb = q >> 1, d = q & 1;
        const bf16_t* a0 = xc + (size_t)m0 * 1280 + nb * 128;
        const bf16_t* b0 = WLG + (size_t)q * 256 * 128;
        gemm_tile<8, true>(shm, 2, [=](int r) { return a0 + (size_t)r * 1280; }, [=](int cidx) { return b0 + (size_t)cidx * 128; },
          KOff64(), KOff64(),
          [=](int row, int col0, const f32x4 (&a)[4]) {
            const int t = m0 + row, c = nb * 128 + (col0 >> 1);
            const uint4 xv = *(const uint4*)&xc[(size_t)t * 1280 + c];
            const unsigned xx[4] = {xv.x, xv.y, xv.z, xv.w};
            float la8[8], u8[8];
#pragma unroll
            for (int e = 0; e < 8; ++e) {
              const float ra = a[e >> 2][e & 3] + b_a[d * 1280 + c + e];
              const float rx = a[2 + (e >> 2)][e & 3] + b_x[d * 1280 + c + e];
              const float la = -8.f * sigmoid_f(ra) * SP[d * 1280 + c + e];
              const float xe = (e & 1) ? hi2f(xx[e >> 1]) : lo2f(xx[e >> 1]);
              la8[e] = la;
              u8[e] = sqrtf(-expm1f(2.f * la)) * (sigmoid_f(rx) * xe);
            }
            uint4 o1, o2;
            o1.x = pack2(la8[0], la8[1]); o1.y = pack2(la8[2], la8[3]); o1.z = pack2(la8[4], la8[5]); o1.w = pack2(la8[6], la8[7]);
            o2.x = pack2(u8[0], u8[1]); o2.y = pack2(u8[2], u8[3]); o2.z = pack2(u8[4], u8[5]); o2.w = pack2(u8[6], u8[7]);
            *(uint4*)&LA[((size_t)d * T_ALL + t) * 1280 + c] = o1;
            *(uint4*)&U[((size_t)d * T_ALL + t) * 1280 + c] = o2;
          });
      }
    }
    xcd_barrier(xbar);
    for (int idx = gtid; idx < 2 * NCH * 1280; idx += gstride) {
      const int c = idx % 1280, dn = idx / 1280, n = dn % NCH, d = dn / NCH;
      float h = 0.f, sl = 0.f;
      for (int sb = 0; sb < 128; sb += 16) {
        float lv[16], uv[16];
#pragma unroll
        for (int e = 0; e < 16; ++e) {
          const int tt = n * 128 + (d == 0 ? sb + e : 127 - sb - e);
          lv[e] = bf2f(LA[((size_t)d * T_ALL + tt) * 1280 + c]); uv[e] = bf2f(U[((size_t)d * T_ALL + tt) * 1280 + c]);
        }
#pragma unroll
        for (int e = 0; e < 16; ++e) { h = __expf(lv[e]) * h + uv[e]; sl += lv[e]; }
      }
      cA[idx] = __expf(sl);
      cH[idx] = h;
    }
    xcd_barrier(xbar);
    for (int idx = gtid; idx < 2 * 1280; idx += gstride) {
      const int d = idx / 1280, c = idx - d * 1280;
      float st = 0.f;
      for (int i = 0; i < NCH; ++i) {
        const int n = scan_order(d, i);
        const int q = (d * NCH + n) * 1280 + c;
        cin[q] = st;
        st = cA[q] * st + cH[q];
      }
    }
    xcd_barrier(xbar);
    for (int idx = gtid; idx < 128 * 1280; idx += gstride) {
      const int c = idx % 1280, n = 2 + idx / 1280;
      float h = cin[(0 * NCH + n) * 1280 + c];
      for (int sb = 0; sb < 128; sb += 16) {
        float lv[16], uv[16];
#pragma unroll
        for (int e = 0; e < 16; ++e) { const size_t o = ((size_t)(n * 128 + sb + e)) * 1280 + c; lv[e] = bf2f(LA[o]); uv[e] = bf2f(U[o]); }
#pragma unroll
        for (int e = 0; e < 16; ++e) { h = __expf(lv[e]) * h + uv[e]; A3[((size_t)(n * 128 + sb + e)) * 1280 + c] = f2bf(h); }
      }
      h = cin[(1 * NCH + n) * 1280 + c];
      for (int sb = 0; sb < 128; sb += 16) {
        float lv[16], uv[16], gv[16], h0[16];
#pragma unroll
        for (int e = 0; e < 16; ++e) {
          const size_t o = ((size_t)(n * 128 + 127 - sb - e)) * 1280 + c;
          lv[e] = bf2f(LA[(size_t)T_ALL * 1280 + o]); uv[e] = bf2f(U[(size_t)T_ALL * 1280 + o]); gv[e] = bf2f(Zg[o]); h0[e] = bf2f(A3[o]);
        }
#pragma unroll
        for (int e = 0; e < 16; ++e) {
          h = __expf(lv[e]) * h + uv[e];
          A3[((size_t)(n * 128 + 127 - sb - e)) * 1280 + c] = f2bf(gv[e] * (h0[e] + h));
        }
      }
    }
    xcd_barrier(xbar);
    const bf16_t* Wo = (const bf16_t*)(ws + W_LRUOUT);
    auto epi_out = [=](int grow, int gcol0, const f32x4 (&a)[4]) { resid_epi(2, grow, gcol0, a); };
    DENSE_PHASE(A3, 1280, Wo, 1280, 4, 20, false, epi_out);
    xcd_barrier(xbar);
  }
  moe_layer(2, T_CTX);

  {
    norm_phase(P, T_CTX, P.in[6] + 3 * 1024, 3, 0, 2, T_CTX, false, false, 0);
    xcd_barrier(xbar);
    bf16_t* YT = (bf16_t*)(R + R3_YT); bf16_t* GT = (bf16_t*)(R + R3_GT); bf16_t* Ff = (bf16_t*)(R + R3_FF);
    const bf16_t* WP = (const bf16_t*)(ws + W_FNP);
    for (int L = vb; L < 64 * 8; L += G) {
      const int tm = L >> 3, n0 = (L & 7) * 256;
      gemm_tile<8, false>(shm, 16,
        [=](int r) { return (const bf16_t*)(hb + (size_t)(T_CTX + 128 * (r & 127) + 2 * tm + (r >> 7)) * DM); },
        [=](int cidx) { return WP + (size_t)(n0 + cidx) * 1024; }, KOff64(), KOff64(),
        [=](int row0, int col, f32x4 v) {
          const int b = 2 * tm + (row0 >> 7), a0 = row0 & 127;
          uint2 o; o.x = pack2(v[0], v[1]); o.y = pack2(v[2], v[3]);
          *(uint2*)&YT[((size_t)b * 2048 + n0 + col) * 128 + a0] = o;
        });
    }
    xcd_barrier(xbar);
    {
      const bf16_t* DA = (const bf16_t*)(ws + W_DA);
      for (int colc = vb; colc < 1024; colc += G) {
        gemm_tile<4, false>(shm, 4,
          [=](int r) { return (const bf16_t*)(YT + ((size_t)r * 2048 + colc) * 128); },
          [=](int cidx) { return DA + (size_t)cidx * 256; },
          [=](int kt) { return kt < 2 ? kt * 64 : 1024 * 128 + (kt - 2) * 64; }, KOff64(),
          [=](int row0, int col, f32x4 v) {
            const int ri = col >> 7, c2 = col & 127;
            uint2 o; o.x = pack2(v[0], v[1]); o.y = pack2(v[2], v[3]);
            *(uint2*)&GT[(((size_t)c2 * 1024 + colc) * 2 + ri) * 128 + row0] = o;
          });
      }
    }
    xcd_barrier(xbar);
    {
      const bf16_t* TW = (const bf16_t*)(ws + W_TW);
      for (int L = vb; L < 128 * 4; L += G) {
        const int c2 = L >> 2, n0 = (L & 3) * 256;
        gemm_tile<4, true>(shm, 4,
          [=](int r) { return TW + ((size_t)c2 * 128 + r) * 256; },
          [=](int cidx) { return (const bf16_t*)(GT + ((size_t)c2 * 1024 + n0 + cidx) * 256); }, KOff64(), KOff64(),
          [=](int row, int col0, const f32x4 (&a)[4]) {
            f32x4 b[4];
#pragma unroll
            for (int n = 0; n < 4; ++n) b[n] = a[n] * (1.f / 2048.f);
            st16bf(Ff + (size_t)(c2 + 128 * row) * 1024 + n0 + col0, b);
          });
      }
    }
    xcd_barrier(xbar);
    const bf16_t* Wo = (const bf16_t*)(ws + W_FNOUT);
    const bf16_t* FfA = Ff - (size_t)T_CTX * 1024;
    auto epi_out = [=](int grow, int gcol0, const f32x4 (&a)[4]) { resid_epi(3, grow, gcol0, a); };
    DENSE_PHASE(FfA, 1024, Wo, 1024, 4, 16, false, epi_out);
    xcd_barrier(xbar);
  }
  moe_layer(3, T_CTX);

  norm_phase(P, T_CTX, P.in[8], 0, -1, 3, T_CTX, true, false, 0);
}

extern "C" void kernel_launch(void* const* d_in, const int* in_sizes, int n_in, void* d_out, int out_size,
                              void* d_ws, size_t ws_size, hipStream_t stream) {
  static int grid_blocks = 0;
  if (!grid_blocks) {
    int dev = 0, cus = 0, per_cu = 0;
    (void)hipGetDevice(&dev);
    (void)hipDeviceGetAttribute(&cus, hipDeviceAttributeMultiprocessorCount, dev);
    (void)hipOccupancyMaxActiveBlocksPerMultiprocessor(&per_cu, mega, NT, 0);
    if (per_cu < 1) fprintf(stderr, "kernel_launch: occupancy query says %d blocks/CU\n", per_cu);
    grid_blocks = cus;
    if (ws_size < WS_NEED) fprintf(stderr, "kernel_launch: workspace too small: %zu < %zu\n", ws_size, (size_t)WS_NEED);
  }
  if (n_in != 38 || ws_size < WS_NEED) return;
  Params p{};
  for (int i = 0; i < 38; ++i) p.in[i] = (const float*)d_in[i];
  p.out = (float*)d_out;
  p.ws = (unsigned char*)d_ws;
  (void)hipMemsetAsync((char*)d_ws + WS_BAR, 0, 16384, stream);
  void* args[] = {&p};
  hipError_t e = hipLaunchCooperativeKernel((void*)mega, dim3(grid_blocks), dim3(NT), args, 0, stream);
  if (e != hipSuccess) fprintf(stderr, "cooperative launch failed: %s (grid %d)\n", hipGetErrorString(e), grid_blocks);
}
```

```cpp
#include <hip/hip_runtime.h>
#include <hip/hip_cooperative_groups.h>
#include <cstdio>
namespace cg = cooperative_groups;

#define T_ALL 16640
#define T_LAT 16384
#define T_CTX 256
#define DM 1024
#define NCH 130
#define EPSN 1e-6f
#define NT 512

typedef unsigned short bf16_t;
using bf16x8 = __attribute__((ext_vector_type(8))) short;
using f32x4 = __attribute__((ext_vector_type(4))) float;

__device__ __forceinline__ float bf2f(bf16_t v) { return __uint_as_float(((unsigned)v) << 16); }
__device__ __forceinline__ bf16_t f2bf(float f) { unsigned u = __float_as_uint(f); u += 0x7fffu + ((u >> 16) & 1u); return (bf16_t)(u >> 16); }
__device__ __forceinline__ unsigned pack2(float a, float b) { return (unsigned)f2bf(a) | (((unsigned)f2bf(b)) << 16); }
__device__ __forceinline__ float lo2f(unsigned u) { return __uint_as_float(u << 16); }
__device__ __forceinline__ float hi2f(unsigned u) { return __uint_as_float(u & 0xffff0000u); }

__device__ __forceinline__ int opaque_tid() { int t = threadIdx.x; asm volatile("" : "+v"(t)); return t; }

constexpr size_t AL(size_t x) { return (x + 255) & ~(size_t)255; }
constexpr size_t WS_MOD    = 0;
constexpr size_t WS_MODP   = AL(WS_MOD + 4 * 2 * 6144 * 4);
constexpr size_t WS_CNT    = AL(WS_MODP + 16 * 4 * 2 * 6144 * 4);
constexpr size_t WS_ZROW   = AL(WS_CNT + 4 * 32 * 32 * 4 + 256);
constexpr size_t WS_BAR    = AL(WS_ZROW + 8192);
constexpr size_t WS_TOK    = AL(WS_BAR + 16384);
constexpr size_t WS_H      = AL(WS_TOK + (size_t)T_ALL * DM * 4);
constexpr size_t WS_HLO    = AL(WS_H + (size_t)T_ALL * DM * 2);
constexpr size_t WS_ASGW   = AL(WS_HLO + (size_t)T_ALL * DM * 2);
constexpr size_t WS_LIST   = AL(WS_ASGW + 33280 * 4);
constexpr size_t WS_ROWTOK = AL(WS_LIST + (size_t)32 * 33280 * 4);
constexpr size_t WS_ROWEXP = AL(WS_ROWTOK + 37376 * 4);
constexpr size_t W_CMIN   = AL(WS_ROWEXP + 292 * 4);
constexpr size_t W_CMOUT  = AL(W_CMIN + (size_t)2048 * 1024 * 2);
constexpr size_t W_MLIN   = AL(W_CMOUT + (size_t)1024 * 1024 * 2);
constexpr size_t W_MLOUT  = AL(W_MLIN + (size_t)3072 * 1024 * 2);
constexpr size_t W_LRUIN  = AL(W_MLOUT + (size_t)1024 * 1024 * 2);
constexpr size_t W_LRUOUT = AL(W_LRUIN + (size_t)2560 * 1024 * 2);
constexpr size_t W_FNIN   = AL(W_LRUOUT + (size_t)1024 * 1280 * 2);
constexpr size_t W_FNP    = AL(W_FNIN + (size_t)1024 * 1024 * 2);
constexpr size_t W_FNOUT  = AL(W_FNP + (size_t)2048 * 1024 * 2);
constexpr size_t W_DC     = AL(W_FNOUT + (size_t)1024 * 1024 * 2);
constexpr size_t W_DA     = AL(W_DC + 512 * 256 * 2);
constexpr size_t W_TW     = AL(W_DA + 256 * 256 * 2);
constexpr size_t W_LRUG   = AL(W_TW + (size_t)128 * 128 * 256 * 2);
constexpr size_t W_SP     = AL(W_LRUG + (size_t)20 * 256 * 128 * 2);
constexpr size_t W_RT     = AL(W_SP + 2 * 1280 * 4);
constexpr size_t W_EGU    = AL(W_RT + (size_t)4 * 64 * 3072 * 2);
constexpr size_t W_ED     = AL(W_EGU + (size_t)128 * 1024 * 1024 * 2);
constexpr size_t WS_R     = AL(W_ED + (size_t)128 * 1024 * 512 * 2);
constexpr size_t R_YBUF = 0;
constexpr size_t R_HB   = AL(R_YBUF + (size_t)33280 * 1024 * 2);
constexpr size_t R_MOE_END = AL(R_HB + (size_t)37376 * 512 * 2);
constexpr size_t R0_ZU  = 0;
constexpr size_t R0_ZVT = AL(R0_ZU + (size_t)T_ALL * 1024 * 2);
constexpr size_t R0_P   = AL(R0_ZVT + (size_t)T_ALL * 1024 * 2);
constexpr size_t R0_WSC = AL(R0_P + (size_t)T_ALL * 1024 * 2);
constexpr size_t R0_END = AL(R0_WSC + (size_t)NCH * 4 * 128 * 128 * 2);
constexpr size_t R1_ZQK  = 0;
constexpr size_t R1_ZO   = AL(R1_ZQK + (size_t)T_ALL * 1024 * 2);
constexpr size_t R1_VT   = AL(R1_ZO + (size_t)T_ALL * 1024 * 2);
constexpr size_t R1_GPRE = AL(R1_VT + (size_t)T_ALL * 1024 * 2);
constexpr size_t R1_QN   = AL(R1_GPRE + (size_t)T_ALL * 16 * 4);
constexpr size_t R1_KN   = AL(R1_QN + (size_t)T_ALL * 512 * 2);
constexpr size_t R1_AS   = AL(R1_KN + (size_t)T_ALL * 512 * 2);
constexpr size_t R1_KWT  = AL(R1_AS + (size_t)8 * T_ALL * 256 * 2);
constexpr size_t R1_BC   = AL(R1_KWT + (size_t)8 * T_ALL * 128 * 2);
constexpr size_t R1_LI   = AL(R1_BC + (size_t)8 * T_ALL * 4);
constexpr size_t R1_GCH  = AL(R1_LI + (size_t)8 * T_ALL * 4);
constexpr size_t R1_NLOC = AL(R1_GCH + 8 * NCH * 4);
constexpr size_t R1_NIN  = AL(R1_NLOC + 8 * NCH * 128 * 4);
constexpr size_t R1_CLOC = AL(R1_NIN + 8 * NCH * 128 * 4);
constexpr size_t R1_CINT = AL(R1_CLOC + (size_t)8 * T_ALL * 256 * 4);
constexpr size_t R1_HDEN = AL(R1_CINT + (size_t)8 * T_ALL * 256 * 2);
constexpr size_t R1_A2   = AL(R1_HDEN + 256);
constexpr size_t R1_END  = AL(R1_A2 + (size_t)T_ALL * 1024 * 2);
constexpr size_t R2_ZG  = 0;
constexpr size_t R2_ZX  = AL(R2_ZG + (size_t)T_ALL * 1280 * 2);
constexpr size_t R2_XC  = AL(R2_ZX + (size_t)T_ALL * 1280 * 2);
constexpr size_t R2_LA  = AL(R2_XC + (size_t)T_ALL * 1280 * 2);
constexpr size_t R2_U   = AL(R2_LA + (size_t)2 * T_ALL * 1280 * 2);
constexpr size_t R2_CA  = AL(R2_U + (size_t)2 * T_ALL * 1280 * 2);
constexpr size_t R2_CH  = AL(R2_CA + 2 * NCH * 1280 * 4);
constexpr size_t R2_CIN = AL(R2_CH + 2 * NCH * 1280 * 4);
constexpr size_t R2_END = AL(R2_CIN + 2 * NCH * 1280 * 4);
constexpr size_t R3_YT = 0;
constexpr size_t R3_GT = AL(R3_YT + (size_t)128 * 2048 * 128 * 2);
constexpr size_t R3_FF = AL(R3_GT + (size_t)128 * 2048 * 128 * 2);
constexpr size_t R3_END = AL(R3_FF + (size_t)T_LAT * 1024 * 2);
constexpr size_t cmax(size_t a, size_t b) { return a > b ? a : b; }
constexpr size_t R_SIZE = cmax(cmax(R_MOE_END, R0_END), cmax(cmax(R1_END, R2_END), R3_END));
constexpr size_t WS_NEED = WS_R + R_SIZE;

struct Params { const float* in[38]; float* out; unsigned char* ws; };

__device__ __forceinline__ float sigmoid_f(float x) { return __frcp_rn(1.f + __expf(-x)); }
__device__ __forceinline__ float silu_f(float x) { return x * __frcp_rn(1.f + __expf(-x)); }
__device__ __forceinline__ float gelu_f(float x) {
  const float u2 = 1.5957691216057308f * (x + 0.044715f * x * x * x);
  return x * __frcp_rn(1.f + __expf(-u2));
}
__device__ __forceinline__ float logsig_f(float x) { return fminf(x, 0.f) - log1pf(expf(-fabsf(x))); }
__device__ __forceinline__ float wave_sum(float v) {
#pragma unroll
  for (int o = 32; o >= 1; o >>= 1) v += __shfl_xor(v, o);
  return v;
}
__device__ __forceinline__ int scan_order(int d, int i) { return d == 0 ? i : (i == 0 ? 1 : (i == 1 ? 0 : 131 - i)); }
__device__ __forceinline__ void st16bf(bf16_t* p, const f32x4 (&a)[4]) {
  uint4 o0, o1;
  o0.x = pack2(a[0][0], a[0][1]); o0.y = pack2(a[0][2], a[0][3]); o0.z = pack2(a[1][0], a[1][1]); o0.w = pack2(a[1][2], a[1][3]);
  o1.x = pack2(a[2][0], a[2][1]); o1.y = pack2(a[2][2], a[2][3]); o1.z = pack2(a[3][0], a[3][1]); o1.w = pack2(a[3][2], a[3][3]);
  *(uint4*)p = o0; *(uint4*)(p + 8) = o1;
}

__device__ __forceinline__ int lds_byte(int r, int c) {
  const int st = (r >> 4) * 2 + (c >> 5), ob = (r & 15) * 64 + (c & 31) * 2;
  return st * 1024 + (ob ^ (((ob >> 9) & 1) << 5));
}
__device__ __forceinline__ void stage_rc(int b, int& R, int& C) {
  const int st = b >> 10, sb = b & 1023, swz = sb ^ (((sb >> 9) & 1) << 5);
  R = (st >> 1) * 16 + (swz >> 6);
  C = (st & 1) * 32 + ((swz & 63) >> 1);
}
__device__ __forceinline__ int perm_col(int p) {
  const int q = p & 63, n = q >> 4, i = q & 15;
  return (p & ~63) + (i >> 2) * 16 + n * 4 + (i & 3);
}

struct KOffL { __device__ __forceinline__ int operator()(int, int kt) const { return kt * 64; } };
#define GEMM_LDS_TOTAL 147456
template <int MI, bool SWAP, class RA, class RB, class KA, class KB, class EP>
__device__ __forceinline__ void gemm_loop(char* shm, int nk, int Lbeg, int Lend, int Lstep, RA rowA, RB rowB, KA koffA, KB koffB, EP epi) {
  constexpr int BM = 32 * MI, GLA = MI / 2, GLB = 4;
  constexpr int TILE_A = BM * 128, TILE_B = 256 * 128, STG = TILE_A + TILE_B;
  constexpr int NBUF = (3 * STG <= GEMM_LDS_TOTAL) ? 3 : 2;
  static_assert(NBUF * STG <= GEMM_LDS_TOTAL, "LDS");
  if (Lbeg >= Lend) return;
  const int tid = opaque_tid(), wid = tid >> 6, lane = tid & 63, wr = wid >> 2, wc = wid & 3, fr = lane & 15, fq = lane >> 4;
  const bf16_t* pa[GLA];
  const bf16_t* pb[GLB];
#define GL_SETP(L_) do { int t2_ = tid; asm volatile("" : "+v"(t2_)); const int w2_ = t2_ >> 6, l2_ = t2_ & 63;        \
    _Pragma("unroll") for (int i = 0; i < GLA; ++i) { int R_, C_; stage_rc(w2_ * 1024 + i * 8192 + l2_ * 16, R_, C_); pa[i] = rowA((L_), R_) + C_; } \
    _Pragma("unroll") for (int i = 0; i < GLB; ++i) { int R_, C_; stage_rc(w2_ * 1024 + i * 8192 + l2_ * 16, R_, C_); pb[i] = rowB((L_), SWAP ? perm_col(R_) : R_) + C_; } } while (0)
#define GL_ISSUE(buf, kt, L_) do { const int ka_ = koffA((L_), (kt)), kb_ = koffB((L_), (kt)); char* base_ = shm + (buf) * STG;  \
    _Pragma("unroll") for (int i = 0; i < GLA; ++i)                                                                    \
      __builtin_amdgcn_global_load_lds((const unsigned*)(pa[i] + ka_), (unsigned*)(base_ + wid * 1024 + i * 8192), 16, 0, 0); \
    _Pragma("unroll") for (int i = 0; i < GLB; ++i)                                                                    \
      __builtin_amdgcn_global_load_lds((const unsigned*)(pb[i] + kb_), (unsigned*)(base_ + TILE_A + wid * 1024 + i * 8192), 16, 0, 0); } while (0)
#define GL_RAWBAR() do { asm volatile("s_waitcnt lgkmcnt(0)" ::: "memory"); __builtin_amdgcn_s_barrier(); } while (0)
  const int npre = nk < NBUF ? nk : NBUF;
  GL_SETP(Lbeg);
  for (int s = 0; s < npre; ++s) GL_ISSUE(s, s, Lbeg);
  for (int L = Lbeg; L < Lend; L += Lstep) {
    f32x4 acc[MI][4];
#pragma unroll
    for (int m = 0; m < MI; ++m)
#pragma unroll
      for (int n = 0; n < 4; ++n) acc[m][n] = f32x4{0.f, 0.f, 0.f, 0.f};
    int cur = 0;
    for (int t = 0; t < nk; ++t) {
      if (NBUF == 3 && t >= 1 && t + 1 < nk) {
        if (GLA + GLB == 6) asm volatile("s_waitcnt vmcnt(6)" ::: "memory"); else asm volatile("s_waitcnt vmcnt(5)" ::: "memory");
      } else asm volatile("s_waitcnt vmcnt(0)" ::: "memory");
      GL_RAWBAR();
      if (t >= 1 && t + NBUF - 1 < nk) { const int nb_ = (cur == 0) ? NBUF - 1 : cur - 1; GL_ISSUE(nb_, t + NBUF - 1, L); }
      const char* sa = shm + cur * STG;
      const char* sb = sa + TILE_A;
#pragma unroll
      for (int ks = 0; ks < 2; ++ks) {
        bf16x8 At[MI], Bf[4];
#pragma unroll
        for (int m = 0; m < MI; ++m) At[m] = *(const bf16x8*)(sa + lds_byte(wr * (MI * 16) + m * 16 + fr, ks * 32 + fq * 8));
#pragma unroll
        for (int n = 0; n < 4; ++n) Bf[n] = *(const bf16x8*)(sb + lds_byte(wc * 64 + n * 16 + fr, ks * 32 + fq * 8));
#pragma unroll
        for (int m = 0; m < MI; ++m)
#pragma unroll
          for (int n = 0; n < 4; ++n) {
            if (SWAP) acc[m][n] = __builtin_amdgcn_mfma_f32_16x16x32_bf16(Bf[n], At[m], acc[m][n], 0, 0, 0);
            else      acc[m][n] = __builtin_amdgcn_mfma_f32_16x16x32_bf16(At[m], Bf[n], acc[m][n], 0, 0, 0);
          }
        __builtin_amdgcn_sched_barrier(0);
      }
      cur = (cur == NBUF - 1) ? 0 : cur + 1;
    }
    GL_RAWBAR();
    const int Ln = L + Lstep;
    if (Ln < Lend) { GL_SETP(Ln); for (int s = 0; s < npre; ++s) GL_ISSUE(s, s, Ln); }
    if constexpr (SWAP) {
#pragma unroll
      for (int m = 0; m < MI; ++m) epi(L, wr * (MI * 16) + m * 16 + fr, wc * 64 + fq * 16, acc[m]);
    } else {
#pragma unroll
      for (int m = 0; m < MI; ++m)
#pragma unroll
        for (int n = 0; n < 4; ++n) epi(L, wr * (MI * 16) + m * 16 + fq * 4, wc * 64 + n * 16 + fr, acc[m][n]);
    }
  }
  asm volatile("s_waitcnt vmcnt(0)" ::: "memory");
#undef GL_SETP
#undef GL_ISSUE
#undef GL_RAWBAR
}

template <class EP>
__device__ __forceinline__ void dense_phase(char* shm, int vb, int G, const bf16_t* A, int lda, const bf16_t* Wt, int ldw,
                                            int ntn, int nk, bool with_ctx, EP epi) {
  const int nbig = 64 * ntn;
  gemm_loop<8, true>(shm, nk, vb, nbig, G,
    [=](int L, int r) { return A + (size_t)((1 + L / ntn) * 256 + r) * lda; },
    [=](int L, int c) { return Wt + (size_t)((L % ntn) * 256 + c) * ldw; }, KOffL(), KOffL(),
    [=](int L, int row, int col0, const f32x4 (&a)[4]) { epi((1 + L / ntn) * 256 + row, (L % ntn) * 256 + col0, a); });
  if (with_ctx) {
    const int s = (vb - (nbig % G) + G) % G;
    gemm_loop<2, true>(shm, nk, s, 4 * ntn, G,
      [=](int L, int r) { return A + (size_t)((L / ntn) * 64 + r) * lda; },
      [=](int L, int c) { return Wt + (size_t)((L % ntn) * 256 + c) * ldw; }, KOffL(), KOffL(),
      [=](int L, int row, int col0, const f32x4 (&a)[4]) { epi((L / ntn) * 64 + row, (L % ntn) * 256 + col0, a); });
  }
}

#define XB_TMO      128
#define XB_XCNT(j)  (256  + 64 * (j))
#define XB_XSUB(j)  (1280 + 64 * (j))
#define XB_XGEN(j)  (2304 + 64 * (j))
#define XB_TOP      3328
#define XB_TOPGEN   3392
#define XCD_BAR_WORDS 3456
#define XB_SPIN_CAP (1u << 22)
#define LAS __attribute__((address_space(3)))
__device__ __forceinline__ unsigned xb_ld(unsigned* p)              { return __hip_atomic_load(p, __ATOMIC_RELAXED, __HIP_MEMORY_SCOPE_AGENT); }
__device__ __forceinline__ unsigned xb_add(unsigned* p, unsigned v) { return __hip_atomic_fetch_add(p, v, __ATOMIC_RELAXED, __HIP_MEMORY_SCOPE_AGENT); }
__device__ __forceinline__ unsigned xb_xcc_id() { return (unsigned)__builtin_amdgcn_s_getreg((3 << 11) | 20) & 0xFu; }
#define XB_SPIN(cond, bar) do { unsigned _sp = 0; while (cond) { __builtin_amdgcn_s_sleep(1); \
    if ((++_sp & 255u) == 0u) { if (xb_ld(&(bar)[XB_TMO])) break; if (_sp > XB_SPIN_CAP) { atomicAdd(&(bar)[XB_TMO], 1u); break; } } } } while (0)
struct XcdBarrier { unsigned* bar; unsigned x; volatile LAS unsigned* st; };
__device__ __forceinline__ XcdBarrier xcd_barrier_post(unsigned* bar, volatile LAS unsigned* st) {
    XcdBarrier b; b.bar = bar; b.x = xb_xcc_id(); b.st = st;
    if (threadIdx.x == 0) (void)xb_add(&bar[XB_XCNT(b.x)], 1u);
    return b;
}
__device__ __forceinline__ void xcd_barrier_complete(unsigned* bar, unsigned x, unsigned& nloc, unsigned& nx) {
    const unsigned G = gridDim.x * gridDim.y * gridDim.z;
    unsigned sum, cnt, mine, sp = 0u;
    for (;;) {
        sum = 0u; cnt = 0u; mine = 0u;
#pragma unroll
        for (unsigned j = 0; j < 16; ++j) { const unsigned c = xb_ld(&bar[XB_XCNT(j)]); sum += c; cnt += (c > 0u) ? 1u : 0u; mine = (j == x) ? c : mine; }
        if (sum == G) break;
        __builtin_amdgcn_s_sleep(1);
        if ((++sp & 255u) == 0u) { if (xb_ld(&bar[XB_TMO])) break; if (sp > XB_SPIN_CAP) { atomicAdd(&bar[XB_TMO], 1u); break; } }
    }
    nloc = mine > 0u ? mine : 1u; nx = cnt > 0u ? cnt : 1u;
}
__device__ __forceinline__ void xcd_barrier(const XcdBarrier& b) {
    asm volatile("s_waitcnt vmcnt(0)" ::: "memory");
    __syncthreads();
    if (threadIdx.x == 0) {
        unsigned* bar = b.bar;
        __builtin_amdgcn_s_waitcnt(0);
        unsigned nloc = b.st[0], nx = b.st[1];
        if (nloc == 0u) { xcd_barrier_complete(bar, b.x, nloc, nx); b.st[0] = nloc; b.st[1] = nx; }
        const unsigned old = xb_add(&bar[XB_XSUB(b.x)], 1u);
        const unsigned gen = old / nloc;
        if (old + 1u == (gen + 1u) * nloc) {
            __builtin_amdgcn_fence(__ATOMIC_RELEASE, "agent");
            asm volatile("s_waitcnt vmcnt(0)" ::: "memory");
            const unsigned og = xb_add(&bar[XB_TOP], 1u);
            const unsigned tg = og / nx;
            if (og + 1u == (tg + 1u) * nx) xb_add(&bar[XB_TOPGEN], 1u);
            else XB_SPIN(xb_ld(&bar[XB_TOPGEN]) == tg, bar);
            __builtin_amdgcn_fence(__ATOMIC_ACQUIRE, "agent");
            xb_add(&bar[XB_XGEN(b.x)], 1u);
            asm volatile("s_waitcnt vmcnt(0)" ::: "memory");
        } else {
            XB_SPIN(xb_ld(&bar[XB_XGEN(b.x)]) == gen, bar);
            __builtin_amdgcn_fence(__ATOMIC_ACQUIRE, "agent");
            asm volatile("s_waitcnt vmcnt(0)" ::: "memory");
        }
    }
    __syncthreads();
}

template <class AF, class BF, class EF>
__device__ __forceinline__ void gemm_naive(int M, int N, int K, AF af, BF bf, EF ef, float* smem_all) {
  const int half = threadIdx.x >> 8, tid = threadIdx.x & 255;
  float* smem = smem_all + half * (2 * 16 * 68);
  const int tilesM = (M + 63) >> 6, tilesN = (N + 63) >> 6;
  const int ntiles = tilesM * tilesN;
  float (*As)[68] = (float (*)[68])smem;
  float (*Bs)[68] = (float (*)[68])(smem + 16 * 68);
  const int ty = tid >> 4, tx = tid & 15;
  const int stride = gridDim.x * 2;
  const int iters = (ntiles + stride - 1) / stride;
  for (int it = 0; it < iters; ++it) {
    const int tile = it * stride + blockIdx.x * 2 + half;
    const bool valid = tile < ntiles;
    const int tm = valid ? tile / tilesN : 0, tn = valid ? tile - tm * tilesN : 0;
    const int m0 = tm << 6, n0 = tn << 6;
    float acc[4][4];
#pragma unroll
    for (int i = 0; i < 4; ++i)
#pragma unroll
      for (int j = 0; j < 4; ++j) acc[i][j] = 0.f;
    for (int k0 = 0; k0 < K; k0 += 16) {
#pragma unroll
      for (int i = 0; i < 4; ++i) {
        const int mm = (tid >> 4) + 16 * i, kk = tid & 15;
        const int m = m0 + mm, k = k0 + kk;
        As[kk][mm] = (valid && m < M && k < K) ? af(m, k, n0) : 0.f;
      }
#pragma unroll
      for (int i = 0; i < 4; ++i) {
        const int kk = (tid >> 6) + 4 * i, nn = tid & 63;
        const int k = k0 + kk, n = n0 + nn;
        Bs[kk][nn] = (valid && k < K && n < N) ? bf(k, n, m0) : 0.f;
      }
      __syncthreads();
#pragma unroll
      for (int kk = 0; kk < 16; ++kk) {
        const float4 a = *(const float4*)&As[kk][ty * 4];
        const float4 b = *(const float4*)&Bs[kk][tx * 4];
        const float av[4] = {a.x, a.y, a.z, a.w};
        const float bv[4] = {b.x, b.y, b.z, b.w};
#pragma unroll
        for (int i = 0; i < 4; ++i)
#pragma unroll
          for (int j = 0; j < 4; ++j) acc[i][j] = fmaf(av[i], bv[j], acc[i][j]);
      }
      __syncthreads();
    }
    if (valid) {
#pragma unroll
      for (int i = 0; i < 4; ++i)
#pragma unroll
        for (int j = 0; j < 4; ++j) {
          const int m = m0 + ty * 4 + i, n = n0 + tx * 4 + j;
          if (m < M && n < N) ef(m, n, acc[i][j]);
        }
    }
  }
}

__device__ __forceinline__ void conv_tile(const float* src, int ldn, bf16_t* dst, int ldk, int k0, int n0, int mapmode, float* sm) {
  const int tid = opaque_tid();
  float (*tl)[65] = (float (*)[65])sm;
  {
    const int row = tid >> 3, c4 = (tid & 7) * 4;
    const float4 a = *(const float4*)&src[(size_t)(k0 + row) * ldn + n0 + c4];
    const float4 b = *(const float4*)&src[(size_t)(k0 + row) * ldn + n0 + 32 + c4];
    tl[row][c4 + 0] = a.x; tl[row][c4 + 1] = a.y; tl[row][c4 + 2] = a.z; tl[row][c4 + 3] = a.w;
    tl[row][32 + c4 + 0] = b.x; tl[row][32 + c4 + 1] = b.y; tl[row][32 + c4 + 2] = b.z; tl[row][32 + c4 + 3] = b.w;
  }
  __syncthreads();
  {
    const int n = tid >> 3, kg = (tid & 7) * 8;
    uint4 o;
    o.x = pack2(tl[kg + 0][n], tl[kg + 1][n]); o.y = pack2(tl[kg + 2][n], tl[kg + 3][n]);
    o.z = pack2(tl[kg + 4][n], tl[kg + 5][n]); o.w = pack2(tl[kg + 6][n], tl[kg + 7][n]);
    const int h = n0 + n;
    const int dr = mapmode == 0 ? h : ((h >> 3) * 16 + (h & 7) + (mapmode == 2 ? 8 : 0));
    *(uint4*)&dst[(size_t)dr * ldk + k0 + kg] = o;
  }
  __syncthreads();
}

__device__ __forceinline__ void norm_phase(const Params& P, int t0, const float* gw,
                                           int mod_layer, int shift_idx,
                                           int pend_layer, int pend_t0,
                                           bool to_out, bool router, int layer, float* wl) {
  int* rl = (int*)((char*)wl + GEMM_LDS_TOTAL + 272);
  unsigned char* ws = P.ws;
  float* tok = (float*)(ws + WS_TOK);
  bf16_t* hb = (bf16_t*)(ws + WS_H);
  const float* mod = (const float*)(ws + WS_MOD);
  const bf16_t* ybuf = (const bf16_t*)(ws + WS_R + R_YBUF);
  const int tid_n = opaque_tid();
  const int lane = tid_n & 63;
  if (router) {
    const float* rgw = P.in[9] + (size_t)layer * 1024 * 4;
    const float* rew = P.in[11] + (size_t)layer * 1024 * 32;
    for (int idx = tid_n; idx < 1024 * 36; idx += NT) {
      const int k = idx / 36, j = idx - k * 36;
      const int rho = (((k >> 8) * 4 + (k & 3)) * 64) + ((k & 255) >> 2);
      wl[rho * 36 + j] = (j < 4) ? rgw[k * 4 + j] : rew[k * 32 + (j - 4)];
    }
    if (tid_n < 80) rl[tid_n] = 0;
    __syncthreads();
  }
  const int gw_id = blockIdx.x * (NT / 64) + (tid_n >> 6);
  const int gw_n = gridDim.x * (NT / 64);
  for (int t = t0 + gw_id; t < T_ALL; t += gw_n) {
    const int s = (t < T_CTX) ? 1 : 0;
    float v[16];
#pragma unroll
    for (int j = 0; j < 4; ++j) {
      const int n = j * 256 + lane * 4;
      const float4 x = *(const float4*)&tok[(size_t)t * DM + n];
      v[j * 4 + 0] = x.x; v[j * 4 + 1] = x.y; v[j * 4 + 2] = x.z; v[j * 4 + 3] = x.w;
    }
    if (pend_layer >= 0 && t >= pend_t0) {
      const float* gate = mod + (size_t)((pend_layer * 2 + s) * 6 + 5) * 1024;
#pragma unroll
      for (int j = 0; j < 4; ++j) {
        const int n = j * 256 + lane * 4;
        const uint2 y0 = *(const uint2*)&ybuf[(size_t)(2 * t) * DM + n];
        const uint2 y1 = *(const uint2*)&ybuf[(size_t)(2 * t + 1) * DM + n];
        const float4 g = *(const float4*)&gate[n];
        v[j * 4 + 0] += g.x * (lo2f(y0.x) + lo2f(y1.x));
        v[j * 4 + 1] += g.y * (hi2f(y0.x) + hi2f(y1.x));
        v[j * 4 + 2] += g.z * (lo2f(y0.y) + lo2f(y1.y));
        v[j * 4 + 3] += g.w * (hi2f(y0.y) + hi2f(y1.y));
        *(float4*)&tok[(size_t)t * DM + n] = make_float4(v[j * 4 + 0], v[j * 4 + 1], v[j * 4 + 2], v[j * 4 + 3]);
      }
    }
    float ss = 0.f;
#pragma unroll
    for (int e = 0; e < 16; ++e) ss += v[e] * v[e];
    ss = wave_sum(ss);
    const float r = 1.f / sqrtf(ss * (1.f / 1024.f) + EPSN);
    float h[16];
#pragma unroll
    for (int j = 0; j < 4; ++j) {
      const int n = j * 256 + lane * 4;
      const float4 g = *(const float4*)&gw[n];
      h[j * 4 + 0] = v[j * 4 + 0] * r * g.x;
      h[j * 4 + 1] = v[j * 4 + 1] * r * g.y;
      h[j * 4 + 2] = v[j * 4 + 2] * r * g.z;
      h[j * 4 + 3] = v[j * 4 + 3] * r * g.w;
      if (shift_idx >= 0) {
        const float* sh = mod + (size_t)((mod_layer * 2 + s) * 6 + shift_idx) * 1024;
        const float* sc = sh + 1024;
        const float4 a = *(const float4*)&sh[n];
        const float4 b = *(const float4*)&sc[n];
        h[j * 4 + 0] = h[j * 4 + 0] * (1.f + b.x) + a.x;
        h[j * 4 + 1] = h[j * 4 + 1] * (1.f + b.y) + a.y;
        h[j * 4 + 2] = h[j * 4 + 2] * (1.f + b.z) + a.z;
        h[j * 4 + 3] = h[j * 4 + 3] * (1.f + b.w) + a.w;
      }
      if (to_out) {
        *(float4*)&P.out[(size_t)(t - T_CTX) * DM + n] = make_float4(h[j * 4 + 0], h[j * 4 + 1], h[j * 4 + 2], h[j * 4 + 3]);
      } else {
        uint2 o; o.x = pack2(h[j * 4 + 0], h[j * 4 + 1]); o.y = pack2(h[j * 4 + 2], h[j * 4 + 3]);
        *(uint2*)&hb[(size_t)t * DM + n] = o;
      }
    }
    if (router) {
      float lg[36];
#pragma unroll
      for (int q = 0; q < 36; ++q) lg[q] = 0.f;
#pragma unroll
      for (int i = 0; i < 16; ++i) {
        const float hv = h[i];
        const float4* wr4 = (const float4*)(wl + (i * 64 + lane) * 36);
#pragma unroll
        for (int q = 0; q < 9; ++q) {
          const float4 w4 = wr4[q];
          lg[q * 4 + 0] += hv * w4.x; lg[q * 4 + 1] += hv * w4.y; lg[q * 4 + 2] += hv * w4.z; lg[q * 4 + 3] += hv * w4.w;
        }
        __builtin_amdgcn_sched_barrier(0);
      }
#pragma unroll
      for (int q = 0; q < 36; ++q) lg[q] = wave_sum(lg[q]);
      const float* rgb = P.in[10] + layer * 4;
      const float* reb = P.in[12] + layer * 32;
#pragma unroll
      for (int q = 0; q < 4; ++q) lg[q] += rgb[q];
#pragma unroll
      for (int q = 0; q < 32; ++q) lg[4 + q] += reb[q];
      int grp = 0; float best = lg[0];
#pragma unroll
      for (int q = 1; q < 4; ++q) if (lg[q] > best) { best = lg[q]; grp = q; }
      float se = 0.f;
#pragma unroll
      for (int q = 0; q < 4; ++q) se += expf(lg[q] - best);
      const float pg = 1.f / se;
      float v0 = -3.0e38f, v1 = -3.0e38f; int i0 = 0, i1 = 0;
#pragma unroll
      for (int g = 0; g < 4; ++g) {
#pragma unroll
        for (int q = 0; q < 8; ++q) {
          const float x = lg[4 + g * 8 + q];
          if (g == grp) {
            if (x > v0) { v1 = v0; i1 = i0; v0 = x; i0 = q; }
            else if (x > v1) { v1 = x; i1 = q; }
          }
        }
      }
      const float w0 = 1.f / (1.f + expf(v1 - v0));
      const float w1 = 1.f - w0;
      if (lane == 0) {
        float* asgw = (float*)(ws + WS_ASGW);
        const int e0 = grp * 8 + i0, e1 = grp * 8 + i1;
        const int p0 = atomicAdd(&rl[e0], 1);
        const int p1 = atomicAdd(&rl[e1], 1);
        const int sl = atomicAdd(&rl[64], 2);
        rl[80 + sl] = 2 * t;         rl[240 + sl] = e0;     rl[400 + sl] = p0;
        rl[80 + sl + 1] = 2 * t + 1; rl[240 + sl + 1] = e1; rl[400 + sl + 1] = p1;
        asgw[2 * t] = w0 * pg;
        asgw[2 * t + 1] = w1 * pg;
      }
    }
  }
  if (router) {
    __syncthreads();
    int* cnt = (int*)(ws + WS_CNT) + layer * 32 * 32;
    int* list = (int*)(ws + WS_LIST);
    if (tid_n < 32) rl[32 + tid_n] = rl[tid_n] ? atomicAdd(&cnt[tid_n * 32], rl[tid_n]) : 0;
    __syncthreads();
    const int nent = rl[64];
    for (int s = tid_n; s < nent; s += NT) {
      const int e = rl[240 + s];
      list[(size_t)e * 33280 + rl[32 + e] + rl[400 + s]] = rl[80 + s];
    }
    __syncthreads();
  }
}

#define tid (opaque_tid())
#define gtid ((int)(blockIdx.x * NT) + opaque_tid())
#define gstride ((int)(gridDim.x * NT))
__global__ void __launch_bounds__(NT, 2) mega(Params P) {
  cg::grid_group grid = cg::this_grid();
  __shared__ __attribute__((aligned(1024))) char shm[GEMM_LDS_TOTAL + 16 + 256 + 2560];
  float* smem = (float*)shm;
  if (threadIdx.x < 4) ((unsigned*)(shm + GEMM_LDS_TOTAL))[threadIdx.x] = 0u;
  __syncthreads();
  XcdBarrier xbar = xcd_barrier_post((unsigned*)(P.ws + WS_BAR), (volatile LAS unsigned*)(shm + GEMM_LDS_TOTAL));
  unsigned char* ws = P.ws;
  const int G = gridDim.x;
  const int vb = (G % 8 == 0) ? ((int)(blockIdx.x & 7) * (G / 8) + (int)(blockIdx.x >> 3)) : (int)blockIdx.x;
  float* tok = (float*)(ws + WS_TOK);
  bf16_t* hb = (bf16_t*)(ws + WS_H);
  float* mod = (float*)(ws + WS_MOD);
  const bf16_t* zrow = (const bf16_t*)(ws + WS_ZROW);
  unsigned char* R = ws + WS_R;

  {
    const float* x = P.in[0]; const float* ctx = P.in[2];
    for (int idx = gtid; idx < T_ALL * 256; idx += gstride) {
      const int t = idx >> 8, n = (idx & 255) * 4;
      float4 o;
      if (t < T_CTX) o = *(const float4*)&ctx[(size_t)t * DM + n];
      else {
        const int tl = t - T_CTX;
        o = *(const float4*)&x[(size_t)tl * DM + n];
        float pe[4];
#pragma unroll
        for (int e = 0; e < 4; ++e) {
          const int nn = n + e, qd = nn >> 8, j = nn & 255;
          const float freq = expf(-9.210340371976184f * (float)j / 256.f);
          const float pos = (qd < 2) ? (float)(tl >> 6) : (float)(tl & 63);
          const float ang = pos * freq;
          pe[e] = (qd & 1) ? cosf(ang) : sinf(ang);
        }
        o.x += pe[0]; o.y += pe[1]; o.z += pe[2]; o.w += pe[3];
      }
      *(float4*)&tok[(size_t)t * DM + n] = o;
    }
    const float* c = P.in[1]; const float* cc = P.in[3]; const float* adaw = P.in[4];
    float* modp = (float*)(ws + WS_MODP);
    for (int idx = gtid; idx < 16 * 4 * 6144; idx += gstride) {
      const int ks = idx / 24576, rem = idx - ks * 24576, i = rem / 6144, j = rem - i * 6144;
      float a0 = 0.f, a1 = 0.f;
      for (int k = ks * 64; k < ks * 64 + 64; ++k) {
        const float w = adaw[((size_t)i * 1024 + k) * 6144 + j];
        a0 += silu_f(c[k]) * w;
        a1 += silu_f(cc[k]) * w;
      }
      modp[(size_t)(ks * 8 + i * 2 + 0) * 6144 + j] = a0;
      modp[(size_t)(ks * 8 + i * 2 + 1) * 6144 + j] = a1;
    }
    if (gtid < 4 * 32 * 32 + 64) ((int*)(ws + WS_CNT))[gtid] = 0;
    if (gtid < 2048) ((unsigned*)(ws + WS_ZROW))[gtid] = 0u;
    bf16_t* DC = (bf16_t*)(ws + W_DC); bf16_t* DA = (bf16_t*)(ws + W_DA); bf16_t* TW = (bf16_t*)(ws + W_TW);
    for (int idx = gtid; idx < 512 * 256; idx += gstride) {
      const int row = idx >> 8, cch = idx & 255, pq = row >> 8, kc = row & 255;
      const float a = (float)((kc * cch) & 255) * (1.f / 128.f);
      DC[idx] = f2bf(pq ? -sinpif(a) : cospif(a));
    }
    for (int idx = gtid; idx < 256 * 256; idx += gstride) {
      const int row = idx >> 8, col = idx & 255, ri = row >> 7, cc2 = row & 127, rj = col >> 7, aa = col & 127;
      const float a = (float)((aa * cc2) & 127) * (1.f / 64.f);
      const float cs = cospif(a), sn = sinpif(a);
      DA[idx] = f2bf(ri == rj ? cs : (ri == 0 ? sn : -sn));
    }
    for (int idx = gtid; idx < 128 * 128 * 256; idx += gstride) {
      const int col = idx & 255, e = (idx >> 8) & 127, c2 = idx >> 15, ri = col >> 7, b = col & 127;
      const float a = (float)((b * (c2 + 128 * e)) & 16383) * (1.f / 8192.f);
      TW[idx] = f2bf(ri ? sinpif(a) : cospif(a));
    }
    for (int idx = gtid; idx < 2 * 1280; idx += gstride) ((float*)(ws + W_SP))[idx] = log1pf(expf(-P.in[34][idx]));
    {
      bf16_t* WR = (bf16_t*)(ws + W_RT);
      for (int idx = gtid; idx < 4 * 64 * 1024; idx += gstride) {
        const int k = idx & 1023, j = (idx >> 10) & 63, l = idx >> 16;
        float w = 0.f;
        if (j < 4) w = P.in[9][((size_t)l * 1024 + k) * 4 + j];
        else if (j < 36) w = P.in[11][((size_t)l * 1024 + k) * 32 + (j - 4)];
        const bf16_t hi = f2bf(w), lo = f2bf(w - bf2f(hi));
        bf16_t* row = WR + ((size_t)l * 64 + j) * 3072;
        row[k] = hi; row[1024 + k] = hi; row[2048 + k] = lo;
      }
    }
    {
      const float* src = P.in[36]; bf16_t* dst = (bf16_t*)(ws + W_FNIN);
      for (int idx = gtid; idx < 1024 * 1024 / 4; idx += gstride) {
        const float4 a = *(const float4*)&src[(size_t)idx * 4];
        uint2 o; o.x = pack2(a.x, a.y); o.y = pack2(a.z, a.w);
        *(uint2*)&dst[(size_t)idx * 4] = o;
      }
    }
    const int NDENSE = 512 + 256 + 768 + 256 + 640 + 320 + 256 + 160;
    const int NTOT = NDENSE + 128 * 384;
    for (int u = blockIdx.x; u < NTOT; u += G) {
      if (u < NDENSE) {
        int v = u;
        if (v < 512) { conv_tile(P.in[16], 2048, (bf16_t*)(ws + W_CMIN), 1024, (v >> 5) * 64, (v & 31) * 64, 0, smem); continue; }
        v -= 512;
        if (v < 256) { conv_tile(P.in[20], 1024, (bf16_t*)(ws + W_CMOUT), 1024, (v >> 4) * 64, (v & 15) * 64, 0, smem); continue; }
        v -= 256;
        if (v < 768) { conv_tile(P.in[21], 3088, (bf16_t*)(ws + W_MLIN), 1024, (v / 48) * 64, (v % 48) * 64, 0, smem); continue; }
        v -= 768;
        if (v < 256) { conv_tile(P.in[26], 1024, (bf16_t*)(ws + W_MLOUT), 1024, (v >> 4) * 64, (v & 15) * 64, 0, smem); continue; }
        v -= 256;
        if (v < 640) { conv_tile(P.in[27], 2560, (bf16_t*)(ws + W_LRUIN), 1024, (v / 40) * 64, (v % 40) * 64, 0, smem); continue; }
        v -= 640;
        if (v < 320) { conv_tile(P.in[35], 1024, (bf16_t*)(ws + W_LRUOUT), 1280, (v >> 4) * 64, (v & 15) * 64, 0, smem); continue; }
        v -= 320;
        if (v < 256) { conv_tile(P.in[37], 1024, (bf16_t*)(ws + W_FNOUT), 1024, (v >> 4) * 64, (v & 15) * 64, 0, smem); continue; }
        v -= 256;
        {
          const int mat = v >> 2, tl4 = v & 3, type = mat / 20, dnb = mat % 20, d = dnb / 10, nb = dnb % 10;
          const float* srcm = (type ? P.in[32] : P.in[30]) + (size_t)dnb * 128 * 128;
          conv_tile(srcm, 128, (bf16_t*)(ws + W_LRUG) + (size_t)(nb * 2 + d) * 256 * 128, 128, (tl4 >> 1) * 64, (tl4 & 1) * 64, type + 1, smem);
        }
      } else {
        const int v = u - NDENSE, le = v / 384, r = v - le * 384, kind = r >> 7, tt = r & 127;
        if (kind < 2) {
          const float* src = (kind == 0 ? P.in[13] : P.in[14]) + (size_t)le * 1024 * 512;
          conv_tile(src, 512, (bf16_t*)(ws + W_EGU) + (size_t)le * 1024 * 1024, 1024, (tt >> 3) * 64, (tt & 7) * 64, kind + 1, smem);
        } else {
          const float* src = P.in[15] + (size_t)le * 512 * 1024;
          conv_tile(src, 1024, (bf16_t*)(ws + W_ED) + (size_t)le * 1024 * 512, 512, (tt >> 4) * 64, (tt & 15) * 64, 0, smem);
        }
      }
    }
  }
  grid.sync();
  {
    const float* modp = (const float*)(ws + WS_MODP);
    const float* adab = P.in[5];
    for (int idx = gtid; idx < 8 * 6144; idx += gstride) {
      const int is = idx / 6144, j = idx - is * 6144, i = is >> 1;
      float a = adab[i * 6144 + j];
      for (int ks = 0; ks < 16; ++ks) a += modp[(size_t)(ks * 8 + is) * 6144 + j];
      mod[idx] = a;
    }
    {
      const bf16_t* DC = (const bf16_t*)(ws + W_DC);
      const bf16_t* WI = (const bf16_t*)(ws + W_FNIN);
      bf16_t* WP = (bf16_t*)(ws + W_FNP);
      gemm_loop<4, true>(shm, 4, vb, 64, G,
        [=](int L, int r) { const int tm = L >> 2; return DC + (size_t)((tm >> 3) * 256 + (tm & 1) * 128 + r) * 256; },
        [=](int L, int cidx) { const int tm = L >> 2; return WI + (size_t)((L & 3) * 256 + cidx) * 1024 + ((tm >> 1) & 3) * 256; }, KOffL(), KOffL(),
        [=](int L, int row, int col0, const f32x4 (&a)[4]) { st16bf(WP + (size_t)((L >> 2) * 128 + row) * 1024 + (L & 3) * 256 + col0, a); });
    }
  }
  xcd_barrier(xbar);

#define MODV(i, s, j, n) mod[(size_t)(((i) * 2 + (s)) * 6 + (j)) * 1024 + (n)]

  auto resid_epi = [=](int layer, int grow, int gcol0, const f32x4 (&a)[4]) {
    const int s = grow < T_CTX ? 1 : 0;
    const float* gate = &MODV(layer, s, 2, gcol0);
    float* p = tok + (size_t)grow * DM + gcol0;
#pragma unroll
    for (int n = 0; n < 4; ++n) {
      float4 t4 = *(float4*)(p + n * 4);
      const float4 g4 = *(const float4*)(gate + n * 4);
      t4.x += g4.x * a[n][0]; t4.y += g4.y * a[n][1]; t4.z += g4.z * a[n][2]; t4.w += g4.w * a[n][3];
      *(float4*)(p + n * 4) = t4;
    }
  };

  auto moe_layer = [&](int layer, int t0) {
    norm_phase(P, t0, P.in[7] + layer * 1024, layer, 3, -1, 0, false, true, layer, smem);
    xcd_barrier(xbar);
    int* cnt = (int*)(ws + WS_CNT) + layer * 32 * 32;
    int* list = (int*)(ws + WS_LIST);
    float* asgw = (float*)(ws + WS_ASGW);
    int* ps = (int*)(shm + GEMM_LDS_TOTAL + 64);
    if (tid == 0) {
      int s = 0;
      for (int e = 0; e < 32; ++e) { ps[e] = s; s += (cnt[e * 32] + 127) / 128 * 128; }
      ps[32] = s;
    }
    __syncthreads();
    const int total = ps[32];
    bf16_t* HB = (bf16_t*)(R + R_HB);
    bf16_t* ybuf = (bf16_t*)(R + R_YBUF);
    const bf16_t* WGU = (const bf16_t*)(ws + W_EGU) + (size_t)layer * 32 * 1024 * 1024;
    const bf16_t* WD = (const bf16_t*)(ws + W_ED) + (size_t)layer * 32 * 1024 * 512;
    const int ntile = (total >> 7) * 4;
    auto blk_e = [=](int mb) { int e = 0; for (int q = 1; q < 32; ++q) if (ps[q] <= mb * 128) e = q; return e; };
    {
      gemm_loop<4, true>(shm, 16, vb, ntile, G,
        [=](int L, int r) { const int mb = L >> 2, e = blk_e(mb), rr = mb * 128 - ps[e] + r;
          return (rr < cnt[e * 32]) ? (const bf16_t*)(hb + (size_t)(list[(size_t)e * 33280 + rr] >> 1) * DM) : zrow; },
        [=](int L, int cidx) { const int e = blk_e(L >> 2); return WGU + (size_t)e * 1024 * 1024 + (size_t)((L & 3) * 256 + cidx) * 1024; },
        KOffL(), KOffL(),
        [=](int L, int row, int col0, const f32x4 (&a)[4]) {
          const int n0 = (L & 3) * 256, m0 = (L >> 2) * 128;
          float hv[8];
#pragma unroll
          for (int j = 0; j < 8; ++j) { const float gv = a[j >> 2][j & 3], uv = a[2 + (j >> 2)][j & 3]; hv[j] = silu_f(gv) * uv; }
          uint4 o; o.x = pack2(hv[0], hv[1]); o.y = pack2(hv[2], hv[3]); o.z = pack2(hv[4], hv[5]); o.w = pack2(hv[6], hv[7]);
          *(uint4*)&HB[(size_t)(m0 + row) * 512 + ((n0 + col0) >> 1)] = o;
        });
    }
    xcd_barrier(xbar);
    {
      gemm_loop<4, true>(shm, 8, vb, ntile, G,
        [=](int L, int r) { return (const bf16_t*)(HB + (size_t)((L >> 2) * 128 + r) * 512); },
        [=](int L, int cidx) { const int e = blk_e(L >> 2); return WD + (size_t)e * 1024 * 512 + (size_t)((L & 3) * 256 + cidx) * 512; },
        KOffL(), KOffL(),
        [=](int L, int row, int col0, const f32x4 (&a)[4]) {
          const int mb = L >> 2, n0 = (L & 3) * 256, e = blk_e(mb), rr = mb * 128 - ps[e] + row;
          if (rr < cnt[e * 32]) {
            const int rt = list[(size_t)e * 33280 + rr];
            const float w = asgw[rt];
            f32x4 bq[4];
#pragma unroll
            for (int n = 0; n < 4; ++n) bq[n] = a[n] * w;
            st16bf(ybuf + (size_t)rt * 1024 + n0 + col0, bq);
          }
        });
    }
    xcd_barrier(xbar);
  };

  {
    norm_phase(P, 0, P.in[6] + 0 * 1024, 0, 0, -1, 0, false, false, 0, smem);
    xcd_barrier(xbar);
    bf16_t* zu = (bf16_t*)(R + R0_ZU); bf16_t* zvT = (bf16_t*)(R + R0_ZVT); bf16_t* pb = (bf16_t*)(R + R0_P);
    bf16_t* Wsc = (bf16_t*)(R + R0_WSC);
    const float* vg = P.in[17]; const float* w_s = P.in[18]; const float* b_s = P.in[19];
    const bf16_t* Wt = (const bf16_t*)(ws + W_CMIN);
    {
      auto epi_u = [=](int grow, int gcol0, const f32x4 (&a)[4]) {
        f32x4 bq[4];
#pragma unroll
        for (int n = 0; n < 4; ++n)
#pragma unroll
          for (int j = 0; j < 4; ++j) bq[n][j] = gelu_f(a[n][j]);
        st16bf(zu + (size_t)grow * 1024 + gcol0, bq);
      };
      auto epi_v = [=](int grow0, int gcol, f32x4 v) {
        uint2 o; o.x = pack2(gelu_f(v[0]), gelu_f(v[1])); o.y = pack2(gelu_f(v[2]), gelu_f(v[3]));
        *(uint2*)&zvT[((size_t)(grow0 >> 7) * 1024 + (gcol - 1024)) * 128 + (grow0 & 127)] = o;
      };
      gemm_loop<8, true>(shm, 16, vb, 256, G,
        [=](int L, int r) { return (const bf16_t*)(hb + (size_t)((1 + (L >> 2)) * 256 + r) * DM); },
        [=](int L, int cidx) { return Wt + (size_t)((L & 3) * 256 + cidx) * 1024; }, KOffL(), KOffL(),
        [=](int L, int row, int col0, const f32x4 (&a)[4]) { epi_u((1 + (L >> 2)) * 256 + row, (L & 3) * 256 + col0, a); });
      gemm_loop<8, false>(shm, 16, vb, 256, G,
        [=](int L, int r) { return (const bf16_t*)(hb + (size_t)((1 + (L >> 2)) * 256 + r) * DM); },
        [=](int L, int cidx) { return Wt + (size_t)((4 + (L & 3)) * 256 + cidx) * 1024; }, KOffL(), KOffL(),
        [=](int L, int row0, int col, f32x4 v) { epi_v((1 + (L >> 2)) * 256 + row0, (4 + (L & 3)) * 256 + col, v); });
      gemm_loop<2, true>(shm, 16, vb, 16, G,
        [=](int L, int r) { return (const bf16_t*)(hb + (size_t)((L >> 2) * 64 + r) * DM); },
        [=](int L, int cidx) { return Wt + (size_t)((L & 3) * 256 + cidx) * 1024; }, KOffL(), KOffL(),
        [=](int L, int row, int col0, const f32x4 (&a)[4]) { epi_u((L >> 2) * 64 + row, (L & 3) * 256 + col0, a); });
      gemm_loop<2, false>(shm, 16, (vb - 16 + G) % G, 16, G,
        [=](int L, int r) { return (const bf16_t*)(hb + (size_t)((L >> 2) * 64 + r) * DM); },
        [=](int L, int cidx) { return Wt + (size_t)((4 + (L & 3)) * 256 + cidx) * 1024; }, KOffL(), KOffL(),
        [=](int L, int row0, int col, f32x4 v) { epi_v((L >> 2) * 64 + row0, (4 + (L & 3)) * 256 + col, v); });
    }
    xcd_barrier(xbar);
    {
      float* s_part = smem;
      float* s_rv = smem + 512;
      for (int n = blockIdx.x; n < NCH; n += G) {
        const int sidx = tid & 127, qt = tid >> 7;
        float ss = 0.f;
        for (int col = qt * 256; col < qt * 256 + 256; ++col) { const float x = bf2f(zvT[((size_t)n * 1024 + col) * 128 + sidx]); ss += x * x; }
        s_part[qt * 128 + sidx] = ss;
        __syncthreads();
        if (tid < 128) s_rv[tid] = 1.f / sqrtf((s_part[tid] + s_part[128 + tid] + s_part[256 + tid] + s_part[384 + tid]) * (1.f / 1024.f) + EPSN);
        __syncthreads();
        for (int idx = tid; idx < 4 * 128 * 32; idx += NT) {
          const int s4 = (idx & 31) * 4, gt = idx >> 5;
          const float4 w4 = *(const float4*)&w_s[(size_t)gt * 128 + s4];
          uint2 o; o.x = pack2(w4.x * s_rv[s4], w4.y * s_rv[s4 + 1]); o.y = pack2(w4.z * s_rv[s4 + 2], w4.w * s_rv[s4 + 3]);
          *(uint2*)&Wsc[((size_t)n * 512 + gt) * 128 + s4] = o;
        }
        __syncthreads();
      }
    }
    xcd_barrier(xbar);
    {
      gemm_loop<4, true>(shm, 2, vb, NCH * 4, G,
        [=](int L, int r) { return (const bf16_t*)(Wsc + ((size_t)(L >> 2) * 512 + (L & 3) * 128 + r) * 128); },
        [=](int L, int cidx) { return (const bf16_t*)(zvT + ((size_t)(L >> 2) * 1024 + (L & 3) * 256 + cidx) * 128); },
        KOffL(), KOffL(),
        [=](int L, int row, int col0, const f32x4 (&a)[4]) {
          const int n = L >> 2, g = L & 3;
          const int t = n * 128 + row, col = g * 256 + col0;
          const float bias = b_s[g * 128 + row];
          const uint4 u0 = *(const uint4*)&zu[(size_t)t * 1024 + col], u1 = *(const uint4*)&zu[(size_t)t * 1024 + col + 8];
          const unsigned uu[8] = {u0.x, u0.y, u0.z, u0.w, u1.x, u1.y, u1.z, u1.w};
          f32x4 o[4];
#pragma unroll
          for (int nn = 0; nn < 4; ++nn) {
            const float4 g4 = *(const float4*)&vg[col + nn * 4];
            o[nn][0] = lo2f(uu[nn * 2]) * (a[nn][0] * g4.x + bias);
            o[nn][1] = hi2f(uu[nn * 2]) * (a[nn][1] * g4.y + bias);
            o[nn][2] = lo2f(uu[nn * 2 + 1]) * (a[nn][2] * g4.z + bias);
            o[nn][3] = hi2f(uu[nn * 2 + 1]) * (a[nn][3] * g4.w + bias);
          }
          st16bf(pb + (size_t)t * 1024 + col, o);
        });
    }
    xcd_barrier(xbar);
    const bf16_t* Wo = (const bf16_t*)(ws + W_CMOUT);
    auto epi_out = [=](int grow, int gcol0, const f32x4 (&a)[4]) { resid_epi(0, grow, gcol0, a); };
    dense_phase(shm, vb, G, pb, 1024, Wo, 1024, 4, 16, true, epi_out);
    xcd_barrier(xbar);
  }
  moe_layer(0, 0);

  {
    norm_phase(P, 0, P.in[6] + 1 * 1024, 1, 0, 0, 0, false, false, 0, smem);
    xcd_barrier(xbar);
    bf16_t* ZQK = (bf16_t*)(R + R1_ZQK); bf16_t* ZO = (bf16_t*)(R + R1_ZO); bf16_t* VT = (bf16_t*)(R + R1_VT);
    float* gpre = (float*)(R + R1_GPRE); bf16_t* Qn = (bf16_t*)(R + R1_QN); bf16_t* Kn = (bf16_t*)(R + R1_KN);
    bf16_t* AS = (bf16_t*)(R + R1_AS); bf16_t* KwT = (bf16_t*)(R + R1_KWT);
    float* bc = (float*)(R + R1_BC); float* li = (float*)(R + R1_LI); float* egch = (float*)(R + R1_GCH);
    float* nloc = (float*)(R + R1_NLOC); float* nin = (float*)(R + R1_NIN);
    float* Cloc = (float*)(R + R1_CLOC); bf16_t* CinT = (bf16_t*)(R + R1_CINT); float* hnum = (float*)(R + R1_CLOC);
    bf16_t* A2 = (bf16_t*)(R + R1_A2);
    const float* w_in = P.in[21]; const float* cw = P.in[22]; const float* cb = P.in[23];
    const float* gb = P.in[24]; const float* ng = P.in[25];
    const bf16_t* Wt = (const bf16_t*)(ws + W_MLIN);
    {
      auto epi_nat = [=](int grow, int gcol0, const f32x4 (&a)[4]) {
        if (gcol0 < 1024) st16bf(ZQK + (size_t)grow * 1024 + gcol0, a); else st16bf(ZO + (size_t)grow * 1024 + gcol0 - 2048, a);
      };
      auto epi_vt = [=](int grow0, int gcol, f32x4 v) {
        uint2 o; o.x = pack2(v[0], v[1]); o.y = pack2(v[2], v[3]);
        *(uint2*)&VT[((size_t)(grow0 >> 7) * 1024 + (gcol - 1024)) * 128 + (grow0 & 127)] = o;
      };
      {
        float* wl = smem;
        const int tq = tid;
        for (int idx = tq; idx < 1024 * 4; idx += NT) {
          const int k = idx >> 2, q = idx & 3;
          const float4 w4 = *(const float4*)&w_in[(size_t)k * 3088 + 3072 + q * 4];
          const int rho = (((k >> 8) * 4 + (k & 3)) * 64) + ((k & 255) >> 2);
          *(float4*)&wl[rho * 16 + q * 4] = w4;
        }
        __syncthreads();
        const int lane = tq & 63;
        for (int t = blockIdx.x * (NT / 64) + (tq >> 6); t < T_ALL; t += G * (NT / 64)) {
          float hv[16];
#pragma unroll
          for (int j = 0; j < 4; ++j) {
            const uint2 z = *(const uint2*)&hb[(size_t)t * DM + j * 256 + lane * 4];
            hv[j * 4 + 0] = lo2f(z.x); hv[j * 4 + 1] = hi2f(z.x); hv[j * 4 + 2] = lo2f(z.y); hv[j * 4 + 3] = hi2f(z.y);
          }
          float a16[16];
#pragma unroll
          for (int j = 0; j < 16; ++j) a16[j] = 0.f;
#pragma unroll
          for (int i = 0; i < 16; ++i) {
            const float4* wr4 = (const float4*)(wl + (i * 64 + lane) * 16);
#pragma unroll
            for (int q = 0; q < 4; ++q) {
              const float4 w4 = wr4[q];
              a16[q * 4 + 0] += hv[i] * w4.x; a16[q * 4 + 1] += hv[i] * w4.y; a16[q * 4 + 2] += hv[i] * w4.z; a16[q * 4 + 3] += hv[i] * w4.w;
            }
            __builtin_amdgcn_sched_barrier(0);
          }
#pragma unroll
          for (int j = 0; j < 16; ++j) a16[j] = wave_sum(a16[j]);
          if (lane == 0) {
#pragma unroll
            for (int j = 0; j < 4; ++j) *(float4*)&gpre[(size_t)t * 16 + j * 4] = make_float4(a16[j * 4], a16[j * 4 + 1], a16[j * 4 + 2], a16[j * 4 + 3]);
          }
        }
        __syncthreads();
      }
      gemm_loop<8, true>(shm, 16, vb, 512, G,
        [=](int L, int r) { return (const bf16_t*)(hb + (size_t)((1 + (L >> 3)) * 256 + r) * DM); },
        [=](int L, int cidx) { const int j = L & 7, tn = j < 4 ? j : j + 4; return Wt + (size_t)(tn * 256 + cidx) * 1024; }, KOffL(), KOffL(),
        [=](int L, int row, int col0, const f32x4 (&a)[4]) { const int j = L & 7, tn = j < 4 ? j : j + 4; epi_nat((1 + (L >> 3)) * 256 + row, tn * 256 + col0, a); });
      gemm_loop<8, false>(shm, 16, vb, 256, G,
        [=](int L, int r) { return (const bf16_t*)(hb + (size_t)((1 + (L >> 2)) * 256 + r) * DM); },
        [=](int L, int cidx) { return Wt + (size_t)((4 + (L & 3)) * 256 + cidx) * 1024; }, KOffL(), KOffL(),
        [=](int L, int row0, int col, f32x4 v) { epi_vt((1 + (L >> 2)) * 256 + row0, (4 + (L & 3)) * 256 + col, v); });
      gemm_loop<2, true>(shm, 16, vb, 32, G,
        [=](int L, int r) { return (const bf16_t*)(hb + (size_t)((L >> 3) * 64 + r) * DM); },
        [=](int L, int cidx) { const int j = L & 7, tn = j < 4 ? j : j + 4; return Wt + (size_t)(tn * 256 + cidx) * 1024; }, KOffL(), KOffL(),
        [=](int L, int row, int col0, const f32x4 (&a)[4]) { const int j = L & 7, tn = j < 4 ? j : j + 4; epi_nat((L >> 3) * 64 + row, tn * 256 + col0, a); });
      gemm_loop<2, false>(shm, 16, (vb - 32 + G) % G, 16, G,
        [=](int L, int r) { return (const bf16_t*)(hb + (size_t)((L >> 2) * 64 + r) * DM); },
        [=](int L, int cidx) { return Wt + (size_t)((4 + (L & 3)) * 256 + cidx) * 1024; }, KOffL(), KOffL(),
        [=](int L, int row0, int col, f32x4 v) { epi_vt((L >> 2) * 64 + row0, (4 + (L & 3)) * 256 + col, v); });
    }
    xcd_barrier(xbar);
    {
      float* s_bc = smem;
      float* s_w  = smem + 1024;
      float* s_k  = smem + 2048;
      const int wv = tid >> 6, lane = tid & 63;
      for (int n = blockIdx.x; n < NCH; n += G) {
        {
          const int dh = wv, d = dh >> 2, hd = dh & 3;
          const int p0 = 2 * lane, p1 = p0 + 1;
          const int t0 = n * 128 + (d == 0 ? p0 : 127 - p0), t1 = n * 128 + (d == 0 ? p1 : 127 - p1);
          const float li0 = gpre[(size_t)t0 * 16 + d * 8 + hd] + gb[d * 8 + hd];
          const float li1 = gpre[(size_t)t1 * 16 + d * 8 + hd] + gb[d * 8 + hd];
          const float lf0 = logsig_f(gpre[(size_t)t0 * 16 + d * 8 + 4 + hd] + gb[d * 8 + 4 + hd]);
          const float lf1 = logsig_f(gpre[(size_t)t1 * 16 + d * 8 + 4 + hd] + gb[d * 8 + 4 + hd]);
          float run = lf0 + lf1;
#pragma unroll
          for (int o = 1; o < 64; o <<= 1) { const float y = __shfl_up(run, o); if (lane >= o) run += y; }
          const float b1 = run, b0 = run - lf1;
          const float g = __shfl(run, 63);
          bc[(size_t)dh * T_ALL + t0] = expf(b0); bc[(size_t)dh * T_ALL + t1] = expf(b1);
          li[(size_t)dh * T_ALL + t0] = expf(li0 - b0); li[(size_t)dh * T_ALL + t1] = expf(li1 - b1);
          s_bc[dh * 128 + (t0 & 127)] = b0; s_bc[dh * 128 + (t1 & 127)] = b1;
          s_w[dh * 128 + (t0 & 127)] = expf(g - b0 + li0); s_w[dh * 128 + (t1 & 127)] = expf(g - b1 + li1);
          if (lane == 0) egch[dh * NCH + n] = expf(g);
        }
        __syncthreads();
        const int lo = n < 2 ? 0 : T_CTX, hi = n < 2 ? T_CTX : T_ALL;
        for (int idx = tid; idx < 128 * 64; idx += NT) {
          const int tl = idx >> 6, c0 = (idx & 63) * 8, t = n * 128 + tl, hd = c0 >> 7;
          float q[8];
#pragma unroll
          for (int e = 0; e < 8; ++e) q[e] = cb[c0 + e];
#pragma unroll
          for (int j = 0; j < 4; ++j) {
            const int tt = t + j - 2;
            if (tt >= lo && tt < hi) {
              const uint4 z = *(const uint4*)&ZQK[(size_t)tt * 1024 + c0];
              const float4 w0 = *(const float4*)&cw[j * 1024 + c0], w1 = *(const float4*)&cw[j * 1024 + c0 + 4];
              q[0] += lo2f(z.x) * w0.x; q[1] += hi2f(z.x) * w0.y; q[2] += lo2f(z.y) * w0.z; q[3] += hi2f(z.y) * w0.w;
              q[4] += lo2f(z.z) * w1.x; q[5] += hi2f(z.z) * w1.y; q[6] += lo2f(z.w) * w1.z; q[7] += hi2f(z.w) * w1.w;
            }
          }
#pragma unroll
          for (int e = 0; e < 8; ++e) q[e] = silu_f(q[e]) * 0.08838834764831845f;
          uint4 o; o.x = pack2(q[0], q[1]); o.y = pack2(q[2], q[3]); o.z = pack2(q[4], q[5]); o.w = pack2(q[6], q[7]);
          *(uint4*)&Qn[(size_t)t * 512 + c0] = o;
#pragma unroll
          for (int d = 0; d < 2; ++d) {
            const int dh = d * 4 + hd;
            const float eb = expf(s_bc[dh * 128 + tl]);
            uint4 o2; o2.x = pack2(q[0] * eb, q[1] * eb); o2.y = pack2(q[2] * eb, q[3] * eb); o2.z = pack2(q[4] * eb, q[5] * eb); o2.w = pack2(q[6] * eb, q[7] * eb);
            *(uint4*)&AS[((size_t)dh * T_ALL + t) * 256 + 128 + (c0 & 127)] = o2;
          }
        }
        for (int hd = 0; hd < 4; ++hd) {
          for (int idx = tid; idx < 128 * 16; idx += NT) {
            const int tl = idx >> 4, k0 = (idx & 15) * 8, t = n * 128 + tl, c0 = 512 + hd * 128 + k0;
            float q[8];
#pragma unroll
            for (int e = 0; e < 8; ++e) q[e] = cb[c0 + e];
#pragma unroll
            for (int j = 0; j < 4; ++j) {
              const int tt = t + j - 2;
              if (tt >= lo && tt < hi) {
                const uint4 z = *(const uint4*)&ZQK[(size_t)tt * 1024 + c0];
                const float4 w0 = *(const float4*)&cw[j * 1024 + c0], w1 = *(const float4*)&cw[j * 1024 + c0 + 4];
                q[0] += lo2f(z.x) * w0.x; q[1] += hi2f(z.x) * w0.y; q[2] += lo2f(z.y) * w0.z; q[3] += hi2f(z.y) * w0.w;
                q[4] += lo2f(z.z) * w1.x; q[5] += hi2f(z.z) * w1.y; q[6] += lo2f(z.w) * w1.z; q[7] += hi2f(z.w) * w1.w;
              }
            }
#pragma unroll
            for (int e = 0; e < 8; ++e) { q[e] = silu_f(q[e]); s_k[tl * 129 + k0 + e] = q[e]; }
            uint4 o; o.x = pack2(q[0], q[1]); o.y = pack2(q[2], q[3]); o.z = pack2(q[4], q[5]); o.w = pack2(q[6], q[7]);
            *(uint4*)&Kn[(size_t)t * 512 + hd * 128 + k0] = o;
          }
          __syncthreads();
          for (int idx = tid; idx < 2 * 128 * 16; idx += NT) {
            const int d = idx >> 11, rem = idx & 2047, kk = rem >> 4, s0 = (rem & 15) * 8, dh = d * 4 + hd;
            float v8[8];
#pragma unroll
            for (int e = 0; e < 8; ++e) v8[e] = s_w[dh * 128 + s0 + e] * s_k[(s0 + e) * 129 + kk];
            uint4 o; o.x = pack2(v8[0], v8[1]); o.y = pack2(v8[2], v8[3]); o.z = pack2(v8[4], v8[5]); o.w = pack2(v8[6], v8[7]);
            *(uint4*)&KwT[((size_t)dh * T_ALL + n * 128 + kk) * 128 + s0] = o;
          }
          if (tid < 256) {
            const int d = tid >> 7, kk = tid & 127, dh = d * 4 + hd;
            float a = 0.f;
            for (int s2 = 0; s2 < 128; ++s2) a += s_w[dh * 128 + s2] * s_k[s2 * 129 + kk];
            nloc[(dh * NCH + n) * 128 + kk] = a;
          }
          __syncthreads();
        }
      }
    }
    xcd_barrier(xbar);
    gemm_loop<4, false>(shm, 2, vb, 1040, G,
      [=](int L, int r) { const int dh = L / NCH, n = L - dh * NCH; return (const bf16_t*)(KwT + ((size_t)dh * T_ALL + n * 128 + r) * 128); },
      [=](int L, int cidx) { const int dh = L / NCH, n = L - dh * NCH, hd = dh & 3; return (const bf16_t*)(VT + ((size_t)n * 1024 + hd * 256 + cidx) * 128); },
      KOffL(), KOffL(),
      [=](int L, int row0, int col, f32x4 v) { *(float4*)&Cloc[(size_t)L * 32768 + (size_t)col * 128 + row0] = make_float4(v[0], v[1], v[2], v[3]); });
    gemm_loop<4, true>(shm, 2, (vb - 16 + G) % G, 520, G,
      [=](int L, int r) { const int hd = L / NCH, n = L - hd * NCH; return (const bf16_t*)(Qn + (size_t)(n * 128 + r) * 512 + hd * 128); },
      [=](int L, int cidx) { const int hd = L / NCH, n = L - hd * NCH; return cidx < 128 ? (const bf16_t*)(Kn + (size_t)(n * 128 + cidx) * 512 + hd * 128) : zrow; },
      KOffL(), KOffL(),
      [=](int L, int row, int col0, const f32x4 (&a)[4]) {
        const int hd = L / NCH, n = L - hd * NCH;
        if (col0 < 128) {
          const int tt = n * 128 + row;
#pragma unroll
          for (int d = 0; d < 2; ++d) {
            const int dh = d * 4 + hd;
            const float bt = bc[(size_t)dh * T_ALL + tt];
            const float* cf = li + (size_t)dh * T_ALL + n * 128 + col0;
            f32x4 o[4];
#pragma unroll
            for (int nn = 0; nn < 4; ++nn) {
              const float4 c4 = *(const float4*)(cf + nn * 4);
              const float cv[4] = {c4.x, c4.y, c4.z, c4.w};
#pragma unroll
              for (int j = 0; j < 4; ++j) {
                const int sc = col0 + nn * 4 + j;
                const bool ok = (d == 0) ? (sc <= row) : (sc >= row);
                o[nn][j] = ok ? a[nn][j] * bt * cv[j] : 0.f;
              }
            }
            st16bf(AS + ((size_t)dh * T_ALL + tt) * 256 + col0, o);
          }
        }
      });
    xcd_barrier(xbar);
    for (int idx = gtid; idx < 8 * (32768 + 128); idx += gstride) {
      const int dh = idx / 32896, e = idx - dh * 32896, d = dh >> 2;
      float st = 0.f;
      if (e < 32768) {
        for (int ib = 0; ib < NCH; ib += 10) {
          float xv[10], gv[10];
#pragma unroll
          for (int u = 0; u < 10; ++u) { const int n = scan_order(d, ib + u); xv[u] = Cloc[(size_t)(dh * NCH + n) * 32768 + e]; gv[u] = egch[dh * NCH + n]; }
#pragma unroll
          for (int u = 0; u < 10; ++u) { const int n = scan_order(d, ib + u); CinT[(size_t)(dh * NCH + n) * 32768 + e] = f2bf(st); st = gv[u] * st + xv[u]; }
        }
      } else {
        const int kk = e - 32768;
        for (int i = 0; i < NCH; ++i) {
          const int n = scan_order(d, i);
          nin[(dh * NCH + n) * 128 + kk] = st;
          st = egch[dh * NCH + n] * st + nloc[(dh * NCH + n) * 128 + kk];
        }
      }
    }
    xcd_barrier(xbar);
    gemm_loop<4, true>(shm, 4, vb, 1040, G,
      [=](int L, int r) { const int dh = L / NCH, n = L - dh * NCH; return (const bf16_t*)(AS + ((size_t)dh * T_ALL + n * 128 + r) * 256); },
      [=](int L, int cidx) { const int dh = L / NCH, n = L - dh * NCH, hd = dh & 3; return (const bf16_t*)(VT + ((size_t)n * 1024 + hd * 256 + cidx) * 128); },
      KOffL(),
      [=](int L, int kt) { const int dh = L / NCH, n = L - dh * NCH, hd = dh & 3;
        const int delta = (int)((CinT + (size_t)L * 32768) - (VT + ((size_t)n * 1024 + hd * 256) * 128));
        return kt < 2 ? kt * 64 : delta + (kt - 2) * 64; },
      [=](int L, int row, int col0, const f32x4 (&a)[4]) {
        const int dh = L / NCH, n = L - dh * NCH;
        float* p = hnum + ((size_t)dh * T_ALL + n * 128 + row) * 256 + col0;
#pragma unroll
        for (int nn = 0; nn < 4; ++nn) *(float4*)(p + nn * 4) = make_float4(a[nn][0], a[nn][1], a[nn][2], a[nn][3]);
      });
    xcd_barrier(xbar);
    {
      const int lane = tid & 63;
      for (int it = blockIdx.x * (NT / 64) + (tid >> 6); it < T_ALL * 4; it += G * (NT / 64)) {
        const int tt = it >> 2, hd = it & 3, n = tt >> 7;
        float hs[4] = {0.f, 0.f, 0.f, 0.f};
#pragma unroll
        for (int d = 0; d < 2; ++d) {
          const int dh = d * 4 + hd;
          const size_t m = (size_t)dh * T_ALL + tt;
          const uint2 av = *(const uint2*)&AS[m * 256 + lane * 4];
          float part;
          if (lane < 32) part = lo2f(av.x) + hi2f(av.x) + lo2f(av.y) + hi2f(av.y);
          else {
            const float4 nv = *(const float4*)&nin[(dh * NCH + n) * 128 + (lane - 32) * 4];
            part = lo2f(av.x) * nv.x + hi2f(av.x) * nv.y + lo2f(av.y) * nv.z + hi2f(av.y) * nv.w;
          }
          const float den = wave_sum(part);
          const float dn = 1.f / fmaxf(fabsf(den), 1.f);
          const float4 x = *(const float4*)&hnum[m * 256 + lane * 4];
          hs[0] += x.x * dn; hs[1] += x.y * dn; hs[2] += x.z * dn; hs[3] += x.w * dn;
        }
        float ss = hs[0] * hs[0] + hs[1] * hs[1] + hs[2] * hs[2] + hs[3] * hs[3];
        ss = wave_sum(ss);
        const float r = 1.f / sqrtf(ss * (1.f / 256.f) + EPSN);
        const int col = hd * 256 + lane * 4;
        const uint2 ov = *(const uint2*)&ZO[(size_t)tt * 1024 + col];
        const float4 g4 = *(const float4*)&ng[col];
        uint2 o;
        o.x = pack2(hs[0] * r * g4.x * sigmoid_f(lo2f(ov.x)), hs[1] * r * g4.y * sigmoid_f(hi2f(ov.x)));
        o.y = pack2(hs[2] * r * g4.z * sigmoid_f(lo2f(ov.y)), hs[3] * r * g4.w * sigmoid_f(hi2f(ov.y)));
        *(uint2*)&A2[(size_t)tt * 1024 + col] = o;
      }
    }
    xcd_barrier(xbar);
    const bf16_t* Wo = (const bf16_t*)(ws + W_MLOUT);
    auto epi_out = [=](int grow, int gcol0, const f32x4 (&a)[4]) { resid_epi(1, grow, gcol0, a); };
    dense_phase(shm, vb, G, A2, 1024, Wo, 1024, 4, 16, true, epi_out);
    xcd_barrier(xbar);
  }
  moe_layer(1, 0);

  {
    norm_phase(P, 0, P.in[6] + 2 * 1024, 2, 0, 1, 0, false, false, 0, smem);
    xcd_barrier(xbar);
    bf16_t* Zg = (bf16_t*)(R + R2_ZG); bf16_t* Zx = (bf16_t*)(R + R2_ZX); bf16_t* xc = (bf16_t*)(R + R2_XC);
    bf16_t* LA = (bf16_t*)(R + R2_LA); bf16_t* U = (bf16_t*)(R + R2_U);
    float* cA = (float*)(R + R2_CA); float* cH = (float*)(R + R2_CH);
    float* cin = (float*)(R + R2_CIN); bf16_t* A3 = (bf16_t*)(R + R2_ZX);
    const float* cw = P.in[28]; const float* cb = P.in[29];
    const float* b_a = P.in[31]; const float* b_x = P.in[33];
    const float* SP = (const float*)(ws + W_SP);
    const bf16_t* Wt = (const bf16_t*)(ws + W_LRUIN);
    auto epi_in = [=](int grow, int gcol0, const f32x4 (&a)[4]) {
      if (gcol0 < 1280) {
        f32x4 bq[4];
#pragma unroll
        for (int n = 0; n < 4; ++n)
#pragma unroll
          for (int j = 0; j < 4; ++j) bq[n][j] = gelu_f(a[n][j]);
        st16bf(Zg + (size_t)grow * 1280 + gcol0, bq);
      } else st16bf(Zx + (size_t)grow * 1280 + gcol0 - 1280, a);
    };
    dense_phase(shm, vb, G, hb, 1024, Wt, 1024, 10, 16, true, epi_in);
    xcd_barrier(xbar);
    for (int idx = gtid; idx < T_ALL * 160; idx += gstride) {
      const int t = idx / 160, c0 = (idx - t * 160) * 8;
      const int lo = t < T_CTX ? 0 : T_CTX, hi = t < T_CTX ? T_CTX : T_ALL;
      float q[8];
#pragma unroll
      for (int e = 0; e < 8; ++e) q[e] = cb[c0 + e];
#pragma unroll
      for (int j = 0; j < 4; ++j) {
        const int tt = t + j - 2;
        if (tt >= lo && tt < hi) {
          const uint4 z = *(const uint4*)&Zx[(size_t)tt * 1280 + c0];
          const float4 w0 = *(const float4*)&cw[j * 1280 + c0], w1 = *(const float4*)&cw[j * 1280 + c0 + 4];
          q[0] += lo2f(z.x) * w0.x; q[1] += hi2f(z.x) * w0.y; q[2] += lo2f(z.y) * w0.z; q[3] += hi2f(z.y) * w0.w;
          q[4] += lo2f(z.z) * w1.x; q[5] += hi2f(z.z) * w1.y; q[6] += lo2f(z.w) * w1.z; q[7] += hi2f(z.w) * w1.w;
        }
      }
      uint4 o; o.x = pack2(q[0], q[1]); o.y = pack2(q[2], q[3]); o.z = pack2(q[4], q[5]); o.w = pack2(q[6], q[7]);
      *(uint4*)&xc[(size_t)t * 1280 + c0] = o;
    }
    xcd_barrier(xbar);
    {
      const bf16_t* WLG = (const bf16_t*)(ws + W_LRUG);
      {
        gemm_loop<8, true>(shm, 2, vb, 65 * 20, G,
          [=](int L, int r) { return (const bf16_t*)(xc + (size_t)((L / 20) * 256 + r) * 1280 + ((L % 20) >> 1) * 128); },
          [=](int L, int cidx) { return WLG + ((size_t)(L % 20) * 256 + cidx) * 128; },
          KOffL(), KOffL(),
          [=](int L, int row, int col0, const f32x4 (&a)[4]) {
            const int m0 = (L / 20) * 256, q = L % 20, nb = q >> 1, d = q & 1;
            const int t = m0 + row, c = nb * 128 + (col0 >> 1);
            const uint4 xv = *(const uint4*)&xc[(size_t)t * 1280 + c];
            const unsigned xx[4] = {xv.x, xv.y, xv.z, xv.w};
            float la8[8], u8[8];
#pragma unroll
            for (int e = 0; e < 8; ++e) {
              const float ra = a[e >> 2][e & 3] + b_a[d * 1280 + c + e];
              const float rx = a[2 + (e >> 2)][e & 3] + b_x[d * 1280 + c + e];
              const float la = -8.f * sigmoid_f(ra) * SP[d * 1280 + c + e];
              const float xe = (e & 1) ? hi2f(xx[e >> 1]) : lo2f(xx[e >> 1]);
              la8[e] = la;
              u8[e] = sqrtf(-expm1f(2.f * la)) * (sigmoid_f(rx) * xe);
            }
            uint4 o1, o2;
            o1.x = pack2(la8[0], la8[1]); o1.y = pack2(la8[2], la8[3]); o1.z = pack2(la8[4], la8[5]); o1.w = pack2(la8[6], la8[7]);
            o2.x = pack2(u8[0], u8[1]); o2.y = pack2(u8[2], u8[3]); o2.z = pack2(u8[4], u8[5]); o2.w = pack2(u8[6], u8[7]);
            *(uint4*)&LA[((size_t)d * T_ALL + t) * 1280 + c] = o1;
            *(uint4*)&U[((size_t)d * T_ALL + t) * 1280 + c] = o2;
          });
      }
    }
    xcd_barrier(xbar);
    for (int idx = gtid; idx < 2 * NCH * 1280; idx += gstride) {
      const int c = idx % 1280, dn = idx / 1280, n = dn % NCH, d = dn / NCH;
      float h = 0.f, sl = 0.f;
      for (int sb = 0; sb < 128; sb += 16) {
        float lv[16], uv[16];
#pragma unroll
        for (int e = 0; e < 16; ++e) {
          const int tt = n * 128 + (d == 0 ? sb + e : 127 - sb - e);
          lv[e] = bf2f(LA[((size_t)d * T_ALL + tt) * 1280 + c]); uv[e] = bf2f(U[((size_t)d * T_ALL + tt) * 1280 + c]);
        }
#pragma unroll
        for (int e = 0; e < 16; ++e) { h = __expf(lv[e]) * h + uv[e]; sl += lv[e]; }
      }
      cA[idx] = __expf(sl);
      cH[idx] = h;
    }
    xcd_barrier(xbar);
    for (int idx = gtid; idx < 2 * 1280; idx += gstride) {
      const int d = idx / 1280, c = idx - d * 1280;
      float st = 0.f;
      for (int i = 0; i < NCH; ++i) {
        const int n = scan_order(d, i);
        const int q = (d * NCH + n) * 1280 + c;
        cin[q] = st;
        st = cA[q] * st + cH[q];
      }
    }
    xcd_barrier(xbar);
    for (int idx = gtid; idx < 128 * 1280; idx += gstride) {
      const int c = idx % 1280, n = 2 + idx / 1280;
      float h = cin[(0 * NCH + n) * 1280 + c];
      for (int sb = 0; sb < 128; sb += 16) {
        float lv[16], uv[16];
#pragma unroll
        for (int e = 0; e < 16; ++e) { const size_t o = ((size_t)(n * 128 + sb + e)) * 1280 + c; lv[e] = bf2f(LA[o]); uv[e] = bf2f(U[o]); }
#pragma unroll
        for (int e = 0; e < 16; ++e) { h = __expf(lv[e]) * h + uv[e]; A3[((size_t)(n * 128 + sb + e)) * 1280 + c] = f2bf(h); }
      }
      h = cin[(1 * NCH + n) * 1280 + c];
      for (int sb = 0; sb < 128; sb += 16) {
        float lv[16], uv[16], gv[16], h0[16];
#pragma unroll
        for (int e = 0; e < 16; ++e) {
          const size_t o = ((size_t)(n * 128 + 127 - sb - e)) * 1280 + c;
          lv[e] = bf2f(LA[(size_t)T_ALL * 1280 + o]); uv[e] = bf2f(U[(size_t)T_ALL * 1280 + o]); gv[e] = bf2f(Zg[o]); h0[e] = bf2f(A3[o]);
        }
#pragma unroll
        for (int e = 0; e < 16; ++e) {
          h = __expf(lv[e]) * h + uv[e];
          A3[((size_t)(n * 128 + 127 - sb - e)) * 1280 + c] = f2bf(gv[e] * (h0[e] + h));
        }
      }
    }
    xcd_barrier(xbar);
    const bf16_t* Wo = (const bf16_t*)(ws + W_LRUOUT);
    auto epi_out = [=](int grow, int gcol0, const f32x4 (&a)[4]) { resid_epi(2, grow, gcol0, a); };
    dense_phase(shm, vb, G, A3, 1280, Wo, 1280, 4, 20, false, epi_out);
    xcd_barrier(xbar);
  }
  moe_layer(2, T_CTX);

  {
    norm_phase(P, T_CTX, P.in[6] + 3 * 1024, 3, 0, 2, T_CTX, false, false, 0, smem);
    xcd_barrier(xbar);
    bf16_t* YT = (bf16_t*)(R + R3_YT); bf16_t* GT = (bf16_t*)(R + R3_GT); bf16_t* Ff = (bf16_t*)(R + R3_FF);
    const bf16_t* WP = (const bf16_t*)(ws + W_FNP);
    gemm_loop<8, false>(shm, 16, vb, 64 * 8, G,
      [=](int L, int r) { return (const bf16_t*)(hb + (size_t)(T_CTX + 128 * (r & 127) + 2 * (L >> 3) + (r >> 7)) * DM); },
      [=](int L, int cidx) { return WP + (size_t)((L & 7) * 256 + cidx) * 1024; }, KOffL(), KOffL(),
      [=](int L, int row0, int col, f32x4 v) {
        const int b = 2 * (L >> 3) + (row0 >> 7), a0 = row0 & 127, n0 = (L & 7) * 256;
        uint2 o; o.x = pack2(v[0], v[1]); o.y = pack2(v[2], v[3]);
        *(uint2*)&YT[((size_t)b * 2048 + n0 + col) * 128 + a0] = o;
      });
    xcd_barrier(xbar);
    {
      const bf16_t* DA = (const bf16_t*)(ws + W_DA);
      gemm_loop<4, false>(shm, 4, vb, 1024, G,
        [=](int L, int r) { return (const bf16_t*)(YT + ((size_t)r * 2048 + L) * 128); },
        [=](int L, int cidx) { return DA + (size_t)cidx * 256; },
        [=](int L, int kt) { return kt < 2 ? kt * 64 : 1024 * 128 + (kt - 2) * 64; }, KOffL(),
        [=](int L, int row0, int col, f32x4 v) {
          const int ri = col >> 7, c2 = col & 127;
          uint2 o; o.x = pack2(v[0], v[1]); o.y = pack2(v[2], v[3]);
          *(uint2*)&GT[(((size_t)c2 * 1024 + L) * 2 + ri) * 128 + row0] = o;
        });
    }
    xcd_barrier(xbar);
    {
      const bf16_t* TW = (const bf16_t*)(ws + W_TW);
      gemm_loop<4, true>(shm, 4, vb, 128 * 4, G,
        [=](int L, int r) { return TW + ((size_t)(L >> 2) * 128 + r) * 256; },
        [=](int L, int cidx) { return (const bf16_t*)(GT + ((size_t)(L >> 2) * 1024 + (L & 3) * 256 + cidx) * 256); }, KOffL(), KOffL(),
        [=](int L, int row, int col0, const f32x4 (&a)[4]) {
          const int c2 = L >> 2, n0 = (L & 3) * 256;
          f32x4 b[4];
#pragma unroll
          for (int n = 0; n < 4; ++n) b[n] = a[n] * (1.f / 2048.f);
          st16bf(Ff + (size_t)(c2 + 128 * row) * 1024 + n0 + col0, b);
        });
    }
    xcd_barrier(xbar);
    const bf16_t* Wo = (const bf16_t*)(ws + W_FNOUT);
    const bf16_t* FfA = Ff - (size_t)T_CTX * 1024;
    auto epi_out = [=](int grow, int gcol0, const f32x4 (&a)[4]) { resid_epi(3, grow, gcol0, a); };
    dense_phase(shm, vb, G, FfA, 1024, Wo, 1024, 4, 16, false, epi_out);
    xcd_barrier(xbar);
  }
  moe_layer(3, T_CTX);

  norm_phase(P, T_CTX, P.in[8], 0, -1, 3, T_CTX, true, false, 0, smem);
}

#undef tid
#undef gtid
#undef gstride
extern "C" void kernel_launch(void* const* d_in, const int* in_sizes, int n_in, void* d_out, int out_size,
                              void* d_ws, size_t ws_size, hipStream_t stream) {
  static int grid_blocks = 0;
  if (!grid_blocks) {
    int dev = 0, cus = 0, per_cu = 0;
    (void)hipGetDevice(&dev);
    (void)hipDeviceGetAttribute(&cus, hipDeviceAttributeMultiprocessorCount, dev);
    (void)hipOccupancyMaxActiveBlocksPerMultiprocessor(&per_cu, mega, NT, 0);
    if (per_cu < 1) fprintf(stderr, "kernel_launch: occupancy query says %d blocks/CU\n", per_cu);
    grid_blocks = cus;
    if (ws_size < WS_NEED) fprintf(stderr, "kernel_launch: workspace too small: %zu < %zu\n", ws_size, (size_t)WS_NEED);
  }
  if (n_in != 38 || ws_size < WS_NEED) return;
  Params p{};
  for (int i = 0; i < 38; ++i) p.in[i] = (const float*)d_in[i];
  p.out = (float*)d_out;
  p.ws = (unsigned char*)d_ws;
  (void)hipMemsetAsync((char*)d_ws + WS_BAR, 0, 16384, stream);
  void* args[] = {&p};
  hipError_t e = hipLaunchCooperativeKernel((void*)mega, dim3(grid_blocks), dim3(NT), args, 0, stream);
  if (e != hipSuccess) fprintf(stderr, "cooperative launch failed: %s (grid %d)\n", hipGetErrorString(e), grid_blocks);
}
```

```cpp
#include <hip/hip_runtime.h>
#include <hip/hip_cooperative_groups.h>
#include <cstdio>
namespace cg = cooperative_groups;

#define T_ALL 16640
#define T_LAT 16384
#define T_CTX 256
#define DM 1024
#define NCH 130
#define EPSN 1e-6f
#define NT 512

typedef unsigned short bf16_t;
using bf16x8 = __attribute__((ext_vector_type(8))) short;
using f32x4 = __attribute__((ext_vector_type(4))) float;

__device__ __forceinline__ float bf2f(bf16_t v) { return __uint_as_float(((unsigned)v) << 16); }
__device__ __forceinline__ bf16_t f2bf(float f) { unsigned u = __float_as_uint(f); u += 0x7fffu + ((u >> 16) & 1u); return (bf16_t)(u >> 16); }
__device__ __forceinline__ unsigned pack2(float a, float b) { return (unsigned)f2bf(a) | (((unsigned)f2bf(b)) << 16); }
__device__ __forceinline__ float lo2f(unsigned u) { return __uint_as_float(u << 16); }
__device__ __forceinline__ float hi2f(unsigned u) { return __uint_as_float(u & 0xffff0000u); }

__device__ __forceinline__ int opaque_tid() { int t = threadIdx.x; asm volatile("" : "+v"(t)); return t; }

constexpr size_t AL(size_t x) { return (x + 255) & ~(size_t)255; }
constexpr size_t WS_MOD    = 0;
constexpr size_t WS_MODP   = AL(WS_MOD + 4 * 2 * 6144 * 4);
constexpr size_t WS_CNT    = AL(WS_MODP + 16 * 4 * 2 * 6144 * 4);
constexpr size_t WS_ZROW   = AL(WS_CNT + 4 * 32 * 32 * 4 + 256);
constexpr size_t WS_BAR    = AL(WS_ZROW + 8192);
constexpr size_t WS_TOK    = AL(WS_BAR + 16384);
constexpr size_t WS_H      = AL(WS_TOK + (size_t)T_ALL * DM * 4);
constexpr size_t WS_HLO    = AL(WS_H + (size_t)T_ALL * DM * 2);
constexpr size_t WS_ASGW   = AL(WS_HLO + (size_t)T_ALL * DM * 2);
constexpr size_t WS_LIST   = AL(WS_ASGW + 33280 * 4);
constexpr size_t WS_ROWTOK = AL(WS_LIST + (size_t)32 * 33280 * 4);
constexpr size_t WS_ROWEXP = AL(WS_ROWTOK + 37376 * 4);
constexpr size_t W_CMIN   = AL(WS_ROWEXP + 292 * 4);
constexpr size_t W_CMOUT  = AL(W_CMIN + (size_t)2048 * 1024 * 2);
constexpr size_t W_MLIN   = AL(W_CMOUT + (size_t)1024 * 1024 * 2);
constexpr size_t W_MLOUT  = AL(W_MLIN + (size_t)3072 * 1024 * 2);
constexpr size_t W_LRUIN  = AL(W_MLOUT + (size_t)1024 * 1024 * 2);
constexpr size_t W_LRUOUT = AL(W_LRUIN + (size_t)2560 * 1024 * 2);
constexpr size_t W_FNIN   = AL(W_LRUOUT + (size_t)1024 * 1280 * 2);
constexpr size_t W_FNP    = AL(W_FNIN + (size_t)1024 * 1024 * 2);
constexpr size_t W_FNOUT  = AL(W_FNP + (size_t)2048 * 1024 * 2);
constexpr size_t W_DC     = AL(W_FNOUT + (size_t)1024 * 1024 * 2);
constexpr size_t W_DA     = AL(W_DC + 512 * 256 * 2);
constexpr size_t W_TW     = AL(W_DA + 256 * 256 * 2);
constexpr size_t W_LRUG   = AL(W_TW + (size_t)128 * 128 * 256 * 2);
constexpr size_t W_SP     = AL(W_LRUG + (size_t)20 * 256 * 128 * 2);
constexpr size_t W_PE     = AL(W_SP + 2 * 1280 * 4);
constexpr size_t W_EGU    = AL(W_PE + (size_t)(2 * 256 + 2 * 64) * 256 * 4);
constexpr size_t W_ED     = AL(W_EGU + (size_t)128 * 1024 * 1024 * 2);
constexpr size_t WS_R     = AL(W_ED + (size_t)128 * 1024 * 512 * 2);
constexpr size_t R_YBUF = 0;
constexpr size_t R_HB   = AL(R_YBUF + (size_t)33280 * 1024 * 2);
constexpr size_t R_MOE_END = AL(R_HB + (size_t)37376 * 512 * 2);
constexpr size_t R0_ZU  = 0;
constexpr size_t R0_ZVT = AL(R0_ZU + (size_t)T_ALL * 1024 * 2);
constexpr size_t R0_P   = AL(R0_ZVT + (size_t)T_ALL * 1024 * 2);
constexpr size_t R0_WSC = AL(R0_P + (size_t)T_ALL * 1024 * 2);
constexpr size_t R0_END = AL(R0_WSC + (size_t)NCH * 4 * 128 * 128 * 2);
constexpr size_t R1_ZQK  = 0;
constexpr size_t R1_ZO   = AL(R1_ZQK + (size_t)T_ALL * 1024 * 2);
constexpr size_t R1_VT   = AL(R1_ZO + (size_t)T_ALL * 1024 * 2);
constexpr size_t R1_GPRE = AL(R1_VT + (size_t)T_ALL * 1024 * 2);
constexpr size_t R1_QN   = AL(R1_GPRE + (size_t)T_ALL * 16 * 4);
constexpr size_t R1_KN   = AL(R1_QN + (size_t)T_ALL * 512 * 2);
constexpr size_t R1_AS   = AL(R1_KN + (size_t)T_ALL * 512 * 2);
constexpr size_t R1_KWT  = AL(R1_AS + (size_t)8 * T_ALL * 256 * 2);
constexpr size_t R1_BC   = AL(R1_KWT + (size_t)8 * T_ALL * 128 * 2);
constexpr size_t R1_LI   = AL(R1_BC + (size_t)8 * T_ALL * 4);
constexpr size_t R1_GCH  = AL(R1_LI + (size_t)8 * T_ALL * 4);
constexpr size_t R1_NLOC = AL(R1_GCH + 8 * NCH * 4);
constexpr size_t R1_NIN  = AL(R1_NLOC + 8 * NCH * 128 * 4);
constexpr size_t R1_CLOC = AL(R1_NIN + 8 * NCH * 128 * 4);
constexpr size_t R1_CINT = AL(R1_CLOC + (size_t)8 * T_ALL * 256 * 4);
constexpr size_t R1_HDEN = AL(R1_CINT + (size_t)8 * T_ALL * 256 * 2);
constexpr size_t R1_A2   = AL(R1_HDEN + 256);
constexpr size_t R1_END  = AL(R1_A2 + (size_t)T_ALL * 1024 * 2);
constexpr size_t R2_ZG  = 0;
constexpr size_t R2_ZX  = AL(R2_ZG + (size_t)T_ALL * 1280 * 2);
constexpr size_t R2_XC  = AL(R2_ZX + (size_t)T_ALL * 1280 * 2);
constexpr size_t R2_LA  = AL(R2_XC + (size_t)T_ALL * 1280 * 2);
constexpr size_t R2_U   = AL(R2_LA + (size_t)2 * T_ALL * 1280 * 2);
constexpr size_t R2_CA  = AL(R2_U + (size_t)2 * T_ALL * 1280 * 2);
constexpr size_t R2_CH  = AL(R2_CA + 2 * NCH * 1280 * 4);
constexpr size_t R2_CIN = AL(R2_CH + 2 * NCH * 1280 * 4);
constexpr size_t R2_END = AL(R2_CIN + 2 * NCH * 1280 * 4);
constexpr size_t R3_YT = 0;
constexpr size_t R3_GT = AL(R3_YT + (size_t)128 * 2048 * 128 * 2);
constexpr size_t R3_FF = AL(R3_GT + (size_t)128 * 2048 * 128 * 2);
constexpr size_t R3_END = AL(R3_FF + (size_t)T_LAT * 1024 * 2);
constexpr size_t cmax(size_t a, size_t b) { return a > b ? a : b; }
constexpr size_t R_SIZE = cmax(cmax(R_MOE_END, R0_END), cmax(cmax(R1_END, R2_END), R3_END));
constexpr size_t WS_NEED = WS_R + R_SIZE;

struct Params { const float* in[38]; float* out; unsigned char* ws; };

__device__ __forceinline__ float sigmoid_f(float x) { return __frcp_rn(1.f + __expf(-x)); }
__device__ __forceinline__ float silu_f(float x) { return x * __frcp_rn(1.f + __expf(-x)); }
__device__ __forceinline__ float gelu_f(float x) {
  const float u2 = 1.5957691216057308f * (x + 0.044715f * x * x * x);
  return x * __frcp_rn(1.f + __expf(-u2));
}
__device__ __forceinline__ float logsig_f(float x) { return fminf(x, 0.f) - log1pf(expf(-fabsf(x))); }
__device__ __forceinline__ float wave_sum(float v) {
#pragma unroll
  for (int o = 32; o >= 1; o >>= 1) v += __shfl_xor(v, o);
  return v;
}
__device__ __forceinline__ int scan_order(int d, int i) { return d == 0 ? i : (i == 0 ? 1 : (i == 1 ? 0 : 131 - i)); }
__device__ __forceinline__ void st16bf(bf16_t* p, const f32x4 (&a)[4]) {
  uint4 o0, o1;
  o0.x = pack2(a[0][0], a[0][1]); o0.y = pack2(a[0][2], a[0][3]); o0.z = pack2(a[1][0], a[1][1]); o0.w = pack2(a[1][2], a[1][3]);
  o1.x = pack2(a[2][0], a[2][1]); o1.y = pack2(a[2][2], a[2][3]); o1.z = pack2(a[3][0], a[3][1]); o1.w = pack2(a[3][2], a[3][3]);
  *(uint4*)p = o0; *(uint4*)(p + 8) = o1;
}

__device__ __forceinline__ int lds_byte(int r, int c) {
  const int st = (r >> 4) * 2 + (c >> 5), ob = (r & 15) * 64 + (c & 31) * 2;
  return st * 1024 + (ob ^ (((ob >> 9) & 1) << 5));
}
__device__ __forceinline__ void stage_rc(int b, int& R, int& C) {
  const int st = b >> 10, sb = b & 1023, swz = sb ^ (((sb >> 9) & 1) << 5);
  R = (st >> 1) * 16 + (swz >> 6);
  C = (st & 1) * 32 + ((swz & 63) >> 1);
}
__device__ __forceinline__ int perm_col(int p) {
  const int q = p & 63, n = q >> 4, i = q & 15;
  return (p & ~63) + (i >> 2) * 16 + n * 4 + (i & 3);
}

struct KOffL { __device__ __forceinline__ int operator()(int, int kt) const { return kt * 64; } };
#define GEMM_LDS_TOTAL 147456
template <int MI, bool SWAP, class RA, class RB, class KA, class KB, class EP>
__device__ __forceinline__ void gemm_loop(char* shm, int nk, int Lbeg, int Lend, int Lstep, RA rowA, RB rowB, KA koffA, KB koffB, EP epi) {
  constexpr int BM = 32 * MI, GLA = MI / 2, GLB = 4;
  constexpr int TILE_A = BM * 128, TILE_B = 256 * 128, STG = TILE_A + TILE_B;
  constexpr int NBUF = (3 * STG <= GEMM_LDS_TOTAL) ? 3 : 2;
  static_assert(NBUF * STG <= GEMM_LDS_TOTAL, "LDS");
  if (Lbeg >= Lend) return;
  const int tid = opaque_tid(), wid = tid >> 6, lane = tid & 63, wr = wid >> 2, wc = wid & 3, fr = lane & 15, fq = lane >> 4;
  const bf16_t* pa[GLA];
  const bf16_t* pb[GLB];
#define GL_SETP(L_) do { int t2_ = tid; asm volatile("" : "+v"(t2_)); const int w2_ = t2_ >> 6, l2_ = t2_ & 63;        \
    _Pragma("unroll") for (int i = 0; i < GLA; ++i) { int R_, C_; stage_rc(w2_ * 1024 + i * 8192 + l2_ * 16, R_, C_); pa[i] = rowA((L_), R_) + C_; } \
    _Pragma("unroll") for (int i = 0; i < GLB; ++i) { int R_, C_; stage_rc(w2_ * 1024 + i * 8192 + l2_ * 16, R_, C_); pb[i] = rowB((L_), SWAP ? perm_col(R_) : R_) + C_; } } while (0)
#define GL_ISSUE(buf, kt, L_) do { const int ka_ = koffA((L_), (kt)), kb_ = koffB((L_), (kt)); char* base_ = shm + (buf) * STG;  \
    _Pragma("unroll") for (int i = 0; i < GLA; ++i)                                                                    \
      __builtin_amdgcn_global_load_lds((const unsigned*)(pa[i] + ka_), (unsigned*)(base_ + wid * 1024 + i * 8192), 16, 0, 0); \
    _Pragma("unroll") for (int i = 0; i < GLB; ++i)                                                                    \
      __builtin_amdgcn_global_load_lds((const unsigned*)(pb[i] + kb_), (unsigned*)(base_ + TILE_A + wid * 1024 + i * 8192), 16, 0, 0); } while (0)
#define GL_RAWBAR() do { asm volatile("s_waitcnt lgkmcnt(0)" ::: "memory"); __builtin_amdgcn_s_barrier(); } while (0)
  const int npre = nk < NBUF ? nk : NBUF;
  GL_SETP(Lbeg);
  for (int s = 0; s < npre; ++s) GL_ISSUE(s, s, Lbeg);
  for (int L = Lbeg; L < Lend; L += Lstep) {
    f32x4 acc[MI][4];
#pragma unroll
    for (int m = 0; m < MI; ++m)
#pragma unroll
      for (int n = 0; n < 4; ++n) acc[m][n] = f32x4{0.f, 0.f, 0.f, 0.f};
    int cur = 0;
    for (int t = 0; t < nk; ++t) {
      if (NBUF == 3 && t >= 1 && t + 1 < nk) {
        if (GLA + GLB == 6) asm volatile("s_waitcnt vmcnt(6)" ::: "memory"); else asm volatile("s_waitcnt vmcnt(5)" ::: "memory");
      } else asm volatile("s_waitcnt vmcnt(0)" ::: "memory");
      GL_RAWBAR();
      if (t >= 1 && t + NBUF - 1 < nk) { const int nb_ = (cur == 0) ? NBUF - 1 : cur - 1; GL_ISSUE(nb_, t + NBUF - 1, L); }
      const char* sa = shm + cur * STG;
      const char* sb = sa + TILE_A;
#pragma unroll
      for (int ks = 0; ks < 2; ++ks) {
        bf16x8 At[MI], Bf[4];
#pragma unroll
        for (int m = 0; m < MI; ++m) At[m] = *(const bf16x8*)(sa + lds_byte(wr * (MI * 16) + m * 16 + fr, ks * 32 + fq * 8));
#pragma unroll
        for (int n = 0; n < 4; ++n) Bf[n] = *(const bf16x8*)(sb + lds_byte(wc * 64 + n * 16 + fr, ks * 32 + fq * 8));
#pragma unroll
        for (int m = 0; m < MI; ++m)
#pragma unroll
          for (int n = 0; n < 4; ++n) {
            if (SWAP) acc[m][n] = __builtin_amdgcn_mfma_f32_16x16x32_bf16(Bf[n], At[m], acc[m][n], 0, 0, 0);
            else      acc[m][n] = __builtin_amdgcn_mfma_f32_16x16x32_bf16(At[m], Bf[n], acc[m][n], 0, 0, 0);
          }
        __builtin_amdgcn_sched_barrier(0);
      }
      cur = (cur == NBUF - 1) ? 0 : cur + 1;
    }
    GL_RAWBAR();
    const int Ln = L + Lstep;
    if (Ln < Lend) { GL_SETP(Ln); for (int s = 0; s < npre; ++s) GL_ISSUE(s, s, Ln); }
    if constexpr (SWAP) {
      epi(L, wr * (MI * 16) + fr, wc * 64 + fq * 16, acc);
    } else {
#pragma unroll
      for (int m = 0; m < MI; ++m)
#pragma unroll
        for (int n = 0; n < 4; ++n) epi(L, wr * (MI * 16) + m * 16 + fq * 4, wc * 64 + n * 16 + fr, acc[m][n]);
    }
  }
  asm volatile("s_waitcnt vmcnt(0)" ::: "memory");
#undef GL_SETP
#undef GL_ISSUE
#undef GL_RAWBAR
}

template <class F> struct PerM {
  F f;
  template <int MI> __device__ __forceinline__ void operator()(int L, int rb, int c0, const f32x4 (&a)[MI][4]) const {
#pragma unroll
    for (int m = 0; m < MI; ++m) f(L, rb + 16 * m, c0, a[m]);
  }
};
template <class F> __device__ __forceinline__ PerM<F> per_m(F f) { return PerM<F>{f}; }

template <class EP>
__device__ __forceinline__ void dense_phase(char* shm, int vb, int G, const bf16_t* A, int lda, const bf16_t* Wt, int ldw,
                                            int ntn, int nk, bool with_ctx, EP epi) {
  const int nbig = 64 * ntn;
  gemm_loop<8, true>(shm, nk, vb, nbig, G,
    [=](int L, int r) { return A + (size_t)((1 + L / ntn) * 256 + r) * lda; },
    [=](int L, int c) { return Wt + (size_t)((L % ntn) * 256 + c) * ldw; }, KOffL(), KOffL(),
    per_m([=](int L, int row, int col0, const f32x4 (&a)[4]) { epi((1 + L / ntn) * 256 + row, (L % ntn) * 256 + col0, a); }));
  if (with_ctx) {
    const int s = (vb - (nbig % G) + G) % G;
    gemm_loop<2, true>(shm, nk, s, 4 * ntn, G,
      [=](int L, int r) { return A + (size_t)((L / ntn) * 64 + r) * lda; },
      [=](int L, int c) { return Wt + (size_t)((L % ntn) * 256 + c) * ldw; }, KOffL(), KOffL(),
      per_m([=](int L, int row, int col0, const f32x4 (&a)[4]) { epi((L / ntn) * 64 + row, (L % ntn) * 256 + col0, a); }));
  }
}

#define XB_TMO      128
#define XB_XCNT(j)  (256  + 64 * (j))
#define XB_XSUB(j)  (1280 + 64 * (j))
#define XB_XGEN(j)  (2304 + 64 * (j))
#define XB_TOP      3328
#define XB_TOPGEN   3392
#define XCD_BAR_WORDS 3456
#define XB_SPIN_CAP (1u << 22)
#define LAS __attribute__((address_space(3)))
__device__ __forceinline__ unsigned xb_ld(unsigned* p)              { return __hip_atomic_load(p, __ATOMIC_RELAXED, __HIP_MEMORY_SCOPE_AGENT); }
__device__ __forceinline__ unsigned xb_add(unsigned* p, unsigned v) { return __hip_atomic_fetch_add(p, v, __ATOMIC_RELAXED, __HIP_MEMORY_SCOPE_AGENT); }
__device__ __forceinline__ unsigned xb_xcc_id() { return (unsigned)__builtin_amdgcn_s_getreg((3 << 11) | 20) & 0xFu; }
#define XB_SPIN(cond, bar) do { unsigned _sp = 0; while (cond) { __builtin_amdgcn_s_sleep(1); \
    if ((++_sp & 255u) == 0u) { if (xb_ld(&(bar)[XB_TMO])) break; if (_sp > XB_SPIN_CAP) { atomicAdd(&(bar)[XB_TMO], 1u); break; } } } } while (0)
struct XcdBarrier { unsigned* bar; unsigned x; volatile LAS unsigned* st; };
__device__ __forceinline__ XcdBarrier xcd_barrier_post(unsigned* bar, volatile LAS unsigned* st) {
    XcdBarrier b; b.bar = bar; b.x = xb_xcc_id(); b.st = st;
    if (threadIdx.x == 0) (void)xb_add(&bar[XB_XCNT(b.x)], 1u);
    return b;
}
__device__ __forceinline__ void xcd_barrier_complete(unsigned* bar, unsigned x, unsigned& nloc, unsigned& nx) {
    const unsigned G = gridDim.x * gridDim.y * gridDim.z;
    unsigned sum, cnt, mine, sp = 0u;
    for (;;) {
        sum = 0u; cnt = 0u; mine = 0u;
#pragma unroll
        for (unsigned j = 0; j < 16; ++j) { const unsigned c = xb_ld(&bar[XB_XCNT(j)]); sum += c; cnt += (c > 0u) ? 1u : 0u; mine = (j == x) ? c : mine; }
        if (sum == G) break;
        __builtin_amdgcn_s_sleep(1);
        if ((++sp & 255u) == 0u) { if (xb_ld(&bar[XB_TMO])) break; if (sp > XB_SPIN_CAP) { atomicAdd(&bar[XB_TMO], 1u); break; } }
    }
    nloc = mine > 0u ? mine : 1u; nx = cnt > 0u ? cnt : 1u;
}
__device__ __forceinline__ void xcd_barrier(const XcdBarrier& b) {
    asm volatile("s_waitcnt vmcnt(0)" ::: "memory");
    __syncthreads();
    if (threadIdx.x == 0) {
        unsigned* bar = b.bar;
        __builtin_amdgcn_s_waitcnt(0);
        unsigned nloc = b.st[0], nx = b.st[1];
        if (nloc == 0u) { xcd_barrier_complete(bar, b.x, nloc, nx); b.st[0] = nloc; b.st[1] = nx; }
        const unsigned old = xb_add(&bar[XB_XSUB(b.x)], 1u);
        const unsigned gen = old / nloc;
        if (old + 1u == (gen + 1u) * nloc) {
            __builtin_amdgcn_fence(__ATOMIC_RELEASE, "agent");
            asm volatile("s_waitcnt vmcnt(0)" ::: "memory");
            const unsigned og = xb_add(&bar[XB_TOP], 1u);
            const unsigned tg = og / nx;
            if (og + 1u == (tg + 1u) * nx) xb_add(&bar[XB_TOPGEN], 1u);
            else XB_SPIN(xb_ld(&bar[XB_TOPGEN]) == tg, bar);
            __builtin_amdgcn_fence(__ATOMIC_ACQUIRE, "agent");
            xb_add(&bar[XB_XGEN(b.x)], 1u);
            asm volatile("s_waitcnt vmcnt(0)" ::: "memory");
        } else {
            XB_SPIN(xb_ld(&bar[XB_XGEN(b.x)]) == gen, bar);
            __builtin_amdgcn_fence(__ATOMIC_ACQUIRE, "agent");
            asm volatile("s_waitcnt vmcnt(0)" ::: "memory");
        }
    }
    __syncthreads();
}

template <class AF, class BF, class EF>
__device__ __forceinline__ void gemm_naive(int M, int N, int K, AF af, BF bf, EF ef, float* smem_all) {
  const int half = threadIdx.x >> 8, tid = threadIdx.x & 255;
  float* smem = smem_all + half * (2 * 16 * 68);
  const int tilesM = (M + 63) >> 6, tilesN = (N + 63) >> 6;
  const int ntiles = tilesM * tilesN;
  float (*As)[68] = (float (*)[68])smem;
  float (*Bs)[68] = (float (*)[68])(smem + 16 * 68);
  const int ty = tid >> 4, tx = tid & 15;
  const int stride = gridDim.x * 2;
  const int iters = (ntiles + stride - 1) / stride;
  for (int it = 0; it < iters; ++it) {
    const int tile = it * stride + blockIdx.x * 2 + half;
    const bool valid = tile < ntiles;
    const int tm = valid ? tile / tilesN : 0, tn = valid ? tile - tm * tilesN : 0;
    const int m0 = tm << 6, n0 = tn << 6;
    float acc[4][4];
#pragma unroll
    for (int i = 0; i < 4; ++i)
#pragma unroll
      for (int j = 0; j < 4; ++j) acc[i][j] = 0.f;
    for (int k0 = 0; k0 < K; k0 += 16) {
#pragma unroll
      for (int i = 0; i < 4; ++i) {
        const int mm = (tid >> 4) + 16 * i, kk = tid & 15;
        const int m = m0 + mm, k = k0 + kk;
        As[kk][mm] = (valid && m < M && k < K) ? af(m, k, n0) : 0.f;
      }
#pragma unroll
      for (int i = 0; i < 4; ++i) {
        const int kk = (tid >> 6) + 4 * i, nn = tid & 63;
        const int k = k0 + kk, n = n0 + nn;
        Bs[kk][nn] = (valid && k < K && n < N) ? bf(k, n, m0) : 0.f;
      }
      __syncthreads();
#pragma unroll
      for (int kk = 0; kk < 16; ++kk) {
        const float4 a = *(const float4*)&As[kk][ty * 4];
        const float4 b = *(const float4*)&Bs[kk][tx * 4];
        const float av[4] = {a.x, a.y, a.z, a.w};
        const float bv[4] = {b.x, b.y, b.z, b.w};
#pragma unroll
        for (int i = 0; i < 4; ++i)
#pragma unroll
          for (int j = 0; j < 4; ++j) acc[i][j] = fmaf(av[i], bv[j], acc[i][j]);
      }
      __syncthreads();
    }
    if (valid) {
#pragma unroll
      for (int i = 0; i < 4; ++i)
#pragma unroll
        for (int j = 0; j < 4; ++j) {
          const int m = m0 + ty * 4 + i, n = n0 + tx * 4 + j;
          if (m < M && n < N) ef(m, n, acc[i][j]);
        }
    }
  }
}

__device__ __forceinline__ void conv_tile(const float* src, int ldn, bf16_t* dst, int ldk, int k0, int n0, int mapmode, float* sm) {
  const int tid = opaque_tid();
  float (*tl)[65] = (float (*)[65])sm;
  {
    const int row = tid >> 3, c4 = (tid & 7) * 4;
    const float4 a = *(const float4*)&src[(size_t)(k0 + row) * ldn + n0 + c4];
    const float4 b = *(const float4*)&src[(size_t)(k0 + row) * ldn + n0 + 32 + c4];
    tl[row][c4 + 0] = a.x; tl[row][c4 + 1] = a.y; tl[row][c4 + 2] = a.z; tl[row][c4 + 3] = a.w;
    tl[row][32 + c4 + 0] = b.x; tl[row][32 + c4 + 1] = b.y; tl[row][32 + c4 + 2] = b.z; tl[row][32 + c4 + 3] = b.w;
  }
  __syncthreads();
  {
    const int n = tid >> 3, kg = (tid & 7) * 8;
    uint4 o;
    o.x = pack2(tl[kg + 0][n], tl[kg + 1][n]); o.y = pack2(tl[kg + 2][n], tl[kg + 3][n]);
    o.z = pack2(tl[kg + 4][n], tl[kg + 5][n]); o.w = pack2(tl[kg + 6][n], tl[kg + 7][n]);
    const int h = n0 + n;
    const int dr = mapmode == 0 ? h : ((h >> 3) * 16 + (h & 7) + (mapmode == 2 ? 8 : 0));
    *(uint4*)&dst[(size_t)dr * ldk + k0 + kg] = o;
  }
  __syncthreads();
}

__device__ __forceinline__ void norm_phase(const Params& P, int t0, const float* gw,
                                           int mod_layer, int shift_idx,
                                           int pend_layer, int pend_t0,
                                           bool to_out, bool router, int layer, float* wl) {
  int* rl = (int*)((char*)wl + GEMM_LDS_TOTAL + 272);
  unsigned char* ws = P.ws;
  float* tok = (float*)(ws + WS_TOK);
  bf16_t* hb = (bf16_t*)(ws + WS_H);
  const float* mod = (const float*)(ws + WS_MOD);
  const bf16_t* ybuf = (const bf16_t*)(ws + WS_R + R_YBUF);
  const int tid_n = opaque_tid();
  const int lane = tid_n & 63;
  if (router) {
    const float* rgw = P.in[9] + (size_t)layer * 1024 * 4;
    const float* rew = P.in[11] + (size_t)layer * 1024 * 32;
    for (int idx = tid_n; idx < 1024 * 36; idx += NT) {
      const int k = idx / 36, j = idx - k * 36;
      const int rho = (((k >> 8) * 4 + (k & 3)) * 64) + ((k & 255) >> 2);
      wl[rho * 36 + j] = (j < 4) ? rgw[k * 4 + j] : rew[k * 32 + (j - 4)];
    }
    if (tid_n < 80) rl[tid_n] = 0;
    __syncthreads();
  }
  const int gw_id = blockIdx.x * (NT / 64) + (tid_n >> 6);
  const int gw_n = gridDim.x * (NT / 64);
  for (int t = t0 + gw_id; t < T_ALL; t += gw_n) {
    const int s = (t < T_CTX) ? 1 : 0;
    float v[16];
#pragma unroll
    for (int j = 0; j < 4; ++j) {
      const int n = j * 256 + lane * 4;
      const float4 x = *(const float4*)&tok[(size_t)t * DM + n];
      v[j * 4 + 0] = x.x; v[j * 4 + 1] = x.y; v[j * 4 + 2] = x.z; v[j * 4 + 3] = x.w;
    }
    if (pend_layer >= 0 && t >= pend_t0) {
      const float* gate = mod + (size_t)((pend_layer * 2 + s) * 6 + 5) * 1024;
#pragma unroll
      for (int j = 0; j < 4; ++j) {
        const int n = j * 256 + lane * 4;
        const uint2 y0 = *(const uint2*)&ybuf[(size_t)(2 * t) * DM + n];
        const uint2 y1 = *(const uint2*)&ybuf[(size_t)(2 * t + 1) * DM + n];
        const float4 g = *(const float4*)&gate[n];
        v[j * 4 + 0] += g.x * (lo2f(y0.x) + lo2f(y1.x));
        v[j * 4 + 1] += g.y * (hi2f(y0.x) + hi2f(y1.x));
        v[j * 4 + 2] += g.z * (lo2f(y0.y) + lo2f(y1.y));
        v[j * 4 + 3] += g.w * (hi2f(y0.y) + hi2f(y1.y));
        *(float4*)&tok[(size_t)t * DM + n] = make_float4(v[j * 4 + 0], v[j * 4 + 1], v[j * 4 + 2], v[j * 4 + 3]);
      }
    }
    float ss = 0.f;
#pragma unroll
    for (int e = 0; e < 16; ++e) ss += v[e] * v[e];
    ss = wave_sum(ss);
    const float r = 1.f / sqrtf(ss * (1.f / 1024.f) + EPSN);
    float h[16];
#pragma unroll
    for (int j = 0; j < 4; ++j) {
      const int n = j * 256 + lane * 4;
      const float4 g = *(const float4*)&gw[n];
      h[j * 4 + 0] = v[j * 4 + 0] * r * g.x;
      h[j * 4 + 1] = v[j * 4 + 1] * r * g.y;
      h[j * 4 + 2] = v[j * 4 + 2] * r * g.z;
      h[j * 4 + 3] = v[j * 4 + 3] * r * g.w;
      if (shift_idx >= 0) {
        const float* sh = mod + (size_t)((mod_layer * 2 + s) * 6 + shift_idx) * 1024;
        const float* sc = sh + 1024;
        const float4 a = *(const float4*)&sh[n];
        const float4 b = *(const float4*)&sc[n];
        h[j * 4 + 0] = h[j * 4 + 0] * (1.f + b.x) + a.x;
        h[j * 4 + 1] = h[j * 4 + 1] * (1.f + b.y) + a.y;
        h[j * 4 + 2] = h[j * 4 + 2] * (1.f + b.z) + a.z;
        h[j * 4 + 3] = h[j * 4 + 3] * (1.f + b.w) + a.w;
      }
      if (to_out) {
        *(float4*)&P.out[(size_t)(t - T_CTX) * DM + n] = make_float4(h[j * 4 + 0], h[j * 4 + 1], h[j * 4 + 2], h[j * 4 + 3]);
      } else {
        uint2 o; o.x = pack2(h[j * 4 + 0], h[j * 4 + 1]); o.y = pack2(h[j * 4 + 2], h[j * 4 + 3]);
        *(uint2*)&hb[(size_t)t * DM + n] = o;
      }
    }
    if (router) {
      float lg[36];
#pragma unroll
      for (int q = 0; q < 36; ++q) lg[q] = 0.f;
#pragma unroll
      for (int i = 0; i < 16; ++i) {
        const float hv = h[i];
        const float4* wr4 = (const float4*)(wl + (i * 64 + lane) * 36);
#pragma unroll
        for (int q = 0; q < 9; ++q) {
          const float4 w4 = wr4[q];
          lg[q * 4 + 0] += hv * w4.x; lg[q * 4 + 1] += hv * w4.y; lg[q * 4 + 2] += hv * w4.z; lg[q * 4 + 3] += hv * w4.w;
        }
        __builtin_amdgcn_sched_barrier(0);
      }
#pragma unroll
      for (int q = 0; q < 36; ++q) lg[q] = wave_sum(lg[q]);
      const float* rgb = P.in[10] + layer * 4;
      const float* reb = P.in[12] + layer * 32;
#pragma unroll
      for (int q = 0; q < 4; ++q) lg[q] += rgb[q];
#pragma unroll
      for (int q = 0; q < 32; ++q) lg[4 + q] += reb[q];
      int grp = 0; float best = lg[0];
#pragma unroll
      for (int q = 1; q < 4; ++q) if (lg[q] > best) { best = lg[q]; grp = q; }
      float se = 0.f;
#pragma unroll
      for (int q = 0; q < 4; ++q) se += expf(lg[q] - best);
      const float pg = 1.f / se;
      float v0 = -3.0e38f, v1 = -3.0e38f; int i0 = 0, i1 = 0;
#pragma unroll
      for (int g = 0; g < 4; ++g) {
#pragma unroll
        for (int q = 0; q < 8; ++q) {
          const float x = lg[4 + g * 8 + q];
          if (g == grp) {
            if (x > v0) { v1 = v0; i1 = i0; v0 = x; i0 = q; }
            else if (x > v1) { v1 = x; i1 = q; }
          }
        }
      }
      const float w0 = 1.f / (1.f + expf(v1 - v0));
      const float w1 = 1.f - w0;
      if (lane == 0) {
        float* asgw = (float*)(ws + WS_ASGW);
        const int e0 = grp * 8 + i0, e1 = grp * 8 + i1;
        const int p0 = atomicAdd(&rl[e0], 1);
        const int p1 = atomicAdd(&rl[e1], 1);
        const int sl = atomicAdd(&rl[64], 2);
        rl[80 + sl] = 2 * t;         rl[240 + sl] = e0;     rl[400 + sl] = p0;
        rl[80 + sl + 1] = 2 * t + 1; rl[240 + sl + 1] = e1; rl[400 + sl + 1] = p1;
        asgw[2 * t] = w0 * pg;
        asgw[2 * t + 1] = w1 * pg;
      }
    }
  }
  if (router) {
    __syncthreads();
    int* cnt = (int*)(ws + WS_CNT) + layer * 32 * 32;
    int* list = (int*)(ws + WS_LIST);
    if (tid_n < 32) rl[32 + tid_n] = rl[tid_n] ? atomicAdd(&cnt[tid_n * 32], rl[tid_n]) : 0;
    __syncthreads();
    const int nent = rl[64];
    for (int s = tid_n; s < nent; s += NT) {
      const int e = rl[240 + s];
      list[(size_t)e * 33280 + rl[32 + e] + rl[400 + s]] = rl[80 + s];
    }
    __syncthreads();
  }
}

#define tid (opaque_tid())
#define gtid ((int)(blockIdx.x * NT) + opaque_tid())
#define gstride ((int)(gridDim.x * NT))
__global__ void __launch_bounds__(NT, 2) mega(Params P) {
  cg::grid_group grid = cg::this_grid();
  __shared__ __attribute__((aligned(1024))) char shm[GEMM_LDS_TOTAL + 16 + 256 + 2560];
  float* smem = (float*)shm;
  if (threadIdx.x < 4) ((unsigned*)(shm + GEMM_LDS_TOTAL))[threadIdx.x] = 0u;
  __syncthreads();
  XcdBarrier xbar = xcd_barrier_post((unsigned*)(P.ws + WS_BAR), (volatile LAS unsigned*)(shm + GEMM_LDS_TOTAL));
  unsigned char* ws = P.ws;
  const int G = gridDim.x;
  const int vb = (G % 8 == 0) ? ((int)(blockIdx.x & 7) * (G / 8) + (int)(blockIdx.x >> 3)) : (int)blockIdx.x;
  float* tok = (float*)(ws + WS_TOK);
  bf16_t* hb = (bf16_t*)(ws + WS_H);
  float* mod = (float*)(ws + WS_MOD);
  const bf16_t* zrow = (const bf16_t*)(ws + WS_ZROW);
  unsigned char* R = ws + WS_R;

  {
    {
      float* PE = (float*)(ws + W_PE);
      for (int idx = gtid; idx < 320 * 256; idx += gstride) {
        const int p = idx >> 8, j = idx & 255;
        const float freq = expf(-9.210340371976184f * (float)j / 256.f);
        const float ang = (float)(p < 256 ? p : p - 256) * freq;
        float sv, cv; sincosf(ang, &sv, &cv);
        if (p < 256) { PE[p * 256 + j] = sv; PE[65536 + p * 256 + j] = cv; }
        else { PE[131072 + (p - 256) * 256 + j] = sv; PE[131072 + 16384 + (p - 256) * 256 + j] = cv; }
      }
    }
    {
      const float* c = P.in[1]; const float* cc = P.in[3]; const float* adaw = P.in[4];
      float* modp = (float*)(ws + WS_MODP);
      float* s_c = smem;
      for (int k = tid; k < 1024; k += NT) { const float a = c[k], b2 = cc[k]; s_c[k] = a / (1.f + expf(-a)); s_c[1024 + k] = b2 / (1.f + expf(-b2)); }
      __syncthreads();
      for (int idx = gtid; idx < 16 * 4 * 1536; idx += gstride) {
        const int ks = idx / 6144, rem = idx - ks * 6144, i = rem / 1536, j = (rem - i * 1536) * 4;
        const float* wp = adaw + ((size_t)i * 1024 + ks * 64) * 6144 + j;
        float4 a0 = make_float4(0.f, 0.f, 0.f, 0.f), a1 = a0;
        for (int kb = 0; kb < 64; kb += 8) {
          float4 w[8];
#pragma unroll
          for (int u = 0; u < 8; ++u) w[u] = *(const float4*)(wp + (size_t)(kb + u) * 6144);
#pragma unroll
          for (int u = 0; u < 8; ++u) {
            const float s0 = s_c[ks * 64 + kb + u], s1 = s_c[1024 + ks * 64 + kb + u];
            a0.x += s0 * w[u].x; a0.y += s0 * w[u].y; a0.z += s0 * w[u].z; a0.w += s0 * w[u].w;
            a1.x += s1 * w[u].x; a1.y += s1 * w[u].y; a1.z += s1 * w[u].z; a1.w += s1 * w[u].w;
          }
        }
        *(float4*)&modp[(size_t)(ks * 8 + i * 2 + 0) * 6144 + j] = a0;
        *(float4*)&modp[(size_t)(ks * 8 + i * 2 + 1) * 6144 + j] = a1;
      }
      __syncthreads();
    }
    if (gtid < 4 * 32 * 32 + 64) ((int*)(ws + WS_CNT))[gtid] = 0;
    if (gtid < 2048) ((unsigned*)(ws + WS_ZROW))[gtid] = 0u;
    bf16_t* DC = (bf16_t*)(ws + W_DC); bf16_t* DA = (bf16_t*)(ws + W_DA); bf16_t* TW = (bf16_t*)(ws + W_TW);
    for (int idx = gtid; idx < 512 * 256; idx += gstride) {
      const int row = idx >> 8, cch = idx & 255, pq = row >> 8, kc = row & 255;
      const float a = (float)((kc * cch) & 255) * (1.f / 128.f);
      DC[idx] = f2bf(pq ? -sinpif(a) : cospif(a));
    }
    for (int idx = gtid; idx < 256 * 256; idx += gstride) {
      const int row = idx >> 8, col = idx & 255, ri = row >> 7, cc2 = row & 127, rj = col >> 7, aa = col & 127;
      const float a = (float)((aa * cc2) & 127) * (1.f / 64.f);
      const float cs = cospif(a), sn = sinpif(a);
      DA[idx] = f2bf(ri == rj ? cs : (ri == 0 ? sn : -sn));
    }
    for (int idx = gtid; idx < 128 * 128 * 256; idx += gstride) {
      const int col = idx & 255, e = (idx >> 8) & 127, c2 = idx >> 15, ri = col >> 7, b = col & 127;
      const float a = (float)((b * (c2 + 128 * e)) & 16383) * (1.f / 8192.f);
      TW[idx] = f2bf(ri ? sinpif(a) : cospif(a));
    }
    for (int idx = gtid; idx < 2 * 1280; idx += gstride) ((float*)(ws + W_SP))[idx] = log1pf(expf(-P.in[34][idx]));
    {
      const float* src = P.in[36]; bf16_t* dst = (bf16_t*)(ws + W_FNIN);
      for (int idx = gtid; idx < 1024 * 1024 / 4; idx += gstride) {
        const float4 a = *(const float4*)&src[(size_t)idx * 4];
        uint2 o; o.x = pack2(a.x, a.y); o.y = pack2(a.z, a.w);
        *(uint2*)&dst[(size_t)idx * 4] = o;
      }
    }
    const int NDENSE = 512 + 256 + 768 + 256 + 640 + 320 + 256 + 160;
    const int NTOT = NDENSE + 128 * 384;
    for (int u = blockIdx.x; u < NTOT; u += G) {
      if (u < NDENSE) {
        int v = u;
        if (v < 512) { conv_tile(P.in[16], 2048, (bf16_t*)(ws + W_CMIN), 1024, (v >> 5) * 64, (v & 31) * 64, 0, smem); continue; }
        v -= 512;
        if (v < 256) { conv_tile(P.in[20], 1024, (bf16_t*)(ws + W_CMOUT), 1024, (v >> 4) * 64, (v & 15) * 64, 0, smem); continue; }
        v -= 256;
        if (v < 768) { conv_tile(P.in[21], 3088, (bf16_t*)(ws + W_MLIN), 1024, (v / 48) * 64, (v % 48) * 64, 0, smem); continue; }
        v -= 768;
        if (v < 256) { conv_tile(P.in[26], 1024, (bf16_t*)(ws + W_MLOUT), 1024, (v >> 4) * 64, (v & 15) * 64, 0, smem); continue; }
        v -= 256;
        if (v < 640) { conv_tile(P.in[27], 2560, (bf16_t*)(ws + W_LRUIN), 1024, (v / 40) * 64, (v % 40) * 64, 0, smem); continue; }
        v -= 640;
        if (v < 320) { conv_tile(P.in[35], 1024, (bf16_t*)(ws + W_LRUOUT), 1280, (v >> 4) * 64, (v & 15) * 64, 0, smem); continue; }
        v -= 320;
        if (v < 256) { conv_tile(P.in[37], 1024, (bf16_t*)(ws + W_FNOUT), 1024, (v >> 4) * 64, (v & 15) * 64, 0, smem); continue; }
        v -= 256;
        {
          const int mat = v >> 2, tl4 = v & 3, type = mat / 20, dnb = mat % 20, d = dnb / 10, nb = dnb % 10;
          const float* srcm = (type ? P.in[32] : P.in[30]) + (size_t)dnb * 128 * 128;
          conv_tile(srcm, 128, (bf16_t*)(ws + W_LRUG) + (size_t)(nb * 2 + d) * 256 * 128, 128, (tl4 >> 1) * 64, (tl4 & 1) * 64, type + 1, smem);
        }
      } else {
        const int v = u - NDENSE, le = v / 384, r = v - le * 384, kind = r >> 7, tt = r & 127;
        if (kind < 2) {
          const float* src = (kind == 0 ? P.in[13] : P.in[14]) + (size_t)le * 1024 * 512;
          conv_tile(src, 512, (bf16_t*)(ws + W_EGU) + (size_t)le * 1024 * 1024, 1024, (tt >> 3) * 64, (tt & 7) * 64, kind + 1, smem);
        } else {
          const float* src = P.in[15] + (size_t)le * 512 * 1024;
          conv_tile(src, 1024, (bf16_t*)(ws + W_ED) + (size_t)le * 1024 * 512, 512, (tt >> 4) * 64, (tt & 15) * 64, 0, smem);
        }
      }
    }
  }
  grid.sync();
  {
    {
      const float* x = P.in[0]; const float* ctx = P.in[2];
      const float* PE = (const float*)(ws + W_PE);
      for (int idx = gtid; idx < T_ALL * 256; idx += gstride) {
        const int t = idx >> 8, n = (idx & 255) * 4;
        float4 o;
        if (t < T_CTX) o = *(const float4*)&ctx[(size_t)t * DM + n];
        else {
          const int tl = t - T_CTX, qd = n >> 8, j = n & 255;
          o = *(const float4*)&x[(size_t)tl * DM + n];
          const float* pp = (qd < 2) ? PE + qd * 65536 + (tl >> 6) * 256 + j : PE + 131072 + (qd - 2) * 16384 + (tl & 63) * 256 + j;
          const float4 pe = *(const float4*)pp;
          o.x += pe.x; o.y += pe.y; o.z += pe.z; o.w += pe.w;
        }
        *(float4*)&tok[(size_t)t * DM + n] = o;
      }
    }
    const float* modp = (const float*)(ws + WS_MODP);
    const float* adab = P.in[5];
    for (int idx = gtid; idx < 8 * 6144; idx += gstride) {
      const int is = idx / 6144, j = idx - is * 6144, i = is >> 1;
      float a = adab[i * 6144 + j];
      for (int ks = 0; ks < 16; ++ks) a += modp[(size_t)(ks * 8 + is) * 6144 + j];
      mod[idx] = a;
    }
    {
      const bf16_t* DC = (const bf16_t*)(ws + W_DC);
      const bf16_t* WI = (const bf16_t*)(ws + W_FNIN);
      bf16_t* WP = (bf16_t*)(ws + W_FNP);
      gemm_loop<4, true>(shm, 4, vb, 64, G,
        [=](int L, int r) { const int tm = L >> 2; return DC + (size_t)((tm >> 3) * 256 + (tm & 1) * 128 + r) * 256; },
        [=](int L, int cidx) { const int tm = L >> 2; return WI + (size_t)((L & 3) * 256 + cidx) * 1024 + ((tm >> 1) & 3) * 256; }, KOffL(), KOffL(),
        per_m([=](int L, int row, int col0, const f32x4 (&a)[4]) { st16bf(WP + (size_t)((L >> 2) * 128 + row) * 1024 + (L & 3) * 256 + col0, a); }));
    }
  }
  xcd_barrier(xbar);

#define MODV(i, s, j, n) mod[(size_t)(((i) * 2 + (s)) * 6 + (j)) * 1024 + (n)]

  auto resid_epi = [=](int layer, int grow, int gcol0, const f32x4 (&a)[4]) {
    const int s = grow < T_CTX ? 1 : 0;
    const float* gate = &MODV(layer, s, 2, gcol0);
    float* p = tok + (size_t)grow * DM + gcol0;
#pragma unroll
    for (int n = 0; n < 4; ++n) {
      float4 t4 = *(float4*)(p + n * 4);
      const float4 g4 = *(const float4*)(gate + n * 4);
      t4.x += g4.x * a[n][0]; t4.y += g4.y * a[n][1]; t4.z += g4.z * a[n][2]; t4.w += g4.w * a[n][3];
      *(float4*)(p + n * 4) = t4;
    }
  };

  auto moe_layer = [&](int layer, int t0) {
    norm_phase(P, t0, P.in[7] + layer * 1024, layer, 3, -1, 0, false, true, layer, smem);
    xcd_barrier(xbar);
    int* cnt = (int*)(ws + WS_CNT) + layer * 32 * 32;
    int* list = (int*)(ws + WS_LIST);
    float* asgw = (float*)(ws + WS_ASGW);
    int* ps = (int*)(shm + GEMM_LDS_TOTAL + 64);
    if (tid == 0) {
      int s = 0;
      for (int e = 0; e < 32; ++e) { ps[e] = s; s += (cnt[e * 32] + 127) / 128 * 128; }
      ps[32] = s;
    }
    __syncthreads();
    const int total = ps[32];
    bf16_t* HB = (bf16_t*)(R + R_HB);
    bf16_t* ybuf = (bf16_t*)(R + R_YBUF);
    const bf16_t* WGU = (const bf16_t*)(ws + W_EGU) + (size_t)layer * 32 * 1024 * 1024;
    const bf16_t* WD = (const bf16_t*)(ws + W_ED) + (size_t)layer * 32 * 1024 * 512;
    const int ntile = (total >> 7) * 4;
    auto blk_e = [=](int mb) { int e = 0; for (int q = 1; q < 32; ++q) if (ps[q] <= mb * 128) e = q; return e; };
    {
      gemm_loop<4, true>(shm, 16, vb, ntile, G,
        [=](int L, int r) { const int mb = L >> 2, e = blk_e(mb), rr = mb * 128 - ps[e] + r;
          return (rr < cnt[e * 32]) ? (const bf16_t*)(hb + (size_t)(list[(size_t)e * 33280 + rr] >> 1) * DM) : zrow; },
        [=](int L, int cidx) { const int e = blk_e(L >> 2); return WGU + (size_t)e * 1024 * 1024 + (size_t)((L & 3) * 256 + cidx) * 1024; },
        KOffL(), KOffL(),
        per_m([=](int L, int row, int col0, const f32x4 (&a)[4]) {
          const int n0 = (L & 3) * 256, m0 = (L >> 2) * 128;
          float hv[8];
#pragma unroll
          for (int j = 0; j < 8; ++j) { const float gv = a[j >> 2][j & 3], uv = a[2 + (j >> 2)][j & 3]; hv[j] = silu_f(gv) * uv; }
          uint4 o; o.x = pack2(hv[0], hv[1]); o.y = pack2(hv[2], hv[3]); o.z = pack2(hv[4], hv[5]); o.w = pack2(hv[6], hv[7]);
          *(uint4*)&HB[(size_t)(m0 + row) * 512 + ((n0 + col0) >> 1)] = o;
        }));
    }
    xcd_barrier(xbar);
    {
      gemm_loop<4, true>(shm, 8, vb, ntile, G,
        [=](int L, int r) { return (const bf16_t*)(HB + (size_t)((L >> 2) * 128 + r) * 512); },
        [=](int L, int cidx) { const int e = blk_e(L >> 2); return WD + (size_t)e * 1024 * 512 + (size_t)((L & 3) * 256 + cidx) * 512; },
        KOffL(), KOffL(),
        per_m([=](int L, int row, int col0, const f32x4 (&a)[4]) {
          const int mb = L >> 2, n0 = (L & 3) * 256, e = blk_e(mb), rr = mb * 128 - ps[e] + row;
          if (rr < cnt[e * 32]) {
            const int rt = list[(size_t)e * 33280 + rr];
            const float w = asgw[rt];
            f32x4 bq[4];
#pragma unroll
            for (int n = 0; n < 4; ++n) bq[n] = a[n] * w;
            st16bf(ybuf + (size_t)rt * 1024 + n0 + col0, bq);
          }
        }));
    }
    xcd_barrier(xbar);
  };

  {
    norm_phase(P, 0, P.in[6] + 0 * 1024, 0, 0, -1, 0, false, false, 0, smem);
    xcd_barrier(xbar);
    bf16_t* zu = (bf16_t*)(R + R0_ZU); bf16_t* zvT = (bf16_t*)(R + R0_ZVT); bf16_t* pb = (bf16_t*)(R + R0_P);
    bf16_t* Wsc = (bf16_t*)(R + R0_WSC);
    const float* vg = P.in[17]; const float* w_s = P.in[18]; const float* b_s = P.in[19];
    const bf16_t* Wt = (const bf16_t*)(ws + W_CMIN);
    {
      auto epi_u = [=](int grow, int gcol0, const f32x4 (&a)[4]) {
        f32x4 bq[4];
#pragma unroll
        for (int n = 0; n < 4; ++n)
#pragma unroll
          for (int j = 0; j < 4; ++j) bq[n][j] = gelu_f(a[n][j]);
        st16bf(zu + (size_t)grow * 1024 + gcol0, bq);
      };
      auto epi_v = [=](int grow0, int gcol, f32x4 v) {
        uint2 o; o.x = pack2(gelu_f(v[0]), gelu_f(v[1])); o.y = pack2(gelu_f(v[2]), gelu_f(v[3]));
        *(uint2*)&zvT[((size_t)(grow0 >> 7) * 1024 + (gcol - 1024)) * 128 + (grow0 & 127)] = o;
      };
      gemm_loop<8, true>(shm, 16, vb, 256, G,
        [=](int L, int r) { return (const bf16_t*)(hb + (size_t)((1 + (L >> 2)) * 256 + r) * DM); },
        [=](int L, int cidx) { return Wt + (size_t)((L & 3) * 256 + cidx) * 1024; }, KOffL(), KOffL(),
        per_m([=](int L, int row, int col0, const f32x4 (&a)[4]) { epi_u((1 + (L >> 2)) * 256 + row, (L & 3) * 256 + col0, a); }));
      gemm_loop<8, false>(shm, 16, vb, 256, G,
        [=](int L, int r) { return (const bf16_t*)(hb + (size_t)((1 + (L >> 2)) * 256 + r) * DM); },
        [=](int L, int cidx) { return Wt + (size_t)((4 + (L & 3)) * 256 + cidx) * 1024; }, KOffL(), KOffL(),
        [=](int L, int row0, int col, f32x4 v) { epi_v((1 + (L >> 2)) * 256 + row0, (4 + (L & 3)) * 256 + col, v); });
      gemm_loop<2, true>(shm, 16, vb, 16, G,
        [=](int L, int r) { return (const bf16_t*)(hb + (size_t)((L >> 2) * 64 + r) * DM); },
        [=](int L, int cidx) { return Wt + (size_t)((L & 3) * 256 + cidx) * 1024; }, KOffL(), KOffL(),
        per_m([=](int L, int row, int col0, const f32x4 (&a)[4]) { epi_u((L >> 2) * 64 + row, (L & 3) * 256 + col0, a); }));
      gemm_loop<2, false>(shm, 16, (vb - 16 + G) % G, 16, G,
        [=](int L, int r) { return (const bf16_t*)(hb + (size_t)((L >> 2) * 64 + r) * DM); },
        [=](int L, int cidx) { return Wt + (size_t)((4 + (L & 3)) * 256 + cidx) * 1024; }, KOffL(), KOffL(),
        [=](int L, int row0, int col, f32x4 v) { epi_v((L >> 2) * 64 + row0, (4 + (L & 3)) * 256 + col, v); });
    }
    xcd_barrier(xbar);
    {
      float* s_part = smem;
      float* s_rv = smem + 4096;
      for (int n = blockIdx.x; n < NCH; n += G) {
        {
          const int tq = tid, cg = tq >> 4, sg = tq & 15;
          float ss8[8];
#pragma unroll
          for (int e = 0; e < 8; ++e) ss8[e] = 0.f;
          for (int it = 0; it < 32; it += 4) {
            uint4 z[4];
#pragma unroll
            for (int u = 0; u < 4; ++u) z[u] = *(const uint4*)&zvT[((size_t)n * 1024 + (it + u) * 32 + cg) * 128 + sg * 8];
#pragma unroll
            for (int u = 0; u < 4; ++u) {
              const unsigned zz[4] = {z[u].x, z[u].y, z[u].z, z[u].w};
#pragma unroll
              for (int e = 0; e < 4; ++e) { const float a = lo2f(zz[e]), b2 = hi2f(zz[e]); ss8[2 * e] += a * a; ss8[2 * e + 1] += b2 * b2; }
            }
          }
#pragma unroll
          for (int e = 0; e < 8; ++e) s_part[cg * 128 + sg * 8 + e] = ss8[e];
        }
        __syncthreads();
        if (tid < 128) {
          float a = 0.f;
          for (int q = 0; q < 32; ++q) a += s_part[q * 128 + tid];
          s_rv[tid] = 1.f / sqrtf(a * (1.f / 1024.f) + EPSN);
        }
        __syncthreads();
        for (int idx = tid; idx < 4 * 128 * 32; idx += NT) {
          const int s4 = (idx & 31) * 4, gt = idx >> 5;
          const float4 w4 = *(const float4*)&w_s[(size_t)gt * 128 + s4];
          uint2 o; o.x = pack2(w4.x * s_rv[s4], w4.y * s_rv[s4 + 1]); o.y = pack2(w4.z * s_rv[s4 + 2], w4.w * s_rv[s4 + 3]);
          *(uint2*)&Wsc[((size_t)n * 512 + gt) * 128 + s4] = o;
        }
        __syncthreads();
      }
    }
    xcd_barrier(xbar);
    {
      gemm_loop<4, true>(shm, 2, vb, NCH * 4, G,
        [=](int L, int r) { return (const bf16_t*)(Wsc + ((size_t)(L >> 2) * 512 + (L & 3) * 128 + r) * 128); },
        [=](int L, int cidx) { return (const bf16_t*)(zvT + ((size_t)(L >> 2) * 1024 + (L & 3) * 256 + cidx) * 128); },
        KOffL(), KOffL(),
        per_m([=](int L, int row, int col0, const f32x4 (&a)[4]) {
          const int n = L >> 2, g = L & 3;
          const int t = n * 128 + row, col = g * 256 + col0;
          const float bias = b_s[g * 128 + row];
          const uint4 u0 = *(const uint4*)&zu[(size_t)t * 1024 + col], u1 = *(const uint4*)&zu[(size_t)t * 1024 + col + 8];
          const unsigned uu[8] = {u0.x, u0.y, u0.z, u0.w, u1.x, u1.y, u1.z, u1.w};
          f32x4 o[4];
#pragma unroll
          for (int nn = 0; nn < 4; ++nn) {
            const float4 g4 = *(const float4*)&vg[col + nn * 4];
            o[nn][0] = lo2f(uu[nn * 2]) * (a[nn][0] * g4.x + bias);
            o[nn][1] = hi2f(uu[nn * 2]) * (a[nn][1] * g4.y + bias);
            o[nn][2] = lo2f(uu[nn * 2 + 1]) * (a[nn][2] * g4.z + bias);
            o[nn][3] = hi2f(uu[nn * 2 + 1]) * (a[nn][3] * g4.w + bias);
          }
          st16bf(pb + (size_t)t * 1024 + col, o);
        }));
    }
    xcd_barrier(xbar);
    const bf16_t* Wo = (const bf16_t*)(ws + W_CMOUT);
    auto epi_out = [=](int grow, int gcol0, const f32x4 (&a)[4]) { resid_epi(0, grow, gcol0, a); };
    dense_phase(shm, vb, G, pb, 1024, Wo, 1024, 4, 16, true, epi_out);
    xcd_barrier(xbar);
  }
  moe_layer(0, 0);

  {
    norm_phase(P, 0, P.in[6] + 1 * 1024, 1, 0, 0, 0, false, false, 0, smem);
    xcd_barrier(xbar);
    bf16_t* ZQK = (bf16_t*)(R + R1_ZQK); bf16_t* ZO = (bf16_t*)(R + R1_ZO); bf16_t* VT = (bf16_t*)(R + R1_VT);
    float* gpre = (float*)(R + R1_GPRE); bf16_t* Qn = (bf16_t*)(R + R1_QN); bf16_t* Kn = (bf16_t*)(R + R1_KN);
    bf16_t* AS = (bf16_t*)(R + R1_AS); bf16_t* KwT = (bf16_t*)(R + R1_KWT);
    float* bc = (float*)(R + R1_BC); float* li = (float*)(R + R1_LI); float* egch = (float*)(R + R1_GCH);
    float* nloc = (float*)(R + R1_NLOC); float* nin = (float*)(R + R1_NIN);
    float* Cloc = (float*)(R + R1_CLOC); bf16_t* CinT = (bf16_t*)(R + R1_CINT); float* hnum = (float*)(R + R1_CLOC);
    bf16_t* A2 = (bf16_t*)(R + R1_A2);
    const float* w_in = P.in[21]; const float* cw = P.in[22]; const float* cb = P.in[23];
    const float* gb = P.in[24]; const float* ng = P.in[25];
    const bf16_t* Wt = (const bf16_t*)(ws + W_MLIN);
    {
      auto epi_nat = [=](int grow, int gcol0, const f32x4 (&a)[4]) {
        if (gcol0 < 1024) st16bf(ZQK + (size_t)grow * 1024 + gcol0, a); else st16bf(ZO + (size_t)grow * 1024 + gcol0 - 2048, a);
      };
      auto epi_vt = [=](int grow0, int gcol, f32x4 v) {
        uint2 o; o.x = pack2(v[0], v[1]); o.y = pack2(v[2], v[3]);
        *(uint2*)&VT[((size_t)(grow0 >> 7) * 1024 + (gcol - 1024)) * 128 + (grow0 & 127)] = o;
      };
      {
        float* wl = smem;
        const int tq = tid;
        for (int idx = tq; idx < 1024 * 4; idx += NT) {
          const int k = idx >> 2, q = idx & 3;
          const float4 w4 = *(const float4*)&w_in[(size_t)k * 3088 + 3072 + q * 4];
          const int rho = (((k >> 8) * 4 + (k & 3)) * 64) + ((k & 255) >> 2);
          *(float4*)&wl[rho * 16 + q * 4] = w4;
        }
        __syncthreads();
        const int lane = tq & 63;
        for (int t = blockIdx.x * (NT / 64) + (tq >> 6); t < T_ALL; t += G * (NT / 64)) {
          float hv[16];
#pragma unroll
          for (int j = 0; j < 4; ++j) {
            const uint2 z = *(const uint2*)&hb[(size_t)t * DM + j * 256 + lane * 4];
            hv[j * 4 + 0] = lo2f(z.x); hv[j * 4 + 1] = hi2f(z.x); hv[j * 4 + 2] = lo2f(z.y); hv[j * 4 + 3] = hi2f(z.y);
          }
          float a16[16];
#pragma unroll
          for (int j = 0; j < 16; ++j) a16[j] = 0.f;
#pragma unroll
          for (int i = 0; i < 16; ++i) {
            const float4* wr4 = (const float4*)(wl + (i * 64 + lane) * 16);
#pragma unroll
            for (int q = 0; q < 4; ++q) {
              const float4 w4 = wr4[q];
              a16[q * 4 + 0] += hv[i] * w4.x; a16[q * 4 + 1] += hv[i] * w4.y; a16[q * 4 + 2] += hv[i] * w4.z; a16[q * 4 + 3] += hv[i] * w4.w;
            }
            __builtin_amdgcn_sched_barrier(0);
          }
#pragma unroll
          for (int j = 0; j < 16; ++j) a16[j] = wave_sum(a16[j]);
          if (lane == 0) {
#pragma unroll
            for (int j = 0; j < 4; ++j) *(float4*)&gpre[(size_t)t * 16 + j * 4] = make_float4(a16[j * 4], a16[j * 4 + 1], a16[j * 4 + 2], a16[j * 4 + 3]);
          }
        }
        __syncthreads();
      }
      gemm_loop<8, true>(shm, 16, vb, 512, G,
        [=](int L, int r) { return (const bf16_t*)(hb + (size_t)((1 + (L >> 3)) * 256 + r) * DM); },
        [=](int L, int cidx) { const int j = L & 7, tn = j < 4 ? j : j + 4; return Wt + (size_t)(tn * 256 + cidx) * 1024; }, KOffL(), KOffL(),
        per_m([=](int L, int row, int col0, const f32x4 (&a)[4]) { const int j = L & 7, tn = j < 4 ? j : j + 4; epi_nat((1 + (L >> 3)) * 256 + row, tn * 256 + col0, a); }));
      gemm_loop<8, false>(shm, 16, vb, 256, G,
        [=](int L, int r) { return (const bf16_t*)(hb + (size_t)((1 + (L >> 2)) * 256 + r) * DM); },
        [=](int L, int cidx) { return Wt + (size_t)((4 + (L & 3)) * 256 + cidx) * 1024; }, KOffL(), KOffL(),
        [=](int L, int row0, int col, f32x4 v) { epi_vt((1 + (L >> 2)) * 256 + row0, (4 + (L & 3)) * 256 + col, v); });
      gemm_loop<2, true>(shm, 16, vb, 32, G,
        [=](int L, int r) { return (const bf16_t*)(hb + (size_t)((L >> 3) * 64 + r) * DM); },
        [=](int L, int cidx) { const int j = L & 7, tn = j < 4 ? j : j + 4; return Wt + (size_t)(tn * 256 + cidx) * 1024; }, KOffL(), KOffL(),
        per_m([=](int L, int row, int col0, const f32x4 (&a)[4]) { const int j = L & 7, tn = j < 4 ? j : j + 4; epi_nat((L >> 3) * 64 + row, tn * 256 + col0, a); }));
      gemm_loop<2, false>(shm, 16, (vb - 32 + G) % G, 16, G,
        [=](int L, int r) { return (const bf16_t*)(hb + (size_t)((L >> 2) * 64 + r) * DM); },
        [=](int L, int cidx) { return Wt + (size_t)((4 + (L & 3)) * 256 + cidx) * 1024; }, KOffL(), KOffL(),
        [=](int L, int row0, int col, f32x4 v) { epi_vt((L >> 2) * 64 + row0, (4 + (L & 3)) * 256 + col, v); });
    }
    xcd_barrier(xbar);
    {
      float* s_bc = smem;
      float* s_w  = smem + 1024;
      float* s_k  = smem + 2048;
      const int wv = tid >> 6, lane = tid & 63;
      for (int n = blockIdx.x; n < NCH; n += G) {
        {
          const int dh = wv, d = dh >> 2, hd = dh & 3;
          const int p0 = 2 * lane, p1 = p0 + 1;
          const int t0 = n * 128 + (d == 0 ? p0 : 127 - p0), t1 = n * 128 + (d == 0 ? p1 : 127 - p1);
          const float li0 = gpre[(size_t)t0 * 16 + d * 8 + hd] + gb[d * 8 + hd];
          const float li1 = gpre[(size_t)t1 * 16 + d * 8 + hd] + gb[d * 8 + hd];
          const float lf0 = logsig_f(gpre[(size_t)t0 * 16 + d * 8 + 4 + hd] + gb[d * 8 + 4 + hd]);
          const float lf1 = logsig_f(gpre[(size_t)t1 * 16 + d * 8 + 4 + hd] + gb[d * 8 + 4 + hd]);
          float run = lf0 + lf1;
#pragma unroll
          for (int o = 1; o < 64; o <<= 1) { const float y = __shfl_up(run, o); if (lane >= o) run += y; }
          const float b1 = run, b0 = run - lf1;
          const float g = __shfl(run, 63);
          bc[(size_t)dh * T_ALL + t0] = expf(b0); bc[(size_t)dh * T_ALL + t1] = expf(b1);
          li[(size_t)dh * T_ALL + t0] = expf(li0 - b0); li[(size_t)dh * T_ALL + t1] = expf(li1 - b1);
          s_bc[dh * 128 + (t0 & 127)] = b0; s_bc[dh * 128 + (t1 & 127)] = b1;
          s_w[dh * 128 + (t0 & 127)] = expf(g - b0 + li0); s_w[dh * 128 + (t1 & 127)] = expf(g - b1 + li1);
          if (lane == 0) egch[dh * NCH + n] = expf(g);
        }
        __syncthreads();
        const int lo = n < 2 ? 0 : T_CTX, hi = n < 2 ? T_CTX : T_ALL;
        for (int idx = tid; idx < 128 * 64; idx += NT) {
          const int tl = idx >> 6, c0 = (idx & 63) * 8, t = n * 128 + tl, hd = c0 >> 7;
          float q[8];
#pragma unroll
          for (int e = 0; e < 8; ++e) q[e] = cb[c0 + e];
#pragma unroll
          for (int j = 0; j < 4; ++j) {
            const int tt = t + j - 2;
            if (tt >= lo && tt < hi) {
              const uint4 z = *(const uint4*)&ZQK[(size_t)tt * 1024 + c0];
              const float4 w0 = *(const float4*)&cw[j * 1024 + c0], w1 = *(const float4*)&cw[j * 1024 + c0 + 4];
              q[0] += lo2f(z.x) * w0.x; q[1] += hi2f(z.x) * w0.y; q[2] += lo2f(z.y) * w0.z; q[3] += hi2f(z.y) * w0.w;
              q[4] += lo2f(z.z) * w1.x; q[5] += hi2f(z.z) * w1.y; q[6] += lo2f(z.w) * w1.z; q[7] += hi2f(z.w) * w1.w;
            }
          }
#pragma unroll
          for (int e = 0; e < 8; ++e) q[e] = silu_f(q[e]) * 0.08838834764831845f;
          uint4 o; o.x = pack2(q[0], q[1]); o.y = pack2(q[2], q[3]); o.z = pack2(q[4], q[5]); o.w = pack2(q[6], q[7]);
          *(uint4*)&Qn[(size_t)t * 512 + c0] = o;
#pragma unroll
          for (int d = 0; d < 2; ++d) {
            const int dh = d * 4 + hd;
            const float eb = expf(s_bc[dh * 128 + tl]);
            uint4 o2; o2.x = pack2(q[0] * eb, q[1] * eb); o2.y = pack2(q[2] * eb, q[3] * eb); o2.z = pack2(q[4] * eb, q[5] * eb); o2.w = pack2(q[6] * eb, q[7] * eb);
            *(uint4*)&AS[((size_t)dh * T_ALL + t) * 256 + 128 + (c0 & 127)] = o2;
          }
        }
        for (int hd = 0; hd < 4; ++hd) {
          for (int idx = tid; idx < 128 * 16; idx += NT) {
            const int tl = idx >> 4, k0 = (idx & 15) * 8, t = n * 128 + tl, c0 = 512 + hd * 128 + k0;
            float q[8];
#pragma unroll
            for (int e = 0; e < 8; ++e) q[e] = cb[c0 + e];
#pragma unroll
            for (int j = 0; j < 4; ++j) {
              const int tt = t + j - 2;
              if (tt >= lo && tt < hi) {
                const uint4 z = *(const uint4*)&ZQK[(size_t)tt * 1024 + c0];
                const float4 w0 = *(const float4*)&cw[j * 1024 + c0], w1 = *(const float4*)&cw[j * 1024 + c0 + 4];
                q[0] += lo2f(z.x) * w0.x; q[1] += hi2f(z.x) * w0.y; q[2] += lo2f(z.y) * w0.z; q[3] += hi2f(z.y) * w0.w;
                q[4] += lo2f(z.z) * w1.x; q[5] += hi2f(z.z) * w1.y; q[6] += lo2f(z.w) * w1.z; q[7] += hi2f(z.w) * w1.w;
              }
            }
#pragma unroll
            for (int e = 0; e < 8; ++e) { q[e] = silu_f(q[e]); s_k[tl * 129 + k0 + e] = q[e]; }
            uint4 o; o.x = pack2(q[0], q[1]); o.y = pack2(q[2], q[3]); o.z = pack2(q[4], q[5]); o.w = pack2(q[6], q[7]);
            *(uint4*)&Kn[(size_t)t * 512 + hd * 128 + k0] = o;
          }
          __syncthreads();
          for (int idx = tid; idx < 2 * 128 * 16; idx += NT) {
            const int d = idx >> 11, rem = idx & 2047, kk = rem >> 4, s0 = (rem & 15) * 8, dh = d * 4 + hd;
            float v8[8];
#pragma unroll
            for (int e = 0; e < 8; ++e) v8[e] = s_w[dh * 128 + s0 + e] * s_k[(s0 + e) * 129 + kk];
            uint4 o; o.x = pack2(v8[0], v8[1]); o.y = pack2(v8[2], v8[3]); o.z = pack2(v8[4], v8[5]); o.w = pack2(v8[6], v8[7]);
            *(uint4*)&KwT[((size_t)dh * T_ALL + n * 128 + kk) * 128 + s0] = o;
          }
          if (tid < 256) {
            const int d = tid >> 7, kk = tid & 127, dh = d * 4 + hd;
            float a = 0.f;
            for (int s2 = 0; s2 < 128; ++s2) a += s_w[dh * 128 + s2] * s_k[s2 * 129 + kk];
            nloc[(dh * NCH + n) * 128 + kk] = a;
          }
          __syncthreads();
        }
      }
    }
    xcd_barrier(xbar);
    gemm_loop<4, false>(shm, 2, vb, 1040, G,
      [=](int L, int r) { const int dh = L / NCH, n = L - dh * NCH; return (const bf16_t*)(KwT + ((size_t)dh * T_ALL + n * 128 + r) * 128); },
      [=](int L, int cidx) { const int dh = L / NCH, n = L - dh * NCH, hd = dh & 3; return (const bf16_t*)(VT + ((size_t)n * 1024 + hd * 256 + cidx) * 128); },
      KOffL(), KOffL(),
      [=](int L, int row0, int col, f32x4 v) { *(float4*)&Cloc[(size_t)L * 32768 + (size_t)col * 128 + row0] = make_float4(v[0], v[1], v[2], v[3]); });
    gemm_loop<4, true>(shm, 2, (vb - 16 + G) % G, 520, G,
      [=](int L, int r) { const int hd = L / NCH, n = L - hd * NCH; return (const bf16_t*)(Qn + (size_t)(n * 128 + r) * 512 + hd * 128); },
      [=](int L, int cidx) { const int hd = L / NCH, n = L - hd * NCH; return cidx < 128 ? (const bf16_t*)(Kn + (size_t)(n * 128 + cidx) * 512 + hd * 128) : zrow; },
      KOffL(), KOffL(),
      per_m([=](int L, int row, int col0, const f32x4 (&a)[4]) {
        const int hd = L / NCH, n = L - hd * NCH;
        if (col0 < 128) {
          const int tt = n * 128 + row;
#pragma unroll
          for (int d = 0; d < 2; ++d) {
            const int dh = d * 4 + hd;
            const float bt = bc[(size_t)dh * T_ALL + tt];
            const float* cf = li + (size_t)dh * T_ALL + n * 128 + col0;
            f32x4 o[4];
#pragma unroll
            for (int nn = 0; nn < 4; ++nn) {
              const float4 c4 = *(const float4*)(cf + nn * 4);
              const float cv[4] = {c4.x, c4.y, c4.z, c4.w};
#pragma unroll
              for (int j = 0; j < 4; ++j) {
                const int sc = col0 + nn * 4 + j;
                const bool ok = (d == 0) ? (sc <= row) : (sc >= row);
                o[nn][j] = ok ? a[nn][j] * bt * cv[j] : 0.f;
              }
            }
            st16bf(AS + ((size_t)dh * T_ALL + tt) * 256 + col0, o);
          }
        }
      }));
    xcd_barrier(xbar);
    for (int idx = gtid; idx < 8 * (32768 + 128); idx += gstride) {
      const int dh = idx / 32896, e = idx - dh * 32896, d = dh >> 2;
      float st = 0.f;
      if (e < 32768) {
        for (int ib = 0; ib < NCH; ib += 10) {
          float xv[10], gv[10];
#pragma unroll
          for (int u = 0; u < 10; ++u) { const int n = scan_order(d, ib + u); xv[u] = Cloc[(size_t)(dh * NCH + n) * 32768 + e]; gv[u] = egch[dh * NCH + n]; }
#pragma unroll
          for (int u = 0; u < 10; ++u) { const int n = scan_order(d, ib + u); CinT[(size_t)(dh * NCH + n) * 32768 + e] = f2bf(st); st = gv[u] * st + xv[u]; }
        }
      } else {
        const int kk = e - 32768;
        for (int i = 0; i < NCH; ++i) {
          const int n = scan_order(d, i);
          nin[(dh * NCH + n) * 128 + kk] = st;
          st = egch[dh * NCH + n] * st + nloc[(dh * NCH + n) * 128 + kk];
        }
      }
    }
    xcd_barrier(xbar);
    gemm_loop<4, true>(shm, 4, vb, 1040, G,
      [=](int L, int r) { const int dh = L / NCH, n = L - dh * NCH; return (const bf16_t*)(AS + ((size_t)dh * T_ALL + n * 128 + r) * 256); },
      [=](int L, int cidx) { const int dh = L / NCH, n = L - dh * NCH, hd = dh & 3; return (const bf16_t*)(VT + ((size_t)n * 1024 + hd * 256 + cidx) * 128); },
      KOffL(),
      [=](int L, int kt) { const int dh = L / NCH, n = L - dh * NCH, hd = dh & 3;
        const int delta = (int)((CinT + (size_t)L * 32768) - (VT + ((size_t)n * 1024 + hd * 256) * 128));
        return kt < 2 ? kt * 64 : delta + (kt - 2) * 64; },
      per_m([=](int L, int row, int col0, const f32x4 (&a)[4]) {
        const int dh = L / NCH, n = L - dh * NCH;
        float* p = hnum + ((size_t)dh * T_ALL + n * 128 + row) * 256 + col0;
#pragma unroll
        for (int nn = 0; nn < 4; ++nn) *(float4*)(p + nn * 4) = make_float4(a[nn][0], a[nn][1], a[nn][2], a[nn][3]);
      }));
    xcd_barrier(xbar);
    {
      const int lane = tid & 63;
      for (int it = blockIdx.x * (NT / 64) + (tid >> 6); it < T_ALL * 4; it += G * (NT / 64)) {
        const int tt = it >> 2, hd = it & 3, n = tt >> 7;
        float hs[4] = {0.f, 0.f, 0.f, 0.f};
#pragma unroll
        for (int d = 0; d < 2; ++d) {
          const int dh = d * 4 + hd;
          const size_t m = (size_t)dh * T_ALL + tt;
          const uint2 av = *(const uint2*)&AS[m * 256 + lane * 4];
          float part;
          if (lane < 32) part = lo2f(av.x) + hi2f(av.x) + lo2f(av.y) + hi2f(av.y);
          else {
            const float4 nv = *(const float4*)&nin[(dh * NCH + n) * 128 + (lane - 32) * 4];
            part = lo2f(av.x) * nv.x + hi2f(av.x) * nv.y + lo2f(av.y) * nv.z + hi2f(av.y) * nv.w;
          }
          const float den = wave_sum(part);
          const float dn = 1.f / fmaxf(fabsf(den), 1.f);
          const float4 x = *(const float4*)&hnum[m * 256 + lane * 4];
          hs[0] += x.x * dn; hs[1] += x.y * dn; hs[2] += x.z * dn; hs[3] += x.w * dn;
        }
        float ss = hs[0] * hs[0] + hs[1] * hs[1] + hs[2] * hs[2] + hs[3] * hs[3];
        ss = wave_sum(ss);
        const float r = 1.f / sqrtf(ss * (1.f / 256.f) + EPSN);
        const int col = hd * 256 + lane * 4;
        const uint2 ov = *(const uint2*)&ZO[(size_t)tt * 1024 + col];
        const float4 g4 = *(const float4*)&ng[col];
        uint2 o;
        o.x = pack2(hs[0] * r * g4.x * sigmoid_f(lo2f(ov.x)), hs[1] * r * g4.y * sigmoid_f(hi2f(ov.x)));
        o.y = pack2(hs[2] * r * g4.z * sigmoid_f(lo2f(ov.y)), hs[3] * r * g4.w * sigmoid_f(hi2f(ov.y)));
        *(uint2*)&A2[(size_t)tt * 1024 + col] = o;
      }
    }
    xcd_barrier(xbar);
    const bf16_t* Wo = (const bf16_t*)(ws + W_MLOUT);
    auto epi_out = [=](int grow, int gcol0, const f32x4 (&a)[4]) { resid_epi(1, grow, gcol0, a); };
    dense_phase(shm, vb, G, A2, 1024, Wo, 1024, 4, 16, true, epi_out);
    xcd_barrier(xbar);
  }
  moe_layer(1, 0);

  {
    norm_phase(P, 0, P.in[6] + 2 * 1024, 2, 0, 1, 0, false, false, 0, smem);
    xcd_barrier(xbar);
    bf16_t* Zg = (bf16_t*)(R + R2_ZG); bf16_t* Zx = (bf16_t*)(R + R2_ZX); bf16_t* xc = (bf16_t*)(R + R2_XC);
    bf16_t* LA = (bf16_t*)(R + R2_LA); bf16_t* U = (bf16_t*)(R + R2_U);
    float* cA = (float*)(R + R2_CA); float* cH = (float*)(R + R2_CH);
    float* cin = (float*)(R + R2_CIN); bf16_t* A3 = (bf16_t*)(R + R2_ZX);
    const float* cw = P.in[28]; const float* cb = P.in[29];
    const float* b_a = P.in[31]; const float* b_x = P.in[33];
    const float* SP = (const float*)(ws + W_SP);
    const bf16_t* Wt = (const bf16_t*)(ws + W_LRUIN);
    auto epi_in = [=](int grow, int gcol0, const f32x4 (&a)[4]) {
      if (gcol0 < 1280) {
        f32x4 bq[4];
#pragma unroll
        for (int n = 0; n < 4; ++n)
#pragma unroll
          for (int j = 0; j < 4; ++j) bq[n][j] = gelu_f(a[n][j]);
        st16bf(Zg + (size_t)grow * 1280 + gcol0, bq);
      } else st16bf(Zx + (size_t)grow * 1280 + gcol0 - 1280, a);
    };
    dense_phase(shm, vb, G, hb, 1024, Wt, 1024, 10, 16, true, epi_in);
    xcd_barrier(xbar);
    for (int idx = gtid; idx < T_ALL * 160; idx += gstride) {
      const int t = idx / 160, c0 = (idx - t * 160) * 8;
      const int lo = t < T_CTX ? 0 : T_CTX, hi = t < T_CTX ? T_CTX : T_ALL;
      float q[8];
#pragma unroll
      for (int e = 0; e < 8; ++e) q[e] = cb[c0 + e];
#pragma unroll
      for (int j = 0; j < 4; ++j) {
        const int tt = t + j - 2;
        if (tt >= lo && tt < hi) {
          const uint4 z = *(const uint4*)&Zx[(size_t)tt * 1280 + c0];
          const float4 w0 = *(const float4*)&cw[j * 1280 + c0], w1 = *(const float4*)&cw[j * 1280 + c0 + 4];
          q[0] += lo2f(z.x) * w0.x; q[1] += hi2f(z.x) * w0.y; q[2] += lo2f(z.y) * w0.z; q[3] += hi2f(z.y) * w0.w;
          q[4] += lo2f(z.z) * w1.x; q[5] += hi2f(z.z) * w1.y; q[6] += lo2f(z.w) * w1.z; q[7] += hi2f(z.w) * w1.w;
        }
      }
      uint4 o; o.x = pack2(q[0], q[1]); o.y = pack2(q[2], q[3]); o.z = pack2(q[4], q[5]); o.w = pack2(q[6], q[7]);
      *(uint4*)&xc[(size_t)t * 1280 + c0] = o;
    }
    xcd_barrier(xbar);
    {
      const bf16_t* WLG = (const bf16_t*)(ws + W_LRUG);
      {
        gemm_loop<8, true>(shm, 2, vb, 65 * 20, G,
          [=](int L, int r) { return (const bf16_t*)(xc + (size_t)((L / 20) * 256 + r) * 1280 + ((L % 20) >> 1) * 128); },
          [=](int L, int cidx) { return WLG + ((size_t)(L % 20) * 256 + cidx) * 128; },
          KOffL(), KOffL(),
          [=](int L, int rb, int col0, const f32x4 (&a)[8][4]) {
            const int m0 = (L / 20) * 256, q = L % 20, nb = q >> 1, d = q & 1;
            const int c = nb * 128 + (col0 >> 1);
            float ba[8], bx[8], sp8[8];
            {
              const float4 t0 = *(const float4*)&b_a[d * 1280 + c], t1 = *(const float4*)&b_a[d * 1280 + c + 4];
              const float4 t2 = *(const float4*)&b_x[d * 1280 + c], t3 = *(const float4*)&b_x[d * 1280 + c + 4];
              const float4 t4 = *(const float4*)&SP[d * 1280 + c], t5 = *(const float4*)&SP[d * 1280 + c + 4];
              ba[0] = t0.x; ba[1] = t0.y; ba[2] = t0.z; ba[3] = t0.w; ba[4] = t1.x; ba[5] = t1.y; ba[6] = t1.z; ba[7] = t1.w;
              bx[0] = t2.x; bx[1] = t2.y; bx[2] = t2.z; bx[3] = t2.w; bx[4] = t3.x; bx[5] = t3.y; bx[6] = t3.z; bx[7] = t3.w;
              sp8[0] = -8.f * t4.x; sp8[1] = -8.f * t4.y; sp8[2] = -8.f * t4.z; sp8[3] = -8.f * t4.w;
              sp8[4] = -8.f * t5.x; sp8[5] = -8.f * t5.y; sp8[6] = -8.f * t5.z; sp8[7] = -8.f * t5.w;
            }
#pragma unroll
            for (int m = 0; m < 8; ++m) {
              const int t = m0 + rb + 16 * m;
              const uint4 xv = *(const uint4*)&xc[(size_t)t * 1280 + c];
              const unsigned xx[4] = {xv.x, xv.y, xv.z, xv.w};
              float la8[8], u8[8];
#pragma unroll
              for (int e = 0; e < 8; ++e) {
                const float ra = a[m][e >> 2][e & 3] + ba[e];
                const float rx = a[m][2 + (e >> 2)][e & 3] + bx[e];
                const float la = sigmoid_f(ra) * sp8[e];
                const float x2 = 2.f * la;
                const float em = -x2 * (1.f + x2 * (0.5f + x2 * (0.16666667f + x2 * (0.041666668f + x2 * (0.0083333338f + x2 * 0.0013888889f)))));
                const float xe = (e & 1) ? hi2f(xx[e >> 1]) : lo2f(xx[e >> 1]);
                la8[e] = la;
                u8[e] = __builtin_amdgcn_sqrtf(em) * (sigmoid_f(rx) * xe);
              }
              uint4 o1, o2;
              o1.x = pack2(la8[0], la8[1]); o1.y = pack2(la8[2], la8[3]); o1.z = pack2(la8[4], la8[5]); o1.w = pack2(la8[6], la8[7]);
              o2.x = pack2(u8[0], u8[1]); o2.y = pack2(u8[2], u8[3]); o2.z = pack2(u8[4], u8[5]); o2.w = pack2(u8[6], u8[7]);
              *(uint4*)&LA[((size_t)d * T_ALL + t) * 1280 + c] = o1;
              *(uint4*)&U[((size_t)d * T_ALL + t) * 1280 + c] = o2;
            }
          });
      }
    }
    xcd_barrier(xbar);
    for (int idx = gtid; idx < 2 * NCH * 320; idx += gstride) {
      const int c = (idx % 320) * 4, dn = idx / 320, n = dn % NCH, d = dn / NCH;
      const bf16_t* la_p = LA + (size_t)d * T_ALL * 1280 + c;
      const bf16_t* u_p = U + (size_t)d * T_ALL * 1280 + c;
      float h[4] = {0.f, 0.f, 0.f, 0.f}, sl[4] = {0.f, 0.f, 0.f, 0.f};
      for (int sb = 0; sb < 128; sb += 8) {
        uint2 lv[8], uv[8];
#pragma unroll
        for (int e = 0; e < 8; ++e) {
          const size_t o = (size_t)(n * 128 + (d == 0 ? sb + e : 127 - sb - e)) * 1280;
          lv[e] = *(const uint2*)(la_p + o); uv[e] = *(const uint2*)(u_p + o);
        }
#pragma unroll
        for (int e = 0; e < 8; ++e) {
          const float l0 = lo2f(lv[e].x), l1 = hi2f(lv[e].x), l2 = lo2f(lv[e].y), l3 = hi2f(lv[e].y);
          h[0] = __expf(l0) * h[0] + lo2f(uv[e].x); h[1] = __expf(l1) * h[1] + hi2f(uv[e].x);
          h[2] = __expf(l2) * h[2] + lo2f(uv[e].y); h[3] = __expf(l3) * h[3] + hi2f(uv[e].y);
          sl[0] += l0; sl[1] += l1; sl[2] += l2; sl[3] += l3;
        }
      }
      *(float4*)&cA[(d * NCH + n) * 1280 + c] = make_float4(__expf(sl[0]), __expf(sl[1]), __expf(sl[2]), __expf(sl[3]));
      *(float4*)&cH[(d * NCH + n) * 1280 + c] = make_float4(h[0], h[1], h[2], h[3]);
    }
    xcd_barrier(xbar);
    for (int idx = gtid; idx < 2 * 1280; idx += gstride) {
      const int d = idx / 1280, c = idx - d * 1280;
      float st = 0.f;
      for (int ib = 0; ib < NCH; ib += 10) {
        float av[10], hv[10];
#pragma unroll
        for (int u = 0; u < 10; ++u) { const int q = (d * NCH + scan_order(d, ib + u)) * 1280 + c; av[u] = cA[q]; hv[u] = cH[q]; }
#pragma unroll
        for (int u = 0; u < 10; ++u) { const int q = (d * NCH + scan_order(d, ib + u)) * 1280 + c; cin[q] = st; st = av[u] * st + hv[u]; }
      }
    }
    xcd_barrier(xbar);
    for (int idx = gtid; idx < 128 * 320; idx += gstride) {
      const int c = (idx % 320) * 4, n = 2 + idx / 320;
      float h[4];
      { const float4 c4 = *(const float4*)&cin[(0 * NCH + n) * 1280 + c]; h[0] = c4.x; h[1] = c4.y; h[2] = c4.z; h[3] = c4.w; }
      for (int sb = 0; sb < 128; sb += 8) {
        uint2 lv[8], uv[8];
#pragma unroll
        for (int e = 0; e < 8; ++e) { const size_t o = (size_t)(n * 128 + sb + e) * 1280 + c; lv[e] = *(const uint2*)&LA[o]; uv[e] = *(const uint2*)&U[o]; }
#pragma unroll
        for (int e = 0; e < 8; ++e) {
          h[0] = __expf(lo2f(lv[e].x)) * h[0] + lo2f(uv[e].x); h[1] = __expf(hi2f(lv[e].x)) * h[1] + hi2f(uv[e].x);
          h[2] = __expf(lo2f(lv[e].y)) * h[2] + lo2f(uv[e].y); h[3] = __expf(hi2f(lv[e].y)) * h[3] + hi2f(uv[e].y);
          uint2 o2; o2.x = pack2(h[0], h[1]); o2.y = pack2(h[2], h[3]);
          *(uint2*)&A3[(size_t)(n * 128 + sb + e) * 1280 + c] = o2;
        }
      }
      { const float4 c4 = *(const float4*)&cin[(1 * NCH + n) * 1280 + c]; h[0] = c4.x; h[1] = c4.y; h[2] = c4.z; h[3] = c4.w; }
      for (int sb = 0; sb < 128; sb += 8) {
        uint2 lv[8], uv[8], gv[8], h0[8];
#pragma unroll
        for (int e = 0; e < 8; ++e) {
          const size_t o = (size_t)(n * 128 + 127 - sb - e) * 1280 + c;
          lv[e] = *(const uint2*)&LA[(size_t)T_ALL * 1280 + o]; uv[e] = *(const uint2*)&U[(size_t)T_ALL * 1280 + o];
          gv[e] = *(const uint2*)&Zg[o]; h0[e] = *(const uint2*)&A3[o];
        }
#pragma unroll
        for (int e = 0; e < 8; ++e) {
          h[0] = __expf(lo2f(lv[e].x)) * h[0] + lo2f(uv[e].x); h[1] = __expf(hi2f(lv[e].x)) * h[1] + hi2f(uv[e].x);
          h[2] = __expf(lo2f(lv[e].y)) * h[2] + lo2f(uv[e].y); h[3] = __expf(hi2f(lv[e].y)) * h[3] + hi2f(uv[e].y);
          uint2 o2;
          o2.x = pack2(lo2f(gv[e].x) * (lo2f(h0[e].x) + h[0]), hi2f(gv[e].x) * (hi2f(h0[e].x) + h[1]));
          o2.y = pack2(lo2f(gv[e].y) * (lo2f(h0[e].y) + h[2]), hi2f(gv[e].y) * (hi2f(h0[e].y) + h[3]));
          *(uint2*)&A3[(size_t)(n * 128 + 127 - sb - e) * 1280 + c] = o2;
        }
      }
    }
    xcd_barrier(xbar);
    const bf16_t* Wo = (const bf16_t*)(ws + W_LRUOUT);
    auto epi_out = [=](int grow, int gcol0, const f32x4 (&a)[4]) { resid_epi(2, grow, gcol0, a); };
    dense_phase(shm, vb, G, A3, 1280, Wo, 1280, 4, 20, false, epi_out);
    xcd_barrier(xbar);
  }
  moe_layer(2, T_CTX);

  {
    norm_phase(P, T_CTX, P.in[6] + 3 * 1024, 3, 0, 2, T_CTX, false, false, 0, smem);
    xcd_barrier(xbar);
    bf16_t* YT = (bf16_t*)(R + R3_YT); bf16_t* GT = (bf16_t*)(R + R3_GT); bf16_t* Ff = (bf16_t*)(R + R3_FF);
    const bf16_t* WP = (const bf16_t*)(ws + W_FNP);
    gemm_loop<8, false>(shm, 16, vb, 64 * 8, G,
      [=](int L, int r) { return (const bf16_t*)(hb + (size_t)(T_CTX + 128 * (r & 127) + 2 * (L >> 3) + (r >> 7)) * DM); },
      [=](int L, int cidx) { return WP + (size_t)((L & 7) * 256 + cidx) * 1024; }, KOffL(), KOffL(),
      [=](int L, int row0, int col, f32x4 v) {
        const int b = 2 * (L >> 3) + (row0 >> 7), a0 = row0 & 127, n0 = (L & 7) * 256;
        uint2 o; o.x = pack2(v[0], v[1]); o.y = pack2(v[2], v[3]);
        *(uint2*)&YT[((size_t)b * 2048 + n0 + col) * 128 + a0] = o;
      });
    xcd_barrier(xbar);
    {
      const bf16_t* DA = (const bf16_t*)(ws + W_DA);
      gemm_loop<4, false>(shm, 4, vb, 1024, G,
        [=](int L, int r) { return (const bf16_t*)(YT + ((size_t)r * 2048 + L) * 128); },
        [=](int L, int cidx) { return DA + (size_t)cidx * 256; },
        [=](int L, int kt) { return kt < 2 ? kt * 64 : 1024 * 128 + (kt - 2) * 64; }, KOffL(),
        [=](int L, int row0, int col, f32x4 v) {
          const int ri = col >> 7, c2 = col & 127;
          uint2 o; o.x = pack2(v[0], v[1]); o.y = pack2(v[2], v[3]);
          *(uint2*)&GT[(((size_t)c2 * 1024 + L) * 2 + ri) * 128 + row0] = o;
        });
    }
    xcd_barrier(xbar);
    {
      const bf16_t* TW = (const bf16_t*)(ws + W_TW);
      gemm_loop<4, true>(shm, 4, vb, 128 * 4, G,
        [=](int L, int r) { return TW + ((size_t)(L >> 2) * 128 + r) * 256; },
        [=](int L, int cidx) { return (const bf16_t*)(GT + ((size_t)(L >> 2) * 1024 + (L & 3) * 256 + cidx) * 256); }, KOffL(), KOffL(),
        per_m([=](int L, int row, int col0, const f32x4 (&a)[4]) {
          const int c2 = L >> 2, n0 = (L & 3) * 256;
          f32x4 b[4];
#pragma unroll
          for (int n = 0; n < 4; ++n) b[n] = a[n] * (1.f / 2048.f);
          st16bf(Ff + (size_t)(c2 + 128 * row) * 1024 + n0 + col0, b);
        }));
    }
    xcd_barrier(xbar);
    const bf16_t* Wo = (const bf16_t*)(ws + W_FNOUT);
    const bf16_t* FfA = Ff - (size_t)T_CTX * 1024;
    auto epi_out = [=](int grow, int gcol0, const f32x4 (&a)[4]) { resid_epi(3, grow, gcol0, a); };
    dense_phase(shm, vb, G, FfA, 1024, Wo, 1024, 4, 16, false, epi_out);
    xcd_barrier(xbar);
  }
  moe_layer(3, T_CTX);

  norm_phase(P, T_CTX, P.in[8], 0, -1, 3, T_CTX, true, false, 0, smem);
}

#undef tid
#undef gtid
#undef gstride
extern "C" void kernel_launch(void* const* d_in, const int* in_sizes, int n_in, void* d_out, int out_size,
                              void* d_ws, size_t ws_size, hipStream_t stream) {
  static int grid_blocks = 0;
  if (!grid_blocks) {
    int dev = 0, cus = 0, per_cu = 0;
    (void)hipGetDevice(&dev);
    (void)hipDeviceGetAttribute(&cus, hipDeviceAttributeMultiprocessorCount, dev);
    (void)hipOccupancyMaxActiveBlocksPerMultiprocessor(&per_cu, mega, NT, 0);
    if (per_cu < 1) fprintf(stderr, "kernel_launch: occupancy query says %d blocks/CU\n", per_cu);
    grid_blocks = cus;
    if (ws_size < WS_NEED) fprintf(stderr, "kernel_launch: workspace too small: %zu < %zu\n", ws_size, (size_t)WS_NEED);
  }
  if (n_in != 38 || ws_size < WS_NEED) return;
  Params p{};
  for (int i = 0; i < 38; ++i) p.in[i] = (const float*)d_in[i];
  p.out = (float*)d_out;
  p.ws = (unsigned char*)d_ws;
  (void)hipMemsetAsync((char*)d_ws + WS_BAR, 0, 16384, stream);
  void* args[] = {&p};
  hipError_t e = hipLaunchCooperativeKernel((void*)mega, dim3(grid_blocks), dim3(NT), args, 0, stream);
  if (e != hipSuccess) fprintf(stderr, "cooperative launch failed: %s (grid %d)\n", hipGetErrorString(e), grid_blocks);
}
```

```cpp
#include <hip/hip_runtime.h>
#include <hip/hip_cooperative_groups.h>
#include <cstdio>
namespace cg = cooperative_groups;

#define T_ALL 16640
#define T_LAT 16384
#define T_CTX 256
#define DM 1024
#define NCH 130
#define EPSN 1e-6f
#define NT 512

typedef unsigned short bf16_t;
using bf16x8 = __attribute__((ext_vector_type(8))) short;
using f32x4 = __attribute__((ext_vector_type(4))) float;

__device__ __forceinline__ float bf2f(bf16_t v) { return __uint_as_float(((unsigned)v) << 16); }
__device__ __forceinline__ bf16_t f2bf(float f) { unsigned u = __float_as_uint(f); u += 0x7fffu + ((u >> 16) & 1u); return (bf16_t)(u >> 16); }
__device__ __forceinline__ unsigned pack2(float a, float b) { return (unsigned)f2bf(a) | (((unsigned)f2bf(b)) << 16); }
__device__ __forceinline__ float lo2f(unsigned u) { return __uint_as_float(u << 16); }
__device__ __forceinline__ float hi2f(unsigned u) { return __uint_as_float(u & 0xffff0000u); }

__device__ __forceinline__ int opaque_tid() { int t = threadIdx.x; asm volatile("" : "+v"(t)); return t; }

constexpr size_t AL(size_t x) { return (x + 255) & ~(size_t)255; }
constexpr size_t WS_MOD    = 0;
constexpr size_t WS_MODP   = AL(WS_MOD + 4 * 2 * 6144 * 4);
constexpr size_t WS_CNT    = AL(WS_MODP + 16 * 4 * 2 * 6144 * 4);
constexpr size_t WS_ZROW   = AL(WS_CNT + 4 * 32 * 32 * 4 + 256);
constexpr size_t WS_BAR    = AL(WS_ZROW + 8192);
constexpr size_t WS_TOK    = AL(WS_BAR + 16384);
constexpr size_t WS_H      = AL(WS_TOK + (size_t)T_ALL * DM * 4);
constexpr size_t WS_HLO    = AL(WS_H + (size_t)T_ALL * DM * 2);
constexpr size_t WS_ASGW   = AL(WS_HLO + (size_t)T_ALL * DM * 2);
constexpr size_t WS_LIST   = AL(WS_ASGW + 33280 * 4);
constexpr size_t WS_ROWTOK = AL(WS_LIST + (size_t)32 * 33280 * 4);
constexpr size_t WS_ROWEXP = AL(WS_ROWTOK + 37376 * 4);
constexpr size_t W_CMIN   = AL(WS_ROWEXP + 292 * 4);
constexpr size_t W_CMOUT  = AL(W_CMIN + (size_t)2048 * 1024 * 2);
constexpr size_t W_MLIN   = AL(W_CMOUT + (size_t)1024 * 1024 * 2);
constexpr size_t W_MLOUT  = AL(W_MLIN + (size_t)3072 * 1024 * 2);
constexpr size_t W_LRUIN  = AL(W_MLOUT + (size_t)1024 * 1024 * 2);
constexpr size_t W_LRUOUT = AL(W_LRUIN + (size_t)2560 * 1024 * 2);
constexpr size_t W_FNIN   = AL(W_LRUOUT + (size_t)1024 * 1280 * 2);
constexpr size_t W_FNP    = AL(W_FNIN + (size_t)1024 * 1024 * 2);
constexpr size_t W_FNOUT  = AL(W_FNP + (size_t)2048 * 1024 * 2);
constexpr size_t W_DC     = AL(W_FNOUT + (size_t)1024 * 1024 * 2);
constexpr size_t W_DA     = AL(W_DC + 512 * 256 * 2);
constexpr size_t W_TW     = AL(W_DA + 256 * 256 * 2);
constexpr size_t W_LRUG   = AL(W_TW + (size_t)128 * 128 * 256 * 2);
constexpr size_t W_SP     = AL(W_LRUG + (size_t)20 * 256 * 128 * 2);
constexpr size_t W_PE     = AL(W_SP + 2 * 1280 * 4);
constexpr size_t W_EGU    = AL(W_PE + (size_t)(2 * 256 + 2 * 64) * 256 * 4);
constexpr size_t W_ED     = AL(W_EGU + (size_t)128 * 1024 * 1024 * 2);
constexpr size_t WS_R     = AL(W_ED + (size_t)128 * 1024 * 512 * 2);
constexpr size_t R_YBUF = 0;
constexpr size_t R_HB   = AL(R_YBUF + (size_t)33280 * 1024 * 2);
constexpr size_t R_MOE_END = AL(R_HB + (size_t)37376 * 512 * 2);
constexpr size_t R0_ZU  = 0;
constexpr size_t R0_ZVT = AL(R0_ZU + (size_t)T_ALL * 1024 * 2);
constexpr size_t R0_P   = AL(R0_ZVT + (size_t)T_ALL * 1024 * 2);
constexpr size_t R0_WSC = AL(R0_P + (size_t)T_ALL * 1024 * 2);
constexpr size_t R0_END = AL(R0_WSC + (size_t)NCH * 4 * 128 * 128 * 2);
constexpr size_t R1_ZQK  = 0;
constexpr size_t R1_ZO   = AL(R1_ZQK + (size_t)T_ALL * 1024 * 2);
constexpr size_t R1_VT   = AL(R1_ZO + (size_t)T_ALL * 1024 * 2);
constexpr size_t R1_GPRE = AL(R1_VT + (size_t)T_ALL * 1024 * 2);
constexpr size_t R1_QN   = AL(R1_GPRE + (size_t)T_ALL * 16 * 4);
constexpr size_t R1_KN   = AL(R1_QN + (size_t)T_ALL * 512 * 2);
constexpr size_t R1_AS   = AL(R1_KN + (size_t)T_ALL * 512 * 2);
constexpr size_t R1_KWT  = AL(R1_AS + (size_t)8 * T_ALL * 256 * 2);
constexpr size_t R1_BC   = AL(R1_KWT + (size_t)8 * T_ALL * 128 * 2);
constexpr size_t R1_LI   = AL(R1_BC + (size_t)8 * T_ALL * 4);
constexpr size_t R1_GCH  = AL(R1_LI + (size_t)8 * T_ALL * 4);
constexpr size_t R1_NLOC = AL(R1_GCH + 8 * NCH * 4);
constexpr size_t R1_NIN  = AL(R1_NLOC + 8 * NCH * 128 * 4);
constexpr size_t R1_CLOC = AL(R1_NIN + 8 * NCH * 128 * 4);
constexpr size_t R1_CINT = AL(R1_CLOC + (size_t)8 * T_ALL * 256 * 4);
constexpr size_t R1_HDEN = AL(R1_CINT + (size_t)8 * T_ALL * 256 * 2);
constexpr size_t R1_A2   = AL(R1_HDEN + 256);
constexpr size_t R1_END  = AL(R1_A2 + (size_t)T_ALL * 1024 * 2);
constexpr size_t R2_ZG  = 0;
constexpr size_t R2_ZX  = AL(R2_ZG + (size_t)T_ALL * 1280 * 2);
constexpr size_t R2_XC  = AL(R2_ZX + (size_t)T_ALL * 1280 * 2);
constexpr size_t R2_LA  = AL(R2_XC + (size_t)T_ALL * 1280 * 2);
constexpr size_t R2_U   = AL(R2_LA + (size_t)2 * T_ALL * 1280 * 2);
constexpr size_t R2_CA  = AL(R2_U + (size_t)2 * T_ALL * 1280 * 2);
constexpr size_t R2_CH  = AL(R2_CA + 2 * NCH * 1280 * 4);
constexpr size_t R2_CIN = AL(R2_CH + 2 * NCH * 1280 * 4);
constexpr size_t R2_END = AL(R2_CIN + 2 * NCH * 1280 * 4);
constexpr size_t R3_YT = 0;
constexpr size_t R3_GT = AL(R3_YT + (size_t)128 * 2048 * 128 * 2);
constexpr size_t R3_FF = AL(R3_GT + (size_t)128 * 2048 * 128 * 2);
constexpr size_t R3_END = AL(R3_FF + (size_t)T_LAT * 1024 * 2);
constexpr size_t cmax(size_t a, size_t b) { return a > b ? a : b; }
constexpr size_t R_SIZE = cmax(cmax(R_MOE_END, R0_END), cmax(cmax(R1_END, R2_END), R3_END));
constexpr size_t WS_NEED = WS_R + R_SIZE;

struct Params { const float* in[38]; float* out; unsigned char* ws; };

__device__ __forceinline__ float sigmoid_f(float x) { return __frcp_rn(1.f + __expf(-x)); }
__device__ __forceinline__ float silu_f(float x) { return x * __frcp_rn(1.f + __expf(-x)); }
__device__ __forceinline__ float gelu_f(float x) {
  const float u2 = 1.5957691216057308f * (x + 0.044715f * x * x * x);
  return x * __frcp_rn(1.f + __expf(-u2));
}
__device__ __forceinline__ float logsig_f(float x) { return fminf(x, 0.f) - log1pf(expf(-fabsf(x))); }
__device__ __forceinline__ float wave_sum(float v) {
#pragma unroll
  for (int o = 32; o >= 1; o >>= 1) v += __shfl_xor(v, o);
  return v;
}
__device__ __forceinline__ int scan_order(int d, int i) { return d == 0 ? i : (i == 0 ? 1 : (i == 1 ? 0 : 131 - i)); }
__device__ __forceinline__ void st16bf(bf16_t* p, const f32x4 (&a)[4]) {
  uint4 o0, o1;
  o0.x = pack2(a[0][0], a[0][1]); o0.y = pack2(a[0][2], a[0][3]); o0.z = pack2(a[1][0], a[1][1]); o0.w = pack2(a[1][2], a[1][3]);
  o1.x = pack2(a[2][0], a[2][1]); o1.y = pack2(a[2][2], a[2][3]); o1.z = pack2(a[3][0], a[3][1]); o1.w = pack2(a[3][2], a[3][3]);
  *(uint4*)p = o0; *(uint4*)(p + 8) = o1;
}

__device__ __forceinline__ int lds_byte(int r, int c) {
  const int st = (r >> 4) * 2 + (c >> 5), ob = (r & 15) * 64 + (c & 31) * 2;
  return st * 1024 + (ob ^ (((ob >> 9) & 1) << 5));
}
__device__ __forceinline__ void stage_rc(int b, int& R, int& C) {
  const int st = b >> 10, sb = b & 1023, swz = sb ^ (((sb >> 9) & 1) << 5);
  R = (st >> 1) * 16 + (swz >> 6);
  C = (st & 1) * 32 + ((swz & 63) >> 1);
}
__device__ __forceinline__ int perm_col(int p) {
  const int q = p & 63, n = q >> 4, i = q & 15;
  return (p & ~63) + (i >> 2) * 16 + n * 4 + (i & 3);
}

struct KOffL { __device__ __forceinline__ int operator()(int, int kt) const { return kt * 64; } };
#define GEMM_LDS_TOTAL 147456
template <int MI, bool SWAP, class RA, class RB, class KA, class KB, class EP>
__device__ __forceinline__ void gemm_loop(char* shm, int nk, int Lbeg, int Lend, int Lstep, RA rowA, RB rowB, KA koffA, KB koffB, EP epi) {
  constexpr int BM = 32 * MI, GLA = MI / 2, GLB = 4;
  constexpr int TILE_A = BM * 128, TILE_B = 256 * 128, STG = TILE_A + TILE_B;
  constexpr int NBUF = (3 * STG <= GEMM_LDS_TOTAL) ? 3 : 2;
  static_assert(NBUF * STG <= GEMM_LDS_TOTAL, "LDS");
  if (Lbeg >= Lend) return;
  const int tid = opaque_tid(), wid = tid >> 6, lane = tid & 63, wr = wid >> 2, wc = wid & 3, fr = lane & 15, fq = lane >> 4;
  const bf16_t* pa[GLA];
  const bf16_t* pb[GLB];
#define GL_SETP(L_) do { int t2_ = tid; asm volatile("" : "+v"(t2_)); const int w2_ = t2_ >> 6, l2_ = t2_ & 63;        \
    _Pragma("unroll") for (int i = 0; i < GLA; ++i) { int R_, C_; stage_rc(w2_ * 1024 + i * 8192 + l2_ * 16, R_, C_); pa[i] = rowA((L_), R_) + C_; } \
    _Pragma("unroll") for (int i = 0; i < GLB; ++i) { int R_, C_; stage_rc(w2_ * 1024 + i * 8192 + l2_ * 16, R_, C_); pb[i] = rowB((L_), SWAP ? perm_col(R_) : R_) + C_; } } while (0)
#define GL_ISSUE(buf, kt, L_) do { const int ka_ = koffA((L_), (kt)), kb_ = koffB((L_), (kt)); char* base_ = shm + (buf) * STG;  \
    _Pragma("unroll") for (int i = 0; i < GLA; ++i)                                                                    \
      __builtin_amdgcn_global_load_lds((const unsigned*)(pa[i] + ka_), (unsigned*)(base_ + wid * 1024 + i * 8192), 16, 0, 0); \
    _Pragma("unroll") for (int i = 0; i < GLB; ++i)                                                                    \
      __builtin_amdgcn_global_load_lds((const unsigned*)(pb[i] + kb_), (unsigned*)(base_ + TILE_A + wid * 1024 + i * 8192), 16, 0, 0); } while (0)
#define GL_RAWBAR() do { asm volatile("s_waitcnt lgkmcnt(0)" ::: "memory"); __builtin_amdgcn_s_barrier(); } while (0)
  const int npre = nk < NBUF ? nk : NBUF;
  GL_SETP(Lbeg);
  for (int s = 0; s < npre; ++s) GL_ISSUE(s, s, Lbeg);
  for (int L = Lbeg; L < Lend; L += Lstep) {
    f32x4 acc[MI][4];
#pragma unroll
    for (int m = 0; m < MI; ++m)
#pragma unroll
      for (int n = 0; n < 4; ++n) acc[m][n] = f32x4{0.f, 0.f, 0.f, 0.f};
    int cur = 0;
    for (int t = 0; t < nk; ++t) {
      if (NBUF == 3 && t >= 1 && t + 1 < nk) {
        if (GLA + GLB == 6) asm volatile("s_waitcnt vmcnt(6)" ::: "memory"); else asm volatile("s_waitcnt vmcnt(5)" ::: "memory");
      } else asm volatile("s_waitcnt vmcnt(0)" ::: "memory");
      GL_RAWBAR();
      if (t >= 1 && t + NBUF - 1 < nk) { const int nb_ = (cur == 0) ? NBUF - 1 : cur - 1; GL_ISSUE(nb_, t + NBUF - 1, L); }
      const char* sa = shm + cur * STG;
      const char* sb = sa + TILE_A;
      const int offA = lds_byte(wr * (MI * 16) + fr, fq * 8), offB = lds_byte(wc * 64 + fr, fq * 8);
#pragma unroll
      for (int ks = 0; ks < 2; ++ks) {
        bf16x8 Bf[4];
#pragma unroll
        for (int n = 0; n < 4; ++n) Bf[n] = *(const bf16x8*)(sb + offB + n * 2048 + ks * 1024);
        constexpr int MG = MI < 4 ? MI : 4;
#pragma unroll
        for (int mh = 0; mh < MI; mh += MG) {
          bf16x8 At[MG];
#pragma unroll
          for (int m = 0; m < MG; ++m) At[m] = *(const bf16x8*)(sa + offA + (mh + m) * 2048 + ks * 1024);
#pragma unroll
          for (int m = 0; m < MG; ++m)
#pragma unroll
            for (int n = 0; n < 4; ++n) {
              if (SWAP) acc[mh + m][n] = __builtin_amdgcn_mfma_f32_16x16x32_bf16(Bf[n], At[m], acc[mh + m][n], 0, 0, 0);
              else      acc[mh + m][n] = __builtin_amdgcn_mfma_f32_16x16x32_bf16(At[m], Bf[n], acc[mh + m][n], 0, 0, 0);
            }
          __builtin_amdgcn_sched_barrier(0);
        }
      }
      cur = (cur == NBUF - 1) ? 0 : cur + 1;
    }
    GL_RAWBAR();
    const int Ln = L + Lstep;
    if (Ln < Lend) { GL_SETP(Ln); for (int s = 0; s < npre; ++s) GL_ISSUE(s, s, Ln); }
    {
      const int t3 = opaque_tid(), w3 = t3 >> 6, l3 = t3 & 63, wr3 = w3 >> 2, wc3 = w3 & 3, fr3 = l3 & 15, fq3 = l3 >> 4;
      if constexpr (SWAP) {
        epi(L, wr3 * (MI * 16) + fr3, wc3 * 64 + fq3 * 16, acc);
      } else {
#pragma unroll
        for (int m = 0; m < MI; ++m)
#pragma unroll
          for (int n = 0; n < 4; ++n) epi(L, wr3 * (MI * 16) + m * 16 + fq3 * 4, wc3 * 64 + n * 16 + fr3, acc[m][n]);
      }
    }
  }
  asm volatile("s_waitcnt vmcnt(0)" ::: "memory");
#undef GL_SETP
#undef GL_ISSUE
#undef GL_RAWBAR
}

template <class F> struct PerM {
  F f;
  template <int MI> __device__ __forceinline__ void operator()(int L, int rb, int c0, const f32x4 (&a)[MI][4]) const {
#pragma unroll
    for (int m = 0; m < MI; ++m) f(L, rb + 16 * m, c0, a[m]);
  }
};
template <class F> __device__ __forceinline__ PerM<F> per_m(F f) { return PerM<F>{f}; }

template <class EP>
__device__ __forceinline__ void dense_phase(char* shm, int vb, int G, const bf16_t* A, int lda, const bf16_t* Wt, int ldw,
                                            int ntn, int nk, bool with_ctx, EP epi) {
  const int nbig = 64 * ntn;
  gemm_loop<8, true>(shm, nk, vb, nbig, G,
    [=](int L, int r) { return A + (size_t)((1 + L / ntn) * 256 + r) * lda; },
    [=](int L, int c) { return Wt + (size_t)((L % ntn) * 256 + c) * ldw; }, KOffL(), KOffL(),
    per_m([=](int L, int row, int col0, const f32x4 (&a)[4]) { epi((1 + L / ntn) * 256 + row, (L % ntn) * 256 + col0, a); }));
  if (with_ctx) {
    const int s = (vb - (nbig % G) + G) % G;
    gemm_loop<2, true>(shm, nk, s, 4 * ntn, G,
      [=](int L, int r) { return A + (size_t)((L / ntn) * 64 + r) * lda; },
      [=](int L, int c) { return Wt + (size_t)((L % ntn) * 256 + c) * ldw; }, KOffL(), KOffL(),
      per_m([=](int L, int row, int col0, const f32x4 (&a)[4]) { epi((L / ntn) * 64 + row, (L % ntn) * 256 + col0, a); }));
  }
}

#define XB_TMO      128
#define XB_XCNT(j)  (256  + 64 * (j))
#define XB_XSUB(j)  (1280 + 64 * (j))
#define XB_XGEN(j)  (2304 + 64 * (j))
#define XB_TOP      3328
#define XB_TOPGEN   3392
#define XCD_BAR_WORDS 3456
#define XB_SPIN_CAP (1u << 22)
#define LAS __attribute__((address_space(3)))
__device__ __forceinline__ unsigned xb_ld(unsigned* p)              { return __hip_atomic_load(p, __ATOMIC_RELAXED, __HIP_MEMORY_SCOPE_AGENT); }
__device__ __forceinline__ unsigned xb_add(unsigned* p, unsigned v) { return __hip_atomic_fetch_add(p, v, __ATOMIC_RELAXED, __HIP_MEMORY_SCOPE_AGENT); }
__device__ __forceinline__ unsigned xb_xcc_id() { return (unsigned)__builtin_amdgcn_s_getreg((3 << 11) | 20) & 0xFu; }
#define XB_SPIN(cond, bar) do { unsigned _sp = 0; while (cond) { __builtin_amdgcn_s_sleep(1); \
    if ((++_sp & 255u) == 0u) { if (xb_ld(&(bar)[XB_TMO])) break; if (_sp > XB_SPIN_CAP) { atomicAdd(&(bar)[XB_TMO], 1u); break; } } } } while (0)
struct XcdBarrier { unsigned* bar; unsigned x; volatile LAS unsigned* st; };
__device__ __forceinline__ XcdBarrier xcd_barrier_post(unsigned* bar, volatile LAS unsigned* st) {
    XcdBarrier b; b.bar = bar; b.x = xb_xcc_id(); b.st = st;
    if (threadIdx.x == 0) (void)xb_add(&bar[XB_XCNT(b.x)], 1u);
    return b;
}
__device__ __forceinline__ void xcd_barrier_complete(unsigned* bar, unsigned x, unsigned& nloc, unsigned& nx) {
    const unsigned G = gridDim.x * gridDim.y * gridDim.z;
    unsigned sum, cnt, mine, sp = 0u;
    for (;;) {
        sum = 0u; cnt = 0u; mine = 0u;
#pragma unroll
        for (unsigned j = 0; j < 16; ++j) { const unsigned c = xb_ld(&bar[XB_XCNT(j)]); sum += c; cnt += (c > 0u) ? 1u : 0u; mine = (j == x) ? c : mine; }
        if (sum == G) break;
        __builtin_amdgcn_s_sleep(1);
        if ((++sp & 255u) == 0u) { if (xb_ld(&bar[XB_TMO])) break; if (sp > XB_SPIN_CAP) { atomicAdd(&bar[XB_TMO], 1u); break; } }
    }
    nloc = mine > 0u ? mine : 1u; nx = cnt > 0u ? cnt : 1u;
}
__device__ __forceinline__ void xcd_barrier(const XcdBarrier& b) {
    asm volatile("s_waitcnt vmcnt(0)" ::: "memory");
    __syncthreads();
    if (threadIdx.x == 0) {
        unsigned* bar = b.bar;
        __builtin_amdgcn_s_waitcnt(0);
        unsigned nloc = b.st[0], nx = b.st[1];
        if (nloc == 0u) { xcd_barrier_complete(bar, b.x, nloc, nx); b.st[0] = nloc; b.st[1] = nx; }
        const unsigned old = xb_add(&bar[XB_XSUB(b.x)], 1u);
        const unsigned gen = old / nloc;
        if (old + 1u == (gen + 1u) * nloc) {
            __builtin_amdgcn_fence(__ATOMIC_RELEASE, "agent");
            asm volatile("s_waitcnt vmcnt(0)" ::: "memory");
            const unsigned og = xb_add(&bar[XB_TOP], 1u);
            const unsigned tg = og / nx;
            if (og + 1u == (tg + 1u) * nx) xb_add(&bar[XB_TOPGEN], 1u);
            else XB_SPIN(xb_ld(&bar[XB_TOPGEN]) == tg, bar);
            __builtin_amdgcn_fence(__ATOMIC_ACQUIRE, "agent");
            xb_add(&bar[XB_XGEN(b.x)], 1u);
            asm volatile("s_waitcnt vmcnt(0)" ::: "memory");
        } else {
            XB_SPIN(xb_ld(&bar[XB_XGEN(b.x)]) == gen, bar);
            __builtin_amdgcn_fence(__ATOMIC_ACQUIRE, "agent");
            asm volatile("s_waitcnt vmcnt(0)" ::: "memory");
        }
    }
    __syncthreads();
}

template <class AF, class BF, class EF>
__device__ __forceinline__ void gemm_naive(int M, int N, int K, AF af, BF bf, EF ef, float* smem_all) {
  const int half = threadIdx.x >> 8, tid = threadIdx.x & 255;
  float* smem = smem_all + half * (2 * 16 * 68);
  const int tilesM = (M + 63) >> 6, tilesN = (N + 63) >> 6;
  const int ntiles = tilesM * tilesN;
  float (*As)[68] = (float (*)[68])smem;
  float (*Bs)[68] = (float (*)[68])(smem + 16 * 68);
  const int ty = tid >> 4, tx = tid & 15;
  const int stride = gridDim.x * 2;
  const int iters = (ntiles + stride - 1) / stride;
  for (int it = 0; it < iters; ++it) {
    const int tile = it * stride + blockIdx.x * 2 + half;
    const bool valid = tile < ntiles;
    const int tm = valid ? tile / tilesN : 0, tn = valid ? tile - tm * tilesN : 0;
    const int m0 = tm << 6, n0 = tn << 6;
    float acc[4][4];
#pragma unroll
    for (int i = 0; i < 4; ++i)
#pragma unroll
      for (int j = 0; j < 4; ++j) acc[i][j] = 0.f;
    for (int k0 = 0; k0 < K; k0 += 16) {
#pragma unroll
      for (int i = 0; i < 4; ++i) {
        const int mm = (tid >> 4) + 16 * i, kk = tid & 15;
        const int m = m0 + mm, k = k0 + kk;
        As[kk][mm] = (valid && m < M && k < K) ? af(m, k, n0) : 0.f;
      }
#pragma unroll
      for (int i = 0; i < 4; ++i) {
        const int kk = (tid >> 6) + 4 * i, nn = tid & 63;
        const int k = k0 + kk, n = n0 + nn;
        Bs[kk][nn] = (valid && k < K && n < N) ? bf(k, n, m0) : 0.f;
      }
      __syncthreads();
#pragma unroll
      for (int kk = 0; kk < 16; ++kk) {
        const float4 a = *(const float4*)&As[kk][ty * 4];
        const float4 b = *(const float4*)&Bs[kk][tx * 4];
        const float av[4] = {a.x, a.y, a.z, a.w};
        const float bv[4] = {b.x, b.y, b.z, b.w};
#pragma unroll
        for (int i = 0; i < 4; ++i)
#pragma unroll
          for (int j = 0; j < 4; ++j) acc[i][j] = fmaf(av[i], bv[j], acc[i][j]);
      }
      __syncthreads();
    }
    if (valid) {
#pragma unroll
      for (int i = 0; i < 4; ++i)
#pragma unroll
        for (int j = 0; j < 4; ++j) {
          const int m = m0 + ty * 4 + i, n = n0 + tx * 4 + j;
          if (m < M && n < N) ef(m, n, acc[i][j]);
        }
    }
  }
}

__device__ __forceinline__ void conv_tile(const float* src, int ldn, bf16_t* dst, int ldk, int k0, int n0, int mapmode, float* sm) {
  const int tid = opaque_tid();
  float (*tl)[65] = (float (*)[65])sm;
  {
    const int row = tid >> 3, c4 = (tid & 7) * 4;
    const float4 a = *(const float4*)&src[(size_t)(k0 + row) * ldn + n0 + c4];
    const float4 b = *(const float4*)&src[(size_t)(k0 + row) * ldn + n0 + 32 + c4];
    tl[row][c4 + 0] = a.x; tl[row][c4 + 1] = a.y; tl[row][c4 + 2] = a.z; tl[row][c4 + 3] = a.w;
    tl[row][32 + c4 + 0] = b.x; tl[row][32 + c4 + 1] = b.y; tl[row][32 + c4 + 2] = b.z; tl[row][32 + c4 + 3] = b.w;
  }
  __syncthreads();
  {
    const int n = tid >> 3, kg = (tid & 7) * 8;
    uint4 o;
    o.x = pack2(tl[kg + 0][n], tl[kg + 1][n]); o.y = pack2(tl[kg + 2][n], tl[kg + 3][n]);
    o.z = pack2(tl[kg + 4][n], tl[kg + 5][n]); o.w = pack2(tl[kg + 6][n], tl[kg + 7][n]);
    const int h = n0 + n;
    const int dr = mapmode == 0 ? h : ((h >> 3) * 16 + (h & 7) + (mapmode == 2 ? 8 : 0));
    *(uint4*)&dst[(size_t)dr * ldk + k0 + kg] = o;
  }
  __syncthreads();
}

__device__ __forceinline__ void norm_phase(const Params& P, int t0, const float* gw,
                                           int mod_layer, int shift_idx,
                                           int pend_layer, int pend_t0,
                                           bool to_out, bool router, int layer, float* wl) {
  int* rl = (int*)((char*)wl + GEMM_LDS_TOTAL + 272);
  unsigned char* ws = P.ws;
  float* tok = (float*)(ws + WS_TOK);
  bf16_t* hb = (bf16_t*)(ws + WS_H);
  const float* mod = (const float*)(ws + WS_MOD);
  const bf16_t* ybuf = (const bf16_t*)(ws + WS_R + R_YBUF);
  const int tid_n = opaque_tid();
  const int lane = tid_n & 63;
  if (router) {
    const float* rgw = P.in[9] + (size_t)layer * 1024 * 4;
    const float* rew = P.in[11] + (size_t)layer * 1024 * 32;
    for (int idx = tid_n; idx < 1024 * 36; idx += NT) {
      const int k = idx / 36, j = idx - k * 36;
      const int rho = (((k >> 8) * 4 + (k & 3)) * 64) + ((k & 255) >> 2);
      wl[rho * 36 + j] = (j < 4) ? rgw[k * 4 + j] : rew[k * 32 + (j - 4)];
    }
    if (tid_n < 80) rl[tid_n] = 0;
    __syncthreads();
  }
  const int gw_id = blockIdx.x * (NT / 64) + (tid_n >> 6);
  const int gw_n = gridDim.x * (NT / 64);
  for (int t = t0 + gw_id; t < T_ALL; t += gw_n) {
    const int s = (t < T_CTX) ? 1 : 0;
    float v[16];
#pragma unroll
    for (int j = 0; j < 4; ++j) {
      const int n = j * 256 + lane * 4;
      const float4 x = *(const float4*)&tok[(size_t)t * DM + n];
      v[j * 4 + 0] = x.x; v[j * 4 + 1] = x.y; v[j * 4 + 2] = x.z; v[j * 4 + 3] = x.w;
    }
    if (pend_layer >= 0 && t >= pend_t0) {
      const float* gate = mod + (size_t)((pend_layer * 2 + s) * 6 + 5) * 1024;
#pragma unroll
      for (int j = 0; j < 4; ++j) {
        const int n = j * 256 + lane * 4;
        const uint2 y0 = *(const uint2*)&ybuf[(size_t)(2 * t) * DM + n];
        const uint2 y1 = *(const uint2*)&ybuf[(size_t)(2 * t + 1) * DM + n];
        const float4 g = *(const float4*)&gate[n];
        v[j * 4 + 0] += g.x * (lo2f(y0.x) + lo2f(y1.x));
        v[j * 4 + 1] += g.y * (hi2f(y0.x) + hi2f(y1.x));
        v[j * 4 + 2] += g.z * (lo2f(y0.y) + lo2f(y1.y));
        v[j * 4 + 3] += g.w * (hi2f(y0.y) + hi2f(y1.y));
        *(float4*)&tok[(size_t)t * DM + n] = make_float4(v[j * 4 + 0], v[j * 4 + 1], v[j * 4 + 2], v[j * 4 + 3]);
      }
    }
    float ss = 0.f;
#pragma unroll
    for (int e = 0; e < 16; ++e) ss += v[e] * v[e];
    ss = wave_sum(ss);
    const float r = 1.f / sqrtf(ss * (1.f / 1024.f) + EPSN);
    float h[16];
#pragma unroll
    for (int j = 0; j < 4; ++j) {
      const int n = j * 256 + lane * 4;
      const float4 g = *(const float4*)&gw[n];
      h[j * 4 + 0] = v[j * 4 + 0] * r * g.x;
      h[j * 4 + 1] = v[j * 4 + 1] * r * g.y;
      h[j * 4 + 2] = v[j * 4 + 2] * r * g.z;
      h[j * 4 + 3] = v[j * 4 + 3] * r * g.w;
      if (shift_idx >= 0) {
        const float* sh = mod + (size_t)((mod_layer * 2 + s) * 6 + shift_idx) * 1024;
        const float* sc = sh + 1024;
        const float4 a = *(const float4*)&sh[n];
        const float4 b = *(const float4*)&sc[n];
        h[j * 4 + 0] = h[j * 4 + 0] * (1.f + b.x) + a.x;
        h[j * 4 + 1] = h[j * 4 + 1] * (1.f + b.y) + a.y;
        h[j * 4 + 2] = h[j * 4 + 2] * (1.f + b.z) + a.z;
        h[j * 4 + 3] = h[j * 4 + 3] * (1.f + b.w) + a.w;
      }
      if (to_out) {
        *(float4*)&P.out[(size_t)(t - T_CTX) * DM + n] = make_float4(h[j * 4 + 0], h[j * 4 + 1], h[j * 4 + 2], h[j * 4 + 3]);
      } else {
        uint2 o; o.x = pack2(h[j * 4 + 0], h[j * 4 + 1]); o.y = pack2(h[j * 4 + 2], h[j * 4 + 3]);
        *(uint2*)&hb[(size_t)t * DM + n] = o;
      }
    }
    if (router) {
      float lg[36];
#pragma unroll
      for (int q = 0; q < 36; ++q) lg[q] = 0.f;
#pragma unroll
      for (int i = 0; i < 16; ++i) {
        const float hv = h[i];
        const float4* wr4 = (const float4*)(wl + (i * 64 + lane) * 36);
#pragma unroll
        for (int q = 0; q < 9; ++q) {
          const float4 w4 = wr4[q];
          lg[q * 4 + 0] += hv * w4.x; lg[q * 4 + 1] += hv * w4.y; lg[q * 4 + 2] += hv * w4.z; lg[q * 4 + 3] += hv * w4.w;
        }
        __builtin_amdgcn_sched_barrier(0);
      }
#pragma unroll
      for (int q = 0; q < 36; ++q) lg[q] = wave_sum(lg[q]);
      const float* rgb = P.in[10] + layer * 4;
      const float* reb = P.in[12] + layer * 32;
#pragma unroll
      for (int q = 0; q < 4; ++q) lg[q] += rgb[q];
#pragma unroll
      for (int q = 0; q < 32; ++q) lg[4 + q] += reb[q];
      int grp = 0; float best = lg[0];
#pragma unroll
      for (int q = 1; q < 4; ++q) if (lg[q] > best) { best = lg[q]; grp = q; }
      float se = 0.f;
#pragma unroll
      for (int q = 0; q < 4; ++q) se += expf(lg[q] - best);
      const float pg = 1.f / se;
      float v0 = -3.0e38f, v1 = -3.0e38f; int i0 = 0, i1 = 0;
#pragma unroll
      for (int g = 0; g < 4; ++g) {
#pragma unroll
        for (int q = 0; q < 8; ++q) {
          const float x = lg[4 + g * 8 + q];
          if (g == grp) {
            if (x > v0) { v1 = v0; i1 = i0; v0 = x; i0 = q; }
            else if (x > v1) { v1 = x; i1 = q; }
          }
        }
      }
      const float w0 = 1.f / (1.f + expf(v1 - v0));
      const float w1 = 1.f - w0;
      if (lane == 0) {
        float* asgw = (float*)(ws + WS_ASGW);
        const int e0 = grp * 8 + i0, e1 = grp * 8 + i1;
        const int p0 = atomicAdd(&rl[e0], 1);
        const int p1 = atomicAdd(&rl[e1], 1);
        const int sl = atomicAdd(&rl[64], 2);
        rl[80 + sl] = 2 * t;         rl[240 + sl] = e0;     rl[400 + sl] = p0;
        rl[80 + sl + 1] = 2 * t + 1; rl[240 + sl + 1] = e1; rl[400 + sl + 1] = p1;
        asgw[2 * t] = w0 * pg;
        asgw[2 * t + 1] = w1 * pg;
      }
    }
  }
  if (router) {
    __syncthreads();
    int* cnt = (int*)(ws + WS_CNT) + layer * 32 * 32;
    int* list = (int*)(ws + WS_LIST);
    if (tid_n < 32) rl[32 + tid_n] = rl[tid_n] ? atomicAdd(&cnt[tid_n * 32], rl[tid_n]) : 0;
    __syncthreads();
    const int nent = rl[64];
    for (int s = tid_n; s < nent; s += NT) {
      const int e = rl[240 + s];
      list[(size_t)e * 33280 + rl[32 + e] + rl[400 + s]] = rl[80 + s];
    }
    __syncthreads();
  }
}


__device__ __forceinline__ void route_token(const float (&lg_in)[36], const float* rgb, const float* reb, int t, int* rl, float* asgw) {
  float lg[36];
#pragma unroll
  for (int q = 0; q < 4; ++q) lg[q] = lg_in[q] + rgb[q];
#pragma unroll
  for (int q = 0; q < 32; ++q) lg[4 + q] = lg_in[4 + q] + reb[q];
  int grp = 0; float best = lg[0];
#pragma unroll
  for (int q = 1; q < 4; ++q) if (lg[q] > best) { best = lg[q]; grp = q; }
  float se = 0.f;
#pragma unroll
  for (int q = 0; q < 4; ++q) se += expf(lg[q] - best);
  const float pg = 1.f / se;
  float v0 = -3.0e38f, v1 = -3.0e38f; int i0 = 0, i1 = 0;
#pragma unroll
  for (int g = 0; g < 4; ++g) {
#pragma unroll
    for (int q = 0; q < 8; ++q) {
      const float x = lg[4 + g * 8 + q];
      if (g == grp) {
        if (x > v0) { v1 = v0; i1 = i0; v0 = x; i0 = q; }
        else if (x > v1) { v1 = x; i1 = q; }
      }
    }
  }
  const float w0 = 1.f / (1.f + expf(v1 - v0));
  const float w1 = 1.f - w0;
  const int e0 = grp * 8 + i0, e1 = grp * 8 + i1;
  const int p0 = atomicAdd(&rl[e0], 1);
  const int p1 = atomicAdd(&rl[e1], 1);
  const int sl = atomicAdd(&rl[64], 2);
  rl[80 + sl] = 2 * t;         rl[240 + sl] = e0;     rl[400 + sl] = p0;
  rl[80 + sl + 1] = 2 * t + 1; rl[240 + sl + 1] = e1; rl[400 + sl + 1] = p1;
  asgw[2 * t] = w0 * pg;
  asgw[2 * t + 1] = w1 * pg;
}

__device__ __forceinline__ void route_token2(float res, int t, int* rl, float* asgw, int lane) {
  const float g0 = __shfl(res, 0), g1 = __shfl(res, 1), g2 = __shfl(res, 2), g3 = __shfl(res, 3);
  int grp = 0; float best = g0;
  if (g1 > best) { best = g1; grp = 1; }
  if (g2 > best) { best = g2; grp = 2; }
  if (g3 > best) { best = g3; grp = 3; }
  const float pg = 1.f / (expf(g0 - best) + expf(g1 - best) + expf(g2 - best) + expf(g3 - best));
  float v0 = -3.0e38f, v1 = -3.0e38f; int i0 = 0, i1 = 0;
#pragma unroll
  for (int q = 0; q < 8; ++q) {
    const float x = __shfl(res, 4 + grp * 8 + q);
    if (x > v0) { v1 = v0; i1 = i0; v0 = x; i0 = q; }
    else if (x > v1) { v1 = x; i1 = q; }
  }
  if (lane == 0) {
    const float w0 = 1.f / (1.f + expf(v1 - v0));
    const float w1 = 1.f - w0;
    const int e0 = grp * 8 + i0, e1 = grp * 8 + i1;
    const int p0 = atomicAdd(&rl[e0], 1);
    const int p1 = atomicAdd(&rl[e1], 1);
    const int sl = atomicAdd(&rl[64], 2);
    rl[80 + sl] = 2 * t;         rl[240 + sl] = e0;     rl[400 + sl] = p0;
    rl[80 + sl + 1] = 2 * t + 1; rl[240 + sl + 1] = e1; rl[400 + sl + 1] = p1;
    asgw[2 * t] = w0 * pg;
    asgw[2 * t + 1] = w1 * pg;
  }
}

__device__ __forceinline__ void ffn_norm_router_phase(const Params& P, int t0, int layer, float* wl) {
  unsigned char* ws = P.ws;
  int* rl = (int*)((char*)wl + GEMM_LDS_TOTAL + 272);
  const float* tok = (const float*)(ws + WS_TOK);
  bf16_t* hb = (bf16_t*)(ws + WS_H);
  const float* mod = (const float*)(ws + WS_MOD);
  const float* gw = P.in[7] + layer * 1024;
  const int tid_n = opaque_tid();
  const int lane0 = tid_n & 63;
  {
    const float* rgw = P.in[9] + (size_t)layer * 1024 * 4;
    const float* rew = P.in[11] + (size_t)layer * 1024 * 32;
    for (int ib = 0; ib < 18; ib += 6) {
      float4 w[6];
#pragma unroll
      for (int u = 0; u < 6; ++u) {
        const int idx = tid_n + (ib + u) * NT, k = idx / 9, q = idx - k * 9;
        const float* wp = (q == 0) ? rgw + k * 4 : rew + k * 32 + (q - 1) * 4;
        w[u] = *(const float4*)wp;
      }
#pragma unroll
      for (int u = 0; u < 6; ++u) {
        const int idx = tid_n + (ib + u) * NT, k = idx / 9, q = idx - k * 9;
        const int rho = (((k >> 8) * 4 + (k & 3)) * 64) + ((k & 255) >> 2);
        *(float4*)&wl[rho * 36 + q * 4] = w[u];
      }
    }
    if (tid_n < 80) rl[tid_n] = 0;
    __syncthreads();
  }
  const float* rgb = P.in[10] + layer * 4;
  const float* reb = P.in[12] + layer * 32;
  float* asgw = (float*)(ws + WS_ASGW);
  const int gw_id = blockIdx.x * (NT / 64) + (tid_n >> 6);
  const int gw_n = gridDim.x * (NT / 64);
  for (int tA = t0 + gw_id; tA < T_ALL; tA += 2 * gw_n) {
    int lane = lane0; asm volatile("" : "+v"(lane));
    const int tB = tA + gw_n;
    const bool hasB = tB < T_ALL;
    const int tBs = hasB ? tB : tA;
    float hA[16], hB[16];
    {
      float vA[16], vB[16];
#pragma unroll
      for (int j = 0; j < 4; ++j) {
        const int n = j * 256 + lane * 4;
        const float4 x = *(const float4*)&tok[(size_t)tA * DM + n];
        const float4 y = *(const float4*)&tok[(size_t)tBs * DM + n];
        vA[j * 4 + 0] = x.x; vA[j * 4 + 1] = x.y; vA[j * 4 + 2] = x.z; vA[j * 4 + 3] = x.w;
        vB[j * 4 + 0] = y.x; vB[j * 4 + 1] = y.y; vB[j * 4 + 2] = y.z; vB[j * 4 + 3] = y.w;
      }
      float sA = 0.f, sB = 0.f;
#pragma unroll
      for (int e = 0; e < 16; ++e) { sA += vA[e] * vA[e]; sB += vB[e] * vB[e]; }
      sA = wave_sum(sA); sB = wave_sum(sB);
      const float rA = 1.f / sqrtf(sA * (1.f / 1024.f) + EPSN), rB = 1.f / sqrtf(sB * (1.f / 1024.f) + EPSN);
      const int stA = (tA < T_CTX) ? 1 : 0, stB = (tBs < T_CTX) ? 1 : 0;
      const float* shA = mod + (size_t)((layer * 2 + stA) * 6 + 3) * 1024;
      const float* shB = mod + (size_t)((layer * 2 + stB) * 6 + 3) * 1024;
#pragma unroll
      for (int j = 0; j < 4; ++j) {
        const int n = j * 256 + lane * 4;
        const float4 g = *(const float4*)&gw[n];
        const float4 a1 = *(const float4*)&shA[n], b1 = *(const float4*)&shA[1024 + n];
        const float4 a2 = *(const float4*)&shB[n], b2 = *(const float4*)&shB[1024 + n];
        hA[j * 4 + 0] = vA[j * 4 + 0] * rA * g.x * (1.f + b1.x) + a1.x; hA[j * 4 + 1] = vA[j * 4 + 1] * rA * g.y * (1.f + b1.y) + a1.y;
        hA[j * 4 + 2] = vA[j * 4 + 2] * rA * g.z * (1.f + b1.z) + a1.z; hA[j * 4 + 3] = vA[j * 4 + 3] * rA * g.w * (1.f + b1.w) + a1.w;
        hB[j * 4 + 0] = vB[j * 4 + 0] * rB * g.x * (1.f + b2.x) + a2.x; hB[j * 4 + 1] = vB[j * 4 + 1] * rB * g.y * (1.f + b2.y) + a2.y;
        hB[j * 4 + 2] = vB[j * 4 + 2] * rB * g.z * (1.f + b2.z) + a2.z; hB[j * 4 + 3] = vB[j * 4 + 3] * rB * g.w * (1.f + b2.w) + a2.w;
        uint2 o; o.x = pack2(hA[j * 4 + 0], hA[j * 4 + 1]); o.y = pack2(hA[j * 4 + 2], hA[j * 4 + 3]);
        *(uint2*)&hb[(size_t)tA * DM + n] = o;
        if (hasB) { uint2 o2; o2.x = pack2(hB[j * 4 + 0], hB[j * 4 + 1]); o2.y = pack2(hB[j * 4 + 2], hB[j * 4 + 3]); *(uint2*)&hb[(size_t)tB * DM + n] = o2; }
      }
    }
    float lA[36], lB[36];
#pragma unroll
    for (int q = 0; q < 36; ++q) { lA[q] = 0.f; lB[q] = 0.f; }
#pragma unroll
    for (int i = 0; i < 16; ++i) {
      const float4* wr4 = (const float4*)(wl + (i * 64 + lane) * 36);
#pragma unroll
      for (int q = 0; q < 9; ++q) {
        const float4 w4 = wr4[q];
        lA[q * 4 + 0] += hA[i] * w4.x; lA[q * 4 + 1] += hA[i] * w4.y; lA[q * 4 + 2] += hA[i] * w4.z; lA[q * 4 + 3] += hA[i] * w4.w;
        lB[q * 4 + 0] += hB[i] * w4.x; lB[q * 4 + 1] += hB[i] * w4.y; lB[q * 4 + 2] += hB[i] * w4.z; lB[q * 4 + 3] += hB[i] * w4.w;
      }
      __builtin_amdgcn_sched_barrier(0);
    }
    float resA = 0.f, resB = 0.f;
#pragma unroll
    for (int q = 0; q < 36; ++q) {
      const float sa = wave_sum(lA[q]), sb2 = wave_sum(lB[q]);
      if (lane == q) { resA = sa; resB = sb2; }
    }
    {
      const float bias = lane < 4 ? rgb[lane] : (lane < 36 ? reb[lane - 4] : 0.f);
      resA += bias; resB += bias;
    }
    route_token2(resA, tA, rl, asgw, lane);
    if (hasB) route_token2(resB, tB, rl, asgw, lane);
  }
  __syncthreads();
  int* cnt = (int*)(ws + WS_CNT) + layer * 32 * 32;
  int* list = (int*)(ws + WS_LIST);
  if (tid_n < 32) rl[32 + tid_n] = rl[tid_n] ? atomicAdd(&cnt[tid_n * 32], rl[tid_n]) : 0;
  __syncthreads();
  const int nent = rl[64];
  for (int s = tid_n; s < nent; s += NT) {
    const int e = rl[240 + s];
    list[(size_t)e * 33280 + rl[32 + e] + rl[400 + s]] = rl[80 + s];
  }
  __syncthreads();
}

#define tid (opaque_tid())
#define gtid ((int)(blockIdx.x * NT) + opaque_tid())
#define gstride ((int)(gridDim.x * NT))
__global__ void __launch_bounds__(NT, 2) mega(Params P) {
  cg::grid_group grid = cg::this_grid();
  __shared__ __attribute__((aligned(1024))) char shm[GEMM_LDS_TOTAL + 16 + 256 + 2560];
  float* smem = (float*)shm;
  if (threadIdx.x < 4) ((unsigned*)(shm + GEMM_LDS_TOTAL))[threadIdx.x] = 0u;
  __syncthreads();
  XcdBarrier xbar = xcd_barrier_post((unsigned*)(P.ws + WS_BAR), (volatile LAS unsigned*)(shm + GEMM_LDS_TOTAL));
  unsigned char* ws = P.ws;
  const int G = gridDim.x;
  const int vb = (G % 8 == 0) ? ((int)(blockIdx.x & 7) * (G / 8) + (int)(blockIdx.x >> 3)) : (int)blockIdx.x;
  float* tok = (float*)(ws + WS_TOK);
  bf16_t* hb = (bf16_t*)(ws + WS_H);
  float* mod = (float*)(ws + WS_MOD);
  const bf16_t* zrow = (const bf16_t*)(ws + WS_ZROW);
  unsigned char* R = ws + WS_R;

  {
    {
      float* PE = (float*)(ws + W_PE);
      for (int idx = gtid; idx < 320 * 256; idx += gstride) {
        const int p = idx >> 8, j = idx & 255;
        const float freq = expf(-9.210340371976184f * (float)j / 256.f);
        const float ang = (float)(p < 256 ? p : p - 256) * freq;
        float sv, cv; sincosf(ang, &sv, &cv);
        if (p < 256) { PE[p * 256 + j] = sv; PE[65536 + p * 256 + j] = cv; }
        else { PE[131072 + (p - 256) * 256 + j] = sv; PE[131072 + 16384 + (p - 256) * 256 + j] = cv; }
      }
    }
    {
      const float* c = P.in[1]; const float* cc = P.in[3]; const float* adaw = P.in[4];
      float* modp = (float*)(ws + WS_MODP);
      float* s_c = smem;
      for (int k = tid; k < 1024; k += NT) { const float a = c[k], b2 = cc[k]; s_c[k] = a / (1.f + expf(-a)); s_c[1024 + k] = b2 / (1.f + expf(-b2)); }
      __syncthreads();
      for (int idx = gtid; idx < 16 * 4 * 1536; idx += gstride) {
        const int ks = idx / 6144, rem = idx - ks * 6144, i = rem / 1536, j = (rem - i * 1536) * 4;
        const float* wp = adaw + ((size_t)i * 1024 + ks * 64) * 6144 + j;
        float4 a0 = make_float4(0.f, 0.f, 0.f, 0.f), a1 = a0;
        for (int kb = 0; kb < 64; kb += 8) {
          float4 w[8];
#pragma unroll
          for (int u = 0; u < 8; ++u) w[u] = *(const float4*)(wp + (size_t)(kb + u) * 6144);
#pragma unroll
          for (int u = 0; u < 8; ++u) {
            const float s0 = s_c[ks * 64 + kb + u], s1 = s_c[1024 + ks * 64 + kb + u];
            a0.x += s0 * w[u].x; a0.y += s0 * w[u].y; a0.z += s0 * w[u].z; a0.w += s0 * w[u].w;
            a1.x += s1 * w[u].x; a1.y += s1 * w[u].y; a1.z += s1 * w[u].z; a1.w += s1 * w[u].w;
          }
        }
        *(float4*)&modp[(size_t)(ks * 8 + i * 2 + 0) * 6144 + j] = a0;
        *(float4*)&modp[(size_t)(ks * 8 + i * 2 + 1) * 6144 + j] = a1;
      }
      __syncthreads();
    }
    if (gtid < 4 * 32 * 32 + 64) ((int*)(ws + WS_CNT))[gtid] = 0;
    if (gtid < 2048) ((unsigned*)(ws + WS_ZROW))[gtid] = 0u;
    bf16_t* DC = (bf16_t*)(ws + W_DC); bf16_t* DA = (bf16_t*)(ws + W_DA); bf16_t* TW = (bf16_t*)(ws + W_TW);
    for (int idx = gtid; idx < 512 * 256; idx += gstride) {
      const int row = idx >> 8, cch = idx & 255, pq = row >> 8, kc = row & 255;
      const float a = (float)((kc * cch) & 255) * (1.f / 128.f);
      DC[idx] = f2bf(pq ? -sinpif(a) : cospif(a));
    }
    for (int idx = gtid; idx < 256 * 256; idx += gstride) {
      const int row = idx >> 8, col = idx & 255, ri = row >> 7, cc2 = row & 127, rj = col >> 7, aa = col & 127;
      const float a = (float)((aa * cc2) & 127) * (1.f / 64.f);
      const float cs = cospif(a), sn = sinpif(a);
      DA[idx] = f2bf(ri == rj ? cs : (ri == 0 ? sn : -sn));
    }
    for (int idx = gtid; idx < 128 * 128 * 256; idx += gstride) {
      const int col = idx & 255, e = (idx >> 8) & 127, c2 = idx >> 15, ri = col >> 7, b = col & 127;
      const float a = (float)((b * (c2 + 128 * e)) & 16383) * (1.f / 8192.f);
      TW[idx] = f2bf(ri ? sinpif(a) : cospif(a));
    }
    for (int idx = gtid; idx < 2 * 1280; idx += gstride) ((float*)(ws + W_SP))[idx] = log1pf(expf(-P.in[34][idx]));
    {
      const float* src = P.in[36]; bf16_t* dst = (bf16_t*)(ws + W_FNIN);
      for (int idx = gtid; idx < 1024 * 1024 / 4; idx += gstride) {
        const float4 a = *(const float4*)&src[(size_t)idx * 4];
        uint2 o; o.x = pack2(a.x, a.y); o.y = pack2(a.z, a.w);
        *(uint2*)&dst[(size_t)idx * 4] = o;
      }
    }
    {
      struct CD { const float* src; bf16_t* dst; int ldn, ldk, k0, n0, mm; };
      const int NDENSE = 512 + 256 + 768 + 256 + 640 + 320 + 256 + 160;
      const int NTOT = NDENSE + 128 * 384;
      auto desc = [=](int u) -> CD {
        CD d;
        if (u < NDENSE) {
          int v = u;
          if (v < 512) { d = CD{P.in[16], (bf16_t*)(ws + W_CMIN), 2048, 1024, (v >> 5) * 64, (v & 31) * 64, 0}; return d; }
          v -= 512;
          if (v < 256) { d = CD{P.in[20], (bf16_t*)(ws + W_CMOUT), 1024, 1024, (v >> 4) * 64, (v & 15) * 64, 0}; return d; }
          v -= 256;
          if (v < 768) { d = CD{P.in[21], (bf16_t*)(ws + W_MLIN), 3088, 1024, (v / 48) * 64, (v % 48) * 64, 0}; return d; }
          v -= 768;
          if (v < 256) { d = CD{P.in[26], (bf16_t*)(ws + W_MLOUT), 1024, 1024, (v >> 4) * 64, (v & 15) * 64, 0}; return d; }
          v -= 256;
          if (v < 640) { d = CD{P.in[27], (bf16_t*)(ws + W_LRUIN), 2560, 1024, (v / 40) * 64, (v % 40) * 64, 0}; return d; }
          v -= 640;
          if (v < 320) { d = CD{P.in[35], (bf16_t*)(ws + W_LRUOUT), 1024, 1280, (v >> 4) * 64, (v & 15) * 64, 0}; return d; }
          v -= 320;
          if (v < 256) { d = CD{P.in[37], (bf16_t*)(ws + W_FNOUT), 1024, 1024, (v >> 4) * 64, (v & 15) * 64, 0}; return d; }
          v -= 256;
          const int mat = v >> 2, tl4 = v & 3, type = mat / 20, dnb = mat % 20, dd = dnb / 10, nb = dnb % 10;
          d = CD{(type ? P.in[32] : P.in[30]) + (size_t)dnb * 128 * 128, (bf16_t*)(ws + W_LRUG) + (size_t)(nb * 2 + dd) * 256 * 128,
                 128, 128, (tl4 >> 1) * 64, (tl4 & 1) * 64, type + 1};
          return d;
        }
        const int v = u - NDENSE, le = v / 384, r = v - le * 384, kind = r >> 7, tt = r & 127;
        if (kind < 2) d = CD{(kind == 0 ? P.in[13] : P.in[14]) + (size_t)le * 1024 * 512, (bf16_t*)(ws + W_EGU) + (size_t)le * 1024 * 1024,
                             512, 1024, (tt >> 3) * 64, (tt & 7) * 64, kind + 1};
        else d = CD{P.in[15] + (size_t)le * 512 * 1024, (bf16_t*)(ws + W_ED) + (size_t)le * 1024 * 512, 1024, 512, (tt >> 4) * 64, (tt & 15) * 64, 0};
        return d;
      };
      const int tq = tid, lrow = tq >> 3, c4 = (tq & 7) * 4, sn = tq >> 3, kg = (tq & 7) * 8;
      float (*tl0)[65] = (float (*)[65])smem;
      float (*tl1)[65] = (float (*)[65])(smem + 64 * 65);
      int u = blockIdx.x;
      CD d0 = desc(u < NTOT ? u : 0), d1 = desc(u + G < NTOT ? u + G : 0);
      float4 a0, b0, a1, b1;
      a0 = *(const float4*)&d0.src[(size_t)(d0.k0 + lrow) * d0.ldn + d0.n0 + c4];
      b0 = *(const float4*)&d0.src[(size_t)(d0.k0 + lrow) * d0.ldn + d0.n0 + 32 + c4];
      a1 = *(const float4*)&d1.src[(size_t)(d1.k0 + lrow) * d1.ldn + d1.n0 + c4];
      b1 = *(const float4*)&d1.src[(size_t)(d1.k0 + lrow) * d1.ldn + d1.n0 + 32 + c4];
      for (; u < NTOT; u += 2 * G) {
        const bool v1 = u + G < NTOT;
        tl0[lrow][c4 + 0] = a0.x; tl0[lrow][c4 + 1] = a0.y; tl0[lrow][c4 + 2] = a0.z; tl0[lrow][c4 + 3] = a0.w;
        tl0[lrow][32 + c4 + 0] = b0.x; tl0[lrow][32 + c4 + 1] = b0.y; tl0[lrow][32 + c4 + 2] = b0.z; tl0[lrow][32 + c4 + 3] = b0.w;
        tl1[lrow][c4 + 0] = a1.x; tl1[lrow][c4 + 1] = a1.y; tl1[lrow][c4 + 2] = a1.z; tl1[lrow][c4 + 3] = a1.w;
        tl1[lrow][32 + c4 + 0] = b1.x; tl1[lrow][32 + c4 + 1] = b1.y; tl1[lrow][32 + c4 + 2] = b1.z; tl1[lrow][32 + c4 + 3] = b1.w;
        __syncthreads();
        const CD c0 = d0, c1 = d1;
        const int un = u + 2 * G;
        if (un < NTOT) {
          d0 = desc(un); d1 = desc(un + G < NTOT ? un + G : un);
          a0 = *(const float4*)&d0.src[(size_t)(d0.k0 + lrow) * d0.ldn + d0.n0 + c4];
          b0 = *(const float4*)&d0.src[(size_t)(d0.k0 + lrow) * d0.ldn + d0.n0 + 32 + c4];
          a1 = *(const float4*)&d1.src[(size_t)(d1.k0 + lrow) * d1.ldn + d1.n0 + c4];
          b1 = *(const float4*)&d1.src[(size_t)(d1.k0 + lrow) * d1.ldn + d1.n0 + 32 + c4];
        }
        {
          uint4 o;
          o.x = pack2(tl0[kg + 0][sn], tl0[kg + 1][sn]); o.y = pack2(tl0[kg + 2][sn], tl0[kg + 3][sn]);
          o.z = pack2(tl0[kg + 4][sn], tl0[kg + 5][sn]); o.w = pack2(tl0[kg + 6][sn], tl0[kg + 7][sn]);
          const int h = c0.n0 + sn;
          const int dr = c0.mm == 0 ? h : ((h >> 3) * 16 + (h & 7) + (c0.mm == 2 ? 8 : 0));
          *(uint4*)&c0.dst[(size_t)dr * c0.ldk + c0.k0 + kg] = o;
        }
        if (v1) {
          uint4 o;
          o.x = pack2(tl1[kg + 0][sn], tl1[kg + 1][sn]); o.y = pack2(tl1[kg + 2][sn], tl1[kg + 3][sn]);
          o.z = pack2(tl1[kg + 4][sn], tl1[kg + 5][sn]); o.w = pack2(tl1[kg + 6][sn], tl1[kg + 7][sn]);
          const int h = c1.n0 + sn;
          const int dr = c1.mm == 0 ? h : ((h >> 3) * 16 + (h & 7) + (c1.mm == 2 ? 8 : 0));
          *(uint4*)&c1.dst[(size_t)dr * c1.ldk + c1.k0 + kg] = o;
        }
        __syncthreads();
      }
    }
  }
  grid.sync();
  {
    {
      const float* x = P.in[0]; const float* ctx = P.in[2];
      const float* PE = (const float*)(ws + W_PE);
      for (int idx = gtid; idx < T_ALL * 256; idx += gstride) {
        const int t = idx >> 8, n = (idx & 255) * 4;
        float4 o;
        if (t < T_CTX) o = *(const float4*)&ctx[(size_t)t * DM + n];
        else {
          const int tl = t - T_CTX, qd = n >> 8, j = n & 255;
          o = *(const float4*)&x[(size_t)tl * DM + n];
          const float* pp = (qd < 2) ? PE + qd * 65536 + (tl >> 6) * 256 + j : PE + 131072 + (qd - 2) * 16384 + (tl & 63) * 256 + j;
          const float4 pe = *(const float4*)pp;
          o.x += pe.x; o.y += pe.y; o.z += pe.z; o.w += pe.w;
        }
        *(float4*)&tok[(size_t)t * DM + n] = o;
      }
    }
    const float* modp = (const float*)(ws + WS_MODP);
    const float* adab = P.in[5];
    for (int idx = gtid; idx < 8 * 6144; idx += gstride) {
      const int is = idx / 6144, j = idx - is * 6144, i = is >> 1;
      float a = adab[i * 6144 + j];
      for (int ks = 0; ks < 16; ++ks) a += modp[(size_t)(ks * 8 + is) * 6144 + j];
      mod[idx] = a;
    }
    {
      const bf16_t* DC = (const bf16_t*)(ws + W_DC);
      const bf16_t* WI = (const bf16_t*)(ws + W_FNIN);
      bf16_t* WP = (bf16_t*)(ws + W_FNP);
      gemm_loop<4, true>(shm, 4, vb, 64, G,
        [=](int L, int r) { const int tm = L >> 2; return DC + (size_t)((tm >> 3) * 256 + (tm & 1) * 128 + r) * 256; },
        [=](int L, int cidx) { const int tm = L >> 2; return WI + (size_t)((L & 3) * 256 + cidx) * 1024 + ((tm >> 1) & 3) * 256; }, KOffL(), KOffL(),
        per_m([=](int L, int row, int col0, const f32x4 (&a)[4]) { st16bf(WP + (size_t)((L >> 2) * 128 + row) * 1024 + (L & 3) * 256 + col0, a); }));
    }
  }
  xcd_barrier(xbar);

#define MODV(i, s, j, n) mod[(size_t)(((i) * 2 + (s)) * 6 + (j)) * 1024 + (n)]

  auto resid_epi = [=](int layer, int grow, int gcol0, const f32x4 (&a)[4]) {
    const int s = grow < T_CTX ? 1 : 0;
    const float* gate = &MODV(layer, s, 2, gcol0);
    float* p = tok + (size_t)grow * DM + gcol0;
#pragma unroll
    for (int n = 0; n < 4; ++n) {
      float4 t4 = *(float4*)(p + n * 4);
      const float4 g4 = *(const float4*)(gate + n * 4);
      t4.x += g4.x * a[n][0]; t4.y += g4.y * a[n][1]; t4.z += g4.z * a[n][2]; t4.w += g4.w * a[n][3];
      *(float4*)(p + n * 4) = t4;
    }
  };

  auto moe_layer = [&](int layer, int t0) __attribute__((always_inline)) {
    ffn_norm_router_phase(P, t0, layer, smem);
    xcd_barrier(xbar);
    int* cnt = (int*)(ws + WS_CNT) + layer * 32 * 32;
    int* list = (int*)(ws + WS_LIST);
    float* asgw = (float*)(ws + WS_ASGW);
    int* ps = (int*)(shm + GEMM_LDS_TOTAL + 64);
    if (tid == 0) {
      int s = 0;
      for (int e = 0; e < 32; ++e) { ps[e] = s; s += (cnt[e * 32] + 127) / 128 * 128; }
      ps[32] = s;
    }
    __syncthreads();
    const int total = ps[32];
    bf16_t* HB = (bf16_t*)(R + R_HB);
    bf16_t* ybuf = (bf16_t*)(R + R_YBUF);
    const bf16_t* WGU = (const bf16_t*)(ws + W_EGU) + (size_t)layer * 32 * 1024 * 1024;
    const bf16_t* WD = (const bf16_t*)(ws + W_ED) + (size_t)layer * 32 * 1024 * 512;
    const int ntile = (total >> 7) * 4;
    auto blk_e = [=](int mb) { int e = 0; for (int q = 1; q < 32; ++q) if (ps[q] <= mb * 128) e = q; return e; };
    {
      gemm_loop<4, true>(shm, 16, vb, ntile, G,
        [=](int L, int r) { const int mb = L >> 2, e = blk_e(mb), rr = mb * 128 - ps[e] + r;
          return (rr < cnt[e * 32]) ? (const bf16_t*)(hb + (size_t)(list[(size_t)e * 33280 + rr] >> 1) * DM) : zrow; },
        [=](int L, int cidx) { const int e = blk_e(L >> 2); return WGU + (size_t)e * 1024 * 1024 + (size_t)((L & 3) * 256 + cidx) * 1024; },
        KOffL(), KOffL(),
        per_m([=](int L, int row, int col0, const f32x4 (&a)[4]) {
          const int n0 = (L & 3) * 256, m0 = (L >> 2) * 128;
          float hv[8];
#pragma unroll
          for (int j = 0; j < 8; ++j) { const float gv = a[j >> 2][j & 3], uv = a[2 + (j >> 2)][j & 3]; hv[j] = silu_f(gv) * uv; }
          uint4 o; o.x = pack2(hv[0], hv[1]); o.y = pack2(hv[2], hv[3]); o.z = pack2(hv[4], hv[5]); o.w = pack2(hv[6], hv[7]);
          *(uint4*)&HB[(size_t)(m0 + row) * 512 + ((n0 + col0) >> 1)] = o;
        }));
    }
    xcd_barrier(xbar);
    {
      gemm_loop<4, true>(shm, 8, vb, ntile, G,
        [=](int L, int r) { return (const bf16_t*)(HB + (size_t)((L >> 2) * 128 + r) * 512); },
        [=](int L, int cidx) { const int e = blk_e(L >> 2); return WD + (size_t)e * 1024 * 512 + (size_t)((L & 3) * 256 + cidx) * 512; },
        KOffL(), KOffL(),
        per_m([=](int L, int row, int col0, const f32x4 (&a)[4]) {
          const int mb = L >> 2, n0 = (L & 3) * 256, e = blk_e(mb), rr = mb * 128 - ps[e] + row;
          if (rr < cnt[e * 32]) {
            const int rt = list[(size_t)e * 33280 + rr];
            const float w = asgw[rt];
            f32x4 bq[4];
#pragma unroll
            for (int n = 0; n < 4; ++n) bq[n] = a[n] * w;
            st16bf(ybuf + (size_t)rt * 1024 + n0 + col0, bq);
          }
        }));
    }
    xcd_barrier(xbar);
  };

  {
    norm_phase(P, 0, P.in[6] + 0 * 1024, 0, 0, -1, 0, false, false, 0, smem);
    xcd_barrier(xbar);
    bf16_t* zu = (bf16_t*)(R + R0_ZU); bf16_t* zvT = (bf16_t*)(R + R0_ZVT); bf16_t* pb = (bf16_t*)(R + R0_P);
    bf16_t* Wsc = (bf16_t*)(R + R0_WSC);
    const float* vg = P.in[17]; const float* w_s = P.in[18]; const float* b_s = P.in[19];
    const bf16_t* Wt = (const bf16_t*)(ws + W_CMIN);
    {
      auto epi_u = [=](int grow, int gcol0, const f32x4 (&a)[4]) {
        f32x4 bq[4];
#pragma unroll
        for (int n = 0; n < 4; ++n)
#pragma unroll
          for (int j = 0; j < 4; ++j) bq[n][j] = gelu_f(a[n][j]);
        st16bf(zu + (size_t)grow * 1024 + gcol0, bq);
      };
      auto epi_v = [=](int grow0, int gcol, f32x4 v) {
        uint2 o; o.x = pack2(gelu_f(v[0]), gelu_f(v[1])); o.y = pack2(gelu_f(v[2]), gelu_f(v[3]));
        *(uint2*)&zvT[((size_t)(grow0 >> 7) * 1024 + (gcol - 1024)) * 128 + (grow0 & 127)] = o;
      };
      gemm_loop<8, true>(shm, 16, vb, 256, G,
        [=](int L, int r) { return (const bf16_t*)(hb + (size_t)((1 + (L >> 2)) * 256 + r) * DM); },
        [=](int L, int cidx) { return Wt + (size_t)((L & 3) * 256 + cidx) * 1024; }, KOffL(), KOffL(),
        per_m([=](int L, int row, int col0, const f32x4 (&a)[4]) { epi_u((1 + (L >> 2)) * 256 + row, (L & 3) * 256 + col0, a); }));
      gemm_loop<8, false>(shm, 16, vb, 256, G,
        [=](int L, int r) { return (const bf16_t*)(hb + (size_t)((1 + (L >> 2)) * 256 + r) * DM); },
        [=](int L, int cidx) { return Wt + (size_t)((4 + (L & 3)) * 256 + cidx) * 1024; }, KOffL(), KOffL(),
        [=](int L, int row0, int col, f32x4 v) { epi_v((1 + (L >> 2)) * 256 + row0, (4 + (L & 3)) * 256 + col, v); });
      gemm_loop<2, true>(shm, 16, vb, 16, G,
        [=](int L, int r) { return (const bf16_t*)(hb + (size_t)((L >> 2) * 64 + r) * DM); },
        [=](int L, int cidx) { return Wt + (size_t)((L & 3) * 256 + cidx) * 1024; }, KOffL(), KOffL(),
        per_m([=](int L, int row, int col0, const f32x4 (&a)[4]) { epi_u((L >> 2) * 64 + row, (L & 3) * 256 + col0, a); }));
      gemm_loop<2, false>(shm, 16, (vb - 16 + G) % G, 16, G,
        [=](int L, int r) { return (const bf16_t*)(hb + (size_t)((L >> 2) * 64 + r) * DM); },
        [=](int L, int cidx) { return Wt + (size_t)((4 + (L & 3)) * 256 + cidx) * 1024; }, KOffL(), KOffL(),
        [=](int L, int row0, int col, f32x4 v) { epi_v((L >> 2) * 64 + row0, (4 + (L & 3)) * 256 + col, v); });
    }
    xcd_barrier(xbar);
    {
      float* s_part = smem;
      float* s_rv = smem + 4096;
      for (int n = blockIdx.x; n < NCH; n += G) {
        {
          const int tq = tid, cg = tq >> 4, sg = tq & 15;
          float ss8[8];
#pragma unroll
          for (int e = 0; e < 8; ++e) ss8[e] = 0.f;
          for (int it = 0; it < 32; it += 4) {
            uint4 z[4];
#pragma unroll
            for (int u = 0; u < 4; ++u) z[u] = *(const uint4*)&zvT[((size_t)n * 1024 + (it + u) * 32 + cg) * 128 + sg * 8];
#pragma unroll
            for (int u = 0; u < 4; ++u) {
              const unsigned zz[4] = {z[u].x, z[u].y, z[u].z, z[u].w};
#pragma unroll
              for (int e = 0; e < 4; ++e) { const float a = lo2f(zz[e]), b2 = hi2f(zz[e]); ss8[2 * e] += a * a; ss8[2 * e + 1] += b2 * b2; }
            }
          }
#pragma unroll
          for (int e = 0; e < 8; ++e) s_part[cg * 128 + sg * 8 + e] = ss8[e];
        }
        __syncthreads();
        if (tid < 128) {
          float a = 0.f;
          for (int q = 0; q < 32; ++q) a += s_part[q * 128 + tid];
          s_rv[tid] = 1.f / sqrtf(a * (1.f / 1024.f) + EPSN);
        }
        __syncthreads();
        for (int idx = tid; idx < 4 * 128 * 32; idx += NT) {
          const int s4 = (idx & 31) * 4, gt = idx >> 5;
          const float4 w4 = *(const float4*)&w_s[(size_t)gt * 128 + s4];
          uint2 o; o.x = pack2(w4.x * s_rv[s4], w4.y * s_rv[s4 + 1]); o.y = pack2(w4.z * s_rv[s4 + 2], w4.w * s_rv[s4 + 3]);
          *(uint2*)&Wsc[((size_t)n * 512 + gt) * 128 + s4] = o;
        }
        __syncthreads();
      }
    }
    xcd_barrier(xbar);
    {
      gemm_loop<4, true>(shm, 2, vb, NCH * 4, G,
        [=](int L, int r) { return (const bf16_t*)(Wsc + ((size_t)(L >> 2) * 512 + (L & 3) * 128 + r) * 128); },
        [=](int L, int cidx) { return (const bf16_t*)(zvT + ((size_t)(L >> 2) * 1024 + (L & 3) * 256 + cidx) * 128); },
        KOffL(), KOffL(),
        per_m([=](int L, int row, int col0, const f32x4 (&a)[4]) {
          const int n = L >> 2, g = L & 3;
          const int t = n * 128 + row, col = g * 256 + col0;
          const float bias = b_s[g * 128 + row];
          const uint4 u0 = *(const uint4*)&zu[(size_t)t * 1024 + col], u1 = *(const uint4*)&zu[(size_t)t * 1024 + col + 8];
          const unsigned uu[8] = {u0.x, u0.y, u0.z, u0.w, u1.x, u1.y, u1.z, u1.w};
          f32x4 o[4];
#pragma unroll
          for (int nn = 0; nn < 4; ++nn) {
            const float4 g4 = *(const float4*)&vg[col + nn * 4];
            o[nn][0] = lo2f(uu[nn * 2]) * (a[nn][0] * g4.x + bias);
            o[nn][1] = hi2f(uu[nn * 2]) * (a[nn][1] * g4.y + bias);
            o[nn][2] = lo2f(uu[nn * 2 + 1]) * (a[nn][2] * g4.z + bias);
            o[nn][3] = hi2f(uu[nn * 2 + 1]) * (a[nn][3] * g4.w + bias);
          }
          st16bf(pb + (size_t)t * 1024 + col, o);
        }));
    }
    xcd_barrier(xbar);
    const bf16_t* Wo = (const bf16_t*)(ws + W_CMOUT);
    auto epi_out = [=](int grow, int gcol0, const f32x4 (&a)[4]) { resid_epi(0, grow, gcol0, a); };
    dense_phase(shm, vb, G, pb, 1024, Wo, 1024, 4, 16, true, epi_out);
    xcd_barrier(xbar);
  }
  moe_layer(0, 0);

  {
    norm_phase(P, 0, P.in[6] + 1 * 1024, 1, 0, 0, 0, false, false, 0, smem);
    xcd_barrier(xbar);
    bf16_t* ZQK = (bf16_t*)(R + R1_ZQK); bf16_t* ZO = (bf16_t*)(R + R1_ZO); bf16_t* VT = (bf16_t*)(R + R1_VT);
    float* gpre = (float*)(R + R1_GPRE); bf16_t* Qn = (bf16_t*)(R + R1_QN); bf16_t* Kn = (bf16_t*)(R + R1_KN);
    bf16_t* AS = (bf16_t*)(R + R1_AS); bf16_t* KwT = (bf16_t*)(R + R1_KWT);
    float* bc = (float*)(R + R1_BC); float* li = (float*)(R + R1_LI); float* egch = (float*)(R + R1_GCH);
    float* nloc = (float*)(R + R1_NLOC); float* nin = (float*)(R + R1_NIN);
    float* Cloc = (float*)(R + R1_CLOC); bf16_t* CinT = (bf16_t*)(R + R1_CINT); bf16_t* hnum = (bf16_t*)(R + R1_CLOC);
    bf16_t* A2 = (bf16_t*)(R + R1_A2);
    const float* w_in = P.in[21]; const float* cw = P.in[22]; const float* cb = P.in[23];
    const float* gb = P.in[24]; const float* ng = P.in[25];
    const bf16_t* Wt = (const bf16_t*)(ws + W_MLIN);
    {
      auto epi_nat = [=](int grow, int gcol0, const f32x4 (&a)[4]) {
        if (gcol0 < 1024) st16bf(ZQK + (size_t)grow * 1024 + gcol0, a); else st16bf(ZO + (size_t)grow * 1024 + gcol0 - 2048, a);
      };
      auto epi_vt = [=](int grow0, int gcol, f32x4 v) {
        uint2 o; o.x = pack2(v[0], v[1]); o.y = pack2(v[2], v[3]);
        *(uint2*)&VT[((size_t)(grow0 >> 7) * 1024 + (gcol - 1024)) * 128 + (grow0 & 127)] = o;
      };
      {
        float* wl = smem;
        const int tq = tid;
        for (int idx = tq; idx < 1024 * 4; idx += NT) {
          const int k = idx >> 2, q = idx & 3;
          const float4 w4 = *(const float4*)&w_in[(size_t)k * 3088 + 3072 + q * 4];
          const int rho = (((k >> 8) * 4 + (k & 3)) * 64) + ((k & 255) >> 2);
          *(float4*)&wl[rho * 16 + q * 4] = w4;
        }
        __syncthreads();
        const int lane = tq & 63;
        for (int t = blockIdx.x * (NT / 64) + (tq >> 6); t < T_ALL; t += G * (NT / 64)) {
          float hv[16];
#pragma unroll
          for (int j = 0; j < 4; ++j) {
            const uint2 z = *(const uint2*)&hb[(size_t)t * DM + j * 256 + lane * 4];
            hv[j * 4 + 0] = lo2f(z.x); hv[j * 4 + 1] = hi2f(z.x); hv[j * 4 + 2] = lo2f(z.y); hv[j * 4 + 3] = hi2f(z.y);
          }
          float a16[16];
#pragma unroll
          for (int j = 0; j < 16; ++j) a16[j] = 0.f;
#pragma unroll
          for (int i = 0; i < 16; ++i) {
            const float4* wr4 = (const float4*)(wl + (i * 64 + lane) * 16);
#pragma unroll
            for (int q = 0; q < 4; ++q) {
              const float4 w4 = wr4[q];
              a16[q * 4 + 0] += hv[i] * w4.x; a16[q * 4 + 1] += hv[i] * w4.y; a16[q * 4 + 2] += hv[i] * w4.z; a16[q * 4 + 3] += hv[i] * w4.w;
            }
            __builtin_amdgcn_sched_barrier(0);
          }
#pragma unroll
          for (int j = 0; j < 16; ++j) a16[j] = wave_sum(a16[j]);
          if (lane == 0) {
#pragma unroll
            for (int j = 0; j < 4; ++j) *(float4*)&gpre[(size_t)t * 16 + j * 4] = make_float4(a16[j * 4], a16[j * 4 + 1], a16[j * 4 + 2], a16[j * 4 + 3]);
          }
        }
        __syncthreads();
      }
      gemm_loop<8, true>(shm, 16, vb, 512, G,
        [=](int L, int r) { return (const bf16_t*)(hb + (size_t)((1 + (L >> 3)) * 256 + r) * DM); },
        [=](int L, int cidx) { const int j = L & 7, tn = j < 4 ? j : j + 4; return Wt + (size_t)(tn * 256 + cidx) * 1024; }, KOffL(), KOffL(),
        per_m([=](int L, int row, int col0, const f32x4 (&a)[4]) { const int j = L & 7, tn = j < 4 ? j : j + 4; epi_nat((1 + (L >> 3)) * 256 + row, tn * 256 + col0, a); }));
      gemm_loop<8, false>(shm, 16, vb, 256, G,
        [=](int L, int r) { return (const bf16_t*)(hb + (size_t)((1 + (L >> 2)) * 256 + r) * DM); },
        [=](int L, int cidx) { return Wt + (size_t)((4 + (L & 3)) * 256 + cidx) * 1024; }, KOffL(), KOffL(),
        [=](int L, int row0, int col, f32x4 v) { epi_vt((1 + (L >> 2)) * 256 + row0, (4 + (L & 3)) * 256 + col, v); });
      gemm_loop<2, true>(shm, 16, vb, 32, G,
        [=](int L, int r) { return (const bf16_t*)(hb + (size_t)((L >> 3) * 64 + r) * DM); },
        [=](int L, int cidx) { const int j = L & 7, tn = j < 4 ? j : j + 4; return Wt + (size_t)(tn * 256 + cidx) * 1024; }, KOffL(), KOffL(),
        per_m([=](int L, int row, int col0, const f32x4 (&a)[4]) { const int j = L & 7, tn = j < 4 ? j : j + 4; epi_nat((L >> 3) * 64 + row, tn * 256 + col0, a); }));
      gemm_loop<2, false>(shm, 16, (vb - 32 + G) % G, 16, G,
        [=](int L, int r) { return (const bf16_t*)(hb + (size_t)((L >> 2) * 64 + r) * DM); },
        [=](int L, int cidx) { return Wt + (size_t)((4 + (L & 3)) * 256 + cidx) * 1024; }, KOffL(), KOffL(),
        [=](int L, int row0, int col, f32x4 v) { epi_vt((L >> 2) * 64 + row0, (4 + (L & 3)) * 256 + col, v); });
    }
    xcd_barrier(xbar);
    {
      float* s_bc = smem;
      float* s_w  = smem + 1024;
      float* s_k  = smem + 2048;
      const int wv = tid >> 6, lane = tid & 63;
      for (int n = blockIdx.x; n < NCH; n += G) {
        {
          const int dh = wv, d = dh >> 2, hd = dh & 3;
          const int p0 = 2 * lane, p1 = p0 + 1;
          const int t0 = n * 128 + (d == 0 ? p0 : 127 - p0), t1 = n * 128 + (d == 0 ? p1 : 127 - p1);
          const float li0 = gpre[(size_t)t0 * 16 + d * 8 + hd] + gb[d * 8 + hd];
          const float li1 = gpre[(size_t)t1 * 16 + d * 8 + hd] + gb[d * 8 + hd];
          const float lf0 = logsig_f(gpre[(size_t)t0 * 16 + d * 8 + 4 + hd] + gb[d * 8 + 4 + hd]);
          const float lf1 = logsig_f(gpre[(size_t)t1 * 16 + d * 8 + 4 + hd] + gb[d * 8 + 4 + hd]);
          float run = lf0 + lf1;
#pragma unroll
          for (int o = 1; o < 64; o <<= 1) { const float y = __shfl_up(run, o); if (lane >= o) run += y; }
          const float b1 = run, b0 = run - lf1;
          const float g = __shfl(run, 63);
          bc[(size_t)dh * T_ALL + t0] = expf(b0); bc[(size_t)dh * T_ALL + t1] = expf(b1);
          li[(size_t)dh * T_ALL + t0] = expf(li0 - b0); li[(size_t)dh * T_ALL + t1] = expf(li1 - b1);
          s_bc[dh * 128 + (t0 & 127)] = b0; s_bc[dh * 128 + (t1 & 127)] = b1;
          s_w[dh * 128 + (t0 & 127)] = expf(g - b0 + li0); s_w[dh * 128 + (t1 & 127)] = expf(g - b1 + li1);
          if (lane == 0) egch[dh * NCH + n] = expf(g);
        }
        __syncthreads();
        const int lo = n < 2 ? 0 : T_CTX, hi = n < 2 ? T_CTX : T_ALL;
        for (int idx = tid; idx < 128 * 64; idx += NT) {
          const int tl = idx >> 6, c0 = (idx & 63) * 8, t = n * 128 + tl, hd = c0 >> 7;
          float q[8];
#pragma unroll
          for (int e = 0; e < 8; ++e) q[e] = cb[c0 + e];
#pragma unroll
          for (int j = 0; j < 4; ++j) {
            const int tt = t + j - 2;
            if (tt >= lo && tt < hi) {
              const uint4 z = *(const uint4*)&ZQK[(size_t)tt * 1024 + c0];
              const float4 w0 = *(const float4*)&cw[j * 1024 + c0], w1 = *(const float4*)&cw[j * 1024 + c0 + 4];
              q[0] += lo2f(z.x) * w0.x; q[1] += hi2f(z.x) * w0.y; q[2] += lo2f(z.y) * w0.z; q[3] += hi2f(z.y) * w0.w;
              q[4] += lo2f(z.z) * w1.x; q[5] += hi2f(z.z) * w1.y; q[6] += lo2f(z.w) * w1.z; q[7] += hi2f(z.w) * w1.w;
            }
          }
#pragma unroll
          for (int e = 0; e < 8; ++e) q[e] = silu_f(q[e]) * 0.08838834764831845f;
          uint4 o; o.x = pack2(q[0], q[1]); o.y = pack2(q[2], q[3]); o.z = pack2(q[4], q[5]); o.w = pack2(q[6], q[7]);
          *(uint4*)&Qn[(size_t)t * 512 + c0] = o;
#pragma unroll
          for (int d = 0; d < 2; ++d) {
            const int dh = d * 4 + hd;
            const float eb = expf(s_bc[dh * 128 + tl]);
            uint4 o2; o2.x = pack2(q[0] * eb, q[1] * eb); o2.y = pack2(q[2] * eb, q[3] * eb); o2.z = pack2(q[4] * eb, q[5] * eb); o2.w = pack2(q[6] * eb, q[7] * eb);
            *(uint4*)&AS[((size_t)dh * T_ALL + t) * 256 + 128 + (c0 & 127)] = o2;
          }
        }
        for (int hd = 0; hd < 4; ++hd) {
          for (int idx = tid; idx < 128 * 16; idx += NT) {
            const int tl = idx >> 4, k0 = (idx & 15) * 8, t = n * 128 + tl, c0 = 512 + hd * 128 + k0;
            float q[8];
#pragma unroll
            for (int e = 0; e < 8; ++e) q[e] = cb[c0 + e];
#pragma unroll
            for (int j = 0; j < 4; ++j) {
              const int tt = t + j - 2;
              if (tt >= lo && tt < hi) {
                const uint4 z = *(const uint4*)&ZQK[(size_t)tt * 1024 + c0];
                const float4 w0 = *(const float4*)&cw[j * 1024 + c0], w1 = *(const float4*)&cw[j * 1024 + c0 + 4];
                q[0] += lo2f(z.x) * w0.x; q[1] += hi2f(z.x) * w0.y; q[2] += lo2f(z.y) * w0.z; q[3] += hi2f(z.y) * w0.w;
                q[4] += lo2f(z.z) * w1.x; q[5] += hi2f(z.z) * w1.y; q[6] += lo2f(z.w) * w1.z; q[7] += hi2f(z.w) * w1.w;
              }
            }
#pragma unroll
            for (int e = 0; e < 8; ++e) { q[e] = silu_f(q[e]); s_k[tl * 129 + k0 + e] = q[e]; }
            uint4 o; o.x = pack2(q[0], q[1]); o.y = pack2(q[2], q[3]); o.z = pack2(q[4], q[5]); o.w = pack2(q[6], q[7]);
            *(uint4*)&Kn[(size_t)t * 512 + hd * 128 + k0] = o;
          }
          __syncthreads();
          for (int idx = tid; idx < 2 * 128 * 16; idx += NT) {
            const int d = idx >> 11, rem = idx & 2047, kk = rem >> 4, s0 = (rem & 15) * 8, dh = d * 4 + hd;
            float v8[8];
#pragma unroll
            for (int e = 0; e < 8; ++e) v8[e] = s_w[dh * 128 + s0 + e] * s_k[(s0 + e) * 129 + kk];
            uint4 o; o.x = pack2(v8[0], v8[1]); o.y = pack2(v8[2], v8[3]); o.z = pack2(v8[4], v8[5]); o.w = pack2(v8[6], v8[7]);
            *(uint4*)&KwT[((size_t)dh * T_ALL + n * 128 + kk) * 128 + s0] = o;
          }
          if (tid < 256) {
            const int d = tid >> 7, kk = tid & 127, dh = d * 4 + hd;
            float a = 0.f;
            for (int s2 = 0; s2 < 128; ++s2) a += s_w[dh * 128 + s2] * s_k[s2 * 129 + kk];
            nloc[(dh * NCH + n) * 128 + kk] = a;
          }
          __syncthreads();
        }
      }
    }
    xcd_barrier(xbar);
    gemm_loop<4, false>(shm, 2, vb, 1040, G,
      [=](int L, int r) { const int dh = L / NCH, n = L - dh * NCH; return (const bf16_t*)(KwT + ((size_t)dh * T_ALL + n * 128 + r) * 128); },
      [=](int L, int cidx) { const int dh = L / NCH, n = L - dh * NCH, hd = dh & 3; return (const bf16_t*)(VT + ((size_t)n * 1024 + hd * 256 + cidx) * 128); },
      KOffL(), KOffL(),
      [=](int L, int row0, int col, f32x4 v) { *(float4*)&Cloc[(size_t)L * 32768 + (size_t)col * 128 + row0] = make_float4(v[0], v[1], v[2], v[3]); });
    gemm_loop<4, true>(shm, 2, (vb - 16 + G) % G, 520, G,
      [=](int L, int r) { const int hd = L / NCH, n = L - hd * NCH; return (const bf16_t*)(Qn + (size_t)(n * 128 + r) * 512 + hd * 128); },
      [=](int L, int cidx) { const int hd = L / NCH, n = L - hd * NCH; return cidx < 128 ? (const bf16_t*)(Kn + (size_t)(n * 128 + cidx) * 512 + hd * 128) : zrow; },
      KOffL(), KOffL(),
      per_m([=](int L, int row, int col0, const f32x4 (&a)[4]) {
        const int hd = L / NCH, n = L - hd * NCH;
        if (col0 < 128) {
          const int tt = n * 128 + row;
#pragma unroll
          for (int d = 0; d < 2; ++d) {
            const int dh = d * 4 + hd;
            const float bt = bc[(size_t)dh * T_ALL + tt];
            const float* cf = li + (size_t)dh * T_ALL + n * 128 + col0;
            f32x4 o[4];
#pragma unroll
            for (int nn = 0; nn < 4; ++nn) {
              const float4 c4 = *(const float4*)(cf + nn * 4);
              const float cv[4] = {c4.x, c4.y, c4.z, c4.w};
#pragma unroll
              for (int j = 0; j < 4; ++j) {
                const int sc = col0 + nn * 4 + j;
                const bool ok = (d == 0) ? (sc <= row) : (sc >= row);
                o[nn][j] = ok ? a[nn][j] * bt * cv[j] : 0.f;
              }
            }
            st16bf(AS + ((size_t)dh * T_ALL + tt) * 256 + col0, o);
          }
        }
      }));
    xcd_barrier(xbar);
    for (int idx = gtid; idx < 8 * (32768 + 128); idx += gstride) {
      const int dh = idx / 32896, e = idx - dh * 32896, d = dh >> 2;
      float st = 0.f;
      if (e < 32768) {
        for (int ib = 0; ib < NCH; ib += 10) {
          float xv[10], gv[10];
#pragma unroll
          for (int u = 0; u < 10; ++u) { const int n = scan_order(d, ib + u); xv[u] = Cloc[(size_t)(dh * NCH + n) * 32768 + e]; gv[u] = egch[dh * NCH + n]; }
#pragma unroll
          for (int u = 0; u < 10; ++u) { const int n = scan_order(d, ib + u); CinT[(size_t)(dh * NCH + n) * 32768 + e] = f2bf(st); st = gv[u] * st + xv[u]; }
        }
      } else {
        const int kk = e - 32768;
        for (int ib = 0; ib < NCH; ib += 10) {
          float xv[10], gv[10];
#pragma unroll
          for (int u = 0; u < 10; ++u) { const int n = scan_order(d, ib + u); xv[u] = nloc[(dh * NCH + n) * 128 + kk]; gv[u] = egch[dh * NCH + n]; }
#pragma unroll
          for (int u = 0; u < 10; ++u) { const int n = scan_order(d, ib + u); nin[(dh * NCH + n) * 128 + kk] = st; st = gv[u] * st + xv[u]; }
        }
      }
    }
    xcd_barrier(xbar);
    gemm_loop<4, true>(shm, 4, vb, 1040, G,
      [=](int L, int r) { const int dh = L / NCH, n = L - dh * NCH; return (const bf16_t*)(AS + ((size_t)dh * T_ALL + n * 128 + r) * 256); },
      [=](int L, int cidx) { const int dh = L / NCH, n = L - dh * NCH, hd = dh & 3; return (const bf16_t*)(VT + ((size_t)n * 1024 + hd * 256 + cidx) * 128); },
      KOffL(),
      [=](int L, int kt) { const int dh = L / NCH, n = L - dh * NCH, hd = dh & 3;
        const int delta = (int)((CinT + (size_t)L * 32768) - (VT + ((size_t)n * 1024 + hd * 256) * 128));
        return kt < 2 ? kt * 64 : delta + (kt - 2) * 64; },
      per_m([=](int L, int row, int col0, const f32x4 (&a)[4]) {
        const int dh = L / NCH, n = L - dh * NCH;
        st16bf(hnum + ((size_t)dh * T_ALL + n * 128 + row) * 256 + col0, a);
      }));
    xcd_barrier(xbar);
    {
      const int tq = tid, lane = tq & 63, hd = lane >> 4, l16 = lane & 15;
      for (int tt = blockIdx.x * (NT / 64) + (tq >> 6); tt < T_ALL; tt += G * (NT / 64)) {
        const int n = tt >> 7;
        float hs[16];
#pragma unroll
        for (int e = 0; e < 16; ++e) hs[e] = 0.f;
#pragma unroll
        for (int d = 0; d < 2; ++d) {
          const int dh = d * 4 + hd;
          const size_t m = (size_t)dh * T_ALL + tt;
          const uint4 a0 = *(const uint4*)&AS[m * 256 + l16 * 16], a1 = *(const uint4*)&AS[m * 256 + l16 * 16 + 8];
          const uint4 x0 = *(const uint4*)&hnum[m * 256 + l16 * 16], x1 = *(const uint4*)&hnum[m * 256 + l16 * 16 + 8];
          const unsigned aa[8] = {a0.x, a0.y, a0.z, a0.w, a1.x, a1.y, a1.z, a1.w};
          float part = 0.f;
          if (l16 < 8) {
#pragma unroll
            for (int e = 0; e < 8; ++e) part += lo2f(aa[e]) + hi2f(aa[e]);
          } else {
            const float* np = nin + (dh * NCH + n) * 128 + (l16 - 8) * 16;
#pragma unroll
            for (int e = 0; e < 4; ++e) {
              const float4 nv = *(const float4*)(np + e * 4);
              part += lo2f(aa[2 * e]) * nv.x + hi2f(aa[2 * e]) * nv.y + lo2f(aa[2 * e + 1]) * nv.z + hi2f(aa[2 * e + 1]) * nv.w;
            }
          }
          part += __shfl_xor(part, 8); part += __shfl_xor(part, 4); part += __shfl_xor(part, 2); part += __shfl_xor(part, 1);
          const float dn = 1.f / fmaxf(fabsf(part), 1.f);
          const unsigned xx[8] = {x0.x, x0.y, x0.z, x0.w, x1.x, x1.y, x1.z, x1.w};
#pragma unroll
          for (int e = 0; e < 8; ++e) { hs[2 * e] += lo2f(xx[e]) * dn; hs[2 * e + 1] += hi2f(xx[e]) * dn; }
        }
        float ss = 0.f;
#pragma unroll
        for (int e = 0; e < 16; ++e) ss += hs[e] * hs[e];
        ss += __shfl_xor(ss, 8); ss += __shfl_xor(ss, 4); ss += __shfl_xor(ss, 2); ss += __shfl_xor(ss, 1);
        const float r = 1.f / sqrtf(ss * (1.f / 256.f) + EPSN);
        const int col = hd * 256 + l16 * 16;
        const uint4 o0 = *(const uint4*)&ZO[(size_t)tt * 1024 + col], o1 = *(const uint4*)&ZO[(size_t)tt * 1024 + col + 8];
        const unsigned oo[8] = {o0.x, o0.y, o0.z, o0.w, o1.x, o1.y, o1.z, o1.w};
        unsigned res[8];
#pragma unroll
        for (int e = 0; e < 4; ++e) {
          const float4 g4 = *(const float4*)&ng[col + e * 4];
          res[2 * e]     = pack2(hs[4 * e + 0] * r * g4.x * sigmoid_f(lo2f(oo[2 * e])),     hs[4 * e + 1] * r * g4.y * sigmoid_f(hi2f(oo[2 * e])));
          res[2 * e + 1] = pack2(hs[4 * e + 2] * r * g4.z * sigmoid_f(lo2f(oo[2 * e + 1])), hs[4 * e + 3] * r * g4.w * sigmoid_f(hi2f(oo[2 * e + 1])));
        }
        *(uint4*)&A2[(size_t)tt * 1024 + col] = make_uint4(res[0], res[1], res[2], res[3]);
        *(uint4*)&A2[(size_t)tt * 1024 + col + 8] = make_uint4(res[4], res[5], res[6], res[7]);
      }
    }
    xcd_barrier(xbar);
    const bf16_t* Wo = (const bf16_t*)(ws + W_MLOUT);
    auto epi_out = [=](int grow, int gcol0, const f32x4 (&a)[4]) { resid_epi(1, grow, gcol0, a); };
    dense_phase(shm, vb, G, A2, 1024, Wo, 1024, 4, 16, true, epi_out);
    xcd_barrier(xbar);
  }
  moe_layer(1, 0);

  {
    norm_phase(P, 0, P.in[6] + 2 * 1024, 2, 0, 1, 0, false, false, 0, smem);
    xcd_barrier(xbar);
    bf16_t* Zg = (bf16_t*)(R + R2_ZG); bf16_t* Zx = (bf16_t*)(R + R2_ZX); bf16_t* xc = (bf16_t*)(R + R2_XC);
    bf16_t* LA = (bf16_t*)(R + R2_LA); bf16_t* U = (bf16_t*)(R + R2_U);
    float* cA = (float*)(R + R2_CA); float* cH = (float*)(R + R2_CH);
    float* cin = (float*)(R + R2_CIN); bf16_t* A3 = (bf16_t*)(R + R2_ZX);
    const float* cw = P.in[28]; const float* cb = P.in[29];
    const float* b_a = P.in[31]; const float* b_x = P.in[33];
    const float* SP = (const float*)(ws + W_SP);
    const bf16_t* Wt = (const bf16_t*)(ws + W_LRUIN);
    auto epi_in = [=](int grow, int gcol0, const f32x4 (&a)[4]) {
      if (gcol0 < 1280) {
        f32x4 bq[4];
#pragma unroll
        for (int n = 0; n < 4; ++n)
#pragma unroll
          for (int j = 0; j < 4; ++j) bq[n][j] = gelu_f(a[n][j]);
        st16bf(Zg + (size_t)grow * 1280 + gcol0, bq);
      } else st16bf(Zx + (size_t)grow * 1280 + gcol0 - 1280, a);
    };
    dense_phase(shm, vb, G, hb, 1024, Wt, 1024, 10, 16, true, epi_in);
    xcd_barrier(xbar);
    for (int idx = gtid; idx < T_ALL * 160; idx += gstride) {
      const int t = idx / 160, c0 = (idx - t * 160) * 8;
      const int lo = t < T_CTX ? 0 : T_CTX, hi = t < T_CTX ? T_CTX : T_ALL;
      float q[8];
#pragma unroll
      for (int e = 0; e < 8; ++e) q[e] = cb[c0 + e];
#pragma unroll
      for (int j = 0; j < 4; ++j) {
        const int tt = t + j - 2;
        if (tt >= lo && tt < hi) {
          const uint4 z = *(const uint4*)&Zx[(size_t)tt * 1280 + c0];
          const float4 w0 = *(const float4*)&cw[j * 1280 + c0], w1 = *(const float4*)&cw[j * 1280 + c0 + 4];
          q[0] += lo2f(z.x) * w0.x; q[1] += hi2f(z.x) * w0.y; q[2] += lo2f(z.y) * w0.z; q[3] += hi2f(z.y) * w0.w;
          q[4] += lo2f(z.z) * w1.x; q[5] += hi2f(z.z) * w1.y; q[6] += lo2f(z.w) * w1.z; q[7] += hi2f(z.w) * w1.w;
        }
      }
      uint4 o; o.x = pack2(q[0], q[1]); o.y = pack2(q[2], q[3]); o.z = pack2(q[4], q[5]); o.w = pack2(q[6], q[7]);
      *(uint4*)&xc[(size_t)t * 1280 + c0] = o;
    }
    xcd_barrier(xbar);
    {
      const bf16_t* WLG = (const bf16_t*)(ws + W_LRUG);
      {
        gemm_loop<8, true>(shm, 2, vb, 65 * 20, G,
          [=](int L, int r) { return (const bf16_t*)(xc + (size_t)((L / 20) * 256 + r) * 1280 + ((L % 20) >> 1) * 128); },
          [=](int L, int cidx) { return WLG + ((size_t)(L % 20) * 256 + cidx) * 128; },
          KOffL(), KOffL(),
          [=](int L, int rb, int col0, const f32x4 (&a)[8][4]) {
            const int m0 = (L / 20) * 256, q = L % 20, nb = q >> 1, d = q & 1;
            const int c = nb * 128 + (col0 >> 1);
            float ba[8], bx[8], sp8[8];
            {
              const float4 t0 = *(const float4*)&b_a[d * 1280 + c], t1 = *(const float4*)&b_a[d * 1280 + c + 4];
              const float4 t2 = *(const float4*)&b_x[d * 1280 + c], t3 = *(const float4*)&b_x[d * 1280 + c + 4];
              const float4 t4 = *(const float4*)&SP[d * 1280 + c], t5 = *(const float4*)&SP[d * 1280 + c + 4];
              ba[0] = t0.x; ba[1] = t0.y; ba[2] = t0.z; ba[3] = t0.w; ba[4] = t1.x; ba[5] = t1.y; ba[6] = t1.z; ba[7] = t1.w;
              bx[0] = t2.x; bx[1] = t2.y; bx[2] = t2.z; bx[3] = t2.w; bx[4] = t3.x; bx[5] = t3.y; bx[6] = t3.z; bx[7] = t3.w;
              sp8[0] = -8.f * t4.x; sp8[1] = -8.f * t4.y; sp8[2] = -8.f * t4.z; sp8[3] = -8.f * t4.w;
              sp8[4] = -8.f * t5.x; sp8[5] = -8.f * t5.y; sp8[6] = -8.f * t5.z; sp8[7] = -8.f * t5.w;
            }
#pragma unroll
            for (int m = 0; m < 8; ++m) {
              const int t = m0 + rb + 16 * m;
              const uint4 xv = *(const uint4*)&xc[(size_t)t * 1280 + c];
              const unsigned xx[4] = {xv.x, xv.y, xv.z, xv.w};
              float la8[8], u8[8];
#pragma unroll
              for (int e = 0; e < 8; ++e) {
                const float ra = a[m][e >> 2][e & 3] + ba[e];
                const float rx = a[m][2 + (e >> 2)][e & 3] + bx[e];
                const float la = sigmoid_f(ra) * sp8[e];
                const float x2 = 2.f * la;
                const float em = -x2 * (1.f + x2 * (0.5f + x2 * (0.16666667f + x2 * (0.041666668f + x2 * (0.0083333338f + x2 * 0.0013888889f)))));
                const float xe = (e & 1) ? hi2f(xx[e >> 1]) : lo2f(xx[e >> 1]);
                la8[e] = la;
                u8[e] = __builtin_amdgcn_sqrtf(em) * (sigmoid_f(rx) * xe);
              }
              uint4 o1, o2;
              o1.x = pack2(la8[0], la8[1]); o1.y = pack2(la8[2], la8[3]); o1.z = pack2(la8[4], la8[5]); o1.w = pack2(la8[6], la8[7]);
              o2.x = pack2(u8[0], u8[1]); o2.y = pack2(u8[2], u8[3]); o2.z = pack2(u8[4], u8[5]); o2.w = pack2(u8[6], u8[7]);
              *(uint4*)&LA[((size_t)d * T_ALL + t) * 1280 + c] = o1;
              *(uint4*)&U[((size_t)d * T_ALL + t) * 1280 + c] = o2;
            }
          });
      }
    }
    xcd_barrier(xbar);
    for (int idx = gtid; idx < 2 * NCH * 320; idx += gstride) {
      const int c = (idx % 320) * 4, dn = idx / 320, n = dn % NCH, d = dn / NCH;
      const bf16_t* la_p = LA + (size_t)d * T_ALL * 1280 + c;
      const bf16_t* u_p = U + (size_t)d * T_ALL * 1280 + c;
      float h[4] = {0.f, 0.f, 0.f, 0.f}, sl[4] = {0.f, 0.f, 0.f, 0.f};
      for (int sb = 0; sb < 128; sb += 8) {
        uint2 lv[8], uv[8];
#pragma unroll
        for (int e = 0; e < 8; ++e) {
          const size_t o = (size_t)(n * 128 + (d == 0 ? sb + e : 127 - sb - e)) * 1280;
          lv[e] = *(const uint2*)(la_p + o); uv[e] = *(const uint2*)(u_p + o);
        }
#pragma unroll
        for (int e = 0; e < 8; ++e) {
          const float l0 = lo2f(lv[e].x), l1 = hi2f(lv[e].x), l2 = lo2f(lv[e].y), l3 = hi2f(lv[e].y);
          h[0] = __expf(l0) * h[0] + lo2f(uv[e].x); h[1] = __expf(l1) * h[1] + hi2f(uv[e].x);
          h[2] = __expf(l2) * h[2] + lo2f(uv[e].y); h[3] = __expf(l3) * h[3] + hi2f(uv[e].y);
          sl[0] += l0; sl[1] += l1; sl[2] += l2; sl[3] += l3;
        }
      }
      *(float4*)&cA[(d * NCH + n) * 1280 + c] = make_float4(__expf(sl[0]), __expf(sl[1]), __expf(sl[2]), __expf(sl[3]));
      *(float4*)&cH[(d * NCH + n) * 1280 + c] = make_float4(h[0], h[1], h[2], h[3]);
    }
    xcd_barrier(xbar);
    for (int idx = gtid; idx < 2 * 1280; idx += gstride) {
      const int d = idx / 1280, c = idx - d * 1280;
      float st = 0.f;
      for (int ib = 0; ib < NCH; ib += 10) {
        float av[10], hv[10];
#pragma unroll
        for (int u = 0; u < 10; ++u) { const int q = (d * NCH + scan_order(d, ib + u)) * 1280 + c; av[u] = cA[q]; hv[u] = cH[q]; }
#pragma unroll
        for (int u = 0; u < 10; ++u) { const int q = (d * NCH + scan_order(d, ib + u)) * 1280 + c; cin[q] = st; st = av[u] * st + hv[u]; }
      }
    }
    xcd_barrier(xbar);
    for (int idx = gtid; idx < 128 * 320; idx += gstride) {
      const int c = (idx % 320) * 4, n = 2 + idx / 320;
      float h[4];
      { const float4 c4 = *(const float4*)&cin[(0 * NCH + n) * 1280 + c]; h[0] = c4.x; h[1] = c4.y; h[2] = c4.z; h[3] = c4.w; }
      for (int sb = 0; sb < 128; sb += 8) {
        uint2 lv[8], uv[8];
#pragma unroll
        for (int e = 0; e < 8; ++e) { const size_t o = (size_t)(n * 128 + sb + e) * 1280 + c; lv[e] = *(const uint2*)&LA[o]; uv[e] = *(const uint2*)&U[o]; }
#pragma unroll
        for (int e = 0; e < 8; ++e) {
          h[0] = __expf(lo2f(lv[e].x)) * h[0] + lo2f(uv[e].x); h[1] = __expf(hi2f(lv[e].x)) * h[1] + hi2f(uv[e].x);
          h[2] = __expf(lo2f(lv[e].y)) * h[2] + lo2f(uv[e].y); h[3] = __expf(hi2f(lv[e].y)) * h[3] + hi2f(uv[e].y);
          uint2 o2; o2.x = pack2(h[0], h[1]); o2.y = pack2(h[2], h[3]);
          *(uint2*)&A3[(size_t)(n * 128 + sb + e) * 1280 + c] = o2;
        }
      }
      { const float4 c4 = *(const float4*)&cin[(1 * NCH + n) * 1280 + c]; h[0] = c4.x; h[1] = c4.y; h[2] = c4.z; h[3] = c4.w; }
      for (int sb = 0; sb < 128; sb += 8) {
        uint2 lv[8], uv[8], gv[8], h0[8];
#pragma unroll
        for (int e = 0; e < 8; ++e) {
          const size_t o = (size_t)(n * 128 + 127 - sb - e) * 1280 + c;
          lv[e] = *(const uint2*)&LA[(size_t)T_ALL * 1280 + o]; uv[e] = *(const uint2*)&U[(size_t)T_ALL * 1280 + o];
          gv[e] = *(const uint2*)&Zg[o]; h0[e] = *(const uint2*)&A3[o];
        }
#pragma unroll
        for (int e = 0; e < 8; ++e) {
          h[0] = __expf(lo2f(lv[e].x)) * h[0] + lo2f(uv[e].x); h[1] = __expf(hi2f(lv[e].x)) * h[1] + hi2f(uv[e].x);
          h[2] = __expf(lo2f(lv[e].y)) * h[2] + lo2f(uv[e].y); h[3] = __expf(hi2f(lv[e].y)) * h[3] + hi2f(uv[e].y);
          uint2 o2;
          o2.x = pack2(lo2f(gv[e].x) * (lo2f(h0[e].x) + h[0]), hi2f(gv[e].x) * (hi2f(h0[e].x) + h[1]));
          o2.y = pack2(lo2f(gv[e].y) * (lo2f(h0[e].y) + h[2]), hi2f(gv[e].y) * (hi2f(h0[e].y) + h[3]));
          *(uint2*)&A3[(size_t)(n * 128 + 127 - sb - e) * 1280 + c] = o2;
        }
      }
    }
    xcd_barrier(xbar);
    const bf16_t* Wo = (const bf16_t*)(ws + W_LRUOUT);
    auto epi_out = [=](int grow, int gcol0, const f32x4 (&a)[4]) { resid_epi(2, grow, gcol0, a); };
    dense_phase(shm, vb, G, A3, 1280, Wo, 1280, 4, 20, false, epi_out);
    xcd_barrier(xbar);
  }
  moe_layer(2, T_CTX);

  {
    norm_phase(P, T_CTX, P.in[6] + 3 * 1024, 3, 0, 2, T_CTX, false, false, 0, smem);
    xcd_barrier(xbar);
    bf16_t* YT = (bf16_t*)(R + R3_YT); bf16_t* GT = (bf16_t*)(R + R3_GT); bf16_t* Ff = (bf16_t*)(R + R3_FF);
    const bf16_t* WP = (const bf16_t*)(ws + W_FNP);
    gemm_loop<8, false>(shm, 16, vb, 64 * 8, G,
      [=](int L, int r) { return (const bf16_t*)(hb + (size_t)(T_CTX + 128 * (r & 127) + 2 * (L >> 3) + (r >> 7)) * DM); },
      [=](int L, int cidx) { return WP + (size_t)((L & 7) * 256 + cidx) * 1024; }, KOffL(), KOffL(),
      [=](int L, int row0, int col, f32x4 v) {
        const int b = 2 * (L >> 3) + (row0 >> 7), a0 = row0 & 127, n0 = (L & 7) * 256;
        uint2 o; o.x = pack2(v[0], v[1]); o.y = pack2(v[2], v[3]);
        *(uint2*)&YT[((size_t)b * 2048 + n0 + col) * 128 + a0] = o;
      });
    xcd_barrier(xbar);
    {
      const bf16_t* DA = (const bf16_t*)(ws + W_DA);
      gemm_loop<4, false>(shm, 4, vb, 1024, G,
        [=](int L, int r) { return (const bf16_t*)(YT + ((size_t)r * 2048 + L) * 128); },
        [=](int L, int cidx) { return DA + (size_t)cidx * 256; },
        [=](int L, int kt) { return kt < 2 ? kt * 64 : 1024 * 128 + (kt - 2) * 64; }, KOffL(),
        [=](int L, int row0, int col, f32x4 v) {
          const int ri = col >> 7, c2 = col & 127;
          uint2 o; o.x = pack2(v[0], v[1]); o.y = pack2(v[2], v[3]);
          *(uint2*)&GT[(((size_t)c2 * 1024 + L) * 2 + ri) * 128 + row0] = o;
        });
    }
    xcd_barrier(xbar);
    {
      const bf16_t* TW = (const bf16_t*)(ws + W_TW);
      gemm_loop<4, true>(shm, 4, vb, 128 * 4, G,
        [=](int L, int r) { return TW + ((size_t)(L >> 2) * 128 + r) * 256; },
        [=](int L, int cidx) { return (const bf16_t*)(GT + ((size_t)(L >> 2) * 1024 + (L & 3) * 256 + cidx) * 256); }, KOffL(), KOffL(),
        per_m([=](int L, int row, int col0, const f32x4 (&a)[4]) {
          const int c2 = L >> 2, n0 = (L & 3) * 256;
          f32x4 b[4];
#pragma unroll
          for (int n = 0; n < 4; ++n) b[n] = a[n] * (1.f / 2048.f);
          st16bf(Ff + (size_t)(c2 + 128 * row) * 1024 + n0 + col0, b);
        }));
    }
    xcd_barrier(xbar);
    const bf16_t* Wo = (const bf16_t*)(ws + W_FNOUT);
    const bf16_t* FfA = Ff - (size_t)T_CTX * 1024;
    auto epi_out = [=](int grow, int gcol0, const f32x4 (&a)[4]) { resid_epi(3, grow, gcol0, a); };
    dense_phase(shm, vb, G, FfA, 1024, Wo, 1024, 4, 16, false, epi_out);
    xcd_barrier(xbar);
  }
  moe_layer(3, T_CTX);

  norm_phase(P, T_CTX, P.in[8], 0, -1, 3, T_CTX, true, false, 0, smem);
}

#undef tid
#undef gtid
#undef gstride
extern "C" void kernel_launch(void* const* d_in, const int* in_sizes, int n_in, void* d_out, int out_size,
                              void* d_ws, size_t ws_size, hipStream_t stream) {
  static int grid_blocks = 0;
  if (!grid_blocks) {
    int dev = 0, cus = 0, per_cu = 0;
    (void)hipGetDevice(&dev);
    (void)hipDeviceGetAttribute(&cus, hipDeviceAttributeMultiprocessorCount, dev);
    (void)hipOccupancyMaxActiveBlocksPerMultiprocessor(&per_cu, mega, NT, 0);
    if (per_cu < 1) fprintf(stderr, "kernel_launch: occupancy query says %d blocks/CU\n", per_cu);
    grid_blocks = cus;
    if (ws_size < WS_NEED) fprintf(stderr, "kernel_launch: workspace too small: %zu < %zu\n", ws_size, (size_t)WS_NEED);
  }
  if (n_in != 38 || ws_size < WS_NEED) return;
  Params p{};
  for (int i = 0; i < 38; ++i) p.in[i] = (const float*)d_in[i];
  p.out = (float*)d_out;
  p.ws = (unsigned char*)d_ws;
  (void)hipMemsetAsync((char*)d_ws + WS_BAR, 0, 16384, stream);
  void* args[] = {&p};
  hipError_t e = hipLaunchCooperativeKernel((void*)mega, dim3(grid_blocks), dim3(NT), args, 0, stream);
  if (e != hipSuccess) fprintf(stderr, "cooperative launch failed: %s (grid %d)\n", hipGetErrorString(e), grid_blocks);
}
```

```cpp
#include <hip/hip_runtime.h>
#include <hip/hip_cooperative_groups.h>
#include <cstdio>
namespace cg = cooperative_groups;

#define T_ALL 16640
#define T_LAT 16384
#define T_CTX 256
#define DM 1024
#define NCH 130
#define EPSN 1e-6f
#define NT 512

typedef unsigned short bf16_t;
using bf16x8 = __attribute__((ext_vector_type(8))) short;
using f32x4 = __attribute__((ext_vector_type(4))) float;

__device__ __forceinline__ float bf2f(bf16_t v) { return __uint_as_float(((unsigned)v) << 16); }
__device__ __forceinline__ bf16_t f2bf(float f) { unsigned u = __float_as_uint(f); u += 0x7fffu + ((u >> 16) & 1u); return (bf16_t)(u >> 16); }
__device__ __forceinline__ unsigned pack2(float a, float b) { return (unsigned)f2bf(a) | (((unsigned)f2bf(b)) << 16); }
__device__ __forceinline__ float lo2f(unsigned u) { return __uint_as_float(u << 16); }
__device__ __forceinline__ float hi2f(unsigned u) { return __uint_as_float(u & 0xffff0000u); }

__device__ __forceinline__ int opaque_tid() { int t = threadIdx.x; asm volatile("" : "+v"(t)); return t; }

constexpr size_t AL(size_t x) { return (x + 255) & ~(size_t)255; }
constexpr size_t WS_MOD    = 0;
constexpr size_t WS_MODP   = AL(WS_MOD + 4 * 2 * 6144 * 4);
constexpr size_t WS_CNT    = AL(WS_MODP + 16 * 4 * 2 * 6144 * 4);
constexpr size_t WS_ZROW   = AL(WS_CNT + 4 * 32 * 32 * 4 + 256);
constexpr size_t WS_BAR    = AL(WS_ZROW + 8192);
constexpr size_t WS_TOK    = AL(WS_BAR + 16384);
constexpr size_t WS_H      = AL(WS_TOK + (size_t)T_ALL * DM * 4);
constexpr size_t WS_HLO    = AL(WS_H + (size_t)T_ALL * DM * 2);
constexpr size_t WS_ASGW   = AL(WS_HLO + (size_t)T_ALL * DM * 2);
constexpr size_t WS_LIST   = AL(WS_ASGW + 33280 * 4);
constexpr size_t WS_ROWTOK = AL(WS_LIST + (size_t)32 * 33280 * 4);
constexpr size_t WS_ROWEXP = AL(WS_ROWTOK + 37376 * 4);
constexpr size_t W_CMIN   = AL(WS_ROWEXP + 292 * 4);
constexpr size_t W_CMOUT  = AL(W_CMIN + (size_t)2048 * 1024 * 2);
constexpr size_t W_MLIN   = AL(W_CMOUT + (size_t)1024 * 1024 * 2);
constexpr size_t W_MLOUT  = AL(W_MLIN + (size_t)3072 * 1024 * 2);
constexpr size_t W_LRUIN  = AL(W_MLOUT + (size_t)1024 * 1024 * 2);
constexpr size_t W_LRUOUT = AL(W_LRUIN + (size_t)2560 * 1024 * 2);
constexpr size_t W_FNIN   = AL(W_LRUOUT + (size_t)1024 * 1280 * 2);
constexpr size_t W_FNP    = AL(W_FNIN + (size_t)1024 * 1024 * 2);
constexpr size_t W_FNOUT  = AL(W_FNP + (size_t)2048 * 1024 * 2);
constexpr size_t W_DC     = AL(W_FNOUT + (size_t)1024 * 1024 * 2);
constexpr size_t W_DA     = AL(W_DC + 512 * 256 * 2);
constexpr size_t W_TW     = AL(W_DA + 256 * 256 * 2);
constexpr size_t W_LRUG   = AL(W_TW + (size_t)128 * 128 * 256 * 2);
constexpr size_t W_SP     = AL(W_LRUG + (size_t)20 * 256 * 128 * 2);
constexpr size_t W_PE     = AL(W_SP + 2 * 1280 * 4);
constexpr size_t W_EGU    = AL(W_PE + (size_t)(2 * 256 + 2 * 64) * 256 * 4);
constexpr size_t W_ED     = AL(W_EGU + (size_t)128 * 1024 * 1024 * 2);
constexpr size_t WS_R     = AL(W_ED + (size_t)128 * 1024 * 512 * 2);
constexpr size_t R_YBUF = 0;
constexpr size_t R_HB   = AL(R_YBUF + (size_t)33280 * 1024 * 2);
constexpr size_t R_MOE_END = AL(R_HB + (size_t)37376 * 512 * 2);
constexpr size_t R0_ZU  = 0;
constexpr size_t R0_ZVT = AL(R0_ZU + (size_t)T_ALL * 1024 * 2);
constexpr size_t R0_P   = AL(R0_ZVT + (size_t)T_ALL * 1024 * 2);
constexpr size_t R0_WSC = AL(R0_P + (size_t)T_ALL * 1024 * 2);
constexpr size_t R0_END = AL(R0_WSC + (size_t)NCH * 4 * 128 * 128 * 2);
constexpr size_t R1_ZQK  = 0;
constexpr size_t R1_ZO   = AL(R1_ZQK + (size_t)T_ALL * 1024 * 2);
constexpr size_t R1_VT   = AL(R1_ZO + (size_t)T_ALL * 1024 * 2);
constexpr size_t R1_GPRE = AL(R1_VT + (size_t)T_ALL * 1024 * 2);
constexpr size_t R1_QN   = AL(R1_GPRE + (size_t)T_ALL * 16 * 4);
constexpr size_t R1_KN   = AL(R1_QN + (size_t)T_ALL * 512 * 2);
constexpr size_t R1_AS   = AL(R1_KN + (size_t)T_ALL * 512 * 2);
constexpr size_t R1_KWT  = AL(R1_AS + (size_t)8 * T_ALL * 256 * 2);
constexpr size_t R1_BC   = AL(R1_KWT + (size_t)8 * T_ALL * 128 * 2);
constexpr size_t R1_LI   = AL(R1_BC + (size_t)8 * T_ALL * 4);
constexpr size_t R1_GCH  = AL(R1_LI + (size_t)8 * T_ALL * 4);
constexpr size_t R1_NLOC = AL(R1_GCH + 8 * NCH * 4);
constexpr size_t R1_NIN  = AL(R1_NLOC + 8 * NCH * 128 * 4);
constexpr size_t R1_CLOC = AL(R1_NIN + 8 * NCH * 128 * 4);
constexpr size_t R1_CINT = AL(R1_CLOC + (size_t)8 * T_ALL * 256 * 4);
constexpr size_t R1_HDEN = AL(R1_CINT + (size_t)8 * T_ALL * 256 * 2);
constexpr size_t R1_A2   = AL(R1_HDEN + 256);
constexpr size_t R1_END  = AL(R1_A2 + (size_t)T_ALL * 1024 * 2);
constexpr size_t R2_ZG  = 0;
constexpr size_t R2_ZX  = AL(R2_ZG + (size_t)T_ALL * 1280 * 2);
constexpr size_t R2_XC  = AL(R2_ZX + (size_t)T_ALL * 1280 * 2);
constexpr size_t R2_LA  = AL(R2_XC + (size_t)T_ALL * 1280 * 2);
constexpr size_t R2_U   = AL(R2_LA + (size_t)2 * T_ALL * 1280 * 2);
constexpr size_t R2_CA  = AL(R2_U + (size_t)2 * T_ALL * 1280 * 2);
constexpr size_t R2_CH  = AL(R2_CA + 2 * NCH * 1280 * 4);
constexpr size_t R2_CIN = AL(R2_CH + 2 * NCH * 1280 * 4);
constexpr size_t R2_END = AL(R2_CIN + 2 * NCH * 1280 * 4);
constexpr size_t R3_YT = 0;
constexpr size_t R3_GT = AL(R3_YT + (size_t)128 * 2048 * 128 * 2);
constexpr size_t R3_FF = AL(R3_GT + (size_t)128 * 2048 * 128 * 2);
constexpr size_t R3_END = AL(R3_FF + (size_t)T_LAT * 1024 * 2);
constexpr size_t cmax(size_t a, size_t b) { return a > b ? a : b; }
constexpr size_t R_SIZE = cmax(cmax(R_MOE_END, R0_END), cmax(cmax(R1_END, R2_END), R3_END));
constexpr size_t WS_NEED = WS_R + R_SIZE;

struct Params { const float* in[38]; float* out; unsigned char* ws; };

__device__ __forceinline__ float sigmoid_f(float x) { return __frcp_rn(1.f + __expf(-x)); }
__device__ __forceinline__ float silu_f(float x) { return x * __frcp_rn(1.f + __expf(-x)); }
__device__ __forceinline__ float gelu_f(float x) {
  const float u2 = 1.5957691216057308f * (x + 0.044715f * x * x * x);
  return x * __frcp_rn(1.f + __expf(-u2));
}
__device__ __forceinline__ float logsig_f(float x) { return fminf(x, 0.f) - log1pf(expf(-fabsf(x))); }
__device__ __forceinline__ float wave_sum(float v) {
#pragma unroll
  for (int o = 32; o >= 1; o >>= 1) v += __shfl_xor(v, o);
  return v;
}
__device__ __forceinline__ int scan_order(int d, int i) { return d == 0 ? i : (i == 0 ? 1 : (i == 1 ? 0 : 131 - i)); }
__device__ __forceinline__ void st16bf(bf16_t* p, const f32x4 (&a)[4]) {
  uint4 o0, o1;
  o0.x = pack2(a[0][0], a[0][1]); o0.y = pack2(a[0][2], a[0][3]); o0.z = pack2(a[1][0], a[1][1]); o0.w = pack2(a[1][2], a[1][3]);
  o1.x = pack2(a[2][0], a[2][1]); o1.y = pack2(a[2][2], a[2][3]); o1.z = pack2(a[3][0], a[3][1]); o1.w = pack2(a[3][2], a[3][3]);
  *(uint4*)p = o0; *(uint4*)(p + 8) = o1;
}

__device__ __forceinline__ int lds_byte(int r, int c) {
  const int st = (r >> 4) * 2 + (c >> 5), ob = (r & 15) * 64 + (c & 31) * 2;
  return st * 1024 + (ob ^ (((ob >> 9) & 1) << 5));
}
__device__ __forceinline__ void stage_rc(int b, int& R, int& C) {
  const int st = b >> 10, sb = b & 1023, swz = sb ^ (((sb >> 9) & 1) << 5);
  R = (st >> 1) * 16 + (swz >> 6);
  C = (st & 1) * 32 + ((swz & 63) >> 1);
}
__device__ __forceinline__ int perm_col(int p) {
  const int q = p & 63, n = q >> 4, i = q & 15;
  return (p & ~63) + (i >> 2) * 16 + n * 4 + (i & 3);
}

struct KOffL { __device__ __forceinline__ int operator()(int, int kt) const { return kt * 64; } };
#define GEMM_LDS_TOTAL 147456
template <int MI, bool SWAP, class RA, class RB, class KA, class KB, class EP>
__device__ __forceinline__ void gemm_loop(char* shm, int nk, int Lbeg, int Lend, int Lstep, RA rowA, RB rowB, KA koffA, KB koffB, EP epi) {
  constexpr int BM = 32 * MI, GLA = MI / 2, GLB = 4;
  constexpr int TILE_A = BM * 128, TILE_B = 256 * 128, STG = TILE_A + TILE_B;
  constexpr int NBUF = (3 * STG <= GEMM_LDS_TOTAL) ? 3 : 2;
  static_assert(NBUF * STG <= GEMM_LDS_TOTAL, "LDS");
  if (Lbeg >= Lend) return;
  const int tid = opaque_tid(), wid = tid >> 6, lane = tid & 63, wr = wid >> 2, wc = wid & 3, fr = lane & 15, fq = lane >> 4;
  const bf16_t* pa[GLA];
  const bf16_t* pb[GLB];
#define GL_SETP(L_) do { int t2_ = tid; asm volatile("" : "+v"(t2_)); const int w2_ = t2_ >> 6, l2_ = t2_ & 63;        \
    _Pragma("unroll") for (int i = 0; i < GLA; ++i) { int R_, C_; stage_rc(w2_ * 1024 + i * 8192 + l2_ * 16, R_, C_); pa[i] = rowA((L_), R_) + C_; } \
    _Pragma("unroll") for (int i = 0; i < GLB; ++i) { int R_, C_; stage_rc(w2_ * 1024 + i * 8192 + l2_ * 16, R_, C_); pb[i] = rowB((L_), SWAP ? perm_col(R_) : R_) + C_; } } while (0)
#define GL_ISSUE(buf, kt, L_) do { const int ka_ = koffA((L_), (kt)), kb_ = koffB((L_), (kt)); char* base_ = shm + (buf) * STG;  \
    _Pragma("unroll") for (int i = 0; i < GLA; ++i)                                                                    \
      __builtin_amdgcn_global_load_lds((const unsigned*)(pa[i] + ka_), (unsigned*)(base_ + wid * 1024 + i * 8192), 16, 0, 0); \
    _Pragma("unroll") for (int i = 0; i < GLB; ++i)                                                                    \
      __builtin_amdgcn_global_load_lds((const unsigned*)(pb[i] + kb_), (unsigned*)(base_ + TILE_A + wid * 1024 + i * 8192), 16, 0, 0); } while (0)
#define GL_RAWBAR() do { asm volatile("s_waitcnt lgkmcnt(0)" ::: "memory"); __builtin_amdgcn_s_barrier(); } while (0)
  const int npre = nk < NBUF ? nk : NBUF;
  GL_SETP(Lbeg);
  for (int s = 0; s < npre; ++s) GL_ISSUE(s, s, Lbeg);
  for (int L = Lbeg; L < Lend; L += Lstep) {
    f32x4 acc[MI][4];
#pragma unroll
    for (int m = 0; m < MI; ++m)
#pragma unroll
      for (int n = 0; n < 4; ++n) acc[m][n] = f32x4{0.f, 0.f, 0.f, 0.f};
    int cur = 0;
    for (int t = 0; t < nk; ++t) {
      if (NBUF == 3 && t >= 1 && t + 1 < nk) {
        if (GLA + GLB == 6) asm volatile("s_waitcnt vmcnt(6)" ::: "memory"); else asm volatile("s_waitcnt vmcnt(5)" ::: "memory");
      } else asm volatile("s_waitcnt vmcnt(0)" ::: "memory");
      GL_RAWBAR();
      if (t >= 1 && t + NBUF - 1 < nk) { const int nb_ = (cur == 0) ? NBUF - 1 : cur - 1; GL_ISSUE(nb_, t + NBUF - 1, L); }
      const char* sa = shm + cur * STG;
      const char* sb = sa + TILE_A;
      const int offA = lds_byte(wr * (MI * 16) + fr, fq * 8), offB = lds_byte(wc * 64 + fr, fq * 8);
#pragma unroll
      for (int ks = 0; ks < 2; ++ks) {
        bf16x8 Bf[4];
#pragma unroll
        for (int n = 0; n < 4; ++n) Bf[n] = *(const bf16x8*)(sb + offB + n * 2048 + ks * 1024);
        constexpr int MG = MI < 4 ? MI : 4;
#pragma unroll
        for (int mh = 0; mh < MI; mh += MG) {
          bf16x8 At[MG];
#pragma unroll
          for (int m = 0; m < MG; ++m) At[m] = *(const bf16x8*)(sa + offA + (mh + m) * 2048 + ks * 1024);
#pragma unroll
          for (int m = 0; m < MG; ++m)
#pragma unroll
            for (int n = 0; n < 4; ++n) {
              if (SWAP) acc[mh + m][n] = __builtin_amdgcn_mfma_f32_16x16x32_bf16(Bf[n], At[m], acc[mh + m][n], 0, 0, 0);
              else      acc[mh + m][n] = __builtin_amdgcn_mfma_f32_16x16x32_bf16(At[m], Bf[n], acc[mh + m][n], 0, 0, 0);
            }
          __builtin_amdgcn_sched_barrier(0);
        }
      }
      cur = (cur == NBUF - 1) ? 0 : cur + 1;
    }
    GL_RAWBAR();
    const int Ln = L + Lstep;
    if (Ln < Lend) { GL_SETP(Ln); for (int s = 0; s < npre; ++s) GL_ISSUE(s, s, Ln); }
    {
      const int t3 = opaque_tid(), w3 = t3 >> 6, l3 = t3 & 63, wr3 = w3 >> 2, wc3 = w3 & 3, fr3 = l3 & 15, fq3 = l3 >> 4;
      if constexpr (SWAP) {
        epi(L, wr3 * (MI * 16) + fr3, wc3 * 64 + fq3 * 16, acc);
      } else {
#pragma unroll
        for (int m = 0; m < MI; ++m)
#pragma unroll
          for (int n = 0; n < 4; ++n) epi(L, wr3 * (MI * 16) + m * 16 + fq3 * 4, wc3 * 64 + n * 16 + fr3, acc[m][n]);
      }
    }
  }
  asm volatile("s_waitcnt vmcnt(0)" ::: "memory");
#undef GL_SETP
#undef GL_ISSUE
#undef GL_RAWBAR
}


__device__ __forceinline__ int lds_byte32(int r, int c) {
  const int ob = (r & 15) * 64 + (c & 31) * 2;
  return (r >> 4) * 1024 + (ob ^ (((ob >> 9) & 1) << 5));
}
__device__ __forceinline__ void stage_rc32(int b, int& R, int& C) {
  const int st = b >> 10, sb = b & 1023, swz = sb ^ (((sb >> 9) & 1) << 5);
  R = st * 16 + (swz >> 6);
  C = (swz & 63) >> 1;
}
template <bool SWAP, class RA, class RB, class KA, class KB, class EP>
__device__ __forceinline__ void gemm_loop32(char* shm, int nk, int Lbeg, int Lend, int Lstep, RA rowA, RB rowB, KA koffA, KB koffB, EP epi) {
  constexpr int MI = 8, GLA = 2, GLB = 2;
  constexpr int TILE_A = 256 * 64, TILE_B = 256 * 64, STG = TILE_A + TILE_B, NBUF = 4;
  static_assert(NBUF * STG <= GEMM_LDS_TOTAL, "LDS");
  if (Lbeg >= Lend) return;
  const int tid = opaque_tid(), wid = tid >> 6, lane = tid & 63, wr = wid >> 2, wc = wid & 3, fr = lane & 15, fq = lane >> 4;
  const bf16_t* pa[GLA];
  const bf16_t* pb[GLB];
#define G32_SETP(L_) do { int t2_ = tid; asm volatile("" : "+v"(t2_)); const int w2_ = t2_ >> 6, l2_ = t2_ & 63;        \
    _Pragma("unroll") for (int i = 0; i < GLA; ++i) { int R_, C_; stage_rc32(w2_ * 1024 + i * 8192 + l2_ * 16, R_, C_); pa[i] = rowA((L_), R_) + C_; } \
    _Pragma("unroll") for (int i = 0; i < GLB; ++i) { int R_, C_; stage_rc32(w2_ * 1024 + i * 8192 + l2_ * 16, R_, C_); pb[i] = rowB((L_), SWAP ? perm_col(R_) : R_) + C_; } } while (0)
#define G32_ISSUE(buf, s_, L_) do { const int ka_ = koffA((L_), (s_) >> 1) + ((s_) & 1) * 32, kb_ = koffB((L_), (s_) >> 1) + ((s_) & 1) * 32; \
    char* base_ = shm + (buf) * STG;                                                                                   \
    _Pragma("unroll") for (int i = 0; i < GLA; ++i)                                                                    \
      __builtin_amdgcn_global_load_lds((const unsigned*)(pa[i] + ka_), (unsigned*)(base_ + wid * 1024 + i * 8192), 16, 0, 0); \
    _Pragma("unroll") for (int i = 0; i < GLB; ++i)                                                                    \
      __builtin_amdgcn_global_load_lds((const unsigned*)(pb[i] + kb_), (unsigned*)(base_ + TILE_A + wid * 1024 + i * 8192), 16, 0, 0); } while (0)
#define G32_RAWBAR() do { asm volatile("s_waitcnt lgkmcnt(0)" ::: "memory"); __builtin_amdgcn_s_barrier(); } while (0)
  const int ns = 2 * nk;
  const int npre = ns < NBUF ? ns : NBUF;
  G32_SETP(Lbeg);
  for (int s = 0; s < npre; ++s) G32_ISSUE(s, s, Lbeg);
  for (int L = Lbeg; L < Lend; L += Lstep) {
    f32x4 acc[MI][4];
#pragma unroll
    for (int m = 0; m < MI; ++m)
#pragma unroll
      for (int n = 0; n < 4; ++n) acc[m][n] = f32x4{0.f, 0.f, 0.f, 0.f};
    int cur = 0;
    for (int t = 0; t < ns; ++t) {
      if (t == 0) asm volatile("s_waitcnt vmcnt(0)" ::: "memory");
      else if (t + 2 < ns) asm volatile("s_waitcnt vmcnt(8)" ::: "memory");
      else if (t + 1 < ns) asm volatile("s_waitcnt vmcnt(4)" ::: "memory");
      else asm volatile("s_waitcnt vmcnt(0)" ::: "memory");
      G32_RAWBAR();
      if (t >= 1 && t + 3 < ns) { const int nb_ = (cur + 3) & 3; G32_ISSUE(nb_, t + 3, L); }
      const char* sa = shm + cur * STG;
      const char* sb = sa + TILE_A;
      const int offA = lds_byte32(wr * 128 + fr, fq * 8), offB = lds_byte32(wc * 64 + fr, fq * 8);
      bf16x8 Bf[4];
#pragma unroll
      for (int n = 0; n < 4; ++n) Bf[n] = *(const bf16x8*)(sb + offB + n * 1024);
#pragma unroll
      for (int mh = 0; mh < MI; mh += 4) {
        bf16x8 At[4];
#pragma unroll
        for (int m = 0; m < 4; ++m) At[m] = *(const bf16x8*)(sa + offA + (mh + m) * 1024);
#pragma unroll
        for (int m = 0; m < 4; ++m)
#pragma unroll
          for (int n = 0; n < 4; ++n) {
            if (SWAP) acc[mh + m][n] = __builtin_amdgcn_mfma_f32_16x16x32_bf16(Bf[n], At[m], acc[mh + m][n], 0, 0, 0);
            else      acc[mh + m][n] = __builtin_amdgcn_mfma_f32_16x16x32_bf16(At[m], Bf[n], acc[mh + m][n], 0, 0, 0);
          }
        __builtin_amdgcn_sched_barrier(0);
      }
      cur = (cur + 1) & 3;
    }
    G32_RAWBAR();
    const int Ln = L + Lstep;
    if (Ln < Lend) { G32_SETP(Ln); for (int s = 0; s < npre; ++s) G32_ISSUE(s, s, Ln); }
    {
      const int t3 = opaque_tid(), w3 = t3 >> 6, l3 = t3 & 63, wr3 = w3 >> 2, wc3 = w3 & 3, fr3 = l3 & 15, fq3 = l3 >> 4;
      if constexpr (SWAP) {
        epi(L, wr3 * 128 + fr3, wc3 * 64 + fq3 * 16, acc);
      } else {
#pragma unroll
        for (int m = 0; m < MI; ++m)
#pragma unroll
          for (int n = 0; n < 4; ++n) epi(L, wr3 * 128 + m * 16 + fq3 * 4, wc3 * 64 + n * 16 + fr3, acc[m][n]);
      }
    }
  }
  asm volatile("s_waitcnt vmcnt(0)" ::: "memory");
#undef G32_SETP
#undef G32_ISSUE
#undef G32_RAWBAR
}
template <int MI, bool SWAP, class RA, class RB, class KA, class KB, class EP>
__device__ __forceinline__ void gemm_run(char* shm, int nk, int Lbeg, int Lend, int Lstep, RA rowA, RB rowB, KA koffA, KB koffB, EP epi) {
#ifdef USE_BK32
  if constexpr (MI == 8) gemm_loop32<SWAP>(shm, nk, Lbeg, Lend, Lstep, rowA, rowB, koffA, koffB, epi);
  else gemm_loop<MI, SWAP>(shm, nk, Lbeg, Lend, Lstep, rowA, rowB, koffA, koffB, epi);
#else
  gemm_loop<MI, SWAP>(shm, nk, Lbeg, Lend, Lstep, rowA, rowB, koffA, koffB, epi);
#endif
}

template <class F> struct PerM {
  F f;
  template <int MI> __device__ __forceinline__ void operator()(int L, int rb, int c0, const f32x4 (&a)[MI][4]) const {
#pragma unroll
    for (int m = 0; m < MI; ++m) f(L, rb + 16 * m, c0, a[m]);
  }
};
template <class F> __device__ __forceinline__ PerM<F> per_m(F f) { return PerM<F>{f}; }

template <class EP>
__device__ __forceinline__ void dense_phase(char* shm, int vb, int G, const bf16_t* A, int lda, const bf16_t* Wt, int ldw,
                                            int ntn, int nk, bool with_ctx, EP epi) {
  const int nbig = 64 * ntn;
  gemm_run<8, true>(shm, nk, vb, nbig, G,
    [=](int L, int r) { return A + (size_t)((1 + L / ntn) * 256 + r) * lda; },
    [=](int L, int c) { return Wt + (size_t)((L % ntn) * 256 + c) * ldw; }, KOffL(), KOffL(),
    per_m([=](int L, int row, int col0, const f32x4 (&a)[4]) { epi((1 + L / ntn) * 256 + row, (L % ntn) * 256 + col0, a); }));
  if (with_ctx) {
    const int s = (vb - (nbig % G) + G) % G;
    gemm_loop<2, true>(shm, nk, s, 4 * ntn, G,
      [=](int L, int r) { return A + (size_t)((L / ntn) * 64 + r) * lda; },
      [=](int L, int c) { return Wt + (size_t)((L % ntn) * 256 + c) * ldw; }, KOffL(), KOffL(),
      per_m([=](int L, int row, int col0, const f32x4 (&a)[4]) { epi((L / ntn) * 64 + row, (L % ntn) * 256 + col0, a); }));
  }
}

#define XB_TMO      128
#define XB_XCNT(j)  (256  + 64 * (j))
#define XB_XSUB(j)  (1280 + 64 * (j))
#define XB_XGEN(j)  (2304 + 64 * (j))
#define XB_TOP      3328
#define XB_TOPGEN   3392
#define XCD_BAR_WORDS 3456
#define XB_SPIN_CAP (1u << 22)
#define LAS __attribute__((address_space(3)))
__device__ __forceinline__ unsigned xb_ld(unsigned* p)              { return __hip_atomic_load(p, __ATOMIC_RELAXED, __HIP_MEMORY_SCOPE_AGENT); }
__device__ __forceinline__ unsigned xb_add(unsigned* p, unsigned v) { return __hip_atomic_fetch_add(p, v, __ATOMIC_RELAXED, __HIP_MEMORY_SCOPE_AGENT); }
__device__ __forceinline__ unsigned xb_xcc_id() { return (unsigned)__builtin_amdgcn_s_getreg((3 << 11) | 20) & 0xFu; }
#define XB_SPIN(cond, bar) do { unsigned _sp = 0; while (cond) { __builtin_amdgcn_s_sleep(1); \
    if ((++_sp & 255u) == 0u) { if (xb_ld(&(bar)[XB_TMO])) break; if (_sp > XB_SPIN_CAP) { atomicAdd(&(bar)[XB_TMO], 1u); break; } } } } while (0)
struct XcdBarrier { unsigned* bar; unsigned x; volatile LAS unsigned* st; };
__device__ __forceinline__ XcdBarrier xcd_barrier_post(unsigned* bar, volatile LAS unsigned* st) {
    XcdBarrier b; b.bar = bar; b.x = xb_xcc_id(); b.st = st;
    if (threadIdx.x == 0) (void)xb_add(&bar[XB_XCNT(b.x)], 1u);
    return b;
}
__device__ __forceinline__ void xcd_barrier_complete(unsigned* bar, unsigned x, unsigned& nloc, unsigned& nx) {
    const unsigned G = gridDim.x * gridDim.y * gridDim.z;
    unsigned sum, cnt, mine, sp = 0u;
    for (;;) {
        sum = 0u; cnt = 0u; mine = 0u;
#pragma unroll
        for (unsigned j = 0; j < 16; ++j) { const unsigned c = xb_ld(&bar[XB_XCNT(j)]); sum += c; cnt += (c > 0u) ? 1u : 0u; mine = (j == x) ? c : mine; }
        if (sum == G) break;
        __builtin_amdgcn_s_sleep(1);
        if ((++sp & 255u) == 0u) { if (xb_ld(&bar[XB_TMO])) break; if (sp > XB_SPIN_CAP) { atomicAdd(&bar[XB_TMO], 1u); break; } }
    }
    nloc = mine > 0u ? mine : 1u; nx = cnt > 0u ? cnt : 1u;
}
__device__ __forceinline__ void xcd_barrier(const XcdBarrier& b) {
    asm volatile("s_waitcnt vmcnt(0)" ::: "memory");
    __syncthreads();
    if (threadIdx.x == 0) {
        unsigned* bar = b.bar;
        __builtin_amdgcn_s_waitcnt(0);
        unsigned nloc = b.st[0], nx = b.st[1];
        if (nloc == 0u) { xcd_barrier_complete(bar, b.x, nloc, nx); b.st[0] = nloc; b.st[1] = nx; }
        const unsigned old = xb_add(&bar[XB_XSUB(b.x)], 1u);
        const unsigned gen = old / nloc;
        if (old + 1u == (gen + 1u) * nloc) {
            __builtin_amdgcn_fence(__ATOMIC_RELEASE, "agent");
            asm volatile("s_waitcnt vmcnt(0)" ::: "memory");
            const unsigned og = xb_add(&bar[XB_TOP], 1u);
            const unsigned tg = og / nx;
            if (og + 1u == (tg + 1u) * nx) xb_add(&bar[XB_TOPGEN], 1u);
            else XB_SPIN(xb_ld(&bar[XB_TOPGEN]) == tg, bar);
            __builtin_amdgcn_fence(__ATOMIC_ACQUIRE, "agent");
            xb_add(&bar[XB_XGEN(b.x)], 1u);
            asm volatile("s_waitcnt vmcnt(0)" ::: "memory");
        } else {
            XB_SPIN(xb_ld(&bar[XB_XGEN(b.x)]) == gen, bar);
            __builtin_amdgcn_fence(__ATOMIC_ACQUIRE, "agent");
            asm volatile("s_waitcnt vmcnt(0)" ::: "memory");
        }
    }
    __syncthreads();
}

template <class AF, class BF, class EF>
__device__ __forceinline__ void gemm_naive(int M, int N, int K, AF af, BF bf, EF ef, float* smem_all) {
  const int half = threadIdx.x >> 8, tid = threadIdx.x & 255;
  float* smem = smem_all + half * (2 * 16 * 68);
  const int tilesM = (M + 63) >> 6, tilesN = (N + 63) >> 6;
  const int ntiles = tilesM * tilesN;
  float (*As)[68] = (float (*)[68])smem;
  float (*Bs)[68] = (float (*)[68])(smem + 16 * 68);
  const int ty = tid >> 4, tx = tid & 15;
  const int stride = gridDim.x * 2;
  const int iters = (ntiles + stride - 1) / stride;
  for (int it = 0; it < iters; ++it) {
    const int tile = it * stride + blockIdx.x * 2 + half;
    const bool valid = tile < ntiles;
    const int tm = valid ? tile / tilesN : 0, tn = valid ? tile - tm * tilesN : 0;
    const int m0 = tm << 6, n0 = tn << 6;
    float acc[4][4];
#pragma unroll
    for (int i = 0; i < 4; ++i)
#pragma unroll
      for (int j = 0; j < 4; ++j) acc[i][j] = 0.f;
    for (int k0 = 0; k0 < K; k0 += 16) {
#pragma unroll
      for (int i = 0; i < 4; ++i) {
        const int mm = (tid >> 4) + 16 * i, kk = tid & 15;
        const int m = m0 + mm, k = k0 + kk;
        As[kk][mm] = (valid && m < M && k < K) ? af(m, k, n0) : 0.f;
      }
#pragma unroll
      for (int i = 0; i < 4; ++i) {
        const int kk = (tid >> 6) + 4 * i, nn = tid & 63;
        const int k = k0 + kk, n = n0 + nn;
        Bs[kk][nn] = (valid && k < K && n < N) ? bf(k, n, m0) : 0.f;
      }
      __syncthreads();
#pragma unroll
      for (int kk = 0; kk < 16; ++kk) {
        const float4 a = *(const float4*)&As[kk][ty * 4];
        const float4 b = *(const float4*)&Bs[kk][tx * 4];
        const float av[4] = {a.x, a.y, a.z, a.w};
        const float bv[4] = {b.x, b.y, b.z, b.w};
#pragma unroll
        for (int i = 0; i < 4; ++i)
#pragma unroll
          for (int j = 0; j < 4; ++j) acc[i][j] = fmaf(av[i], bv[j], acc[i][j]);
      }
      __syncthreads();
    }
    if (valid) {
#pragma unroll
      for (int i = 0; i < 4; ++i)
#pragma unroll
        for (int j = 0; j < 4; ++j) {
          const int m = m0 + ty * 4 + i, n = n0 + tx * 4 + j;
          if (m < M && n < N) ef(m, n, acc[i][j]);
        }
    }
  }
}

__device__ __forceinline__ void conv_tile(const float* src, int ldn, bf16_t* dst, int ldk, int k0, int n0, int mapmode, float* sm) {
  const int tid = opaque_tid();
  float (*tl)[65] = (float (*)[65])sm;
  {
    const int row = tid >> 3, c4 = (tid & 7) * 4;
    const float4 a = *(const float4*)&src[(size_t)(k0 + row) * ldn + n0 + c4];
    const float4 b = *(const float4*)&src[(size_t)(k0 + row) * ldn + n0 + 32 + c4];
    tl[row][c4 + 0] = a.x; tl[row][c4 + 1] = a.y; tl[row][c4 + 2] = a.z; tl[row][c4 + 3] = a.w;
    tl[row][32 + c4 + 0] = b.x; tl[row][32 + c4 + 1] = b.y; tl[row][32 + c4 + 2] = b.z; tl[row][32 + c4 + 3] = b.w;
  }
  __syncthreads();
  {
    const int n = tid >> 3, kg = (tid & 7) * 8;
    uint4 o;
    o.x = pack2(tl[kg + 0][n], tl[kg + 1][n]); o.y = pack2(tl[kg + 2][n], tl[kg + 3][n]);
    o.z = pack2(tl[kg + 4][n], tl[kg + 5][n]); o.w = pack2(tl[kg + 6][n], tl[kg + 7][n]);
    const int h = n0 + n;
    const int dr = mapmode == 0 ? h : ((h >> 3) * 16 + (h & 7) + (mapmode == 2 ? 8 : 0));
    *(uint4*)&dst[(size_t)dr * ldk + k0 + kg] = o;
  }
  __syncthreads();
}

__device__ __forceinline__ void norm_phase(const Params& P, int t0, const float* gw,
                                           int mod_layer, int shift_idx,
                                           int pend_layer, int pend_t0,
                                           bool to_out, bool router, int layer, float* wl) {
  int* rl = (int*)((char*)wl + GEMM_LDS_TOTAL + 272);
  unsigned char* ws = P.ws;
  float* tok = (float*)(ws + WS_TOK);
  bf16_t* hb = (bf16_t*)(ws + WS_H);
  const float* mod = (const float*)(ws + WS_MOD);
  const bf16_t* ybuf = (const bf16_t*)(ws + WS_R + R_YBUF);
  const int tid_n = opaque_tid();
  const int lane = tid_n & 63;
  if (router) {
    const float* rgw = P.in[9] + (size_t)layer * 1024 * 4;
    const float* rew = P.in[11] + (size_t)layer * 1024 * 32;
    for (int idx = tid_n; idx < 1024 * 36; idx += NT) {
      const int k = idx / 36, j = idx - k * 36;
      const int rho = (((k >> 8) * 4 + (k & 3)) * 64) + ((k & 255) >> 2);
      wl[rho * 36 + j] = (j < 4) ? rgw[k * 4 + j] : rew[k * 32 + (j - 4)];
    }
    if (tid_n < 80) rl[tid_n] = 0;
    __syncthreads();
  }
  const int gw_id = blockIdx.x * (NT / 64) + (tid_n >> 6);
  const int gw_n = gridDim.x * (NT / 64);
  for (int t = t0 + gw_id; t < T_ALL; t += gw_n) {
    const int s = (t < T_CTX) ? 1 : 0;
    float v[16];
    if (pend_layer == -2) {
      const float* PE = (const float*)(ws + W_PE);
#pragma unroll
      for (int j = 0; j < 4; ++j) {
        const int n = j * 256 + lane * 4;
        float4 x;
        if (t < T_CTX) x = *(const float4*)&P.in[2][(size_t)t * DM + n];
        else {
          const int tl = t - T_CTX;
          x = *(const float4*)&P.in[0][(size_t)tl * DM + n];
          const float* pp = (j < 2) ? PE + j * 65536 + (tl >> 6) * 256 + lane * 4 : PE + 131072 + (j - 2) * 16384 + (tl & 63) * 256 + lane * 4;
          const float4 pe = *(const float4*)pp;
          x.x += pe.x; x.y += pe.y; x.z += pe.z; x.w += pe.w;
        }
        v[j * 4 + 0] = x.x; v[j * 4 + 1] = x.y; v[j * 4 + 2] = x.z; v[j * 4 + 3] = x.w;
        *(float4*)&tok[(size_t)t * DM + n] = x;
      }
    } else {
#pragma unroll
    for (int j = 0; j < 4; ++j) {
      const int n = j * 256 + lane * 4;
      const float4 x = *(const float4*)&tok[(size_t)t * DM + n];
      v[j * 4 + 0] = x.x; v[j * 4 + 1] = x.y; v[j * 4 + 2] = x.z; v[j * 4 + 3] = x.w;
    }
    }
    if (pend_layer >= 0 && t >= pend_t0) {
      const float* gate = mod + (size_t)((pend_layer * 2 + s) * 6 + 5) * 1024;
#pragma unroll
      for (int j = 0; j < 4; ++j) {
        const int n = j * 256 + lane * 4;
        const uint2 y0 = *(const uint2*)&ybuf[(size_t)(2 * t) * DM + n];
        const uint2 y1 = *(const uint2*)&ybuf[(size_t)(2 * t + 1) * DM + n];
        const float4 g = *(const float4*)&gate[n];
        v[j * 4 + 0] += g.x * (lo2f(y0.x) + lo2f(y1.x));
        v[j * 4 + 1] += g.y * (hi2f(y0.x) + hi2f(y1.x));
        v[j * 4 + 2] += g.z * (lo2f(y0.y) + lo2f(y1.y));
        v[j * 4 + 3] += g.w * (hi2f(y0.y) + hi2f(y1.y));
        *(float4*)&tok[(size_t)t * DM + n] = make_float4(v[j * 4 + 0], v[j * 4 + 1], v[j * 4 + 2], v[j * 4 + 3]);
      }
    }
    float ss = 0.f;
#pragma unroll
    for (int e = 0; e < 16; ++e) ss += v[e] * v[e];
    ss = wave_sum(ss);
    const float r = 1.f / sqrtf(ss * (1.f / 1024.f) + EPSN);
    float h[16];
#pragma unroll
    for (int j = 0; j < 4; ++j) {
      const int n = j * 256 + lane * 4;
      const float4 g = *(const float4*)&gw[n];
      h[j * 4 + 0] = v[j * 4 + 0] * r * g.x;
      h[j * 4 + 1] = v[j * 4 + 1] * r * g.y;
      h[j * 4 + 2] = v[j * 4 + 2] * r * g.z;
      h[j * 4 + 3] = v[j * 4 + 3] * r * g.w;
      if (shift_idx >= 0) {
        const float* sh = mod + (size_t)((mod_layer * 2 + s) * 6 + shift_idx) * 1024;
        const float* sc = sh + 1024;
        const float4 a = *(const float4*)&sh[n];
        const float4 b = *(const float4*)&sc[n];
        h[j * 4 + 0] = h[j * 4 + 0] * (1.f + b.x) + a.x;
        h[j * 4 + 1] = h[j * 4 + 1] * (1.f + b.y) + a.y;
        h[j * 4 + 2] = h[j * 4 + 2] * (1.f + b.z) + a.z;
        h[j * 4 + 3] = h[j * 4 + 3] * (1.f + b.w) + a.w;
      }
      if (to_out) {
        *(float4*)&P.out[(size_t)(t - T_CTX) * DM + n] = make_float4(h[j * 4 + 0], h[j * 4 + 1], h[j * 4 + 2], h[j * 4 + 3]);
      } else {
        uint2 o; o.x = pack2(h[j * 4 + 0], h[j * 4 + 1]); o.y = pack2(h[j * 4 + 2], h[j * 4 + 3]);
        *(uint2*)&hb[(size_t)t * DM + n] = o;
      }
    }
    if (router) {
      float lg[36];
#pragma unroll
      for (int q = 0; q < 36; ++q) lg[q] = 0.f;
#pragma unroll
      for (int i = 0; i < 16; ++i) {
        const float hv = h[i];
        const float4* wr4 = (const float4*)(wl + (i * 64 + lane) * 36);
#pragma unroll
        for (int q = 0; q < 9; ++q) {
          const float4 w4 = wr4[q];
          lg[q * 4 + 0] += hv * w4.x; lg[q * 4 + 1] += hv * w4.y; lg[q * 4 + 2] += hv * w4.z; lg[q * 4 + 3] += hv * w4.w;
        }
        __builtin_amdgcn_sched_barrier(0);
      }
#pragma unroll
      for (int q = 0; q < 36; ++q) lg[q] = wave_sum(lg[q]);
      const float* rgb = P.in[10] + layer * 4;
      const float* reb = P.in[12] + layer * 32;
#pragma unroll
      for (int q = 0; q < 4; ++q) lg[q] += rgb[q];
#pragma unroll
      for (int q = 0; q < 32; ++q) lg[4 + q] += reb[q];
      int grp = 0; float best = lg[0];
#pragma unroll
      for (int q = 1; q < 4; ++q) if (lg[q] > best) { best = lg[q]; grp = q; }
      float se = 0.f;
#pragma unroll
      for (int q = 0; q < 4; ++q) se += expf(lg[q] - best);
      const float pg = 1.f / se;
      float v0 = -3.0e38f, v1 = -3.0e38f; int i0 = 0, i1 = 0;
#pragma unroll
      for (int g = 0; g < 4; ++g) {
#pragma unroll
        for (int q = 0; q < 8; ++q) {
          const float x = lg[4 + g * 8 + q];
          if (g == grp) {
            if (x > v0) { v1 = v0; i1 = i0; v0 = x; i0 = q; }
            else if (x > v1) { v1 = x; i1 = q; }
          }
        }
      }
      const float w0 = 1.f / (1.f + expf(v1 - v0));
      const float w1 = 1.f - w0;
      if (lane == 0) {
        float* asgw = (float*)(ws + WS_ASGW);
        const int e0 = grp * 8 + i0, e1 = grp * 8 + i1;
        const int p0 = atomicAdd(&rl[e0], 1);
        const int p1 = atomicAdd(&rl[e1], 1);
        const int sl = atomicAdd(&rl[64], 2);
        rl[80 + sl] = 2 * t;         rl[240 + sl] = e0;     rl[400 + sl] = p0;
        rl[80 + sl + 1] = 2 * t + 1; rl[240 + sl + 1] = e1; rl[400 + sl + 1] = p1;
        asgw[2 * t] = w0 * pg;
        asgw[2 * t + 1] = w1 * pg;
      }
    }
  }
  if (router) {
    __syncthreads();
    int* cnt = (int*)(ws + WS_CNT) + layer * 32 * 32;
    int* list = (int*)(ws + WS_LIST);
    if (tid_n < 32) rl[32 + tid_n] = rl[tid_n] ? atomicAdd(&cnt[tid_n * 32], rl[tid_n]) : 0;
    __syncthreads();
    const int nent = rl[64];
    for (int s = tid_n; s < nent; s += NT) {
      const int e = rl[240 + s];
      list[(size_t)e * 33280 + rl[32 + e] + rl[400 + s]] = rl[80 + s];
    }
    __syncthreads();
  }
}


__device__ __forceinline__ void route_token(const float (&lg_in)[36], const float* rgb, const float* reb, int t, int* rl, float* asgw) {
  float lg[36];
#pragma unroll
  for (int q = 0; q < 4; ++q) lg[q] = lg_in[q] + rgb[q];
#pragma unroll
  for (int q = 0; q < 32; ++q) lg[4 + q] = lg_in[4 + q] + reb[q];
  int grp = 0; float best = lg[0];
#pragma unroll
  for (int q = 1; q < 4; ++q) if (lg[q] > best) { best = lg[q]; grp = q; }
  float se = 0.f;
#pragma unroll
  for (int q = 0; q < 4; ++q) se += expf(lg[q] - best);
  const float pg = 1.f / se;
  float v0 = -3.0e38f, v1 = -3.0e38f; int i0 = 0, i1 = 0;
#pragma unroll
  for (int g = 0; g < 4; ++g) {
#pragma unroll
    for (int q = 0; q < 8; ++q) {
      const float x = lg[4 + g * 8 + q];
      if (g == grp) {
        if (x > v0) { v1 = v0; i1 = i0; v0 = x; i0 = q; }
        else if (x > v1) { v1 = x; i1 = q; }
      }
    }
  }
  const float w0 = 1.f / (1.f + expf(v1 - v0));
  const float w1 = 1.f - w0;
  const int e0 = grp * 8 + i0, e1 = grp * 8 + i1;
  const int p0 = atomicAdd(&rl[e0], 1);
  const int p1 = atomicAdd(&rl[e1], 1);
  const int sl = atomicAdd(&rl[64], 2);
  rl[80 + sl] = 2 * t;         rl[240 + sl] = e0;     rl[400 + sl] = p0;
  rl[80 + sl + 1] = 2 * t + 1; rl[240 + sl + 1] = e1; rl[400 + sl + 1] = p1;
  asgw[2 * t] = w0 * pg;
  asgw[2 * t + 1] = w1 * pg;
}

__device__ __forceinline__ void route_token2(float res, int t, int* rl, float* asgw, int lane) {
  const float g0 = __shfl(res, 0), g1 = __shfl(res, 1), g2 = __shfl(res, 2), g3 = __shfl(res, 3);
  int grp = 0; float best = g0;
  if (g1 > best) { best = g1; grp = 1; }
  if (g2 > best) { best = g2; grp = 2; }
  if (g3 > best) { best = g3; grp = 3; }
  const float pg = 1.f / (expf(g0 - best) + expf(g1 - best) + expf(g2 - best) + expf(g3 - best));
  float v0 = -3.0e38f, v1 = -3.0e38f; int i0 = 0, i1 = 0;
#pragma unroll
  for (int q = 0; q < 8; ++q) {
    const float x = __shfl(res, 4 + grp * 8 + q);
    if (x > v0) { v1 = v0; i1 = i0; v0 = x; i0 = q; }
    else if (x > v1) { v1 = x; i1 = q; }
  }
  if (lane == 0) {
    const float w0 = 1.f / (1.f + expf(v1 - v0));
    const float w1 = 1.f - w0;
    const int e0 = grp * 8 + i0, e1 = grp * 8 + i1;
    const int p0 = atomicAdd(&rl[e0], 1);
    const int p1 = atomicAdd(&rl[e1], 1);
    const int sl = atomicAdd(&rl[64], 2);
    rl[80 + sl] = 2 * t;         rl[240 + sl] = e0;     rl[400 + sl] = p0;
    rl[80 + sl + 1] = 2 * t + 1; rl[240 + sl + 1] = e1; rl[400 + sl + 1] = p1;
    asgw[2 * t] = w0 * pg;
    asgw[2 * t + 1] = w1 * pg;
  }
}

__device__ __forceinline__ void ffn_norm_router_phase(const Params& P, int t0, int layer, float* wl) {
  unsigned char* ws = P.ws;
  int* rl = (int*)((char*)wl + GEMM_LDS_TOTAL + 272);
  const float* tok = (const float*)(ws + WS_TOK);
  bf16_t* hb = (bf16_t*)(ws + WS_H);
  const float* mod = (const float*)(ws + WS_MOD);
  const float* gw = P.in[7] + layer * 1024;
  const int tid_n = opaque_tid();
  const int lane0 = tid_n & 63;
  {
    const float* rgw = P.in[9] + (size_t)layer * 1024 * 4;
    const float* rew = P.in[11] + (size_t)layer * 1024 * 32;
    for (int ib = 0; ib < 18; ib += 6) {
      float4 w[6];
#pragma unroll
      for (int u = 0; u < 6; ++u) {
        const int idx = tid_n + (ib + u) * NT, k = idx / 9, q = idx - k * 9;
        const float* wp = (q == 0) ? rgw + k * 4 : rew + k * 32 + (q - 1) * 4;
        w[u] = *(const float4*)wp;
      }
#pragma unroll
      for (int u = 0; u < 6; ++u) {
        const int idx = tid_n + (ib + u) * NT, k = idx / 9, q = idx - k * 9;
        const int rho = (((k >> 8) * 4 + (k & 3)) * 64) + ((k & 255) >> 2);
        *(float4*)&wl[rho * 36 + q * 4] = w[u];
      }
    }
    if (tid_n < 80) rl[tid_n] = 0;
    __syncthreads();
  }
  const float* rgb = P.in[10] + layer * 4;
  const float* reb = P.in[12] + layer * 32;
  float* asgw = (float*)(ws + WS_ASGW);
  const int gw_id = blockIdx.x * (NT / 64) + (tid_n >> 6);
  const int gw_n = gridDim.x * (NT / 64);
  for (int tA = t0 + gw_id; tA < T_ALL; tA += 2 * gw_n) {
    int lane = lane0; asm volatile("" : "+v"(lane));
    const int tB = tA + gw_n;
    const bool hasB = tB < T_ALL;
    const int tBs = hasB ? tB : tA;
    float hA[16], hB[16];
    {
      float vA[16], vB[16];
#pragma unroll
      for (int j = 0; j < 4; ++j) {
        const int n = j * 256 + lane * 4;
        const float4 x = *(const float4*)&tok[(size_t)tA * DM + n];
        const float4 y = *(const float4*)&tok[(size_t)tBs * DM + n];
        vA[j * 4 + 0] = x.x; vA[j * 4 + 1] = x.y; vA[j * 4 + 2] = x.z; vA[j * 4 + 3] = x.w;
        vB[j * 4 + 0] = y.x; vB[j * 4 + 1] = y.y; vB[j * 4 + 2] = y.z; vB[j * 4 + 3] = y.w;
      }
      float sA = 0.f, sB = 0.f;
#pragma unroll
      for (int e = 0; e < 16; ++e) { sA += vA[e] * vA[e]; sB += vB[e] * vB[e]; }
      sA = wave_sum(sA); sB = wave_sum(sB);
      const float rA = 1.f / sqrtf(sA * (1.f / 1024.f) + EPSN), rB = 1.f / sqrtf(sB * (1.f / 1024.f) + EPSN);
      const int stA = (tA < T_CTX) ? 1 : 0, stB = (tBs < T_CTX) ? 1 : 0;
      const float* shA = mod + (size_t)((layer * 2 + stA) * 6 + 3) * 1024;
      const float* shB = mod + (size_t)((layer * 2 + stB) * 6 + 3) * 1024;
#pragma unroll
      for (int j = 0; j < 4; ++j) {
        const int n = j * 256 + lane * 4;
        const float4 g = *(const float4*)&gw[n];
        const float4 a1 = *(const float4*)&shA[n], b1 = *(const float4*)&shA[1024 + n];
        const float4 a2 = *(const float4*)&shB[n], b2 = *(const float4*)&shB[1024 + n];
        hA[j * 4 + 0] = vA[j * 4 + 0] * rA * g.x * (1.f + b1.x) + a1.x; hA[j * 4 + 1] = vA[j * 4 + 1] * rA * g.y * (1.f + b1.y) + a1.y;
        hA[j * 4 + 2] = vA[j * 4 + 2] * rA * g.z * (1.f + b1.z) + a1.z; hA[j * 4 + 3] = vA[j * 4 + 3] * rA * g.w * (1.f + b1.w) + a1.w;
        hB[j * 4 + 0] = vB[j * 4 + 0] * rB * g.x * (1.f + b2.x) + a2.x; hB[j * 4 + 1] = vB[j * 4 + 1] * rB * g.y * (1.f + b2.y) + a2.y;
        hB[j * 4 + 2] = vB[j * 4 + 2] * rB * g.z * (1.f + b2.z) + a2.z; hB[j * 4 + 3] = vB[j * 4 + 3] * rB * g.w * (1.f + b2.w) + a2.w;
        uint2 o; o.x = pack2(hA[j * 4 + 0], hA[j * 4 + 1]); o.y = pack2(hA[j * 4 + 2], hA[j * 4 + 3]);
        *(uint2*)&hb[(size_t)tA * DM + n] = o;
        if (hasB) { uint2 o2; o2.x = pack2(hB[j * 4 + 0], hB[j * 4 + 1]); o2.y = pack2(hB[j * 4 + 2], hB[j * 4 + 3]); *(uint2*)&hb[(size_t)tB * DM + n] = o2; }
      }
    }
    float lA[36], lB[36];
#pragma unroll
    for (int q = 0; q < 36; ++q) { lA[q] = 0.f; lB[q] = 0.f; }
#pragma unroll
    for (int i = 0; i < 16; ++i) {
      const float4* wr4 = (const float4*)(wl + (i * 64 + lane) * 36);
#pragma unroll
      for (int q = 0; q < 9; ++q) {
        const float4 w4 = wr4[q];
        lA[q * 4 + 0] += hA[i] * w4.x; lA[q * 4 + 1] += hA[i] * w4.y; lA[q * 4 + 2] += hA[i] * w4.z; lA[q * 4 + 3] += hA[i] * w4.w;
        lB[q * 4 + 0] += hB[i] * w4.x; lB[q * 4 + 1] += hB[i] * w4.y; lB[q * 4 + 2] += hB[i] * w4.z; lB[q * 4 + 3] += hB[i] * w4.w;
      }
      __builtin_amdgcn_sched_barrier(0);
    }
    float resA = 0.f, resB = 0.f;
#pragma unroll
    for (int q = 0; q < 36; ++q) {
      const float sa = wave_sum(lA[q]), sb2 = wave_sum(lB[q]);
      if (lane == q) { resA = sa; resB = sb2; }
    }
    {
      const float bias = lane < 4 ? rgb[lane] : (lane < 36 ? reb[lane - 4] : 0.f);
      resA += bias; resB += bias;
    }
    route_token2(resA, tA, rl, asgw, lane);
    if (hasB) route_token2(resB, tB, rl, asgw, lane);
  }
  __syncthreads();
  int* cnt = (int*)(ws + WS_CNT) + layer * 32 * 32;
  int* list = (int*)(ws + WS_LIST);
  if (tid_n < 32) rl[32 + tid_n] = rl[tid_n] ? atomicAdd(&cnt[tid_n * 32], rl[tid_n]) : 0;
  __syncthreads();
  const int nent = rl[64];
  for (int s = tid_n; s < nent; s += NT) {
    const int e = rl[240 + s];
    list[(size_t)e * 33280 + rl[32 + e] + rl[400 + s]] = rl[80 + s];
  }
  __syncthreads();
}

#define tid (opaque_tid())
#define gtid ((int)(blockIdx.x * NT) + opaque_tid())
#define gstride ((int)(gridDim.x * NT))
__global__ void __launch_bounds__(NT, 2) mega(Params P) {
  cg::grid_group grid = cg::this_grid();
  __shared__ __attribute__((aligned(1024))) char shm[GEMM_LDS_TOTAL + 16 + 256 + 2560];
  float* smem = (float*)shm;
  if (threadIdx.x < 4) ((unsigned*)(shm + GEMM_LDS_TOTAL))[threadIdx.x] = 0u;
  __syncthreads();
  XcdBarrier xbar = xcd_barrier_post((unsigned*)(P.ws + WS_BAR), (volatile LAS unsigned*)(shm + GEMM_LDS_TOTAL));
  unsigned char* ws = P.ws;
  const int G = gridDim.x;
  const int vb = (G % 8 == 0) ? ((int)(blockIdx.x & 7) * (G / 8) + (int)(blockIdx.x >> 3)) : (int)blockIdx.x;
  float* tok = (float*)(ws + WS_TOK);
  bf16_t* hb = (bf16_t*)(ws + WS_H);
  float* mod = (float*)(ws + WS_MOD);
  const bf16_t* zrow = (const bf16_t*)(ws + WS_ZROW);
  unsigned char* R = ws + WS_R;

  {
    {
      float* PE = (float*)(ws + W_PE);
      for (int idx = gtid; idx < 320 * 256; idx += gstride) {
        const int p = idx >> 8, j = idx & 255;
        const float freq = expf(-9.210340371976184f * (float)j / 256.f);
        const float ang = (float)(p < 256 ? p : p - 256) * freq;
        float sv, cv; sincosf(ang, &sv, &cv);
        if (p < 256) { PE[p * 256 + j] = sv; PE[65536 + p * 256 + j] = cv; }
        else { PE[131072 + (p - 256) * 256 + j] = sv; PE[131072 + 16384 + (p - 256) * 256 + j] = cv; }
      }
    }
    {
      const float* c = P.in[1]; const float* cc = P.in[3]; const float* adaw = P.in[4];
      float* modp = (float*)(ws + WS_MODP);
      float* s_c = smem;
      for (int k = tid; k < 1024; k += NT) { const float a = c[k], b2 = cc[k]; s_c[k] = a / (1.f + expf(-a)); s_c[1024 + k] = b2 / (1.f + expf(-b2)); }
      __syncthreads();
      for (int idx = gtid; idx < 16 * 4 * 1536; idx += gstride) {
        const int ks = idx / 6144, rem = idx - ks * 6144, i = rem / 1536, j = (rem - i * 1536) * 4;
        const float* wp = adaw + ((size_t)i * 1024 + ks * 64) * 6144 + j;
        float4 a0 = make_float4(0.f, 0.f, 0.f, 0.f), a1 = a0;
        for (int kb = 0; kb < 64; kb += 8) {
          float4 w[8];
#pragma unroll
          for (int u = 0; u < 8; ++u) w[u] = *(const float4*)(wp + (size_t)(kb + u) * 6144);
#pragma unroll
          for (int u = 0; u < 8; ++u) {
            const float s0 = s_c[ks * 64 + kb + u], s1 = s_c[1024 + ks * 64 + kb + u];
            a0.x += s0 * w[u].x; a0.y += s0 * w[u].y; a0.z += s0 * w[u].z; a0.w += s0 * w[u].w;
            a1.x += s1 * w[u].x; a1.y += s1 * w[u].y; a1.z += s1 * w[u].z; a1.w += s1 * w[u].w;
          }
        }
        *(float4*)&modp[(size_t)(ks * 8 + i * 2 + 0) * 6144 + j] = a0;
        *(float4*)&modp[(size_t)(ks * 8 + i * 2 + 1) * 6144 + j] = a1;
      }
      __syncthreads();
    }
    if (gtid < 4 * 32 * 32 + 64) ((int*)(ws + WS_CNT))[gtid] = 0;
    if (gtid < 2048) ((unsigned*)(ws + WS_ZROW))[gtid] = 0u;
    bf16_t* DC = (bf16_t*)(ws + W_DC); bf16_t* DA = (bf16_t*)(ws + W_DA); bf16_t* TW = (bf16_t*)(ws + W_TW);
    for (int idx = gtid; idx < 512 * 256; idx += gstride) {
      const int row = idx >> 8, cch = idx & 255, pq = row >> 8, kc = row & 255;
      const float a = (float)((kc * cch) & 255) * (1.f / 128.f);
      DC[idx] = f2bf(pq ? -sinpif(a) : cospif(a));
    }
    for (int idx = gtid; idx < 256 * 256; idx += gstride) {
      const int row = idx >> 8, col = idx & 255, ri = row >> 7, cc2 = row & 127, rj = col >> 7, aa = col & 127;
      const float a = (float)((aa * cc2) & 127) * (1.f / 64.f);
      const float cs = cospif(a), sn = sinpif(a);
      DA[idx] = f2bf(ri == rj ? cs : (ri == 0 ? sn : -sn));
    }
    for (int idx = gtid; idx < 128 * 128 * 256; idx += gstride) {
      const int col = idx & 255, e = (idx >> 8) & 127, c2 = idx >> 15, ri = col >> 7, b = col & 127;
      const float a = (float)((b * (c2 + 128 * e)) & 16383) * (1.f / 8192.f);
      TW[idx] = f2bf(ri ? sinpif(a) : cospif(a));
    }
    for (int idx = gtid; idx < 2 * 1280; idx += gstride) ((float*)(ws + W_SP))[idx] = log1pf(expf(-P.in[34][idx]));
    {
      const float* src = P.in[36]; bf16_t* dst = (bf16_t*)(ws + W_FNIN);
      for (int idx = gtid; idx < 1024 * 1024 / 4; idx += gstride) {
        const float4 a = *(const float4*)&src[(size_t)idx * 4];
        uint2 o; o.x = pack2(a.x, a.y); o.y = pack2(a.z, a.w);
        *(uint2*)&dst[(size_t)idx * 4] = o;
      }
    }
    {
      struct CD { const float* src; bf16_t* dst; int ldn, ldk, k0, n0, mm; };
      const int NDENSE = 512 + 256 + 768 + 256 + 640 + 320 + 256 + 160;
      const int NTOT = NDENSE + 128 * 384;
      auto desc = [=](int u) -> CD {
        CD d;
        if (u < NDENSE) {
          int v = u;
          if (v < 512) { d = CD{P.in[16], (bf16_t*)(ws + W_CMIN), 2048, 1024, (v >> 5) * 64, (v & 31) * 64, 0}; return d; }
          v -= 512;
          if (v < 256) { d = CD{P.in[20], (bf16_t*)(ws + W_CMOUT), 1024, 1024, (v >> 4) * 64, (v & 15) * 64, 0}; return d; }
          v -= 256;
          if (v < 768) { d = CD{P.in[21], (bf16_t*)(ws + W_MLIN), 3088, 1024, (v / 48) * 64, (v % 48) * 64, 0}; return d; }
          v -= 768;
          if (v < 256) { d = CD{P.in[26], (bf16_t*)(ws + W_MLOUT), 1024, 1024, (v >> 4) * 64, (v & 15) * 64, 0}; return d; }
          v -= 256;
          if (v < 640) { d = CD{P.in[27], (bf16_t*)(ws + W_LRUIN), 2560, 1024, (v / 40) * 64, (v % 40) * 64, 0}; return d; }
          v -= 640;
          if (v < 320) { d = CD{P.in[35], (bf16_t*)(ws + W_LRUOUT), 1024, 1280, (v >> 4) * 64, (v & 15) * 64, 0}; return d; }
          v -= 320;
          if (v < 256) { d = CD{P.in[37], (bf16_t*)(ws + W_FNOUT), 1024, 1024, (v >> 4) * 64, (v & 15) * 64, 0}; return d; }
          v -= 256;
          const int mat = v >> 2, tl4 = v & 3, type = mat / 20, dnb = mat % 20, dd = dnb / 10, nb = dnb % 10;
          d = CD{(type ? P.in[32] : P.in[30]) + (size_t)dnb * 128 * 128, (bf16_t*)(ws + W_LRUG) + (size_t)(nb * 2 + dd) * 256 * 128,
                 128, 128, (tl4 >> 1) * 64, (tl4 & 1) * 64, type + 1};
          return d;
        }
        const int v = u - NDENSE, le = v / 384, r = v - le * 384, kind = r >> 7, tt = r & 127;
        if (kind < 2) d = CD{(kind == 0 ? P.in[13] : P.in[14]) + (size_t)le * 1024 * 512, (bf16_t*)(ws + W_EGU) + (size_t)le * 1024 * 1024,
                             512, 1024, (tt >> 3) * 64, (tt & 7) * 64, kind + 1};
        else d = CD{P.in[15] + (size_t)le * 512 * 1024, (bf16_t*)(ws + W_ED) + (size_t)le * 1024 * 512, 1024, 512, (tt >> 4) * 64, (tt & 15) * 64, 0};
        return d;
      };
      const int tq = tid, lrow = tq >> 3, c4 = (tq & 7) * 4, sn = tq >> 3, kg = (tq & 7) * 8;
      float (*tl0)[65] = (float (*)[65])smem;
      float (*tl1)[65] = (float (*)[65])(smem + 64 * 65);
      int u = blockIdx.x;
      CD d0 = desc(u < NTOT ? u : 0), d1 = desc(u + G < NTOT ? u + G : 0);
      float4 a0, b0, a1, b1;
      a0 = *(const float4*)&d0.src[(size_t)(d0.k0 + lrow) * d0.ldn + d0.n0 + c4];
      b0 = *(const float4*)&d0.src[(size_t)(d0.k0 + lrow) * d0.ldn + d0.n0 + 32 + c4];
      a1 = *(const float4*)&d1.src[(size_t)(d1.k0 + lrow) * d1.ldn + d1.n0 + c4];
      b1 = *(const float4*)&d1.src[(size_t)(d1.k0 + lrow) * d1.ldn + d1.n0 + 32 + c4];
      for (; u < NTOT; u += 2 * G) {
        const bool v1 = u + G < NTOT;
        tl0[lrow][c4 + 0] = a0.x; tl0[lrow][c4 + 1] = a0.y; tl0[lrow][c4 + 2] = a0.z; tl0[lrow][c4 + 3] = a0.w;
        tl0[lrow][32 + c4 + 0] = b0.x; tl0[lrow][32 + c4 + 1] = b0.y; tl0[lrow][32 + c4 + 2] = b0.z; tl0[lrow][32 + c4 + 3] = b0.w;
        tl1[lrow][c4 + 0] = a1.x; tl1[lrow][c4 + 1] = a1.y; tl1[lrow][c4 + 2] = a1.z; tl1[lrow][c4 + 3] = a1.w;
        tl1[lrow][32 + c4 + 0] = b1.x; tl1[lrow][32 + c4 + 1] = b1.y; tl1[lrow][32 + c4 + 2] = b1.z; tl1[lrow][32 + c4 + 3] = b1.w;
        __syncthreads();
        const CD c0 = d0, c1 = d1;
        const int un = u + 2 * G;
        if (un < NTOT) {
          d0 = desc(un); d1 = desc(un + G < NTOT ? un + G : un);
          a0 = *(const float4*)&d0.src[(size_t)(d0.k0 + lrow) * d0.ldn + d0.n0 + c4];
          b0 = *(const float4*)&d0.src[(size_t)(d0.k0 + lrow) * d0.ldn + d0.n0 + 32 + c4];
          a1 = *(const float4*)&d1.src[(size_t)(d1.k0 + lrow) * d1.ldn + d1.n0 + c4];
          b1 = *(const float4*)&d1.src[(size_t)(d1.k0 + lrow) * d1.ldn + d1.n0 + 32 + c4];
        }
        {
          uint4 o;
          o.x = pack2(tl0[kg + 0][sn], tl0[kg + 1][sn]); o.y = pack2(tl0[kg + 2][sn], tl0[kg + 3][sn]);
          o.z = pack2(tl0[kg + 4][sn], tl0[kg + 5][sn]); o.w = pack2(tl0[kg + 6][sn], tl0[kg + 7][sn]);
          const int h = c0.n0 + sn;
          const int dr = c0.mm == 0 ? h : ((h >> 3) * 16 + (h & 7) + (c0.mm == 2 ? 8 : 0));
          *(uint4*)&c0.dst[(size_t)dr * c0.ldk + c0.k0 + kg] = o;
        }
        if (v1) {
          uint4 o;
          o.x = pack2(tl1[kg + 0][sn], tl1[kg + 1][sn]); o.y = pack2(tl1[kg + 2][sn], tl1[kg + 3][sn]);
          o.z = pack2(tl1[kg + 4][sn], tl1[kg + 5][sn]); o.w = pack2(tl1[kg + 6][sn], tl1[kg + 7][sn]);
          const int h = c1.n0 + sn;
          const int dr = c1.mm == 0 ? h : ((h >> 3) * 16 + (h & 7) + (c1.mm == 2 ? 8 : 0));
          *(uint4*)&c1.dst[(size_t)dr * c1.ldk + c1.k0 + kg] = o;
        }
        __syncthreads();
      }
    }
  }
  grid.sync();
  {
    const float* modp = (const float*)(ws + WS_MODP);
    const float* adab = P.in[5];
    for (int idx = gtid; idx < 8 * 6144; idx += gstride) {
      const int is = idx / 6144, j = idx - is * 6144, i = is >> 1;
      float a = adab[i * 6144 + j];
      for (int ks = 0; ks < 16; ++ks) a += modp[(size_t)(ks * 8 + is) * 6144 + j];
      mod[idx] = a;
    }
    {
      const bf16_t* DC = (const bf16_t*)(ws + W_DC);
      const bf16_t* WI = (const bf16_t*)(ws + W_FNIN);
      bf16_t* WP = (bf16_t*)(ws + W_FNP);
      gemm_loop<4, true>(shm, 4, vb, 64, G,
        [=](int L, int r) { const int tm = L >> 2; return DC + (size_t)((tm >> 3) * 256 + (tm & 1) * 128 + r) * 256; },
        [=](int L, int cidx) { const int tm = L >> 2; return WI + (size_t)((L & 3) * 256 + cidx) * 1024 + ((tm >> 1) & 3) * 256; }, KOffL(), KOffL(),
        per_m([=](int L, int row, int col0, const f32x4 (&a)[4]) { st16bf(WP + (size_t)((L >> 2) * 128 + row) * 1024 + (L & 3) * 256 + col0, a); }));
    }
  }
  xcd_barrier(xbar);

#define MODV(i, s, j, n) mod[(size_t)(((i) * 2 + (s)) * 6 + (j)) * 1024 + (n)]

  auto resid_epi = [=](int layer, int grow, int gcol0, const f32x4 (&a)[4]) {
    const int s = grow < T_CTX ? 1 : 0;
    const float* gate = &MODV(layer, s, 2, gcol0);
    float* p = tok + (size_t)grow * DM + gcol0;
#pragma unroll
    for (int n = 0; n < 4; ++n) {
      float4 t4 = *(float4*)(p + n * 4);
      const float4 g4 = *(const float4*)(gate + n * 4);
      t4.x += g4.x * a[n][0]; t4.y += g4.y * a[n][1]; t4.z += g4.z * a[n][2]; t4.w += g4.w * a[n][3];
      *(float4*)(p + n * 4) = t4;
    }
  };

  auto moe_layer = [&](int layer, int t0) __attribute__((always_inline)) {
    ffn_norm_router_phase(P, t0, layer, smem);
    xcd_barrier(xbar);
    int* cnt = (int*)(ws + WS_CNT) + layer * 32 * 32;
    int* list = (int*)(ws + WS_LIST);
    float* asgw = (float*)(ws + WS_ASGW);
    int* ps = (int*)(shm + GEMM_LDS_TOTAL + 64);
    if (tid == 0) {
      int s = 0;
      for (int e = 0; e < 32; ++e) { ps[e] = s; s += (cnt[e * 32] + 127) / 128 * 128; }
      ps[32] = s;
    }
    __syncthreads();
    const int total = ps[32];
    bf16_t* HB = (bf16_t*)(R + R_HB);
    bf16_t* ybuf = (bf16_t*)(R + R_YBUF);
    const bf16_t* WGU = (const bf16_t*)(ws + W_EGU) + (size_t)layer * 32 * 1024 * 1024;
    const bf16_t* WD = (const bf16_t*)(ws + W_ED) + (size_t)layer * 32 * 1024 * 512;
    const int ntile = (total >> 7) * 4;
    auto blk_e = [=](int mb) { int e = 0; for (int q = 1; q < 32; ++q) if (ps[q] <= mb * 128) e = q; return e; };
    {
      gemm_loop<4, true>(shm, 16, vb, ntile, G,
        [=](int L, int r) { const int mb = L >> 2, e = blk_e(mb), rr = mb * 128 - ps[e] + r;
          return (rr < cnt[e * 32]) ? (const bf16_t*)(hb + (size_t)(list[(size_t)e * 33280 + rr] >> 1) * DM) : zrow; },
        [=](int L, int cidx) { const int e = blk_e(L >> 2); return WGU + (size_t)e * 1024 * 1024 + (size_t)((L & 3) * 256 + cidx) * 1024; },
        KOffL(), KOffL(),
        per_m([=](int L, int row, int col0, const f32x4 (&a)[4]) {
          const int n0 = (L & 3) * 256, m0 = (L >> 2) * 128;
          float hv[8];
#pragma unroll
          for (int j = 0; j < 8; ++j) { const float gv = a[j >> 2][j & 3], uv = a[2 + (j >> 2)][j & 3]; hv[j] = silu_f(gv) * uv; }
          uint4 o; o.x = pack2(hv[0], hv[1]); o.y = pack2(hv[2], hv[3]); o.z = pack2(hv[4], hv[5]); o.w = pack2(hv[6], hv[7]);
          *(uint4*)&HB[(size_t)(m0 + row) * 512 + ((n0 + col0) >> 1)] = o;
        }));
    }
    xcd_barrier(xbar);
    {
      gemm_loop<4, true>(shm, 8, vb, ntile, G,
        [=](int L, int r) { return (const bf16_t*)(HB + (size_t)((L >> 2) * 128 + r) * 512); },
        [=](int L, int cidx) { const int e = blk_e(L >> 2); return WD + (size_t)e * 1024 * 512 + (size_t)((L & 3) * 256 + cidx) * 512; },
        KOffL(), KOffL(),
        per_m([=](int L, int row, int col0, const f32x4 (&a)[4]) {
          const int mb = L >> 2, n0 = (L & 3) * 256, e = blk_e(mb), rr = mb * 128 - ps[e] + row;
          if (rr < cnt[e * 32]) {
            const int rt = list[(size_t)e * 33280 + rr];
            const float w = asgw[rt];
            f32x4 bq[4];
#pragma unroll
            for (int n = 0; n < 4; ++n) bq[n] = a[n] * w;
            st16bf(ybuf + (size_t)rt * 1024 + n0 + col0, bq);
          }
        }));
    }
    xcd_barrier(xbar);
  };

  {
    norm_phase(P, 0, P.in[6] + 0 * 1024, 0, 0, -2, 0, false, false, 0, smem);
    xcd_barrier(xbar);
    bf16_t* zu = (bf16_t*)(R + R0_ZU); bf16_t* zvT = (bf16_t*)(R + R0_ZVT); bf16_t* pb = (bf16_t*)(R + R0_P);
    bf16_t* Wsc = (bf16_t*)(R + R0_WSC);
    const float* vg = P.in[17]; const float* w_s = P.in[18]; const float* b_s = P.in[19];
    const bf16_t* Wt = (const bf16_t*)(ws + W_CMIN);
    {
      auto epi_u = [=](int grow, int gcol0, const f32x4 (&a)[4]) {
        f32x4 bq[4];
#pragma unroll
        for (int n = 0; n < 4; ++n)
#pragma unroll
          for (int j = 0; j < 4; ++j) bq[n][j] = gelu_f(a[n][j]);
        st16bf(zu + (size_t)grow * 1024 + gcol0, bq);
      };
      auto epi_v = [=](int grow0, int gcol, f32x4 v) {
        uint2 o; o.x = pack2(gelu_f(v[0]), gelu_f(v[1])); o.y = pack2(gelu_f(v[2]), gelu_f(v[3]));
        *(uint2*)&zvT[((size_t)(grow0 >> 7) * 1024 + (gcol - 1024)) * 128 + (grow0 & 127)] = o;
      };
      gemm_run<8, true>(shm, 16, vb, 256, G,
        [=](int L, int r) { return (const bf16_t*)(hb + (size_t)((1 + (L >> 2)) * 256 + r) * DM); },
        [=](int L, int cidx) { return Wt + (size_t)((L & 3) * 256 + cidx) * 1024; }, KOffL(), KOffL(),
        per_m([=](int L, int row, int col0, const f32x4 (&a)[4]) { epi_u((1 + (L >> 2)) * 256 + row, (L & 3) * 256 + col0, a); }));
      gemm_run<8, false>(shm, 16, vb, 256, G,
        [=](int L, int r) { return (const bf16_t*)(hb + (size_t)((1 + (L >> 2)) * 256 + r) * DM); },
        [=](int L, int cidx) { return Wt + (size_t)((4 + (L & 3)) * 256 + cidx) * 1024; }, KOffL(), KOffL(),
        [=](int L, int row0, int col, f32x4 v) { epi_v((1 + (L >> 2)) * 256 + row0, (4 + (L & 3)) * 256 + col, v); });
      gemm_loop<2, true>(shm, 16, vb, 16, G,
        [=](int L, int r) { return (const bf16_t*)(hb + (size_t)((L >> 2) * 64 + r) * DM); },
        [=](int L, int cidx) { return Wt + (size_t)((L & 3) * 256 + cidx) * 1024; }, KOffL(), KOffL(),
        per_m([=](int L, int row, int col0, const f32x4 (&a)[4]) { epi_u((L >> 2) * 64 + row, (L & 3) * 256 + col0, a); }));
      gemm_loop<2, false>(shm, 16, (vb - 16 + G) % G, 16, G,
        [=](int L, int r) { return (const bf16_t*)(hb + (size_t)((L >> 2) * 64 + r) * DM); },
        [=](int L, int cidx) { return Wt + (size_t)((4 + (L & 3)) * 256 + cidx) * 1024; }, KOffL(), KOffL(),
        [=](int L, int row0, int col, f32x4 v) { epi_v((L >> 2) * 64 + row0, (4 + (L & 3)) * 256 + col, v); });
    }
    xcd_barrier(xbar);
    {
      float* s_part = smem;
      float* s_rv = smem + 4096;
      for (int n = blockIdx.x; n < NCH; n += G) {
        {
          const int tq = tid, cg = tq >> 4, sg = tq & 15;
          float ss8[8];
#pragma unroll
          for (int e = 0; e < 8; ++e) ss8[e] = 0.f;
          for (int it = 0; it < 32; it += 4) {
            uint4 z[4];
#pragma unroll
            for (int u = 0; u < 4; ++u) z[u] = *(const uint4*)&zvT[((size_t)n * 1024 + (it + u) * 32 + cg) * 128 + sg * 8];
#pragma unroll
            for (int u = 0; u < 4; ++u) {
              const unsigned zz[4] = {z[u].x, z[u].y, z[u].z, z[u].w};
#pragma unroll
              for (int e = 0; e < 4; ++e) { const float a = lo2f(zz[e]), b2 = hi2f(zz[e]); ss8[2 * e] += a * a; ss8[2 * e + 1] += b2 * b2; }
            }
          }
#pragma unroll
          for (int e = 0; e < 8; ++e) s_part[cg * 128 + sg * 8 + e] = ss8[e];
        }
        __syncthreads();
        if (tid < 128) {
          float a = 0.f;
          for (int q = 0; q < 32; ++q) a += s_part[q * 128 + tid];
          s_rv[tid] = 1.f / sqrtf(a * (1.f / 1024.f) + EPSN);
        }
        __syncthreads();
        for (int idx = tid; idx < 4 * 128 * 32; idx += NT) {
          const int s4 = (idx & 31) * 4, gt = idx >> 5;
          const float4 w4 = *(const float4*)&w_s[(size_t)gt * 128 + s4];
          uint2 o; o.x = pack2(w4.x * s_rv[s4], w4.y * s_rv[s4 + 1]); o.y = pack2(w4.z * s_rv[s4 + 2], w4.w * s_rv[s4 + 3]);
          *(uint2*)&Wsc[((size_t)n * 512 + gt) * 128 + s4] = o;
        }
        __syncthreads();
      }
    }
    xcd_barrier(xbar);
    {
      gemm_loop<4, true>(shm, 2, vb, NCH * 4, G,
        [=](int L, int r) { return (const bf16_t*)(Wsc + ((size_t)(L >> 2) * 512 + (L & 3) * 128 + r) * 128); },
        [=](int L, int cidx) { return (const bf16_t*)(zvT + ((size_t)(L >> 2) * 1024 + (L & 3) * 256 + cidx) * 128); },
        KOffL(), KOffL(),
        per_m([=](int L, int row, int col0, const f32x4 (&a)[4]) {
          const int n = L >> 2, g = L & 3;
          const int t = n * 128 + row, col = g * 256 + col0;
          const float bias = b_s[g * 128 + row];
          const uint4 u0 = *(const uint4*)&zu[(size_t)t * 1024 + col], u1 = *(const uint4*)&zu[(size_t)t * 1024 + col + 8];
          const unsigned uu[8] = {u0.x, u0.y, u0.z, u0.w, u1.x, u1.y, u1.z, u1.w};
          f32x4 o[4];
#pragma unroll
          for (int nn = 0; nn < 4; ++nn) {
            const float4 g4 = *(const float4*)&vg[col + nn * 4];
            o[nn][0] = lo2f(uu[nn * 2]) * (a[nn][0] * g4.x + bias);
            o[nn][1] = hi2f(uu[nn * 2]) * (a[nn][1] * g4.y + bias);
            o[nn][2] = lo2f(uu[nn * 2 + 1]) * (a[nn][2] * g4.z + bias);
            o[nn][3] = hi2f(uu[nn * 2 + 1]) * (a[nn][3] * g4.w + bias);
          }
          st16bf(pb + (size_t)t * 1024 + col, o);
        }));
    }
    xcd_barrier(xbar);
    const bf16_t* Wo = (const bf16_t*)(ws + W_CMOUT);
    auto epi_out = [=](int grow, int gcol0, const f32x4 (&a)[4]) { resid_epi(0, grow, gcol0, a); };
    dense_phase(shm, vb, G, pb, 1024, Wo, 1024, 4, 16, true, epi_out);
    xcd_barrier(xbar);
  }
  moe_layer(0, 0);

  {
    norm_phase(P, 0, P.in[6] + 1 * 1024, 1, 0, 0, 0, false, false, 0, smem);
    xcd_barrier(xbar);
    bf16_t* ZQK = (bf16_t*)(R + R1_ZQK); bf16_t* ZO = (bf16_t*)(R + R1_ZO); bf16_t* VT = (bf16_t*)(R + R1_VT);
    float* gpre = (float*)(R + R1_GPRE); bf16_t* Qn = (bf16_t*)(R + R1_QN); bf16_t* Kn = (bf16_t*)(R + R1_KN);
    bf16_t* AS = (bf16_t*)(R + R1_AS); bf16_t* KwT = (bf16_t*)(R + R1_KWT);
    float* bc = (float*)(R + R1_BC); float* li = (float*)(R + R1_LI); float* egch = (float*)(R + R1_GCH);
    float* nloc = (float*)(R + R1_NLOC); float* nin = (float*)(R + R1_NIN);
    float* Cloc = (float*)(R + R1_CLOC); bf16_t* CinT = (bf16_t*)(R + R1_CINT); bf16_t* hnum = (bf16_t*)(R + R1_CLOC);
    bf16_t* A2 = (bf16_t*)(R + R1_A2);
    const float* w_in = P.in[21]; const float* cw = P.in[22]; const float* cb = P.in[23];
    const float* gb = P.in[24]; const float* ng = P.in[25];
    const bf16_t* Wt = (const bf16_t*)(ws + W_MLIN);
    {
      auto epi_nat = [=](int grow, int gcol0, const f32x4 (&a)[4]) {
        if (gcol0 < 1024) st16bf(ZQK + (size_t)grow * 1024 + gcol0, a); else st16bf(ZO + (size_t)grow * 1024 + gcol0 - 2048, a);
      };
      auto epi_vt = [=](int grow0, int gcol, f32x4 v) {
        uint2 o; o.x = pack2(v[0], v[1]); o.y = pack2(v[2], v[3]);
        *(uint2*)&VT[((size_t)(grow0 >> 7) * 1024 + (gcol - 1024)) * 128 + (grow0 & 127)] = o;
      };
      {
        float* wl = smem;
        const int tq = tid;
        for (int idx = tq; idx < 1024 * 4; idx += NT) {
          const int k = idx >> 2, q = idx & 3;
          const float4 w4 = *(const float4*)&w_in[(size_t)k * 3088 + 3072 + q * 4];
          const int rho = (((k >> 8) * 4 + (k & 3)) * 64) + ((k & 255) >> 2);
          *(float4*)&wl[rho * 16 + q * 4] = w4;
        }
        __syncthreads();
        const int lane = tq & 63;
        for (int t = blockIdx.x * (NT / 64) + (tq >> 6); t < T_ALL; t += G * (NT / 64)) {
          float hv[16];
#pragma unroll
          for (int j = 0; j < 4; ++j) {
            const uint2 z = *(const uint2*)&hb[(size_t)t * DM + j * 256 + lane * 4];
            hv[j * 4 + 0] = lo2f(z.x); hv[j * 4 + 1] = hi2f(z.x); hv[j * 4 + 2] = lo2f(z.y); hv[j * 4 + 3] = hi2f(z.y);
          }
          float a16[16];
#pragma unroll
          for (int j = 0; j < 16; ++j) a16[j] = 0.f;
#pragma unroll
          for (int i = 0; i < 16; ++i) {
            const float4* wr4 = (const float4*)(wl + (i * 64 + lane) * 16);
#pragma unroll
            for (int q = 0; q < 4; ++q) {
              const float4 w4 = wr4[q];
              a16[q * 4 + 0] += hv[i] * w4.x; a16[q * 4 + 1] += hv[i] * w4.y; a16[q * 4 + 2] += hv[i] * w4.z; a16[q * 4 + 3] += hv[i] * w4.w;
            }
            __builtin_amdgcn_sched_barrier(0);
          }
#pragma unroll
          for (int j = 0; j < 16; ++j) a16[j] = wave_sum(a16[j]);
          if (lane == 0) {
#pragma unroll
            for (int j = 0; j < 4; ++j) *(float4*)&gpre[(size_t)t * 16 + j * 4] = make_float4(a16[j * 4], a16[j * 4 + 1], a16[j * 4 + 2], a16[j * 4 + 3]);
          }
        }
        __syncthreads();
      }
      gemm_run<8, true>(shm, 16, vb, 512, G,
        [=](int L, int r) { return (const bf16_t*)(hb + (size_t)((1 + (L >> 3)) * 256 + r) * DM); },
        [=](int L, int cidx) { const int j = L & 7, tn = j < 4 ? j : j + 4; return Wt + (size_t)(tn * 256 + cidx) * 1024; }, KOffL(), KOffL(),
        per_m([=](int L, int row, int col0, const f32x4 (&a)[4]) { const int j = L & 7, tn = j < 4 ? j : j + 4; epi_nat((1 + (L >> 3)) * 256 + row, tn * 256 + col0, a); }));
      gemm_run<8, false>(shm, 16, vb, 256, G,
        [=](int L, int r) { return (const bf16_t*)(hb + (size_t)((1 + (L >> 2)) * 256 + r) * DM); },
        [=](int L, int cidx) { return Wt + (size_t)((4 + (L & 3)) * 256 + cidx) * 1024; }, KOffL(), KOffL(),
        [=](int L, int row0, int col, f32x4 v) { epi_vt((1 + (L >> 2)) * 256 + row0, (4 + (L & 3)) * 256 + col, v); });
      gemm_loop<2, true>(shm, 16, vb, 32, G,
        [=](int L, int r) { return (const bf16_t*)(hb + (size_t)((L >> 3) * 64 + r) * DM); },
        [=](int L, int cidx) { const int j = L & 7, tn = j < 4 ? j : j + 4; return Wt + (size_t)(tn * 256 + cidx) * 1024; }, KOffL(), KOffL(),
        per_m([=](int L, int row, int col0, const f32x4 (&a)[4]) { const int j = L & 7, tn = j < 4 ? j : j + 4; epi_nat((L >> 3) * 64 + row, tn * 256 + col0, a); }));
      gemm_loop<2, false>(shm, 16, (vb - 32 + G) % G, 16, G,
        [=](int L, int r) { return (const bf16_t*)(hb + (size_t)((L >> 2) * 64 + r) * DM); },
        [=](int L, int cidx) { return Wt + (size_t)((4 + (L & 3)) * 256 + cidx) * 1024; }, KOffL(), KOffL(),
        [=](int L, int row0, int col, f32x4 v) { epi_vt((L >> 2) * 64 + row0, (4 + (L & 3)) * 256 + col, v); });
    }
    xcd_barrier(xbar);
    {
      float* s_bc = smem;
      float* s_w  = smem + 1024;
      float* s_k  = smem + 2048;
      const int wv = tid >> 6, lane = tid & 63;
      for (int n = blockIdx.x; n < NCH; n += G) {
        {
          const int dh = wv, d = dh >> 2, hd = dh & 3;
          const int p0 = 2 * lane, p1 = p0 + 1;
          const int t0 = n * 128 + (d == 0 ? p0 : 127 - p0), t1 = n * 128 + (d == 0 ? p1 : 127 - p1);
          const float li0 = gpre[(size_t)t0 * 16 + d * 8 + hd] + gb[d * 8 + hd];
          const float li1 = gpre[(size_t)t1 * 16 + d * 8 + hd] + gb[d * 8 + hd];
          const float lf0 = logsig_f(gpre[(size_t)t0 * 16 + d * 8 + 4 + hd] + gb[d * 8 + 4 + hd]);
          const float lf1 = logsig_f(gpre[(size_t)t1 * 16 + d * 8 + 4 + hd] + gb[d * 8 + 4 + hd]);
          float run = lf0 + lf1;
#pragma unroll
          for (int o = 1; o < 64; o <<= 1) { const float y = __shfl_up(run, o); if (lane >= o) run += y; }
          const float b1 = run, b0 = run - lf1;
          const float g = __shfl(run, 63);
          bc[(size_t)dh * T_ALL + t0] = expf(b0); bc[(size_t)dh * T_ALL + t1] = expf(b1);
          li[(size_t)dh * T_ALL + t0] = expf(li0 - b0); li[(size_t)dh * T_ALL + t1] = expf(li1 - b1);
          s_bc[dh * 128 + (t0 & 127)] = b0; s_bc[dh * 128 + (t1 & 127)] = b1;
          s_w[dh * 128 + (t0 & 127)] = expf(g - b0 + li0); s_w[dh * 128 + (t1 & 127)] = expf(g - b1 + li1);
          if (lane == 0) egch[dh * NCH + n] = expf(g);
        }
        __syncthreads();
        const int lo = n < 2 ? 0 : T_CTX, hi = n < 2 ? T_CTX : T_ALL;
        for (int idx = tid; idx < 128 * 64; idx += NT) {
          const int tl = idx >> 6, c0 = (idx & 63) * 8, t = n * 128 + tl, hd = c0 >> 7;
          float q[8];
#pragma unroll
          for (int e = 0; e < 8; ++e) q[e] = cb[c0 + e];
#pragma unroll
          for (int j = 0; j < 4; ++j) {
            const int tt = t + j - 2;
            if (tt >= lo && tt < hi) {
              const uint4 z = *(const uint4*)&ZQK[(size_t)tt * 1024 + c0];
              const float4 w0 = *(const float4*)&cw[j * 1024 + c0], w1 = *(const float4*)&cw[j * 1024 + c0 + 4];
              q[0] += lo2f(z.x) * w0.x; q[1] += hi2f(z.x) * w0.y; q[2] += lo2f(z.y) * w0.z; q[3] += hi2f(z.y) * w0.w;
              q[4] += lo2f(z.z) * w1.x; q[5] += hi2f(z.z) * w1.y; q[6] += lo2f(z.w) * w1.z; q[7] += hi2f(z.w) * w1.w;
            }
          }
#pragma unroll
          for (int e = 0; e < 8; ++e) q[e] = silu_f(q[e]) * 0.08838834764831845f;
          uint4 o; o.x = pack2(q[0], q[1]); o.y = pack2(q[2], q[3]); o.z = pack2(q[4], q[5]); o.w = pack2(q[6], q[7]);
          *(uint4*)&Qn[(size_t)t * 512 + c0] = o;
#pragma unroll
          for (int d = 0; d < 2; ++d) {
            const int dh = d * 4 + hd;
            const float eb = expf(s_bc[dh * 128 + tl]);
            uint4 o2; o2.x = pack2(q[0] * eb, q[1] * eb); o2.y = pack2(q[2] * eb, q[3] * eb); o2.z = pack2(q[4] * eb, q[5] * eb); o2.w = pack2(q[6] * eb, q[7] * eb);
            *(uint4*)&AS[((size_t)dh * T_ALL + t) * 256 + 128 + (c0 & 127)] = o2;
          }
        }
        for (int hd = 0; hd < 4; ++hd) {
          for (int idx = tid; idx < 128 * 16; idx += NT) {
            const int tl = idx >> 4, k0 = (idx & 15) * 8, t = n * 128 + tl, c0 = 512 + hd * 128 + k0;
            float q[8];
#pragma unroll
            for (int e = 0; e < 8; ++e) q[e] = cb[c0 + e];
#pragma unroll
            for (int j = 0; j < 4; ++j) {
              const int tt = t + j - 2;
              if (tt >= lo && tt < hi) {
                const uint4 z = *(const uint4*)&ZQK[(size_t)tt * 1024 + c0];
                const float4 w0 = *(const float4*)&cw[j * 1024 + c0], w1 = *(const float4*)&cw[j * 1024 + c0 + 4];
                q[0] += lo2f(z.x) * w0.x; q[1] += hi2f(z.x) * w0.y; q[2] += lo2f(z.y) * w0.z; q[3] += hi2f(z.y) * w0.w;
                q[4] += lo2f(z.z) * w1.x; q[5] += hi2f(z.z) * w1.y; q[6] += lo2f(z.w) * w1.z; q[7] += hi2f(z.w) * w1.w;
              }
            }
#pragma unroll
            for (int e = 0; e < 8; ++e) { q[e] = silu_f(q[e]); s_k[tl * 129 + k0 + e] = q[e]; }
            uint4 o; o.x = pack2(q[0], q[1]); o.y = pack2(q[2], q[3]); o.z = pack2(q[4], q[5]); o.w = pack2(q[6], q[7]);
            *(uint4*)&Kn[(size_t)t * 512 + hd * 128 + k0] = o;
          }
          __syncthreads();
          for (int idx = tid; idx < 2 * 128 * 16; idx += NT) {
            const int d = idx >> 11, rem = idx & 2047, kk = rem >> 4, s0 = (rem & 15) * 8, dh = d * 4 + hd;
            float v8[8];
#pragma unroll
            for (int e = 0; e < 8; ++e) v8[e] = s_w[dh * 128 + s0 + e] * s_k[(s0 + e) * 129 + kk];
            uint4 o; o.x = pack2(v8[0], v8[1]); o.y = pack2(v8[2], v8[3]); o.z = pack2(v8[4], v8[5]); o.w = pack2(v8[6], v8[7]);
            *(uint4*)&KwT[((size_t)dh * T_ALL + n * 128 + kk) * 128 + s0] = o;
          }
          if (tid < 256) {
            const int d = tid >> 7, kk = tid & 127, dh = d * 4 + hd;
            float a = 0.f;
            for (int s2 = 0; s2 < 128; ++s2) a += s_w[dh * 128 + s2] * s_k[s2 * 129 + kk];
            nloc[(dh * NCH + n) * 128 + kk] = a;
          }
          __syncthreads();
        }
      }
    }
    xcd_barrier(xbar);
    gemm_loop<4, false>(shm, 2, vb, 1040, G,
      [=](int L, int r) { const int dh = L / NCH, n = L - dh * NCH; return (const bf16_t*)(KwT + ((size_t)dh * T_ALL + n * 128 + r) * 128); },
      [=](int L, int cidx) { const int dh = L / NCH, n = L - dh * NCH, hd = dh & 3; return (const bf16_t*)(VT + ((size_t)n * 1024 + hd * 256 + cidx) * 128); },
      KOffL(), KOffL(),
      [=](int L, int row0, int col, f32x4 v) { *(float4*)&Cloc[(size_t)L * 32768 + (size_t)col * 128 + row0] = make_float4(v[0], v[1], v[2], v[3]); });
    gemm_loop<4, true>(shm, 2, (vb - 16 + G) % G, 520, G,
      [=](int L, int r) { const int hd = L / NCH, n = L - hd * NCH; return (const bf16_t*)(Qn + (size_t)(n * 128 + r) * 512 + hd * 128); },
      [=](int L, int cidx) { const int hd = L / NCH, n = L - hd * NCH; return cidx < 128 ? (const bf16_t*)(Kn + (size_t)(n * 128 + cidx) * 512 + hd * 128) : zrow; },
      KOffL(), KOffL(),
      per_m([=](int L, int row, int col0, const f32x4 (&a)[4]) {
        const int hd = L / NCH, n = L - hd * NCH;
        if (col0 < 128) {
          const int tt = n * 128 + row;
#pragma unroll
          for (int d = 0; d < 2; ++d) {
            const int dh = d * 4 + hd;
            const float bt = bc[(size_t)dh * T_ALL + tt];
            const float* cf = li + (size_t)dh * T_ALL + n * 128 + col0;
            f32x4 o[4];
#pragma unroll
            for (int nn = 0; nn < 4; ++nn) {
              const float4 c4 = *(const float4*)(cf + nn * 4);
              const float cv[4] = {c4.x, c4.y, c4.z, c4.w};
#pragma unroll
              for (int j = 0; j < 4; ++j) {
                const int sc = col0 + nn * 4 + j;
                const bool ok = (d == 0) ? (sc <= row) : (sc >= row);
                o[nn][j] = ok ? a[nn][j] * bt * cv[j] : 0.f;
              }
            }
            st16bf(AS + ((size_t)dh * T_ALL + tt) * 256 + col0, o);
          }
        }
      }));
    xcd_barrier(xbar);
    for (int idx = gtid; idx < 8 * (32768 + 128); idx += gstride) {
      const int dh = idx / 32896, e = idx - dh * 32896, d = dh >> 2;
      float st = 0.f;
      if (e < 32768) {
        for (int ib = 0; ib < NCH; ib += 10) {
          float xv[10], gv[10];
#pragma unroll
          for (int u = 0; u < 10; ++u) { const int n = scan_order(d, ib + u); xv[u] = Cloc[(size_t)(dh * NCH + n) * 32768 + e]; gv[u] = egch[dh * NCH + n]; }
#pragma unroll
          for (int u = 0; u < 10; ++u) { const int n = scan_order(d, ib + u); CinT[(size_t)(dh * NCH + n) * 32768 + e] = f2bf(st); st = gv[u] * st + xv[u]; }
        }
      } else {
        const int kk = e - 32768;
        for (int ib = 0; ib < NCH; ib += 10) {
          float xv[10], gv[10];
#pragma unroll
          for (int u = 0; u < 10; ++u) { const int n = scan_order(d, ib + u); xv[u] = nloc[(dh * NCH + n) * 128 + kk]; gv[u] = egch[dh * NCH + n]; }
#pragma unroll
          for (int u = 0; u < 10; ++u) { const int n = scan_order(d, ib + u); nin[(dh * NCH + n) * 128 + kk] = st; st = gv[u] * st + xv[u]; }
        }
      }
    }
    xcd_barrier(xbar);
    gemm_loop<4, true>(shm, 4, vb, 1040, G,
      [=](int L, int r) { const int dh = L / NCH, n = L - dh * NCH; return (const bf16_t*)(AS + ((size_t)dh * T_ALL + n * 128 + r) * 256); },
      [=](int L, int cidx) { const int dh = L / NCH, n = L - dh * NCH, hd = dh & 3; return (const bf16_t*)(VT + ((size_t)n * 1024 + hd * 256 + cidx) * 128); },
      KOffL(),
      [=](int L, int kt) { const int dh = L / NCH, n = L - dh * NCH, hd = dh & 3;
        const int delta = (int)((CinT + (size_t)L * 32768) - (VT + ((size_t)n * 1024 + hd * 256) * 128));
        return kt < 2 ? kt * 64 : delta + (kt - 2) * 64; },
      per_m([=](int L, int row, int col0, const f32x4 (&a)[4]) {
        const int dh = L / NCH, n = L - dh * NCH;
        st16bf(hnum + ((size_t)dh * T_ALL + n * 128 + row) * 256 + col0, a);
      }));
    xcd_barrier(xbar);
    {
      const int tq = tid, lane = tq & 63, hd = lane >> 4, l16 = lane & 15;
      for (int tt = blockIdx.x * (NT / 64) + (tq >> 6); tt < T_ALL; tt += G * (NT / 64)) {
        const int n = tt >> 7;
        float hs[16];
#pragma unroll
        for (int e = 0; e < 16; ++e) hs[e] = 0.f;
#pragma unroll
        for (int d = 0; d < 2; ++d) {
          const int dh = d * 4 + hd;
          const size_t m = (size_t)dh * T_ALL + tt;
          const uint4 a0 = *(const uint4*)&AS[m * 256 + l16 * 16], a1 = *(const uint4*)&AS[m * 256 + l16 * 16 + 8];
          const uint4 x0 = *(const uint4*)&hnum[m * 256 + l16 * 16], x1 = *(const uint4*)&hnum[m * 256 + l16 * 16 + 8];
          const unsigned aa[8] = {a0.x, a0.y, a0.z, a0.w, a1.x, a1.y, a1.z, a1.w};
          float part = 0.f;
          if (l16 < 8) {
#pragma unroll
            for (int e = 0; e < 8; ++e) part += lo2f(aa[e]) + hi2f(aa[e]);
          } else {
            const float* np = nin + (dh * NCH + n) * 128 + (l16 - 8) * 16;
#pragma unroll
            for (int e = 0; e < 4; ++e) {
              const float4 nv = *(const float4*)(np + e * 4);
              part += lo2f(aa[2 * e]) * nv.x + hi2f(aa[2 * e]) * nv.y + lo2f(aa[2 * e + 1]) * nv.z + hi2f(aa[2 * e + 1]) * nv.w;
            }
          }
          part += __shfl_xor(part, 8); part += __shfl_xor(part, 4); part += __shfl_xor(part, 2); part += __shfl_xor(part, 1);
          const float dn = 1.f / fmaxf(fabsf(part), 1.f);
          const unsigned xx[8] = {x0.x, x0.y, x0.z, x0.w, x1.x, x1.y, x1.z, x1.w};
#pragma unroll
          for (int e = 0; e < 8; ++e) { hs[2 * e] += lo2f(xx[e]) * dn; hs[2 * e + 1] += hi2f(xx[e]) * dn; }
        }
        float ss = 0.f;
#pragma unroll
        for (int e = 0; e < 16; ++e) ss += hs[e] * hs[e];
        ss += __shfl_xor(ss, 8); ss += __shfl_xor(ss, 4); ss += __shfl_xor(ss, 2); ss += __shfl_xor(ss, 1);
        const float r = 1.f / sqrtf(ss * (1.f / 256.f) + EPSN);
        const int col = hd * 256 + l16 * 16;
        const uint4 o0 = *(const uint4*)&ZO[(size_t)tt * 1024 + col], o1 = *(const uint4*)&ZO[(size_t)tt * 1024 + col + 8];
        const unsigned oo[8] = {o0.x, o0.y, o0.z, o0.w, o1.x, o1.y, o1.z, o1.w};
        unsigned res[8];
#pragma unroll
        for (int e = 0; e < 4; ++e) {
          const float4 g4 = *(const float4*)&ng[col + e * 4];
          res[2 * e]     = pack2(hs[4 * e + 0] * r * g4.x * sigmoid_f(lo2f(oo[2 * e])),     hs[4 * e + 1] * r * g4.y * sigmoid_f(hi2f(oo[2 * e])));
          res[2 * e + 1] = pack2(hs[4 * e + 2] * r * g4.z * sigmoid_f(lo2f(oo[2 * e + 1])), hs[4 * e + 3] * r * g4.w * sigmoid_f(hi2f(oo[2 * e + 1])));
        }
        *(uint4*)&A2[(size_t)tt * 1024 + col] = make_uint4(res[0], res[1], res[2], res[3]);
        *(uint4*)&A2[(size_t)tt * 1024 + col + 8] = make_uint4(res[4], res[5], res[6], res[7]);
      }
    }
    xcd_barrier(xbar);
    const bf16_t* Wo = (const bf16_t*)(ws + W_MLOUT);
    auto epi_out = [=](int grow, int gcol0, const f32x4 (&a)[4]) { resid_epi(1, grow, gcol0, a); };
    dense_phase(shm, vb, G, A2, 1024, Wo, 1024, 4, 16, true, epi_out);
    xcd_barrier(xbar);
  }
  moe_layer(1, 0);

  {
    norm_phase(P, 0, P.in[6] + 2 * 1024, 2, 0, 1, 0, false, false, 0, smem);
    xcd_barrier(xbar);
    bf16_t* Zg = (bf16_t*)(R + R2_ZG); bf16_t* Zx = (bf16_t*)(R + R2_ZX); bf16_t* xc = (bf16_t*)(R + R2_XC);
    bf16_t* LA = (bf16_t*)(R + R2_LA); bf16_t* U = (bf16_t*)(R + R2_U);
    float* cA = (float*)(R + R2_CA); float* cH = (float*)(R + R2_CH);
    float* cin = (float*)(R + R2_CIN); bf16_t* A3 = (bf16_t*)(R + R2_ZX);
    const float* cw = P.in[28]; const float* cb = P.in[29];
    const float* b_a = P.in[31]; const float* b_x = P.in[33];
    const float* SP = (const float*)(ws + W_SP);
    const bf16_t* Wt = (const bf16_t*)(ws + W_LRUIN);
    auto epi_in = [=](int grow, int gcol0, const f32x4 (&a)[4]) {
      if (gcol0 < 1280) {
        f32x4 bq[4];
#pragma unroll
        for (int n = 0; n < 4; ++n)
#pragma unroll
          for (int j = 0; j < 4; ++j) bq[n][j] = gelu_f(a[n][j]);
        st16bf(Zg + (size_t)grow * 1280 + gcol0, bq);
      } else st16bf(Zx + (size_t)grow * 1280 + gcol0 - 1280, a);
    };
    dense_phase(shm, vb, G, hb, 1024, Wt, 1024, 10, 16, true, epi_in);
    xcd_barrier(xbar);
    for (int idx = gtid; idx < T_ALL * 160; idx += gstride) {
      const int t = idx / 160, c0 = (idx - t * 160) * 8;
      const int lo = t < T_CTX ? 0 : T_CTX, hi = t < T_CTX ? T_CTX : T_ALL;
      float q[8];
#pragma unroll
      for (int e = 0; e < 8; ++e) q[e] = cb[c0 + e];
#pragma unroll
      for (int j = 0; j < 4; ++j) {
        const int tt = t + j - 2;
        if (tt >= lo && tt < hi) {
          const uint4 z = *(const uint4*)&Zx[(size_t)tt * 1280 + c0];
          const float4 w0 = *(const float4*)&cw[j * 1280 + c0], w1 = *(const float4*)&cw[j * 1280 + c0 + 4];
          q[0] += lo2f(z.x) * w0.x; q[1] += hi2f(z.x) * w0.y; q[2] += lo2f(z.y) * w0.z; q[3] += hi2f(z.y) * w0.w;
          q[4] += lo2f(z.z) * w1.x; q[5] += hi2f(z.z) * w1.y; q[6] += lo2f(z.w) * w1.z; q[7] += hi2f(z.w) * w1.w;
        }
      }
      uint4 o; o.x = pack2(q[0], q[1]); o.y = pack2(q[2], q[3]); o.z = pack2(q[4], q[5]); o.w = pack2(q[6], q[7]);
      *(uint4*)&xc[(size_t)t * 1280 + c0] = o;
    }
    xcd_barrier(xbar);
    {
      const bf16_t* WLG = (const bf16_t*)(ws + W_LRUG);
      {
        gemm_run<8, true>(shm, 2, vb, 65 * 20, G,
          [=](int L, int r) { return (const bf16_t*)(xc + (size_t)((L / 20) * 256 + r) * 1280 + ((L % 20) >> 1) * 128); },
          [=](int L, int cidx) { return WLG + ((size_t)(L % 20) * 256 + cidx) * 128; },
          KOffL(), KOffL(),
          [=](int L, int rb, int col0, const f32x4 (&a)[8][4]) {
            const int m0 = (L / 20) * 256, q = L % 20, nb = q >> 1, d = q & 1;
            const int c = nb * 128 + (col0 >> 1);
            float ba[8], bx[8], sp8[8];
            {
              const float4 t0 = *(const float4*)&b_a[d * 1280 + c], t1 = *(const float4*)&b_a[d * 1280 + c + 4];
              const float4 t2 = *(const float4*)&b_x[d * 1280 + c], t3 = *(const float4*)&b_x[d * 1280 + c + 4];
              const float4 t4 = *(const float4*)&SP[d * 1280 + c], t5 = *(const float4*)&SP[d * 1280 + c + 4];
              ba[0] = t0.x; ba[1] = t0.y; ba[2] = t0.z; ba[3] = t0.w; ba[4] = t1.x; ba[5] = t1.y; ba[6] = t1.z; ba[7] = t1.w;
              bx[0] = t2.x; bx[1] = t2.y; bx[2] = t2.z; bx[3] = t2.w; bx[4] = t3.x; bx[5] = t3.y; bx[6] = t3.z; bx[7] = t3.w;
              sp8[0] = -8.f * t4.x; sp8[1] = -8.f * t4.y; sp8[2] = -8.f * t4.z; sp8[3] = -8.f * t4.w;
              sp8[4] = -8.f * t5.x; sp8[5] = -8.f * t5.y; sp8[6] = -8.f * t5.z; sp8[7] = -8.f * t5.w;
            }
#pragma unroll
            for (int m = 0; m < 8; ++m) {
              const int t = m0 + rb + 16 * m;
              const uint4 xv = *(const uint4*)&xc[(size_t)t * 1280 + c];
              const unsigned xx[4] = {xv.x, xv.y, xv.z, xv.w};
              float la8[8], u8[8];
#pragma unroll
              for (int e = 0; e < 8; ++e) {
                const float ra = a[m][e >> 2][e & 3] + ba[e];
                const float rx = a[m][2 + (e >> 2)][e & 3] + bx[e];
                const float la = sigmoid_f(ra) * sp8[e];
                const float x2 = 2.f * la;
                const float em = -x2 * (1.f + x2 * (0.5f + x2 * (0.16666667f + x2 * (0.041666668f + x2 * (0.0083333338f + x2 * 0.0013888889f)))));
                const float xe = (e & 1) ? hi2f(xx[e >> 1]) : lo2f(xx[e >> 1]);
                la8[e] = la;
                u8[e] = __builtin_amdgcn_sqrtf(em) * (sigmoid_f(rx) * xe);
              }
              uint4 o1, o2;
              o1.x = pack2(la8[0], la8[1]); o1.y = pack2(la8[2], la8[3]); o1.z = pack2(la8[4], la8[5]); o1.w = pack2(la8[6], la8[7]);
              o2.x = pack2(u8[0], u8[1]); o2.y = pack2(u8[2], u8[3]); o2.z = pack2(u8[4], u8[5]); o2.w = pack2(u8[6], u8[7]);
              *(uint4*)&LA[((size_t)d * T_ALL + t) * 1280 + c] = o1;
              *(uint4*)&U[((size_t)d * T_ALL + t) * 1280 + c] = o2;
            }
          });
      }
    }
    xcd_barrier(xbar);
    for (int idx = gtid; idx < 2 * NCH * 640; idx += gstride) {
      const int c = (idx % 640) * 2, dn = idx / 640, n = dn % NCH, d = dn / NCH;
      const bf16_t* la_p = LA + (size_t)d * T_ALL * 1280 + c;
      const bf16_t* u_p = U + (size_t)d * T_ALL * 1280 + c;
      float h0 = 0.f, h1 = 0.f, s0 = 0.f, s1 = 0.f;
      for (int sb = 0; sb < 128; sb += 16) {
        unsigned lv[16], uv[16];
#pragma unroll
        for (int e = 0; e < 16; ++e) {
          const size_t o = (size_t)(n * 128 + (d == 0 ? sb + e : 127 - sb - e)) * 1280;
          lv[e] = *(const unsigned*)(la_p + o); uv[e] = *(const unsigned*)(u_p + o);
        }
#pragma unroll
        for (int e = 0; e < 16; ++e) {
          const float l0 = lo2f(lv[e]), l1 = hi2f(lv[e]);
          h0 = __expf(l0) * h0 + lo2f(uv[e]); h1 = __expf(l1) * h1 + hi2f(uv[e]);
          s0 += l0; s1 += l1;
        }
      }
      *(float2*)&cA[(d * NCH + n) * 1280 + c] = make_float2(__expf(s0), __expf(s1));
      *(float2*)&cH[(d * NCH + n) * 1280 + c] = make_float2(h0, h1);
    }
    xcd_barrier(xbar);
    for (int idx = gtid; idx < 2 * 1280; idx += gstride) {
      const int d = idx / 1280, c = idx - d * 1280;
      float st = 0.f;
      for (int ib = 0; ib < NCH; ib += 10) {
        float av[10], hv[10];
#pragma unroll
        for (int u = 0; u < 10; ++u) { const int q = (d * NCH + scan_order(d, ib + u)) * 1280 + c; av[u] = cA[q]; hv[u] = cH[q]; }
#pragma unroll
        for (int u = 0; u < 10; ++u) { const int q = (d * NCH + scan_order(d, ib + u)) * 1280 + c; cin[q] = st; st = av[u] * st + hv[u]; }
      }
    }
    xcd_barrier(xbar);
    for (int idx = gtid; idx < 128 * 640; idx += gstride) {
      const int c = (idx % 640) * 2, n = 2 + idx / 640;
      float h0, h1;
      { const float2 c2 = *(const float2*)&cin[(0 * NCH + n) * 1280 + c]; h0 = c2.x; h1 = c2.y; }
      for (int sb = 0; sb < 128; sb += 16) {
        unsigned lv[16], uv[16];
#pragma unroll
        for (int e = 0; e < 16; ++e) { const size_t o = (size_t)(n * 128 + sb + e) * 1280 + c; lv[e] = *(const unsigned*)&LA[o]; uv[e] = *(const unsigned*)&U[o]; }
#pragma unroll
        for (int e = 0; e < 16; ++e) {
          h0 = __expf(lo2f(lv[e])) * h0 + lo2f(uv[e]); h1 = __expf(hi2f(lv[e])) * h1 + hi2f(uv[e]);
          *(unsigned*)&A3[(size_t)(n * 128 + sb + e) * 1280 + c] = pack2(h0, h1);
        }
      }
      { const float2 c2 = *(const float2*)&cin[(1 * NCH + n) * 1280 + c]; h0 = c2.x; h1 = c2.y; }
      for (int sb = 0; sb < 128; sb += 16) {
        unsigned lv[16], uv[16], gv[16], hp[16];
#pragma unroll
        for (int e = 0; e < 16; ++e) {
          const size_t o = (size_t)(n * 128 + 127 - sb - e) * 1280 + c;
          lv[e] = *(const unsigned*)&LA[(size_t)T_ALL * 1280 + o]; uv[e] = *(const unsigned*)&U[(size_t)T_ALL * 1280 + o];
          gv[e] = *(const unsigned*)&Zg[o]; hp[e] = *(const unsigned*)&A3[o];
        }
#pragma unroll
        for (int e = 0; e < 16; ++e) {
          h0 = __expf(lo2f(lv[e])) * h0 + lo2f(uv[e]); h1 = __expf(hi2f(lv[e])) * h1 + hi2f(uv[e]);
          *(unsigned*)&A3[(size_t)(n * 128 + 127 - sb - e) * 1280 + c] = pack2(lo2f(gv[e]) * (lo2f(hp[e]) + h0), hi2f(gv[e]) * (hi2f(hp[e]) + h1));
        }
      }
    }
    xcd_barrier(xbar);
    const bf16_t* Wo = (const bf16_t*)(ws + W_LRUOUT);
    auto epi_out = [=](int grow, int gcol0, const f32x4 (&a)[4]) { resid_epi(2, grow, gcol0, a); };
    dense_phase(shm, vb, G, A3, 1280, Wo, 1280, 4, 20, false, epi_out);
    xcd_barrier(xbar);
  }
  moe_layer(2, T_CTX);

  {
    norm_phase(P, T_CTX, P.in[6] + 3 * 1024, 3, 0, 2, T_CTX, false, false, 0, smem);
    xcd_barrier(xbar);
    bf16_t* YT = (bf16_t*)(R + R3_YT); bf16_t* GT = (bf16_t*)(R + R3_GT); bf16_t* Ff = (bf16_t*)(R + R3_FF);
    const bf16_t* WP = (const bf16_t*)(ws + W_FNP);
    gemm_run<8, false>(shm, 16, vb, 64 * 8, G,
      [=](int L, int r) { return (const bf16_t*)(hb + (size_t)(T_CTX + 128 * (r & 127) + 2 * (L >> 3) + (r >> 7)) * DM); },
      [=](int L, int cidx) { return WP + (size_t)((L & 7) * 256 + cidx) * 1024; }, KOffL(), KOffL(),
      [=](int L, int row0, int col, f32x4 v) {
        const int b = 2 * (L >> 3) + (row0 >> 7), a0 = row0 & 127, n0 = (L & 7) * 256;
        uint2 o; o.x = pack2(v[0], v[1]); o.y = pack2(v[2], v[3]);
        *(uint2*)&YT[((size_t)b * 2048 + n0 + col) * 128 + a0] = o;
      });
    xcd_barrier(xbar);
    {
      const bf16_t* DA = (const bf16_t*)(ws + W_DA);
      gemm_loop<4, false>(shm, 4, vb, 1024, G,
        [=](int L, int r) { return (const bf16_t*)(YT + ((size_t)r * 2048 + L) * 128); },
        [=](int L, int cidx) { return DA + (size_t)cidx * 256; },
        [=](int L, int kt) { return kt < 2 ? kt * 64 : 1024 * 128 + (kt - 2) * 64; }, KOffL(),
        [=](int L, int row0, int col, f32x4 v) {
          const int ri = col >> 7, c2 = col & 127;
          uint2 o; o.x = pack2(v[0], v[1]); o.y = pack2(v[2], v[3]);
          *(uint2*)&GT[(((size_t)c2 * 1024 + L) * 2 + ri) * 128 + row0] = o;
        });
    }
    xcd_barrier(xbar);
    {
      const bf16_t* TW = (const bf16_t*)(ws + W_TW);
      gemm_loop<4, true>(shm, 4, vb, 128 * 4, G,
        [=](int L, int r) { return TW + ((size_t)(L >> 2) * 128 + r) * 256; },
        [=](int L, int cidx) { return (const bf16_t*)(GT + ((size_t)(L >> 2) * 1024 + (L & 3) * 256 + cidx) * 256); }, KOffL(), KOffL(),
        per_m([=](int L, int row, int col0, const f32x4 (&a)[4]) {
          const int c2 = L >> 2, n0 = (L & 3) * 256;
          f32x4 b[4];
#pragma unroll
          for (int n = 0; n < 4; ++n) b[n] = a[n] * (1.f / 2048.f);
          st16bf(Ff + (size_t)(c2 + 128 * row) * 1024 + n0 + col0, b);
        }));
    }
    xcd_barrier(xbar);
    const bf16_t* Wo = (const bf16_t*)(ws + W_FNOUT);
    const bf16_t* FfA = Ff - (size_t)T_CTX * 1024;
    auto epi_out = [=](int grow, int gcol0, const f32x4 (&a)[4]) { resid_epi(3, grow, gcol0, a); };
    dense_phase(shm, vb, G, FfA, 1024, Wo, 1024, 4, 16, false, epi_out);
    xcd_barrier(xbar);
  }
  moe_layer(3, T_CTX);

  norm_phase(P, T_CTX, P.in[8], 0, -1, 3, T_CTX, true, false, 0, smem);
}

#undef tid
#undef gtid
#undef gstride
extern "C" void kernel_launch(void* const* d_in, const int* in_sizes, int n_in, void* d_out, int out_size,
                              void* d_ws, size_t ws_size, hipStream_t stream) {
  static int grid_blocks = 0;
  if (!grid_blocks) {
    int dev = 0, cus = 0, per_cu = 0;
    (void)hipGetDevice(&dev);
    (void)hipDeviceGetAttribute(&cus, hipDeviceAttributeMultiprocessorCount, dev);
    (void)hipOccupancyMaxActiveBlocksPerMultiprocessor(&per_cu, mega, NT, 0);
    if (per_cu < 1) fprintf(stderr, "kernel_launch: occupancy query says %d blocks/CU\n", per_cu);
    grid_blocks = cus;
    if (ws_size < WS_NEED) fprintf(stderr, "kernel_launch: workspace too small: %zu < %zu\n", ws_size, (size_t)WS_NEED);
  }
  if (n_in != 38 || ws_size < WS_NEED) return;
  Params p{};
  for (int i = 0; i < 38; ++i) p.in[i] = (const float*)d_in[i];
  p.out = (float*)d_out;
  p.ws = (unsigned char*)d_ws;
  (void)hipMemsetAsync((char*)d_ws + WS_BAR, 0, 16384, stream);
  void* args[] = {&p};
  hipError_t e = hipLaunchCooperativeKernel((void*)mega, dim3(grid_blocks), dim3(NT), args, 0, stream);
  if (e != hipSuccess) fprintf(stderr, "cooperative launch failed: %s (grid %d)\n", hipGetErrorString(e), grid_blocks);
}
```

```cpp
#include <hip/hip_runtime.h>
#include <hip/hip_cooperative_groups.h>
#include <cstdio>
namespace cg = cooperative_groups;

#define T_ALL 16640
#define T_LAT 16384
#define T_CTX 256
#define DM 1024
#define NCH 130
#define EPSN 1e-6f
#define NT 512

typedef unsigned short bf16_t;
using bf16x8 = __attribute__((ext_vector_type(8))) short;
using f32x4 = __attribute__((ext_vector_type(4))) float;

__device__ __forceinline__ float bf2f(bf16_t v) { return __uint_as_float(((unsigned)v) << 16); }
__device__ __forceinline__ bf16_t f2bf(float f) { const __bf16 h = (__bf16)f; return __builtin_bit_cast(unsigned short, h); }
__device__ __forceinline__ unsigned pack2(float a, float b) {
  typedef __attribute__((ext_vector_type(2))) float f32x2_t;
  typedef __attribute__((ext_vector_type(2))) __bf16 bf16x2_t;
  const f32x2_t f = {a, b};
  const bf16x2_t h = __builtin_convertvector(f, bf16x2_t);
  return __builtin_bit_cast(unsigned, h);
}
__device__ __forceinline__ float lo2f(unsigned u) { return __uint_as_float(u << 16); }
__device__ __forceinline__ float hi2f(unsigned u) { return __uint_as_float(u & 0xffff0000u); }

__device__ __forceinline__ int opaque_tid() { int t = threadIdx.x; asm volatile("" : "+v"(t)); return t; }

__device__ __forceinline__ float4 ntload4(const float* p) {
  typedef __attribute__((ext_vector_type(4))) float f4v;
  const f4v v = __builtin_nontemporal_load((const f4v*)p);
  return make_float4(v[0], v[1], v[2], v[3]);
}

constexpr size_t AL(size_t x) { return (x + 255) & ~(size_t)255; }
constexpr size_t WS_MOD    = 0;
constexpr size_t WS_MODP   = AL(WS_MOD + 4 * 2 * 6144 * 4);
constexpr size_t WS_CNT    = AL(WS_MODP + 16 * 4 * 2 * 6144 * 4);
constexpr size_t WS_ZROW   = AL(WS_CNT + 4 * 32 * 32 * 4 + 256);
constexpr size_t WS_BAR    = AL(WS_ZROW + 8192);
constexpr size_t WS_TOK    = AL(WS_BAR + 16384);
constexpr size_t WS_H      = AL(WS_TOK + (size_t)T_ALL * DM * 4);
constexpr size_t WS_HLO    = AL(WS_H + (size_t)T_ALL * DM * 2);
constexpr size_t WS_ASGW   = AL(WS_HLO + (size_t)T_ALL * DM * 2);
constexpr size_t WS_LIST   = AL(WS_ASGW + 33280 * 4);
constexpr size_t WS_ROWTOK = AL(WS_LIST + (size_t)32 * 33280 * 4);
constexpr size_t WS_ROWEXP = AL(WS_ROWTOK + 37376 * 4);
constexpr size_t W_CMIN   = AL(WS_ROWEXP + 292 * 4);
constexpr size_t W_CMOUT  = AL(W_CMIN + (size_t)2048 * 1024 * 2);
constexpr size_t W_MLIN   = AL(W_CMOUT + (size_t)1024 * 1024 * 2);
constexpr size_t W_MLOUT  = AL(W_MLIN + (size_t)3072 * 1024 * 2);
constexpr size_t W_LRUIN  = AL(W_MLOUT + (size_t)1024 * 1024 * 2);
constexpr size_t W_LRUOUT = AL(W_LRUIN + (size_t)2560 * 1024 * 2);
constexpr size_t W_FNIN   = AL(W_LRUOUT + (size_t)1024 * 1280 * 2);
constexpr size_t W_FNP    = AL(W_FNIN + (size_t)1024 * 1024 * 2);
constexpr size_t W_FNOUT  = AL(W_FNP + (size_t)2048 * 1024 * 2);
constexpr size_t W_DC     = AL(W_FNOUT + (size_t)1024 * 1024 * 2);
constexpr size_t W_DA     = AL(W_DC + 512 * 256 * 2);
constexpr size_t W_TW     = AL(W_DA + 256 * 256 * 2);
constexpr size_t W_LRUG   = AL(W_TW + (size_t)128 * 128 * 256 * 2);
constexpr size_t W_SP     = AL(W_LRUG + (size_t)20 * 256 * 128 * 2);
constexpr size_t W_PE     = AL(W_SP + 2 * 1280 * 4);
constexpr size_t W_EGU    = AL(W_PE + (size_t)(2 * 256 + 2 * 64) * 256 * 4);
constexpr size_t W_ED     = AL(W_EGU + (size_t)128 * 1024 * 1024 * 2);
constexpr size_t WS_R     = AL(W_ED + (size_t)128 * 1024 * 512 * 2);
constexpr size_t R_YBUF = 0;
constexpr size_t R_HB   = AL(R_YBUF + (size_t)33280 * 1024 * 2);
constexpr size_t R_MOE_END = AL(R_HB + (size_t)37376 * 512 * 2);
constexpr size_t R0_ZU  = 0;
constexpr size_t R0_ZVT = AL(R0_ZU + (size_t)T_ALL * 1024 * 2);
constexpr size_t R0_P   = AL(R0_ZVT + (size_t)T_ALL * 1024 * 2);
constexpr size_t R0_WSC = AL(R0_P + (size_t)T_ALL * 1024 * 2);
constexpr size_t R0_END = AL(R0_WSC + (size_t)NCH * 4 * 128 * 128 * 2);
constexpr size_t R1_ZQK  = 0;
constexpr size_t R1_ZO   = AL(R1_ZQK + (size_t)T_ALL * 1024 * 2);
constexpr size_t R1_VT   = AL(R1_ZO + (size_t)T_ALL * 1024 * 2);
constexpr size_t R1_GPRE = AL(R1_VT + (size_t)T_ALL * 1024 * 2);
constexpr size_t R1_QN   = AL(R1_GPRE + (size_t)T_ALL * 16 * 4);
constexpr size_t R1_KN   = AL(R1_QN + (size_t)T_ALL * 512 * 2);
constexpr size_t R1_AS   = AL(R1_KN + (size_t)T_ALL * 512 * 2);
constexpr size_t R1_KWT  = AL(R1_AS + (size_t)8 * T_ALL * 256 * 2);
constexpr size_t R1_BC   = AL(R1_KWT + (size_t)8 * T_ALL * 128 * 2);
constexpr size_t R1_LI   = AL(R1_BC + (size_t)8 * T_ALL * 4);
constexpr size_t R1_GCH  = AL(R1_LI + (size_t)8 * T_ALL * 4);
constexpr size_t R1_NLOC = AL(R1_GCH + 8 * NCH * 4);
constexpr size_t R1_NIN  = AL(R1_NLOC + 8 * NCH * 128 * 4);
constexpr size_t R1_CLOC = AL(R1_NIN + 8 * NCH * 128 * 4);
constexpr size_t R1_CINT = AL(R1_CLOC + (size_t)8 * T_ALL * 256 * 4);
constexpr size_t R1_HDEN = AL(R1_CINT + (size_t)8 * T_ALL * 256 * 2);
constexpr size_t R1_A2   = R1_ZQK;
constexpr size_t R1_END  = AL(R1_HDEN + 256);
constexpr size_t R2_ZG  = 0;
constexpr size_t R2_ZX  = AL(R2_ZG + (size_t)T_ALL * 1280 * 2);
constexpr size_t R2_XC  = AL(R2_ZX + (size_t)T_ALL * 1280 * 2);
constexpr size_t R2_LA  = AL(R2_XC + (size_t)T_ALL * 1280 * 2);
constexpr size_t R2_U   = AL(R2_LA + (size_t)2 * T_ALL * 1280 * 2);
constexpr size_t R2_CA  = AL(R2_U + (size_t)2 * T_ALL * 1280 * 2);
constexpr size_t R2_CH  = AL(R2_CA + 2 * NCH * 1280 * 4);
constexpr size_t R2_CIN = AL(R2_CH + 2 * NCH * 1280 * 4);
constexpr size_t R2_END = AL(R2_CIN + 2 * NCH * 1280 * 4);
constexpr size_t R3_YT = 0;
constexpr size_t R3_GT = AL(R3_YT + (size_t)128 * 2048 * 128 * 2);
constexpr size_t R3_FF = AL(R3_GT + (size_t)128 * 2048 * 128 * 2);
constexpr size_t R3_END = AL(R3_FF + (size_t)T_LAT * 1024 * 2);
constexpr size_t cmax(size_t a, size_t b) { return a > b ? a : b; }
constexpr size_t R_SIZE = cmax(cmax(R_MOE_END, R0_END), cmax(cmax(R1_END, R2_END), R3_END));
constexpr size_t WS_NEED = WS_R + R_SIZE;

struct Params { const float* in[38]; float* out; unsigned char* ws; };

__device__ __forceinline__ float sigmoid_f(float x) { return __builtin_amdgcn_rcpf(1.f + __expf(-x)); }
__device__ __forceinline__ float silu_f(float x) { return x * __builtin_amdgcn_rcpf(1.f + __expf(-x)); }
__device__ __forceinline__ float gelu_f(float x) {
  const float u2 = 1.5957691216057308f * (x + 0.044715f * x * x * x);
  return x * __builtin_amdgcn_rcpf(1.f + __expf(-u2));
}
__device__ __forceinline__ float logsig_f(float x) { return fminf(x, 0.f) - log1pf(expf(-fabsf(x))); }
__device__ __forceinline__ float dpp_add(float v, const int ctrl_sel) {
  int x = __float_as_int(v), y;
  if (ctrl_sel == 0) y = __builtin_amdgcn_mov_dpp(x, 0xB1, 0xf, 0xf, false);
  else if (ctrl_sel == 1) y = __builtin_amdgcn_mov_dpp(x, 0x4E, 0xf, 0xf, false);
  else if (ctrl_sel == 2) y = __builtin_amdgcn_mov_dpp(x, 0x141, 0xf, 0xf, false);
  else y = __builtin_amdgcn_mov_dpp(x, 0x140, 0xf, 0xf, false);
  return v + __int_as_float(y);
}
__device__ __forceinline__ float wave_sum(float v) {
  v = dpp_add(v, 0); v = dpp_add(v, 1); v = dpp_add(v, 2); v = dpp_add(v, 3);
  {
    const unsigned x = __float_as_uint(v);
    const auto r = __builtin_amdgcn_permlane16_swap(x, x, false, false);
    v = __uint_as_float(r[0]) + __uint_as_float(r[1]);
  }
  {
    const unsigned x = __float_as_uint(v);
    const auto r = __builtin_amdgcn_permlane32_swap(x, x, false, false);
    v = __uint_as_float(r[0]) + __uint_as_float(r[1]);
  }
  return v;
}
__device__ __forceinline__ float reduce36(const float (&l)[36], int lane) {
  float res = 0.f;
  const int l31 = lane & 31;
#pragma unroll
  for (int q = 0; q < 18; ++q) {
    const auto r = __builtin_amdgcn_permlane32_swap(__float_as_uint(l[2 * q]), __float_as_uint(l[2 * q + 1]), false, false);
    float v = __uint_as_float(r[0]) + __uint_as_float(r[1]);
    v = dpp_add(v, 0); v = dpp_add(v, 1); v = dpp_add(v, 2); v = dpp_add(v, 3);
    const unsigned x = __float_as_uint(v);
    const auto s = __builtin_amdgcn_permlane16_swap(x, x, false, false);
    v = __uint_as_float(s[0]) + __uint_as_float(s[1]);
    if (l31 == q) res = v;
  }
  return res;
}
__device__ __forceinline__ float fold_pair_sum(float x, float y) {
  const auto r = __builtin_amdgcn_permlane32_swap(__float_as_uint(x), __float_as_uint(y), false, false);
  float v = __uint_as_float(r[0]) + __uint_as_float(r[1]);
  v = dpp_add(v, 0); v = dpp_add(v, 1); v = dpp_add(v, 2); v = dpp_add(v, 3);
  const unsigned u = __float_as_uint(v);
  const auto s = __builtin_amdgcn_permlane16_swap(u, u, false, false);
  return __uint_as_float(s[0]) + __uint_as_float(s[1]);
}
__device__ __forceinline__ int scan_order(int d, int i) { return d == 0 ? i : (i == 0 ? 1 : (i == 1 ? 0 : 131 - i)); }
__device__ __forceinline__ void st16bf(bf16_t* p, const f32x4 (&a)[4]) {
  uint4 o0, o1;
  o0.x = pack2(a[0][0], a[0][1]); o0.y = pack2(a[0][2], a[0][3]); o0.z = pack2(a[1][0], a[1][1]); o0.w = pack2(a[1][2], a[1][3]);
  o1.x = pack2(a[2][0], a[2][1]); o1.y = pack2(a[2][2], a[2][3]); o1.z = pack2(a[3][0], a[3][1]); o1.w = pack2(a[3][2], a[3][3]);
  *(uint4*)p = o0; *(uint4*)(p + 8) = o1;
}

__device__ __forceinline__ int lds_byte(int r, int c) {
  const int st = (r >> 4) * 2 + (c >> 5), ob = (r & 15) * 64 + (c & 31) * 2;
  return st * 1024 + (ob ^ (((ob >> 9) & 1) << 5));
}
__device__ __forceinline__ void stage_rc(int b, int& R, int& C) {
  const int st = b >> 10, sb = b & 1023, swz = sb ^ (((sb >> 9) & 1) << 5);
  R = (st >> 1) * 16 + (swz >> 6);
  C = (st & 1) * 32 + ((swz & 63) >> 1);
}
__device__ __forceinline__ int perm_col(int p) {
  const int q = p & 63, n = q >> 4, i = q & 15;
  return (p & ~63) + (i >> 2) * 16 + n * 4 + (i & 3);
}

struct KOffL { __device__ __forceinline__ int operator()(int, int kt) const { return kt * 64; } };
#define GEMM_LDS_TOTAL 147456
template <int MI, bool SWAP, class RA, class RB, class KA, class KB, class EP>
__device__ __forceinline__ void gemm_loop(char* shm, int nk, int Lbeg, int Lend, int Lstep, RA rowA, RB rowB, KA koffA, KB koffB, EP epi) {
  constexpr int BM = 32 * MI, GLA = MI / 2, GLB = 4;
  constexpr int TILE_A = BM * 128, TILE_B = 256 * 128, STG = TILE_A + TILE_B;
  constexpr int NBUF = (3 * STG <= GEMM_LDS_TOTAL) ? 3 : 2;
  static_assert(NBUF * STG <= GEMM_LDS_TOTAL, "LDS");
  if (Lbeg >= Lend) return;
  const int tid = opaque_tid(), wid = tid >> 6, lane = tid & 63, wr = wid >> 2, wc = wid & 3, fr = lane & 15, fq = lane >> 4;
  const bf16_t* pa[GLA];
  const bf16_t* pb[GLB];
#define GL_SETP(L_) do { int t2_ = tid; asm volatile("" : "+v"(t2_)); const int w2_ = t2_ >> 6, l2_ = t2_ & 63;        \
    _Pragma("unroll") for (int i = 0; i < GLA; ++i) { int R_, C_; stage_rc(w2_ * 1024 + i * 8192 + l2_ * 16, R_, C_); pa[i] = rowA((L_), R_) + C_; } \
    _Pragma("unroll") for (int i = 0; i < GLB; ++i) { int R_, C_; stage_rc(w2_ * 1024 + i * 8192 + l2_ * 16, R_, C_); pb[i] = rowB((L_), SWAP ? perm_col(R_) : R_) + C_; } } while (0)
#define GL_ISSUE(buf, kt, L_) do { const int ka_ = koffA((L_), (kt)), kb_ = koffB((L_), (kt)); char* base_ = shm + (buf) * STG;  \
    _Pragma("unroll") for (int i = 0; i < GLA; ++i)                                                                    \
      __builtin_amdgcn_global_load_lds((const unsigned*)(pa[i] + ka_), (unsigned*)(base_ + wid * 1024 + i * 8192), 16, 0, 0); \
    _Pragma("unroll") for (int i = 0; i < GLB; ++i)                                                                    \
      __builtin_amdgcn_global_load_lds((const unsigned*)(pb[i] + kb_), (unsigned*)(base_ + TILE_A + wid * 1024 + i * 8192), 16, 0, 0); } while (0)
#define GL_PIECE(pi, buf, ka_, kb_) do { char* base_ = shm + (buf) * STG;                                              \
    if ((pi) < GLA) __builtin_amdgcn_global_load_lds((const unsigned*)(pa[(pi) < GLA ? (pi) : 0] + (ka_)), (unsigned*)(base_ + wid * 1024 + (pi) * 8192), 16, 0, 0); \
    else __builtin_amdgcn_global_load_lds((const unsigned*)(pb[(pi) >= GLA ? (pi) - GLA : 0] + (kb_)), (unsigned*)(base_ + TILE_A + wid * 1024 + ((pi) - GLA) * 8192), 16, 0, 0); } while (0)
#define GL_RAWBAR() do { asm volatile("s_waitcnt lgkmcnt(0)" ::: "memory"); __builtin_amdgcn_s_barrier(); } while (0)
  const int npre = nk < NBUF ? nk : NBUF;
  GL_SETP(Lbeg);
  for (int s = 0; s < npre; ++s) GL_ISSUE(s, s, Lbeg);
  for (int L = Lbeg; L < Lend; L += Lstep) {
    f32x4 acc[MI][4];
#pragma unroll
    for (int m = 0; m < MI; ++m)
#pragma unroll
      for (int n = 0; n < 4; ++n) acc[m][n] = f32x4{0.f, 0.f, 0.f, 0.f};
    int cur = 0;
    for (int t = 0; t < nk; ++t) {
      if (NBUF == 3 && t >= 1 && t + 1 < nk) {
        if (GLA + GLB == 6) asm volatile("s_waitcnt vmcnt(6)" ::: "memory"); else asm volatile("s_waitcnt vmcnt(5)" ::: "memory");
      } else asm volatile("s_waitcnt vmcnt(0)" ::: "memory");
      GL_RAWBAR();
      const bool doiss = (t >= 1 && t + NBUF - 1 < nk);
      const int nb_ = (cur == 0) ? NBUF - 1 : cur - 1;
      const int ka2 = doiss ? koffA(L, t + NBUF - 1) : 0, kb2 = doiss ? koffB(L, t + NBUF - 1) : 0;
      const char* sa = shm + cur * STG;
      const char* sb = sa + TILE_A;
      const int offA = lds_byte(wr * (MI * 16) + fr, fq * 8), offB = lds_byte(wc * 64 + fr, fq * 8);
#pragma unroll
      for (int ks = 0; ks < 2; ++ks) {
        bf16x8 Bf[4];
#pragma unroll
        for (int n = 0; n < 4; ++n) Bf[n] = *(const bf16x8*)(sb + offB + n * 2048 + ks * 1024);
        constexpr int MG = MI < 4 ? MI : 4;
#pragma unroll
        for (int mh = 0; mh < MI; mh += MG) {
          bf16x8 At[MG];
#pragma unroll
          for (int m = 0; m < MG; ++m) At[m] = *(const bf16x8*)(sa + offA + (mh + m) * 2048 + ks * 1024);
          __builtin_amdgcn_s_setprio(1);
#pragma unroll
          for (int m = 0; m < MG; ++m)
#pragma unroll
            for (int n = 0; n < 4; ++n) {
              if (SWAP) acc[mh + m][n] = __builtin_amdgcn_mfma_f32_16x16x32_bf16(Bf[n], At[m], acc[mh + m][n], 0, 0, 0);
              else      acc[mh + m][n] = __builtin_amdgcn_mfma_f32_16x16x32_bf16(At[m], Bf[n], acc[mh + m][n], 0, 0, 0);
            }
          __builtin_amdgcn_s_setprio(0);
          __builtin_amdgcn_sched_barrier(0);
          if (doiss) {
            constexpr int NG = 2 * (MI / MG), NP = GLA + GLB;
            const int g = ks * (MI / MG) + mh / MG;
#pragma unroll
            for (int pi = 0; pi < NP; ++pi)
              if (pi >= g * NP / NG && pi < (g + 1) * NP / NG) GL_PIECE(pi, nb_, ka2, kb2);
          }
          __builtin_amdgcn_sched_barrier(0);
        }
      }
      cur = (cur == NBUF - 1) ? 0 : cur + 1;
    }
    GL_RAWBAR();
    const int Ln = L + Lstep;
    if (Ln < Lend) { GL_SETP(Ln); for (int s = 0; s < npre; ++s) GL_ISSUE(s, s, Ln); }
    {
      const int t3 = opaque_tid(), w3 = t3 >> 6, l3 = t3 & 63, wr3 = w3 >> 2, wc3 = w3 & 3, fr3 = l3 & 15, fq3 = l3 >> 4;
      if constexpr (SWAP) {
        epi(L, wr3 * (MI * 16) + fr3, wc3 * 64 + fq3 * 16, acc);
      } else {
#pragma unroll
        for (int m = 0; m < MI; ++m)
#pragma unroll
          for (int n = 0; n < 4; ++n) epi(L, wr3 * (MI * 16) + m * 16 + fq3 * 4, wc3 * 64 + n * 16 + fr3, acc[m][n]);
      }
    }
  }
  asm volatile("s_waitcnt vmcnt(0)" ::: "memory");
#undef GL_SETP
#undef GL_ISSUE
#undef GL_PIECE
#undef GL_RAWBAR
}


__device__ __forceinline__ int lds_byte32(int r, int c) {
  const int ob = (r & 15) * 64 + (c & 31) * 2;
  return (r >> 4) * 1024 + (ob ^ (((ob >> 9) & 1) << 5));
}
__device__ __forceinline__ void stage_rc32(int b, int& R, int& C) {
  const int st = b >> 10, sb = b & 1023, swz = sb ^ (((sb >> 9) & 1) << 5);
  R = st * 16 + (swz >> 6);
  C = (swz & 63) >> 1;
}
template <bool SWAP, class RA, class RB, class KA, class KB, class EP>
__device__ __forceinline__ void gemm_loop32(char* shm, int nk, int Lbeg, int Lend, int Lstep, RA rowA, RB rowB, KA koffA, KB koffB, EP epi) {
  constexpr int MI = 8, GLA = 2, GLB = 2;
  constexpr int TILE_A = 256 * 64, TILE_B = 256 * 64, STG = TILE_A + TILE_B, NBUF = 4;
  static_assert(NBUF * STG <= GEMM_LDS_TOTAL, "LDS");
  if (Lbeg >= Lend) return;
  const int tid = opaque_tid(), wid = tid >> 6, lane = tid & 63, wr = wid >> 2, wc = wid & 3, fr = lane & 15, fq = lane >> 4;
  const bf16_t* pa[GLA];
  const bf16_t* pb[GLB];
#define G32_SETP(L_) do { int t2_ = tid; asm volatile("" : "+v"(t2_)); const int w2_ = t2_ >> 6, l2_ = t2_ & 63;        \
    _Pragma("unroll") for (int i = 0; i < GLA; ++i) { int R_, C_; stage_rc32(w2_ * 1024 + i * 8192 + l2_ * 16, R_, C_); pa[i] = rowA((L_), R_) + C_; } \
    _Pragma("unroll") for (int i = 0; i < GLB; ++i) { int R_, C_; stage_rc32(w2_ * 1024 + i * 8192 + l2_ * 16, R_, C_); pb[i] = rowB((L_), SWAP ? perm_col(R_) : R_) + C_; } } while (0)
#define G32_ISSUE(buf, s_, L_) do { const int ka_ = koffA((L_), (s_) >> 1) + ((s_) & 1) * 32, kb_ = koffB((L_), (s_) >> 1) + ((s_) & 1) * 32; \
    char* base_ = shm + (buf) * STG;                                                                                   \
    _Pragma("unroll") for (int i = 0; i < GLA; ++i)                                                                    \
      __builtin_amdgcn_global_load_lds((const unsigned*)(pa[i] + ka_), (unsigned*)(base_ + wid * 1024 + i * 8192), 16, 0, 0); \
    _Pragma("unroll") for (int i = 0; i < GLB; ++i)                                                                    \
      __builtin_amdgcn_global_load_lds((const unsigned*)(pb[i] + kb_), (unsigned*)(base_ + TILE_A + wid * 1024 + i * 8192), 16, 0, 0); } while (0)
#define G32_RAWBAR() do { asm volatile("s_waitcnt lgkmcnt(0)" ::: "memory"); __builtin_amdgcn_s_barrier(); } while (0)
  const int ns = 2 * nk;
  const int npre = ns < NBUF ? ns : NBUF;
  G32_SETP(Lbeg);
  for (int s = 0; s < npre; ++s) G32_ISSUE(s, s, Lbeg);
  for (int L = Lbeg; L < Lend; L += Lstep) {
    f32x4 acc[MI][4];
#pragma unroll
    for (int m = 0; m < MI; ++m)
#pragma unroll
      for (int n = 0; n < 4; ++n) acc[m][n] = f32x4{0.f, 0.f, 0.f, 0.f};
    int cur = 0;
    for (int t = 0; t < ns; ++t) {
      if (t == 0) asm volatile("s_waitcnt vmcnt(0)" ::: "memory");
      else if (t + 2 < ns) asm volatile("s_waitcnt vmcnt(8)" ::: "memory");
      else if (t + 1 < ns) asm volatile("s_waitcnt vmcnt(4)" ::: "memory");
      else asm volatile("s_waitcnt vmcnt(0)" ::: "memory");
      G32_RAWBAR();
      if (t >= 1 && t + 3 < ns) { const int nb_ = (cur + 3) & 3; G32_ISSUE(nb_, t + 3, L); }
      const char* sa = shm + cur * STG;
      const char* sb = sa + TILE_A;
      const int offA = lds_byte32(wr * 128 + fr, fq * 8), offB = lds_byte32(wc * 64 + fr, fq * 8);
      bf16x8 Bf[4];
#pragma unroll
      for (int n = 0; n < 4; ++n) Bf[n] = *(const bf16x8*)(sb + offB + n * 1024);
#pragma unroll
      for (int mh = 0; mh < MI; mh += 4) {
        bf16x8 At[4];
#pragma unroll
        for (int m = 0; m < 4; ++m) At[m] = *(const bf16x8*)(sa + offA + (mh + m) * 1024);
#pragma unroll
        for (int m = 0; m < 4; ++m)
#pragma unroll
          for (int n = 0; n < 4; ++n) {
            if (SWAP) acc[mh + m][n] = __builtin_amdgcn_mfma_f32_16x16x32_bf16(Bf[n], At[m], acc[mh + m][n], 0, 0, 0);
            else      acc[mh + m][n] = __builtin_amdgcn_mfma_f32_16x16x32_bf16(At[m], Bf[n], acc[mh + m][n], 0, 0, 0);
          }
        __builtin_amdgcn_sched_barrier(0);
      }
      cur = (cur + 1) & 3;
    }
    G32_RAWBAR();
    const int Ln = L + Lstep;
    if (Ln < Lend) { G32_SETP(Ln); for (int s = 0; s < npre; ++s) G32_ISSUE(s, s, Ln); }
    {
      const int t3 = opaque_tid(), w3 = t3 >> 6, l3 = t3 & 63, wr3 = w3 >> 2, wc3 = w3 & 3, fr3 = l3 & 15, fq3 = l3 >> 4;
      if constexpr (SWAP) {
        epi(L, wr3 * 128 + fr3, wc3 * 64 + fq3 * 16, acc);
      } else {
#pragma unroll
        for (int m = 0; m < MI; ++m)
#pragma unroll
          for (int n = 0; n < 4; ++n) epi(L, wr3 * 128 + m * 16 + fq3 * 4, wc3 * 64 + n * 16 + fr3, acc[m][n]);
      }
    }
  }
  asm volatile("s_waitcnt vmcnt(0)" ::: "memory");
#undef G32_SETP
#undef G32_ISSUE
#undef G32_RAWBAR
}
template <int MI, bool SWAP, class RA, class RB, class KA, class KB, class EP>
__device__ __forceinline__ void gemm_run(char* shm, int nk, int Lbeg, int Lend, int Lstep, RA rowA, RB rowB, KA koffA, KB koffB, EP epi) {
#ifdef USE_BK32
  if constexpr (MI == 8) gemm_loop32<SWAP>(shm, nk, Lbeg, Lend, Lstep, rowA, rowB, koffA, koffB, epi);
  else gemm_loop<MI, SWAP>(shm, nk, Lbeg, Lend, Lstep, rowA, rowB, koffA, koffB, epi);
#else
  gemm_loop<MI, SWAP>(shm, nk, Lbeg, Lend, Lstep, rowA, rowB, koffA, koffB, epi);
#endif
}


template <class RA, class RB, class EP>
__device__ __forceinline__ void skinny_items(char* shm, int ibeg, int iend, int istep, RA rowA, RB rowB, EP epi) {
  for (int item = ibeg; item < iend; item += istep) {
    const int t = opaque_tid(), w = t >> 6, lane = t & 63, fr = lane & 15, fq = lane >> 4;
    f32x4 acc[4][4];
#pragma unroll
    for (int m = 0; m < 4; ++m)
#pragma unroll
      for (int n = 0; n < 4; ++n) acc[m][n] = f32x4{0.f, 0.f, 0.f, 0.f};
    const bf16_t* pa[4];
    const bf16_t* pb[4];
#pragma unroll
    for (int m = 0; m < 4; ++m) pa[m] = rowA(item, m * 16 + fr) + w * 128 + fq * 8;
#pragma unroll
    for (int n = 0; n < 4; ++n) pb[n] = rowB(item, perm_col(n * 16 + fr)) + w * 128 + fq * 8;
#pragma unroll
    for (int hf = 0; hf < 2; ++hf) {
      bf16x8 At[4][2], Bf[4][2];
#pragma unroll
      for (int m = 0; m < 4; ++m)
#pragma unroll
        for (int k2 = 0; k2 < 2; ++k2) At[m][k2] = *(const bf16x8*)(pa[m] + (hf * 2 + k2) * 32);
#pragma unroll
      for (int n = 0; n < 4; ++n)
#pragma unroll
        for (int k2 = 0; k2 < 2; ++k2) Bf[n][k2] = *(const bf16x8*)(pb[n] + (hf * 2 + k2) * 32);
#pragma unroll
      for (int k2 = 0; k2 < 2; ++k2)
#pragma unroll
        for (int m = 0; m < 4; ++m)
#pragma unroll
          for (int n = 0; n < 4; ++n) acc[m][n] = __builtin_amdgcn_mfma_f32_16x16x32_bf16(Bf[n][k2], At[m][k2], acc[m][n], 0, 0, 0);
    }
    float4* red = (float4*)shm;
#pragma unroll
    for (int m = 0; m < 4; ++m)
#pragma unroll
      for (int n = 0; n < 4; ++n) red[(w * 16 + m * 4 + n) * 64 + lane] = make_float4(acc[m][n][0], acc[m][n][1], acc[m][n][2], acc[m][n][3]);
    __syncthreads();
    if (t < 256) {
      const int m = t >> 6;
      f32x4 s[4];
#pragma unroll
      for (int n = 0; n < 4; ++n) {
        float4 a = red[(0 * 16 + m * 4 + n) * 64 + lane];
#pragma unroll
        for (int w2 = 1; w2 < 8; ++w2) { const float4 b = red[(w2 * 16 + m * 4 + n) * 64 + lane]; a.x += b.x; a.y += b.y; a.z += b.z; a.w += b.w; }
        s[n] = f32x4{a.x, a.y, a.z, a.w};
      }
      epi(item, m * 16 + fr, fq * 16, s);
    }
    __syncthreads();
  }
}

template <class F> struct PerM {
  F f;
  template <int MI> __device__ __forceinline__ void operator()(int L, int rb, int c0, const f32x4 (&a)[MI][4]) const {
#pragma unroll
    for (int m = 0; m < MI; ++m) f(L, rb + 16 * m, c0, a[m]);
  }
};
template <class F> __device__ __forceinline__ PerM<F> per_m(F f) { return PerM<F>{f}; }

template <int MI, bool SWAP, bool PERM, class RA, class RB, class KA, class KB, class F>
__device__ __forceinline__ void gemm_bal(char* shm, int nk, int vb, int ntile, int G, RA rowA, RB rowB, KA koffA, KB koffB, F f) {
  constexpr int HALF = 16 * MI;
  const int tail = ntile % G;
  const bool split = tail > 0 && 2 * tail <= G;
  const int nfull = split ? ntile - tail : ntile;
  if constexpr (SWAP && PERM) gemm_loop<MI, SWAP>(shm, nk, vb, nfull, G, rowA, rowB, koffA, koffB, per_m(f));
  else                        gemm_loop<MI, SWAP>(shm, nk, vb, nfull, G, rowA, rowB, koffA, koffB, f);
  if (split) {
    auto ra = [=](int H, int r) { return rowA(nfull + (H >> 1), r + HALF * (H & 1)); };
    auto rb = [=](int H, int c) { return rowB(nfull + (H >> 1), c); };
    auto ka = [=](int H, int kt) { return koffA(nfull + (H >> 1), kt); };
    auto kb = [=](int H, int kt) { return koffB(nfull + (H >> 1), kt); };
    auto ff = [=](int H, int row, int col, const auto& a) { f(nfull + (H >> 1), row + HALF * (H & 1), col, a); };
    if constexpr (SWAP && PERM) gemm_loop<MI / 2, SWAP>(shm, nk, vb, 2 * tail, G, ra, rb, ka, kb, per_m(ff));
    else                        gemm_loop<MI / 2, SWAP>(shm, nk, vb, 2 * tail, G, ra, rb, ka, kb, ff);
  }
}

template <bool BAL = false, class EP>
__device__ __forceinline__ void dense_phase(char* shm, int vb, int G, const bf16_t* A, int lda, const bf16_t* Wt, int ldw,
                                            int ntn, int nk, int with_ctx, EP epi) {
  const int nbig = 64 * ntn;
  if constexpr (BAL)
    gemm_bal<8, true, true>(shm, nk, vb, nbig, G,
      [=](int L, int r) { return A + (size_t)((1 + L / ntn) * 256 + r) * lda; },
      [=](int L, int c) { return Wt + (size_t)((L % ntn) * 256 + c) * ldw; }, KOffL(), KOffL(),
      [=](int L, int row, int col0, const f32x4 (&a)[4]) { epi((1 + L / ntn) * 256 + row, (L % ntn) * 256 + col0, a); });
  else
  gemm_run<8, true>(shm, nk, vb, nbig, G,
    [=](int L, int r) { return A + (size_t)((1 + L / ntn) * 256 + r) * lda; },
    [=](int L, int c) { return Wt + (size_t)((L % ntn) * 256 + c) * ldw; }, KOffL(), KOffL(),
    per_m([=](int L, int row, int col0, const f32x4 (&a)[4]) { epi((1 + L / ntn) * 256 + row, (L % ntn) * 256 + col0, a); }));
  if (with_ctx == 2) {
    skinny_items(shm, vb, 16 * ntn, G,
      [=](int it, int r) { return A + (size_t)((it / (4 * ntn)) * 64 + r) * lda; },
      [=](int it, int c) { return Wt + (size_t)((it % (4 * ntn)) * 64 + c) * ldw; },
      [=](int it, int row, int col0, const f32x4 (&a)[4]) { epi((it / (4 * ntn)) * 64 + row, (it % (4 * ntn)) * 64 + col0, a); });
  } else if (with_ctx == 1) {
    const int s = (vb - (nbig % G) + G) % G;
    gemm_loop<2, true>(shm, nk, s, 4 * ntn, G,
      [=](int L, int r) { return A + (size_t)((L / ntn) * 64 + r) * lda; },
      [=](int L, int c) { return Wt + (size_t)((L % ntn) * 256 + c) * ldw; }, KOffL(), KOffL(),
      per_m([=](int L, int row, int col0, const f32x4 (&a)[4]) { epi((L / ntn) * 64 + row, (L % ntn) * 256 + col0, a); }));
  }
}

#define XB_TMO      128
#define XB_XCNT(j)  (256  + 64 * (j))
#define XB_XSUB(j)  (1280 + 64 * (j))
#define XB_XGEN(j)  (2304 + 64 * (j))
#define XB_TOP      3328
#define XB_TOPGEN   3392
#define XCD_BAR_WORDS 3456
#define XB_SPIN_CAP (1u << 22)
#define LAS __attribute__((address_space(3)))
__device__ __forceinline__ unsigned xb_ld(unsigned* p)              { return __hip_atomic_load(p, __ATOMIC_RELAXED, __HIP_MEMORY_SCOPE_AGENT); }
__device__ __forceinline__ unsigned xb_add(unsigned* p, unsigned v) { return __hip_atomic_fetch_add(p, v, __ATOMIC_RELAXED, __HIP_MEMORY_SCOPE_AGENT); }
__device__ __forceinline__ unsigned xb_xcc_id() { return (unsigned)__builtin_amdgcn_s_getreg((3 << 11) | 20) & 0xFu; }
#define XB_SPIN(cond, bar) do { unsigned _sp = 0; while (cond) { __builtin_amdgcn_s_sleep(1); \
    if ((++_sp & 255u) == 0u) { if (xb_ld(&(bar)[XB_TMO])) break; if (_sp > XB_SPIN_CAP) { atomicAdd(&(bar)[XB_TMO], 1u); break; } } } } while (0)
struct XcdBarrier { unsigned* bar; unsigned x; volatile LAS unsigned* st; };
__device__ __forceinline__ XcdBarrier xcd_barrier_post(unsigned* bar, volatile LAS unsigned* st) {
    XcdBarrier b; b.bar = bar; b.x = xb_xcc_id(); b.st = st;
    if (threadIdx.x == 0) (void)xb_add(&bar[XB_XCNT(b.x)], 1u);
    return b;
}
__device__ __forceinline__ void xcd_barrier_complete(unsigned* bar, unsigned x, unsigned& nloc, unsigned& nx) {
    const unsigned G = gridDim.x * gridDim.y * gridDim.z;
    unsigned sum, cnt, mine, sp = 0u;
    for (;;) {
        sum = 0u; cnt = 0u; mine = 0u;
#pragma unroll
        for (unsigned j = 0; j < 16; ++j) { const unsigned c = xb_ld(&bar[XB_XCNT(j)]); sum += c; cnt += (c > 0u) ? 1u : 0u; mine = (j == x) ? c : mine; }
        if (sum == G) break;
        __builtin_amdgcn_s_sleep(1);
        if ((++sp & 255u) == 0u) { if (xb_ld(&bar[XB_TMO])) break; if (sp > XB_SPIN_CAP) { atomicAdd(&bar[XB_TMO], 1u); break; } }
    }
    nloc = mine > 0u ? mine : 1u; nx = cnt > 0u ? cnt : 1u;
}
__device__ __forceinline__ void xcd_barrier(const XcdBarrier& b) {
    asm volatile("s_waitcnt vmcnt(0)" ::: "memory");
    __syncthreads();
    if (threadIdx.x == 0) {
        unsigned* bar = b.bar;
        __builtin_amdgcn_s_waitcnt(0);
        unsigned nloc = b.st[0], nx = b.st[1];
        if (nloc == 0u) { xcd_barrier_complete(bar, b.x, nloc, nx); b.st[0] = nloc; b.st[1] = nx; }
        const unsigned old = xb_add(&bar[XB_XSUB(b.x)], 1u);
        const unsigned gen = old / nloc;
        if (old + 1u == (gen + 1u) * nloc) {
            __builtin_amdgcn_fence(__ATOMIC_RELEASE, "agent");
            asm volatile("s_waitcnt vmcnt(0)" ::: "memory");
            const unsigned og = xb_add(&bar[XB_TOP], 1u);
            const unsigned tg = og / nx;
            if (og + 1u == (tg + 1u) * nx) xb_add(&bar[XB_TOPGEN], 1u);
            else XB_SPIN(xb_ld(&bar[XB_TOPGEN]) == tg, bar);
            __builtin_amdgcn_fence(__ATOMIC_ACQUIRE, "agent");
            xb_add(&bar[XB_XGEN(b.x)], 1u);
            asm volatile("s_waitcnt vmcnt(0)" ::: "memory");
        } else {
            XB_SPIN(xb_ld(&bar[XB_XGEN(b.x)]) == gen, bar);
            __builtin_amdgcn_fence(__ATOMIC_ACQUIRE, "agent");
            asm volatile("s_waitcnt vmcnt(0)" ::: "memory");
        }
    }
    __syncthreads();
}

template <class AF, class BF, class EF>
__device__ __forceinline__ void gemm_naive(int M, int N, int K, AF af, BF bf, EF ef, float* smem_all) {
  const int half = threadIdx.x >> 8, tid = threadIdx.x & 255;
  float* smem = smem_all + half * (2 * 16 * 68);
  const int tilesM = (M + 63) >> 6, tilesN = (N + 63) >> 6;
  const int ntiles = tilesM * tilesN;
  float (*As)[68] = (float (*)[68])smem;
  float (*Bs)[68] = (float (*)[68])(smem + 16 * 68);
  const int ty = tid >> 4, tx = tid & 15;
  const int stride = gridDim.x * 2;
  const int iters = (ntiles + stride - 1) / stride;
  for (int it = 0; it < iters; ++it) {
    const int tile = it * stride + blockIdx.x * 2 + half;
    const bool valid = tile < ntiles;
    const int tm = valid ? tile / tilesN : 0, tn = valid ? tile - tm * tilesN : 0;
    const int m0 = tm << 6, n0 = tn << 6;
    float acc[4][4];
#pragma unroll
    for (int i = 0; i < 4; ++i)
#pragma unroll
      for (int j = 0; j < 4; ++j) acc[i][j] = 0.f;
    for (int k0 = 0; k0 < K; k0 += 16) {
#pragma unroll
      for (int i = 0; i < 4; ++i) {
        const int mm = (tid >> 4) + 16 * i, kk = tid & 15;
        const int m = m0 + mm, k = k0 + kk;
        As[kk][mm] = (valid && m < M && k < K) ? af(m, k, n0) : 0.f;
      }
#pragma unroll
      for (int i = 0; i < 4; ++i) {
        const int kk = (tid >> 6) + 4 * i, nn = tid & 63;
        const int k = k0 + kk, n = n0 + nn;
        Bs[kk][nn] = (valid && k < K && n < N) ? bf(k, n, m0) : 0.f;
      }
      __syncthreads();
#pragma unroll
      for (int kk = 0; kk < 16; ++kk) {
        const float4 a = *(const float4*)&As[kk][ty * 4];
        const float4 b = *(const float4*)&Bs[kk][tx * 4];
        const float av[4] = {a.x, a.y, a.z, a.w};
        const float bv[4] = {b.x, b.y, b.z, b.w};
#pragma unroll
        for (int i = 0; i < 4; ++i)
#pragma unroll
          for (int j = 0; j < 4; ++j) acc[i][j] = fmaf(av[i], bv[j], acc[i][j]);
      }
      __syncthreads();
    }
    if (valid) {
#pragma unroll
      for (int i = 0; i < 4; ++i)
#pragma unroll
        for (int j = 0; j < 4; ++j) {
          const int m = m0 + ty * 4 + i, n = n0 + tx * 4 + j;
          if (m < M && n < N) ef(m, n, acc[i][j]);
        }
    }
  }
}

__device__ __forceinline__ void conv_tile(const float* src, int ldn, bf16_t* dst, int ldk, int k0, int n0, int mapmode, float* sm) {
  const int tid = opaque_tid();
  float (*tl)[65] = (float (*)[65])sm;
  {
    const int row = tid >> 3, c4 = (tid & 7) * 4;
    const float4 a = *(const float4*)&src[(size_t)(k0 + row) * ldn + n0 + c4];
    const float4 b = *(const float4*)&src[(size_t)(k0 + row) * ldn + n0 + 32 + c4];
    tl[row][c4 + 0] = a.x; tl[row][c4 + 1] = a.y; tl[row][c4 + 2] = a.z; tl[row][c4 + 3] = a.w;
    tl[row][32 + c4 + 0] = b.x; tl[row][32 + c4 + 1] = b.y; tl[row][32 + c4 + 2] = b.z; tl[row][32 + c4 + 3] = b.w;
  }
  __syncthreads();
  {
    const int n = tid >> 3, kg = (tid & 7) * 8;
    uint4 o;
    o.x = pack2(tl[kg + 0][n], tl[kg + 1][n]); o.y = pack2(tl[kg + 2][n], tl[kg + 3][n]);
    o.z = pack2(tl[kg + 4][n], tl[kg + 5][n]); o.w = pack2(tl[kg + 6][n], tl[kg + 7][n]);
    const int h = n0 + n;
    const int dr = mapmode == 0 ? h : ((h >> 3) * 16 + (h & 7) + (mapmode == 2 ? 8 : 0));
    *(uint4*)&dst[(size_t)dr * ldk + k0 + kg] = o;
  }
  __syncthreads();
}

__device__ __forceinline__ void norm_phase(const Params& P, int t0, const float* gw,
                                           int mod_layer, int shift_idx,
                                           int pend_layer, int pend_t0,
                                           bool to_out, bool router, int layer, float* wl) {
  int* rl = (int*)((char*)wl + GEMM_LDS_TOTAL + 272);
  unsigned char* ws = P.ws;
  bf16_t* tok = (bf16_t*)(ws + WS_TOK);
  bf16_t* hb = (bf16_t*)(ws + WS_H);
  const float* mod = (const float*)(ws + WS_MOD);
  const bf16_t* ybuf = (const bf16_t*)(ws + WS_R + R_YBUF);
  const int tid_n = opaque_tid();
  const int lane = tid_n & 63;
  if (router) {
    const float* rgw = P.in[9] + (size_t)layer * 1024 * 4;
    const float* rew = P.in[11] + (size_t)layer * 1024 * 32;
    for (int idx = tid_n; idx < 1024 * 36; idx += NT) {
      const int k = idx / 36, j = idx - k * 36;
      const int rho = (((k >> 8) * 4 + (k & 3)) * 64) + ((k & 255) >> 2);
      wl[rho * 36 + j] = (j < 4) ? rgw[k * 4 + j] : rew[k * 32 + (j - 4)];
    }
    if (tid_n < 80) rl[tid_n] = 0;
    __syncthreads();
  }
  const int gw_id = blockIdx.x * (NT / 64) + (tid_n >> 6);
  const int gw_n = gridDim.x * (NT / 64);
  for (int t = t0 + gw_id; t < T_ALL; t += gw_n) {
    const int s = (t < T_CTX) ? 1 : 0;
    float v[16];
    if (pend_layer == -2) {
      const float* PE = (const float*)(ws + W_PE);
#pragma unroll
      for (int j = 0; j < 4; ++j) {
        const int n = j * 256 + lane * 4;
        float4 x;
        if (t < T_CTX) x = ntload4(&P.in[2][(size_t)t * DM + n]);
        else {
          const int tl = t - T_CTX;
          x = ntload4(&P.in[0][(size_t)tl * DM + n]);
          const float* pp = (j < 2) ? PE + j * 65536 + (tl >> 6) * 256 + lane * 4 : PE + 131072 + (j - 2) * 16384 + (tl & 63) * 256 + lane * 4;
          const float4 pe = *(const float4*)pp;
          x.x += pe.x; x.y += pe.y; x.z += pe.z; x.w += pe.w;
        }
        v[j * 4 + 0] = x.x; v[j * 4 + 1] = x.y; v[j * 4 + 2] = x.z; v[j * 4 + 3] = x.w;
        { uint2 o; o.x = pack2(x.x, x.y); o.y = pack2(x.z, x.w); *(uint2*)&tok[(size_t)t * DM + n] = o; }
      }
    } else {
#pragma unroll
    for (int j = 0; j < 4; ++j) {
      const int n = j * 256 + lane * 4;
      const uint2 x = *(const uint2*)&tok[(size_t)t * DM + n];
      v[j * 4 + 0] = lo2f(x.x); v[j * 4 + 1] = hi2f(x.x); v[j * 4 + 2] = lo2f(x.y); v[j * 4 + 3] = hi2f(x.y);
    }
    }
    if (pend_layer >= 0 && t >= pend_t0) {
      const float* gate = mod + (size_t)((pend_layer * 2 + s) * 6 + 5) * 1024;
#pragma unroll
      for (int j = 0; j < 4; ++j) {
        const int n = j * 256 + lane * 4;
        const uint2 y0 = *(const uint2*)&ybuf[(size_t)(2 * t) * DM + n];
        const uint2 y1 = *(const uint2*)&ybuf[(size_t)(2 * t + 1) * DM + n];
        const float4 g = *(const float4*)&gate[n];
        v[j * 4 + 0] += g.x * (lo2f(y0.x) + lo2f(y1.x));
        v[j * 4 + 1] += g.y * (hi2f(y0.x) + hi2f(y1.x));
        v[j * 4 + 2] += g.z * (lo2f(y0.y) + lo2f(y1.y));
        v[j * 4 + 3] += g.w * (hi2f(y0.y) + hi2f(y1.y));
        { uint2 o; o.x = pack2(v[j * 4 + 0], v[j * 4 + 1]); o.y = pack2(v[j * 4 + 2], v[j * 4 + 3]); *(uint2*)&tok[(size_t)t * DM + n] = o; }
      }
    }
    float ss = 0.f;
#pragma unroll
    for (int e = 0; e < 16; ++e) ss += v[e] * v[e];
    ss = wave_sum(ss);
    const float r = 1.f / sqrtf(ss * (1.f / 1024.f) + EPSN);
    float h[16];
#pragma unroll
    for (int j = 0; j < 4; ++j) {
      const int n = j * 256 + lane * 4;
      const float4 g = *(const float4*)&gw[n];
      h[j * 4 + 0] = v[j * 4 + 0] * r * g.x;
      h[j * 4 + 1] = v[j * 4 + 1] * r * g.y;
      h[j * 4 + 2] = v[j * 4 + 2] * r * g.z;
      h[j * 4 + 3] = v[j * 4 + 3] * r * g.w;
      if (shift_idx >= 0) {
        const float* sh = mod + (size_t)((mod_layer * 2 + s) * 6 + shift_idx) * 1024;
        const float* sc = sh + 1024;
        const float4 a = *(const float4*)&sh[n];
        const float4 b = *(const float4*)&sc[n];
        h[j * 4 + 0] = h[j * 4 + 0] * (1.f + b.x) + a.x;
        h[j * 4 + 1] = h[j * 4 + 1] * (1.f + b.y) + a.y;
        h[j * 4 + 2] = h[j * 4 + 2] * (1.f + b.z) + a.z;
        h[j * 4 + 3] = h[j * 4 + 3] * (1.f + b.w) + a.w;
      }
      if (to_out) {
        { typedef __attribute__((ext_vector_type(4))) float f4v; const f4v ov = {h[j * 4 + 0], h[j * 4 + 1], h[j * 4 + 2], h[j * 4 + 3]};
          __builtin_nontemporal_store(ov, (f4v*)&P.out[(size_t)(t - T_CTX) * DM + n]); }
      } else {
        uint2 o; o.x = pack2(h[j * 4 + 0], h[j * 4 + 1]); o.y = pack2(h[j * 4 + 2], h[j * 4 + 3]);
        *(uint2*)&hb[(size_t)t * DM + n] = o;
      }
    }
    if (router) {
      float lg[36];
#pragma unroll
      for (int q = 0; q < 36; ++q) lg[q] = 0.f;
#pragma unroll
      for (int i = 0; i < 16; ++i) {
        const float hv = h[i];
        const float4* wr4 = (const float4*)(wl + (i * 64 + lane) * 36);
#pragma unroll
        for (int q = 0; q < 9; ++q) {
          const float4 w4 = wr4[q];
          lg[q * 4 + 0] += hv * w4.x; lg[q * 4 + 1] += hv * w4.y; lg[q * 4 + 2] += hv * w4.z; lg[q * 4 + 3] += hv * w4.w;
        }
        __builtin_amdgcn_sched_barrier(0);
      }
#pragma unroll
      for (int q = 0; q < 36; ++q) lg[q] = wave_sum(lg[q]);
      const float* rgb = P.in[10] + layer * 4;
      const float* reb = P.in[12] + layer * 32;
#pragma unroll
      for (int q = 0; q < 4; ++q) lg[q] += rgb[q];
#pragma unroll
      for (int q = 0; q < 32; ++q) lg[4 + q] += reb[q];
      int grp = 0; float best = lg[0];
#pragma unroll
      for (int q = 1; q < 4; ++q) if (lg[q] > best) { best = lg[q]; grp = q; }
      float se = 0.f;
#pragma unroll
      for (int q = 0; q < 4; ++q) se += expf(lg[q] - best);
      const float pg = 1.f / se;
      float v0 = -3.0e38f, v1 = -3.0e38f; int i0 = 0, i1 = 0;
#pragma unroll
      for (int g = 0; g < 4; ++g) {
#pragma unroll
        for (int q = 0; q < 8; ++q) {
          const float x = lg[4 + g * 8 + q];
          if (g == grp) {
            if (x > v0) { v1 = v0; i1 = i0; v0 = x; i0 = q; }
            else if (x > v1) { v1 = x; i1 = q; }
          }
        }
      }
      const float w0 = 1.f / (1.f + expf(v1 - v0));
      const float w1 = 1.f - w0;
      if (lane == 0) {
        float* asgw = (float*)(ws + WS_ASGW);
        const int e0 = grp * 8 + i0, e1 = grp * 8 + i1;
        const int p0 = atomicAdd(&rl[e0], 1);
        const int p1 = atomicAdd(&rl[e1], 1);
        const int sl = atomicAdd(&rl[64], 2);
        rl[80 + sl] = 2 * t;         rl[240 + sl] = e0;     rl[400 + sl] = p0;
        rl[80 + sl + 1] = 2 * t + 1; rl[240 + sl + 1] = e1; rl[400 + sl + 1] = p1;
        asgw[2 * t] = w0 * pg;
        asgw[2 * t + 1] = w1 * pg;
      }
    }
  }
  if (router) {
    __syncthreads();
    int* cnt = (int*)(ws + WS_CNT) + layer * 32 * 32;
    int* list = (int*)(ws + WS_LIST);
    if (tid_n < 32) rl[32 + tid_n] = rl[tid_n] ? atomicAdd(&cnt[tid_n * 32], rl[tid_n]) : 0;
    __syncthreads();
    const int nent = rl[64];
    for (int s = tid_n; s < nent; s += NT) {
      const int e = rl[240 + s];
      list[(size_t)e * 33280 + rl[32 + e] + rl[400 + s]] = rl[80 + s];
    }
    __syncthreads();
  }
}


__device__ __forceinline__ void route_token(const float (&lg_in)[36], const float* rgb, const float* reb, int t, int* rl, float* asgw) {
  float lg[36];
#pragma unroll
  for (int q = 0; q < 4; ++q) lg[q] = lg_in[q] + rgb[q];
#pragma unroll
  for (int q = 0; q < 32; ++q) lg[4 + q] = lg_in[4 + q] + reb[q];
  int grp = 0; float best = lg[0];
#pragma unroll
  for (int q = 1; q < 4; ++q) if (lg[q] > best) { best = lg[q]; grp = q; }
  float se = 0.f;
#pragma unroll
  for (int q = 0; q < 4; ++q) se += expf(lg[q] - best);
  const float pg = 1.f / se;
  float v0 = -3.0e38f, v1 = -3.0e38f; int i0 = 0, i1 = 0;
#pragma unroll
  for (int g = 0; g < 4; ++g) {
#pragma unroll
    for (int q = 0; q < 8; ++q) {
      const float x = lg[4 + g * 8 + q];
      if (g == grp) {
        if (x > v0) { v1 = v0; i1 = i0; v0 = x; i0 = q; }
        else if (x > v1) { v1 = x; i1 = q; }
      }
    }
  }
  const float w0 = 1.f / (1.f + expf(v1 - v0));
  const float w1 = 1.f - w0;
  const int e0 = grp * 8 + i0, e1 = grp * 8 + i1;
  const int p0 = atomicAdd(&rl[e0], 1);
  const int p1 = atomicAdd(&rl[e1], 1);
  const int sl = atomicAdd(&rl[64], 2);
  rl[80 + sl] = 2 * t;         rl[240 + sl] = e0;     rl[400 + sl] = p0;
  rl[80 + sl + 1] = 2 * t + 1; rl[240 + sl + 1] = e1; rl[400 + sl + 1] = p1;
  asgw[2 * t] = w0 * pg;
  asgw[2 * t + 1] = w1 * pg;
}

__device__ __forceinline__ void route_token2(float res, int t, int* rl, float* asgw, int lane) {
  const float g0 = __shfl(res, 0), g1 = __shfl(res, 32), g2 = __shfl(res, 1), g3 = __shfl(res, 33);
  int grp = 0; float best = g0;
  if (g1 > best) { best = g1; grp = 1; }
  if (g2 > best) { best = g2; grp = 2; }
  if (g3 > best) { best = g3; grp = 3; }
  const float pg = 1.f / (expf(g0 - best) + expf(g1 - best) + expf(g2 - best) + expf(g3 - best));
  float v0 = -3.0e38f, v1 = -3.0e38f; int i0 = 0, i1 = 0;
#pragma unroll
  for (int q = 0; q < 8; ++q) {
    const float x = __shfl(res, (q & 1) * 32 + 2 + grp * 4 + (q >> 1));
    if (x > v0) { v1 = v0; i1 = i0; v0 = x; i0 = q; }
    else if (x > v1) { v1 = x; i1 = q; }
  }
  if (lane == 0) {
    const float w0 = 1.f / (1.f + expf(v1 - v0));
    const float w1 = 1.f - w0;
    const int e0 = grp * 8 + i0, e1 = grp * 8 + i1;
    const int p0 = atomicAdd(&rl[e0], 1);
    const int p1 = atomicAdd(&rl[e1], 1);
    const int sl = atomicAdd(&rl[64], 2);
    rl[80 + sl] = 2 * t;         rl[240 + sl] = e0;     rl[400 + sl] = p0;
    rl[80 + sl + 1] = 2 * t + 1; rl[240 + sl + 1] = e1; rl[400 + sl + 1] = p1;
    asgw[2 * t] = w0 * pg;
    asgw[2 * t + 1] = w1 * pg;
  }
}

__device__ __forceinline__ void ffn_norm_router_phase(const Params& P, int t0, int layer, float* wl) {
  unsigned char* ws = P.ws;
  int* rl = (int*)((char*)wl + GEMM_LDS_TOTAL + 272);
  const bf16_t* tok = (const bf16_t*)(ws + WS_TOK);
  bf16_t* hb = (bf16_t*)(ws + WS_H);
  const float* mod = (const float*)(ws + WS_MOD);
  const float* gw = P.in[7] + layer * 1024;
  const int tid_n = opaque_tid();
  const int lane0 = tid_n & 63;
  {
    const float* rgw = P.in[9] + (size_t)layer * 1024 * 4;
    const float* rew = P.in[11] + (size_t)layer * 1024 * 32;
    for (int ib = 0; ib < 18; ib += 6) {
      float4 w[6];
#pragma unroll
      for (int u = 0; u < 6; ++u) {
        const int idx = tid_n + (ib + u) * NT, k = idx / 9, q = idx - k * 9;
        const float* wp = (q == 0) ? rgw + k * 4 : rew + k * 32 + (q - 1) * 4;
        w[u] = *(const float4*)wp;
      }
#pragma unroll
      for (int u = 0; u < 6; ++u) {
        const int idx = tid_n + (ib + u) * NT, k = idx / 9, q = idx - k * 9;
        const int rho = (((k >> 8) * 4 + (k & 3)) * 64) + ((k & 255) >> 2);
        *(float4*)&wl[rho * 36 + q * 4] = w[u];
      }
    }
    if (tid_n < 80) rl[tid_n] = 0;
    __syncthreads();
  }
  const float* rgb = P.in[10] + layer * 4;
  const float* reb = P.in[12] + layer * 32;
  float* asgw = (float*)(ws + WS_ASGW);
  const int gw_id = blockIdx.x * (NT / 64) + (tid_n >> 6);
  const int gw_n = gridDim.x * (NT / 64);
  for (int tA = t0 + gw_id; tA < T_ALL; tA += 2 * gw_n) {
    int lane = lane0; asm volatile("" : "+v"(lane));
    const int tB = tA + gw_n;
    const bool hasB = tB < T_ALL;
    const int tBs = hasB ? tB : tA;
    float hA[16], hB[16];
    {
      float vA[16], vB[16];
#pragma unroll
      for (int j = 0; j < 4; ++j) {
        const int n = j * 256 + lane * 4;
        const uint2 x = *(const uint2*)&tok[(size_t)tA * DM + n];
        const uint2 y = *(const uint2*)&tok[(size_t)tBs * DM + n];
        vA[j * 4 + 0] = lo2f(x.x); vA[j * 4 + 1] = hi2f(x.x); vA[j * 4 + 2] = lo2f(x.y); vA[j * 4 + 3] = hi2f(x.y);
        vB[j * 4 + 0] = lo2f(y.x); vB[j * 4 + 1] = hi2f(y.x); vB[j * 4 + 2] = lo2f(y.y); vB[j * 4 + 3] = hi2f(y.y);
      }
      float sA = 0.f, sB = 0.f;
#pragma unroll
      for (int e = 0; e < 16; ++e) { sA += vA[e] * vA[e]; sB += vB[e] * vB[e]; }
      sA = wave_sum(sA); sB = wave_sum(sB);
      const float rA = 1.f / sqrtf(sA * (1.f / 1024.f) + EPSN), rB = 1.f / sqrtf(sB * (1.f / 1024.f) + EPSN);
      const int stA = (tA < T_CTX) ? 1 : 0, stB = (tBs < T_CTX) ? 1 : 0;
      const float* shA = mod + (size_t)((layer * 2 + stA) * 6 + 3) * 1024;
      const float* shB = mod + (size_t)((layer * 2 + stB) * 6 + 3) * 1024;
#pragma unroll
      for (int j = 0; j < 4; ++j) {
        const int n = j * 256 + lane * 4;
        const float4 g = *(const float4*)&gw[n];
        const float4 a1 = *(const float4*)&shA[n], b1 = *(const float4*)&shA[1024 + n];
        const float4 a2 = *(const float4*)&shB[n], b2 = *(const float4*)&shB[1024 + n];
        hA[j * 4 + 0] = vA[j * 4 + 0] * rA * g.x * (1.f + b1.x) + a1.x; hA[j * 4 + 1] = vA[j * 4 + 1] * rA * g.y * (1.f + b1.y) + a1.y;
        hA[j * 4 + 2] = vA[j * 4 + 2] * rA * g.z * (1.f + b1.z) + a1.z; hA[j * 4 + 3] = vA[j * 4 + 3] * rA * g.w * (1.f + b1.w) + a1.w;
        hB[j * 4 + 0] = vB[j * 4 + 0] * rB * g.x * (1.f + b2.x) + a2.x; hB[j * 4 + 1] = vB[j * 4 + 1] * rB * g.y * (1.f + b2.y) + a2.y;
        hB[j * 4 + 2] = vB[j * 4 + 2] * rB * g.z * (1.f + b2.z) + a2.z; hB[j * 4 + 3] = vB[j * 4 + 3] * rB * g.w * (1.f + b2.w) + a2.w;
        uint2 o; o.x = pack2(hA[j * 4 + 0], hA[j * 4 + 1]); o.y = pack2(hA[j * 4 + 2], hA[j * 4 + 3]);
        *(uint2*)&hb[(size_t)tA * DM + n] = o;
        if (hasB) { uint2 o2; o2.x = pack2(hB[j * 4 + 0], hB[j * 4 + 1]); o2.y = pack2(hB[j * 4 + 2], hB[j * 4 + 3]); *(uint2*)&hb[(size_t)tB * DM + n] = o2; }
      }
    }
    float gA[4], gB[4];
#pragma unroll
    for (int q = 0; q < 4; ++q) { gA[q] = 0.f; gB[q] = 0.f; }
#pragma unroll
    for (int i = 0; i < 16; ++i) {
      const float4 w4 = *(const float4*)(wl + (i * 64 + lane) * 36);
      gA[0] += hA[i] * w4.x; gA[1] += hA[i] * w4.y; gA[2] += hA[i] * w4.z; gA[3] += hA[i] * w4.w;
      gB[0] += hB[i] * w4.x; gB[1] += hB[i] * w4.y; gB[2] += hB[i] * w4.z; gB[3] += hB[i] * w4.w;
      __builtin_amdgcn_sched_barrier(0);
    }
    float gl[4];
#pragma unroll
    for (int q = 0; q < 4; ++q) gl[q] = fold_pair_sum(gA[q], gB[q]) + rgb[q];
    int grp = 0; float best = gl[0];
    if (gl[1] > best) { best = gl[1]; grp = 1; }
    if (gl[2] > best) { best = gl[2]; grp = 2; }
    if (gl[3] > best) { best = gl[3]; grp = 3; }
    const float pg = 1.f / (expf(gl[0] - best) + expf(gl[1] - best) + expf(gl[2] - best) + expf(gl[3] - best));
    const int grpA = __builtin_amdgcn_readlane(grp, 0), grpB = __builtin_amdgcn_readlane(grp, 32);
    float eA[8], eB[8];
#pragma unroll
    for (int q = 0; q < 8; ++q) { eA[q] = 0.f; eB[q] = 0.f; }
    const float* rowA = wl + lane * 36 + 4 + grpA * 8;
    const float* rowB = wl + lane * 36 + 4 + grpB * 8;
#pragma unroll
    for (int i = 0; i < 16; ++i) {
      const float4 a0 = *(const float4*)(rowA + i * 2304), a1 = *(const float4*)(rowA + i * 2304 + 4);
      const float4 b0 = *(const float4*)(rowB + i * 2304), b1 = *(const float4*)(rowB + i * 2304 + 4);
      eA[0] += hA[i] * a0.x; eA[1] += hA[i] * a0.y; eA[2] += hA[i] * a0.z; eA[3] += hA[i] * a0.w;
      eA[4] += hA[i] * a1.x; eA[5] += hA[i] * a1.y; eA[6] += hA[i] * a1.z; eA[7] += hA[i] * a1.w;
      eB[0] += hB[i] * b0.x; eB[1] += hB[i] * b0.y; eB[2] += hB[i] * b0.z; eB[3] += hB[i] * b0.w;
      eB[4] += hB[i] * b1.x; eB[5] += hB[i] * b1.y; eB[6] += hB[i] * b1.z; eB[7] += hB[i] * b1.w;
      asm volatile("" : "+v"(eA[0]), "+v"(eA[1]), "+v"(eA[2]), "+v"(eA[3]), "+v"(eA[4]), "+v"(eA[5]), "+v"(eA[6]), "+v"(eA[7]));
      asm volatile("" : "+v"(eB[0]), "+v"(eB[1]), "+v"(eB[2]), "+v"(eB[3]), "+v"(eB[4]), "+v"(eB[5]), "+v"(eB[6]), "+v"(eB[7]));
      __builtin_amdgcn_sched_barrier(0);
    }
    {
      const float4 r0 = *(const float4*)(reb + grp * 8), r1 = *(const float4*)(reb + grp * 8 + 4);
      const float rb8[8] = {r0.x, r0.y, r0.z, r0.w, r1.x, r1.y, r1.z, r1.w};
      float v0 = -3.0e38f, v1 = -3.0e38f; int i0 = 0, i1 = 0;
#pragma unroll
      for (int q = 0; q < 8; ++q) {
        const float x = fold_pair_sum(eA[q], eB[q]) + rb8[q];
        if (x > v0) { v1 = v0; i1 = i0; v0 = x; i0 = q; }
        else if (x > v1) { v1 = x; i1 = q; }
      }
      if (lane == 0 || (lane == 32 && hasB)) {
        const int t = lane == 0 ? tA : tB;
        const float w0 = 1.f / (1.f + expf(v1 - v0));
        const float w1 = 1.f - w0;
        const int e0 = grp * 8 + i0, e1 = grp * 8 + i1;
        const int p0 = atomicAdd(&rl[e0], 1);
        const int p1 = atomicAdd(&rl[e1], 1);
        const int sl = atomicAdd(&rl[64], 2);
        rl[80 + sl] = 2 * t;         rl[240 + sl] = e0;     rl[400 + sl] = p0;
        rl[80 + sl + 1] = 2 * t + 1; rl[240 + sl + 1] = e1; rl[400 + sl + 1] = p1;
        asgw[2 * t] = w0 * pg;
        asgw[2 * t + 1] = w1 * pg;
      }
    }
  }
  __syncthreads();
  int* cnt = (int*)(ws + WS_CNT) + layer * 32 * 32;
  int* list = (int*)(ws + WS_LIST);
  if (tid_n < 32) rl[32 + tid_n] = rl[tid_n] ? atomicAdd(&cnt[tid_n * 32], rl[tid_n]) : 0;
  __syncthreads();
  const int nent = rl[64];
  for (int s = tid_n; s < nent; s += NT) {
    const int e = rl[240 + s];
    list[(size_t)e * 33280 + rl[32 + e] + rl[400 + s]] = rl[80 + s];
  }
  __syncthreads();
}

#define tid (opaque_tid())
#define gtid ((int)(blockIdx.x * NT) + opaque_tid())
#define gstride ((int)(gridDim.x * NT))
__global__ void __launch_bounds__(NT, 2) mega(Params P) {
  cg::grid_group grid = cg::this_grid();
  __shared__ __attribute__((aligned(1024))) char shm[GEMM_LDS_TOTAL + 16 + 256 + 2560];
  float* smem = (float*)shm;
  if (threadIdx.x < 4) ((unsigned*)(shm + GEMM_LDS_TOTAL))[threadIdx.x] = 0u;
  __syncthreads();
  XcdBarrier xbar = xcd_barrier_post((unsigned*)(P.ws + WS_BAR), (volatile LAS unsigned*)(shm + GEMM_LDS_TOTAL));
  unsigned char* ws = P.ws;
  const int G = gridDim.x;
  const int vb = (G % 8 == 0) ? ((int)(blockIdx.x & 7) * (G / 8) + (int)(blockIdx.x >> 3)) : (int)blockIdx.x;
  bf16_t* tok = (bf16_t*)(ws + WS_TOK);
  bf16_t* hb = (bf16_t*)(ws + WS_H);
  float* mod = (float*)(ws + WS_MOD);
  const bf16_t* zrow = (const bf16_t*)(ws + WS_ZROW);
  unsigned char* R = ws + WS_R;

  {
    {
      float* PE = (float*)(ws + W_PE);
      for (int idx = gtid; idx < 320 * 256; idx += gstride) {
        const int p = idx >> 8, j = idx & 255;
        const float freq = expf(-9.210340371976184f * (float)j / 256.f);
        const float ang = (float)(p < 256 ? p : p - 256) * freq;
        float sv, cv; sincosf(ang, &sv, &cv);
        if (p < 256) { PE[p * 256 + j] = sv; PE[65536 + p * 256 + j] = cv; }
        else { PE[131072 + (p - 256) * 256 + j] = sv; PE[131072 + 16384 + (p - 256) * 256 + j] = cv; }
      }
    }
    {
      const float* c = P.in[1]; const float* cc = P.in[3]; const float* adaw = P.in[4];
      float* modp = (float*)(ws + WS_MODP);
      float* s_c = smem;
      for (int k = tid; k < 1024; k += NT) { const float a = c[k], b2 = cc[k]; s_c[k] = a / (1.f + expf(-a)); s_c[1024 + k] = b2 / (1.f + expf(-b2)); }
      __syncthreads();
      for (int idx = gtid; idx < 16 * 4 * 1536; idx += gstride) {
        const int ks = idx / 6144, rem = idx - ks * 6144, i = rem / 1536, j = (rem - i * 1536) * 4;
        const float* wp = adaw + ((size_t)i * 1024 + ks * 64) * 6144 + j;
        float4 a0 = make_float4(0.f, 0.f, 0.f, 0.f), a1 = a0;
        for (int kb = 0; kb < 64; kb += 8) {
          float4 w[8];
#pragma unroll
          for (int u = 0; u < 8; ++u) w[u] = ntload4(wp + (size_t)(kb + u) * 6144);
#pragma unroll
          for (int u = 0; u < 8; ++u) {
            const float s0 = s_c[ks * 64 + kb + u], s1 = s_c[1024 + ks * 64 + kb + u];
            a0.x += s0 * w[u].x; a0.y += s0 * w[u].y; a0.z += s0 * w[u].z; a0.w += s0 * w[u].w;
            a1.x += s1 * w[u].x; a1.y += s1 * w[u].y; a1.z += s1 * w[u].z; a1.w += s1 * w[u].w;
          }
        }
        *(float4*)&modp[(size_t)(ks * 8 + i * 2 + 0) * 6144 + j] = a0;
        *(float4*)&modp[(size_t)(ks * 8 + i * 2 + 1) * 6144 + j] = a1;
      }
      __syncthreads();
    }
    if (gtid < 4 * 32 * 32 + 64) ((int*)(ws + WS_CNT))[gtid] = 0;
    if (gtid < 2048) ((unsigned*)(ws + WS_ZROW))[gtid] = 0u;
    bf16_t* DC = (bf16_t*)(ws + W_DC); bf16_t* DA = (bf16_t*)(ws + W_DA); bf16_t* TW = (bf16_t*)(ws + W_TW);
    for (int idx = gtid; idx < 512 * 256; idx += gstride) {
      const int row = idx >> 8, cch = idx & 255, pq = row >> 8, kc = row & 255;
      const float a = (float)((kc * cch) & 255) * (1.f / 128.f);
      DC[idx] = f2bf(pq ? -sinpif(a) : cospif(a));
    }
    for (int idx = gtid; idx < 256 * 256; idx += gstride) {
      const int row = idx >> 8, col = idx & 255, ri = row >> 7, cc2 = row & 127, rj = col >> 7, aa = col & 127;
      const float a = (float)((aa * cc2) & 127) * (1.f / 64.f);
      const float cs = cospif(a), sn = sinpif(a);
      DA[idx] = f2bf(ri == rj ? cs : (ri == 0 ? sn : -sn));
    }
    for (int idx = gtid; idx < 128 * 128 * 256; idx += gstride) {
      const int col = idx & 255, e = (idx >> 8) & 127, c2 = idx >> 15, ri = col >> 7, b = col & 127;
      const float a = (float)((b * (c2 + 128 * e)) & 16383) * (1.f / 8192.f);
      TW[idx] = f2bf(ri ? sinpif(a) : cospif(a));
    }
    for (int idx = gtid; idx < 2 * 1280; idx += gstride) ((float*)(ws + W_SP))[idx] = log1pf(expf(-P.in[34][idx]));
    for (int idx = gtid; idx < 16 * 1024; idx += gstride) {
      const int k = idx >> 4, g = idx & 15;
      const float w = P.in[21][(size_t)k * 3088 + 3072 + g];
      const bf16_t hi = f2bf(w);
      bf16_t* WG = (bf16_t*)(ws + WS_HLO);
      WG[(size_t)(2 * g) * 1024 + k] = hi;
      WG[(size_t)(2 * g + 1) * 1024 + k] = f2bf(w - bf2f(hi));
    }
    {
      const float* src = P.in[36]; bf16_t* dst = (bf16_t*)(ws + W_FNIN);
      for (int idx = gtid; idx < 1024 * 1024 / 4; idx += gstride) {
        const float4 a = *(const float4*)&src[(size_t)idx * 4];
        uint2 o; o.x = pack2(a.x, a.y); o.y = pack2(a.z, a.w);
        *(uint2*)&dst[(size_t)idx * 4] = o;
      }
    }
    {
      struct CD { const float* src; bf16_t* dst; int ldn, ldk, k0, n0, mm, nt; };
      const int NDENSE = 512 + 256 + 768 + 256 + 640 + 320 + 256 + 160;
      const int NTOT = NDENSE + 128 * 384;
      auto desc = [=](int u) -> CD {
        CD d;
        if (u < NDENSE) {
          int v = u;
          if (v < 512) { d = CD{P.in[16], (bf16_t*)(ws + W_CMIN), 2048, 1024, (v >> 5) * 64, (v & 31) * 64, 0, 0}; return d; }
          v -= 512;
          if (v < 256) { d = CD{P.in[20], (bf16_t*)(ws + W_CMOUT), 1024, 1024, (v >> 4) * 64, (v & 15) * 64, 0, 0}; return d; }
          v -= 256;
          if (v < 768) { d = CD{P.in[21], (bf16_t*)(ws + W_MLIN), 3088, 1024, (v / 48) * 64, (v % 48) * 64, 0, 0}; return d; }
          v -= 768;
          if (v < 256) { d = CD{P.in[26], (bf16_t*)(ws + W_MLOUT), 1024, 1024, (v >> 4) * 64, (v & 15) * 64, 0, 0}; return d; }
          v -= 256;
          if (v < 640) { d = CD{P.in[27], (bf16_t*)(ws + W_LRUIN), 2560, 1024, (v / 40) * 64, (v % 40) * 64, 0, 0}; return d; }
          v -= 640;
          if (v < 320) { d = CD{P.in[35], (bf16_t*)(ws + W_LRUOUT), 1024, 1280, (v >> 4) * 64, (v & 15) * 64, 0, 0}; return d; }
          v -= 320;
          if (v < 256) { d = CD{P.in[37], (bf16_t*)(ws + W_FNOUT), 1024, 1024, (v >> 4) * 64, (v & 15) * 64, 0, 0}; return d; }
          v -= 256;
          const int mat = v >> 2, tl4 = v & 3, type = mat / 20, dnb = mat % 20, dd = dnb / 10, nb = dnb % 10;
          d = CD{(type ? P.in[32] : P.in[30]) + (size_t)dnb * 128 * 128, (bf16_t*)(ws + W_LRUG) + (size_t)(nb * 2 + dd) * 256 * 128,
                 128, 128, (tl4 >> 1) * 64, (tl4 & 1) * 64, type + 1, 0};
          return d;
        }
        const int v = u - NDENSE, le = v / 384, r = v - le * 384, kind = r >> 7, tt = r & 127;
        if (kind < 2) d = CD{(kind == 0 ? P.in[13] : P.in[14]) + (size_t)le * 1024 * 512, (bf16_t*)(ws + W_EGU) + (size_t)le * 1024 * 1024,
                             512, 1024, (tt >> 3) * 64, (tt & 7) * 64, kind + 1, le >= 32 ? 1 : 0};
        else d = CD{P.in[15] + (size_t)le * 512 * 1024, (bf16_t*)(ws + W_ED) + (size_t)le * 1024 * 512, 1024, 512, (tt >> 4) * 64, (tt & 15) * 64, 0, le >= 32 ? 1 : 0};
        return d;
      };
      const int tq = tid, lrow = tq >> 3, c4 = (tq & 7) * 4, sn = tq >> 3, kg = (tq & 7) * 8;
      float (*tl0)[65] = (float (*)[65])smem;
      float (*tl1)[65] = (float (*)[65])(smem + 64 * 65);
      int u = blockIdx.x;
      CD d0 = desc(u < NTOT ? u : 0), d1 = desc(u + G < NTOT ? u + G : 0);
      float4 a0, b0, a1, b1;
      a0 = ntload4(&d0.src[(size_t)(d0.k0 + lrow) * d0.ldn + d0.n0 + c4]);
      b0 = ntload4(&d0.src[(size_t)(d0.k0 + lrow) * d0.ldn + d0.n0 + 32 + c4]);
      a1 = ntload4(&d1.src[(size_t)(d1.k0 + lrow) * d1.ldn + d1.n0 + c4]);
      b1 = ntload4(&d1.src[(size_t)(d1.k0 + lrow) * d1.ldn + d1.n0 + 32 + c4]);
      for (; u < NTOT; u += 2 * G) {
        const bool v1 = u + G < NTOT;
        tl0[lrow][c4 + 0] = a0.x; tl0[lrow][c4 + 1] = a0.y; tl0[lrow][c4 + 2] = a0.z; tl0[lrow][c4 + 3] = a0.w;
        tl0[lrow][32 + c4 + 0] = b0.x; tl0[lrow][32 + c4 + 1] = b0.y; tl0[lrow][32 + c4 + 2] = b0.z; tl0[lrow][32 + c4 + 3] = b0.w;
        tl1[lrow][c4 + 0] = a1.x; tl1[lrow][c4 + 1] = a1.y; tl1[lrow][c4 + 2] = a1.z; tl1[lrow][c4 + 3] = a1.w;
        tl1[lrow][32 + c4 + 0] = b1.x; tl1[lrow][32 + c4 + 1] = b1.y; tl1[lrow][32 + c4 + 2] = b1.z; tl1[lrow][32 + c4 + 3] = b1.w;
        __syncthreads();
        const CD c0 = d0, c1 = d1;
        const int un = u + 2 * G;
        if (un < NTOT) {
          d0 = desc(un); d1 = desc(un + G < NTOT ? un + G : un);
          a0 = ntload4(&d0.src[(size_t)(d0.k0 + lrow) * d0.ldn + d0.n0 + c4]);
          b0 = ntload4(&d0.src[(size_t)(d0.k0 + lrow) * d0.ldn + d0.n0 + 32 + c4]);
          a1 = ntload4(&d1.src[(size_t)(d1.k0 + lrow) * d1.ldn + d1.n0 + c4]);
          b1 = ntload4(&d1.src[(size_t)(d1.k0 + lrow) * d1.ldn + d1.n0 + 32 + c4]);
        }
        {
          uint4 o;
          o.x = pack2(tl0[kg + 0][sn], tl0[kg + 1][sn]); o.y = pack2(tl0[kg + 2][sn], tl0[kg + 3][sn]);
          o.z = pack2(tl0[kg + 4][sn], tl0[kg + 5][sn]); o.w = pack2(tl0[kg + 6][sn], tl0[kg + 7][sn]);
          const int h = c0.n0 + sn;
          const int dr = c0.mm == 0 ? h : ((h >> 3) * 16 + (h & 7) + (c0.mm == 2 ? 8 : 0));
          { typedef __attribute__((ext_vector_type(4))) unsigned u4v; const u4v ov = {o.x, o.y, o.z, o.w}; u4v* dp = (u4v*)&c0.dst[(size_t)dr * c0.ldk + c0.k0 + kg];
            if (c0.nt) __builtin_nontemporal_store(ov, dp); else *dp = ov; }
        }
        if (v1) {
          uint4 o;
          o.x = pack2(tl1[kg + 0][sn], tl1[kg + 1][sn]); o.y = pack2(tl1[kg + 2][sn], tl1[kg + 3][sn]);
          o.z = pack2(tl1[kg + 4][sn], tl1[kg + 5][sn]); o.w = pack2(tl1[kg + 6][sn], tl1[kg + 7][sn]);
          const int h = c1.n0 + sn;
          const int dr = c1.mm == 0 ? h : ((h >> 3) * 16 + (h & 7) + (c1.mm == 2 ? 8 : 0));
          { typedef __attribute__((ext_vector_type(4))) unsigned u4v; const u4v ov = {o.x, o.y, o.z, o.w}; u4v* dp = (u4v*)&c1.dst[(size_t)dr * c1.ldk + c1.k0 + kg];
            if (c1.nt) __builtin_nontemporal_store(ov, dp); else *dp = ov; }
        }
        __syncthreads();
      }
    }
  }
  grid.sync();
  {
    const float* modp = (const float*)(ws + WS_MODP);
    const float* adab = P.in[5];
    for (int idx = gtid; idx < 8 * 6144; idx += gstride) {
      const int is = idx / 6144, j = idx - is * 6144, i = is >> 1;
      float a = adab[i * 6144 + j];
      for (int ks = 0; ks < 16; ++ks) a += modp[(size_t)(ks * 8 + is) * 6144 + j];
      mod[idx] = a;
    }
    {
      const bf16_t* DC = (const bf16_t*)(ws + W_DC);
      const bf16_t* WI = (const bf16_t*)(ws + W_FNIN);
      bf16_t* WP = (bf16_t*)(ws + W_FNP);
      gemm_loop<4, true>(shm, 4, vb, 64, G,
        [=](int L, int r) { const int tm = L >> 2; return DC + (size_t)((tm >> 3) * 256 + (tm & 1) * 128 + r) * 256; },
        [=](int L, int cidx) { const int tm = L >> 2; return WI + (size_t)((L & 3) * 256 + cidx) * 1024 + ((tm >> 1) & 3) * 256; }, KOffL(), KOffL(),
        per_m([=](int L, int row, int col0, const f32x4 (&a)[4]) { st16bf(WP + (size_t)((L >> 2) * 128 + row) * 1024 + (L & 3) * 256 + col0, a); }));
    }
  }
  xcd_barrier(xbar);

#define MODV(i, s, j, n) mod[(size_t)(((i) * 2 + (s)) * 6 + (j)) * 1024 + (n)]

  auto resid_epi = [=](int layer, int grow, int gcol0, const f32x4 (&a)[4]) {
    const int s = grow < T_CTX ? 1 : 0;
    const float* gate = &MODV(layer, s, 2, gcol0);
    bf16_t* p = tok + (size_t)grow * DM + gcol0;
    const uint4 x0 = *(const uint4*)p, x1 = *(const uint4*)(p + 8);
    const unsigned xx[8] = {x0.x, x0.y, x0.z, x0.w, x1.x, x1.y, x1.z, x1.w};
    f32x4 o[4];
#pragma unroll
    for (int n = 0; n < 4; ++n) {
      const float4 g4 = *(const float4*)(gate + n * 4);
      o[n][0] = lo2f(xx[2 * n]) + g4.x * a[n][0]; o[n][1] = hi2f(xx[2 * n]) + g4.y * a[n][1];
      o[n][2] = lo2f(xx[2 * n + 1]) + g4.z * a[n][2]; o[n][3] = hi2f(xx[2 * n + 1]) + g4.w * a[n][3];
    }
    st16bf(p, o);
  };

  auto moe_layer = [&](int layer, int t0) __attribute__((always_inline)) {
    ffn_norm_router_phase(P, t0, layer, smem);
    xcd_barrier(xbar);
    int* cnt = (int*)(ws + WS_CNT) + layer * 32 * 32;
    int* list = (int*)(ws + WS_LIST);
    float* asgw = (float*)(ws + WS_ASGW);
    int* ps = (int*)(shm + GEMM_LDS_TOTAL + 64);
    if (tid == 0) {
      int s = 0;
      for (int e = 0; e < 32; ++e) { ps[e] = s; s += (cnt[e * 32] + 127) / 128 * 128; }
      ps[32] = s;
    }
    __syncthreads();
    const int total = ps[32];
    bf16_t* HB = (bf16_t*)(R + R_HB);
    bf16_t* ybuf = (bf16_t*)(R + R_YBUF);
    const bf16_t* WGU = (const bf16_t*)(ws + W_EGU) + (size_t)layer * 32 * 1024 * 1024;
    const bf16_t* WD = (const bf16_t*)(ws + W_ED) + (size_t)layer * 32 * 1024 * 512;
    const int ntile = (total >> 7) * 4;
    auto blk_e = [=](int mb) { int e = 0; for (int q = 1; q < 32; ++q) if (ps[q] <= mb * 128) e = q; return e; };
    const int tail = ntile % G;
    const bool split = tail > 0 && 2 * tail <= G;
    const int nfull = split ? ntile - tail : ntile;
    {
      auto a1 = [=](int L, int r) { const int mb = L >> 2, e = blk_e(mb), rr = mb * 128 - ps[e] + r;
          return (rr < cnt[e * 32]) ? (const bf16_t*)(hb + (size_t)(list[(size_t)e * 33280 + rr] >> 1) * DM) : zrow; };
      auto b1 = [=](int L, int cidx) { const int e = blk_e(L >> 2); return WGU + (size_t)e * 1024 * 1024 + (size_t)((L & 3) * 256 + cidx) * 1024; };
      auto e1 = [=](int L, int row, int col0, const f32x4 (&a)[4]) {
          const int n0 = (L & 3) * 256, m0 = (L >> 2) * 128;
          float hv[8];
#pragma unroll
          for (int j = 0; j < 8; ++j) { const float gv = a[j >> 2][j & 3], uv = a[2 + (j >> 2)][j & 3]; hv[j] = silu_f(gv) * uv; }
          uint4 o; o.x = pack2(hv[0], hv[1]); o.y = pack2(hv[2], hv[3]); o.z = pack2(hv[4], hv[5]); o.w = pack2(hv[6], hv[7]);
          *(uint4*)&HB[(size_t)(m0 + row) * 512 + ((n0 + col0) >> 1)] = o;
        };
      gemm_loop<4, true>(shm, 16, vb, nfull, G, a1, b1, KOffL(), KOffL(), per_m(e1));
      if (split)
        gemm_loop<2, true>(shm, 16, vb, 2 * tail, G,
          [=](int H, int r) { return a1(nfull + (H >> 1), r + 64 * (H & 1)); },
          [=](int H, int cidx) { return b1(nfull + (H >> 1), cidx); }, KOffL(), KOffL(),
          per_m([=](int H, int row, int col0, const f32x4 (&a)[4]) { e1(nfull + (H >> 1), row + 64 * (H & 1), col0, a); }));
    }
    xcd_barrier(xbar);
    {
      auto a2 = [=](int L, int r) { return (const bf16_t*)(HB + (size_t)((L >> 2) * 128 + r) * 512); };
      auto b2 = [=](int L, int cidx) { const int e = blk_e(L >> 2); return WD + (size_t)e * 1024 * 512 + (size_t)((L & 3) * 256 + cidx) * 512; };
      auto e2 = [=](int L, int row, int col0, const f32x4 (&a)[4]) {
          const int mb = L >> 2, n0 = (L & 3) * 256, e = blk_e(mb), rr = mb * 128 - ps[e] + row;
          if (rr < cnt[e * 32]) {
            const int rt = list[(size_t)e * 33280 + rr];
            const float w = asgw[rt];
            f32x4 bq[4];
#pragma unroll
            for (int n = 0; n < 4; ++n) bq[n] = a[n] * w;
            st16bf(ybuf + (size_t)rt * 1024 + n0 + col0, bq);
          }
        };
      gemm_loop<4, true>(shm, 8, vb, nfull, G, a2, b2, KOffL(), KOffL(), per_m(e2));
      if (split)
        gemm_loop<2, true>(shm, 8, vb, 2 * tail, G,
          [=](int H, int r) { return a2(nfull + (H >> 1), r + 64 * (H & 1)); },
          [=](int H, int cidx) { return b2(nfull + (H >> 1), cidx); }, KOffL(), KOffL(),
          per_m([=](int H, int row, int col0, const f32x4 (&a)[4]) { e2(nfull + (H >> 1), row + 64 * (H & 1), col0, a); }));
    }
    xcd_barrier(xbar);
  };

  {
    norm_phase(P, 0, P.in[6] + 0 * 1024, 0, 0, -2, 0, false, false, 0, smem);
    xcd_barrier(xbar);
    bf16_t* zu = (bf16_t*)(R + R0_ZU); bf16_t* zvT = (bf16_t*)(R + R0_ZVT); bf16_t* pb = (bf16_t*)(R + R0_P);
    bf16_t* Wsc = (bf16_t*)(R + R0_WSC);
    const float* vg = P.in[17]; const float* w_s = P.in[18]; const float* b_s = P.in[19];
    const bf16_t* Wt = (const bf16_t*)(ws + W_CMIN);
    {
      auto epi_u = [=](int grow, int gcol0, const f32x4 (&a)[4]) {
        f32x4 bq[4];
#pragma unroll
        for (int n = 0; n < 4; ++n)
#pragma unroll
          for (int j = 0; j < 4; ++j) bq[n][j] = gelu_f(a[n][j]);
        st16bf(zu + (size_t)grow * 1024 + gcol0, bq);
      };
      auto epi_vT = [=](int vcol, int t0c, const f32x4 (&a)[4]) {
        f32x4 bq[4];
#pragma unroll
        for (int n = 0; n < 4; ++n)
#pragma unroll
          for (int j = 0; j < 4; ++j) bq[n][j] = gelu_f(a[n][j]);
        st16bf(zvT + ((size_t)(t0c >> 7) * 1024 + vcol) * 128 + (t0c & 127), bq);
      };
      gemm_run<8, true>(shm, 16, vb, 256, G,
        [=](int L, int r) { return (const bf16_t*)(hb + (size_t)((1 + (L >> 2)) * 256 + r) * DM); },
        [=](int L, int cidx) { return Wt + (size_t)((L & 3) * 256 + cidx) * 1024; }, KOffL(), KOffL(),
        per_m([=](int L, int row, int col0, const f32x4 (&a)[4]) { epi_u((1 + (L >> 2)) * 256 + row, (L & 3) * 256 + col0, a); }));
      gemm_run<8, true>(shm, 16, vb, 256, G,
        [=](int L, int r) { return Wt + (size_t)((4 + (L & 3)) * 256 + r) * 1024; },
        [=](int L, int cidx) { return (const bf16_t*)(hb + (size_t)((1 + (L >> 2)) * 256 + cidx) * DM); }, KOffL(), KOffL(),
        per_m([=](int L, int row, int col0, const f32x4 (&a)[4]) { epi_vT((L & 3) * 256 + row, (1 + (L >> 2)) * 256 + col0, a); }));
      skinny_items(shm, vb, 128, G,
        [=](int it, int r) { return it < 64 ? (const bf16_t*)(hb + (size_t)((it >> 4) * 64 + r) * DM) : Wt + (size_t)(1024 + ((it - 64) >> 2) * 64 + r) * 1024; },
        [=](int it, int c) { return it < 64 ? Wt + (size_t)((it & 15) * 64 + c) * 1024 : (const bf16_t*)(hb + (size_t)(((it - 64) & 3) * 64 + c) * DM); },
        [=](int it, int row, int col0, const f32x4 (&a)[4]) {
          if (it < 64) epi_u((it >> 4) * 64 + row, (it & 15) * 64 + col0, a);
          else epi_vT(((it - 64) >> 2) * 64 + row, ((it - 64) & 3) * 64 + col0, a);
        });
    }
    xcd_barrier(xbar);
    {
      float* s_part = smem;
      float* s_rv = smem + 4096;
      for (int n = blockIdx.x; n < NCH; n += G) {
        {
          const int tq = tid, cg = tq >> 4, sg = tq & 15;
          float ss8[8];
#pragma unroll
          for (int e = 0; e < 8; ++e) ss8[e] = 0.f;
          for (int it = 0; it < 32; it += 4) {
            uint4 z[4];
#pragma unroll
            for (int u = 0; u < 4; ++u) z[u] = *(const uint4*)&zvT[((size_t)n * 1024 + (it + u) * 32 + cg) * 128 + sg * 8];
#pragma unroll
            for (int u = 0; u < 4; ++u) {
              const unsigned zz[4] = {z[u].x, z[u].y, z[u].z, z[u].w};
#pragma unroll
              for (int e = 0; e < 4; ++e) { const float a = lo2f(zz[e]), b2 = hi2f(zz[e]); ss8[2 * e] += a * a; ss8[2 * e + 1] += b2 * b2; }
            }
          }
#pragma unroll
          for (int e = 0; e < 8; ++e) s_part[cg * 128 + sg * 8 + e] = ss8[e];
        }
        __syncthreads();
        if (tid < 128) {
          float a = 0.f;
          for (int q = 0; q < 32; ++q) a += s_part[q * 128 + tid];
          s_rv[tid] = 1.f / sqrtf(a * (1.f / 1024.f) + EPSN);
        }
        __syncthreads();
        for (int idx = tid; idx < 4 * 128 * 32; idx += NT) {
          const int s4 = (idx & 31) * 4, gt = idx >> 5;
          const float4 w4 = *(const float4*)&w_s[(size_t)gt * 128 + s4];
          uint2 o; o.x = pack2(w4.x * s_rv[s4], w4.y * s_rv[s4 + 1]); o.y = pack2(w4.z * s_rv[s4 + 2], w4.w * s_rv[s4 + 3]);
          *(uint2*)&Wsc[((size_t)n * 512 + gt) * 128 + s4] = o;
        }
        __syncthreads();
      }
    }
    xcd_barrier(xbar);
    {
      gemm_bal<4, true, true>(shm, 2, vb, NCH * 4, G,
        [=](int L, int r) { return (const bf16_t*)(Wsc + ((size_t)(L >> 2) * 512 + (L & 3) * 128 + r) * 128); },
        [=](int L, int cidx) { return (const bf16_t*)(zvT + ((size_t)(L >> 2) * 1024 + (L & 3) * 256 + cidx) * 128); },
        KOffL(), KOffL(),
        ([=](int L, int row, int col0, const f32x4 (&a)[4]) {
          const int n = L >> 2, g = L & 3;
          const int t = n * 128 + row, col = g * 256 + col0;
          const float bias = b_s[g * 128 + row];
          const uint4 u0 = *(const uint4*)&zu[(size_t)t * 1024 + col], u1 = *(const uint4*)&zu[(size_t)t * 1024 + col + 8];
          const unsigned uu[8] = {u0.x, u0.y, u0.z, u0.w, u1.x, u1.y, u1.z, u1.w};
          f32x4 o[4];
#pragma unroll
          for (int nn = 0; nn < 4; ++nn) {
            const float4 g4 = *(const float4*)&vg[col + nn * 4];
            o[nn][0] = lo2f(uu[nn * 2]) * (a[nn][0] * g4.x + bias);
            o[nn][1] = hi2f(uu[nn * 2]) * (a[nn][1] * g4.y + bias);
            o[nn][2] = lo2f(uu[nn * 2 + 1]) * (a[nn][2] * g4.z + bias);
            o[nn][3] = hi2f(uu[nn * 2 + 1]) * (a[nn][3] * g4.w + bias);
          }
          st16bf(pb + (size_t)t * 1024 + col, o);
        }));
    }
    xcd_barrier(xbar);
    const bf16_t* Wo = (const bf16_t*)(ws + W_CMOUT);
    auto epi_out = [=](int grow, int gcol0, const f32x4 (&a)[4]) { resid_epi(0, grow, gcol0, a); };
    dense_phase(shm, vb, G, pb, 1024, Wo, 1024, 4, 16, 2, epi_out);
    xcd_barrier(xbar);
  }
  moe_layer(0, 0);

  {
    norm_phase(P, 0, P.in[6] + 1 * 1024, 1, 0, 0, 0, false, false, 0, smem);
    xcd_barrier(xbar);
    bf16_t* ZQK = (bf16_t*)(R + R1_ZQK); bf16_t* ZO = (bf16_t*)(R + R1_ZO); bf16_t* VT = (bf16_t*)(R + R1_VT);
    float* gpre = (float*)(R + R1_GPRE); bf16_t* Qn = (bf16_t*)(R + R1_QN); bf16_t* Kn = (bf16_t*)(R + R1_KN);
    bf16_t* AS = (bf16_t*)(R + R1_AS); bf16_t* KwT = (bf16_t*)(R + R1_KWT);
    float* bc = (float*)(R + R1_BC); float* li = (float*)(R + R1_LI); float* egch = (float*)(R + R1_GCH);
    float* nloc = (float*)(R + R1_NLOC); float* nin = (float*)(R + R1_NIN);
    float* Cloc = (float*)(R + R1_CLOC); bf16_t* CinT = (bf16_t*)(R + R1_CINT); bf16_t* hnum = (bf16_t*)(R + R1_CLOC);
    bf16_t* A2 = (bf16_t*)(R + R1_A2);
    const float* w_in = P.in[21]; const float* cw = P.in[22]; const float* cb = P.in[23];
    const float* gb = P.in[24]; const float* ng = P.in[25];
    const bf16_t* Wt = (const bf16_t*)(ws + W_MLIN);
    {
      auto epi_nat = [=](int grow, int gcol0, const f32x4 (&a)[4]) {
        if (gcol0 < 1024) st16bf(ZQK + (size_t)grow * 1024 + gcol0, a); else st16bf(ZO + (size_t)grow * 1024 + gcol0 - 2048, a);
      };
      auto epi_vt = [=](int vcol, int t0c, const f32x4 (&a)[4]) {
        st16bf(VT + ((size_t)(t0c >> 7) * 1024 + vcol) * 128 + (t0c & 127), a);
      };
      {
        const bf16_t* WG = (const bf16_t*)(ws + WS_HLO);
        skinny_items(shm, vb, T_ALL / 64, G,
          [=](int it, int r) { return (const bf16_t*)(hb + (size_t)(it * 64 + r) * DM); },
          [=](int it, int c) { return c < 32 ? WG + (size_t)c * 1024 : zrow; },
          [=](int it, int row, int col0, const f32x4 (&a)[4]) {
            if (col0 < 32) {
              float* gp = gpre + (size_t)(it * 64 + row) * 16 + (col0 >> 1);
              *(float4*)gp = make_float4(a[0][0] + a[0][1], a[0][2] + a[0][3], a[1][0] + a[1][1], a[1][2] + a[1][3]);
              *(float4*)(gp + 4) = make_float4(a[2][0] + a[2][1], a[2][2] + a[2][3], a[3][0] + a[3][1], a[3][2] + a[3][3]);
            }
          });
      }
      gemm_run<8, true>(shm, 16, vb, 512, G,
        [=](int L, int r) { return (const bf16_t*)(hb + (size_t)((1 + (L >> 3)) * 256 + r) * DM); },
        [=](int L, int cidx) { const int j = L & 7, tn = j < 4 ? j : j + 4; return Wt + (size_t)(tn * 256 + cidx) * 1024; }, KOffL(), KOffL(),
        per_m([=](int L, int row, int col0, const f32x4 (&a)[4]) { const int j = L & 7, tn = j < 4 ? j : j + 4; epi_nat((1 + (L >> 3)) * 256 + row, tn * 256 + col0, a); }));
      gemm_run<8, true>(shm, 16, vb, 256, G,
        [=](int L, int r) { return Wt + (size_t)((4 + (L & 3)) * 256 + r) * 1024; },
        [=](int L, int cidx) { return (const bf16_t*)(hb + (size_t)((1 + (L >> 2)) * 256 + cidx) * DM); }, KOffL(), KOffL(),
        per_m([=](int L, int row, int col0, const f32x4 (&a)[4]) { epi_vt((L & 3) * 256 + row, (1 + (L >> 2)) * 256 + col0, a); }));
      skinny_items(shm, vb, 192, G,
        [=](int it, int r) { return it < 128 ? (const bf16_t*)(hb + (size_t)((it >> 5) * 64 + r) * DM) : Wt + (size_t)(1024 + ((it - 128) >> 2) * 64 + r) * 1024; },
        [=](int it, int c) { const int cb = it & 31, col = cb < 16 ? cb * 64 : 2048 + (cb - 16) * 64;
          return it < 128 ? Wt + (size_t)(col + c) * 1024 : (const bf16_t*)(hb + (size_t)(((it - 128) & 3) * 64 + c) * DM); },
        [=](int it, int row, int col0, const f32x4 (&a)[4]) {
          if (it < 128) { const int cb = it & 31, col = cb < 16 ? cb * 64 : 2048 + (cb - 16) * 64; epi_nat((it >> 5) * 64 + row, col + col0, a); }
          else epi_vt(((it - 128) >> 2) * 64 + row, ((it - 128) & 3) * 64 + col0, a);
        });
    }
    xcd_barrier(xbar);
    {
      float* s_bc = smem;
      float* s_w  = smem + 1024;
      float* s_k  = smem + 2048;
      const int wv = tid >> 6, lane = tid & 63;
      auto prep_item = [&](int n, int h0, int hc) __attribute__((always_inline)) {
        if ((wv & 3) >= h0 && (wv & 3) < h0 + hc) {
          const int dh = wv, d = dh >> 2, hd = dh & 3;
          const int p0 = 2 * lane, p1 = p0 + 1;
          const int t0 = n * 128 + (d == 0 ? p0 : 127 - p0), t1 = n * 128 + (d == 0 ? p1 : 127 - p1);
          const float li0 = gpre[(size_t)t0 * 16 + d * 8 + hd] + gb[d * 8 + hd];
          const float li1 = gpre[(size_t)t1 * 16 + d * 8 + hd] + gb[d * 8 + hd];
          const float lf0 = logsig_f(gpre[(size_t)t0 * 16 + d * 8 + 4 + hd] + gb[d * 8 + 4 + hd]);
          const float lf1 = logsig_f(gpre[(size_t)t1 * 16 + d * 8 + 4 + hd] + gb[d * 8 + 4 + hd]);
          float run = lf0 + lf1;
#pragma unroll
          for (int o = 1; o < 64; o <<= 1) { const float y = __shfl_up(run, o); if (lane >= o) run += y; }
          const float b1 = run, b0 = run - lf1;
          const float g = __shfl(run, 63);
          bc[(size_t)dh * T_ALL + t0] = expf(b0); bc[(size_t)dh * T_ALL + t1] = expf(b1);
          li[(size_t)dh * T_ALL + t0] = expf(li0 - b0); li[(size_t)dh * T_ALL + t1] = expf(li1 - b1);
          s_bc[dh * 128 + (t0 & 127)] = b0; s_bc[dh * 128 + (t1 & 127)] = b1;
          s_w[dh * 128 + (t0 & 127)] = expf(g - b0 + li0); s_w[dh * 128 + (t1 & 127)] = expf(g - b1 + li1);
          if (lane == 0) egch[dh * NCH + n] = expf(g);
        }
        __syncthreads();
        const int lo = n < 2 ? 0 : T_CTX, hi = n < 2 ? T_CTX : T_ALL;
        const int qsh = hc == 2 ? 5 : 4;
        for (int ib = tid; ib < (128 << qsh); ib += 4 * NT) {
          uint4 zq[4][4];
#pragma unroll
          for (int u = 0; u < 4; ++u) {
            const int idx = ib + u * NT, tl = idx >> qsh, c0 = h0 * 128 + (idx & ((1 << qsh) - 1)) * 8, t = n * 128 + tl;
#pragma unroll
            for (int j = 0; j < 4; ++j) {
              const int tt = t + j - 2, ttc = tt < lo ? lo : (tt >= hi ? hi - 1 : tt);
              uint4 v = *(const uint4*)&ZQK[(size_t)ttc * 1024 + c0];
              if (tt != ttc) v = make_uint4(0u, 0u, 0u, 0u);
              zq[u][j] = v;
            }
          }
#pragma unroll
          for (int u = 0; u < 4; ++u) {
          const int idx = ib + u * NT;
          const int tl = idx >> qsh, c0 = h0 * 128 + (idx & ((1 << qsh) - 1)) * 8, t = n * 128 + tl, hd = c0 >> 7;
          float q[8];
#pragma unroll
          for (int e = 0; e < 8; ++e) q[e] = cb[c0 + e];
#pragma unroll
          for (int j = 0; j < 4; ++j) {
            const uint4 z = zq[u][j];
            const float4 w0 = *(const float4*)&cw[j * 1024 + c0], w1 = *(const float4*)&cw[j * 1024 + c0 + 4];
            q[0] += lo2f(z.x) * w0.x; q[1] += hi2f(z.x) * w0.y; q[2] += lo2f(z.y) * w0.z; q[3] += hi2f(z.y) * w0.w;
            q[4] += lo2f(z.z) * w1.x; q[5] += hi2f(z.z) * w1.y; q[6] += lo2f(z.w) * w1.z; q[7] += hi2f(z.w) * w1.w;
          }
#pragma unroll
          for (int e = 0; e < 8; ++e) q[e] = silu_f(q[e]) * 0.08838834764831845f;
          uint4 o; o.x = pack2(q[0], q[1]); o.y = pack2(q[2], q[3]); o.z = pack2(q[4], q[5]); o.w = pack2(q[6], q[7]);
          *(uint4*)&Qn[(size_t)t * 512 + c0] = o;
#pragma unroll
          for (int d = 0; d < 2; ++d) {
            const int dh = d * 4 + hd;
            const float eb = expf(s_bc[dh * 128 + tl]);
            uint4 o2; o2.x = pack2(q[0] * eb, q[1] * eb); o2.y = pack2(q[2] * eb, q[3] * eb); o2.z = pack2(q[4] * eb, q[5] * eb); o2.w = pack2(q[6] * eb, q[7] * eb);
            *(uint4*)&AS[((size_t)dh * T_ALL + t) * 256 + 128 + (c0 & 127)] = o2;
          }
          }
        }
        for (int hd = h0; hd < h0 + hc; ++hd) {
          for (int ib = tid; ib < 128 * 16; ib += 4 * NT) {
            uint4 zk[4][4];
#pragma unroll
            for (int u = 0; u < 4; ++u) {
              const int idx = ib + u * NT, tl = idx >> 4, k0 = (idx & 15) * 8, t = n * 128 + tl, c0 = 512 + hd * 128 + k0;
#pragma unroll
              for (int j = 0; j < 4; ++j) {
                const int tt = t + j - 2, ttc = tt < lo ? lo : (tt >= hi ? hi - 1 : tt);
                uint4 v = *(const uint4*)&ZQK[(size_t)ttc * 1024 + c0];
                if (tt != ttc) v = make_uint4(0u, 0u, 0u, 0u);
                zk[u][j] = v;
              }
            }
#pragma unroll
            for (int u = 0; u < 4; ++u) {
            const int idx = ib + u * NT;
            const int tl = idx >> 4, k0 = (idx & 15) * 8, t = n * 128 + tl, c0 = 512 + hd * 128 + k0;
            float q[8];
#pragma unroll
            for (int e = 0; e < 8; ++e) q[e] = cb[c0 + e];
#pragma unroll
            for (int j = 0; j < 4; ++j) {
              const uint4 z = zk[u][j];
              const float4 w0 = *(const float4*)&cw[j * 1024 + c0], w1 = *(const float4*)&cw[j * 1024 + c0 + 4];
              q[0] += lo2f(z.x) * w0.x; q[1] += hi2f(z.x) * w0.y; q[2] += lo2f(z.y) * w0.z; q[3] += hi2f(z.y) * w0.w;
              q[4] += lo2f(z.z) * w1.x; q[5] += hi2f(z.z) * w1.y; q[6] += lo2f(z.w) * w1.z; q[7] += hi2f(z.w) * w1.w;
            }
#pragma unroll
            for (int e = 0; e < 8; ++e) { q[e] = silu_f(q[e]); s_k[tl * 129 + k0 + e] = q[e]; }
            uint4 o; o.x = pack2(q[0], q[1]); o.y = pack2(q[2], q[3]); o.z = pack2(q[4], q[5]); o.w = pack2(q[6], q[7]);
            *(uint4*)&Kn[(size_t)t * 512 + hd * 128 + k0] = o;
            }
          }
          __syncthreads();
          for (int idx = tid; idx < 2 * 128 * 16; idx += NT) {
            const int d = idx >> 11, rem = idx & 2047, kk = rem >> 4, s0 = (rem & 15) * 8, dh = d * 4 + hd;
            float v8[8];
#pragma unroll
            for (int e = 0; e < 8; ++e) v8[e] = s_w[dh * 128 + s0 + e] * s_k[(s0 + e) * 129 + kk];
            uint4 o; o.x = pack2(v8[0], v8[1]); o.y = pack2(v8[2], v8[3]); o.z = pack2(v8[4], v8[5]); o.w = pack2(v8[6], v8[7]);
            *(uint4*)&KwT[((size_t)dh * T_ALL + n * 128 + kk) * 128 + s0] = o;
          }
          if (tid < 256) {
            const int d = tid >> 7, kk = tid & 127, dh = d * 4 + hd;
            float a = 0.f;
            for (int s2 = 0; s2 < 128; ++s2) a += s_w[dh * 128 + s2] * s_k[s2 * 129 + kk];
            nloc[(dh * NCH + n) * 128 + kk] = a;
          }
          __syncthreads();
        }
      };
      const int nitem = NCH * 2, xtra = nitem - G;
      if (xtra > 0 && 4 * xtra <= G) {
        const int b = blockIdx.x, nsolo = G - 2 * xtra;
        if (b < nsolo) prep_item(b >> 1, (b & 1) * 2, 2);
        else {
          for (int u = 3 * (b - nsolo); u < 3 * (b - nsolo) + 3; ++u) {
            const int it = nsolo + (u >> 1);
            prep_item(it >> 1, (it & 1) * 2 + (u & 1), 1);
          }
        }
      } else {
        for (int it = blockIdx.x; it < nitem; it += G) prep_item(it >> 1, (it & 1) * 2, 2);
      }
    }
    xcd_barrier(xbar);
    bf16_t* Clocb = (bf16_t*)Cloc;
    gemm_bal<4, true, true>(shm, 2, vb, 1040, G,
      [=](int L, int r) { const int n = L >> 3, hd = (L >> 1) & 3, mh = L & 1; return (const bf16_t*)(VT + ((size_t)n * 1024 + hd * 256 + mh * 128 + r) * 128); },
      [=](int L, int cidx) { const int n = L >> 3, hd = (L >> 1) & 3, dh = (cidx >> 7) * 4 + hd; return (const bf16_t*)(KwT + ((size_t)dh * T_ALL + n * 128 + (cidx & 127)) * 128); },
      KOffL(), KOffL(),
      [=](int L, int row, int col0, const f32x4 (&a)[4]) {
        const int n = L >> 3, hd = (L >> 1) & 3, mh = L & 1, dh = (col0 >> 7) * 4 + hd;
        st16bf(Clocb + (size_t)(dh * NCH + n) * 32768 + (size_t)(mh * 128 + row) * 128 + (col0 & 127), a);
      });
    gemm_bal<4, true, true>(shm, 2, (vb - 32 + G) % G, 520, G,
      [=](int L, int r) { const int hd = L / NCH, n = L - hd * NCH; return (const bf16_t*)(Qn + (size_t)(n * 128 + r) * 512 + hd * 128); },
      [=](int L, int cidx) { const int hd = L / NCH, n = L - hd * NCH; return cidx < 128 ? (const bf16_t*)(Kn + (size_t)(n * 128 + cidx) * 512 + hd * 128) : zrow; },
      KOffL(), KOffL(),
      ([=](int L, int row, int col0, const f32x4 (&a)[4]) {
        const int hd = L / NCH, n = L - hd * NCH;
        if (col0 < 128) {
          const int tt = n * 128 + row;
#pragma unroll
          for (int d = 0; d < 2; ++d) {
            const int dh = d * 4 + hd;
            const float bt = bc[(size_t)dh * T_ALL + tt];
            const float* cf = li + (size_t)dh * T_ALL + n * 128 + col0;
            f32x4 o[4];
#pragma unroll
            for (int nn = 0; nn < 4; ++nn) {
              const float4 c4 = *(const float4*)(cf + nn * 4);
              const float cv[4] = {c4.x, c4.y, c4.z, c4.w};
#pragma unroll
              for (int j = 0; j < 4; ++j) {
                const int sc = col0 + nn * 4 + j;
                const bool ok = (d == 0) ? (sc <= row) : (sc >= row);
                o[nn][j] = ok ? a[nn][j] * bt * cv[j] : 0.f;
              }
            }
            st16bf(AS + ((size_t)dh * T_ALL + tt) * 256 + col0, o);
          }
        }
      }));
    xcd_barrier(xbar);
    const unsigned* Clocp = (const unsigned*)(R + R1_CLOC);
    unsigned* CinTp = (unsigned*)CinT;
    for (int idx = gtid; idx < 8 * 16384; idx += gstride) {
      const int dh = idx >> 14, e = idx & 16383, d = dh >> 2;
      const bool hasn = idx < 8 * 128;
      const int dh2 = hasn ? (idx >> 7) : 0, kk = idx & 127, d2 = dh2 >> 2;
      float st = 0.f, st1 = 0.f, st2 = 0.f;
      for (int ib = 0; ib < NCH; ib += 10) {
        unsigned xv[10]; float gv[10], xv2[10], gv2[10];
#pragma unroll
        for (int u = 0; u < 10; ++u) { const int n = scan_order(d, ib + u); xv[u] = Clocp[(size_t)(dh * NCH + n) * 16384 + e]; gv[u] = egch[dh * NCH + n]; }
        if (hasn) {
#pragma unroll
          for (int u = 0; u < 10; ++u) { const int n = scan_order(d2, ib + u); xv2[u] = nloc[(dh2 * NCH + n) * 128 + kk]; gv2[u] = egch[dh2 * NCH + n]; }
        }
#pragma unroll
        for (int u = 0; u < 10; ++u) {
          const int n = scan_order(d, ib + u);
          CinTp[(size_t)(dh * NCH + n) * 16384 + e] = pack2(st, st1);
          st = gv[u] * st + lo2f(xv[u]); st1 = gv[u] * st1 + hi2f(xv[u]);
        }
        if (hasn) {
#pragma unroll
          for (int u = 0; u < 10; ++u) { const int n = scan_order(d2, ib + u); nin[(dh2 * NCH + n) * 128 + kk] = st2; st2 = gv2[u] * st2 + xv2[u]; }
        }
      }
    }
    xcd_barrier(xbar);
    gemm_bal<4, true, true>(shm, 4, vb, 1040, G,
      [=](int L, int r) { const int dh = L / NCH, n = L - dh * NCH; return (const bf16_t*)(AS + ((size_t)dh * T_ALL + n * 128 + r) * 256); },
      [=](int L, int cidx) { const int dh = L / NCH, n = L - dh * NCH, hd = dh & 3; return (const bf16_t*)(VT + ((size_t)n * 1024 + hd * 256 + cidx) * 128); },
      KOffL(),
      [=](int L, int kt) { const int dh = L / NCH, n = L - dh * NCH, hd = dh & 3;
        const int delta = (int)((CinT + (size_t)L * 32768) - (VT + ((size_t)n * 1024 + hd * 256) * 128));
        return kt < 2 ? kt * 64 : delta + (kt - 2) * 64; },
      ([=](int L, int row, int col0, const f32x4 (&a)[4]) {
        const int dh = L / NCH, n = L - dh * NCH;
        st16bf(hnum + ((size_t)dh * T_ALL + n * 128 + row) * 256 + col0, a);
      }));
    xcd_barrier(xbar);
    {
      const int tq = tid, lane = tq & 63, hd = lane >> 4, l16 = lane & 15;
      for (int tt = blockIdx.x * (NT / 64) + (tq >> 6); tt < T_ALL; tt += G * (NT / 64)) {
        const int n = tt >> 7;
        float hs[16];
#pragma unroll
        for (int e = 0; e < 16; ++e) hs[e] = 0.f;
#pragma unroll
        for (int d = 0; d < 2; ++d) {
          const int dh = d * 4 + hd;
          const size_t m = (size_t)dh * T_ALL + tt;
          const uint4 a0 = *(const uint4*)&AS[m * 256 + l16 * 16], a1 = *(const uint4*)&AS[m * 256 + l16 * 16 + 8];
          const uint4 x0 = *(const uint4*)&hnum[m * 256 + l16 * 16], x1 = *(const uint4*)&hnum[m * 256 + l16 * 16 + 8];
          const unsigned aa[8] = {a0.x, a0.y, a0.z, a0.w, a1.x, a1.y, a1.z, a1.w};
          float part = 0.f;
          if (l16 < 8) {
#pragma unroll
            for (int e = 0; e < 8; ++e) part += lo2f(aa[e]) + hi2f(aa[e]);
          } else {
            const float* np = nin + (dh * NCH + n) * 128 + (l16 - 8) * 16;
#pragma unroll
            for (int e = 0; e < 4; ++e) {
              const float4 nv = *(const float4*)(np + e * 4);
              part += lo2f(aa[2 * e]) * nv.x + hi2f(aa[2 * e]) * nv.y + lo2f(aa[2 * e + 1]) * nv.z + hi2f(aa[2 * e + 1]) * nv.w;
            }
          }
          part += __shfl_xor(part, 8); part += __shfl_xor(part, 4); part += __shfl_xor(part, 2); part += __shfl_xor(part, 1);
          const float dn = 1.f / fmaxf(fabsf(part), 1.f);
          const unsigned xx[8] = {x0.x, x0.y, x0.z, x0.w, x1.x, x1.y, x1.z, x1.w};
#pragma unroll
          for (int e = 0; e < 8; ++e) { hs[2 * e] += lo2f(xx[e]) * dn; hs[2 * e + 1] += hi2f(xx[e]) * dn; }
        }
        float ss = 0.f;
#pragma unroll
        for (int e = 0; e < 16; ++e) ss += hs[e] * hs[e];
        ss += __shfl_xor(ss, 8); ss += __shfl_xor(ss, 4); ss += __shfl_xor(ss, 2); ss += __shfl_xor(ss, 1);
        const float r = 1.f / sqrtf(ss * (1.f / 256.f) + EPSN);
        const int col = hd * 256 + l16 * 16;
        const uint4 o0 = *(const uint4*)&ZO[(size_t)tt * 1024 + col], o1 = *(const uint4*)&ZO[(size_t)tt * 1024 + col + 8];
        const unsigned oo[8] = {o0.x, o0.y, o0.z, o0.w, o1.x, o1.y, o1.z, o1.w};
        unsigned res[8];
#pragma unroll
        for (int e = 0; e < 4; ++e) {
          const float4 g4 = *(const float4*)&ng[col + e * 4];
          res[2 * e]     = pack2(hs[4 * e + 0] * r * g4.x * sigmoid_f(lo2f(oo[2 * e])),     hs[4 * e + 1] * r * g4.y * sigmoid_f(hi2f(oo[2 * e])));
          res[2 * e + 1] = pack2(hs[4 * e + 2] * r * g4.z * sigmoid_f(lo2f(oo[2 * e + 1])), hs[4 * e + 3] * r * g4.w * sigmoid_f(hi2f(oo[2 * e + 1])));
        }
        *(uint4*)&A2[(size_t)tt * 1024 + col] = make_uint4(res[0], res[1], res[2], res[3]);
        *(uint4*)&A2[(size_t)tt * 1024 + col + 8] = make_uint4(res[4], res[5], res[6], res[7]);
      }
    }
    xcd_barrier(xbar);
    const bf16_t* Wo = (const bf16_t*)(ws + W_MLOUT);
    auto epi_out = [=](int grow, int gcol0, const f32x4 (&a)[4]) { resid_epi(1, grow, gcol0, a); };
    dense_phase(shm, vb, G, A2, 1024, Wo, 1024, 4, 16, 2, epi_out);
    xcd_barrier(xbar);
  }
  moe_layer(1, 0);

  {
    norm_phase(P, 0, P.in[6] + 2 * 1024, 2, 0, 1, 0, false, false, 0, smem);
    xcd_barrier(xbar);
    bf16_t* Zg = (bf16_t*)(R + R2_ZG); bf16_t* Zx = (bf16_t*)(R + R2_ZX); bf16_t* xc = (bf16_t*)(R + R2_XC);
    bf16_t* LA = (bf16_t*)(R + R2_LA); bf16_t* U = (bf16_t*)(R + R2_U);
    float* cA = (float*)(R + R2_CA); float* cH = (float*)(R + R2_CH);
    float* cin = (float*)(R + R2_CIN); bf16_t* A3 = (bf16_t*)(R + R2_ZX);
    const float* cw = P.in[28]; const float* cb = P.in[29];
    const float* b_a = P.in[31]; const float* b_x = P.in[33];
    const float* SP = (const float*)(ws + W_SP);
    const bf16_t* Wt = (const bf16_t*)(ws + W_LRUIN);
    auto epi_in = [=](int grow, int gcol0, const f32x4 (&a)[4]) {
      if (gcol0 < 1280) {
        f32x4 bq[4];
#pragma unroll
        for (int n = 0; n < 4; ++n)
#pragma unroll
          for (int j = 0; j < 4; ++j) bq[n][j] = gelu_f(a[n][j]);
        st16bf(Zg + (size_t)grow * 1280 + gcol0, bq);
      } else st16bf(Zx + (size_t)grow * 1280 + gcol0 - 1280, a);
    };
    dense_phase<true>(shm, vb, G, hb, 1024, Wt, 1024, 10, 16, 2, epi_in);
    xcd_barrier(xbar);
    for (int idx = gtid; idx < T_ALL * 160; idx += gstride) {
      const int t = idx / 160, c0 = (idx - t * 160) * 8;
      const int lo = t < T_CTX ? 0 : T_CTX, hi = t < T_CTX ? T_CTX : T_ALL;
      float q[8];
#pragma unroll
      for (int e = 0; e < 8; ++e) q[e] = cb[c0 + e];
#pragma unroll
      for (int j = 0; j < 4; ++j) {
        const int tt = t + j - 2;
        if (tt >= lo && tt < hi) {
          const uint4 z = *(const uint4*)&Zx[(size_t)tt * 1280 + c0];
          const float4 w0 = *(const float4*)&cw[j * 1280 + c0], w1 = *(const float4*)&cw[j * 1280 + c0 + 4];
          q[0] += lo2f(z.x) * w0.x; q[1] += hi2f(z.x) * w0.y; q[2] += lo2f(z.y) * w0.z; q[3] += hi2f(z.y) * w0.w;
          q[4] += lo2f(z.z) * w1.x; q[5] += hi2f(z.z) * w1.y; q[6] += lo2f(z.w) * w1.z; q[7] += hi2f(z.w) * w1.w;
        }
      }
      uint4 o; o.x = pack2(q[0], q[1]); o.y = pack2(q[2], q[3]); o.z = pack2(q[4], q[5]); o.w = pack2(q[6], q[7]);
      *(uint4*)&xc[(size_t)t * 1280 + c0] = o;
    }
    xcd_barrier(xbar);
    {
      const bf16_t* WLG = (const bf16_t*)(ws + W_LRUG);
      {
        gemm_bal<8, true, false>(shm, 2, vb, 65 * 20, G,
          [=](int L, int r) { return (const bf16_t*)(xc + (size_t)((L / 20) * 256 + r) * 1280 + ((L % 20) >> 1) * 128); },
          [=](int L, int cidx) { return WLG + ((size_t)(L % 20) * 256 + cidx) * 128; },
          KOffL(), KOffL(),
          [=](int L, int rb, int col0, const auto& a) {
            constexpr int MIe = (int)(sizeof(a) / sizeof(a[0]));
            const int m0 = (L / 20) * 256, q = L % 20, nb = q >> 1, d = q & 1;
            const int c = nb * 128 + (col0 >> 1);
            float ba[8], bx[8], sp8[8];
            {
              const float4 t0 = *(const float4*)&b_a[d * 1280 + c], t1 = *(const float4*)&b_a[d * 1280 + c + 4];
              const float4 t2 = *(const float4*)&b_x[d * 1280 + c], t3 = *(const float4*)&b_x[d * 1280 + c + 4];
              const float4 t4 = *(const float4*)&SP[d * 1280 + c], t5 = *(const float4*)&SP[d * 1280 + c + 4];
              ba[0] = t0.x; ba[1] = t0.y; ba[2] = t0.z; ba[3] = t0.w; ba[4] = t1.x; ba[5] = t1.y; ba[6] = t1.z; ba[7] = t1.w;
              bx[0] = t2.x; bx[1] = t2.y; bx[2] = t2.z; bx[3] = t2.w; bx[4] = t3.x; bx[5] = t3.y; bx[6] = t3.z; bx[7] = t3.w;
              sp8[0] = -8.f * t4.x; sp8[1] = -8.f * t4.y; sp8[2] = -8.f * t4.z; sp8[3] = -8.f * t4.w;
              sp8[4] = -8.f * t5.x; sp8[5] = -8.f * t5.y; sp8[6] = -8.f * t5.z; sp8[7] = -8.f * t5.w;
            }
#pragma unroll
            for (int m = 0; m < MIe; ++m) {
              const int t = m0 + rb + 16 * m;
              const uint4 xv = *(const uint4*)&xc[(size_t)t * 1280 + c];
              const unsigned xx[4] = {xv.x, xv.y, xv.z, xv.w};
              float la8[8], u8[8];
#pragma unroll
              for (int e = 0; e < 8; ++e) {
                const float ra = a[m][e >> 2][e & 3] + ba[e];
                const float rx = a[m][2 + (e >> 2)][e & 3] + bx[e];
                const float la = sigmoid_f(ra) * sp8[e];
                const float x2 = 2.f * la;
                const float em = -x2 * (1.f + x2 * (0.5f + x2 * (0.16666667f + x2 * (0.041666668f + x2 * (0.0083333338f + x2 * 0.0013888889f)))));
                const float xe = (e & 1) ? hi2f(xx[e >> 1]) : lo2f(xx[e >> 1]);
                la8[e] = la;
                u8[e] = __builtin_amdgcn_sqrtf(em) * (sigmoid_f(rx) * xe);
              }
              uint4 o1, o2;
              o1.x = pack2(la8[0], la8[1]); o1.y = pack2(la8[2], la8[3]); o1.z = pack2(la8[4], la8[5]); o1.w = pack2(la8[6], la8[7]);
              o2.x = pack2(u8[0], u8[1]); o2.y = pack2(u8[2], u8[3]); o2.z = pack2(u8[4], u8[5]); o2.w = pack2(u8[6], u8[7]);
              *(uint4*)&LA[((size_t)d * T_ALL + t) * 1280 + c] = o1;
              *(uint4*)&U[((size_t)d * T_ALL + t) * 1280 + c] = o2;
            }
          });
      }
    }
    xcd_barrier(xbar);
    for (int idx = gtid; idx < 2 * NCH * 640; idx += gstride) {
      const int c = (idx % 640) * 2, dn = idx / 640, n = dn % NCH, d = dn / NCH;
      const bf16_t* la_p = LA + (size_t)d * T_ALL * 1280 + c;
      const bf16_t* u_p = U + (size_t)d * T_ALL * 1280 + c;
      float h0 = 0.f, h1 = 0.f, s0 = 0.f, s1 = 0.f;
      for (int sb = 0; sb < 128; sb += 16) {
        unsigned lv[16], uv[16];
#pragma unroll
        for (int e = 0; e < 16; ++e) {
          const size_t o = (size_t)(n * 128 + (d == 0 ? sb + e : 127 - sb - e)) * 1280;
          lv[e] = *(const unsigned*)(la_p + o); uv[e] = *(const unsigned*)(u_p + o);
        }
#pragma unroll
        for (int e = 0; e < 16; ++e) {
          const float l0 = lo2f(lv[e]), l1 = hi2f(lv[e]);
          h0 = __expf(l0) * h0 + lo2f(uv[e]); h1 = __expf(l1) * h1 + hi2f(uv[e]);
          s0 += l0; s1 += l1;
        }
      }
      *(float2*)&cA[(d * NCH + n) * 1280 + c] = make_float2(__expf(s0), __expf(s1));
      *(float2*)&cH[(d * NCH + n) * 1280 + c] = make_float2(h0, h1);
    }
    xcd_barrier(xbar);
    for (int idx = gtid; idx < 2 * 1280; idx += gstride) {
      const int d = idx / 1280, c = idx - d * 1280;
      float st = 0.f;
      for (int ib = 0; ib < NCH; ib += 10) {
        float av[10], hv[10];
#pragma unroll
        for (int u = 0; u < 10; ++u) { const int q = (d * NCH + scan_order(d, ib + u)) * 1280 + c; av[u] = cA[q]; hv[u] = cH[q]; }
#pragma unroll
        for (int u = 0; u < 10; ++u) { const int q = (d * NCH + scan_order(d, ib + u)) * 1280 + c; cin[q] = st; st = av[u] * st + hv[u]; }
      }
    }
    xcd_barrier(xbar);
    const int p2_per = (128 * 640 + G - 1) / G;
    for (int i2 = tid; i2 < p2_per; i2 += NT) {
      const int idx = blockIdx.x * p2_per + i2;
      if (idx >= 128 * 640) break;
      const int c = (idx % 640) * 2, n = 2 + idx / 640;
      float h0, h1;
      { const float2 c2 = *(const float2*)&cin[(0 * NCH + n) * 1280 + c]; h0 = c2.x; h1 = c2.y; }
      for (int sb = 0; sb < 128; sb += 16) {
        unsigned lv[16], uv[16];
#pragma unroll
        for (int e = 0; e < 16; ++e) { const size_t o = (size_t)(n * 128 + sb + e) * 1280 + c; lv[e] = *(const unsigned*)&LA[o]; uv[e] = *(const unsigned*)&U[o]; }
#pragma unroll
        for (int e = 0; e < 16; ++e) {
          h0 = __expf(lo2f(lv[e])) * h0 + lo2f(uv[e]); h1 = __expf(hi2f(lv[e])) * h1 + hi2f(uv[e]);
          *(unsigned*)&A3[(size_t)(n * 128 + sb + e) * 1280 + c] = pack2(h0, h1);
        }
      }
      { const float2 c2 = *(const float2*)&cin[(1 * NCH + n) * 1280 + c]; h0 = c2.x; h1 = c2.y; }
      for (int sb = 0; sb < 128; sb += 16) {
        unsigned lv[16], uv[16], gv[16], hp[16];
#pragma unroll
        for (int e = 0; e < 16; ++e) {
          const size_t o = (size_t)(n * 128 + 127 - sb - e) * 1280 + c;
          lv[e] = *(const unsigned*)&LA[(size_t)T_ALL * 1280 + o]; uv[e] = *(const unsigned*)&U[(size_t)T_ALL * 1280 + o];
          gv[e] = *(const unsigned*)&Zg[o]; hp[e] = *(const unsigned*)&A3[o];
        }
#pragma unroll
        for (int e = 0; e < 16; ++e) {
          h0 = __expf(lo2f(lv[e])) * h0 + lo2f(uv[e]); h1 = __expf(hi2f(lv[e])) * h1 + hi2f(uv[e]);
          *(unsigned*)&A3[(size_t)(n * 128 + 127 - sb - e) * 1280 + c] = pack2(lo2f(gv[e]) * (lo2f(hp[e]) + h0), hi2f(gv[e]) * (hi2f(hp[e]) + h1));
        }
      }
    }
    xcd_barrier(xbar);
    const bf16_t* Wo = (const bf16_t*)(ws + W_LRUOUT);
    auto epi_out = [=](int grow, int gcol0, const f32x4 (&a)[4]) { resid_epi(2, grow, gcol0, a); };
    dense_phase(shm, vb, G, A3, 1280, Wo, 1280, 4, 20, 0, epi_out);
    xcd_barrier(xbar);
  }
  moe_layer(2, T_CTX);

  {
    norm_phase(P, T_CTX, P.in[6] + 3 * 1024, 3, 0, 2, T_CTX, false, false, 0, smem);
    xcd_barrier(xbar);
    bf16_t* YT = (bf16_t*)(R + R3_YT); bf16_t* GT = (bf16_t*)(R + R3_GT); bf16_t* Ff = (bf16_t*)(R + R3_FF);
    const bf16_t* WP = (const bf16_t*)(ws + W_FNP);
    gemm_run<8, true>(shm, 16, vb, 64 * 8, G,
      [=](int L, int r) { return WP + (size_t)((L & 7) * 256 + r) * 1024; },
      [=](int L, int cidx) { return (const bf16_t*)(hb + (size_t)(T_CTX + 128 * (cidx & 127) + 2 * (L >> 3) + (cidx >> 7)) * DM); }, KOffL(), KOffL(),
      per_m([=](int L, int row, int col0, const f32x4 (&a)[4]) {
        const int b = 2 * (L >> 3) + (col0 >> 7), a0 = col0 & 127, nrow = (L & 7) * 256 + row;
        st16bf(YT + ((size_t)b * 2048 + nrow) * 128 + a0, a);
      }));
    xcd_barrier(xbar);
    {
      const bf16_t* DA = (const bf16_t*)(ws + W_DA);
      gemm_run<8, true>(shm, 4, vb, 512, G,
        [=](int L, int r) { return DA + (size_t)r * 256; },
        [=](int L, int cidx) { return (const bf16_t*)(YT + ((size_t)(cidx & 127) * 2048 + 2 * L + (cidx >> 7)) * 128); },
        KOffL(), [=](int L, int kt) { return kt < 2 ? kt * 64 : 1024 * 128 + (kt - 2) * 64; },
        per_m([=](int L, int row, int col0, const f32x4 (&a)[4]) {
          const int ri = row >> 7, c2 = row & 127, colc = 2 * L + (col0 >> 7), b0 = col0 & 127;
          st16bf(GT + (((size_t)c2 * 1024 + colc) * 2 + ri) * 128 + b0, a);
        }));
    }
    xcd_barrier(xbar);
    {
      const bf16_t* TW = (const bf16_t*)(ws + W_TW);
      gemm_loop<4, true>(shm, 4, vb, 128 * 4, G,
        [=](int L, int r) { return TW + ((size_t)(L >> 2) * 128 + r) * 256; },
        [=](int L, int cidx) { return (const bf16_t*)(GT + ((size_t)(L >> 2) * 1024 + (L & 3) * 256 + cidx) * 256); }, KOffL(), KOffL(),
        per_m([=](int L, int row, int col0, const f32x4 (&a)[4]) {
          const int c2 = L >> 2, n0 = (L & 3) * 256;
          f32x4 b[4];
#pragma unroll
          for (int n = 0; n < 4; ++n) b[n] = a[n] * (1.f / 2048.f);
          st16bf(Ff + (size_t)(c2 + 128 * row) * 1024 + n0 + col0, b);
        }));
    }
    xcd_barrier(xbar);
    const bf16_t* Wo = (const bf16_t*)(ws + W_FNOUT);
    const bf16_t* FfA = Ff - (size_t)T_CTX * 1024;
    auto epi_out = [=](int grow, int gcol0, const f32x4 (&a)[4]) { resid_epi(3, grow, gcol0, a); };
    dense_phase(shm, vb, G, FfA, 1024, Wo, 1024, 4, 16, 0, epi_out);
    xcd_barrier(xbar);
  }
  moe_layer(3, T_CTX);

  norm_phase(P, T_CTX, P.in[8], 0, -1, 3, T_CTX, true, false, 0, smem);
}

#undef tid
#undef gtid
#undef gstride
extern "C" void kernel_launch(void* const* d_in, const int* in_sizes, int n_in, void* d_out, int out_size,
                              void* d_ws, size_t ws_size, hipStream_t stream) {
  static int grid_blocks = 0;
  if (!grid_blocks) {
    int dev = 0, cus = 0, per_cu = 0;
    (void)hipGetDevice(&dev);
    (void)hipDeviceGetAttribute(&cus, hipDeviceAttributeMultiprocessorCount, dev);
    (void)hipOccupancyMaxActiveBlocksPerMultiprocessor(&per_cu, mega, NT, 0);
    if (per_cu < 1) fprintf(stderr, "kernel_launch: occupancy query says %d blocks/CU\n", per_cu);
    grid_blocks = cus;
    if (ws_size < WS_NEED) fprintf(stderr, "kernel_launch: workspace too small: %zu < %zu\n", ws_size, (size_t)WS_NEED);
  }
  if (n_in != 38 || ws_size < WS_NEED) return;
  Params p{};
  for (int i = 0; i < 38; ++i) p.in[i] = (const float*)d_in[i];
  p.out = (float*)d_out;
  p.ws = (unsigned char*)d_ws;
  (void)hipMemsetAsync((char*)d_ws + WS_BAR, 0, 16384, stream);
  void* args[] = {&p};
  hipError_t e = hipLaunchCooperativeKernel((void*)mega, dim3(grid_blocks), dim3(NT), args, 0, stream);
  if (e != hipSuccess) fprintf(stderr, "cooperative launch failed: %s (grid %d)\n", hipGetErrorString(e), grid_blocks);
}
```

```cpp
#include <hip/hip_runtime.h>
#include <hip/hip_cooperative_groups.h>
#include <cstdio>
namespace cg = cooperative_groups;

#define T_ALL 16640
#define T_LAT 16384
#define T_CTX 256
#define DM 1024
#define NCH 130
#define EPSN 1e-6f
#define NT 512

typedef unsigned short bf16_t;
using bf16x8 = __attribute__((ext_vector_type(8))) short;
using f32x4 = __attribute__((ext_vector_type(4))) float;

__device__ __forceinline__ float bf2f(bf16_t v) { return __uint_as_float(((unsigned)v) << 16); }
__device__ __forceinline__ bf16_t f2bf(float f) { const __bf16 h = (__bf16)f; return __builtin_bit_cast(unsigned short, h); }
__device__ __forceinline__ unsigned pack2(float a, float b) {
  typedef __attribute__((ext_vector_type(2))) float f32x2_t;
  typedef __attribute__((ext_vector_type(2))) __bf16 bf16x2_t;
  const f32x2_t f = {a, b};
  const bf16x2_t h = __builtin_convertvector(f, bf16x2_t);
  return __builtin_bit_cast(unsigned, h);
}
__device__ __forceinline__ float lo2f(unsigned u) { return __uint_as_float(u << 16); }
__device__ __forceinline__ float hi2f(unsigned u) { return __uint_as_float(u & 0xffff0000u); }

__device__ __forceinline__ int opaque_tid() { int t = threadIdx.x; asm volatile("" : "+v"(t)); return t; }

__device__ __forceinline__ float4 ntload4(const float* p) {
  typedef __attribute__((ext_vector_type(4))) float f4v;
  const f4v v = __builtin_nontemporal_load((const f4v*)p);
  return make_float4(v[0], v[1], v[2], v[3]);
}

constexpr size_t AL(size_t x) { return (x + 255) & ~(size_t)255; }
constexpr size_t WS_MOD    = 0;
constexpr size_t WS_MODP   = AL(WS_MOD + 4 * 2 * 6144 * 4);
constexpr size_t WS_CNT    = AL(WS_MODP + 16 * 4 * 2 * 6144 * 4);
constexpr size_t WS_ZROW   = AL(WS_CNT + 4 * 32 * 32 * 4 + 256);
constexpr size_t WS_BAR    = AL(WS_ZROW + 8192);
constexpr size_t WS_TOK    = AL(WS_BAR + 16384);
constexpr size_t WS_H      = AL(WS_TOK + (size_t)T_ALL * DM * 4);
constexpr size_t WS_HLO    = AL(WS_H + (size_t)T_ALL * DM * 2);
constexpr size_t WS_ASGW   = AL(WS_HLO + (size_t)T_ALL * DM * 2);
constexpr size_t WS_LIST   = AL(WS_ASGW + 33280 * 4);
constexpr size_t WS_ROWTOK = AL(WS_LIST + (size_t)32 * 33280 * 4);
constexpr size_t WS_ROWEXP = AL(WS_ROWTOK + 37376 * 4);
constexpr size_t W_CMIN   = AL(WS_ROWEXP + 292 * 4);
constexpr size_t W_CMOUT  = AL(W_CMIN + (size_t)2048 * 1024 * 2);
constexpr size_t W_MLIN   = AL(W_CMOUT + (size_t)1024 * 1024 * 2);
constexpr size_t W_MLOUT  = AL(W_MLIN + (size_t)3072 * 1024 * 2);
constexpr size_t W_LRUIN  = AL(W_MLOUT + (size_t)1024 * 1024 * 2);
constexpr size_t W_LRUOUT = AL(W_LRUIN + (size_t)2560 * 1024 * 2);
constexpr size_t W_FNIN   = AL(W_LRUOUT + (size_t)1024 * 1280 * 2);
constexpr size_t W_FNP    = AL(W_FNIN + (size_t)1024 * 1024 * 2);
constexpr size_t W_FNOUT  = AL(W_FNP + (size_t)2048 * 1024 * 2);
constexpr size_t W_DC     = AL(W_FNOUT + (size_t)1024 * 1024 * 2);
constexpr size_t W_DA     = AL(W_DC + 512 * 256 * 2);
constexpr size_t W_TW     = AL(W_DA + 256 * 256 * 2);
constexpr size_t W_LRUG   = AL(W_TW + (size_t)128 * 128 * 256 * 2);
constexpr size_t W_SP     = AL(W_LRUG + (size_t)20 * 256 * 128 * 2);
constexpr size_t W_PE     = AL(W_SP + 2 * 1280 * 4);
constexpr size_t W_EGU    = AL(W_PE + (size_t)(2 * 256 + 2 * 64) * 256 * 4);
constexpr size_t W_ED     = AL(W_EGU + (size_t)128 * 1024 * 1024 * 2);
constexpr size_t WS_R     = AL(W_ED + (size_t)128 * 1024 * 512 * 2);
constexpr size_t R_YBUF = 0;
constexpr size_t R_HB   = AL(R_YBUF + (size_t)33280 * 1024 * 2);
constexpr size_t R_MOE_END = AL(R_HB + (size_t)37376 * 512 * 2);
constexpr size_t R0_ZU  = 0;
constexpr size_t R0_ZVT = AL(R0_ZU + (size_t)T_ALL * 1024 * 2);
constexpr size_t R0_P   = AL(R0_ZVT + (size_t)T_ALL * 1024 * 2);
constexpr size_t R0_WSC = AL(R0_P + (size_t)T_ALL * 1024 * 2);
constexpr size_t R0_END = AL(R0_WSC + (size_t)NCH * 4 * 128 * 128 * 2);
constexpr size_t R1_ZQK  = 0;
constexpr size_t R1_ZO   = AL(R1_ZQK + (size_t)T_ALL * 1024 * 2);
constexpr size_t R1_VT   = AL(R1_ZO + (size_t)T_ALL * 1024 * 2);
constexpr size_t R1_GPRE = AL(R1_VT + (size_t)T_ALL * 1024 * 2);
constexpr size_t R1_QN   = AL(R1_GPRE + (size_t)T_ALL * 16 * 4);
constexpr size_t R1_KN   = AL(R1_QN + (size_t)T_ALL * 512 * 2);
constexpr size_t R1_AS   = AL(R1_KN + (size_t)T_ALL * 512 * 2);
constexpr size_t R1_KWT  = AL(R1_AS + (size_t)8 * T_ALL * 256 * 2);
constexpr size_t R1_BC   = AL(R1_KWT + (size_t)8 * T_ALL * 128 * 2);
constexpr size_t R1_LI   = AL(R1_BC + (size_t)8 * T_ALL * 4);
constexpr size_t R1_GCH  = AL(R1_LI + (size_t)8 * T_ALL * 4);
constexpr size_t R1_NLOC = AL(R1_GCH + 8 * NCH * 4);
constexpr size_t R1_NIN  = AL(R1_NLOC + 8 * NCH * 128 * 4);
constexpr size_t R1_CLOC = AL(R1_NIN + 8 * NCH * 128 * 4);
constexpr size_t R1_CINT = AL(R1_CLOC + (size_t)8 * T_ALL * 256 * 4);
constexpr size_t R1_HDEN = AL(R1_CINT + (size_t)8 * T_ALL * 256 * 2);
constexpr size_t R1_A2   = R1_ZQK;
constexpr size_t R1_END  = AL(R1_HDEN + 256);
constexpr size_t R2_ZG  = 0;
constexpr size_t R2_ZX  = AL(R2_ZG + (size_t)T_ALL * 1280 * 2);
constexpr size_t R2_XC  = AL(R2_ZX + (size_t)T_ALL * 1280 * 2);
constexpr size_t R2_LA  = AL(R2_XC + (size_t)T_ALL * 1280 * 2);
constexpr size_t R2_U   = AL(R2_LA + (size_t)2 * T_ALL * 1280 * 2);
constexpr size_t R2_CA  = AL(R2_U + (size_t)2 * T_ALL * 1280 * 2);
constexpr size_t R2_CH  = AL(R2_CA + 2 * NCH * 1280 * 4);
constexpr size_t R2_CIN = AL(R2_CH + 2 * NCH * 1280 * 4);
constexpr size_t R2_END = AL(R2_CIN + 2 * NCH * 1280 * 4);
constexpr size_t R3_YT = 0;
constexpr size_t R3_GT = AL(R3_YT + (size_t)128 * 2048 * 128 * 2);
constexpr size_t R3_FF = AL(R3_GT + (size_t)128 * 2048 * 128 * 2);
constexpr size_t R3_END = AL(R3_FF + (size_t)T_LAT * 1024 * 2);
constexpr size_t cmax(size_t a, size_t b) { return a > b ? a : b; }
constexpr size_t R_SIZE = cmax(cmax(R_MOE_END, R0_END), cmax(cmax(R1_END, R2_END), R3_END));
constexpr size_t WS_NEED = WS_R + R_SIZE;

struct Params { const float* in[38]; float* out; unsigned char* ws; };

__device__ __forceinline__ float sigmoid_f(float x) { return __builtin_amdgcn_rcpf(1.f + __expf(-x)); }
__device__ __forceinline__ float silu_f(float x) { return x * __builtin_amdgcn_rcpf(1.f + __expf(-x)); }
__device__ __forceinline__ float gelu_f(float x) {
  const float u2 = 1.5957691216057308f * (x + 0.044715f * x * x * x);
  return x * __builtin_amdgcn_rcpf(1.f + __expf(-u2));
}
__device__ __forceinline__ float logsig_f(float x) { return fminf(x, 0.f) - log1pf(expf(-fabsf(x))); }
__device__ __forceinline__ float dpp_add(float v, const int ctrl_sel) {
  int x = __float_as_int(v), y;
  if (ctrl_sel == 0) y = __builtin_amdgcn_mov_dpp(x, 0xB1, 0xf, 0xf, false);
  else if (ctrl_sel == 1) y = __builtin_amdgcn_mov_dpp(x, 0x4E, 0xf, 0xf, false);
  else if (ctrl_sel == 2) y = __builtin_amdgcn_mov_dpp(x, 0x141, 0xf, 0xf, false);
  else y = __builtin_amdgcn_mov_dpp(x, 0x140, 0xf, 0xf, false);
  return v + __int_as_float(y);
}
__device__ __forceinline__ float wave_sum(float v) {
  v = dpp_add(v, 0); v = dpp_add(v, 1); v = dpp_add(v, 2); v = dpp_add(v, 3);
  {
    const unsigned x = __float_as_uint(v);
    const auto r = __builtin_amdgcn_permlane16_swap(x, x, false, false);
    v = __uint_as_float(r[0]) + __uint_as_float(r[1]);
  }
  {
    const unsigned x = __float_as_uint(v);
    const auto r = __builtin_amdgcn_permlane32_swap(x, x, false, false);
    v = __uint_as_float(r[0]) + __uint_as_float(r[1]);
  }
  return v;
}
__device__ __forceinline__ float reduce36(const float (&l)[36], int lane) {
  float res = 0.f;
  const int l31 = lane & 31;
#pragma unroll
  for (int q = 0; q < 18; ++q) {
    const auto r = __builtin_amdgcn_permlane32_swap(__float_as_uint(l[2 * q]), __float_as_uint(l[2 * q + 1]), false, false);
    float v = __uint_as_float(r[0]) + __uint_as_float(r[1]);
    v = dpp_add(v, 0); v = dpp_add(v, 1); v = dpp_add(v, 2); v = dpp_add(v, 3);
    const unsigned x = __float_as_uint(v);
    const auto s = __builtin_amdgcn_permlane16_swap(x, x, false, false);
    v = __uint_as_float(s[0]) + __uint_as_float(s[1]);
    if (l31 == q) res = v;
  }
  return res;
}
__device__ __forceinline__ float fold_pair_sum(float x, float y) {
  const auto r = __builtin_amdgcn_permlane32_swap(__float_as_uint(x), __float_as_uint(y), false, false);
  float v = __uint_as_float(r[0]) + __uint_as_float(r[1]);
  v = dpp_add(v, 0); v = dpp_add(v, 1); v = dpp_add(v, 2); v = dpp_add(v, 3);
  const unsigned u = __float_as_uint(v);
  const auto s = __builtin_amdgcn_permlane16_swap(u, u, false, false);
  return __uint_as_float(s[0]) + __uint_as_float(s[1]);
}
__device__ __forceinline__ int scan_order(int d, int i) { return d == 0 ? i : (i == 0 ? 1 : (i == 1 ? 0 : 131 - i)); }
__device__ __forceinline__ void st16bf(bf16_t* p, const f32x4 (&a)[4]) {
  uint4 o0, o1;
  o0.x = pack2(a[0][0], a[0][1]); o0.y = pack2(a[0][2], a[0][3]); o0.z = pack2(a[1][0], a[1][1]); o0.w = pack2(a[1][2], a[1][3]);
  o1.x = pack2(a[2][0], a[2][1]); o1.y = pack2(a[2][2], a[2][3]); o1.z = pack2(a[3][0], a[3][1]); o1.w = pack2(a[3][2], a[3][3]);
  *(uint4*)p = o0; *(uint4*)(p + 8) = o1;
}

__device__ __forceinline__ int lds_byte(int r, int c) {
  const int st = (r >> 4) * 2 + (c >> 5), ob = (r & 15) * 64 + (c & 31) * 2;
  return st * 1024 + (ob ^ (((ob >> 9) & 1) << 5));
}
__device__ __forceinline__ void stage_rc(int b, int& R, int& C) {
  const int st = b >> 10, sb = b & 1023, swz = sb ^ (((sb >> 9) & 1) << 5);
  R = (st >> 1) * 16 + (swz >> 6);
  C = (st & 1) * 32 + ((swz & 63) >> 1);
}
__device__ __forceinline__ int perm_col(int p) {
  const int q = p & 63, n = q >> 4, i = q & 15;
  return (p & ~63) + (i >> 2) * 16 + n * 4 + (i & 3);
}

struct KOffL { __device__ __forceinline__ int operator()(int, int kt) const { return kt * 64; } };
#define GEMM_LDS_TOTAL 147456
template <int MI, bool SWAP, class RA, class RB, class KA, class KB, class EP>
__device__ __forceinline__ void gemm_loop(char* shm, int nk, int Lbeg, int Lend, int Lstep, RA rowA, RB rowB, KA koffA, KB koffB, EP epi) {
  constexpr int BM = 32 * MI, GLA = MI / 2, GLB = 4;
  constexpr int TILE_A = BM * 128, TILE_B = 256 * 128, STG = TILE_A + TILE_B;
  constexpr int NBUF = (3 * STG <= GEMM_LDS_TOTAL) ? 3 : 2;
  static_assert(NBUF * STG <= GEMM_LDS_TOTAL, "LDS");
  if (Lbeg >= Lend) return;
  const int tid = opaque_tid(), wid = tid >> 6, lane = tid & 63, wr = wid >> 2, wc = wid & 3, fr = lane & 15, fq = lane >> 4;
  const bf16_t* pa[GLA];
  const bf16_t* pb[GLB];
#define GL_SETP(L_) do { int t2_ = tid; asm volatile("" : "+v"(t2_)); const int w2_ = t2_ >> 6, l2_ = t2_ & 63;        \
    _Pragma("unroll") for (int i = 0; i < GLA; ++i) { int R_, C_; stage_rc(w2_ * 1024 + i * 8192 + l2_ * 16, R_, C_); pa[i] = rowA((L_), R_) + C_; } \
    _Pragma("unroll") for (int i = 0; i < GLB; ++i) { int R_, C_; stage_rc(w2_ * 1024 + i * 8192 + l2_ * 16, R_, C_); pb[i] = rowB((L_), SWAP ? perm_col(R_) : R_) + C_; } } while (0)
#define GL_ISSUE(buf, kt, L_) do { const int ka_ = koffA((L_), (kt)), kb_ = koffB((L_), (kt)); char* base_ = shm + (buf) * STG;  \
    _Pragma("unroll") for (int i = 0; i < GLA; ++i)                                                                    \
      __builtin_amdgcn_global_load_lds((const unsigned*)(pa[i] + ka_), (unsigned*)(base_ + wid * 1024 + i * 8192), 16, 0, 0); \
    _Pragma("unroll") for (int i = 0; i < GLB; ++i)                                                                    \
      __builtin_amdgcn_global_load_lds((const unsigned*)(pb[i] + kb_), (unsigned*)(base_ + TILE_A + wid * 1024 + i * 8192), 16, 0, 0); } while (0)
#define GL_PIECE(pi, buf, ka_, kb_) do { char* base_ = shm + (buf) * STG;                                              \
    if ((pi) < GLA) __builtin_amdgcn_global_load_lds((const unsigned*)(pa[(pi) < GLA ? (pi) : 0] + (ka_)), (unsigned*)(base_ + wid * 1024 + (pi) * 8192), 16, 0, 0); \
    else __builtin_amdgcn_global_load_lds((const unsigned*)(pb[(pi) >= GLA ? (pi) - GLA : 0] + (kb_)), (unsigned*)(base_ + TILE_A + wid * 1024 + ((pi) - GLA) * 8192), 16, 0, 0); } while (0)
#define GL_RAWBAR() do { asm volatile("s_waitcnt lgkmcnt(0)" ::: "memory"); __builtin_amdgcn_s_barrier(); } while (0)
  const int npre = nk < NBUF ? nk : NBUF;
  GL_SETP(Lbeg);
  for (int s = 0; s < npre; ++s) GL_ISSUE(s, s, Lbeg);
  for (int L = Lbeg; L < Lend; L += Lstep) {
    f32x4 acc[MI][4];
#pragma unroll
    for (int m = 0; m < MI; ++m)
#pragma unroll
      for (int n = 0; n < 4; ++n) acc[m][n] = f32x4{0.f, 0.f, 0.f, 0.f};
    int cur = 0;
    for (int t = 0; t < nk; ++t) {
      if (NBUF == 3 && t >= 1 && t + 1 < nk) {
        if (GLA + GLB == 6) asm volatile("s_waitcnt vmcnt(6)" ::: "memory"); else asm volatile("s_waitcnt vmcnt(5)" ::: "memory");
      } else asm volatile("s_waitcnt vmcnt(0)" ::: "memory");
      GL_RAWBAR();
      const bool doiss = (t >= 1 && t + NBUF - 1 < nk);
      const int nb_ = (cur == 0) ? NBUF - 1 : cur - 1;
      const int ka2 = doiss ? koffA(L, t + NBUF - 1) : 0, kb2 = doiss ? koffB(L, t + NBUF - 1) : 0;
      const char* sa = shm + cur * STG;
      const char* sb = sa + TILE_A;
      const int offA = lds_byte(wr * (MI * 16) + fr, fq * 8), offB = lds_byte(wc * 64 + fr, fq * 8);
#pragma unroll
      for (int ks = 0; ks < 2; ++ks) {
        bf16x8 Bf[4];
#pragma unroll
        for (int n = 0; n < 4; ++n) Bf[n] = *(const bf16x8*)(sb + offB + n * 2048 + ks * 1024);
        constexpr int MG = MI < 4 ? MI : 4;
#pragma unroll
        for (int mh = 0; mh < MI; mh += MG) {
          bf16x8 At[MG];
#pragma unroll
          for (int m = 0; m < MG; ++m) At[m] = *(const bf16x8*)(sa + offA + (mh + m) * 2048 + ks * 1024);
          __builtin_amdgcn_s_setprio(1);
#pragma unroll
          for (int m = 0; m < MG; ++m)
#pragma unroll
            for (int n = 0; n < 4; ++n) {
              if (SWAP) acc[mh + m][n] = __builtin_amdgcn_mfma_f32_16x16x32_bf16(Bf[n], At[m], acc[mh + m][n], 0, 0, 0);
              else      acc[mh + m][n] = __builtin_amdgcn_mfma_f32_16x16x32_bf16(At[m], Bf[n], acc[mh + m][n], 0, 0, 0);
            }
          __builtin_amdgcn_s_setprio(0);
          __builtin_amdgcn_sched_barrier(0);
          if (doiss) {
            constexpr int NG = 2 * (MI / MG), NP = GLA + GLB;
            const int g = ks * (MI / MG) + mh / MG;
#pragma unroll
            for (int pi = 0; pi < NP; ++pi)
              if (pi >= g * NP / NG && pi < (g + 1) * NP / NG) GL_PIECE(pi, nb_, ka2, kb2);
          }
          __builtin_amdgcn_sched_barrier(0);
        }
      }
      cur = (cur == NBUF - 1) ? 0 : cur + 1;
    }
    GL_RAWBAR();
    const int Ln = L + Lstep;
    if (Ln < Lend) { GL_SETP(Ln); for (int s = 0; s < npre; ++s) GL_ISSUE(s, s, Ln); }
    {
      const int t3 = opaque_tid(), w3 = t3 >> 6, l3 = t3 & 63, wr3 = w3 >> 2, wc3 = w3 & 3, fr3 = l3 & 15, fq3 = l3 >> 4;
      if constexpr (SWAP) {
        epi(L, wr3 * (MI * 16) + fr3, wc3 * 64 + fq3 * 16, acc);
      } else {
#pragma unroll
        for (int m = 0; m < MI; ++m)
#pragma unroll
          for (int n = 0; n < 4; ++n) epi(L, wr3 * (MI * 16) + m * 16 + fq3 * 4, wc3 * 64 + n * 16 + fr3, acc[m][n]);
      }
    }
  }
  asm volatile("s_waitcnt vmcnt(0)" ::: "memory");
#undef GL_SETP
#undef GL_ISSUE
#undef GL_PIECE
#undef GL_RAWBAR
}


__device__ __forceinline__ int lds_byte32(int r, int c) {
  const int ob = (r & 15) * 64 + (c & 31) * 2;
  return (r >> 4) * 1024 + (ob ^ (((ob >> 9) & 1) << 5));
}
__device__ __forceinline__ void stage_rc32(int b, int& R, int& C) {
  const int st = b >> 10, sb = b & 1023, swz = sb ^ (((sb >> 9) & 1) << 5);
  R = st * 16 + (swz >> 6);
  C = (swz & 63) >> 1;
}
template <bool SWAP, class RA, class RB, class KA, class KB, class EP>
__device__ __forceinline__ void gemm_loop32(char* shm, int nk, int Lbeg, int Lend, int Lstep, RA rowA, RB rowB, KA koffA, KB koffB, EP epi) {
  constexpr int MI = 8, GLA = 2, GLB = 2;
  constexpr int TILE_A = 256 * 64, TILE_B = 256 * 64, STG = TILE_A + TILE_B, NBUF = 4;
  static_assert(NBUF * STG <= GEMM_LDS_TOTAL, "LDS");
  if (Lbeg >= Lend) return;
  const int tid = opaque_tid(), wid = tid >> 6, lane = tid & 63, wr = wid >> 2, wc = wid & 3, fr = lane & 15, fq = lane >> 4;
  const bf16_t* pa[GLA];
  const bf16_t* pb[GLB];
#define G32_SETP(L_) do { int t2_ = tid; asm volatile("" : "+v"(t2_)); const int w2_ = t2_ >> 6, l2_ = t2_ & 63;        \
    _Pragma("unroll") for (int i = 0; i < GLA; ++i) { int R_, C_; stage_rc32(w2_ * 1024 + i * 8192 + l2_ * 16, R_, C_); pa[i] = rowA((L_), R_) + C_; } \
    _Pragma("unroll") for (int i = 0; i < GLB; ++i) { int R_, C_; stage_rc32(w2_ * 1024 + i * 8192 + l2_ * 16, R_, C_); pb[i] = rowB((L_), SWAP ? perm_col(R_) : R_) + C_; } } while (0)
#define G32_ISSUE(buf, s_, L_) do { const int ka_ = koffA((L_), (s_) >> 1) + ((s_) & 1) * 32, kb_ = koffB((L_), (s_) >> 1) + ((s_) & 1) * 32; \
    char* base_ = shm + (buf) * STG;                                                                                   \
    _Pragma("unroll") for (int i = 0; i < GLA; ++i)                                                                    \
      __builtin_amdgcn_global_load_lds((const unsigned*)(pa[i] + ka_), (unsigned*)(base_ + wid * 1024 + i * 8192), 16, 0, 0); \
    _Pragma("unroll") for (int i = 0; i < GLB; ++i)                                                                    \
      __builtin_amdgcn_global_load_lds((const unsigned*)(pb[i] + kb_), (unsigned*)(base_ + TILE_A + wid * 1024 + i * 8192), 16, 0, 0); } while (0)
#define G32_RAWBAR() do { asm volatile("s_waitcnt lgkmcnt(0)" ::: "memory"); __builtin_amdgcn_s_barrier(); } while (0)
  const int ns = 2 * nk;
  const int npre = ns < NBUF ? ns : NBUF;
  G32_SETP(Lbeg);
  for (int s = 0; s < npre; ++s) G32_ISSUE(s, s, Lbeg);
  for (int L = Lbeg; L < Lend; L += Lstep) {
    f32x4 acc[MI][4];
#pragma unroll
    for (int m = 0; m < MI; ++m)
#pragma unroll
      for (int n = 0; n < 4; ++n) acc[m][n] = f32x4{0.f, 0.f, 0.f, 0.f};
    int cur = 0;
    for (int t = 0; t < ns; ++t) {
      if (t == 0) asm volatile("s_waitcnt vmcnt(0)" ::: "memory");
      else if (t + 2 < ns) asm volatile("s_waitcnt vmcnt(8)" ::: "memory");
      else if (t + 1 < ns) asm volatile("s_waitcnt vmcnt(4)" ::: "memory");
      else asm volatile("s_waitcnt vmcnt(0)" ::: "memory");
      G32_RAWBAR();
      if (t >= 1 && t + 3 < ns) { const int nb_ = (cur + 3) & 3; G32_ISSUE(nb_, t + 3, L); }
      const char* sa = shm + cur * STG;
      const char* sb = sa + TILE_A;
      const int offA = lds_byte32(wr * 128 + fr, fq * 8), offB = lds_byte32(wc * 64 + fr, fq * 8);
      bf16x8 Bf[4];
#pragma unroll
      for (int n = 0; n < 4; ++n) Bf[n] = *(const bf16x8*)(sb + offB + n * 1024);
#pragma unroll
      for (int mh = 0; mh < MI; mh += 4) {
        bf16x8 At[4];
#pragma unroll
        for (int m = 0; m < 4; ++m) At[m] = *(const bf16x8*)(sa + offA + (mh + m) * 1024);
#pragma unroll
        for (int m = 0; m < 4; ++m)
#pragma unroll
          for (int n = 0; n < 4; ++n) {
            if (SWAP) acc[mh + m][n] = __builtin_amdgcn_mfma_f32_16x16x32_bf16(Bf[n], At[m], acc[mh + m][n], 0, 0, 0);
            else      acc[mh + m][n] = __builtin_amdgcn_mfma_f32_16x16x32_bf16(At[m], Bf[n], acc[mh + m][n], 0, 0, 0);
          }
        __builtin_amdgcn_sched_barrier(0);
      }
      cur = (cur + 1) & 3;
    }
    G32_RAWBAR();
    const int Ln = L + Lstep;
    if (Ln < Lend) { G32_SETP(Ln); for (int s = 0; s < npre; ++s) G32_ISSUE(s, s, Ln); }
    {
      const int t3 = opaque_tid(), w3 = t3 >> 6, l3 = t3 & 63, wr3 = w3 >> 2, wc3 = w3 & 3, fr3 = l3 & 15, fq3 = l3 >> 4;
      if constexpr (SWAP) {
        epi(L, wr3 * 128 + fr3, wc3 * 64 + fq3 * 16, acc);
      } else {
#pragma unroll
        for (int m = 0; m < MI; ++m)
#pragma unroll
          for (int n = 0; n < 4; ++n) epi(L, wr3 * 128 + m * 16 + fq3 * 4, wc3 * 64 + n * 16 + fr3, acc[m][n]);
      }
    }
  }
  asm volatile("s_waitcnt vmcnt(0)" ::: "memory");
#undef G32_SETP
#undef G32_ISSUE
#undef G32_RAWBAR
}
template <int MI, bool SWAP, class RA, class RB, class KA, class KB, class EP>
__device__ __forceinline__ void gemm_run(char* shm, int nk, int Lbeg, int Lend, int Lstep, RA rowA, RB rowB, KA koffA, KB koffB, EP epi) {
#ifdef USE_BK32
  if constexpr (MI == 8) gemm_loop32<SWAP>(shm, nk, Lbeg, Lend, Lstep, rowA, rowB, koffA, koffB, epi);
  else gemm_loop<MI, SWAP>(shm, nk, Lbeg, Lend, Lstep, rowA, rowB, koffA, koffB, epi);
#else
  gemm_loop<MI, SWAP>(shm, nk, Lbeg, Lend, Lstep, rowA, rowB, koffA, koffB, epi);
#endif
}


template <class RA, class RB, class EP>
__device__ __forceinline__ void skinny_items(char* shm, int ibeg, int iend, int istep, RA rowA, RB rowB, EP epi) {
  for (int item = ibeg; item < iend; item += istep) {
    const int t = opaque_tid(), w = t >> 6, lane = t & 63, fr = lane & 15, fq = lane >> 4;
    f32x4 acc[4][4];
#pragma unroll
    for (int m = 0; m < 4; ++m)
#pragma unroll
      for (int n = 0; n < 4; ++n) acc[m][n] = f32x4{0.f, 0.f, 0.f, 0.f};
    const bf16_t* pa[4];
    const bf16_t* pb[4];
#pragma unroll
    for (int m = 0; m < 4; ++m) pa[m] = rowA(item, m * 16 + fr) + w * 128 + fq * 8;
#pragma unroll
    for (int n = 0; n < 4; ++n) pb[n] = rowB(item, perm_col(n * 16 + fr)) + w * 128 + fq * 8;
#pragma unroll
    for (int hf = 0; hf < 2; ++hf) {
      bf16x8 At[4][2], Bf[4][2];
#pragma unroll
      for (int m = 0; m < 4; ++m)
#pragma unroll
        for (int k2 = 0; k2 < 2; ++k2) At[m][k2] = *(const bf16x8*)(pa[m] + (hf * 2 + k2) * 32);
#pragma unroll
      for (int n = 0; n < 4; ++n)
#pragma unroll
        for (int k2 = 0; k2 < 2; ++k2) Bf[n][k2] = *(const bf16x8*)(pb[n] + (hf * 2 + k2) * 32);
#pragma unroll
      for (int k2 = 0; k2 < 2; ++k2)
#pragma unroll
        for (int m = 0; m < 4; ++m)
#pragma unroll
          for (int n = 0; n < 4; ++n) acc[m][n] = __builtin_amdgcn_mfma_f32_16x16x32_bf16(Bf[n][k2], At[m][k2], acc[m][n], 0, 0, 0);
    }
    float4* red = (float4*)shm;
#pragma unroll
    for (int m = 0; m < 4; ++m)
#pragma unroll
      for (int n = 0; n < 4; ++n) red[(w * 16 + m * 4 + n) * 64 + lane] = make_float4(acc[m][n][0], acc[m][n][1], acc[m][n][2], acc[m][n][3]);
    __syncthreads();
    if (t < 256) {
      const int m = t >> 6;
      f32x4 s[4];
#pragma unroll
      for (int n = 0; n < 4; ++n) {
        float4 a = red[(0 * 16 + m * 4 + n) * 64 + lane];
#pragma unroll
        for (int w2 = 1; w2 < 8; ++w2) { const float4 b = red[(w2 * 16 + m * 4 + n) * 64 + lane]; a.x += b.x; a.y += b.y; a.z += b.z; a.w += b.w; }
        s[n] = f32x4{a.x, a.y, a.z, a.w};
      }
      epi(item, m * 16 + fr, fq * 16, s);
    }
    __syncthreads();
  }
}

template <class F> struct PerM {
  F f;
  template <int MI> __device__ __forceinline__ void operator()(int L, int rb, int c0, const f32x4 (&a)[MI][4]) const {
#pragma unroll
    for (int m = 0; m < MI; ++m) f(L, rb + 16 * m, c0, a[m]);
  }
};
template <class F> __device__ __forceinline__ PerM<F> per_m(F f) { return PerM<F>{f}; }

template <int MI, bool SWAP, bool PERM, class RA, class RB, class KA, class KB, class F>
__device__ __forceinline__ void gemm_bal(char* shm, int nk, int vb, int ntile, int G, RA rowA, RB rowB, KA koffA, KB koffB, F f) {
  constexpr int HALF = 16 * MI;
  const int tail = ntile % G;
  const bool split = tail > 0 && 2 * tail <= G;
  const int nfull = split ? ntile - tail : ntile;
  if constexpr (SWAP && PERM) gemm_loop<MI, SWAP>(shm, nk, vb, nfull, G, rowA, rowB, koffA, koffB, per_m(f));
  else                        gemm_loop<MI, SWAP>(shm, nk, vb, nfull, G, rowA, rowB, koffA, koffB, f);
  if (split) {
    auto ra = [=](int H, int r) { return rowA(nfull + (H >> 1), r + HALF * (H & 1)); };
    auto rb = [=](int H, int c) { return rowB(nfull + (H >> 1), c); };
    auto ka = [=](int H, int kt) { return koffA(nfull + (H >> 1), kt); };
    auto kb = [=](int H, int kt) { return koffB(nfull + (H >> 1), kt); };
    auto ff = [=](int H, int row, int col, const auto& a) { f(nfull + (H >> 1), row + HALF * (H & 1), col, a); };
    if constexpr (SWAP && PERM) gemm_loop<MI / 2, SWAP>(shm, nk, vb, 2 * tail, G, ra, rb, ka, kb, per_m(ff));
    else                        gemm_loop<MI / 2, SWAP>(shm, nk, vb, 2 * tail, G, ra, rb, ka, kb, ff);
  }
}

template <bool BAL = false, class EP>
__device__ __forceinline__ void dense_phase(char* shm, int vb, int G, const bf16_t* A, int lda, const bf16_t* Wt, int ldw,
                                            int ntn, int nk, int with_ctx, EP epi) {
  const int nbig = 64 * ntn;
  if constexpr (BAL)
    gemm_bal<8, true, true>(shm, nk, vb, nbig, G,
      [=](int L, int r) { return A + (size_t)((1 + L / ntn) * 256 + r) * lda; },
      [=](int L, int c) { return Wt + (size_t)((L % ntn) * 256 + c) * ldw; }, KOffL(), KOffL(),
      [=](int L, int row, int col0, const f32x4 (&a)[4]) { epi((1 + L / ntn) * 256 + row, (L % ntn) * 256 + col0, a); });
  else
  gemm_run<8, true>(shm, nk, vb, nbig, G,
    [=](int L, int r) { return A + (size_t)((1 + L / ntn) * 256 + r) * lda; },
    [=](int L, int c) { return Wt + (size_t)((L % ntn) * 256 + c) * ldw; }, KOffL(), KOffL(),
    per_m([=](int L, int row, int col0, const f32x4 (&a)[4]) { epi((1 + L / ntn) * 256 + row, (L % ntn) * 256 + col0, a); }));
  if (with_ctx == 2) {
    skinny_items(shm, vb, 16 * ntn, G,
      [=](int it, int r) { return A + (size_t)((it / (4 * ntn)) * 64 + r) * lda; },
      [=](int it, int c) { return Wt + (size_t)((it % (4 * ntn)) * 64 + c) * ldw; },
      [=](int it, int row, int col0, const f32x4 (&a)[4]) { epi((it / (4 * ntn)) * 64 + row, (it % (4 * ntn)) * 64 + col0, a); });
  } else if (with_ctx == 1) {
    const int s = (vb - (nbig % G) + G) % G;
    gemm_loop<2, true>(shm, nk, s, 4 * ntn, G,
      [=](int L, int r) { return A + (size_t)((L / ntn) * 64 + r) * lda; },
      [=](int L, int c) { return Wt + (size_t)((L % ntn) * 256 + c) * ldw; }, KOffL(), KOffL(),
      per_m([=](int L, int row, int col0, const f32x4 (&a)[4]) { epi((L / ntn) * 64 + row, (L % ntn) * 256 + col0, a); }));
  }
}

#define XB_TMO      128
#define XB_XCNT(j)  (256  + 64 * (j))
#define XB_XSUB(j)  (1280 + 64 * (j))
#define XB_XGEN(j)  (2304 + 64 * (j))
#define XB_TOP      3328
#define XB_TOPGEN   3392
#define XCD_BAR_WORDS 3456
#define XB_SPIN_CAP (1u << 22)
#define LAS __attribute__((address_space(3)))
__device__ __forceinline__ unsigned xb_ld(unsigned* p)              { return __hip_atomic_load(p, __ATOMIC_RELAXED, __HIP_MEMORY_SCOPE_AGENT); }
__device__ __forceinline__ unsigned xb_add(unsigned* p, unsigned v) { return __hip_atomic_fetch_add(p, v, __ATOMIC_RELAXED, __HIP_MEMORY_SCOPE_AGENT); }
__device__ __forceinline__ unsigned xb_xcc_id() { return (unsigned)__builtin_amdgcn_s_getreg((3 << 11) | 20) & 0xFu; }
#define XB_SPIN(cond, bar) do { unsigned _sp = 0; while (cond) { __builtin_amdgcn_s_sleep(1); \
    if ((++_sp & 255u) == 0u) { if (xb_ld(&(bar)[XB_TMO])) break; if (_sp > XB_SPIN_CAP) { atomicAdd(&(bar)[XB_TMO], 1u); break; } } } } while (0)
struct XcdBarrier { unsigned* bar; unsigned x; volatile LAS unsigned* st; };
__device__ __forceinline__ XcdBarrier xcd_barrier_post(unsigned* bar, volatile LAS unsigned* st) {
    XcdBarrier b; b.bar = bar; b.x = xb_xcc_id(); b.st = st;
    if (threadIdx.x == 0) (void)xb_add(&bar[XB_XCNT(b.x)], 1u);
    return b;
}
__device__ __forceinline__ void xcd_barrier_complete(unsigned* bar, unsigned x, unsigned& nloc, unsigned& nx) {
    const unsigned G = gridDim.x * gridDim.y * gridDim.z;
    unsigned sum, cnt, mine, sp = 0u;
    for (;;) {
        sum = 0u; cnt = 0u; mine = 0u;
#pragma unroll
        for (unsigned j = 0; j < 16; ++j) { const unsigned c = xb_ld(&bar[XB_XCNT(j)]); sum += c; cnt += (c > 0u) ? 1u : 0u; mine = (j == x) ? c : mine; }
        if (sum == G) break;
        __builtin_amdgcn_s_sleep(1);
        if ((++sp & 255u) == 0u) { if (xb_ld(&bar[XB_TMO])) break; if (sp > XB_SPIN_CAP) { atomicAdd(&bar[XB_TMO], 1u); break; } }
    }
    nloc = mine > 0u ? mine : 1u; nx = cnt > 0u ? cnt : 1u;
}
__device__ __forceinline__ void xcd_barrier(const XcdBarrier& b) {
    asm volatile("s_waitcnt vmcnt(0)" ::: "memory");
    __syncthreads();
    if (threadIdx.x == 0) {
        unsigned* bar = b.bar;
        __builtin_amdgcn_s_waitcnt(0);
        unsigned nloc = b.st[0], nx = b.st[1];
        if (nloc == 0u) { xcd_barrier_complete(bar, b.x, nloc, nx); b.st[0] = nloc; b.st[1] = nx; }
        const unsigned old = xb_add(&bar[XB_XSUB(b.x)], 1u);
        const unsigned gen = old / nloc;
        if (old + 1u == (gen + 1u) * nloc) {
            __builtin_amdgcn_fence(__ATOMIC_RELEASE, "agent");
            asm volatile("s_waitcnt vmcnt(0)" ::: "memory");
            const unsigned og = xb_add(&bar[XB_TOP], 1u);
            const unsigned tg = og / nx;
            if (og + 1u == (tg + 1u) * nx) xb_add(&bar[XB_TOPGEN], 1u);
            else XB_SPIN(xb_ld(&bar[XB_TOPGEN]) == tg, bar);
            __builtin_amdgcn_fence(__ATOMIC_ACQUIRE, "agent");
            xb_add(&bar[XB_XGEN(b.x)], 1u);
            asm volatile("s_waitcnt vmcnt(0)" ::: "memory");
        } else {
            XB_SPIN(xb_ld(&bar[XB_XGEN(b.x)]) == gen, bar);
            __builtin_amdgcn_fence(__ATOMIC_ACQUIRE, "agent");
            asm volatile("s_waitcnt vmcnt(0)" ::: "memory");
        }
    }
    __syncthreads();
}

template <class AF, class BF, class EF>
__device__ __forceinline__ void gemm_naive(int M, int N, int K, AF af, BF bf, EF ef, float* smem_all) {
  const int half = threadIdx.x >> 8, tid = threadIdx.x & 255;
  float* smem = smem_all + half * (2 * 16 * 68);
  const int tilesM = (M + 63) >> 6, tilesN = (N + 63) >> 6;
  const int ntiles = tilesM * tilesN;
  float (*As)[68] = (float (*)[68])smem;
  float (*Bs)[68] = (float (*)[68])(smem + 16 * 68);
  const int ty = tid >> 4, tx = tid & 15;
  const int stride = gridDim.x * 2;
  const int iters = (ntiles + stride - 1) / stride;
  for (int it = 0; it < iters; ++it) {
    const int tile = it * stride + blockIdx.x * 2 + half;
    const bool valid = tile < ntiles;
    const int tm = valid ? tile / tilesN : 0, tn = valid ? tile - tm * tilesN : 0;
    const int m0 = tm << 6, n0 = tn << 6;
    float acc[4][4];
#pragma unroll
    for (int i = 0; i < 4; ++i)
#pragma unroll
      for (int j = 0; j < 4; ++j) acc[i][j] = 0.f;
    for (int k0 = 0; k0 < K; k0 += 16) {
#pragma unroll
      for (int i = 0; i < 4; ++i) {
        const int mm = (tid >> 4) + 16 * i, kk = tid & 15;
        const int m = m0 + mm, k = k0 + kk;
        As[kk][mm] = (valid && m < M && k < K) ? af(m, k, n0) : 0.f;
      }
#pragma unroll
      for (int i = 0; i < 4; ++i) {
        const int kk = (tid >> 6) + 4 * i, nn = tid & 63;
        const int k = k0 + kk, n = n0 + nn;
        Bs[kk][nn] = (valid && k < K && n < N) ? bf(k, n, m0) : 0.f;
      }
      __syncthreads();
#pragma unroll
      for (int kk = 0; kk < 16; ++kk) {
        const float4 a = *(const float4*)&As[kk][ty * 4];
        const float4 b = *(const float4*)&Bs[kk][tx * 4];
        const float av[4] = {a.x, a.y, a.z, a.w};
        const float bv[4] = {b.x, b.y, b.z, b.w};
#pragma unroll
        for (int i = 0; i < 4; ++i)
#pragma unroll
          for (int j = 0; j < 4; ++j) acc[i][j] = fmaf(av[i], bv[j], acc[i][j]);
      }
      __syncthreads();
    }
    if (valid) {
#pragma unroll
      for (int i = 0; i < 4; ++i)
#pragma unroll
        for (int j = 0; j < 4; ++j) {
          const int m = m0 + ty * 4 + i, n = n0 + tx * 4 + j;
          if (m < M && n < N) ef(m, n, acc[i][j]);
        }
    }
  }
}

__device__ __forceinline__ void conv_tile(const float* src, int ldn, bf16_t* dst, int ldk, int k0, int n0, int mapmode, float* sm) {
  const int tid = opaque_tid();
  float (*tl)[65] = (float (*)[65])sm;
  {
    const int row = tid >> 3, c4 = (tid & 7) * 4;
    const float4 a = *(const float4*)&src[(size_t)(k0 + row) * ldn + n0 + c4];
    const float4 b = *(const float4*)&src[(size_t)(k0 + row) * ldn + n0 + 32 + c4];
    tl[row][c4 + 0] = a.x; tl[row][c4 + 1] = a.y; tl[row][c4 + 2] = a.z; tl[row][c4 + 3] = a.w;
    tl[row][32 + c4 + 0] = b.x; tl[row][32 + c4 + 1] = b.y; tl[row][32 + c4 + 2] = b.z; tl[row][32 + c4 + 3] = b.w;
  }
  __syncthreads();
  {
    const int n = tid >> 3, kg = (tid & 7) * 8;
    uint4 o;
    o.x = pack2(tl[kg + 0][n], tl[kg + 1][n]); o.y = pack2(tl[kg + 2][n], tl[kg + 3][n]);
    o.z = pack2(tl[kg + 4][n], tl[kg + 5][n]); o.w = pack2(tl[kg + 6][n], tl[kg + 7][n]);
    const int h = n0 + n;
    const int dr = mapmode == 0 ? h : ((h >> 3) * 16 + (h & 7) + (mapmode == 2 ? 8 : 0));
    *(uint4*)&dst[(size_t)dr * ldk + k0 + kg] = o;
  }
  __syncthreads();
}

__device__ __forceinline__ void norm_phase(const Params& P, int t0, const float* gw,
                                           int mod_layer, int shift_idx,
                                           int pend_layer, int pend_t0,
                                           bool to_out, bool router, int layer, float* wl) {
  int* rl = (int*)((char*)wl + GEMM_LDS_TOTAL + 272);
  unsigned char* ws = P.ws;
  bf16_t* tok = (bf16_t*)(ws + WS_TOK);
  bf16_t* hb = (bf16_t*)(ws + WS_H);
  const float* mod = (const float*)(ws + WS_MOD);
  const bf16_t* ybuf = (const bf16_t*)(ws + WS_R + R_YBUF);
  const int tid_n = opaque_tid();
  const int lane = tid_n & 63;
  if (router) {
    const float* rgw = P.in[9] + (size_t)layer * 1024 * 4;
    const float* rew = P.in[11] + (size_t)layer * 1024 * 32;
    for (int idx = tid_n; idx < 1024 * 36; idx += NT) {
      const int k = idx / 36, j = idx - k * 36;
      const int rho = (((k >> 8) * 4 + (k & 3)) * 64) + ((k & 255) >> 2);
      wl[rho * 36 + j] = (j < 4) ? rgw[k * 4 + j] : rew[k * 32 + (j - 4)];
    }
    if (tid_n < 80) rl[tid_n] = 0;
    __syncthreads();
  }
  const int gw_id = blockIdx.x * (NT / 64) + (tid_n >> 6);
  const int gw_n = gridDim.x * (NT / 64);
  for (int t = t0 + gw_id; t < T_ALL; t += gw_n) {
    const int s = (t < T_CTX) ? 1 : 0;
    float v[16];
    if (pend_layer == -2) {
      const float* PE = (const float*)(ws + W_PE);
#pragma unroll
      for (int j = 0; j < 4; ++j) {
        const int n = j * 256 + lane * 4;
        float4 x;
        if (t < T_CTX) x = ntload4(&P.in[2][(size_t)t * DM + n]);
        else {
          const int tl = t - T_CTX;
          x = ntload4(&P.in[0][(size_t)tl * DM + n]);
          const float* pp = (j < 2) ? PE + j * 65536 + (tl >> 6) * 256 + lane * 4 : PE + 131072 + (j - 2) * 16384 + (tl & 63) * 256 + lane * 4;
          const float4 pe = *(const float4*)pp;
          x.x += pe.x; x.y += pe.y; x.z += pe.z; x.w += pe.w;
        }
        v[j * 4 + 0] = x.x; v[j * 4 + 1] = x.y; v[j * 4 + 2] = x.z; v[j * 4 + 3] = x.w;
        { uint2 o; o.x = pack2(x.x, x.y); o.y = pack2(x.z, x.w); *(uint2*)&tok[(size_t)t * DM + n] = o; }
      }
    } else {
#pragma unroll
    for (int j = 0; j < 4; ++j) {
      const int n = j * 256 + lane * 4;
      const uint2 x = *(const uint2*)&tok[(size_t)t * DM + n];
      v[j * 4 + 0] = lo2f(x.x); v[j * 4 + 1] = hi2f(x.x); v[j * 4 + 2] = lo2f(x.y); v[j * 4 + 3] = hi2f(x.y);
    }
    }
    if (pend_layer >= 0 && t >= pend_t0) {
      const float* gate = mod + (size_t)((pend_layer * 2 + s) * 6 + 5) * 1024;
#pragma unroll
      for (int j = 0; j < 4; ++j) {
        const int n = j * 256 + lane * 4;
        const uint2 y0 = *(const uint2*)&ybuf[(size_t)(2 * t) * DM + n];
        const uint2 y1 = *(const uint2*)&ybuf[(size_t)(2 * t + 1) * DM + n];
        const float4 g = *(const float4*)&gate[n];
        v[j * 4 + 0] += g.x * (lo2f(y0.x) + lo2f(y1.x));
        v[j * 4 + 1] += g.y * (hi2f(y0.x) + hi2f(y1.x));
        v[j * 4 + 2] += g.z * (lo2f(y0.y) + lo2f(y1.y));
        v[j * 4 + 3] += g.w * (hi2f(y0.y) + hi2f(y1.y));
        { uint2 o; o.x = pack2(v[j * 4 + 0], v[j * 4 + 1]); o.y = pack2(v[j * 4 + 2], v[j * 4 + 3]); *(uint2*)&tok[(size_t)t * DM + n] = o; }
      }
    }
    float ss = 0.f;
#pragma unroll
    for (int e = 0; e < 16; ++e) ss += v[e] * v[e];
    ss = wave_sum(ss);
    const float r = 1.f / sqrtf(ss * (1.f / 1024.f) + EPSN);
    float h[16];
#pragma unroll
    for (int j = 0; j < 4; ++j) {
      const int n = j * 256 + lane * 4;
      const float4 g = *(const float4*)&gw[n];
      h[j * 4 + 0] = v[j * 4 + 0] * r * g.x;
      h[j * 4 + 1] = v[j * 4 + 1] * r * g.y;
      h[j * 4 + 2] = v[j * 4 + 2] * r * g.z;
      h[j * 4 + 3] = v[j * 4 + 3] * r * g.w;
      if (shift_idx >= 0) {
        const float* sh = mod + (size_t)((mod_layer * 2 + s) * 6 + shift_idx) * 1024;
        const float* sc = sh + 1024;
        const float4 a = *(const float4*)&sh[n];
        const float4 b = *(const float4*)&sc[n];
        h[j * 4 + 0] = h[j * 4 + 0] * (1.f + b.x) + a.x;
        h[j * 4 + 1] = h[j * 4 + 1] * (1.f + b.y) + a.y;
        h[j * 4 + 2] = h[j * 4 + 2] * (1.f + b.z) + a.z;
        h[j * 4 + 3] = h[j * 4 + 3] * (1.f + b.w) + a.w;
      }
      if (to_out) {
        { typedef __attribute__((ext_vector_type(4))) float f4v; const f4v ov = {h[j * 4 + 0], h[j * 4 + 1], h[j * 4 + 2], h[j * 4 + 3]};
          __builtin_nontemporal_store(ov, (f4v*)&P.out[(size_t)(t - T_CTX) * DM + n]); }
      } else {
        uint2 o; o.x = pack2(h[j * 4 + 0], h[j * 4 + 1]); o.y = pack2(h[j * 4 + 2], h[j * 4 + 3]);
        *(uint2*)&hb[(size_t)t * DM + n] = o;
      }
    }
    if (router) {
      float lg[36];
#pragma unroll
      for (int q = 0; q < 36; ++q) lg[q] = 0.f;
#pragma unroll
      for (int i = 0; i < 16; ++i) {
        const float hv = h[i];
        const float4* wr4 = (const float4*)(wl + (i * 64 + lane) * 36);
#pragma unroll
        for (int q = 0; q < 9; ++q) {
          const float4 w4 = wr4[q];
          lg[q * 4 + 0] += hv * w4.x; lg[q * 4 + 1] += hv * w4.y; lg[q * 4 + 2] += hv * w4.z; lg[q * 4 + 3] += hv * w4.w;
        }
        __builtin_amdgcn_sched_barrier(0);
      }
#pragma unroll
      for (int q = 0; q < 36; ++q) lg[q] = wave_sum(lg[q]);
      const float* rgb = P.in[10] + layer * 4;
      const float* reb = P.in[12] + layer * 32;
#pragma unroll
      for (int q = 0; q < 4; ++q) lg[q] += rgb[q];
#pragma unroll
      for (int q = 0; q < 32; ++q) lg[4 + q] += reb[q];
      int grp = 0; float best = lg[0];
#pragma unroll
      for (int q = 1; q < 4; ++q) if (lg[q] > best) { best = lg[q]; grp = q; }
      float se = 0.f;
#pragma unroll
      for (int q = 0; q < 4; ++q) se += expf(lg[q] - best);
      const float pg = 1.f / se;
      float v0 = -3.0e38f, v1 = -3.0e38f; int i0 = 0, i1 = 0;
#pragma unroll
      for (int g = 0; g < 4; ++g) {
#pragma unroll
        for (int q = 0; q < 8; ++q) {
          const float x = lg[4 + g * 8 + q];
          if (g == grp) {
            if (x > v0) { v1 = v0; i1 = i0; v0 = x; i0 = q; }
            else if (x > v1) { v1 = x; i1 = q; }
          }
        }
      }
      const float w0 = 1.f / (1.f + expf(v1 - v0));
      const float w1 = 1.f - w0;
      if (lane == 0) {
        float* asgw = (float*)(ws + WS_ASGW);
        const int e0 = grp * 8 + i0, e1 = grp * 8 + i1;
        const int p0 = atomicAdd(&rl[e0], 1);
        const int p1 = atomicAdd(&rl[e1], 1);
        const int sl = atomicAdd(&rl[64], 2);
        rl[80 + sl] = 2 * t;         rl[240 + sl] = e0;     rl[400 + sl] = p0;
        rl[80 + sl + 1] = 2 * t + 1; rl[240 + sl + 1] = e1; rl[400 + sl + 1] = p1;
        asgw[2 * t] = w0 * pg;
        asgw[2 * t + 1] = w1 * pg;
      }
    }
  }
  if (router) {
    __syncthreads();
    int* cnt = (int*)(ws + WS_CNT) + layer * 32 * 32;
    int* list = (int*)(ws + WS_LIST);
    if (tid_n < 32) rl[32 + tid_n] = rl[tid_n] ? atomicAdd(&cnt[tid_n * 32], rl[tid_n]) : 0;
    __syncthreads();
    const int nent = rl[64];
    for (int s = tid_n; s < nent; s += NT) {
      const int e = rl[240 + s];
      list[(size_t)e * 33280 + rl[32 + e] + rl[400 + s]] = rl[80 + s];
    }
    __syncthreads();
  }
}


__device__ __forceinline__ void route_token(const float (&lg_in)[36], const float* rgb, const float* reb, int t, int* rl, float* asgw) {
  float lg[36];
#pragma unroll
  for (int q = 0; q < 4; ++q) lg[q] = lg_in[q] + rgb[q];
#pragma unroll
  for (int q = 0; q < 32; ++q) lg[4 + q] = lg_in[4 + q] + reb[q];
  int grp = 0; float best = lg[0];
#pragma unroll
  for (int q = 1; q < 4; ++q) if (lg[q] > best) { best = lg[q]; grp = q; }
  float se = 0.f;
#pragma unroll
  for (int q = 0; q < 4; ++q) se += expf(lg[q] - best);
  const float pg = 1.f / se;
  float v0 = -3.0e38f, v1 = -3.0e38f; int i0 = 0, i1 = 0;
#pragma unroll
  for (int g = 0; g < 4; ++g) {
#pragma unroll
    for (int q = 0; q < 8; ++q) {
      const float x = lg[4 + g * 8 + q];
      if (g == grp) {
        if (x > v0) { v1 = v0; i1 = i0; v0 = x; i0 = q; }
        else if (x > v1) { v1 = x; i1 = q; }
      }
    }
  }
  const float w0 = 1.f / (1.f + expf(v1 - v0));
  const float w1 = 1.f - w0;
  const int e0 = grp * 8 + i0, e1 = grp * 8 + i1;
  const int p0 = atomicAdd(&rl[e0], 1);
  const int p1 = atomicAdd(&rl[e1], 1);
  const int sl = atomicAdd(&rl[64], 2);
  rl[80 + sl] = 2 * t;         rl[240 + sl] = e0;     rl[400 + sl] = p0;
  rl[80 + sl + 1] = 2 * t + 1; rl[240 + sl + 1] = e1; rl[400 + sl + 1] = p1;
  asgw[2 * t] = w0 * pg;
  asgw[2 * t + 1] = w1 * pg;
}

__device__ __forceinline__ void route_token2(float res, int t, int* rl, float* asgw, int lane) {
  const float g0 = __shfl(res, 0), g1 = __shfl(res, 32), g2 = __shfl(res, 1), g3 = __shfl(res, 33);
  int grp = 0; float best = g0;
  if (g1 > best) { best = g1; grp = 1; }
  if (g2 > best) { best = g2; grp = 2; }
  if (g3 > best) { best = g3; grp = 3; }
  const float pg = 1.f / (expf(g0 - best) + expf(g1 - best) + expf(g2 - best) + expf(g3 - best));
  float v0 = -3.0e38f, v1 = -3.0e38f; int i0 = 0, i1 = 0;
#pragma unroll
  for (int q = 0; q < 8; ++q) {
    const float x = __shfl(res, (q & 1) * 32 + 2 + grp * 4 + (q >> 1));
    if (x > v0) { v1 = v0; i1 = i0; v0 = x; i0 = q; }
    else if (x > v1) { v1 = x; i1 = q; }
  }
  if (lane == 0) {
    const float w0 = 1.f / (1.f + expf(v1 - v0));
    const float w1 = 1.f - w0;
    const int e0 = grp * 8 + i0, e1 = grp * 8 + i1;
    const int p0 = atomicAdd(&rl[e0], 1);
    const int p1 = atomicAdd(&rl[e1], 1);
    const int sl = atomicAdd(&rl[64], 2);
    rl[80 + sl] = 2 * t;         rl[240 + sl] = e0;     rl[400 + sl] = p0;
    rl[80 + sl + 1] = 2 * t + 1; rl[240 + sl + 1] = e1; rl[400 + sl + 1] = p1;
    asgw[2 * t] = w0 * pg;
    asgw[2 * t + 1] = w1 * pg;
  }
}

__device__ __forceinline__ void ffn_norm_router_phase(const Params& P, int t0, int layer, float* wl) {
  unsigned char* ws = P.ws;
  int* rl = (int*)((char*)wl + GEMM_LDS_TOTAL + 272);
  const bf16_t* tok = (const bf16_t*)(ws + WS_TOK);
  bf16_t* hb = (bf16_t*)(ws + WS_H);
  const float* mod = (const float*)(ws + WS_MOD);
  const float* gw = P.in[7] + layer * 1024;
  const int tid_n = opaque_tid();
  const int lane0 = tid_n & 63;
  {
    const float* rgw = P.in[9] + (size_t)layer * 1024 * 4;
    const float* rew = P.in[11] + (size_t)layer * 1024 * 32;
    for (int ib = 0; ib < 18; ib += 6) {
      float4 w[6];
#pragma unroll
      for (int u = 0; u < 6; ++u) {
        const int idx = tid_n + (ib + u) * NT, k = idx / 9, q = idx - k * 9;
        const float* wp = (q == 0) ? rgw + k * 4 : rew + k * 32 + (q - 1) * 4;
        w[u] = *(const float4*)wp;
      }
#pragma unroll
      for (int u = 0; u < 6; ++u) {
        const int idx = tid_n + (ib + u) * NT, k = idx / 9, q = idx - k * 9;
        const int rho = (((k >> 8) * 4 + (k & 3)) * 64) + ((k & 255) >> 2);
        *(float4*)&wl[rho * 36 + q * 4] = w[u];
      }
    }
    if (tid_n < 80) rl[tid_n] = 0;
    __syncthreads();
  }
  const float* rgb = P.in[10] + layer * 4;
  const float* reb = P.in[12] + layer * 32;
  float* asgw = (float*)(ws + WS_ASGW);
  const int gw_id = blockIdx.x * (NT / 64) + (tid_n >> 6);
  const int gw_n = gridDim.x * (NT / 64);
  for (int tA = t0 + gw_id; tA < T_ALL; tA += 2 * gw_n) {
    int lane = lane0; asm volatile("" : "+v"(lane));
    const int tB = tA + gw_n;
    const bool hasB = tB < T_ALL;
    const int tBs = hasB ? tB : tA;
    float hA[16], hB[16];
    {
      float vA[16], vB[16];
#pragma unroll
      for (int j = 0; j < 4; ++j) {
        const int n = j * 256 + lane * 4;
        const uint2 x = *(const uint2*)&tok[(size_t)tA * DM + n];
        const uint2 y = *(const uint2*)&tok[(size_t)tBs * DM + n];
        vA[j * 4 + 0] = lo2f(x.x); vA[j * 4 + 1] = hi2f(x.x); vA[j * 4 + 2] = lo2f(x.y); vA[j * 4 + 3] = hi2f(x.y);
        vB[j * 4 + 0] = lo2f(y.x); vB[j * 4 + 1] = hi2f(y.x); vB[j * 4 + 2] = lo2f(y.y); vB[j * 4 + 3] = hi2f(y.y);
      }
      float sA = 0.f, sB = 0.f;
#pragma unroll
      for (int e = 0; e < 16; ++e) { sA += vA[e] * vA[e]; sB += vB[e] * vB[e]; }
      sA = wave_sum(sA); sB = wave_sum(sB);
      const float rA = 1.f / sqrtf(sA * (1.f / 1024.f) + EPSN), rB = 1.f / sqrtf(sB * (1.f / 1024.f) + EPSN);
      const int stA = (tA < T_CTX) ? 1 : 0, stB = (tBs < T_CTX) ? 1 : 0;
      const float* shA = mod + (size_t)((layer * 2 + stA) * 6 + 3) * 1024;
      const float* shB = mod + (size_t)((layer * 2 + stB) * 6 + 3) * 1024;
#pragma unroll
      for (int j = 0; j < 4; ++j) {
        const int n = j * 256 + lane * 4;
        const float4 g = *(const float4*)&gw[n];
        const float4 a1 = *(const float4*)&shA[n], b1 = *(const float4*)&shA[1024 + n];
        const float4 a2 = *(const float4*)&shB[n], b2 = *(const float4*)&shB[1024 + n];
        hA[j * 4 + 0] = vA[j * 4 + 0] * rA * g.x * (1.f + b1.x) + a1.x; hA[j * 4 + 1] = vA[j * 4 + 1] * rA * g.y * (1.f + b1.y) + a1.y;
        hA[j * 4 + 2] = vA[j * 4 + 2] * rA * g.z * (1.f + b1.z) + a1.z; hA[j * 4 + 3] = vA[j * 4 + 3] * rA * g.w * (1.f + b1.w) + a1.w;
        hB[j * 4 + 0] = vB[j * 4 + 0] * rB * g.x * (1.f + b2.x) + a2.x; hB[j * 4 + 1] = vB[j * 4 + 1] * rB * g.y * (1.f + b2.y) + a2.y;
        hB[j * 4 + 2] = vB[j * 4 + 2] * rB * g.z * (1.f + b2.z) + a2.z; hB[j * 4 + 3] = vB[j * 4 + 3] * rB * g.w * (1.f + b2.w) + a2.w;
        uint2 o; o.x = pack2(hA[j * 4 + 0], hA[j * 4 + 1]); o.y = pack2(hA[j * 4 + 2], hA[j * 4 + 3]);
        *(uint2*)&hb[(size_t)tA * DM + n] = o;
        if (hasB) { uint2 o2; o2.x = pack2(hB[j * 4 + 0], hB[j * 4 + 1]); o2.y = pack2(hB[j * 4 + 2], hB[j * 4 + 3]); *(uint2*)&hb[(size_t)tB * DM + n] = o2; }
      }
    }
    float gA[4], gB[4];
#pragma unroll
    for (int q = 0; q < 4; ++q) { gA[q] = 0.f; gB[q] = 0.f; }
#pragma unroll
    for (int i = 0; i < 16; ++i) {
      const float4 w4 = *(const float4*)(wl + (i * 64 + lane) * 36);
      gA[0] += hA[i] * w4.x; gA[1] += hA[i] * w4.y; gA[2] += hA[i] * w4.z; gA[3] += hA[i] * w4.w;
      gB[0] += hB[i] * w4.x; gB[1] += hB[i] * w4.y; gB[2] += hB[i] * w4.z; gB[3] += hB[i] * w4.w;
      __builtin_amdgcn_sched_barrier(0);
    }
    float gl[4];
#pragma unroll
    for (int q = 0; q < 4; ++q) gl[q] = fold_pair_sum(gA[q], gB[q]) + rgb[q];
    int grp = 0; float best = gl[0];
    if (gl[1] > best) { best = gl[1]; grp = 1; }
    if (gl[2] > best) { best = gl[2]; grp = 2; }
    if (gl[3] > best) { best = gl[3]; grp = 3; }
    const float pg = 1.f / (expf(gl[0] - best) + expf(gl[1] - best) + expf(gl[2] - best) + expf(gl[3] - best));
    const int grpA = __builtin_amdgcn_readlane(grp, 0), grpB = __builtin_amdgcn_readlane(grp, 32);
    float eA[8], eB[8];
#pragma unroll
    for (int q = 0; q < 8; ++q) { eA[q] = 0.f; eB[q] = 0.f; }
    const float* rowA = wl + lane * 36 + 4 + grpA * 8;
    const float* rowB = wl + lane * 36 + 4 + grpB * 8;
#pragma unroll
    for (int i = 0; i < 16; ++i) {
      const float4 a0 = *(const float4*)(rowA + i * 2304), a1 = *(const float4*)(rowA + i * 2304 + 4);
      const float4 b0 = *(const float4*)(rowB + i * 2304), b1 = *(const float4*)(rowB + i * 2304 + 4);
      eA[0] += hA[i] * a0.x; eA[1] += hA[i] * a0.y; eA[2] += hA[i] * a0.z; eA[3] += hA[i] * a0.w;
      eA[4] += hA[i] * a1.x; eA[5] += hA[i] * a1.y; eA[6] += hA[i] * a1.z; eA[7] += hA[i] * a1.w;
      eB[0] += hB[i] * b0.x; eB[1] += hB[i] * b0.y; eB[2] += hB[i] * b0.z; eB[3] += hB[i] * b0.w;
      eB[4] += hB[i] * b1.x; eB[5] += hB[i] * b1.y; eB[6] += hB[i] * b1.z; eB[7] += hB[i] * b1.w;
      asm volatile("" : "+v"(eA[0]), "+v"(eA[1]), "+v"(eA[2]), "+v"(eA[3]), "+v"(eA[4]), "+v"(eA[5]), "+v"(eA[6]), "+v"(eA[7]));
      asm volatile("" : "+v"(eB[0]), "+v"(eB[1]), "+v"(eB[2]), "+v"(eB[3]), "+v"(eB[4]), "+v"(eB[5]), "+v"(eB[6]), "+v"(eB[7]));
      __builtin_amdgcn_sched_barrier(0);
    }
    {
      const float4 r0 = *(const float4*)(reb + grp * 8), r1 = *(const float4*)(reb + grp * 8 + 4);
      const float rb8[8] = {r0.x, r0.y, r0.z, r0.w, r1.x, r1.y, r1.z, r1.w};
      float v0 = -3.0e38f, v1 = -3.0e38f; int i0 = 0, i1 = 0;
#pragma unroll
      for (int q = 0; q < 8; ++q) {
        const float x = fold_pair_sum(eA[q], eB[q]) + rb8[q];
        if (x > v0) { v1 = v0; i1 = i0; v0 = x; i0 = q; }
        else if (x > v1) { v1 = x; i1 = q; }
      }
      if (lane == 0 || (lane == 32 && hasB)) {
        const int t = lane == 0 ? tA : tB;
        const float w0 = 1.f / (1.f + expf(v1 - v0));
        const float w1 = 1.f - w0;
        const int e0 = grp * 8 + i0, e1 = grp * 8 + i1;
        const int p0 = atomicAdd(&rl[e0], 1);
        const int p1 = atomicAdd(&rl[e1], 1);
        const int sl = atomicAdd(&rl[64], 2);
        rl[80 + sl] = 2 * t;         rl[240 + sl] = e0;     rl[400 + sl] = p0;
        rl[80 + sl + 1] = 2 * t + 1; rl[240 + sl + 1] = e1; rl[400 + sl + 1] = p1;
        asgw[2 * t] = w0 * pg;
        asgw[2 * t + 1] = w1 * pg;
      }
    }
  }
  __syncthreads();
  int* cnt = (int*)(ws + WS_CNT) + layer * 32 * 32;
  int* list = (int*)(ws + WS_LIST);
  if (tid_n < 32) rl[32 + tid_n] = rl[tid_n] ? atomicAdd(&cnt[tid_n * 32], rl[tid_n]) : 0;
  __syncthreads();
  const int nent = rl[64];
  for (int s = tid_n; s < nent; s += NT) {
    const int e = rl[240 + s];
    list[(size_t)e * 33280 + rl[32 + e] + rl[400 + s]] = rl[80 + s];
  }
  __syncthreads();
}

#define tid (opaque_tid())
#define gtid ((int)(blockIdx.x * NT) + opaque_tid())
#define gstride ((int)(gridDim.x * NT))
__global__ void __launch_bounds__(NT, 2) mega(Params P) {
  cg::grid_group grid = cg::this_grid();
  __shared__ __attribute__((aligned(1024))) char shm[GEMM_LDS_TOTAL + 16 + 256 + 2560];
  float* smem = (float*)shm;
  if (threadIdx.x < 4) ((unsigned*)(shm + GEMM_LDS_TOTAL))[threadIdx.x] = 0u;
  __syncthreads();
  XcdBarrier xbar = xcd_barrier_post((unsigned*)(P.ws + WS_BAR), (volatile LAS unsigned*)(shm + GEMM_LDS_TOTAL));
  unsigned char* ws = P.ws;
  const int G = gridDim.x;
  const int vb = (G % 8 == 0) ? ((int)(blockIdx.x & 7) * (G / 8) + (int)(blockIdx.x >> 3)) : (int)blockIdx.x;
  bf16_t* tok = (bf16_t*)(ws + WS_TOK);
  bf16_t* hb = (bf16_t*)(ws + WS_H);
  float* mod = (float*)(ws + WS_MOD);
  const bf16_t* zrow = (const bf16_t*)(ws + WS_ZROW);
  unsigned char* R = ws + WS_R;

  {
    {
      float* PE = (float*)(ws + W_PE);
      for (int idx = gtid; idx < 320 * 256; idx += gstride) {
        const int p = idx >> 8, j = idx & 255;
        const float freq = expf(-9.210340371976184f * (float)j / 256.f);
        const float ang = (float)(p < 256 ? p : p - 256) * freq;
        float sv, cv; sincosf(ang, &sv, &cv);
        if (p < 256) { PE[p * 256 + j] = sv; PE[65536 + p * 256 + j] = cv; }
        else { PE[131072 + (p - 256) * 256 + j] = sv; PE[131072 + 16384 + (p - 256) * 256 + j] = cv; }
      }
    }
    {
      const float* c = P.in[1]; const float* cc = P.in[3]; const float* adaw = P.in[4];
      float* modp = (float*)(ws + WS_MODP);
      float* s_c = smem;
      for (int k = tid; k < 1024; k += NT) { const float a = c[k], b2 = cc[k]; s_c[k] = a / (1.f + expf(-a)); s_c[1024 + k] = b2 / (1.f + expf(-b2)); }
      __syncthreads();
      for (int idx = gtid; idx < 16 * 4 * 1536; idx += gstride) {
        const int ks = idx / 6144, rem = idx - ks * 6144, i = rem / 1536, j = (rem - i * 1536) * 4;
        const float* wp = adaw + ((size_t)i * 1024 + ks * 64) * 6144 + j;
        float4 a0 = make_float4(0.f, 0.f, 0.f, 0.f), a1 = a0;
        for (int kb = 0; kb < 64; kb += 8) {
          float4 w[8];
#pragma unroll
          for (int u = 0; u < 8; ++u) w[u] = ntload4(wp + (size_t)(kb + u) * 6144);
#pragma unroll
          for (int u = 0; u < 8; ++u) {
            const float s0 = s_c[ks * 64 + kb + u], s1 = s_c[1024 + ks * 64 + kb + u];
            a0.x += s0 * w[u].x; a0.y += s0 * w[u].y; a0.z += s0 * w[u].z; a0.w += s0 * w[u].w;
            a1.x += s1 * w[u].x; a1.y += s1 * w[u].y; a1.z += s1 * w[u].z; a1.w += s1 * w[u].w;
          }
        }
        *(float4*)&modp[(size_t)(ks * 8 + i * 2 + 0) * 6144 + j] = a0;
        *(float4*)&modp[(size_t)(ks * 8 + i * 2 + 1) * 6144 + j] = a1;
      }
      __syncthreads();
    }
    if (gtid < 4 * 32 * 32 + 64) ((int*)(ws + WS_CNT))[gtid] = 0;
    if (gtid < 2048) ((unsigned*)(ws + WS_ZROW))[gtid] = 0u;
    bf16_t* DC = (bf16_t*)(ws + W_DC); bf16_t* DA = (bf16_t*)(ws + W_DA); bf16_t* TW = (bf16_t*)(ws + W_TW);
    for (int idx = gtid; idx < 512 * 256; idx += gstride) {
      const int row = idx >> 8, cch = idx & 255, pq = row >> 8, kc = row & 255;
      const float a = (float)((kc * cch) & 255) * (1.f / 128.f);
      DC[idx] = f2bf(pq ? -sinpif(a) : cospif(a));
    }
    for (int idx = gtid; idx < 256 * 256; idx += gstride) {
      const int row = idx >> 8, col = idx & 255, ri = row >> 7, cc2 = row & 127, rj = col >> 7, aa = col & 127;
      const float a = (float)((aa * cc2) & 127) * (1.f / 64.f);
      const float cs = cospif(a), sn = sinpif(a);
      DA[idx] = f2bf(ri == rj ? cs : (ri == 0 ? sn : -sn));
    }
    for (int idx = gtid; idx < 128 * 128 * 256; idx += gstride) {
      const int col = idx & 255, e = (idx >> 8) & 127, c2 = idx >> 15, ri = col >> 7, b = col & 127;
      const float a = (float)((b * (c2 + 128 * e)) & 16383) * (1.f / 8192.f);
      TW[idx] = f2bf(ri ? sinpif(a) : cospif(a));
    }
    for (int idx = gtid; idx < 2 * 1280; idx += gstride) ((float*)(ws + W_SP))[idx] = log1pf(expf(-P.in[34][idx]));
    for (int idx = gtid; idx < 16 * 1024; idx += gstride) {
      const int k = idx >> 4, g = idx & 15;
      const float w = P.in[21][(size_t)k * 3088 + 3072 + g];
      const bf16_t hi = f2bf(w);
      bf16_t* WG = (bf16_t*)(ws + WS_HLO);
      WG[(size_t)(2 * g) * 1024 + k] = hi;
      WG[(size_t)(2 * g + 1) * 1024 + k] = f2bf(w - bf2f(hi));
    }
    {
      const float* src = P.in[36]; bf16_t* dst = (bf16_t*)(ws + W_FNIN);
      for (int idx = gtid; idx < 1024 * 1024 / 4; idx += gstride) {
        const float4 a = *(const float4*)&src[(size_t)idx * 4];
        uint2 o; o.x = pack2(a.x, a.y); o.y = pack2(a.z, a.w);
        *(uint2*)&dst[(size_t)idx * 4] = o;
      }
    }
    {
      struct CD { const float* src; bf16_t* dst; int ldn, ldk, k0, n0, mm, nt; };
      const int NDENSE = (512 + 256 + 768 + 256 + 640 + 320 + 256 + 160) / 2;
      const int NTOT = NDENSE + 128 * 192;
      auto desc = [=](int u) -> CD {
        CD d;
        if (u < NDENSE) {
          int v = u;
          if (v < 256) { d = CD{P.in[16], (bf16_t*)(ws + W_CMIN), 2048, 1024, (v >> 5) * 128, (v & 31) * 64, 0, 0}; return d; }
          v -= 256;
          if (v < 128) { d = CD{P.in[20], (bf16_t*)(ws + W_CMOUT), 1024, 1024, (v >> 4) * 128, (v & 15) * 64, 0, 0}; return d; }
          v -= 128;
          if (v < 384) { d = CD{P.in[21], (bf16_t*)(ws + W_MLIN), 3088, 1024, (v / 48) * 128, (v % 48) * 64, 0, 0}; return d; }
          v -= 384;
          if (v < 128) { d = CD{P.in[26], (bf16_t*)(ws + W_MLOUT), 1024, 1024, (v >> 4) * 128, (v & 15) * 64, 0, 0}; return d; }
          v -= 128;
          if (v < 320) { d = CD{P.in[27], (bf16_t*)(ws + W_LRUIN), 2560, 1024, (v / 40) * 128, (v % 40) * 64, 0, 0}; return d; }
          v -= 320;
          if (v < 160) { d = CD{P.in[35], (bf16_t*)(ws + W_LRUOUT), 1024, 1280, (v >> 4) * 128, (v & 15) * 64, 0, 0}; return d; }
          v -= 160;
          if (v < 128) { d = CD{P.in[37], (bf16_t*)(ws + W_FNOUT), 1024, 1024, (v >> 4) * 128, (v & 15) * 64, 0, 0}; return d; }
          v -= 128;
          const int mat = v >> 1, tl2 = v & 1, type = mat / 20, dnb = mat % 20, dd = dnb / 10, nb = dnb % 10;
          d = CD{(type ? P.in[32] : P.in[30]) + (size_t)dnb * 128 * 128, (bf16_t*)(ws + W_LRUG) + (size_t)(nb * 2 + dd) * 256 * 128,
                 128, 128, 0, tl2 * 64, type + 1, 0};
          return d;
        }
        const int v = u - NDENSE, le = v / 192, r = v - le * 192, kind = r >> 6, tt = r & 63;
        if (kind < 2) d = CD{(kind == 0 ? P.in[13] : P.in[14]) + (size_t)le * 1024 * 512, (bf16_t*)(ws + W_EGU) + (size_t)le * 1024 * 1024,
                             512, 1024, (tt >> 3) * 128, (tt & 7) * 64, kind + 1, le >= 32 ? 1 : 0};
        else d = CD{P.in[15] + (size_t)le * 512 * 1024, (bf16_t*)(ws + W_ED) + (size_t)le * 1024 * 512, 1024, 512, (tt >> 4) * 128, (tt & 15) * 64, 0, le >= 32 ? 1 : 0};
        return d;
      };
      auto upper = [](CD d) -> CD { d.k0 += 64; return d; };
      const int tq = tid, lrow = tq >> 3, c4 = (tq & 7) * 4, sn = tq >> 3, kg = (tq & 7) * 8;
      float (*tl0)[65] = (float (*)[65])smem;
      float (*tl1)[65] = (float (*)[65])(smem + 64 * 65);
      int u = blockIdx.x;
      CD d0 = desc(u < NTOT ? u : 0), d1 = upper(d0);
      float4 a0, b0, a1, b1;
      a0 = ntload4(&d0.src[(size_t)(d0.k0 + lrow) * d0.ldn + d0.n0 + c4]);
      b0 = ntload4(&d0.src[(size_t)(d0.k0 + lrow) * d0.ldn + d0.n0 + 32 + c4]);
      a1 = ntload4(&d1.src[(size_t)(d1.k0 + lrow) * d1.ldn + d1.n0 + c4]);
      b1 = ntload4(&d1.src[(size_t)(d1.k0 + lrow) * d1.ldn + d1.n0 + 32 + c4]);
      for (; u < NTOT; u += G) {
        const bool v1 = true;
        tl0[lrow][c4 + 0] = a0.x; tl0[lrow][c4 + 1] = a0.y; tl0[lrow][c4 + 2] = a0.z; tl0[lrow][c4 + 3] = a0.w;
        tl0[lrow][32 + c4 + 0] = b0.x; tl0[lrow][32 + c4 + 1] = b0.y; tl0[lrow][32 + c4 + 2] = b0.z; tl0[lrow][32 + c4 + 3] = b0.w;
        tl1[lrow][c4 + 0] = a1.x; tl1[lrow][c4 + 1] = a1.y; tl1[lrow][c4 + 2] = a1.z; tl1[lrow][c4 + 3] = a1.w;
        tl1[lrow][32 + c4 + 0] = b1.x; tl1[lrow][32 + c4 + 1] = b1.y; tl1[lrow][32 + c4 + 2] = b1.z; tl1[lrow][32 + c4 + 3] = b1.w;
        __syncthreads();
        const CD c0 = d0, c1 = d1;
        const int un = u + G;
        if (un < NTOT) {
          d0 = desc(un); d1 = upper(d0);
          a0 = ntload4(&d0.src[(size_t)(d0.k0 + lrow) * d0.ldn + d0.n0 + c4]);
          b0 = ntload4(&d0.src[(size_t)(d0.k0 + lrow) * d0.ldn + d0.n0 + 32 + c4]);
          a1 = ntload4(&d1.src[(size_t)(d1.k0 + lrow) * d1.ldn + d1.n0 + c4]);
          b1 = ntload4(&d1.src[(size_t)(d1.k0 + lrow) * d1.ldn + d1.n0 + 32 + c4]);
        }
        {
          uint4 o;
          o.x = pack2(tl0[kg + 0][sn], tl0[kg + 1][sn]); o.y = pack2(tl0[kg + 2][sn], tl0[kg + 3][sn]);
          o.z = pack2(tl0[kg + 4][sn], tl0[kg + 5][sn]); o.w = pack2(tl0[kg + 6][sn], tl0[kg + 7][sn]);
          const int h = c0.n0 + sn;
          const int dr = c0.mm == 0 ? h : ((h >> 3) * 16 + (h & 7) + (c0.mm == 2 ? 8 : 0));
          { typedef __attribute__((ext_vector_type(4))) unsigned u4v; const u4v ov = {o.x, o.y, o.z, o.w}; u4v* dp = (u4v*)&c0.dst[(size_t)dr * c0.ldk + c0.k0 + kg];
            if (c0.nt) __builtin_nontemporal_store(ov, dp); else *dp = ov; }
        }
        if (v1) {
          uint4 o;
          o.x = pack2(tl1[kg + 0][sn], tl1[kg + 1][sn]); o.y = pack2(tl1[kg + 2][sn], tl1[kg + 3][sn]);
          o.z = pack2(tl1[kg + 4][sn], tl1[kg + 5][sn]); o.w = pack2(tl1[kg + 6][sn], tl1[kg + 7][sn]);
          const int h = c1.n0 + sn;
          const int dr = c1.mm == 0 ? h : ((h >> 3) * 16 + (h & 7) + (c1.mm == 2 ? 8 : 0));
          { typedef __attribute__((ext_vector_type(4))) unsigned u4v; const u4v ov = {o.x, o.y, o.z, o.w}; u4v* dp = (u4v*)&c1.dst[(size_t)dr * c1.ldk + c1.k0 + kg];
            if (c1.nt) __builtin_nontemporal_store(ov, dp); else *dp = ov; }
        }
        __syncthreads();
      }
    }
  }
  grid.sync();
  {
    const float* modp = (const float*)(ws + WS_MODP);
    const float* adab = P.in[5];
    for (int idx = gtid; idx < 8 * 6144; idx += gstride) {
      const int is = idx / 6144, j = idx - is * 6144, i = is >> 1;
      float a = adab[i * 6144 + j];
      for (int ks = 0; ks < 16; ++ks) a += modp[(size_t)(ks * 8 + is) * 6144 + j];
      mod[idx] = a;
    }
    {
      const bf16_t* DC = (const bf16_t*)(ws + W_DC);
      const bf16_t* WI = (const bf16_t*)(ws + W_FNIN);
      bf16_t* WP = (bf16_t*)(ws + W_FNP);
      gemm_loop<4, true>(shm, 4, vb, 64, G,
        [=](int L, int r) { const int tm = L >> 2; return DC + (size_t)((tm >> 3) * 256 + (tm & 1) * 128 + r) * 256; },
        [=](int L, int cidx) { const int tm = L >> 2; return WI + (size_t)((L & 3) * 256 + cidx) * 1024 + ((tm >> 1) & 3) * 256; }, KOffL(), KOffL(),
        per_m([=](int L, int row, int col0, const f32x4 (&a)[4]) { st16bf(WP + (size_t)((L >> 2) * 128 + row) * 1024 + (L & 3) * 256 + col0, a); }));
    }
  }
  xcd_barrier(xbar);

#define MODV(i, s, j, n) mod[(size_t)(((i) * 2 + (s)) * 6 + (j)) * 1024 + (n)]

  auto resid_epi = [=](int layer, int grow, int gcol0, const f32x4 (&a)[4]) {
    const int s = grow < T_CTX ? 1 : 0;
    const float* gate = &MODV(layer, s, 2, gcol0);
    bf16_t* p = tok + (size_t)grow * DM + gcol0;
    const uint4 x0 = *(const uint4*)p, x1 = *(const uint4*)(p + 8);
    const unsigned xx[8] = {x0.x, x0.y, x0.z, x0.w, x1.x, x1.y, x1.z, x1.w};
    f32x4 o[4];
#pragma unroll
    for (int n = 0; n < 4; ++n) {
      const float4 g4 = *(const float4*)(gate + n * 4);
      o[n][0] = lo2f(xx[2 * n]) + g4.x * a[n][0]; o[n][1] = hi2f(xx[2 * n]) + g4.y * a[n][1];
      o[n][2] = lo2f(xx[2 * n + 1]) + g4.z * a[n][2]; o[n][3] = hi2f(xx[2 * n + 1]) + g4.w * a[n][3];
    }
    st16bf(p, o);
  };

  auto moe_layer = [&](int layer, int t0) __attribute__((always_inline)) {
    ffn_norm_router_phase(P, t0, layer, smem);
    xcd_barrier(xbar);
    int* cnt = (int*)(ws + WS_CNT) + layer * 32 * 32;
    int* list = (int*)(ws + WS_LIST);
    float* asgw = (float*)(ws + WS_ASGW);
    int* ps = (int*)(shm + GEMM_LDS_TOTAL + 64);
    if (tid == 0) {
      int s = 0;
      for (int e = 0; e < 32; ++e) { ps[e] = s; s += (cnt[e * 32] + 127) / 128 * 128; }
      ps[32] = s;
    }
    __syncthreads();
    const int total = ps[32];
    bf16_t* HB = (bf16_t*)(R + R_HB);
    bf16_t* ybuf = (bf16_t*)(R + R_YBUF);
    const bf16_t* WGU = (const bf16_t*)(ws + W_EGU) + (size_t)layer * 32 * 1024 * 1024;
    const bf16_t* WD = (const bf16_t*)(ws + W_ED) + (size_t)layer * 32 * 1024 * 512;
    const int ntile = (total >> 7) * 4;
    auto blk_e = [=](int mb) { int e = 0; for (int q = 1; q < 32; ++q) if (ps[q] <= mb * 128) e = q; return e; };
    const int tail = ntile % G;
    const bool split = tail > 0 && 2 * tail <= G;
    const int nfull = split ? ntile - tail : ntile;
    {
      auto a1 = [=](int L, int r) { const int mb = L >> 2, e = blk_e(mb), rr = mb * 128 - ps[e] + r;
          return (rr < cnt[e * 32]) ? (const bf16_t*)(hb + (size_t)(list[(size_t)e * 33280 + rr] >> 1) * DM) : zrow; };
      auto b1 = [=](int L, int cidx) { const int e = blk_e(L >> 2); return WGU + (size_t)e * 1024 * 1024 + (size_t)((L & 3) * 256 + cidx) * 1024; };
      auto e1 = [=](int L, int row, int col0, const f32x4 (&a)[4]) {
          const int n0 = (L & 3) * 256, m0 = (L >> 2) * 128;
          float hv[8];
#pragma unroll
          for (int j = 0; j < 8; ++j) { const float gv = a[j >> 2][j & 3], uv = a[2 + (j >> 2)][j & 3]; hv[j] = silu_f(gv) * uv; }
          uint4 o; o.x = pack2(hv[0], hv[1]); o.y = pack2(hv[2], hv[3]); o.z = pack2(hv[4], hv[5]); o.w = pack2(hv[6], hv[7]);
          *(uint4*)&HB[(size_t)(m0 + row) * 512 + ((n0 + col0) >> 1)] = o;
        };
      gemm_loop<4, true>(shm, 16, vb, nfull, G, a1, b1, KOffL(), KOffL(), per_m(e1));
      if (split)
        gemm_loop<2, true>(shm, 16, vb, 2 * tail, G,
          [=](int H, int r) { return a1(nfull + (H >> 1), r + 64 * (H & 1)); },
          [=](int H, int cidx) { return b1(nfull + (H >> 1), cidx); }, KOffL(), KOffL(),
          per_m([=](int H, int row, int col0, const f32x4 (&a)[4]) { e1(nfull + (H >> 1), row + 64 * (H & 1), col0, a); }));
    }
    xcd_barrier(xbar);
    {
      auto a2 = [=](int L, int r) { return (const bf16_t*)(HB + (size_t)((L >> 2) * 128 + r) * 512); };
      auto b2 = [=](int L, int cidx) { const int e = blk_e(L >> 2); return WD + (size_t)e * 1024 * 512 + (size_t)((L & 3) * 256 + cidx) * 512; };
      auto e2 = [=](int L, int row, int col0, const f32x4 (&a)[4]) {
          const int mb = L >> 2, n0 = (L & 3) * 256, e = blk_e(mb), rr = mb * 128 - ps[e] + row;
          if (rr < cnt[e * 32]) {
            const int rt = list[(size_t)e * 33280 + rr];
            const float w = asgw[rt];
            f32x4 bq[4];
#pragma unroll
            for (int n = 0; n < 4; ++n) bq[n] = a[n] * w;
            st16bf(ybuf + (size_t)rt * 1024 + n0 + col0, bq);
          }
        };
      gemm_loop<4, true>(shm, 8, vb, nfull, G, a2, b2, KOffL(), KOffL(), per_m(e2));
      if (split)
        gemm_loop<2, true>(shm, 8, vb, 2 * tail, G,
          [=](int H, int r) { return a2(nfull + (H >> 1), r + 64 * (H & 1)); },
          [=](int H, int cidx) { return b2(nfull + (H >> 1), cidx); }, KOffL(), KOffL(),
          per_m([=](int H, int row, int col0, const f32x4 (&a)[4]) { e2(nfull + (H >> 1), row + 64 * (H & 1), col0, a); }));
    }
    xcd_barrier(xbar);
  };

  {
    norm_phase(P, 0, P.in[6] + 0 * 1024, 0, 0, -2, 0, false, false, 0, smem);
    xcd_barrier(xbar);
    bf16_t* zu = (bf16_t*)(R + R0_ZU); bf16_t* zvT = (bf16_t*)(R + R0_ZVT); bf16_t* pb = (bf16_t*)(R + R0_P);
    bf16_t* Wsc = (bf16_t*)(R + R0_WSC);
    const float* vg = P.in[17]; const float* w_s = P.in[18]; const float* b_s = P.in[19];
    const bf16_t* Wt = (const bf16_t*)(ws + W_CMIN);
    {
      auto epi_u = [=](int grow, int gcol0, const f32x4 (&a)[4]) {
        f32x4 bq[4];
#pragma unroll
        for (int n = 0; n < 4; ++n)
#pragma unroll
          for (int j = 0; j < 4; ++j) bq[n][j] = gelu_f(a[n][j]);
        st16bf(zu + (size_t)grow * 1024 + gcol0, bq);
      };
      auto epi_vT = [=](int vcol, int t0c, const f32x4 (&a)[4]) {
        f32x4 bq[4];
#pragma unroll
        for (int n = 0; n < 4; ++n)
#pragma unroll
          for (int j = 0; j < 4; ++j) bq[n][j] = gelu_f(a[n][j]);
        st16bf(zvT + ((size_t)(t0c >> 7) * 1024 + vcol) * 128 + (t0c & 127), bq);
      };
      gemm_run<8, true>(shm, 16, vb, 256, G,
        [=](int L, int r) { return (const bf16_t*)(hb + (size_t)((1 + (L >> 2)) * 256 + r) * DM); },
        [=](int L, int cidx) { return Wt + (size_t)((L & 3) * 256 + cidx) * 1024; }, KOffL(), KOffL(),
        per_m([=](int L, int row, int col0, const f32x4 (&a)[4]) { epi_u((1 + (L >> 2)) * 256 + row, (L & 3) * 256 + col0, a); }));
      gemm_run<8, true>(shm, 16, vb, 256, G,
        [=](int L, int r) { return Wt + (size_t)((4 + (L & 3)) * 256 + r) * 1024; },
        [=](int L, int cidx) { return (const bf16_t*)(hb + (size_t)((1 + (L >> 2)) * 256 + cidx) * DM); }, KOffL(), KOffL(),
        per_m([=](int L, int row, int col0, const f32x4 (&a)[4]) { epi_vT((L & 3) * 256 + row, (1 + (L >> 2)) * 256 + col0, a); }));
      skinny_items(shm, vb, 128, G,
        [=](int it, int r) { return it < 64 ? (const bf16_t*)(hb + (size_t)((it >> 4) * 64 + r) * DM) : Wt + (size_t)(1024 + ((it - 64) >> 2) * 64 + r) * 1024; },
        [=](int it, int c) { return it < 64 ? Wt + (size_t)((it & 15) * 64 + c) * 1024 : (const bf16_t*)(hb + (size_t)(((it - 64) & 3) * 64 + c) * DM); },
        [=](int it, int row, int col0, const f32x4 (&a)[4]) {
          if (it < 64) epi_u((it >> 4) * 64 + row, (it & 15) * 64 + col0, a);
          else epi_vT(((it - 64) >> 2) * 64 + row, ((it - 64) & 3) * 64 + col0, a);
        });
    }
    xcd_barrier(xbar);
    {
      float* s_part = smem;
      float* s_rv = smem + 4096;
      for (int n = blockIdx.x; n < NCH; n += G) {
        {
          const int tq = tid, cg = tq >> 4, sg = tq & 15;
          float ss8[8];
#pragma unroll
          for (int e = 0; e < 8; ++e) ss8[e] = 0.f;
          for (int it = 0; it < 32; it += 4) {
            uint4 z[4];
#pragma unroll
            for (int u = 0; u < 4; ++u) z[u] = *(const uint4*)&zvT[((size_t)n * 1024 + (it + u) * 32 + cg) * 128 + sg * 8];
#pragma unroll
            for (int u = 0; u < 4; ++u) {
              const unsigned zz[4] = {z[u].x, z[u].y, z[u].z, z[u].w};
#pragma unroll
              for (int e = 0; e < 4; ++e) { const float a = lo2f(zz[e]), b2 = hi2f(zz[e]); ss8[2 * e] += a * a; ss8[2 * e + 1] += b2 * b2; }
            }
          }
#pragma unroll
          for (int e = 0; e < 8; ++e) s_part[cg * 128 + sg * 8 + e] = ss8[e];
        }
        __syncthreads();
        if (tid < 128) {
          float a = 0.f;
          for (int q = 0; q < 32; ++q) a += s_part[q * 128 + tid];
          s_rv[tid] = 1.f / sqrtf(a * (1.f / 1024.f) + EPSN);
        }
        __syncthreads();
        for (int idx = tid; idx < 4 * 128 * 32; idx += NT) {
          const int s4 = (idx & 31) * 4, gt = idx >> 5;
          const float4 w4 = *(const float4*)&w_s[(size_t)gt * 128 + s4];
          uint2 o; o.x = pack2(w4.x * s_rv[s4], w4.y * s_rv[s4 + 1]); o.y = pack2(w4.z * s_rv[s4 + 2], w4.w * s_rv[s4 + 3]);
          *(uint2*)&Wsc[((size_t)n * 512 + gt) * 128 + s4] = o;
        }
        __syncthreads();
      }
    }
    xcd_barrier(xbar);
    {
      gemm_bal<4, true, true>(shm, 2, vb, NCH * 4, G,
        [=](int L, int r) { return (const bf16_t*)(Wsc + ((size_t)(L >> 2) * 512 + (L & 3) * 128 + r) * 128); },
        [=](int L, int cidx) { return (const bf16_t*)(zvT + ((size_t)(L >> 2) * 1024 + (L & 3) * 256 + cidx) * 128); },
        KOffL(), KOffL(),
        ([=](int L, int row, int col0, const f32x4 (&a)[4]) {
          const int n = L >> 2, g = L & 3;
          const int t = n * 128 + row, col = g * 256 + col0;
          const float bias = b_s[g * 128 + row];
          const uint4 u0 = *(const uint4*)&zu[(size_t)t * 1024 + col], u1 = *(const uint4*)&zu[(size_t)t * 1024 + col + 8];
          const unsigned uu[8] = {u0.x, u0.y, u0.z, u0.w, u1.x, u1.y, u1.z, u1.w};
          f32x4 o[4];
#pragma unroll
          for (int nn = 0; nn < 4; ++nn) {
            const float4 g4 = *(const float4*)&vg[col + nn * 4];
            o[nn][0] = lo2f(uu[nn * 2]) * (a[nn][0] * g4.x + bias);
            o[nn][1] = hi2f(uu[nn * 2]) * (a[nn][1] * g4.y + bias);
            o[nn][2] = lo2f(uu[nn * 2 + 1]) * (a[nn][2] * g4.z + bias);
            o[nn][3] = hi2f(uu[nn * 2 + 1]) * (a[nn][3] * g4.w + bias);
          }
          st16bf(pb + (size_t)t * 1024 + col, o);
        }));
    }
    xcd_barrier(xbar);
    const bf16_t* Wo = (const bf16_t*)(ws + W_CMOUT);
    auto epi_out = [=](int grow, int gcol0, const f32x4 (&a)[4]) { resid_epi(0, grow, gcol0, a); };
    dense_phase(shm, vb, G, pb, 1024, Wo, 1024, 4, 16, 2, epi_out);
    xcd_barrier(xbar);
  }
  moe_layer(0, 0);

  {
    norm_phase(P, 0, P.in[6] + 1 * 1024, 1, 0, 0, 0, false, false, 0, smem);
    xcd_barrier(xbar);
    bf16_t* ZQK = (bf16_t*)(R + R1_ZQK); bf16_t* ZO = (bf16_t*)(R + R1_ZO); bf16_t* VT = (bf16_t*)(R + R1_VT);
    float* gpre = (float*)(R + R1_GPRE); bf16_t* Qn = (bf16_t*)(R + R1_QN); bf16_t* Kn = (bf16_t*)(R + R1_KN);
    bf16_t* AS = (bf16_t*)(R + R1_AS); bf16_t* KwT = (bf16_t*)(R + R1_KWT);
    float* bc = (float*)(R + R1_BC); float* li = (float*)(R + R1_LI); float* egch = (float*)(R + R1_GCH);
    float* nloc = (float*)(R + R1_NLOC); float* nin = (float*)(R + R1_NIN);
    float* Cloc = (float*)(R + R1_CLOC); bf16_t* CinT = (bf16_t*)(R + R1_CINT); bf16_t* hnum = (bf16_t*)(R + R1_CLOC);
    bf16_t* A2 = (bf16_t*)(R + R1_A2);
    const float* w_in = P.in[21]; const float* cw = P.in[22]; const float* cb = P.in[23];
    const float* gb = P.in[24]; const float* ng = P.in[25];
    const bf16_t* Wt = (const bf16_t*)(ws + W_MLIN);
    {
      auto epi_nat = [=](int grow, int gcol0, const f32x4 (&a)[4]) {
        if (gcol0 < 1024) st16bf(ZQK + (size_t)grow * 1024 + gcol0, a); else st16bf(ZO + (size_t)grow * 1024 + gcol0 - 2048, a);
      };
      auto epi_vt = [=](int vcol, int t0c, const f32x4 (&a)[4]) {
        st16bf(VT + ((size_t)(t0c >> 7) * 1024 + vcol) * 128 + (t0c & 127), a);
      };
      {
        const bf16_t* WG = (const bf16_t*)(ws + WS_HLO);
        skinny_items(shm, vb, T_ALL / 64, G,
          [=](int it, int r) { return (const bf16_t*)(hb + (size_t)(it * 64 + r) * DM); },
          [=](int it, int c) { return c < 32 ? WG + (size_t)c * 1024 : zrow; },
          [=](int it, int row, int col0, const f32x4 (&a)[4]) {
            if (col0 < 32) {
              float* gp = gpre + (size_t)(it * 64 + row) * 16 + (col0 >> 1);
              *(float4*)gp = make_float4(a[0][0] + a[0][1], a[0][2] + a[0][3], a[1][0] + a[1][1], a[1][2] + a[1][3]);
              *(float4*)(gp + 4) = make_float4(a[2][0] + a[2][1], a[2][2] + a[2][3], a[3][0] + a[3][1], a[3][2] + a[3][3]);
            }
          });
      }
      gemm_run<8, true>(shm, 16, vb, 512, G,
        [=](int L, int r) { return (const bf16_t*)(hb + (size_t)((1 + (L >> 3)) * 256 + r) * DM); },
        [=](int L, int cidx) { const int j = L & 7, tn = j < 4 ? j : j + 4; return Wt + (size_t)(tn * 256 + cidx) * 1024; }, KOffL(), KOffL(),
        per_m([=](int L, int row, int col0, const f32x4 (&a)[4]) { const int j = L & 7, tn = j < 4 ? j : j + 4; epi_nat((1 + (L >> 3)) * 256 + row, tn * 256 + col0, a); }));
      gemm_run<8, true>(shm, 16, vb, 256, G,
        [=](int L, int r) { return Wt + (size_t)((4 + (L & 3)) * 256 + r) * 1024; },
        [=](int L, int cidx) { return (const bf16_t*)(hb + (size_t)((1 + (L >> 2)) * 256 + cidx) * DM); }, KOffL(), KOffL(),
        per_m([=](int L, int row, int col0, const f32x4 (&a)[4]) { epi_vt((L & 3) * 256 + row, (1 + (L >> 2)) * 256 + col0, a); }));
      skinny_items(shm, vb, 192, G,
        [=](int it, int r) { return it < 128 ? (const bf16_t*)(hb + (size_t)((it >> 5) * 64 + r) * DM) : Wt + (size_t)(1024 + ((it - 128) >> 2) * 64 + r) * 1024; },
        [=](int it, int c) { const int cb = it & 31, col = cb < 16 ? cb * 64 : 2048 + (cb - 16) * 64;
          return it < 128 ? Wt + (size_t)(col + c) * 1024 : (const bf16_t*)(hb + (size_t)(((it - 128) & 3) * 64 + c) * DM); },
        [=](int it, int row, int col0, const f32x4 (&a)[4]) {
          if (it < 128) { const int cb = it & 31, col = cb < 16 ? cb * 64 : 2048 + (cb - 16) * 64; epi_nat((it >> 5) * 64 + row, col + col0, a); }
          else epi_vt(((it - 128) >> 2) * 64 + row, ((it - 128) & 3) * 64 + col0, a);
        });
    }
    xcd_barrier(xbar);
    {
      float* s_bc = smem;
      float* s_w  = smem + 1024;
      float* s_k  = smem + 2048;
      const int wv = tid >> 6, lane = tid & 63;
      auto prep_item = [&](int n, int h0, int hc) __attribute__((always_inline)) {
        if ((wv & 3) >= h0 && (wv & 3) < h0 + hc) {
          const int dh = wv, d = dh >> 2, hd = dh & 3;
          const int p0 = 2 * lane, p1 = p0 + 1;
          const int t0 = n * 128 + (d == 0 ? p0 : 127 - p0), t1 = n * 128 + (d == 0 ? p1 : 127 - p1);
          const float li0 = gpre[(size_t)t0 * 16 + d * 8 + hd] + gb[d * 8 + hd];
          const float li1 = gpre[(size_t)t1 * 16 + d * 8 + hd] + gb[d * 8 + hd];
          const float lf0 = logsig_f(gpre[(size_t)t0 * 16 + d * 8 + 4 + hd] + gb[d * 8 + 4 + hd]);
          const float lf1 = logsig_f(gpre[(size_t)t1 * 16 + d * 8 + 4 + hd] + gb[d * 8 + 4 + hd]);
          float run = lf0 + lf1;
#pragma unroll
          for (int o = 1; o < 64; o <<= 1) { const float y = __shfl_up(run, o); if (lane >= o) run += y; }
          const float b1 = run, b0 = run - lf1;
          const float g = __shfl(run, 63);
          bc[(size_t)dh * T_ALL + t0] = expf(b0); bc[(size_t)dh * T_ALL + t1] = expf(b1);
          li[(size_t)dh * T_ALL + t0] = expf(li0 - b0); li[(size_t)dh * T_ALL + t1] = expf(li1 - b1);
          s_bc[dh * 128 + (t0 & 127)] = b0; s_bc[dh * 128 + (t1 & 127)] = b1;
          s_w[dh * 128 + (t0 & 127)] = expf(g - b0 + li0); s_w[dh * 128 + (t1 & 127)] = expf(g - b1 + li1);
          if (lane == 0) egch[dh * NCH + n] = expf(g);
        }
        __syncthreads();
        const int lo = n < 2 ? 0 : T_CTX, hi = n < 2 ? T_CTX : T_ALL;
        const int qsh = hc == 2 ? 5 : 4;
        for (int idx = tid; idx < (128 << qsh); idx += NT) {
          const int tl = idx >> qsh, c0 = h0 * 128 + (idx & ((1 << qsh) - 1)) * 8, t = n * 128 + tl, hd = c0 >> 7;
          float q[8];
#pragma unroll
          for (int e = 0; e < 8; ++e) q[e] = cb[c0 + e];
#pragma unroll
          for (int j = 0; j < 4; ++j) {
            const int tt = t + j - 2;
            if (tt >= lo && tt < hi) {
              const uint4 z = *(const uint4*)&ZQK[(size_t)tt * 1024 + c0];
              const float4 w0 = *(const float4*)&cw[j * 1024 + c0], w1 = *(const float4*)&cw[j * 1024 + c0 + 4];
              q[0] += lo2f(z.x) * w0.x; q[1] += hi2f(z.x) * w0.y; q[2] += lo2f(z.y) * w0.z; q[3] += hi2f(z.y) * w0.w;
              q[4] += lo2f(z.z) * w1.x; q[5] += hi2f(z.z) * w1.y; q[6] += lo2f(z.w) * w1.z; q[7] += hi2f(z.w) * w1.w;
            }
          }
#pragma unroll
          for (int e = 0; e < 8; ++e) q[e] = silu_f(q[e]) * 0.08838834764831845f;
          uint4 o; o.x = pack2(q[0], q[1]); o.y = pack2(q[2], q[3]); o.z = pack2(q[4], q[5]); o.w = pack2(q[6], q[7]);
          *(uint4*)&Qn[(size_t)t * 512 + c0] = o;
#pragma unroll
          for (int d = 0; d < 2; ++d) {
            const int dh = d * 4 + hd;
            const float eb = expf(s_bc[dh * 128 + tl]);
            uint4 o2; o2.x = pack2(q[0] * eb, q[1] * eb); o2.y = pack2(q[2] * eb, q[3] * eb); o2.z = pack2(q[4] * eb, q[5] * eb); o2.w = pack2(q[6] * eb, q[7] * eb);
            *(uint4*)&AS[((size_t)dh * T_ALL + t) * 256 + 128 + (c0 & 127)] = o2;
          }
        }
        for (int hd = h0; hd < h0 + hc; ++hd) {
          for (int idx = tid; idx < 128 * 16; idx += NT) {
            const int tl = idx >> 4, k0 = (idx & 15) * 8, t = n * 128 + tl, c0 = 512 + hd * 128 + k0;
            float q[8];
#pragma unroll
            for (int e = 0; e < 8; ++e) q[e] = cb[c0 + e];
#pragma unroll
            for (int j = 0; j < 4; ++j) {
              const int tt = t + j - 2;
              if (tt >= lo && tt < hi) {
                const uint4 z = *(const uint4*)&ZQK[(size_t)tt * 1024 + c0];
                const float4 w0 = *(const float4*)&cw[j * 1024 + c0], w1 = *(const float4*)&cw[j * 1024 + c0 + 4];
                q[0] += lo2f(z.x) * w0.x; q[1] += hi2f(z.x) * w0.y; q[2] += lo2f(z.y) * w0.z; q[3] += hi2f(z.y) * w0.w;
                q[4] += lo2f(z.z) * w1.x; q[5] += hi2f(z.z) * w1.y; q[6] += lo2f(z.w) * w1.z; q[7] += hi2f(z.w) * w1.w;
              }
            }
#pragma unroll
            for (int e = 0; e < 8; ++e) { q[e] = silu_f(q[e]); s_k[tl * 129 + k0 + e] = q[e]; }
            uint4 o; o.x = pack2(q[0], q[1]); o.y = pack2(q[2], q[3]); o.z = pack2(q[4], q[5]); o.w = pack2(q[6], q[7]);
            *(uint4*)&Kn[(size_t)t * 512 + hd * 128 + k0] = o;
          }
          __syncthreads();
          for (int idx = tid; idx < 2 * 128 * 16; idx += NT) {
            const int d = idx >> 11, rem = idx & 2047, kk = rem >> 4, s0 = (rem & 15) * 8, dh = d * 4 + hd;
            float v8[8];
#pragma unroll
            for (int e = 0; e < 8; ++e) v8[e] = s_w[dh * 128 + s0 + e] * s_k[(s0 + e) * 129 + kk];
            uint4 o; o.x = pack2(v8[0], v8[1]); o.y = pack2(v8[2], v8[3]); o.z = pack2(v8[4], v8[5]); o.w = pack2(v8[6], v8[7]);
            *(uint4*)&KwT[((size_t)dh * T_ALL + n * 128 + kk) * 128 + s0] = o;
          }
          if (tid < 256) {
            const int d = tid >> 7, kk = tid & 127, dh = d * 4 + hd;
            float a = 0.f;
            for (int s2 = 0; s2 < 128; ++s2) a += s_w[dh * 128 + s2] * s_k[s2 * 129 + kk];
            nloc[(dh * NCH + n) * 128 + kk] = a;
          }
          __syncthreads();
        }
      };
      const int nitem = NCH * 2, xtra = nitem - G;
      if (xtra > 0 && 4 * xtra <= G) {
        const int b = blockIdx.x, nsolo = G - 2 * xtra;
        if (b < nsolo) prep_item(b >> 1, (b & 1) * 2, 2);
        else {
          for (int u = 3 * (b - nsolo); u < 3 * (b - nsolo) + 3; ++u) {
            const int it = nsolo + (u >> 1);
            prep_item(it >> 1, (it & 1) * 2 + (u & 1), 1);
          }
        }
      } else {
        for (int it = blockIdx.x; it < nitem; it += G) prep_item(it >> 1, (it & 1) * 2, 2);
      }
    }
    xcd_barrier(xbar);
    bf16_t* Clocb = (bf16_t*)Cloc;
    gemm_bal<4, true, true>(shm, 2, vb, 1040, G,
      [=](int L, int r) { const int n = L >> 3, hd = (L >> 1) & 3, mh = L & 1; return (const bf16_t*)(VT + ((size_t)n * 1024 + hd * 256 + mh * 128 + r) * 128); },
      [=](int L, int cidx) { const int n = L >> 3, hd = (L >> 1) & 3, dh = (cidx >> 7) * 4 + hd; return (const bf16_t*)(KwT + ((size_t)dh * T_ALL + n * 128 + (cidx & 127)) * 128); },
      KOffL(), KOffL(),
      [=](int L, int row, int col0, const f32x4 (&a)[4]) {
        const int n = L >> 3, hd = (L >> 1) & 3, mh = L & 1, dh = (col0 >> 7) * 4 + hd;
        st16bf(Clocb + (size_t)(dh * NCH + n) * 32768 + (size_t)(mh * 128 + row) * 128 + (col0 & 127), a);
      });
    gemm_bal<4, true, true>(shm, 2, (vb - 32 + G) % G, 520, G,
      [=](int L, int r) { const int hd = L / NCH, n = L - hd * NCH; return (const bf16_t*)(Qn + (size_t)(n * 128 + r) * 512 + hd * 128); },
      [=](int L, int cidx) { const int hd = L / NCH, n = L - hd * NCH; return cidx < 128 ? (const bf16_t*)(Kn + (size_t)(n * 128 + cidx) * 512 + hd * 128) : zrow; },
      KOffL(), KOffL(),
      ([=](int L, int row, int col0, const f32x4 (&a)[4]) {
        const int hd = L / NCH, n = L - hd * NCH;
        if (col0 < 128) {
          const int tt = n * 128 + row;
#pragma unroll
          for (int d = 0; d < 2; ++d) {
            const int dh = d * 4 + hd;
            const float bt = bc[(size_t)dh * T_ALL + tt];
            const float* cf = li + (size_t)dh * T_ALL + n * 128 + col0;
            f32x4 o[4];
#pragma unroll
            for (int nn = 0; nn < 4; ++nn) {
              const float4 c4 = *(const float4*)(cf + nn * 4);
              const float cv[4] = {c4.x, c4.y, c4.z, c4.w};
#pragma unroll
              for (int j = 0; j < 4; ++j) {
                const int sc = col0 + nn * 4 + j;
                const bool ok = (d == 0) ? (sc <= row) : (sc >= row);
                o[nn][j] = ok ? a[nn][j] * bt * cv[j] : 0.f;
              }
            }
            st16bf(AS + ((size_t)dh * T_ALL + tt) * 256 + col0, o);
          }
        }
      }));
    xcd_barrier(xbar);
    const unsigned* Clocp = (const unsigned*)(R + R1_CLOC);
    unsigned* CinTp = (unsigned*)CinT;
    for (int idx = gtid; idx < 8 * 16384; idx += gstride) {
      const int dh = idx >> 14, e = idx & 16383, d = dh >> 2;
      const bool hasn = idx < 8 * 128;
      const int dh2 = hasn ? (idx >> 7) : 0, kk = idx & 127, d2 = dh2 >> 2;
      float st = 0.f, st1 = 0.f, st2 = 0.f;
      for (int ib = 0; ib < NCH; ib += 10) {
        unsigned xv[10]; float gv[10], xv2[10], gv2[10];
#pragma unroll
        for (int u = 0; u < 10; ++u) { const int n = scan_order(d, ib + u); xv[u] = Clocp[(size_t)(dh * NCH + n) * 16384 + e]; gv[u] = egch[dh * NCH + n]; }
        if (hasn) {
#pragma unroll
          for (int u = 0; u < 10; ++u) { const int n = scan_order(d2, ib + u); xv2[u] = nloc[(dh2 * NCH + n) * 128 + kk]; gv2[u] = egch[dh2 * NCH + n]; }
        }
#pragma unroll
        for (int u = 0; u < 10; ++u) {
          const int n = scan_order(d, ib + u);
          CinTp[(size_t)(dh * NCH + n) * 16384 + e] = pack2(st, st1);
          st = gv[u] * st + lo2f(xv[u]); st1 = gv[u] * st1 + hi2f(xv[u]);
        }
        if (hasn) {
#pragma unroll
          for (int u = 0; u < 10; ++u) { const int n = scan_order(d2, ib + u); nin[(dh2 * NCH + n) * 128 + kk] = st2; st2 = gv2[u] * st2 + xv2[u]; }
        }
      }
    }
    xcd_barrier(xbar);
    gemm_bal<4, true, true>(shm, 4, vb, 1040, G,
      [=](int L, int r) { const int dh = L / NCH, n = L - dh * NCH; return (const bf16_t*)(AS + ((size_t)dh * T_ALL + n * 128 + r) * 256); },
      [=](int L, int cidx) { const int dh = L / NCH, n = L - dh * NCH, hd = dh & 3; return (const bf16_t*)(VT + ((size_t)n * 1024 + hd * 256 + cidx) * 128); },
      KOffL(),
      [=](int L, int kt) { const int dh = L / NCH, n = L - dh * NCH, hd = dh & 3;
        const int delta = (int)((CinT + (size_t)L * 32768) - (VT + ((size_t)n * 1024 + hd * 256) * 128));
        return kt < 2 ? kt * 64 : delta + (kt - 2) * 64; },
      ([=](int L, int row, int col0, const f32x4 (&a)[4]) {
        const int dh = L / NCH, n = L - dh * NCH;
        st16bf(hnum + ((size_t)dh * T_ALL + n * 128 + row) * 256 + col0, a);
      }));
    xcd_barrier(xbar);
    {
      const int tq = tid, lane = tq & 63, hd = lane >> 4, l16 = lane & 15;
      for (int tt = blockIdx.x * (NT / 64) + (tq >> 6); tt < T_ALL; tt += G * (NT / 64)) {
        const int n = tt >> 7;
        float hs[16];
#pragma unroll
        for (int e = 0; e < 16; ++e) hs[e] = 0.f;
#pragma unroll
        for (int d = 0; d < 2; ++d) {
          const int dh = d * 4 + hd;
          const size_t m = (size_t)dh * T_ALL + tt;
          const uint4 a0 = *(const uint4*)&AS[m * 256 + l16 * 16], a1 = *(const uint4*)&AS[m * 256 + l16 * 16 + 8];
          const uint4 x0 = *(const uint4*)&hnum[m * 256 + l16 * 16], x1 = *(const uint4*)&hnum[m * 256 + l16 * 16 + 8];
          const unsigned aa[8] = {a0.x, a0.y, a0.z, a0.w, a1.x, a1.y, a1.z, a1.w};
          float part = 0.f;
          if (l16 < 8) {
#pragma unroll
            for (int e = 0; e < 8; ++e) part += lo2f(aa[e]) + hi2f(aa[e]);
          } else {
            const float* np = nin + (dh * NCH + n) * 128 + (l16 - 8) * 16;
#pragma unroll
            for (int e = 0; e < 4; ++e) {
              const float4 nv = *(const float4*)(np + e * 4);
              part += lo2f(aa[2 * e]) * nv.x + hi2f(aa[2 * e]) * nv.y + lo2f(aa[2 * e + 1]) * nv.z + hi2f(aa[2 * e + 1]) * nv.w;
            }
          }
          part += __shfl_xor(part, 8); part += __shfl_xor(part, 4); part += __shfl_xor(part, 2); part += __shfl_xor(part, 1);
          const float dn = 1.f / fmaxf(fabsf(part), 1.f);
          const unsigned xx[8] = {x0.x, x0.y, x0.z, x0.w, x1.x, x1.y, x1.z, x1.w};
#pragma unroll
          for (int e = 0; e < 8; ++e) { hs[2 * e] += lo2f(xx[e]) * dn; hs[2 * e + 1] += hi2f(xx[e]) * dn; }
        }
        float ss = 0.f;
#pragma unroll
        for (int e = 0; e < 16; ++e) ss += hs[e] * hs[e];
        ss += __shfl_xor(ss, 8); ss += __shfl_xor(ss, 4); ss += __shfl_xor(ss, 2); ss += __shfl_xor(ss, 1);
        const float r = 1.f / sqrtf(ss * (1.f / 256.f) + EPSN);
        const int col = hd * 256 + l16 * 16;
        const uint4 o0 = *(const uint4*)&ZO[(size_t)tt * 1024 + col], o1 = *(const uint4*)&ZO[(size_t)tt * 1024 + col + 8];
        const unsigned oo[8] = {o0.x, o0.y, o0.z, o0.w, o1.x, o1.y, o1.z, o1.w};
        unsigned res[8];
#pragma unroll
        for (int e = 0; e < 4; ++e) {
          const float4 g4 = *(const float4*)&ng[col + e * 4];
          res[2 * e]     = pack2(hs[4 * e + 0] * r * g4.x * sigmoid_f(lo2f(oo[2 * e])),     hs[4 * e + 1] * r * g4.y * sigmoid_f(hi2f(oo[2 * e])));
          res[2 * e + 1] = pack2(hs[4 * e + 2] * r * g4.z * sigmoid_f(lo2f(oo[2 * e + 1])), hs[4 * e + 3] * r * g4.w * sigmoid_f(hi2f(oo[2 * e + 1])));
        }
        *(uint4*)&A2[(size_t)tt * 1024 + col] = make_uint4(res[0], res[1], res[2], res[3]);
        *(uint4*)&A2[(size_t)tt * 1024 + col + 8] = make_uint4(res[4], res[5], res[6], res[7]);
      }
    }
    xcd_barrier(xbar);
    const bf16_t* Wo = (const bf16_t*)(ws + W_MLOUT);
    auto epi_out = [=](int grow, int gcol0, const f32x4 (&a)[4]) { resid_epi(1, grow, gcol0, a); };
    dense_phase(shm, vb, G, A2, 1024, Wo, 1024, 4, 16, 2, epi_out);
    xcd_barrier(xbar);
  }
  moe_layer(1, 0);

  {
    norm_phase(P, 0, P.in[6] + 2 * 1024, 2, 0, 1, 0, false, false, 0, smem);
    xcd_barrier(xbar);
    bf16_t* Zg = (bf16_t*)(R + R2_ZG); bf16_t* Zx = (bf16_t*)(R + R2_ZX); bf16_t* xc = (bf16_t*)(R + R2_XC);
    bf16_t* LA = (bf16_t*)(R + R2_LA); bf16_t* U = (bf16_t*)(R + R2_U);
    float* cA = (float*)(R + R2_CA); float* cH = (float*)(R + R2_CH);
    float* cin = (float*)(R + R2_CIN); bf16_t* A3 = (bf16_t*)(R + R2_ZX);
    const float* cw = P.in[28]; const float* cb = P.in[29];
    const float* b_a = P.in[31]; const float* b_x = P.in[33];
    const float* SP = (const float*)(ws + W_SP);
    const bf16_t* Wt = (const bf16_t*)(ws + W_LRUIN);
    auto epi_in = [=](int grow, int gcol0, const f32x4 (&a)[4]) {
      if (gcol0 < 1280) {
        f32x4 bq[4];
#pragma unroll
        for (int n = 0; n < 4; ++n)
#pragma unroll
          for (int j = 0; j < 4; ++j) bq[n][j] = gelu_f(a[n][j]);
        st16bf(Zg + (size_t)grow * 1280 + gcol0, bq);
      } else st16bf(Zx + (size_t)grow * 1280 + gcol0 - 1280, a);
    };
    dense_phase<true>(shm, vb, G, hb, 1024, Wt, 1024, 10, 16, 2, epi_in);
    xcd_barrier(xbar);
    for (int idx = gtid; idx < T_ALL * 160; idx += gstride) {
      const int t = idx / 160, c0 = (idx - t * 160) * 8;
      const int lo = t < T_CTX ? 0 : T_CTX, hi = t < T_CTX ? T_CTX : T_ALL;
      float q[8];
#pragma unroll
      for (int e = 0; e < 8; ++e) q[e] = cb[c0 + e];
#pragma unroll
      for (int j = 0; j < 4; ++j) {
        const int tt = t + j - 2;
        if (tt >= lo && tt < hi) {
          const uint4 z = *(const uint4*)&Zx[(size_t)tt * 1280 + c0];
          const float4 w0 = *(const float4*)&cw[j * 1280 + c0], w1 = *(const float4*)&cw[j * 1280 + c0 + 4];
          q[0] += lo2f(z.x) * w0.x; q[1] += hi2f(z.x) * w0.y; q[2] += lo2f(z.y) * w0.z; q[3] += hi2f(z.y) * w0.w;
          q[4] += lo2f(z.z) * w1.x; q[5] += hi2f(z.z) * w1.y; q[6] += lo2f(z.w) * w1.z; q[7] += hi2f(z.w) * w1.w;
        }
      }
      uint4 o; o.x = pack2(q[0], q[1]); o.y = pack2(q[2], q[3]); o.z = pack2(q[4], q[5]); o.w = pack2(q[6], q[7]);
      *(uint4*)&xc[(size_t)t * 1280 + c0] = o;
    }
    xcd_barrier(xbar);
    {
      const bf16_t* WLG = (const bf16_t*)(ws + W_LRUG);
      {
        gemm_bal<8, true, false>(shm, 2, vb, 65 * 20, G,
          [=](int L, int r) { return (const bf16_t*)(xc + (size_t)((L / 20) * 256 + r) * 1280 + ((L % 20) >> 1) * 128); },
          [=](int L, int cidx) { return WLG + ((size_t)(L % 20) * 256 + cidx) * 128; },
          KOffL(), KOffL(),
          [=](int L, int rb, int col0, const auto& a) {
            constexpr int MIe = (int)(sizeof(a) / sizeof(a[0]));
            const int m0 = (L / 20) * 256, q = L % 20, nb = q >> 1, d = q & 1;
            const int c = nb * 128 + (col0 >> 1);
            float ba[8], bx[8], sp8[8];
            {
              const float4 t0 = *(const float4*)&b_a[d * 1280 + c], t1 = *(const float4*)&b_a[d * 1280 + c + 4];
              const float4 t2 = *(const float4*)&b_x[d * 1280 + c], t3 = *(const float4*)&b_x[d * 1280 + c + 4];
              const float4 t4 = *(const float4*)&SP[d * 1280 + c], t5 = *(const float4*)&SP[d * 1280 + c + 4];
              ba[0] = t0.x; ba[1] = t0.y; ba[2] = t0.z; ba[3] = t0.w; ba[4] = t1.x; ba[5] = t1.y; ba[6] = t1.z; ba[7] = t1.w;
              bx[0] = t2.x; bx[1] = t2.y; bx[2] = t2.z; bx[3] = t2.w; bx[4] = t3.x; bx[5] = t3.y; bx[6] = t3.z; bx[7] = t3.w;
              sp8[0] = -8.f * t4.x; sp8[1] = -8.f * t4.y; sp8[2] = -8.f * t4.z; sp8[3] = -8.f * t4.w;
              sp8[4] = -8.f * t5.x; sp8[5] = -8.f * t5.y; sp8[6] = -8.f * t5.z; sp8[7] = -8.f * t5.w;
            }
#pragma unroll
            for (int m = 0; m < MIe; ++m) {
              const int t = m0 + rb + 16 * m;
              const uint4 xv = *(const uint4*)&xc[(size_t)t * 1280 + c];
              const unsigned xx[4] = {xv.x, xv.y, xv.z, xv.w};
              float la8[8], u8[8];
#pragma unroll
              for (int e = 0; e < 8; ++e) {
                const float ra = a[m][e >> 2][e & 3] + ba[e];
                const float rx = a[m][2 + (e >> 2)][e & 3] + bx[e];
                const float la = sigmoid_f(ra) * sp8[e];
                const float x2 = 2.f * la;
                const float em = -x2 * (1.f + x2 * (0.5f + x2 * (0.16666667f + x2 * (0.041666668f + x2 * (0.0083333338f + x2 * 0.0013888889f)))));
                const float xe = (e & 1) ? hi2f(xx[e >> 1]) : lo2f(xx[e >> 1]);
                la8[e] = la;
                u8[e] = __builtin_amdgcn_sqrtf(em) * (sigmoid_f(rx) * xe);
              }
              uint4 o1, o2;
              o1.x = pack2(la8[0], la8[1]); o1.y = pack2(la8[2], la8[3]); o1.z = pack2(la8[4], la8[5]); o1.w = pack2(la8[6], la8[7]);
              o2.x = pack2(u8[0], u8[1]); o2.y = pack2(u8[2], u8[3]); o2.z = pack2(u8[4], u8[5]); o2.w = pack2(u8[6], u8[7]);
              *(uint4*)&LA[((size_t)d * T_ALL + t) * 1280 + c] = o1;
              *(uint4*)&U[((size_t)d * T_ALL + t) * 1280 + c] = o2;
            }
          });
      }
    }
    xcd_barrier(xbar);
    for (int idx = gtid; idx < 2 * NCH * 640; idx += gstride) {
      const int c = (idx % 640) * 2, dn = idx / 640, n = dn % NCH, d = dn / NCH;
      const bf16_t* la_p = LA + (size_t)d * T_ALL * 1280 + c;
      const bf16_t* u_p = U + (size_t)d * T_ALL * 1280 + c;
      float h0 = 0.f, h1 = 0.f, s0 = 0.f, s1 = 0.f;
      for (int sb = 0; sb < 128; sb += 16) {
        unsigned lv[16], uv[16];
#pragma unroll
        for (int e = 0; e < 16; ++e) {
          const size_t o = (size_t)(n * 128 + (d == 0 ? sb + e : 127 - sb - e)) * 1280;
          lv[e] = *(const unsigned*)(la_p + o); uv[e] = *(const unsigned*)(u_p + o);
        }
#pragma unroll
        for (int e = 0; e < 16; ++e) {
          const float l0 = lo2f(lv[e]), l1 = hi2f(lv[e]);
          h0 = __expf(l0) * h0 + lo2f(uv[e]); h1 = __expf(l1) * h1 + hi2f(uv[e]);
          s0 += l0; s1 += l1;
        }
      }
      *(float2*)&cA[(d * NCH + n) * 1280 + c] = make_float2(__expf(s0), __expf(s1));
      *(float2*)&cH[(d * NCH + n) * 1280 + c] = make_float2(h0, h1);
    }
    xcd_barrier(xbar);
    for (int idx = gtid; idx < 2 * 1280; idx += gstride) {
      const int d = idx / 1280, c = idx - d * 1280;
      float st = 0.f;
      for (int ib = 0; ib < NCH; ib += 10) {
        float av[10], hv[10];
#pragma unroll
        for (int u = 0; u < 10; ++u) { const int q = (d * NCH + scan_order(d, ib + u)) * 1280 + c; av[u] = cA[q]; hv[u] = cH[q]; }
#pragma unroll
        for (int u = 0; u < 10; ++u) { const int q = (d * NCH + scan_order(d, ib + u)) * 1280 + c; cin[q] = st; st = av[u] * st + hv[u]; }
      }
    }
    xcd_barrier(xbar);
    const int p2_per = (128 * 640 + G - 1) / G;
    for (int i2 = tid; i2 < p2_per; i2 += NT) {
      const int idx = blockIdx.x * p2_per + i2;
      if (idx >= 128 * 640) break;
      const int c = (idx % 640) * 2, n = 2 + idx / 640;
      float h0, h1;
      { const float2 c2 = *(const float2*)&cin[(0 * NCH + n) * 1280 + c]; h0 = c2.x; h1 = c2.y; }
      for (int sb = 0; sb < 128; sb += 16) {
        unsigned lv[16], uv[16];
#pragma unroll
        for (int e = 0; e < 16; ++e) { const size_t o = (size_t)(n * 128 + sb + e) * 1280 + c; lv[e] = *(const unsigned*)&LA[o]; uv[e] = *(const unsigned*)&U[o]; }
#pragma unroll
        for (int e = 0; e < 16; ++e) {
          h0 = __expf(lo2f(lv[e])) * h0 + lo2f(uv[e]); h1 = __expf(hi2f(lv[e])) * h1 + hi2f(uv[e]);
          *(unsigned*)&A3[(size_t)(n * 128 + sb + e) * 1280 + c] = pack2(h0, h1);
        }
      }
      { const float2 c2 = *(const float2*)&cin[(1 * NCH + n) * 1280 + c]; h0 = c2.x; h1 = c2.y; }
      for (int sb = 0; sb < 128; sb += 16) {
        unsigned lv[16], uv[16], gv[16], hp[16];
#pragma unroll
        for (int e = 0; e < 16; ++e) {
          const size_t o = (size_t)(n * 128 + 127 - sb - e) * 1280 + c;
          lv[e] = *(const unsigned*)&LA[(size_t)T_ALL * 1280 + o]; uv[e] = *(const unsigned*)&U[(size_t)T_ALL * 1280 + o];
          gv[e] = *(const unsigned*)&Zg[o]; hp[e] = *(const unsigned*)&A3[o];
        }
#pragma unroll
        for (int e = 0; e < 16; ++e) {
          h0 = __expf(lo2f(lv[e])) * h0 + lo2f(uv[e]); h1 = __expf(hi2f(lv[e])) * h1 + hi2f(uv[e]);
          *(unsigned*)&A3[(size_t)(n * 128 + 127 - sb - e) * 1280 + c] = pack2(lo2f(gv[e]) * (lo2f(hp[e]) + h0), hi2f(gv[e]) * (hi2f(hp[e]) + h1));
        }
      }
    }
    xcd_barrier(xbar);
    const bf16_t* Wo = (const bf16_t*)(ws + W_LRUOUT);
    auto epi_out = [=](int grow, int gcol0, const f32x4 (&a)[4]) { resid_epi(2, grow, gcol0, a); };
    dense_phase(shm, vb, G, A3, 1280, Wo, 1280, 4, 20, 0, epi_out);
    xcd_barrier(xbar);
  }
  moe_layer(2, T_CTX);

  {
    norm_phase(P, T_CTX, P.in[6] + 3 * 1024, 3, 0, 2, T_CTX, false, false, 0, smem);
    xcd_barrier(xbar);
    bf16_t* YT = (bf16_t*)(R + R3_YT); bf16_t* GT = (bf16_t*)(R + R3_GT); bf16_t* Ff = (bf16_t*)(R + R3_FF);
    const bf16_t* WP = (const bf16_t*)(ws + W_FNP);
    gemm_run<8, true>(shm, 16, vb, 64 * 8, G,
      [=](int L, int r) { return WP + (size_t)((L & 7) * 256 + r) * 1024; },
      [=](int L, int cidx) { return (const bf16_t*)(hb + (size_t)(T_CTX + 128 * (cidx & 127) + 2 * (L >> 3) + (cidx >> 7)) * DM); }, KOffL(), KOffL(),
      per_m([=](int L, int row, int col0, const f32x4 (&a)[4]) {
        const int b = 2 * (L >> 3) + (col0 >> 7), a0 = col0 & 127, nrow = (L & 7) * 256 + row;
        st16bf(YT + ((size_t)b * 2048 + nrow) * 128 + a0, a);
      }));
    xcd_barrier(xbar);
    {
      const bf16_t* DA = (const bf16_t*)(ws + W_DA);
      gemm_run<8, true>(shm, 4, vb, 512, G,
        [=](int L, int r) { return DA + (size_t)r * 256; },
        [=](int L, int cidx) { return (const bf16_t*)(YT + ((size_t)(cidx & 127) * 2048 + 2 * L + (cidx >> 7)) * 128); },
        KOffL(), [=](int L, int kt) { return kt < 2 ? kt * 64 : 1024 * 128 + (kt - 2) * 64; },
        per_m([=](int L, int row, int col0, const f32x4 (&a)[4]) {
          const int ri = row >> 7, c2 = row & 127, colc = 2 * L + (col0 >> 7), b0 = col0 & 127;
          st16bf(GT + (((size_t)c2 * 1024 + colc) * 2 + ri) * 128 + b0, a);
        }));
    }
    xcd_barrier(xbar);
    {
      const bf16_t* TW = (const bf16_t*)(ws + W_TW);
      gemm_loop<4, true>(shm, 4, vb, 128 * 4, G,
        [=](int L, int r) { return TW + ((size_t)(L >> 2) * 128 + r) * 256; },
        [=](int L, int cidx) { return (const bf16_t*)(GT + ((size_t)(L >> 2) * 1024 + (L & 3) * 256 + cidx) * 256); }, KOffL(), KOffL(),
        per_m([=](int L, int row, int col0, const f32x4 (&a)[4]) {
          const int c2 = L >> 2, n0 = (L & 3) * 256;
          f32x4 b[4];
#pragma unroll
          for (int n = 0; n < 4; ++n) b[n] = a[n] * (1.f / 2048.f);
          st16bf(Ff + (size_t)(c2 + 128 * row) * 1024 + n0 + col0, b);
        }));
    }
    xcd_barrier(xbar);
    const bf16_t* Wo = (const bf16_t*)(ws + W_FNOUT);
    const bf16_t* FfA = Ff - (size_t)T_CTX * 1024;
    auto epi_out = [=](int grow, int gcol0, const f32x4 (&a)[4]) { resid_epi(3, grow, gcol0, a); };
    dense_phase(shm, vb, G, FfA, 1024, Wo, 1024, 4, 16, 0, epi_out);
    xcd_barrier(xbar);
  }
  moe_layer(3, T_CTX);

  norm_phase(P, T_CTX, P.in[8], 0, -1, 3, T_CTX, true, false, 0, smem);
}

#undef tid
#undef gtid
#undef gstride
extern "C" void kernel_launch(void* const* d_in, const int* in_sizes, int n_in, void* d_out, int out_size,
                              void* d_ws, size_t ws_size, hipStream_t stream) {
  static int grid_blocks = 0;
  if (!grid_blocks) {
    int dev = 0, cus = 0, per_cu = 0;
    (void)hipGetDevice(&dev);
    (void)hipDeviceGetAttribute(&cus, hipDeviceAttributeMultiprocessorCount, dev);
    (void)hipOccupancyMaxActiveBlocksPerMultiprocessor(&per_cu, mega, NT, 0);
    if (per_cu < 1) fprintf(stderr, "kernel_launch: occupancy query says %d blocks/CU\n", per_cu);
    grid_blocks = cus;
    if (ws_size < WS_NEED) fprintf(stderr, "kernel_launch: workspace too small: %zu < %zu\n", ws_size, (size_t)WS_NEED);
  }
  if (n_in != 38 || ws_size < WS_NEED) return;
  Params p{};
  for (int i = 0; i < 38; ++i) p.in[i] = (const float*)d_in[i];
  p.out = (float*)d_out;
  p.ws = (unsigned char*)d_ws;
  (void)hipMemsetAsync((char*)d_ws + WS_BAR, 0, 16384, stream);
  void* args[] = {&p};
  hipError_t e = hipLaunchCooperativeKernel((void*)mega, dim3(grid_blocks), dim3(NT), args, 0, stream);
  if (e != hipSuccess) fprintf(stderr, "cooperative launch failed: %s (grid %d)\n", hipGetErrorString(e), grid_blocks);
}
```

```cpp
#include <hip/hip_runtime.h>
#include <hip/hip_cooperative_groups.h>
#include <cstdio>
namespace cg = cooperative_groups;

#define T_ALL 16640
#define T_LAT 16384
#define T_CTX 256
#define DM 1024
#define NCH 130
#define EPSN 1e-6f
#define NT 512

typedef unsigned short bf16_t;
using bf16x8 = __attribute__((ext_vector_type(8))) short;
using f32x4 = __attribute__((ext_vector_type(4))) float;

__device__ __forceinline__ float bf2f(bf16_t v) { return __uint_as_float(((unsigned)v) << 16); }
__device__ __forceinline__ bf16_t f2bf(float f) { const __bf16 h = (__bf16)f; return __builtin_bit_cast(unsigned short, h); }
__device__ __forceinline__ unsigned pack2(float a, float b) {
  typedef __attribute__((ext_vector_type(2))) float f32x2_t;
  typedef __attribute__((ext_vector_type(2))) __bf16 bf16x2_t;
  const f32x2_t f = {a, b};
  const bf16x2_t h = __builtin_convertvector(f, bf16x2_t);
  return __builtin_bit_cast(unsigned, h);
}
__device__ __forceinline__ float lo2f(unsigned u) { return __uint_as_float(u << 16); }
__device__ __forceinline__ float hi2f(unsigned u) { return __uint_as_float(u & 0xffff0000u); }

__device__ __forceinline__ int opaque_tid() { int t = threadIdx.x; asm volatile("" : "+v"(t)); return t; }

__device__ __forceinline__ float4 ntload4(const float* p) {
  typedef __attribute__((ext_vector_type(4))) float f4v;
  const f4v v = __builtin_nontemporal_load((const f4v*)p);
  return make_float4(v[0], v[1], v[2], v[3]);
}

constexpr size_t AL(size_t x) { return (x + 255) & ~(size_t)255; }
constexpr size_t WS_MOD    = 0;
constexpr size_t WS_MODP   = AL(WS_MOD + 4 * 2 * 6144 * 4);
constexpr size_t WS_CNT    = AL(WS_MODP + 16 * 4 * 2 * 6144 * 4);
constexpr size_t WS_ZROW   = AL(WS_CNT + 4 * 32 * 32 * 4 + 256);
constexpr size_t WS_BAR    = AL(WS_ZROW + 8192);
constexpr size_t WS_TOK    = AL(WS_BAR + 16384);
constexpr size_t WS_H      = AL(WS_TOK + (size_t)T_ALL * DM * 4);
constexpr size_t WS_HLO    = AL(WS_H + (size_t)T_ALL * DM * 2);
constexpr size_t WS_ASGW   = AL(WS_HLO + (size_t)T_ALL * DM * 2);
constexpr size_t WS_LIST   = AL(WS_ASGW + 33280 * 4);
constexpr size_t WS_ROWTOK = AL(WS_LIST + (size_t)32 * 33280 * 4);
constexpr size_t WS_ROWEXP = AL(WS_ROWTOK + 37376 * 4);
constexpr size_t W_CMIN   = AL(WS_ROWEXP + 292 * 4);
constexpr size_t W_CMOUT  = AL(W_CMIN + (size_t)2048 * 1024 * 2);
constexpr size_t W_MLIN   = AL(W_CMOUT + (size_t)1024 * 1024 * 2);
constexpr size_t W_MLOUT  = AL(W_MLIN + (size_t)3072 * 1024 * 2);
constexpr size_t W_LRUIN  = AL(W_MLOUT + (size_t)1024 * 1024 * 2);
constexpr size_t W_LRUOUT = AL(W_LRUIN + (size_t)2560 * 1024 * 2);
constexpr size_t W_FNIN   = AL(W_LRUOUT + (size_t)1024 * 1280 * 2);
constexpr size_t W_FNP    = AL(W_FNIN + (size_t)1024 * 1024 * 2);
constexpr size_t W_FNOUT  = AL(W_FNP + (size_t)2048 * 1024 * 2);
constexpr size_t W_DC     = AL(W_FNOUT + (size_t)1024 * 1024 * 2);
constexpr size_t W_DA     = AL(W_DC + 512 * 256 * 2);
constexpr size_t W_TW     = AL(W_DA + 256 * 256 * 2);
constexpr size_t W_LRUG   = AL(W_TW + (size_t)128 * 128 * 256 * 2);
constexpr size_t W_SP     = AL(W_LRUG + (size_t)20 * 256 * 128 * 2);
constexpr size_t W_PE     = AL(W_SP + 2 * 1280 * 4);
constexpr size_t W_EGU    = AL(W_PE + (size_t)(2 * 256 + 2 * 64) * 256 * 4);
constexpr size_t W_ED     = AL(W_EGU + (size_t)128 * 1024 * 1024 * 2);
constexpr size_t WS_R     = AL(W_ED + (size_t)128 * 1024 * 512 * 2);
constexpr size_t R_YBUF = 0;
constexpr size_t R_HB   = AL(R_YBUF + (size_t)33280 * 1024 * 2);
constexpr size_t R_MOE_END = AL(R_HB + (size_t)37376 * 512 * 2);
constexpr size_t R0_ZU  = 0;
constexpr size_t R0_ZVT = AL(R0_ZU + (size_t)T_ALL * 1024 * 2);
constexpr size_t R0_P   = AL(R0_ZVT + (size_t)T_ALL * 1024 * 2);
constexpr size_t R0_WSC = AL(R0_P + (size_t)T_ALL * 1024 * 2);
constexpr size_t R0_END = AL(R0_WSC + (size_t)NCH * 4 * 128 * 128 * 2);
constexpr size_t R1_ZQK  = 0;
constexpr size_t R1_ZO   = AL(R1_ZQK + (size_t)T_ALL * 1024 * 2);
constexpr size_t R1_VT   = AL(R1_ZO + (size_t)T_ALL * 1024 * 2);
constexpr size_t R1_GPRE = AL(R1_VT + (size_t)T_ALL * 1024 * 2);
constexpr size_t R1_QN   = AL(R1_GPRE + (size_t)T_ALL * 16 * 4);
constexpr size_t R1_KN   = AL(R1_QN + (size_t)T_ALL * 512 * 2);
constexpr size_t R1_AS   = AL(R1_KN + (size_t)T_ALL * 512 * 2);
constexpr size_t R1_KWT  = AL(R1_AS + (size_t)8 * T_ALL * 256 * 2);
constexpr size_t R1_BC   = AL(R1_KWT + (size_t)8 * T_ALL * 128 * 2);
constexpr size_t R1_LI   = AL(R1_BC + (size_t)8 * T_ALL * 4);
constexpr size_t R1_GCH  = AL(R1_LI + (size_t)8 * T_ALL * 4);
constexpr size_t R1_NLOC = AL(R1_GCH + 8 * NCH * 4);
constexpr size_t R1_NIN  = AL(R1_NLOC + 8 * NCH * 128 * 4);
constexpr size_t R1_CLOC = AL(R1_NIN + 8 * NCH * 128 * 4);
constexpr size_t R1_CINT = AL(R1_CLOC + (size_t)8 * T_ALL * 256 * 4);
constexpr size_t R1_HDEN = AL(R1_CINT + (size_t)8 * T_ALL * 256 * 2);
constexpr size_t R1_A2   = R1_ZQK;
constexpr size_t R1_END  = AL(R1_HDEN + 256);
constexpr size_t R2_ZG  = 0;
constexpr size_t R2_ZX  = AL(R2_ZG + (size_t)T_ALL * 1280 * 2);
constexpr size_t R2_XC  = AL(R2_ZX + (size_t)T_ALL * 1280 * 2);
constexpr size_t R2_LA  = AL(R2_XC + (size_t)T_ALL * 1280 * 2);
constexpr size_t R2_U   = AL(R2_LA + (size_t)2 * T_ALL * 1280 * 2);
constexpr size_t R2_CA  = AL(R2_U + (size_t)2 * T_ALL * 1280 * 2);
constexpr size_t R2_CH  = AL(R2_CA + 2 * NCH * 1280 * 4);
constexpr size_t R2_CIN = AL(R2_CH + 2 * NCH * 1280 * 4);
constexpr size_t R2_END = AL(R2_CIN + 2 * NCH * 1280 * 4);
constexpr size_t R3_YT = 0;
constexpr size_t R3_GT = AL(R3_YT + (size_t)128 * 2048 * 128 * 2);
constexpr size_t R3_FF = AL(R3_GT + (size_t)128 * 2048 * 128 * 2);
constexpr size_t R3_END = AL(R3_FF + (size_t)T_LAT * 1024 * 2);
constexpr size_t cmax(size_t a, size_t b) { return a > b ? a : b; }
constexpr size_t R_SIZE = cmax(cmax(R_MOE_END, R0_END), cmax(cmax(R1_END, R2_END), R3_END));
constexpr size_t WS_NEED = WS_R + R_SIZE;

struct Params { const float* in[38]; float* out; unsigned char* ws; };

__device__ __forceinline__ float sigmoid_f(float x) { return __builtin_amdgcn_rcpf(1.f + __expf(-x)); }
__device__ __forceinline__ float silu_f(float x) { return x * __builtin_amdgcn_rcpf(1.f + __expf(-x)); }
__device__ __forceinline__ float gelu_f(float x) {
  const float u2 = 1.5957691216057308f * (x + 0.044715f * x * x * x);
  return x * __builtin_amdgcn_rcpf(1.f + __expf(-u2));
}
__device__ __forceinline__ float logsig_f(float x) { return fminf(x, 0.f) - log1pf(expf(-fabsf(x))); }
__device__ __forceinline__ float dpp_add(float v, const int ctrl_sel) {
  int x = __float_as_int(v), y;
  if (ctrl_sel == 0) y = __builtin_amdgcn_mov_dpp(x, 0xB1, 0xf, 0xf, false);
  else if (ctrl_sel == 1) y = __builtin_amdgcn_mov_dpp(x, 0x4E, 0xf, 0xf, false);
  else if (ctrl_sel == 2) y = __builtin_amdgcn_mov_dpp(x, 0x141, 0xf, 0xf, false);
  else y = __builtin_amdgcn_mov_dpp(x, 0x140, 0xf, 0xf, false);
  return v + __int_as_float(y);
}
__device__ __forceinline__ float wave_sum(float v) {
  v = dpp_add(v, 0); v = dpp_add(v, 1); v = dpp_add(v, 2); v = dpp_add(v, 3);
  {
    const unsigned x = __float_as_uint(v);
    const auto r = __builtin_amdgcn_permlane16_swap(x, x, false, false);
    v = __uint_as_float(r[0]) + __uint_as_float(r[1]);
  }
  {
    const unsigned x = __float_as_uint(v);
    const auto r = __builtin_amdgcn_permlane32_swap(x, x, false, false);
    v = __uint_as_float(r[0]) + __uint_as_float(r[1]);
  }
  return v;
}
__device__ __forceinline__ float reduce36(const float (&l)[36], int lane) {
  float res = 0.f;
  const int l31 = lane & 31;
#pragma unroll
  for (int q = 0; q < 18; ++q) {
    const auto r = __builtin_amdgcn_permlane32_swap(__float_as_uint(l[2 * q]), __float_as_uint(l[2 * q + 1]), false, false);
    float v = __uint_as_float(r[0]) + __uint_as_float(r[1]);
    v = dpp_add(v, 0); v = dpp_add(v, 1); v = dpp_add(v, 2); v = dpp_add(v, 3);
    const unsigned x = __float_as_uint(v);
    const auto s = __builtin_amdgcn_permlane16_swap(x, x, false, false);
    v = __uint_as_float(s[0]) + __uint_as_float(s[1]);
    if (l31 == q) res = v;
  }
  return res;
}
__device__ __forceinline__ float fold_pair_sum(float x, float y) {
  const auto r = __builtin_amdgcn_permlane32_swap(__float_as_uint(x), __float_as_uint(y), false, false);
  float v = __uint_as_float(r[0]) + __uint_as_float(r[1]);
  v = dpp_add(v, 0); v = dpp_add(v, 1); v = dpp_add(v, 2); v = dpp_add(v, 3);
  const unsigned u = __float_as_uint(v);
  const auto s = __builtin_amdgcn_permlane16_swap(u, u, false, false);
  return __uint_as_float(s[0]) + __uint_as_float(s[1]);
}
__device__ __forceinline__ int scan_order(int d, int i) { return d == 0 ? i : (i == 0 ? 1 : (i == 1 ? 0 : 131 - i)); }
__device__ __forceinline__ void st16bf(bf16_t* p, const f32x4 (&a)[4]) {
  uint4 o0, o1;
  o0.x = pack2(a[0][0], a[0][1]); o0.y = pack2(a[0][2], a[0][3]); o0.z = pack2(a[1][0], a[1][1]); o0.w = pack2(a[1][2], a[1][3]);
  o1.x = pack2(a[2][0], a[2][1]); o1.y = pack2(a[2][2], a[2][3]); o1.z = pack2(a[3][0], a[3][1]); o1.w = pack2(a[3][2], a[3][3]);
  *(uint4*)p = o0; *(uint4*)(p + 8) = o1;
}

__device__ __forceinline__ int lds_byte(int r, int c) {
  const int st = (r >> 4) * 2 + (c >> 5), ob = (r & 15) * 64 + (c & 31) * 2;
  return st * 1024 + (ob ^ (((ob >> 9) & 1) << 5));
}
__device__ __forceinline__ void stage_rc(int b, int& R, int& C) {
  const int st = b >> 10, sb = b & 1023, swz = sb ^ (((sb >> 9) & 1) << 5);
  R = (st >> 1) * 16 + (swz >> 6);
  C = (st & 1) * 32 + ((swz & 63) >> 1);
}
__device__ __forceinline__ int perm_col(int p) {
  const int q = p & 63, n = q >> 4, i = q & 15;
  return (p & ~63) + (i >> 2) * 16 + n * 4 + (i & 3);
}

struct KOffL { __device__ __forceinline__ int operator()(int, int kt) const { return kt * 64; } };
#define GEMM_LDS_TOTAL 147456
template <int MI, bool SWAP, class RA, class RB, class KA, class KB, class EP>
__device__ __forceinline__ void gemm_loop(char* shm, int nk, int Lbeg, int Lend, int Lstep, RA rowA, RB rowB, KA koffA, KB koffB, EP epi) {
  constexpr int BM = 32 * MI, GLA = MI / 2, GLB = 4;
  constexpr int TILE_A = BM * 128, TILE_B = 256 * 128, STG = TILE_A + TILE_B;
  constexpr int NBUF = (3 * STG <= GEMM_LDS_TOTAL) ? 3 : 2;
  static_assert(NBUF * STG <= GEMM_LDS_TOTAL, "LDS");
  if (Lbeg >= Lend) return;
  const int tid = opaque_tid(), wid = tid >> 6, lane = tid & 63, wr = wid >> 2, wc = wid & 3, fr = lane & 15, fq = lane >> 4;
  const char* wsb;
  { const unsigned long long v_ = *(const unsigned long long*)(shm + GEMM_LDS_TOTAL + 2832);
    wsb = (const char*)(((unsigned long long)(unsigned)__builtin_amdgcn_readfirstlane((int)(v_ >> 32)) << 32) | (unsigned long long)(unsigned)__builtin_amdgcn_readfirstlane((int)(unsigned)v_)); }
  const __amdgpu_buffer_rsrc_t rsrc = __builtin_amdgcn_make_buffer_rsrc((void*)wsb, (short)0, 0x7fffffff, 0x00020000);
  unsigned pa[GLA];
  unsigned pb[GLB];
#define GL_SETP2(PA_, PB_, L_) do { int t2_ = tid; asm volatile("" : "+v"(t2_)); const int w2_ = t2_ >> 6, l2_ = t2_ & 63;        \
    _Pragma("unroll") for (int i = 0; i < GLA; ++i) { int R_, C_; stage_rc(w2_ * 1024 + i * 8192 + l2_ * 16, R_, C_); PA_[i] = (unsigned)((const char*)(rowA((L_), R_) + C_) - wsb); } \
    _Pragma("unroll") for (int i = 0; i < GLB; ++i) { int R_, C_; stage_rc(w2_ * 1024 + i * 8192 + l2_ * 16, R_, C_); PB_[i] = (unsigned)((const char*)(rowB((L_), SWAP ? perm_col(R_) : R_) + C_) - wsb); } } while (0)
#define GL_SETP(L_) GL_SETP2(pa, pb, L_)
  constexpr bool EARLY = (MI <= 4);
  unsigned npa[GLA];
  unsigned npb[GLB];
#define GL_ISSUE(buf, kt, L_) do { const int ka_ = koffA((L_), (kt)), kb_ = koffB((L_), (kt)); char* base_ = shm + (buf) * STG;  \
    _Pragma("unroll") for (int i = 0; i < GLA; ++i)                                                                    \
      __builtin_amdgcn_raw_ptr_buffer_load_lds(rsrc, (__attribute__((address_space(3))) void*)(base_ + wid * 1024 + i * 8192), 16, pa[i] + 2u * (unsigned)ka_, 0, 0, 0); \
    _Pragma("unroll") for (int i = 0; i < GLB; ++i)                                                                    \
      __builtin_amdgcn_raw_ptr_buffer_load_lds(rsrc, (__attribute__((address_space(3))) void*)(base_ + TILE_A + wid * 1024 + i * 8192), 16, pb[i] + 2u * (unsigned)kb_, 0, 0, 0); } while (0)
#define GL_PIECE(pi, buf, ka_, kb_) do { char* base_ = shm + (buf) * STG;                                              \
    if ((pi) < GLA) __builtin_amdgcn_raw_ptr_buffer_load_lds(rsrc, (__attribute__((address_space(3))) void*)(base_ + wid * 1024 + (pi) * 8192), 16, pa[(pi) < GLA ? (pi) : 0] + 2u * (unsigned)(ka_), 0, 0, 0); \
    else __builtin_amdgcn_raw_ptr_buffer_load_lds(rsrc, (__attribute__((address_space(3))) void*)(base_ + TILE_A + wid * 1024 + ((pi) - GLA) * 8192), 16, pb[(pi) >= GLA ? (pi) - GLA : 0] + 2u * (unsigned)(kb_), 0, 0, 0); } while (0)
#define GL_RAWBAR() do { asm volatile("s_waitcnt lgkmcnt(0)" ::: "memory"); __builtin_amdgcn_s_barrier(); } while (0)
  const int npre = nk < NBUF ? nk : NBUF;
  GL_SETP(Lbeg);
  for (int s = 0; s < npre; ++s) GL_ISSUE(s, s, Lbeg);
  for (int L = Lbeg; L < Lend; L += Lstep) {
    f32x4 acc[MI][4];
#pragma unroll
    for (int m = 0; m < MI; ++m)
#pragma unroll
      for (int n = 0; n < 4; ++n) acc[m][n] = f32x4{0.f, 0.f, 0.f, 0.f};
    int cur = 0;
    for (int t = 0; t < nk; ++t) {
      if (NBUF == 3 && t >= 1 && t + 1 < nk) {
        if (GLA + GLB == 6) asm volatile("s_waitcnt vmcnt(6)" ::: "memory"); else asm volatile("s_waitcnt vmcnt(5)" ::: "memory");
      } else asm volatile("s_waitcnt vmcnt(0)" ::: "memory");
      GL_RAWBAR();
      if (EARLY && t == 0 && L + Lstep < Lend) GL_SETP2(npa, npb, L + Lstep);
      const bool doiss = (t >= 1 && t + NBUF - 1 < nk);
      const int nb_ = (cur == 0) ? NBUF - 1 : cur - 1;
      const int ka2 = doiss ? koffA(L, t + NBUF - 1) : 0, kb2 = doiss ? koffB(L, t + NBUF - 1) : 0;
      const char* sa = shm + cur * STG;
      const char* sb = sa + TILE_A;
      const int offA = lds_byte(wr * (MI * 16) + fr, fq * 8), offB = lds_byte(wc * 64 + fr, fq * 8);
#pragma unroll
      for (int ks = 0; ks < 2; ++ks) {
        bf16x8 Bf[4];
#pragma unroll
        for (int n = 0; n < 4; ++n) Bf[n] = *(const bf16x8*)(sb + offB + n * 2048 + ks * 1024);
        constexpr int MG = MI < 4 ? MI : 4;
        constexpr int NPRE = 2;
#pragma unroll
        for (int mh = 0; mh < MI; mh += MG) {
          bf16x8 At[MG];
#pragma unroll
          for (int m = 0; m < MG; ++m) At[m] = *(const bf16x8*)(sa + offA + (mh + m) * 2048 + ks * 1024);
          if (ks == 0 && mh == 0 && doiss) {
            __builtin_amdgcn_sched_barrier(0);
#pragma unroll
            for (int pi = 0; pi < NPRE; ++pi) GL_PIECE(pi, nb_, ka2, kb2);
            __builtin_amdgcn_sched_barrier(0);
          }
          __builtin_amdgcn_s_setprio(1);
#pragma unroll
          for (int m = 0; m < MG; ++m)
#pragma unroll
            for (int n = 0; n < 4; ++n) {
              if (SWAP) acc[mh + m][n] = __builtin_amdgcn_mfma_f32_16x16x32_bf16(Bf[n], At[m], acc[mh + m][n], 0, 0, 0);
              else      acc[mh + m][n] = __builtin_amdgcn_mfma_f32_16x16x32_bf16(At[m], Bf[n], acc[mh + m][n], 0, 0, 0);
            }
          __builtin_amdgcn_s_setprio(0);
          __builtin_amdgcn_sched_barrier(0);
          if (doiss) {
            constexpr int NG = 2 * (MI / MG), NP = GLA + GLB, NR = NP - NPRE;
            const int g = ks * (MI / MG) + mh / MG;
#pragma unroll
            for (int pi = 0; pi < NP; ++pi)
              if (pi >= NPRE + NR - NR * (NG - g) * (NG - g) / (NG * NG) && pi < NPRE + NR - NR * (NG - g - 1) * (NG - g - 1) / (NG * NG)) GL_PIECE(pi, nb_, ka2, kb2);
          }
          __builtin_amdgcn_sched_barrier(0);
        }
      }
      cur = (cur == NBUF - 1) ? 0 : cur + 1;
    }
    GL_RAWBAR();
    const int Ln = L + Lstep;
    if (Ln < Lend) {
      if (EARLY) {
#pragma unroll
        for (int i = 0; i < GLA; ++i) pa[i] = npa[i];
#pragma unroll
        for (int i = 0; i < GLB; ++i) pb[i] = npb[i];
      } else GL_SETP(Ln);
      for (int s = 0; s < npre; ++s) GL_ISSUE(s, s, Ln);
    }
    {
      const int t3 = opaque_tid(), w3 = t3 >> 6, l3 = t3 & 63, wr3 = w3 >> 2, wc3 = w3 & 3, fr3 = l3 & 15, fq3 = l3 >> 4;
      if constexpr (SWAP) {
        epi(L, wr3 * (MI * 16) + fr3, wc3 * 64 + fq3 * 16, acc);
      } else {
#pragma unroll
        for (int m = 0; m < MI; ++m)
#pragma unroll
          for (int n = 0; n < 4; ++n) epi(L, wr3 * (MI * 16) + m * 16 + fq3 * 4, wc3 * 64 + n * 16 + fr3, acc[m][n]);
      }
    }
  }
  asm volatile("s_waitcnt vmcnt(0)" ::: "memory");
#undef GL_SETP
#undef GL_SETP2
#undef GL_ISSUE
#undef GL_PIECE
#undef GL_RAWBAR
}


__device__ __forceinline__ int lds_byte32(int r, int c) {
  const int ob = (r & 15) * 64 + (c & 31) * 2;
  return (r >> 4) * 1024 + (ob ^ (((ob >> 9) & 1) << 5));
}
__device__ __forceinline__ void stage_rc32(int b, int& R, int& C) {
  const int st = b >> 10, sb = b & 1023, swz = sb ^ (((sb >> 9) & 1) << 5);
  R = st * 16 + (swz >> 6);
  C = (swz & 63) >> 1;
}
template <bool SWAP, class RA, class RB, class KA, class KB, class EP>
__device__ __forceinline__ void gemm_loop32(char* shm, int nk, int Lbeg, int Lend, int Lstep, RA rowA, RB rowB, KA koffA, KB koffB, EP epi) {
  constexpr int MI = 8, GLA = 2, GLB = 2;
  constexpr int TILE_A = 256 * 64, TILE_B = 256 * 64, STG = TILE_A + TILE_B, NBUF = 4;
  static_assert(NBUF * STG <= GEMM_LDS_TOTAL, "LDS");
  if (Lbeg >= Lend) return;
  const int tid = opaque_tid(), wid = tid >> 6, lane = tid & 63, wr = wid >> 2, wc = wid & 3, fr = lane & 15, fq = lane >> 4;
  const bf16_t* pa[GLA];
  const bf16_t* pb[GLB];
#define G32_SETP(L_) do { int t2_ = tid; asm volatile("" : "+v"(t2_)); const int w2_ = t2_ >> 6, l2_ = t2_ & 63;        \
    _Pragma("unroll") for (int i = 0; i < GLA; ++i) { int R_, C_; stage_rc32(w2_ * 1024 + i * 8192 + l2_ * 16, R_, C_); pa[i] = rowA((L_), R_) + C_; } \
    _Pragma("unroll") for (int i = 0; i < GLB; ++i) { int R_, C_; stage_rc32(w2_ * 1024 + i * 8192 + l2_ * 16, R_, C_); pb[i] = rowB((L_), SWAP ? perm_col(R_) : R_) + C_; } } while (0)
#define G32_ISSUE(buf, s_, L_) do { const int ka_ = koffA((L_), (s_) >> 1) + ((s_) & 1) * 32, kb_ = koffB((L_), (s_) >> 1) + ((s_) & 1) * 32; \
    char* base_ = shm + (buf) * STG;                                                                                   \
    _Pragma("unroll") for (int i = 0; i < GLA; ++i)                                                                    \
      __builtin_amdgcn_global_load_lds((const unsigned*)(pa[i] + ka_), (unsigned*)(base_ + wid * 1024 + i * 8192), 16, 0, 0); \
    _Pragma("unroll") for (int i = 0; i < GLB; ++i)                                                                    \
      __builtin_amdgcn_global_load_lds((const unsigned*)(pb[i] + kb_), (unsigned*)(base_ + TILE_A + wid * 1024 + i * 8192), 16, 0, 0); } while (0)
#define G32_RAWBAR() do { asm volatile("s_waitcnt lgkmcnt(0)" ::: "memory"); __builtin_amdgcn_s_barrier(); } while (0)
  const int ns = 2 * nk;
  const int npre = ns < NBUF ? ns : NBUF;
  G32_SETP(Lbeg);
  for (int s = 0; s < npre; ++s) G32_ISSUE(s, s, Lbeg);
  for (int L = Lbeg; L < Lend; L += Lstep) {
    f32x4 acc[MI][4];
#pragma unroll
    for (int m = 0; m < MI; ++m)
#pragma unroll
      for (int n = 0; n < 4; ++n) acc[m][n] = f32x4{0.f, 0.f, 0.f, 0.f};
    int cur = 0;
    for (int t = 0; t < ns; ++t) {
      if (t == 0) asm volatile("s_waitcnt vmcnt(0)" ::: "memory");
      else if (t + 2 < ns) asm volatile("s_waitcnt vmcnt(8)" ::: "memory");
      else if (t + 1 < ns) asm volatile("s_waitcnt vmcnt(4)" ::: "memory");
      else asm volatile("s_waitcnt vmcnt(0)" ::: "memory");
      G32_RAWBAR();
      if (t >= 1 && t + 3 < ns) { const int nb_ = (cur + 3) & 3; G32_ISSUE(nb_, t + 3, L); }
      const char* sa = shm + cur * STG;
      const char* sb = sa + TILE_A;
      const int offA = lds_byte32(wr * 128 + fr, fq * 8), offB = lds_byte32(wc * 64 + fr, fq * 8);
      bf16x8 Bf[4];
#pragma unroll
      for (int n = 0; n < 4; ++n) Bf[n] = *(const bf16x8*)(sb + offB + n * 1024);
#pragma unroll
      for (int mh = 0; mh < MI; mh += 4) {
        bf16x8 At[4];
#pragma unroll
        for (int m = 0; m < 4; ++m) At[m] = *(const bf16x8*)(sa + offA + (mh + m) * 1024);
#pragma unroll
        for (int m = 0; m < 4; ++m)
#pragma unroll
          for (int n = 0; n < 4; ++n) {
            if (SWAP) acc[mh + m][n] = __builtin_amdgcn_mfma_f32_16x16x32_bf16(Bf[n], At[m], acc[mh + m][n], 0, 0, 0);
            else      acc[mh + m][n] = __builtin_amdgcn_mfma_f32_16x16x32_bf16(At[m], Bf[n], acc[mh + m][n], 0, 0, 0);
          }
        __builtin_amdgcn_sched_barrier(0);
      }
      cur = (cur + 1) & 3;
    }
    G32_RAWBAR();
    const int Ln = L + Lstep;
    if (Ln < Lend) { G32_SETP(Ln); for (int s = 0; s < npre; ++s) G32_ISSUE(s, s, Ln); }
    {
      const int t3 = opaque_tid(), w3 = t3 >> 6, l3 = t3 & 63, wr3 = w3 >> 2, wc3 = w3 & 3, fr3 = l3 & 15, fq3 = l3 >> 4;
      if constexpr (SWAP) {
        epi(L, wr3 * 128 + fr3, wc3 * 64 + fq3 * 16, acc);
      } else {
#pragma unroll
        for (int m = 0; m < MI; ++m)
#pragma unroll
          for (int n = 0; n < 4; ++n) epi(L, wr3 * 128 + m * 16 + fq3 * 4, wc3 * 64 + n * 16 + fr3, acc[m][n]);
      }
    }
  }
  asm volatile("s_waitcnt vmcnt(0)" ::: "memory");
#undef G32_SETP
#undef G32_ISSUE
#undef G32_RAWBAR
}
template <int MI, bool SWAP, class RA, class RB, class KA, class KB, class EP>
__device__ __forceinline__ void gemm_run(char* shm, int nk, int Lbeg, int Lend, int Lstep, RA rowA, RB rowB, KA koffA, KB koffB, EP epi) {
#ifdef USE_BK32
  if constexpr (MI == 8) gemm_loop32<SWAP>(shm, nk, Lbeg, Lend, Lstep, rowA, rowB, koffA, koffB, epi);
  else gemm_loop<MI, SWAP>(shm, nk, Lbeg, Lend, Lstep, rowA, rowB, koffA, koffB, epi);
#else
  gemm_loop<MI, SWAP>(shm, nk, Lbeg, Lend, Lstep, rowA, rowB, koffA, koffB, epi);
#endif
}


template <class RA, class RB, class EP>
__device__ __forceinline__ void skinny_items(char* shm, int ibeg, int iend, int istep, RA rowA, RB rowB, EP epi) {
  for (int item = ibeg; item < iend; item += istep) {
    const int t = opaque_tid(), w = t >> 6, lane = t & 63, fr = lane & 15, fq = lane >> 4;
    f32x4 acc[4][4];
#pragma unroll
    for (int m = 0; m < 4; ++m)
#pragma unroll
      for (int n = 0; n < 4; ++n) acc[m][n] = f32x4{0.f, 0.f, 0.f, 0.f};
    const bf16_t* pa[4];
    const bf16_t* pb[4];
#pragma unroll
    for (int m = 0; m < 4; ++m) pa[m] = rowA(item, m * 16 + fr) + w * 128 + fq * 8;
#pragma unroll
    for (int n = 0; n < 4; ++n) pb[n] = rowB(item, perm_col(n * 16 + fr)) + w * 128 + fq * 8;
#pragma unroll
    for (int hf = 0; hf < 2; ++hf) {
      bf16x8 At[4][2], Bf[4][2];
#pragma unroll
      for (int m = 0; m < 4; ++m)
#pragma unroll
        for (int k2 = 0; k2 < 2; ++k2) At[m][k2] = *(const bf16x8*)(pa[m] + (hf * 2 + k2) * 32);
#pragma unroll
      for (int n = 0; n < 4; ++n)
#pragma unroll
        for (int k2 = 0; k2 < 2; ++k2) Bf[n][k2] = *(const bf16x8*)(pb[n] + (hf * 2 + k2) * 32);
#pragma unroll
      for (int k2 = 0; k2 < 2; ++k2)
#pragma unroll
        for (int m = 0; m < 4; ++m)
#pragma unroll
          for (int n = 0; n < 4; ++n) acc[m][n] = __builtin_amdgcn_mfma_f32_16x16x32_bf16(Bf[n][k2], At[m][k2], acc[m][n], 0, 0, 0);
    }
    float4* red = (float4*)shm;
#pragma unroll
    for (int m = 0; m < 4; ++m)
#pragma unroll
      for (int n = 0; n < 4; ++n) red[(w * 16 + m * 4 + n) * 64 + lane] = make_float4(acc[m][n][0], acc[m][n][1], acc[m][n][2], acc[m][n][3]);
    __syncthreads();
    if (t < 256) {
      const int m = t >> 6;
      f32x4 s[4];
#pragma unroll
      for (int n = 0; n < 4; ++n) {
        float4 a = red[(0 * 16 + m * 4 + n) * 64 + lane];
#pragma unroll
        for (int w2 = 1; w2 < 8; ++w2) { const float4 b = red[(w2 * 16 + m * 4 + n) * 64 + lane]; a.x += b.x; a.y += b.y; a.z += b.z; a.w += b.w; }
        s[n] = f32x4{a.x, a.y, a.z, a.w};
      }
      epi(item, m * 16 + fr, fq * 16, s);
    }
    __syncthreads();
  }
}

template <class F> struct PerM {
  F f;
  template <int MI> __device__ __forceinline__ void operator()(int L, int rb, int c0, const f32x4 (&a)[MI][4]) const {
#pragma unroll
    for (int m = 0; m < MI; ++m) f(L, rb + 16 * m, c0, a[m]);
  }
};
template <class F> __device__ __forceinline__ PerM<F> per_m(F f) { return PerM<F>{f}; }

template <int MI, bool SWAP, bool PERM, class RA, class RB, class KA, class KB, class F>
__device__ __forceinline__ void gemm_bal(char* shm, int nk, int vb, int ntile, int G, RA rowA, RB rowB, KA koffA, KB koffB, F f) {
  constexpr int HALF = 16 * MI;
  const int tail = ntile % G;
  const bool split = tail > 0 && 2 * tail <= G;
  const int nfull = split ? ntile - tail : ntile;
  if constexpr (SWAP && PERM) gemm_loop<MI, SWAP>(shm, nk, vb, nfull, G, rowA, rowB, koffA, koffB, per_m(f));
  else                        gemm_loop<MI, SWAP>(shm, nk, vb, nfull, G, rowA, rowB, koffA, koffB, f);
  if (split) {
    auto ra = [=](int H, int r) { return rowA(nfull + (H >> 1), r + HALF * (H & 1)); };
    auto rb = [=](int H, int c) { return rowB(nfull + (H >> 1), c); };
    auto ka = [=](int H, int kt) { return koffA(nfull + (H >> 1), kt); };
    auto kb = [=](int H, int kt) { return koffB(nfull + (H >> 1), kt); };
    auto ff = [=](int H, int row, int col, const auto& a) { f(nfull + (H >> 1), row + HALF * (H & 1), col, a); };
    if constexpr (SWAP && PERM) gemm_loop<MI / 2, SWAP>(shm, nk, vb, 2 * tail, G, ra, rb, ka, kb, per_m(ff));
    else                        gemm_loop<MI / 2, SWAP>(shm, nk, vb, 2 * tail, G, ra, rb, ka, kb, ff);
  }
}

template <bool BAL = false, class EP>
__device__ __forceinline__ void dense_phase(char* shm, int vb, int G, const bf16_t* A, int lda, const bf16_t* Wt, int ldw,
                                            int ntn, int nk, int with_ctx, EP epi) {
  const int nbig = 64 * ntn;
  if constexpr (BAL)
    gemm_bal<8, true, true>(shm, nk, vb, nbig, G,
      [=](int L, int r) { return A + (size_t)((1 + L / ntn) * 256 + r) * lda; },
      [=](int L, int c) { return Wt + (size_t)((L % ntn) * 256 + c) * ldw; }, KOffL(), KOffL(),
      [=](int L, int row, int col0, const f32x4 (&a)[4]) { epi((1 + L / ntn) * 256 + row, (L % ntn) * 256 + col0, a); });
  else
  gemm_run<8, true>(shm, nk, vb, nbig, G,
    [=](int L, int r) { return A + (size_t)((1 + L / ntn) * 256 + r) * lda; },
    [=](int L, int c) { return Wt + (size_t)((L % ntn) * 256 + c) * ldw; }, KOffL(), KOffL(),
    per_m([=](int L, int row, int col0, const f32x4 (&a)[4]) { epi((1 + L / ntn) * 256 + row, (L % ntn) * 256 + col0, a); }));
  if (with_ctx == 2) {
    skinny_items(shm, vb, 16 * ntn, G,
      [=](int it, int r) { return A + (size_t)((it / (4 * ntn)) * 64 + r) * lda; },
      [=](int it, int c) { return Wt + (size_t)((it % (4 * ntn)) * 64 + c) * ldw; },
      [=](int it, int row, int col0, const f32x4 (&a)[4]) { epi((it / (4 * ntn)) * 64 + row, (it % (4 * ntn)) * 64 + col0, a); });
  } else if (with_ctx == 1) {
    const int s = (vb - (nbig % G) + G) % G;
    gemm_loop<2, true>(shm, nk, s, 4 * ntn, G,
      [=](int L, int r) { return A + (size_t)((L / ntn) * 64 + r) * lda; },
      [=](int L, int c) { return Wt + (size_t)((L % ntn) * 256 + c) * ldw; }, KOffL(), KOffL(),
      per_m([=](int L, int row, int col0, const f32x4 (&a)[4]) { epi((L / ntn) * 64 + row, (L % ntn) * 256 + col0, a); }));
  }
}

#define XB_TMO      128
#define XB_XCNT(j)  (256  + 64 * (j))
#define XB_XSUB(j)  (1280 + 64 * (j))
#define XB_XGEN(j)  (2304 + 64 * (j))
#define XB_TOP      3328
#define XB_TOPGEN   3392
#define XCD_BAR_WORDS 3456
#define XB_SPIN_CAP (1u << 22)
#define LAS __attribute__((address_space(3)))
__device__ __forceinline__ unsigned xb_ld(unsigned* p)              { return __hip_atomic_load(p, __ATOMIC_RELAXED, __HIP_MEMORY_SCOPE_AGENT); }
__device__ __forceinline__ unsigned xb_add(unsigned* p, unsigned v) { return __hip_atomic_fetch_add(p, v, __ATOMIC_RELAXED, __HIP_MEMORY_SCOPE_AGENT); }
__device__ __forceinline__ unsigned xb_xcc_id() { return (unsigned)__builtin_amdgcn_s_getreg((3 << 11) | 20) & 0xFu; }
#define XB_SPIN(cond, bar) do { unsigned _sp = 0; while (cond) { __builtin_amdgcn_s_sleep(1); \
    if ((++_sp & 255u) == 0u) { if (xb_ld(&(bar)[XB_TMO])) break; if (_sp > XB_SPIN_CAP) { atomicAdd(&(bar)[XB_TMO], 1u); break; } } } } while (0)
struct XcdBarrier { unsigned* bar; unsigned x; volatile LAS unsigned* st; };
__device__ __forceinline__ XcdBarrier xcd_barrier_post(unsigned* bar, volatile LAS unsigned* st) {
    XcdBarrier b; b.bar = bar; b.x = xb_xcc_id(); b.st = st;
    if (threadIdx.x == 0) (void)xb_add(&bar[XB_XCNT(b.x)], 1u);
    return b;
}
__device__ __forceinline__ void xcd_barrier_complete(unsigned* bar, unsigned x, unsigned& nloc, unsigned& nx) {
    const unsigned G = gridDim.x * gridDim.y * gridDim.z;
    unsigned sum, cnt, mine, sp = 0u;
    for (;;) {
        sum = 0u; cnt = 0u; mine = 0u;
#pragma unroll
        for (unsigned j = 0; j < 16; ++j) { const unsigned c = xb_ld(&bar[XB_XCNT(j)]); sum += c; cnt += (c > 0u) ? 1u : 0u; mine = (j == x) ? c : mine; }
        if (sum == G) break;
        __builtin_amdgcn_s_sleep(1);
        if ((++sp & 255u) == 0u) { if (xb_ld(&bar[XB_TMO])) break; if (sp > XB_SPIN_CAP) { atomicAdd(&bar[XB_TMO], 1u); break; } }
    }
    nloc = mine > 0u ? mine : 1u; nx = cnt > 0u ? cnt : 1u;
}
__device__ __forceinline__ void xcd_barrier(const XcdBarrier& b) {
    asm volatile("s_waitcnt vmcnt(0)" ::: "memory");
    __syncthreads();
    if (threadIdx.x == 0) {
        unsigned* bar = b.bar;
        __builtin_amdgcn_s_waitcnt(0);
        unsigned nloc = b.st[0], nx = b.st[1];
        if (nloc == 0u) { xcd_barrier_complete(bar, b.x, nloc, nx); b.st[0] = nloc; b.st[1] = nx; }
        const unsigned old = xb_add(&bar[XB_XSUB(b.x)], 1u);
        const unsigned gen = old / nloc;
        if (old + 1u == (gen + 1u) * nloc) {
            __builtin_amdgcn_fence(__ATOMIC_RELEASE, "agent");
            asm volatile("s_waitcnt vmcnt(0)" ::: "memory");
            const unsigned og = xb_add(&bar[XB_TOP], 1u);
            const unsigned tg = og / nx;
            if (og + 1u == (tg + 1u) * nx) xb_add(&bar[XB_TOPGEN], 1u);
            else XB_SPIN(xb_ld(&bar[XB_TOPGEN]) == tg, bar);
            __builtin_amdgcn_fence(__ATOMIC_ACQUIRE, "agent");
            xb_add(&bar[XB_XGEN(b.x)], 1u);
            asm volatile("s_waitcnt vmcnt(0)" ::: "memory");
        } else {
            XB_SPIN(xb_ld(&bar[XB_XGEN(b.x)]) == gen, bar);
            __builtin_amdgcn_fence(__ATOMIC_ACQUIRE, "agent");
            asm volatile("s_waitcnt vmcnt(0)" ::: "memory");
        }
    }
    __syncthreads();
}

template <class AF, class BF, class EF>
__device__ __forceinline__ void gemm_naive(int M, int N, int K, AF af, BF bf, EF ef, float* smem_all) {
  const int half = threadIdx.x >> 8, tid = threadIdx.x & 255;
  float* smem = smem_all + half * (2 * 16 * 68);
  const int tilesM = (M + 63) >> 6, tilesN = (N + 63) >> 6;
  const int ntiles = tilesM * tilesN;
  float (*As)[68] = (float (*)[68])smem;
  float (*Bs)[68] = (float (*)[68])(smem + 16 * 68);
  const int ty = tid >> 4, tx = tid & 15;
  const int stride = gridDim.x * 2;
  const int iters = (ntiles + stride - 1) / stride;
  for (int it = 0; it < iters; ++it) {
    const int tile = it * stride + blockIdx.x * 2 + half;
    const bool valid = tile < ntiles;
    const int tm = valid ? tile / tilesN : 0, tn = valid ? tile - tm * tilesN : 0;
    const int m0 = tm << 6, n0 = tn << 6;
    float acc[4][4];
#pragma unroll
    for (int i = 0; i < 4; ++i)
#pragma unroll
      for (int j = 0; j < 4; ++j) acc[i][j] = 0.f;
    for (int k0 = 0; k0 < K; k0 += 16) {
#pragma unroll
      for (int i = 0; i < 4; ++i) {
        const int mm = (tid >> 4) + 16 * i, kk = tid & 15;
        const int m = m0 + mm, k = k0 + kk;
        As[kk][mm] = (valid && m < M && k < K) ? af(m, k, n0) : 0.f;
      }
#pragma unroll
      for (int i = 0; i < 4; ++i) {
        const int kk = (tid >> 6) + 4 * i, nn = tid & 63;
        const int k = k0 + kk, n = n0 + nn;
        Bs[kk][nn] = (valid && k < K && n < N) ? bf(k, n, m0) : 0.f;
      }
      __syncthreads();
#pragma unroll
      for (int kk = 0; kk < 16; ++kk) {
        const float4 a = *(const float4*)&As[kk][ty * 4];
        const float4 b = *(const float4*)&Bs[kk][tx * 4];
        const float av[4] = {a.x, a.y, a.z, a.w};
        const float bv[4] = {b.x, b.y, b.z, b.w};
#pragma unroll
        for (int i = 0; i < 4; ++i)
#pragma unroll
          for (int j = 0; j < 4; ++j) acc[i][j] = fmaf(av[i], bv[j], acc[i][j]);
      }
      __syncthreads();
    }
    if (valid) {
#pragma unroll
      for (int i = 0; i < 4; ++i)
#pragma unroll
        for (int j = 0; j < 4; ++j) {
          const int m = m0 + ty * 4 + i, n = n0 + tx * 4 + j;
          if (m < M && n < N) ef(m, n, acc[i][j]);
        }
    }
  }
}

__device__ __forceinline__ void conv_tile(const float* src, int ldn, bf16_t* dst, int ldk, int k0, int n0, int mapmode, float* sm) {
  const int tid = opaque_tid();
  float (*tl)[65] = (float (*)[65])sm;
  {
    const int row = tid >> 3, c4 = (tid & 7) * 4;
    const float4 a = *(const float4*)&src[(size_t)(k0 + row) * ldn + n0 + c4];
    const float4 b = *(const float4*)&src[(size_t)(k0 + row) * ldn + n0 + 32 + c4];
    tl[row][c4 + 0] = a.x; tl[row][c4 + 1] = a.y; tl[row][c4 + 2] = a.z; tl[row][c4 + 3] = a.w;
    tl[row][32 + c4 + 0] = b.x; tl[row][32 + c4 + 1] = b.y; tl[row][32 + c4 + 2] = b.z; tl[row][32 + c4 + 3] = b.w;
  }
  __syncthreads();
  {
    const int n = tid >> 3, kg = (tid & 7) * 8;
    uint4 o;
    o.x = pack2(tl[kg + 0][n], tl[kg + 1][n]); o.y = pack2(tl[kg + 2][n], tl[kg + 3][n]);
    o.z = pack2(tl[kg + 4][n], tl[kg + 5][n]); o.w = pack2(tl[kg + 6][n], tl[kg + 7][n]);
    const int h = n0 + n;
    const int dr = mapmode == 0 ? h : ((h >> 3) * 16 + (h & 7) + (mapmode == 2 ? 8 : 0));
    *(uint4*)&dst[(size_t)dr * ldk + k0 + kg] = o;
  }
  __syncthreads();
}

__device__ __forceinline__ void norm_phase(const Params& P, int t0, const float* gw,
                                           int mod_layer, int shift_idx,
                                           int pend_layer, int pend_t0,
                                           bool to_out, bool router, int layer, float* wl) {
  int* rl = (int*)((char*)wl + GEMM_LDS_TOTAL + 272);
  unsigned char* ws = P.ws;
  bf16_t* tok = (bf16_t*)(ws + WS_TOK);
  bf16_t* hb = (bf16_t*)(ws + WS_H);
  const float* mod = (const float*)(ws + WS_MOD);
  const bf16_t* ybuf = (const bf16_t*)(ws + WS_R + R_YBUF);
  const int tid_n = opaque_tid();
  const int lane = tid_n & 63;
  if (router) {
    const float* rgw = P.in[9] + (size_t)layer * 1024 * 4;
    const float* rew = P.in[11] + (size_t)layer * 1024 * 32;
    for (int idx = tid_n; idx < 1024 * 36; idx += NT) {
      const int k = idx / 36, j = idx - k * 36;
      const int rho = (((k >> 8) * 4 + (k & 3)) * 64) + ((k & 255) >> 2);
      wl[rho * 36 + j] = (j < 4) ? rgw[k * 4 + j] : rew[k * 32 + (j - 4)];
    }
    if (tid_n < 80) rl[tid_n] = 0;
    __syncthreads();
  }
  const int gw_id = blockIdx.x * (NT / 64) + (tid_n >> 6);
  const int gw_n = gridDim.x * (NT / 64);
  for (int t = t0 + gw_id; t < T_ALL; t += gw_n) {
    const int s = (t < T_CTX) ? 1 : 0;
    float v[16];
    if (pend_layer == -2) {
      const float* PE = (const float*)(ws + W_PE);
#pragma unroll
      for (int j = 0; j < 4; ++j) {
        const int n = j * 256 + lane * 4;
        float4 x;
        if (t < T_CTX) x = ntload4(&P.in[2][(size_t)t * DM + n]);
        else {
          const int tl = t - T_CTX;
          x = ntload4(&P.in[0][(size_t)tl * DM + n]);
          const float* pp = (j < 2) ? PE + j * 65536 + (tl >> 6) * 256 + lane * 4 : PE + 131072 + (j - 2) * 16384 + (tl & 63) * 256 + lane * 4;
          const float4 pe = *(const float4*)pp;
          x.x += pe.x; x.y += pe.y; x.z += pe.z; x.w += pe.w;
        }
        v[j * 4 + 0] = x.x; v[j * 4 + 1] = x.y; v[j * 4 + 2] = x.z; v[j * 4 + 3] = x.w;
        { uint2 o; o.x = pack2(x.x, x.y); o.y = pack2(x.z, x.w); *(uint2*)&tok[(size_t)t * DM + n] = o; }
      }
    } else {
#pragma unroll
    for (int j = 0; j < 4; ++j) {
      const int n = j * 256 + lane * 4;
      const uint2 x = *(const uint2*)&tok[(size_t)t * DM + n];
      v[j * 4 + 0] = lo2f(x.x); v[j * 4 + 1] = hi2f(x.x); v[j * 4 + 2] = lo2f(x.y); v[j * 4 + 3] = hi2f(x.y);
    }
    }
    if (pend_layer >= 0 && t >= pend_t0) {
      const float* gate = mod + (size_t)((pend_layer * 2 + s) * 6 + 5) * 1024;
#pragma unroll
      for (int j = 0; j < 4; ++j) {
        const int n = j * 256 + lane * 4;
        const uint2 y0 = *(const uint2*)&ybuf[(size_t)(2 * t) * DM + n];
        const uint2 y1 = *(const uint2*)&ybuf[(size_t)(2 * t + 1) * DM + n];
        const float4 g = *(const float4*)&gate[n];
        v[j * 4 + 0] += g.x * (lo2f(y0.x) + lo2f(y1.x));
        v[j * 4 + 1] += g.y * (hi2f(y0.x) + hi2f(y1.x));
        v[j * 4 + 2] += g.z * (lo2f(y0.y) + lo2f(y1.y));
        v[j * 4 + 3] += g.w * (hi2f(y0.y) + hi2f(y1.y));
        { uint2 o; o.x = pack2(v[j * 4 + 0], v[j * 4 + 1]); o.y = pack2(v[j * 4 + 2], v[j * 4 + 3]); *(uint2*)&tok[(size_t)t * DM + n] = o; }
      }
    }
    float ss = 0.f;
#pragma unroll
    for (int e = 0; e < 16; ++e) ss += v[e] * v[e];
    ss = wave_sum(ss);
    const float r = 1.f / sqrtf(ss * (1.f / 1024.f) + EPSN);
    float h[16];
#pragma unroll
    for (int j = 0; j < 4; ++j) {
      const int n = j * 256 + lane * 4;
      const float4 g = *(const float4*)&gw[n];
      h[j * 4 + 0] = v[j * 4 + 0] * r * g.x;
      h[j * 4 + 1] = v[j * 4 + 1] * r * g.y;
      h[j * 4 + 2] = v[j * 4 + 2] * r * g.z;
      h[j * 4 + 3] = v[j * 4 + 3] * r * g.w;
      if (shift_idx >= 0) {
        const float* sh = mod + (size_t)((mod_layer * 2 + s) * 6 + shift_idx) * 1024;
        const float* sc = sh + 1024;
        const float4 a = *(const float4*)&sh[n];
        const float4 b = *(const float4*)&sc[n];
        h[j * 4 + 0] = h[j * 4 + 0] * (1.f + b.x) + a.x;
        h[j * 4 + 1] = h[j * 4 + 1] * (1.f + b.y) + a.y;
        h[j * 4 + 2] = h[j * 4 + 2] * (1.f + b.z) + a.z;
        h[j * 4 + 3] = h[j * 4 + 3] * (1.f + b.w) + a.w;
      }
      if (to_out) {
        { typedef __attribute__((ext_vector_type(4))) float f4v; const f4v ov = {h[j * 4 + 0], h[j * 4 + 1], h[j * 4 + 2], h[j * 4 + 3]};
          __builtin_nontemporal_store(ov, (f4v*)&P.out[(size_t)(t - T_CTX) * DM + n]); }
      } else {
        uint2 o; o.x = pack2(h[j * 4 + 0], h[j * 4 + 1]); o.y = pack2(h[j * 4 + 2], h[j * 4 + 3]);
        *(uint2*)&hb[(size_t)t * DM + n] = o;
      }
    }
    if (router) {
      float lg[36];
#pragma unroll
      for (int q = 0; q < 36; ++q) lg[q] = 0.f;
#pragma unroll
      for (int i = 0; i < 16; ++i) {
        const float hv = h[i];
        const float4* wr4 = (const float4*)(wl + (i * 64 + lane) * 36);
#pragma unroll
        for (int q = 0; q < 9; ++q) {
          const float4 w4 = wr4[q];
          lg[q * 4 + 0] += hv * w4.x; lg[q * 4 + 1] += hv * w4.y; lg[q * 4 + 2] += hv * w4.z; lg[q * 4 + 3] += hv * w4.w;
        }
        __builtin_amdgcn_sched_barrier(0);
      }
#pragma unroll
      for (int q = 0; q < 36; ++q) lg[q] = wave_sum(lg[q]);
      const float* rgb = P.in[10] + layer * 4;
      const float* reb = P.in[12] + layer * 32;
#pragma unroll
      for (int q = 0; q < 4; ++q) lg[q] += rgb[q];
#pragma unroll
      for (int q = 0; q < 32; ++q) lg[4 + q] += reb[q];
      int grp = 0; float best = lg[0];
#pragma unroll
      for (int q = 1; q < 4; ++q) if (lg[q] > best) { best = lg[q]; grp = q; }
      float se = 0.f;
#pragma unroll
      for (int q = 0; q < 4; ++q) se += expf(lg[q] - best);
      const float pg = 1.f / se;
      float v0 = -3.0e38f, v1 = -3.0e38f; int i0 = 0, i1 = 0;
#pragma unroll
      for (int g = 0; g < 4; ++g) {
#pragma unroll
        for (int q = 0; q < 8; ++q) {
          const float x = lg[4 + g * 8 + q];
          if (g == grp) {
            if (x > v0) { v1 = v0; i1 = i0; v0 = x; i0 = q; }
            else if (x > v1) { v1 = x; i1 = q; }
          }
        }
      }
      const float w0 = 1.f / (1.f + expf(v1 - v0));
      const float w1 = 1.f - w0;
      if (lane == 0) {
        float* asgw = (float*)(ws + WS_ASGW);
        const int e0 = grp * 8 + i0, e1 = grp * 8 + i1;
        const int p0 = atomicAdd(&rl[e0], 1);
        const int p1 = atomicAdd(&rl[e1], 1);
        const int sl = atomicAdd(&rl[64], 2);
        rl[80 + sl] = 2 * t;         rl[240 + sl] = e0;     rl[400 + sl] = p0;
        rl[80 + sl + 1] = 2 * t + 1; rl[240 + sl + 1] = e1; rl[400 + sl + 1] = p1;
        asgw[2 * t] = w0 * pg;
        asgw[2 * t + 1] = w1 * pg;
      }
    }
  }
  if (router) {
    __syncthreads();
    int* cnt = (int*)(ws + WS_CNT) + layer * 32 * 32;
    int* list = (int*)(ws + WS_LIST);
    if (tid_n < 32) rl[32 + tid_n] = rl[tid_n] ? atomicAdd(&cnt[tid_n * 32], rl[tid_n]) : 0;
    __syncthreads();
    const int nent = rl[64];
    for (int s = tid_n; s < nent; s += NT) {
      const int e = rl[240 + s];
      list[(size_t)e * 33280 + rl[32 + e] + rl[400 + s]] = rl[80 + s];
    }
    __syncthreads();
  }
}


__device__ __forceinline__ void route_token(const float (&lg_in)[36], const float* rgb, const float* reb, int t, int* rl, float* asgw) {
  float lg[36];
#pragma unroll
  for (int q = 0; q < 4; ++q) lg[q] = lg_in[q] + rgb[q];
#pragma unroll
  for (int q = 0; q < 32; ++q) lg[4 + q] = lg_in[4 + q] + reb[q];
  int grp = 0; float best = lg[0];
#pragma unroll
  for (int q = 1; q < 4; ++q) if (lg[q] > best) { best = lg[q]; grp = q; }
  float se = 0.f;
#pragma unroll
  for (int q = 0; q < 4; ++q) se += expf(lg[q] - best);
  const float pg = 1.f / se;
  float v0 = -3.0e38f, v1 = -3.0e38f; int i0 = 0, i1 = 0;
#pragma unroll
  for (int g = 0; g < 4; ++g) {
#pragma unroll
    for (int q = 0; q < 8; ++q) {
      const float x = lg[4 + g * 8 + q];
      if (g == grp) {
        if (x > v0) { v1 = v0; i1 = i0; v0 = x; i0 = q; }
        else if (x > v1) { v1 = x; i1 = q; }
      }
    }
  }
  const float w0 = 1.f / (1.f + expf(v1 - v0));
  const float w1 = 1.f - w0;
  const int e0 = grp * 8 + i0, e1 = grp * 8 + i1;
  const int p0 = atomicAdd(&rl[e0], 1);
  const int p1 = atomicAdd(&rl[e1], 1);
  const int sl = atomicAdd(&rl[64], 2);
  rl[80 + sl] = 2 * t;         rl[240 + sl] = e0;     rl[400 + sl] = p0;
  rl[80 + sl + 1] = 2 * t + 1; rl[240 + sl + 1] = e1; rl[400 + sl + 1] = p1;
  asgw[2 * t] = w0 * pg;
  asgw[2 * t + 1] = w1 * pg;
}

__device__ __forceinline__ void route_token2(float res, int t, int* rl, float* asgw, int lane) {
  const float g0 = __shfl(res, 0), g1 = __shfl(res, 32), g2 = __shfl(res, 1), g3 = __shfl(res, 33);
  int grp = 0; float best = g0;
  if (g1 > best) { best = g1; grp = 1; }
  if (g2 > best) { best = g2; grp = 2; }
  if (g3 > best) { best = g3; grp = 3; }
  const float pg = 1.f / (expf(g0 - best) + expf(g1 - best) + expf(g2 - best) + expf(g3 - best));
  float v0 = -3.0e38f, v1 = -3.0e38f; int i0 = 0, i1 = 0;
#pragma unroll
  for (int q = 0; q < 8; ++q) {
    const float x = __shfl(res, (q & 1) * 32 + 2 + grp * 4 + (q >> 1));
    if (x > v0) { v1 = v0; i1 = i0; v0 = x; i0 = q; }
    else if (x > v1) { v1 = x; i1 = q; }
  }
  if (lane == 0) {
    const float w0 = 1.f / (1.f + expf(v1 - v0));
    const float w1 = 1.f - w0;
    const int e0 = grp * 8 + i0, e1 = grp * 8 + i1;
    const int p0 = atomicAdd(&rl[e0], 1);
    const int p1 = atomicAdd(&rl[e1], 1);
    const int sl = atomicAdd(&rl[64], 2);
    rl[80 + sl] = 2 * t;         rl[240 + sl] = e0;     rl[400 + sl] = p0;
    rl[80 + sl + 1] = 2 * t + 1; rl[240 + sl + 1] = e1; rl[400 + sl + 1] = p1;
    asgw[2 * t] = w0 * pg;
    asgw[2 * t + 1] = w1 * pg;
  }
}

__device__ __forceinline__ void ffn_norm_router_phase(const Params& P, int t0, int layer, float* wl) {
  unsigned char* ws = P.ws;
  int* rl = (int*)((char*)wl + GEMM_LDS_TOTAL + 272);
  const bf16_t* tok = (const bf16_t*)(ws + WS_TOK);
  bf16_t* hb = (bf16_t*)(ws + WS_H);
  const float* mod = (const float*)(ws + WS_MOD);
  const float* gw = P.in[7] + layer * 1024;
  const int tid_n = opaque_tid();
  const int lane0 = tid_n & 63;
  uint2 pfA[4], pfB[4];
  if (t0 + (int)(blockIdx.x * (NT / 64)) + (tid_n >> 6) < T_ALL) {
    const int gwn0 = gridDim.x * (NT / 64), tA = t0 + (int)(blockIdx.x * (NT / 64)) + (tid_n >> 6), tBs = (tA + gwn0 < T_ALL) ? tA + gwn0 : tA;
#pragma unroll
    for (int j = 0; j < 4; ++j) {
      pfA[j] = *(const uint2*)&tok[(size_t)tA * DM + j * 256 + lane0 * 4];
      pfB[j] = *(const uint2*)&tok[(size_t)tBs * DM + j * 256 + lane0 * 4];
    }
  }
  {
    const float* rgw = P.in[9] + (size_t)layer * 1024 * 4;
    const float* rew = P.in[11] + (size_t)layer * 1024 * 32;
    for (int ib = 0; ib < 18; ib += 6) {
      float4 w[6];
#pragma unroll
      for (int u = 0; u < 6; ++u) {
        const int idx = tid_n + (ib + u) * NT, k = idx / 9, q = idx - k * 9;
        const float* wp = (q == 0) ? rgw + k * 4 : rew + k * 32 + (q - 1) * 4;
        w[u] = *(const float4*)wp;
      }
#pragma unroll
      for (int u = 0; u < 6; ++u) {
        const int idx = tid_n + (ib + u) * NT, k = idx / 9, q = idx - k * 9;
        const int rho = (((k >> 8) * 4 + (k & 3)) * 64) + ((k & 255) >> 2);
        *(float4*)&wl[rho * 36 + q * 4] = w[u];
      }
    }
    if (tid_n < 80) rl[tid_n] = 0;
    __syncthreads();
  }
  const float* rgb = P.in[10] + layer * 4;
  const float* reb = P.in[12] + layer * 32;
  float* asgw = (float*)(ws + WS_ASGW);
  const int gw_id = blockIdx.x * (NT / 64) + (tid_n >> 6);
  const int gw_n = gridDim.x * (NT / 64);
  for (int tA = t0 + gw_id; tA < T_ALL; tA += 2 * gw_n) {
    int lane = lane0; asm volatile("" : "+v"(lane));
    const int tB = tA + gw_n;
    const bool hasB = tB < T_ALL;
    const int tBs = hasB ? tB : tA;
    float hA[16], hB[16];
    {
      float vA[16], vB[16];
#pragma unroll
      for (int j = 0; j < 4; ++j) {
        const int n = j * 256 + lane * 4;
        const uint2 x = pfA[j];
        const uint2 y = pfB[j];
        vA[j * 4 + 0] = lo2f(x.x); vA[j * 4 + 1] = hi2f(x.x); vA[j * 4 + 2] = lo2f(x.y); vA[j * 4 + 3] = hi2f(x.y);
        vB[j * 4 + 0] = lo2f(y.x); vB[j * 4 + 1] = hi2f(y.x); vB[j * 4 + 2] = lo2f(y.y); vB[j * 4 + 3] = hi2f(y.y);
      }
      float sA = 0.f, sB = 0.f;
#pragma unroll
      for (int e = 0; e < 16; ++e) { sA += vA[e] * vA[e]; sB += vB[e] * vB[e]; }
      sA = wave_sum(sA); sB = wave_sum(sB);
      const float rA = 1.f / sqrtf(sA * (1.f / 1024.f) + EPSN), rB = 1.f / sqrtf(sB * (1.f / 1024.f) + EPSN);
      const int stA = (tA < T_CTX) ? 1 : 0, stB = (tBs < T_CTX) ? 1 : 0;
      const float* shA = mod + (size_t)((layer * 2 + stA) * 6 + 3) * 1024;
      const float* shB = mod + (size_t)((layer * 2 + stB) * 6 + 3) * 1024;
#pragma unroll
      for (int j = 0; j < 4; ++j) {
        const int n = j * 256 + lane * 4;
        const float4 g = *(const float4*)&gw[n];
        const float4 a1 = *(const float4*)&shA[n], b1 = *(const float4*)&shA[1024 + n];
        const float4 a2 = *(const float4*)&shB[n], b2 = *(const float4*)&shB[1024 + n];
        hA[j * 4 + 0] = vA[j * 4 + 0] * rA * g.x * (1.f + b1.x) + a1.x; hA[j * 4 + 1] = vA[j * 4 + 1] * rA * g.y * (1.f + b1.y) + a1.y;
        hA[j * 4 + 2] = vA[j * 4 + 2] * rA * g.z * (1.f + b1.z) + a1.z; hA[j * 4 + 3] = vA[j * 4 + 3] * rA * g.w * (1.f + b1.w) + a1.w;
        hB[j * 4 + 0] = vB[j * 4 + 0] * rB * g.x * (1.f + b2.x) + a2.x; hB[j * 4 + 1] = vB[j * 4 + 1] * rB * g.y * (1.f + b2.y) + a2.y;
        hB[j * 4 + 2] = vB[j * 4 + 2] * rB * g.z * (1.f + b2.z) + a2.z; hB[j * 4 + 3] = vB[j * 4 + 3] * rB * g.w * (1.f + b2.w) + a2.w;
        uint2 o; o.x = pack2(hA[j * 4 + 0], hA[j * 4 + 1]); o.y = pack2(hA[j * 4 + 2], hA[j * 4 + 3]);
        *(uint2*)&hb[(size_t)tA * DM + n] = o;
        if (hasB) { uint2 o2; o2.x = pack2(hB[j * 4 + 0], hB[j * 4 + 1]); o2.y = pack2(hB[j * 4 + 2], hB[j * 4 + 3]); *(uint2*)&hb[(size_t)tB * DM + n] = o2; }
      }
    }
    {
      const int tA2 = tA + 2 * gw_n;
      if (tA2 < T_ALL) {
        const int tB2 = (tA2 + gw_n < T_ALL) ? tA2 + gw_n : tA2;
#pragma unroll
        for (int j = 0; j < 4; ++j) {
          pfA[j] = *(const uint2*)&tok[(size_t)tA2 * DM + j * 256 + lane * 4];
          pfB[j] = *(const uint2*)&tok[(size_t)tB2 * DM + j * 256 + lane * 4];
        }
      }
    }
    float gA[4], gB[4];
#pragma unroll
    for (int q = 0; q < 4; ++q) { gA[q] = 0.f; gB[q] = 0.f; }
#pragma unroll
    for (int i = 0; i < 16; ++i) {
      const float4 w4 = *(const float4*)(wl + (i * 64 + lane) * 36);
      gA[0] += hA[i] * w4.x; gA[1] += hA[i] * w4.y; gA[2] += hA[i] * w4.z; gA[3] += hA[i] * w4.w;
      gB[0] += hB[i] * w4.x; gB[1] += hB[i] * w4.y; gB[2] += hB[i] * w4.z; gB[3] += hB[i] * w4.w;
      __builtin_amdgcn_sched_barrier(0);
    }
    float gl[4];
#pragma unroll
    for (int q = 0; q < 4; ++q) gl[q] = fold_pair_sum(gA[q], gB[q]) + rgb[q];
    int grp = 0; float best = gl[0];
    if (gl[1] > best) { best = gl[1]; grp = 1; }
    if (gl[2] > best) { best = gl[2]; grp = 2; }
    if (gl[3] > best) { best = gl[3]; grp = 3; }
    const float pg = 1.f / (expf(gl[0] - best) + expf(gl[1] - best) + expf(gl[2] - best) + expf(gl[3] - best));
    const int grpA = __builtin_amdgcn_readlane(grp, 0), grpB = __builtin_amdgcn_readlane(grp, 32);
    float eA[8], eB[8];
#pragma unroll
    for (int q = 0; q < 8; ++q) { eA[q] = 0.f; eB[q] = 0.f; }
    const float* rowA = wl + lane * 36 + 4 + grpA * 8;
    const float* rowB = wl + lane * 36 + 4 + grpB * 8;
#pragma unroll
    for (int i = 0; i < 16; ++i) {
      const float4 a0 = *(const float4*)(rowA + i * 2304), a1 = *(const float4*)(rowA + i * 2304 + 4);
      const float4 b0 = *(const float4*)(rowB + i * 2304), b1 = *(const float4*)(rowB + i * 2304 + 4);
      eA[0] += hA[i] * a0.x; eA[1] += hA[i] * a0.y; eA[2] += hA[i] * a0.z; eA[3] += hA[i] * a0.w;
      eA[4] += hA[i] * a1.x; eA[5] += hA[i] * a1.y; eA[6] += hA[i] * a1.z; eA[7] += hA[i] * a1.w;
      eB[0] += hB[i] * b0.x; eB[1] += hB[i] * b0.y; eB[2] += hB[i] * b0.z; eB[3] += hB[i] * b0.w;
      eB[4] += hB[i] * b1.x; eB[5] += hB[i] * b1.y; eB[6] += hB[i] * b1.z; eB[7] += hB[i] * b1.w;
      asm volatile("" : "+v"(eA[0]), "+v"(eA[1]), "+v"(eA[2]), "+v"(eA[3]), "+v"(eA[4]), "+v"(eA[5]), "+v"(eA[6]), "+v"(eA[7]));
      asm volatile("" : "+v"(eB[0]), "+v"(eB[1]), "+v"(eB[2]), "+v"(eB[3]), "+v"(eB[4]), "+v"(eB[5]), "+v"(eB[6]), "+v"(eB[7]));
      __builtin_amdgcn_sched_barrier(0);
    }
    {
      const float4 r0 = *(const float4*)(reb + grp * 8), r1 = *(const float4*)(reb + grp * 8 + 4);
      const float rb8[8] = {r0.x, r0.y, r0.z, r0.w, r1.x, r1.y, r1.z, r1.w};
      float v0 = -3.0e38f, v1 = -3.0e38f; int i0 = 0, i1 = 0;
#pragma unroll
      for (int q = 0; q < 8; ++q) {
        const float x = fold_pair_sum(eA[q], eB[q]) + rb8[q];
        if (x > v0) { v1 = v0; i1 = i0; v0 = x; i0 = q; }
        else if (x > v1) { v1 = x; i1 = q; }
      }
      if (lane == 0 || (lane == 32 && hasB)) {
        const int t = lane == 0 ? tA : tB;
        const float w0 = 1.f / (1.f + expf(v1 - v0));
        const float w1 = 1.f - w0;
        const int e0 = grp * 8 + i0, e1 = grp * 8 + i1;
        const int p0 = atomicAdd(&rl[e0], 1);
        const int p1 = atomicAdd(&rl[e1], 1);
        const int sl = atomicAdd(&rl[64], 2);
        rl[80 + sl] = 2 * t;         rl[240 + sl] = e0;     rl[400 + sl] = p0;
        rl[80 + sl + 1] = 2 * t + 1; rl[240 + sl + 1] = e1; rl[400 + sl + 1] = p1;
        asgw[2 * t] = w0 * pg;
        asgw[2 * t + 1] = w1 * pg;
      }
    }
  }
  __syncthreads();
  int* cnt = (int*)(ws + WS_CNT) + layer * 32 * 32;
  int* list = (int*)(ws + WS_LIST);
  if (tid_n < 32) rl[32 + tid_n] = rl[tid_n] ? atomicAdd(&cnt[tid_n * 32], rl[tid_n]) : 0;
  __syncthreads();
  const int nent = rl[64];
  for (int s = tid_n; s < nent; s += NT) {
    const int e = rl[240 + s];
    list[(size_t)e * 33280 + rl[32 + e] + rl[400 + s]] = rl[80 + s];
  }
  __syncthreads();
}

#define tid (opaque_tid())
#define gtid ((int)(blockIdx.x * NT) + opaque_tid())
#define gstride ((int)(gridDim.x * NT))
__global__ void __launch_bounds__(NT, 2) mega(Params P) {
  cg::grid_group grid = cg::this_grid();
  __shared__ __attribute__((aligned(1024))) char shm[GEMM_LDS_TOTAL + 16 + 256 + 2560 + 16];
  float* smem = (float*)shm;
  if (threadIdx.x < 4) ((unsigned*)(shm + GEMM_LDS_TOTAL))[threadIdx.x] = 0u;
  if (threadIdx.x == 0) *(unsigned long long*)(shm + GEMM_LDS_TOTAL + 2832) = (unsigned long long)P.ws;
  __syncthreads();
  XcdBarrier xbar = xcd_barrier_post((unsigned*)(P.ws + WS_BAR), (volatile LAS unsigned*)(shm + GEMM_LDS_TOTAL));
  unsigned char* ws = P.ws;
  const int G = gridDim.x;
  const int vb = (G % 8 == 0) ? ((int)(blockIdx.x & 7) * (G / 8) + (int)(blockIdx.x >> 3)) : (int)blockIdx.x;
  bf16_t* tok = (bf16_t*)(ws + WS_TOK);
  bf16_t* hb = (bf16_t*)(ws + WS_H);
  float* mod = (float*)(ws + WS_MOD);
  const bf16_t* zrow = (const bf16_t*)(ws + WS_ZROW);
  unsigned char* R = ws + WS_R;

  {
    {
      float* PE = (float*)(ws + W_PE);
      for (int idx = gtid; idx < 320 * 256; idx += gstride) {
        const int p = idx >> 8, j = idx & 255;
        const float freq = expf(-9.210340371976184f * (float)j / 256.f);
        const float ang = (float)(p < 256 ? p : p - 256) * freq;
        float sv, cv; sincosf(ang, &sv, &cv);
        if (p < 256) { PE[p * 256 + j] = sv; PE[65536 + p * 256 + j] = cv; }
        else { PE[131072 + (p - 256) * 256 + j] = sv; PE[131072 + 16384 + (p - 256) * 256 + j] = cv; }
      }
    }
    {
      const float* c = P.in[1]; const float* cc = P.in[3]; const float* adaw = P.in[4];
      float* modp = (float*)(ws + WS_MODP);
      float* s_c = smem;
      for (int k = tid; k < 1024; k += NT) { const float a = c[k], b2 = cc[k]; s_c[k] = a / (1.f + expf(-a)); s_c[1024 + k] = b2 / (1.f + expf(-b2)); }
      __syncthreads();
      for (int idx = gtid; idx < 16 * 4 * 1536; idx += gstride) {
        const int ks = idx / 6144, rem = idx - ks * 6144, i = rem / 1536, j = (rem - i * 1536) * 4;
        const float* wp = adaw + ((size_t)i * 1024 + ks * 64) * 6144 + j;
        float4 a0 = make_float4(0.f, 0.f, 0.f, 0.f), a1 = a0;
        for (int kb = 0; kb < 64; kb += 8) {
          float4 w[8];
#pragma unroll
          for (int u = 0; u < 8; ++u) w[u] = ntload4(wp + (size_t)(kb + u) * 6144);
#pragma unroll
          for (int u = 0; u < 8; ++u) {
            const float s0 = s_c[ks * 64 + kb + u], s1 = s_c[1024 + ks * 64 + kb + u];
            a0.x += s0 * w[u].x; a0.y += s0 * w[u].y; a0.z += s0 * w[u].z; a0.w += s0 * w[u].w;
            a1.x += s1 * w[u].x; a1.y += s1 * w[u].y; a1.z += s1 * w[u].z; a1.w += s1 * w[u].w;
          }
        }
        *(float4*)&modp[(size_t)(ks * 8 + i * 2 + 0) * 6144 + j] = a0;
        *(float4*)&modp[(size_t)(ks * 8 + i * 2 + 1) * 6144 + j] = a1;
      }
      __syncthreads();
    }
    if (gtid < 4 * 32 * 32 + 64) ((int*)(ws + WS_CNT))[gtid] = 0;
    if (gtid < 2048) ((unsigned*)(ws + WS_ZROW))[gtid] = 0u;
    bf16_t* DC = (bf16_t*)(ws + W_DC); bf16_t* DA = (bf16_t*)(ws + W_DA); bf16_t* TW = (bf16_t*)(ws + W_TW);
    for (int idx = gtid; idx < 512 * 256; idx += gstride) {
      const int row = idx >> 8, cch = idx & 255, pq = row >> 8, kc = row & 255;
      const float a = (float)((kc * cch) & 255) * (1.f / 128.f);
      DC[idx] = f2bf(pq ? -sinpif(a) : cospif(a));
    }
    for (int idx = gtid; idx < 256 * 256; idx += gstride) {
      const int row = idx >> 8, col = idx & 255, ri = row >> 7, cc2 = row & 127, rj = col >> 7, aa = col & 127;
      const float a = (float)((aa * cc2) & 127) * (1.f / 64.f);
      const float cs = cospif(a), sn = sinpif(a);
      DA[idx] = f2bf(ri == rj ? cs : (ri == 0 ? sn : -sn));
    }
    for (int idx = gtid; idx < 128 * 128 * 256; idx += gstride) {
      const int col = idx & 255, e = (idx >> 8) & 127, c2 = idx >> 15, ri = col >> 7, b = col & 127;
      const float a = (float)((b * (c2 + 128 * e)) & 16383) * (1.f / 8192.f);
      TW[idx] = f2bf(ri ? sinpif(a) : cospif(a));
    }
    for (int idx = gtid; idx < 2 * 1280; idx += gstride) ((float*)(ws + W_SP))[idx] = log1pf(expf(-P.in[34][idx]));
    for (int idx = gtid; idx < 16 * 1024; idx += gstride) {
      const int k = idx >> 4, g = idx & 15;
      const float w = P.in[21][(size_t)k * 3088 + 3072 + g];
      const bf16_t hi = f2bf(w);
      bf16_t* WG = (bf16_t*)(ws + WS_HLO);
      WG[(size_t)(2 * g) * 1024 + k] = hi;
      WG[(size_t)(2 * g + 1) * 1024 + k] = f2bf(w - bf2f(hi));
    }
    {
      const float* src = P.in[36]; bf16_t* dst = (bf16_t*)(ws + W_FNIN);
      for (int idx = gtid; idx < 1024 * 1024 / 4; idx += gstride) {
        const float4 a = *(const float4*)&src[(size_t)idx * 4];
        uint2 o; o.x = pack2(a.x, a.y); o.y = pack2(a.z, a.w);
        *(uint2*)&dst[(size_t)idx * 4] = o;
      }
    }
    {
      struct CD { const float* src; bf16_t* dst; int ldn, ldk, k0, n0, mm, nt; };
      const int NDENSE = (512 + 256 + 768 + 256 + 640 + 320 + 256 + 160) / 2;
      const int NTOT = NDENSE + 128 * 192;
      auto desc = [=](int u) -> CD {
        CD d;
        if (u < NDENSE) {
          int v = u;
          if (v < 256) { d = CD{P.in[16], (bf16_t*)(ws + W_CMIN), 2048, 1024, (v >> 5) * 128, (v & 31) * 64, 0, 0}; return d; }
          v -= 256;
          if (v < 128) { d = CD{P.in[20], (bf16_t*)(ws + W_CMOUT), 1024, 1024, (v >> 4) * 128, (v & 15) * 64, 0, 0}; return d; }
          v -= 128;
          if (v < 384) { d = CD{P.in[21], (bf16_t*)(ws + W_MLIN), 3088, 1024, (v / 48) * 128, (v % 48) * 64, 0, 0}; return d; }
          v -= 384;
          if (v < 128) { d = CD{P.in[26], (bf16_t*)(ws + W_MLOUT), 1024, 1024, (v >> 4) * 128, (v & 15) * 64, 0, 0}; return d; }
          v -= 128;
          if (v < 320) { d = CD{P.in[27], (bf16_t*)(ws + W_LRUIN), 2560, 1024, (v / 40) * 128, (v % 40) * 64, 0, 0}; return d; }
          v -= 320;
          if (v < 160) { d = CD{P.in[35], (bf16_t*)(ws + W_LRUOUT), 1024, 1280, (v >> 4) * 128, (v & 15) * 64, 0, 0}; return d; }
          v -= 160;
          if (v < 128) { d = CD{P.in[37], (bf16_t*)(ws + W_FNOUT), 1024, 1024, (v >> 4) * 128, (v & 15) * 64, 0, 0}; return d; }
          v -= 128;
          const int mat = v >> 1, tl2 = v & 1, type = mat / 20, dnb = mat % 20, dd = dnb / 10, nb = dnb % 10;
          d = CD{(type ? P.in[32] : P.in[30]) + (size_t)dnb * 128 * 128, (bf16_t*)(ws + W_LRUG) + (size_t)(nb * 2 + dd) * 256 * 128,
                 128, 128, 0, tl2 * 64, type + 1, 0};
          return d;
        }
        const int v = u - NDENSE, le = v / 192, r = v - le * 192, kind = r >> 6, tt = r & 63;
        if (kind < 2) d = CD{(kind == 0 ? P.in[13] : P.in[14]) + (size_t)le * 1024 * 512, (bf16_t*)(ws + W_EGU) + (size_t)le * 1024 * 1024,
                             512, 1024, (tt >> 3) * 128, (tt & 7) * 64, kind + 1, le >= 32 ? 1 : 0};
        else d = CD{P.in[15] + (size_t)le * 512 * 1024, (bf16_t*)(ws + W_ED) + (size_t)le * 1024 * 512, 1024, 512, (tt >> 4) * 128, (tt & 15) * 64, 0, le >= 32 ? 1 : 0};
        return d;
      };
      auto upper = [](CD d) -> CD { d.k0 += 64; return d; };
      const int tq = tid, lrow = tq >> 3, c4 = (tq & 7) * 4, sn = tq >> 3, kg = (tq & 7) * 8;
      float (*tl0)[65] = (float (*)[65])smem;
      float (*tl1)[65] = (float (*)[65])(smem + 64 * 65);
      int u = blockIdx.x;
      CD d0 = desc(u < NTOT ? u : 0), d1 = upper(d0);
      float4 a0, b0, a1, b1;
      a0 = ntload4(&d0.src[(size_t)(d0.k0 + lrow) * d0.ldn + d0.n0 + c4]);
      b0 = ntload4(&d0.src[(size_t)(d0.k0 + lrow) * d0.ldn + d0.n0 + 32 + c4]);
      a1 = ntload4(&d1.src[(size_t)(d1.k0 + lrow) * d1.ldn + d1.n0 + c4]);
      b1 = ntload4(&d1.src[(size_t)(d1.k0 + lrow) * d1.ldn + d1.n0 + 32 + c4]);
      for (; u < NTOT; u += G) {
        const bool v1 = true;
        tl0[lrow][c4 + 0] = a0.x; tl0[lrow][c4 + 1] = a0.y; tl0[lrow][c4 + 2] = a0.z; tl0[lrow][c4 + 3] = a0.w;
        tl0[lrow][32 + c4 + 0] = b0.x; tl0[lrow][32 + c4 + 1] = b0.y; tl0[lrow][32 + c4 + 2] = b0.z; tl0[lrow][32 + c4 + 3] = b0.w;
        tl1[lrow][c4 + 0] = a1.x; tl1[lrow][c4 + 1] = a1.y; tl1[lrow][c4 + 2] = a1.z; tl1[lrow][c4 + 3] = a1.w;
        tl1[lrow][32 + c4 + 0] = b1.x; tl1[lrow][32 + c4 + 1] = b1.y; tl1[lrow][32 + c4 + 2] = b1.z; tl1[lrow][32 + c4 + 3] = b1.w;
        __syncthreads();
        const CD c0 = d0, c1 = d1;
        const int un = u + G;
        if (un < NTOT) {
          d0 = desc(un); d1 = upper(d0);
          a0 = ntload4(&d0.src[(size_t)(d0.k0 + lrow) * d0.ldn + d0.n0 + c4]);
          b0 = ntload4(&d0.src[(size_t)(d0.k0 + lrow) * d0.ldn + d0.n0 + 32 + c4]);
          a1 = ntload4(&d1.src[(size_t)(d1.k0 + lrow) * d1.ldn + d1.n0 + c4]);
          b1 = ntload4(&d1.src[(size_t)(d1.k0 + lrow) * d1.ldn + d1.n0 + 32 + c4]);
        }
        {
          uint4 o;
          o.x = pack2(tl0[kg + 0][sn], tl0[kg + 1][sn]); o.y = pack2(tl0[kg + 2][sn], tl0[kg + 3][sn]);
          o.z = pack2(tl0[kg + 4][sn], tl0[kg + 5][sn]); o.w = pack2(tl0[kg + 6][sn], tl0[kg + 7][sn]);
          const int h = c0.n0 + sn;
          const int dr = c0.mm == 0 ? h : ((h >> 3) * 16 + (h & 7) + (c0.mm == 2 ? 8 : 0));
          { typedef __attribute__((ext_vector_type(4))) unsigned u4v; const u4v ov = {o.x, o.y, o.z, o.w}; u4v* dp = (u4v*)&c0.dst[(size_t)dr * c0.ldk + c0.k0 + kg];
            if (c0.nt) __builtin_nontemporal_store(ov, dp); else *dp = ov; }
        }
        if (v1) {
          uint4 o;
          o.x = pack2(tl1[kg + 0][sn], tl1[kg + 1][sn]); o.y = pack2(tl1[kg + 2][sn], tl1[kg + 3][sn]);
          o.z = pack2(tl1[kg + 4][sn], tl1[kg + 5][sn]); o.w = pack2(tl1[kg + 6][sn], tl1[kg + 7][sn]);
          const int h = c1.n0 + sn;
          const int dr = c1.mm == 0 ? h : ((h >> 3) * 16 + (h & 7) + (c1.mm == 2 ? 8 : 0));
          { typedef __attribute__((ext_vector_type(4))) unsigned u4v; const u4v ov = {o.x, o.y, o.z, o.w}; u4v* dp = (u4v*)&c1.dst[(size_t)dr * c1.ldk + c1.k0 + kg];
            if (c1.nt) __builtin_nontemporal_store(ov, dp); else *dp = ov; }
        }
        __syncthreads();
      }
    }
  }
  grid.sync();
  {
    const float* modp = (const float*)(ws + WS_MODP);
    const float* adab = P.in[5];
    for (int idx = gtid; idx < 8 * 6144; idx += gstride) {
      const int is = idx / 6144, j = idx - is * 6144, i = is >> 1;
      float a = adab[i * 6144 + j];
      for (int ks = 0; ks < 16; ++ks) a += modp[(size_t)(ks * 8 + is) * 6144 + j];
      mod[idx] = a;
    }
    {
      const bf16_t* DC = (const bf16_t*)(ws + W_DC);
      const bf16_t* WI = (const bf16_t*)(ws + W_FNIN);
      bf16_t* WP = (bf16_t*)(ws + W_FNP);
      gemm_loop<4, true>(shm, 4, vb, 64, G,
        [=](int L, int r) { const int tm = L >> 2; return DC + (size_t)((tm >> 3) * 256 + (tm & 1) * 128 + r) * 256; },
        [=](int L, int cidx) { const int tm = L >> 2; return WI + (size_t)((L & 3) * 256 + cidx) * 1024 + ((tm >> 1) & 3) * 256; }, KOffL(), KOffL(),
        per_m([=](int L, int row, int col0, const f32x4 (&a)[4]) { st16bf(WP + (size_t)((L >> 2) * 128 + row) * 1024 + (L & 3) * 256 + col0, a); }));
    }
  }
  xcd_barrier(xbar);

#define MODV(i, s, j, n) mod[(size_t)(((i) * 2 + (s)) * 6 + (j)) * 1024 + (n)]

  auto resid_epi = [=](int layer, int grow, int gcol0, const f32x4 (&a)[4]) {
    const int s = grow < T_CTX ? 1 : 0;
    const float* gate = &MODV(layer, s, 2, gcol0);
    bf16_t* p = tok + (size_t)grow * DM + gcol0;
    const uint4 x0 = *(const uint4*)p, x1 = *(const uint4*)(p + 8);
    const unsigned xx[8] = {x0.x, x0.y, x0.z, x0.w, x1.x, x1.y, x1.z, x1.w};
    f32x4 o[4];
#pragma unroll
    for (int n = 0; n < 4; ++n) {
      const float4 g4 = *(const float4*)(gate + n * 4);
      o[n][0] = lo2f(xx[2 * n]) + g4.x * a[n][0]; o[n][1] = hi2f(xx[2 * n]) + g4.y * a[n][1];
      o[n][2] = lo2f(xx[2 * n + 1]) + g4.z * a[n][2]; o[n][3] = hi2f(xx[2 * n + 1]) + g4.w * a[n][3];
    }
    st16bf(p, o);
  };

  auto moe_layer = [&](int layer, int t0) __attribute__((always_inline)) {
    ffn_norm_router_phase(P, t0, layer, smem);
    xcd_barrier(xbar);
    int* cnt = (int*)(ws + WS_CNT) + layer * 32 * 32;
    int* list = (int*)(ws + WS_LIST);
    float* asgw = (float*)(ws + WS_ASGW);
    int* ps = (int*)(shm + GEMM_LDS_TOTAL + 64);
    if (tid == 0) {
      int s = 0;
      for (int e = 0; e < 32; ++e) { ps[e] = s; s += (cnt[e * 32] + 127) / 128 * 128; }
      ps[32] = s;
    }
    __syncthreads();
    const int total = ps[32];
    bf16_t* HB = (bf16_t*)(R + R_HB);
    bf16_t* ybuf = (bf16_t*)(R + R_YBUF);
    const bf16_t* WGU = (const bf16_t*)(ws + W_EGU) + (size_t)layer * 32 * 1024 * 1024;
    const bf16_t* WD = (const bf16_t*)(ws + W_ED) + (size_t)layer * 32 * 1024 * 512;
    const int ntile = (total >> 7) * 4;
    auto blk_e = [=](int mb) { int e = 0; for (int q = 1; q < 32; ++q) if (ps[q] <= mb * 128) e = q; return e; };
    const int tail = ntile % G;
    const bool split = tail > 0 && 2 * tail <= G;
    const int nfull = split ? ntile - tail : ntile;
    {
      auto a1 = [=](int L, int r) { const int mb = L >> 2, e = blk_e(mb), rr = mb * 128 - ps[e] + r;
          return (rr < cnt[e * 32]) ? (const bf16_t*)(hb + (size_t)(list[(size_t)e * 33280 + rr] >> 1) * DM) : zrow; };
      auto b1 = [=](int L, int cidx) { const int e = blk_e(L >> 2); return WGU + (size_t)e * 1024 * 1024 + (size_t)((L & 3) * 256 + cidx) * 1024; };
      auto e1 = [=](int L, int row, int col0, const f32x4 (&a)[4]) {
          const int n0 = (L & 3) * 256, m0 = (L >> 2) * 128;
          float hv[8];
#pragma unroll
          for (int j = 0; j < 8; ++j) { const float gv = a[j >> 2][j & 3], uv = a[2 + (j >> 2)][j & 3]; hv[j] = silu_f(gv) * uv; }
          uint4 o; o.x = pack2(hv[0], hv[1]); o.y = pack2(hv[2], hv[3]); o.z = pack2(hv[4], hv[5]); o.w = pack2(hv[6], hv[7]);
          *(uint4*)&HB[(size_t)(m0 + row) * 512 + ((n0 + col0) >> 1)] = o;
        };
      gemm_loop<4, true>(shm, 16, vb, nfull, G, a1, b1, KOffL(), KOffL(), per_m(e1));
      if (split)
        gemm_loop<2, true>(shm, 16, vb, 2 * tail, G,
          [=](int H, int r) { return a1(nfull + (H >> 1), r + 64 * (H & 1)); },
          [=](int H, int cidx) { return b1(nfull + (H >> 1), cidx); }, KOffL(), KOffL(),
          per_m([=](int H, int row, int col0, const f32x4 (&a)[4]) { e1(nfull + (H >> 1), row + 64 * (H & 1), col0, a); }));
    }
    xcd_barrier(xbar);
    {
      auto a2 = [=](int L, int r) { return (const bf16_t*)(HB + (size_t)((L >> 2) * 128 + r) * 512); };
      auto b2 = [=](int L, int cidx) { const int e = blk_e(L >> 2); return WD + (size_t)e * 1024 * 512 + (size_t)((L & 3) * 256 + cidx) * 512; };
      auto e2 = [=](int L, int row, int col0, const f32x4 (&a)[4]) {
          const int mb = L >> 2, n0 = (L & 3) * 256, e = blk_e(mb), rr = mb * 128 - ps[e] + row;
          if (rr < cnt[e * 32]) {
            const int rt = list[(size_t)e * 33280 + rr];
            const float w = asgw[rt];
            f32x4 bq[4];
#pragma unroll
            for (int n = 0; n < 4; ++n) bq[n] = a[n] * w;
            st16bf(ybuf + (size_t)rt * 1024 + n0 + col0, bq);
          }
        };
      gemm_loop<4, true>(shm, 8, vb, nfull, G, a2, b2, KOffL(), KOffL(), per_m(e2));
      if (split)
        gemm_loop<2, true>(shm, 8, vb, 2 * tail, G,
          [=](int H, int r) { return a2(nfull + (H >> 1), r + 64 * (H & 1)); },
          [=](int H, int cidx) { return b2(nfull + (H >> 1), cidx); }, KOffL(), KOffL(),
          per_m([=](int H, int row, int col0, const f32x4 (&a)[4]) { e2(nfull + (H >> 1), row + 64 * (H & 1), col0, a); }));
    }
    xcd_barrier(xbar);
  };

  {
    norm_phase(P, 0, P.in[6] + 0 * 1024, 0, 0, -2, 0, false, false, 0, smem);
    xcd_barrier(xbar);
    bf16_t* zu = (bf16_t*)(R + R0_ZU); bf16_t* zvT = (bf16_t*)(R + R0_ZVT); bf16_t* pb = (bf16_t*)(R + R0_P);
    bf16_t* Wsc = (bf16_t*)(R + R0_WSC);
    const float* vg = P.in[17]; const float* w_s = P.in[18]; const float* b_s = P.in[19];
    const bf16_t* Wt = (const bf16_t*)(ws + W_CMIN);
    {
      auto epi_u = [=](int grow, int gcol0, const f32x4 (&a)[4]) {
        f32x4 bq[4];
#pragma unroll
        for (int n = 0; n < 4; ++n)
#pragma unroll
          for (int j = 0; j < 4; ++j) bq[n][j] = gelu_f(a[n][j]);
        st16bf(zu + (size_t)grow * 1024 + gcol0, bq);
      };
      auto epi_vT = [=](int vcol, int t0c, const f32x4 (&a)[4]) {
        f32x4 bq[4];
#pragma unroll
        for (int n = 0; n < 4; ++n)
#pragma unroll
          for (int j = 0; j < 4; ++j) bq[n][j] = gelu_f(a[n][j]);
        st16bf(zvT + ((size_t)(t0c >> 7) * 1024 + vcol) * 128 + (t0c & 127), bq);
      };
      gemm_run<8, true>(shm, 16, vb, 256, G,
        [=](int L, int r) { return (const bf16_t*)(hb + (size_t)((1 + (L >> 2)) * 256 + r) * DM); },
        [=](int L, int cidx) { return Wt + (size_t)((L & 3) * 256 + cidx) * 1024; }, KOffL(), KOffL(),
        per_m([=](int L, int row, int col0, const f32x4 (&a)[4]) { epi_u((1 + (L >> 2)) * 256 + row, (L & 3) * 256 + col0, a); }));
      gemm_run<8, true>(shm, 16, vb, 256, G,
        [=](int L, int r) { return Wt + (size_t)((4 + (L & 3)) * 256 + r) * 1024; },
        [=](int L, int cidx) { return (const bf16_t*)(hb + (size_t)((1 + (L >> 2)) * 256 + cidx) * DM); }, KOffL(), KOffL(),
        per_m([=](int L, int row, int col0, const f32x4 (&a)[4]) { epi_vT((L & 3) * 256 + row, (1 + (L >> 2)) * 256 + col0, a); }));
      skinny_items(shm, vb, 128, G,
        [=](int it, int r) { return it < 64 ? (const bf16_t*)(hb + (size_t)((it >> 4) * 64 + r) * DM) : Wt + (size_t)(1024 + ((it - 64) >> 2) * 64 + r) * 1024; },
        [=](int it, int c) { return it < 64 ? Wt + (size_t)((it & 15) * 64 + c) * 1024 : (const bf16_t*)(hb + (size_t)(((it - 64) & 3) * 64 + c) * DM); },
        [=](int it, int row, int col0, const f32x4 (&a)[4]) {
          if (it < 64) epi_u((it >> 4) * 64 + row, (it & 15) * 64 + col0, a);
          else epi_vT(((it - 64) >> 2) * 64 + row, ((it - 64) & 3) * 64 + col0, a);
        });
    }
    xcd_barrier(xbar);
    {
      float* s_part = smem;
      float* s_rv = smem + 4096;
      for (int n = blockIdx.x; n < NCH; n += G) {
        {
          const int tq = tid, cg = tq >> 4, sg = tq & 15;
          float ss8[8];
#pragma unroll
          for (int e = 0; e < 8; ++e) ss8[e] = 0.f;
          for (int it = 0; it < 32; it += 4) {
            uint4 z[4];
#pragma unroll
            for (int u = 0; u < 4; ++u) z[u] = *(const uint4*)&zvT[((size_t)n * 1024 + (it + u) * 32 + cg) * 128 + sg * 8];
#pragma unroll
            for (int u = 0; u < 4; ++u) {
              const unsigned zz[4] = {z[u].x, z[u].y, z[u].z, z[u].w};
#pragma unroll
              for (int e = 0; e < 4; ++e) { const float a = lo2f(zz[e]), b2 = hi2f(zz[e]); ss8[2 * e] += a * a; ss8[2 * e + 1] += b2 * b2; }
            }
          }
#pragma unroll
          for (int e = 0; e < 8; ++e) s_part[cg * 128 + sg * 8 + e] = ss8[e];
        }
        __syncthreads();
        if (tid < 128) {
          float a = 0.f;
          for (int q = 0; q < 32; ++q) a += s_part[q * 128 + tid];
          s_rv[tid] = 1.f / sqrtf(a * (1.f / 1024.f) + EPSN);
        }
        __syncthreads();
        for (int idx = tid; idx < 4 * 128 * 32; idx += NT) {
          const int s4 = (idx & 31) * 4, gt = idx >> 5;
          const float4 w4 = *(const float4*)&w_s[(size_t)gt * 128 + s4];
          uint2 o; o.x = pack2(w4.x * s_rv[s4], w4.y * s_rv[s4 + 1]); o.y = pack2(w4.z * s_rv[s4 + 2], w4.w * s_rv[s4 + 3]);
          *(uint2*)&Wsc[((size_t)n * 512 + gt) * 128 + s4] = o;
        }
        __syncthreads();
      }
    }
    xcd_barrier(xbar);
    {
      gemm_bal<4, true, true>(shm, 2, vb, NCH * 4, G,
        [=](int L, int r) { return (const bf16_t*)(Wsc + ((size_t)(L >> 2) * 512 + (L & 3) * 128 + r) * 128); },
        [=](int L, int cidx) { return (const bf16_t*)(zvT + ((size_t)(L >> 2) * 1024 + (L & 3) * 256 + cidx) * 128); },
        KOffL(), KOffL(),
        ([=](int L, int row, int col0, const f32x4 (&a)[4]) {
          const int n = L >> 2, g = L & 3;
          const int t = n * 128 + row, col = g * 256 + col0;
          const float bias = b_s[g * 128 + row];
          const uint4 u0 = *(const uint4*)&zu[(size_t)t * 1024 + col], u1 = *(const uint4*)&zu[(size_t)t * 1024 + col + 8];
          const unsigned uu[8] = {u0.x, u0.y, u0.z, u0.w, u1.x, u1.y, u1.z, u1.w};
          f32x4 o[4];
#pragma unroll
          for (int nn = 0; nn < 4; ++nn) {
            const float4 g4 = *(const float4*)&vg[col + nn * 4];
            o[nn][0] = lo2f(uu[nn * 2]) * (a[nn][0] * g4.x + bias);
            o[nn][1] = hi2f(uu[nn * 2]) * (a[nn][1] * g4.y + bias);
            o[nn][2] = lo2f(uu[nn * 2 + 1]) * (a[nn][2] * g4.z + bias);
            o[nn][3] = hi2f(uu[nn * 2 + 1]) * (a[nn][3] * g4.w + bias);
          }
          st16bf(pb + (size_t)t * 1024 + col, o);
        }));
    }
    xcd_barrier(xbar);
    const bf16_t* Wo = (const bf16_t*)(ws + W_CMOUT);
    auto epi_out = [=](int grow, int gcol0, const f32x4 (&a)[4]) { resid_epi(0, grow, gcol0, a); };
    dense_phase(shm, vb, G, pb, 1024, Wo, 1024, 4, 16, 2, epi_out);
    xcd_barrier(xbar);
  }
  moe_layer(0, 0);

  {
    norm_phase(P, 0, P.in[6] + 1 * 1024, 1, 0, 0, 0, false, false, 0, smem);
    xcd_barrier(xbar);
    bf16_t* ZQK = (bf16_t*)(R + R1_ZQK); bf16_t* ZO = (bf16_t*)(R + R1_ZO); bf16_t* VT = (bf16_t*)(R + R1_VT);
    float* gpre = (float*)(R + R1_GPRE); bf16_t* Qn = (bf16_t*)(R + R1_QN); bf16_t* Kn = (bf16_t*)(R + R1_KN);
    bf16_t* AS = (bf16_t*)(R + R1_AS); bf16_t* KwT = (bf16_t*)(R + R1_KWT);
    float* bc = (float*)(R + R1_BC); float* li = (float*)(R + R1_LI); float* egch = (float*)(R + R1_GCH);
    float* nloc = (float*)(R + R1_NLOC); float* nin = (float*)(R + R1_NIN);
    float* Cloc = (float*)(R + R1_CLOC); bf16_t* CinT = (bf16_t*)(R + R1_CINT); bf16_t* hnum = (bf16_t*)(R + R1_CLOC);
    bf16_t* A2 = (bf16_t*)(R + R1_A2);
    const float* w_in = P.in[21]; const float* cw = P.in[22]; const float* cb = P.in[23];
    const float* gb = P.in[24]; const float* ng = P.in[25];
    const bf16_t* Wt = (const bf16_t*)(ws + W_MLIN);
    {
      auto epi_nat = [=](int grow, int gcol0, const f32x4 (&a)[4]) {
        if (gcol0 < 1024) st16bf(ZQK + (size_t)grow * 1024 + gcol0, a); else st16bf(ZO + (size_t)grow * 1024 + gcol0 - 2048, a);
      };
      auto epi_vt = [=](int vcol, int t0c, const f32x4 (&a)[4]) {
        st16bf(VT + ((size_t)(t0c >> 7) * 1024 + vcol) * 128 + (t0c & 127), a);
      };
      {
        const bf16_t* WG = (const bf16_t*)(ws + WS_HLO);
        skinny_items(shm, vb, T_ALL / 64, G,
          [=](int it, int r) { return (const bf16_t*)(hb + (size_t)(it * 64 + r) * DM); },
          [=](int it, int c) { return c < 32 ? WG + (size_t)c * 1024 : zrow; },
          [=](int it, int row, int col0, const f32x4 (&a)[4]) {
            if (col0 < 32) {
              float* gp = gpre + (size_t)(it * 64 + row) * 16 + (col0 >> 1);
              *(float4*)gp = make_float4(a[0][0] + a[0][1], a[0][2] + a[0][3], a[1][0] + a[1][1], a[1][2] + a[1][3]);
              *(float4*)(gp + 4) = make_float4(a[2][0] + a[2][1], a[2][2] + a[2][3], a[3][0] + a[3][1], a[3][2] + a[3][3]);
            }
          });
      }
      gemm_run<8, true>(shm, 16, vb, 512, G,
        [=](int L, int r) { return (const bf16_t*)(hb + (size_t)((1 + (L >> 3)) * 256 + r) * DM); },
        [=](int L, int cidx) { const int j = L & 7, tn = j < 4 ? j : j + 4; return Wt + (size_t)(tn * 256 + cidx) * 1024; }, KOffL(), KOffL(),
        per_m([=](int L, int row, int col0, const f32x4 (&a)[4]) { const int j = L & 7, tn = j < 4 ? j : j + 4; epi_nat((1 + (L >> 3)) * 256 + row, tn * 256 + col0, a); }));
      gemm_run<8, true>(shm, 16, vb, 256, G,
        [=](int L, int r) { return Wt + (size_t)((4 + (L & 3)) * 256 + r) * 1024; },
        [=](int L, int cidx) { return (const bf16_t*)(hb + (size_t)((1 + (L >> 2)) * 256 + cidx) * DM); }, KOffL(), KOffL(),
        per_m([=](int L, int row, int col0, const f32x4 (&a)[4]) { epi_vt((L & 3) * 256 + row, (1 + (L >> 2)) * 256 + col0, a); }));
      skinny_items(shm, vb, 192, G,
        [=](int it, int r) { return it < 128 ? (const bf16_t*)(hb + (size_t)((it >> 5) * 64 + r) * DM) : Wt + (size_t)(1024 + ((it - 128) >> 2) * 64 + r) * 1024; },
        [=](int it, int c) { const int cb = it & 31, col = cb < 16 ? cb * 64 : 2048 + (cb - 16) * 64;
          return it < 128 ? Wt + (size_t)(col + c) * 1024 : (const bf16_t*)(hb + (size_t)(((it - 128) & 3) * 64 + c) * DM); },
        [=](int it, int row, int col0, const f32x4 (&a)[4]) {
          if (it < 128) { const int cb = it & 31, col = cb < 16 ? cb * 64 : 2048 + (cb - 16) * 64; epi_nat((it >> 5) * 64 + row, col + col0, a); }
          else epi_vt(((it - 128) >> 2) * 64 + row, ((it - 128) & 3) * 64 + col0, a);
        });
    }
    xcd_barrier(xbar);
    {
      float* s_bc = smem;
      float* s_w  = smem + 1024;
      float* s_k  = smem + 2048;
      const int wv = tid >> 6, lane = tid & 63;
      auto prep_item = [&](int n, int h0, int hc) __attribute__((always_inline)) {
        if ((wv & 3) >= h0 && (wv & 3) < h0 + hc) {
          const int dh = wv, d = dh >> 2, hd = dh & 3;
          const int p0 = 2 * lane, p1 = p0 + 1;
          const int t0 = n * 128 + (d == 0 ? p0 : 127 - p0), t1 = n * 128 + (d == 0 ? p1 : 127 - p1);
          const float li0 = gpre[(size_t)t0 * 16 + d * 8 + hd] + gb[d * 8 + hd];
          const float li1 = gpre[(size_t)t1 * 16 + d * 8 + hd] + gb[d * 8 + hd];
          const float lf0 = logsig_f(gpre[(size_t)t0 * 16 + d * 8 + 4 + hd] + gb[d * 8 + 4 + hd]);
          const float lf1 = logsig_f(gpre[(size_t)t1 * 16 + d * 8 + 4 + hd] + gb[d * 8 + 4 + hd]);
          float run = lf0 + lf1;
#pragma unroll
          for (int o = 1; o < 64; o <<= 1) { const float y = __shfl_up(run, o); if (lane >= o) run += y; }
          const float b1 = run, b0 = run - lf1;
          const float g = __shfl(run, 63);
          bc[(size_t)dh * T_ALL + t0] = expf(b0); bc[(size_t)dh * T_ALL + t1] = expf(b1);
          li[(size_t)dh * T_ALL + t0] = expf(li0 - b0); li[(size_t)dh * T_ALL + t1] = expf(li1 - b1);
          s_bc[dh * 128 + (t0 & 127)] = b0; s_bc[dh * 128 + (t1 & 127)] = b1;
          s_w[dh * 128 + (t0 & 127)] = expf(g - b0 + li0); s_w[dh * 128 + (t1 & 127)] = expf(g - b1 + li1);
          if (lane == 0) egch[dh * NCH + n] = expf(g);
        }
        __syncthreads();
        const int lo = n < 2 ? 0 : T_CTX, hi = n < 2 ? T_CTX : T_ALL;
        const int qsh = hc == 2 ? 5 : 4;
        for (int idx = tid; idx < (128 << qsh); idx += NT) {
          const int tl = idx >> qsh, c0 = h0 * 128 + (idx & ((1 << qsh) - 1)) * 8, t = n * 128 + tl, hd = c0 >> 7;
          float q[8];
#pragma unroll
          for (int e = 0; e < 8; ++e) q[e] = cb[c0 + e];
#pragma unroll
          for (int j = 0; j < 4; ++j) {
            const int tt = t + j - 2;
            if (tt >= lo && tt < hi) {
              const uint4 z = *(const uint4*)&ZQK[(size_t)tt * 1024 + c0];
              const float4 w0 = *(const float4*)&cw[j * 1024 + c0], w1 = *(const float4*)&cw[j * 1024 + c0 + 4];
              q[0] += lo2f(z.x) * w0.x; q[1] += hi2f(z.x) * w0.y; q[2] += lo2f(z.y) * w0.z; q[3] += hi2f(z.y) * w0.w;
              q[4] += lo2f(z.z) * w1.x; q[5] += hi2f(z.z) * w1.y; q[6] += lo2f(z.w) * w1.z; q[7] += hi2f(z.w) * w1.w;
            }
          }
#pragma unroll
          for (int e = 0; e < 8; ++e) q[e] = silu_f(q[e]) * 0.08838834764831845f;
          uint4 o; o.x = pack2(q[0], q[1]); o.y = pack2(q[2], q[3]); o.z = pack2(q[4], q[5]); o.w = pack2(q[6], q[7]);
          *(uint4*)&Qn[(size_t)t * 512 + c0] = o;
#pragma unroll
          for (int d = 0; d < 2; ++d) {
            const int dh = d * 4 + hd;
            const float eb = expf(s_bc[dh * 128 + tl]);
            uint4 o2; o2.x = pack2(q[0] * eb, q[1] * eb); o2.y = pack2(q[2] * eb, q[3] * eb); o2.z = pack2(q[4] * eb, q[5] * eb); o2.w = pack2(q[6] * eb, q[7] * eb);
            *(uint4*)&AS[((size_t)dh * T_ALL + t) * 256 + 128 + (c0 & 127)] = o2;
          }
        }
        for (int hd = h0; hd < h0 + hc; ++hd) {
          for (int idx = tid; idx < 128 * 16; idx += NT) {
            const int tl = idx >> 4, k0 = (idx & 15) * 8, t = n * 128 + tl, c0 = 512 + hd * 128 + k0;
            float q[8];
#pragma unroll
            for (int e = 0; e < 8; ++e) q[e] = cb[c0 + e];
#pragma unroll
            for (int j = 0; j < 4; ++j) {
              const int tt = t + j - 2;
              if (tt >= lo && tt < hi) {
                const uint4 z = *(const uint4*)&ZQK[(size_t)tt * 1024 + c0];
                const float4 w0 = *(const float4*)&cw[j * 1024 + c0], w1 = *(const float4*)&cw[j * 1024 + c0 + 4];
                q[0] += lo2f(z.x) * w0.x; q[1] += hi2f(z.x) * w0.y; q[2] += lo2f(z.y) * w0.z; q[3] += hi2f(z.y) * w0.w;
                q[4] += lo2f(z.z) * w1.x; q[5] += hi2f(z.z) * w1.y; q[6] += lo2f(z.w) * w1.z; q[7] += hi2f(z.w) * w1.w;
              }
            }
#pragma unroll
            for (int e = 0; e < 8; ++e) { q[e] = silu_f(q[e]); s_k[tl * 129 + k0 + e] = q[e]; }
            uint4 o; o.x = pack2(q[0], q[1]); o.y = pack2(q[2], q[3]); o.z = pack2(q[4], q[5]); o.w = pack2(q[6], q[7]);
            *(uint4*)&Kn[(size_t)t * 512 + hd * 128 + k0] = o;
          }
          __syncthreads();
          for (int idx = tid; idx < 2 * 128 * 16; idx += NT) {
            const int d = idx >> 11, rem = idx & 2047, kk = rem >> 4, s0 = (rem & 15) * 8, dh = d * 4 + hd;
            float v8[8];
#pragma unroll
            for (int e = 0; e < 8; ++e) v8[e] = s_w[dh * 128 + s0 + e] * s_k[(s0 + e) * 129 + kk];
            uint4 o; o.x = pack2(v8[0], v8[1]); o.y = pack2(v8[2], v8[3]); o.z = pack2(v8[4], v8[5]); o.w = pack2(v8[6], v8[7]);
            *(uint4*)&KwT[((size_t)dh * T_ALL + n * 128 + kk) * 128 + s0] = o;
          }
          if (tid < 256) {
            const int d = tid >> 7, kk = tid & 127, dh = d * 4 + hd;
            float a = 0.f;
            for (int s2 = 0; s2 < 128; ++s2) a += s_w[dh * 128 + s2] * s_k[s2 * 129 + kk];
            nloc[(dh * NCH + n) * 128 + kk] = a;
          }
          __syncthreads();
        }
      };
      const int nitem = NCH * 2, xtra = nitem - G;
      if (xtra > 0 && 4 * xtra <= G) {
        const int b = blockIdx.x, nsolo = G - 2 * xtra;
        if (b < nsolo) prep_item(b >> 1, (b & 1) * 2, 2);
        else {
          for (int u = 3 * (b - nsolo); u < 3 * (b - nsolo) + 3; ++u) {
            const int it = nsolo + (u >> 1);
            prep_item(it >> 1, (it & 1) * 2 + (u & 1), 1);
          }
        }
      } else {
        for (int it = blockIdx.x; it < nitem; it += G) prep_item(it >> 1, (it & 1) * 2, 2);
      }
    }
    xcd_barrier(xbar);
    bf16_t* Clocb = (bf16_t*)Cloc;
    gemm_bal<4, true, true>(shm, 2, vb, 1040, G,
      [=](int L, int r) { const int n = L >> 3, hd = (L >> 1) & 3, mh = L & 1; return (const bf16_t*)(VT + ((size_t)n * 1024 + hd * 256 + mh * 128 + r) * 128); },
      [=](int L, int cidx) { const int n = L >> 3, hd = (L >> 1) & 3, dh = (cidx >> 7) * 4 + hd; return (const bf16_t*)(KwT + ((size_t)dh * T_ALL + n * 128 + (cidx & 127)) * 128); },
      KOffL(), KOffL(),
      [=](int L, int row, int col0, const f32x4 (&a)[4]) {
        const int n = L >> 3, hd = (L >> 1) & 3, mh = L & 1, dh = (col0 >> 7) * 4 + hd;
        st16bf(Clocb + (size_t)(dh * NCH + n) * 32768 + (size_t)(mh * 128 + row) * 128 + (col0 & 127), a);
      });
    gemm_bal<4, true, true>(shm, 2, (vb - 32 + G) % G, 520, G,
      [=](int L, int r) { const int hd = L / NCH, n = L - hd * NCH; return (const bf16_t*)(Qn + (size_t)(n * 128 + r) * 512 + hd * 128); },
      [=](int L, int cidx) { const int hd = L / NCH, n = L - hd * NCH; return cidx < 128 ? (const bf16_t*)(Kn + (size_t)(n * 128 + cidx) * 512 + hd * 128) : zrow; },
      KOffL(), KOffL(),
      ([=](int L, int row, int col0, const f32x4 (&a)[4]) {
        const int hd = L / NCH, n = L - hd * NCH;
        if (col0 < 128) {
          const int tt = n * 128 + row;
#pragma unroll
          for (int d = 0; d < 2; ++d) {
            const int dh = d * 4 + hd;
            const float bt = bc[(size_t)dh * T_ALL + tt];
            const float* cf = li + (size_t)dh * T_ALL + n * 128 + col0;
            f32x4 o[4];
#pragma unroll
            for (int nn = 0; nn < 4; ++nn) {
              const float4 c4 = *(const float4*)(cf + nn * 4);
              const float cv[4] = {c4.x, c4.y, c4.z, c4.w};
#pragma unroll
              for (int j = 0; j < 4; ++j) {
                const int sc = col0 + nn * 4 + j;
                const bool ok = (d == 0) ? (sc <= row) : (sc >= row);
                o[nn][j] = ok ? a[nn][j] * bt * cv[j] : 0.f;
              }
            }
            st16bf(AS + ((size_t)dh * T_ALL + tt) * 256 + col0, o);
          }
        }
      }));
    xcd_barrier(xbar);
    const unsigned* Clocp = (const unsigned*)(R + R1_CLOC);
    unsigned* CinTp = (unsigned*)CinT;
    for (int idx = gtid; idx < 8 * 16384; idx += gstride) {
      const int dh = idx >> 14, e = idx & 16383, d = dh >> 2;
      const bool hasn = idx < 8 * 128;
      const int dh2 = hasn ? (idx >> 7) : 0, kk = idx & 127, d2 = dh2 >> 2;
      float st = 0.f, st1 = 0.f, st2 = 0.f;
      for (int ib = 0; ib < NCH; ib += 10) {
        unsigned xv[10]; float gv[10], xv2[10], gv2[10];
#pragma unroll
        for (int u = 0; u < 10; ++u) { const int n = scan_order(d, ib + u); xv[u] = Clocp[(size_t)(dh * NCH + n) * 16384 + e]; gv[u] = egch[dh * NCH + n]; }
        if (hasn) {
#pragma unroll
          for (int u = 0; u < 10; ++u) { const int n = scan_order(d2, ib + u); xv2[u] = nloc[(dh2 * NCH + n) * 128 + kk]; gv2[u] = egch[dh2 * NCH + n]; }
        }
#pragma unroll
        for (int u = 0; u < 10; ++u) {
          const int n = scan_order(d, ib + u);
          CinTp[(size_t)(dh * NCH + n) * 16384 + e] = pack2(st, st1);
          st = gv[u] * st + lo2f(xv[u]); st1 = gv[u] * st1 + hi2f(xv[u]);
        }
        if (hasn) {
#pragma unroll
          for (int u = 0; u < 10; ++u) { const int n = scan_order(d2, ib + u); nin[(dh2 * NCH + n) * 128 + kk] = st2; st2 = gv2[u] * st2 + xv2[u]; }
        }
      }
    }
    xcd_barrier(xbar);
    gemm_bal<4, true, true>(shm, 4, vb, 1040, G,
      [=](int L, int r) { const int dh = L / NCH, n = L - dh * NCH; return (const bf16_t*)(AS + ((size_t)dh * T_ALL + n * 128 + r) * 256); },
      [=](int L, int cidx) { const int dh = L / NCH, n = L - dh * NCH, hd = dh & 3; return (const bf16_t*)(VT + ((size_t)n * 1024 + hd * 256 + cidx) * 128); },
      KOffL(),
      [=](int L, int kt) { const int dh = L / NCH, n = L - dh * NCH, hd = dh & 3;
        const int delta = (int)((CinT + (size_t)L * 32768) - (VT + ((size_t)n * 1024 + hd * 256) * 128));
        return kt < 2 ? kt * 64 : delta + (kt - 2) * 64; },
      ([=](int L, int row, int col0, const f32x4 (&a)[4]) {
        const int dh = L / NCH, n = L - dh * NCH;
        st16bf(hnum + ((size_t)dh * T_ALL + n * 128 + row) * 256 + col0, a);
      }));
    xcd_barrier(xbar);
    {
      const int tq = tid, lane = tq & 63, hd = lane >> 4, l16 = lane & 15;
      for (int tt = blockIdx.x * (NT / 64) + (tq >> 6); tt < T_ALL; tt += G * (NT / 64)) {
        const int n = tt >> 7;
        float hs[16];
#pragma unroll
        for (int e = 0; e < 16; ++e) hs[e] = 0.f;
#pragma unroll
        for (int d = 0; d < 2; ++d) {
          const int dh = d * 4 + hd;
          const size_t m = (size_t)dh * T_ALL + tt;
          const uint4 a0 = *(const uint4*)&AS[m * 256 + l16 * 16], a1 = *(const uint4*)&AS[m * 256 + l16 * 16 + 8];
          const uint4 x0 = *(const uint4*)&hnum[m * 256 + l16 * 16], x1 = *(const uint4*)&hnum[m * 256 + l16 * 16 + 8];
          const unsigned aa[8] = {a0.x, a0.y, a0.z, a0.w, a1.x, a1.y, a1.z, a1.w};
          float part = 0.f;
          if (l16 < 8) {
#pragma unroll
            for (int e = 0; e < 8; ++e) part += lo2f(aa[e]) + hi2f(aa[e]);
          } else {
            const float* np = nin + (dh * NCH + n) * 128 + (l16 - 8) * 16;
#pragma unroll
            for (int e = 0; e < 4; ++e) {
              const float4 nv = *(const float4*)(np + e * 4);
              part += lo2f(aa[2 * e]) * nv.x + hi2f(aa[2 * e]) * nv.y + lo2f(aa[2 * e + 1]) * nv.z + hi2f(aa[2 * e + 1]) * nv.w;
            }
          }
          part += __shfl_xor(part, 8); part += __shfl_xor(part, 4); part += __shfl_xor(part, 2); part += __shfl_xor(part, 1);
          const float dn = 1.f / fmaxf(fabsf(part), 1.f);
          const unsigned xx[8] = {x0.x, x0.y, x0.z, x0.w, x1.x, x1.y, x1.z, x1.w};
#pragma unroll
          for (int e = 0; e < 8; ++e) { hs[2 * e] += lo2f(xx[e]) * dn; hs[2 * e + 1] += hi2f(xx[e]) * dn; }
        }
        float ss = 0.f;
#pragma unroll
        for (int e = 0; e < 16; ++e) ss += hs[e] * hs[e];
        ss += __shfl_xor(ss, 8); ss += __shfl_xor(ss, 4); ss += __shfl_xor(ss, 2); ss += __shfl_xor(ss, 1);
        const float r = 1.f / sqrtf(ss * (1.f / 256.f) + EPSN);
        const int col = hd * 256 + l16 * 16;
        const uint4 o0 = *(const uint4*)&ZO[(size_t)tt * 1024 + col], o1 = *(const uint4*)&ZO[(size_t)tt * 1024 + col + 8];
        const unsigned oo[8] = {o0.x, o0.y, o0.z, o0.w, o1.x, o1.y, o1.z, o1.w};
        unsigned res[8];
#pragma unroll
        for (int e = 0; e < 4; ++e) {
          const float4 g4 = *(const float4*)&ng[col + e * 4];
          res[2 * e]     = pack2(hs[4 * e + 0] * r * g4.x * sigmoid_f(lo2f(oo[2 * e])),     hs[4 * e + 1] * r * g4.y * sigmoid_f(hi2f(oo[2 * e])));
          res[2 * e + 1] = pack2(hs[4 * e + 2] * r * g4.z * sigmoid_f(lo2f(oo[2 * e + 1])), hs[4 * e + 3] * r * g4.w * sigmoid_f(hi2f(oo[2 * e + 1])));
        }
        *(uint4*)&A2[(size_t)tt * 1024 + col] = make_uint4(res[0], res[1], res[2], res[3]);
        *(uint4*)&A2[(size_t)tt * 1024 + col + 8] = make_uint4(res[4], res[5], res[6], res[7]);
      }
    }
    xcd_barrier(xbar);
    const bf16_t* Wo = (const bf16_t*)(ws + W_MLOUT);
    auto epi_out = [=](int grow, int gcol0, const f32x4 (&a)[4]) { resid_epi(1, grow, gcol0, a); };
    dense_phase(shm, vb, G, A2, 1024, Wo, 1024, 4, 16, 2, epi_out);
    xcd_barrier(xbar);
  }
  moe_layer(1, 0);

  {
    norm_phase(P, 0, P.in[6] + 2 * 1024, 2, 0, 1, 0, false, false, 0, smem);
    xcd_barrier(xbar);
    bf16_t* Zg = (bf16_t*)(R + R2_ZG); bf16_t* Zx = (bf16_t*)(R + R2_ZX); bf16_t* xc = (bf16_t*)(R + R2_XC);
    bf16_t* LA = (bf16_t*)(R + R2_LA); bf16_t* U = (bf16_t*)(R + R2_U);
    float* cA = (float*)(R + R2_CA); float* cH = (float*)(R + R2_CH);
    float* cin = (float*)(R + R2_CIN); bf16_t* A3 = (bf16_t*)(R + R2_ZX);
    const float* cw = P.in[28]; const float* cb = P.in[29];
    const float* b_a = P.in[31]; const float* b_x = P.in[33];
    const float* SP = (const float*)(ws + W_SP);
    const bf16_t* Wt = (const bf16_t*)(ws + W_LRUIN);
    auto epi_in = [=](int grow, int gcol0, const f32x4 (&a)[4]) {
      if (gcol0 < 1280) {
        f32x4 bq[4];
#pragma unroll
        for (int n = 0; n < 4; ++n)
#pragma unroll
          for (int j = 0; j < 4; ++j) bq[n][j] = gelu_f(a[n][j]);
        st16bf(Zg + (size_t)grow * 1280 + gcol0, bq);
      } else st16bf(Zx + (size_t)grow * 1280 + gcol0 - 1280, a);
    };
    dense_phase<true>(shm, vb, G, hb, 1024, Wt, 1024, 10, 16, 2, epi_in);
    xcd_barrier(xbar);
    for (int idx = gtid; idx < T_ALL * 160; idx += gstride) {
      const int t = idx / 160, c0 = (idx - t * 160) * 8;
      const int lo = t < T_CTX ? 0 : T_CTX, hi = t < T_CTX ? T_CTX : T_ALL;
      float q[8];
#pragma unroll
      for (int e = 0; e < 8; ++e) q[e] = cb[c0 + e];
#pragma unroll
      for (int j = 0; j < 4; ++j) {
        const int tt = t + j - 2;
        if (tt >= lo && tt < hi) {
          const uint4 z = *(const uint4*)&Zx[(size_t)tt * 1280 + c0];
          const float4 w0 = *(const float4*)&cw[j * 1280 + c0], w1 = *(const float4*)&cw[j * 1280 + c0 + 4];
          q[0] += lo2f(z.x) * w0.x; q[1] += hi2f(z.x) * w0.y; q[2] += lo2f(z.y) * w0.z; q[3] += hi2f(z.y) * w0.w;
          q[4] += lo2f(z.z) * w1.x; q[5] += hi2f(z.z) * w1.y; q[6] += lo2f(z.w) * w1.z; q[7] += hi2f(z.w) * w1.w;
        }
      }
      uint4 o; o.x = pack2(q[0], q[1]); o.y = pack2(q[2], q[3]); o.z = pack2(q[4], q[5]); o.w = pack2(q[6], q[7]);
      *(uint4*)&xc[(size_t)t * 1280 + c0] = o;
    }
    xcd_barrier(xbar);
    {
      const bf16_t* WLG = (const bf16_t*)(ws + W_LRUG);
      {
        gemm_bal<8, true, false>(shm, 2, vb, 65 * 20, G,
          [=](int L, int r) { return (const bf16_t*)(xc + (size_t)((L / 20) * 256 + r) * 1280 + ((L % 20) >> 1) * 128); },
          [=](int L, int cidx) { return WLG + ((size_t)(L % 20) * 256 + cidx) * 128; },
          KOffL(), KOffL(),
          [=](int L, int rb, int col0, const auto& a) {
            constexpr int MIe = (int)(sizeof(a) / sizeof(a[0]));
            const int m0 = (L / 20) * 256, q = L % 20, nb = q >> 1, d = q & 1;
            const int c = nb * 128 + (col0 >> 1);
            float ba[8], bx[8], sp8[8];
            {
              const float4 t0 = *(const float4*)&b_a[d * 1280 + c], t1 = *(const float4*)&b_a[d * 1280 + c + 4];
              const float4 t2 = *(const float4*)&b_x[d * 1280 + c], t3 = *(const float4*)&b_x[d * 1280 + c + 4];
              const float4 t4 = *(const float4*)&SP[d * 1280 + c], t5 = *(const float4*)&SP[d * 1280 + c + 4];
              ba[0] = t0.x; ba[1] = t0.y; ba[2] = t0.z; ba[3] = t0.w; ba[4] = t1.x; ba[5] = t1.y; ba[6] = t1.z; ba[7] = t1.w;
              bx[0] = t2.x; bx[1] = t2.y; bx[2] = t2.z; bx[3] = t2.w; bx[4] = t3.x; bx[5] = t3.y; bx[6] = t3.z; bx[7] = t3.w;
              sp8[0] = -8.f * t4.x; sp8[1] = -8.f * t4.y; sp8[2] = -8.f * t4.z; sp8[3] = -8.f * t4.w;
              sp8[4] = -8.f * t5.x; sp8[5] = -8.f * t5.y; sp8[6] = -8.f * t5.z; sp8[7] = -8.f * t5.w;
            }
#pragma unroll
            for (int m = 0; m < MIe; ++m) {
              const int t = m0 + rb + 16 * m;
              const uint4 xv = *(const uint4*)&xc[(size_t)t * 1280 + c];
              const unsigned xx[4] = {xv.x, xv.y, xv.z, xv.w};
              float la8[8], u8[8];
#pragma unroll
              for (int e = 0; e < 8; ++e) {
                const float ra = a[m][e >> 2][e & 3] + ba[e];
                const float rx = a[m][2 + (e >> 2)][e & 3] + bx[e];
                const float la = sigmoid_f(ra) * sp8[e];
                const float x2 = 2.f * la;
                const float em = -x2 * (1.f + x2 * (0.5f + x2 * (0.16666667f + x2 * (0.041666668f + x2 * (0.0083333338f + x2 * 0.0013888889f)))));
                const float xe = (e & 1) ? hi2f(xx[e >> 1]) : lo2f(xx[e >> 1]);
                la8[e] = la;
                u8[e] = __builtin_amdgcn_sqrtf(em) * (sigmoid_f(rx) * xe);
              }
              uint4 o1, o2;
              o1.x = pack2(la8[0], la8[1]); o1.y = pack2(la8[2], la8[3]); o1.z = pack2(la8[4], la8[5]); o1.w = pack2(la8[6], la8[7]);
              o2.x = pack2(u8[0], u8[1]); o2.y = pack2(u8[2], u8[3]); o2.z = pack2(u8[4], u8[5]); o2.w = pack2(u8[6], u8[7]);
              *(uint4*)&LA[((size_t)d * T_ALL + t) * 1280 + c] = o1;
              *(uint4*)&U[((size_t)d * T_ALL + t) * 1280 + c] = o2;
            }
          });
      }
    }
    xcd_barrier(xbar);
    for (int idx = gtid; idx < 2 * NCH * 640; idx += gstride) {
      const int c = (idx % 640) * 2, dn = idx / 640, n = dn % NCH, d = dn / NCH;
      const bf16_t* la_p = LA + (size_t)d * T_ALL * 1280 + c;
      const bf16_t* u_p = U + (size_t)d * T_ALL * 1280 + c;
      float h0 = 0.f, h1 = 0.f, s0 = 0.f, s1 = 0.f;
      for (int sb = 0; sb < 128; sb += 16) {
        unsigned lv[16], uv[16];
#pragma unroll
        for (int e = 0; e < 16; ++e) {
          const size_t o = (size_t)(n * 128 + (d == 0 ? sb + e : 127 - sb - e)) * 1280;
          lv[e] = *(const unsigned*)(la_p + o); uv[e] = *(const unsigned*)(u_p + o);
        }
#pragma unroll
        for (int e = 0; e < 16; ++e) {
          const float l0 = lo2f(lv[e]), l1 = hi2f(lv[e]);
          h0 = __expf(l0) * h0 + lo2f(uv[e]); h1 = __expf(l1) * h1 + hi2f(uv[e]);
          s0 += l0; s1 += l1;
        }
      }
      *(float2*)&cA[(d * NCH + n) * 1280 + c] = make_float2(__expf(s0), __expf(s1));
      *(float2*)&cH[(d * NCH + n) * 1280 + c] = make_float2(h0, h1);
    }
    xcd_barrier(xbar);
    for (int idx = gtid; idx < 2 * 1280; idx += gstride) {
      const int d = idx / 1280, c = idx - d * 1280;
      float st = 0.f;
      for (int ib = 0; ib < NCH; ib += 10) {
        float av[10], hv[10];
#pragma unroll
        for (int u = 0; u < 10; ++u) { const int q = (d * NCH + scan_order(d, ib + u)) * 1280 + c; av[u] = cA[q]; hv[u] = cH[q]; }
#pragma unroll
        for (int u = 0; u < 10; ++u) { const int q = (d * NCH + scan_order(d, ib + u)) * 1280 + c; cin[q] = st; st = av[u] * st + hv[u]; }
      }
    }
    xcd_barrier(xbar);
    const int p2_per = (128 * 640 + G - 1) / G;
    for (int i2 = tid; i2 < p2_per; i2 += NT) {
      const int idx = blockIdx.x * p2_per + i2;
      if (idx >= 128 * 640) break;
      const int c = (idx % 640) * 2, n = 2 + idx / 640;
      float h0, h1;
      { const float2 c2 = *(const float2*)&cin[(0 * NCH + n) * 1280 + c]; h0 = c2.x; h1 = c2.y; }
      for (int sb = 0; sb < 128; sb += 16) {
        unsigned lv[16], uv[16];
#pragma unroll
        for (int e = 0; e < 16; ++e) { const size_t o = (size_t)(n * 128 + sb + e) * 1280 + c; lv[e] = *(const unsigned*)&LA[o]; uv[e] = *(const unsigned*)&U[o]; }
#pragma unroll
        for (int e = 0; e < 16; ++e) {
          h0 = __expf(lo2f(lv[e])) * h0 + lo2f(uv[e]); h1 = __expf(hi2f(lv[e])) * h1 + hi2f(uv[e]);
          *(unsigned*)&A3[(size_t)(n * 128 + sb + e) * 1280 + c] = pack2(h0, h1);
        }
      }
      { const float2 c2 = *(const float2*)&cin[(1 * NCH + n) * 1280 + c]; h0 = c2.x; h1 = c2.y; }
      for (int sb = 0; sb < 128; sb += 16) {
        unsigned lv[16], uv[16], gv[16], hp[16];
#pragma unroll
        for (int e = 0; e < 16; ++e) {
          const size_t o = (size_t)(n * 128 + 127 - sb - e) * 1280 + c;
          lv[e] = *(const unsigned*)&LA[(size_t)T_ALL * 1280 + o]; uv[e] = *(const unsigned*)&U[(size_t)T_ALL * 1280 + o];
          gv[e] = *(const unsigned*)&Zg[o]; hp[e] = *(const unsigned*)&A3[o];
        }
#pragma unroll
        for (int e = 0; e < 16; ++e) {
          h0 = __expf(lo2f(lv[e])) * h0 + lo2f(uv[e]); h1 = __expf(hi2f(lv[e])) * h1 + hi2f(uv[e]);
          *(unsigned*)&A3[(size_t)(n * 128 + 127 - sb - e) * 1280 + c] = pack2(lo2f(gv[e]) * (lo2f(hp[e]) + h0), hi2f(gv[e]) * (hi2f(hp[e]) + h1));
        }
      }
    }
    xcd_barrier(xbar);
    const bf16_t* Wo = (const bf16_t*)(ws + W_LRUOUT);
    auto epi_out = [=](int grow, int gcol0, const f32x4 (&a)[4]) { resid_epi(2, grow, gcol0, a); };
    dense_phase(shm, vb, G, A3, 1280, Wo, 1280, 4, 20, 0, epi_out);
    xcd_barrier(xbar);
  }
  moe_layer(2, T_CTX);

  {
    norm_phase(P, T_CTX, P.in[6] + 3 * 1024, 3, 0, 2, T_CTX, false, false, 0, smem);
    xcd_barrier(xbar);
    bf16_t* YT = (bf16_t*)(R + R3_YT); bf16_t* GT = (bf16_t*)(R + R3_GT); bf16_t* Ff = (bf16_t*)(R + R3_FF);
    const bf16_t* WP = (const bf16_t*)(ws + W_FNP);
    gemm_run<8, true>(shm, 16, vb, 64 * 8, G,
      [=](int L, int r) { return WP + (size_t)((L & 7) * 256 + r) * 1024; },
      [=](int L, int cidx) { return (const bf16_t*)(hb + (size_t)(T_CTX + 128 * (cidx & 127) + 2 * (L >> 3) + (cidx >> 7)) * DM); }, KOffL(), KOffL(),
      per_m([=](int L, int row, int col0, const f32x4 (&a)[4]) {
        const int b = 2 * (L >> 3) + (col0 >> 7), a0 = col0 & 127, nrow = (L & 7) * 256 + row;
        st16bf(YT + ((size_t)b * 2048 + nrow) * 128 + a0, a);
      }));
    xcd_barrier(xbar);
    {
      const bf16_t* DA = (const bf16_t*)(ws + W_DA);
      gemm_run<8, true>(shm, 4, vb, 512, G,
        [=](int L, int r) { return DA + (size_t)r * 256; },
        [=](int L, int cidx) { return (const bf16_t*)(YT + ((size_t)(cidx & 127) * 2048 + 2 * L + (cidx >> 7)) * 128); },
        KOffL(), [=](int L, int kt) { return kt < 2 ? kt * 64 : 1024 * 128 + (kt - 2) * 64; },
        per_m([=](int L, int row, int col0, const f32x4 (&a)[4]) {
          const int ri = row >> 7, c2 = row & 127, colc = 2 * L + (col0 >> 7), b0 = col0 & 127;
          st16bf(GT + (((size_t)c2 * 1024 + colc) * 2 + ri) * 128 + b0, a);
        }));
    }
    xcd_barrier(xbar);
    {
      const bf16_t* TW = (const bf16_t*)(ws + W_TW);
      gemm_loop<4, true>(shm, 4, vb, 128 * 4, G,
        [=](int L, int r) { return TW + ((size_t)(L >> 2) * 128 + r) * 256; },
        [=](int L, int cidx) { return (const bf16_t*)(GT + ((size_t)(L >> 2) * 1024 + (L & 3) * 256 + cidx) * 256); }, KOffL(), KOffL(),
        per_m([=](int L, int row, int col0, const f32x4 (&a)[4]) {
          const int c2 = L >> 2, n0 = (L & 3) * 256;
          f32x4 b[4];
#pragma unroll
          for (int n = 0; n < 4; ++n) b[n] = a[n] * (1.f / 2048.f);
          st16bf(Ff + (size_t)(c2 + 128 * row) * 1024 + n0 + col0, b);
        }));
    }
    xcd_barrier(xbar);
    const bf16_t* Wo = (const bf16_t*)(ws + W_FNOUT);
    const bf16_t* FfA = Ff - (size_t)T_CTX * 1024;
    auto epi_out = [=](int grow, int gcol0, const f32x4 (&a)[4]) { resid_epi(3, grow, gcol0, a); };
    dense_phase(shm, vb, G, FfA, 1024, Wo, 1024, 4, 16, 0, epi_out);
    xcd_barrier(xbar);
  }
  moe_layer(3, T_CTX);

  norm_phase(P, T_CTX, P.in[8], 0, -1, 3, T_CTX, true, false, 0, smem);
}

#undef tid
#undef gtid
#undef gstride
extern "C" void kernel_launch(void* const* d_in, const int* in_sizes, int n_in, void* d_out, int out_size,
                              void* d_ws, size_t ws_size, hipStream_t stream) {
  static int grid_blocks = 0;
  if (!grid_blocks) {
    int dev = 0, cus = 0, per_cu = 0;
    (void)hipGetDevice(&dev);
    (void)hipDeviceGetAttribute(&cus, hipDeviceAttributeMultiprocessorCount, dev);
    (void)hipOccupancyMaxActiveBlocksPerMultiprocessor(&per_cu, mega, NT, 0);
    if (per_cu < 1) fprintf(stderr, "kernel_launch: occupancy query says %d blocks/CU\n", per_cu);
    grid_blocks = cus;
    if (ws_size < WS_NEED) fprintf(stderr, "kernel_launch: workspace too small: %zu < %zu\n", ws_size, (size_t)WS_NEED);
  }
  if (n_in != 38 || ws_size < WS_NEED) return;
  Params p{};
  for (int i = 0; i < 38; ++i) p.in[i] = (const float*)d_in[i];
  p.out = (float*)d_out;
  p.ws = (unsigned char*)d_ws;
  (void)hipMemsetAsync((char*)d_ws + WS_BAR, 0, 16384, stream);
  void* args[] = {&p};
  hipError_t e = hipLaunchCooperativeKernel((void*)mega, dim3(grid_blocks), dim3(NT), args, 0, stream);
  if (e != hipSuccess) fprintf(stderr, "cooperative launch failed: %s (grid %d)\n", hipGetErrorString(e), grid_blocks);
}
```
